# Optimizing an MI355X kernel written in HIP

```python
import jax, jax.numpy as jnp
from jax import lax
import numpy as np

D_MODEL = 1024
BATCH = 8
SEQ = 2048
DEPTH = 2

GRID_W = 64
CTX_LEN = 256
BRANCH_WIDTH = 512
N_BRANCH = 3
LRU_WIDTH = BRANCH_WIDTH
LRU_BLOCKS = 8
LRU_BLOCK = LRU_WIDTH // LRU_BLOCKS
LRU_C = 8.0
CONV_W = 4
CONV_LEFT = 2
HG_HEADS = 4
HG_DK = 128
HG_DV = BRANCH_WIDTH // HG_HEADS
HG_QK = HG_HEADS * HG_DK
HG_WIDTH = HG_HEADS * HG_DV
HG_CHUNK = 64
NA_HEADS = 8
NA_DH = BRANCH_WIDTH // NA_HEADS
NA_WIDTH = NA_HEADS * NA_DH
WIN_R = 8
WIN_C = 16
ROPE_BASE = 10000.0
MASK_VALUE = -1e30
D_FF = 4 * D_MODEL
EPS = 1e-6
PROJ_SIZES = (LRU_WIDTH, LRU_WIDTH, HG_QK, 2 * HG_QK, HG_WIDTH, HG_WIDTH, 3 * NA_WIDTH, N_BRANCH * D_MODEL)
D_IN = sum(PROJ_SIZES)

kernel_name = 'hybrid_rglru_hgrn2_natten_dit_block'

F32 = jnp.float32


def rms_norm(x, g):
    x32 = x.astype(F32)
    y = x32 * lax.rsqrt(jnp.mean(jnp.square(x32), axis=-1, keepdims=True) + EPS)
    return (y * g.astype(F32)).astype(x.dtype)


def modulation(cond, w, b):
    m = (jax.nn.silu(cond) @ w + b)[..., None, :]
    return jnp.split(m, 6, axis=-1)


def split_projection(p):
    idx = np.cumsum(PROJ_SIZES)[:-1].tolist()
    return jnp.split(p, idx, axis=-1)


def centred_depthwise_conv(x, w, b):
    T = x.shape[1]
    xp = jnp.pad(x, ((0, 0), (CONV_LEFT, CONV_W - 1 - CONV_LEFT), (0, 0)))
    out = b
    for j in range(CONV_W):
        out = out + xp[:, j:j + T] * w[j]
    return out


def _lin_combine(left, right):
    a_l, b_l = left
    a_r, b_r = right
    return a_l * a_r, a_r * b_l + b_r


def linear_scan(a, b, h0, reverse):
    a_cum, h = lax.associative_scan(_lin_combine, (a, b), reverse=reverse, axis=1)
    if h0 is not None:
        h = h + a_cum * h0[:, None]
    return h


def rglru_branch(x_in, gate_in, conv_w, conv_b, wa, ba, wx, bx, lam, h0):
    B, T, _ = x_in.shape
    xc = centred_depthwise_conv(x_in, conv_w, conv_b).astype(F32)
    xb = xc.reshape(B, T, LRU_BLOCKS, LRU_BLOCK)
    r = jax.nn.sigmoid(jnp.einsum('btni,dnio->dbtno', xb, wa.astype(F32)).reshape(2, B, T, LRU_WIDTH) + ba.astype(F32)[:, None, None])
    i = jax.nn.sigmoid(jnp.einsum('btni,dnio->dbtno', xb, wx.astype(F32)).reshape(2, B, T, LRU_WIDTH) + bx.astype(F32)[:, None, None])
    log_a = -LRU_C * r * jax.nn.softplus(-lam.astype(F32))[:, None, None]
    a = jnp.exp(log_a)
    b = jnp.sqrt(-jnp.expm1(2.0 * log_a)) * (i * xc[None])
    h0f, h0b = (None, None) if h0 is None else (h0[0], h0[1])
    hf = linear_scan(a[0], b[0], h0f, False)
    hb = linear_scan(a[1], b[1], h0b, True)
    y = ((hf + hb) * jax.nn.gelu(gate_in.astype(F32))).astype(x_in.dtype)
    return y, jnp.stack([hf[:, -1], hb[:, 0]])


def gated_linear_chunks(q, k, v, g, s0):
    B, T, H, _ = q.shape
    n = T // HG_CHUNK

    def chunks(t):
        return t.reshape(B, n, HG_CHUNK, H, t.shape[-1]).transpose(1, 0, 3, 2, 4)

    qc, kc, vc = chunks(q), chunks(k), chunks(v)
    bc = jnp.cumsum(chunks(g), axis=3)
    incl = jnp.tril(jnp.ones((HG_CHUNK, HG_CHUNK), dtype=bool))

    def step(S, inp):
        qi, ki, vi, bi = inp
        diff = bi[:, :, :, None, :] - bi[:, :, None, :, :]
        decay = jnp.where(incl[:, :, None], jnp.exp(jnp.minimum(diff, 0.0)), 0.0)
        att = jnp.einsum('bhtd,bhsd,bhtsd->bhts', qi, ki, decay)
        o = att @ vi + jnp.einsum('bhtd,bhde->bhte', qi * jnp.exp(bi), S)
        b_last = bi[:, :, -1:, :]
        S = jnp.exp(b_last[:, :, 0, :, None]) * S + jnp.einsum('bhsd,bhse->bhde', ki * jnp.exp(b_last - bi), vi)
        return S, o

    s_fin, o = lax.scan(step, s0, (qc, kc, vc, bc))
    return o.transpose(1, 0, 3, 2, 4).reshape(B, T, H, -1), s_fin


def hgrn2_direction(q, f_raw, v, lb, s0, reverse):
    f = lb + (1.0 - lb) * jax.nn.sigmoid(f_raw)
    g = jnp.log(f)
    k = 1.0 - f
    if reverse:
        q, k, v, g = (jnp.flip(t, axis=1) for t in (q, k, v, g))
    o, s = gated_linear_chunks(q, k, v, g, s0)
    if reverse:
        o = jnp.flip(o, axis=1)
    return o, s


def hgrn2_branch(q_raw, f_raw, i_raw, og_raw, lb, norm_g, s0):
    B, T, _ = q_raw.shape
    q = jax.nn.silu(q_raw.astype(F32)).reshape(B, T, HG_HEADS, HG_DK)
    f = f_raw.astype(F32).reshape(B, T, 2, HG_HEADS, HG_DK)
    v = i_raw.astype(F32).reshape(B, T, HG_HEADS, HG_DV)
    lbh = lb.reshape(2, HG_HEADS, HG_DK)
    if s0 is None:
        s0 = jnp.zeros((2, B, HG_HEADS, HG_DK, HG_DV), F32)
    o_f, s_f = hgrn2_direction(q, f[:, :, 0], v, lbh[0], s0[0], False)
    o_b, s_b = hgrn2_direction(q, f[:, :, 1], v, lbh[1], s0[1], True)
    o = rms_norm(o_f + o_b, norm_g) * jax.nn.sigmoid(og_raw.astype(F32).reshape(B, T, HG_HEADS, HG_DV))
    return o.reshape(B, T, HG_WIDTH).astype(q_raw.dtype), jnp.stack([s_f, s_b])


def na_heads(qkv, q_g, k_g):
    B, T, _ = qkv.shape
    qkv = qkv.reshape(B, T, 3, NA_HEADS, NA_DH)
    return rms_norm(qkv[:, :, 0], q_g), rms_norm(qkv[:, :, 1], k_g), qkv[:, :, 2]


def axial_rope(x):
    T, dh = x.shape[1], x.shape[-1]
    half = dh // 2
    nf = half // 2
    t = jnp.arange(T)
    inv_freq = ROPE_BASE ** (-jnp.arange(nf, dtype=F32) / nf)

    def rotate(xh, pos):
        ang = pos.astype(F32)[:, None] * inv_freq
        cos = jnp.cos(ang)[None, :, None, :]
        sin = jnp.sin(ang)[None, :, None, :]
        x1 = xh[..., :nf].astype(F32)
        x2 = xh[..., nf:].astype(F32)
        return jnp.concatenate([x1 * cos - x2 * sin, x2 * cos + x1 * sin], axis=-1)

    out = jnp.concatenate([rotate(x[..., :half], t // GRID_W), rotate(x[..., half:], t % GRID_W)], axis=-1)
    return out.astype(x.dtype)


def neighbourhood_attention(q, k, v, q_plain, k_ctx, v_ctx, rpb):
    B, T, H, dh = q.shape
    rows = T // GRID_W
    wr = min(WIN_R, rows)
    scale = dh ** -0.5
    r = jnp.arange(rows)
    key_rows = jnp.clip(r - wr // 2, 0, rows - wr)[:, None] + jnp.arange(wr)
    col = jnp.arange(GRID_W)
    c_start = jnp.clip(col - WIN_C // 2, 0, GRID_W - WIN_C)
    col_ok = (col[None, :] >= c_start[:, None]) & (col[None, :] < c_start[:, None] + WIN_C)
    d_row = key_rows - r[:, None] + (WIN_R - 1)
    d_col = jnp.clip(col[None, :] - col[:, None], -(WIN_C - 1), WIN_C - 1) + (WIN_C - 1)
    bias = rpb.astype(F32)[:, d_row[:, None, :, None], d_col[None, :, None, :]]

    qg = q.reshape(B, rows, GRID_W, H, dh)
    kg = k.reshape(B, rows, GRID_W, H, dh)[:, key_rows]
    vg = v.reshape(B, rows, GRID_W, H, dh)[:, key_rows]
    s_loc = jnp.einsum('brqhd,brwchd->bhrqwc', qg, kg).astype(F32) * scale + bias[None]
    s_loc = jnp.where(col_ok[:, None, :], s_loc, MASK_VALUE)
    s_ctx = jnp.einsum('brqhd,blhd->bhrql', q_plain.reshape(B, rows, GRID_W, H, dh), k_ctx).astype(F32) * scale
    n_loc = wr * GRID_W
    s = jnp.concatenate([s_loc.reshape(B, H, rows, GRID_W, n_loc), s_ctx], axis=-1)
    p = jax.nn.softmax(s, axis=-1).astype(v.dtype)
    p_loc = p[..., :n_loc].reshape(B, H, rows, GRID_W, wr, GRID_W)
    p_ctx = p[..., n_loc:]
    o = jnp.einsum('bhrqwc,brwchd->brqhd', p_loc, vg) + jnp.einsum('bhrql,blhd->brqhd', p_ctx, v_ctx)
    return o.reshape(B, T, H * dh)


def context_attention(q, k, v):
    B, L, H, dh = q.shape
    s = jnp.einsum('bqhd,bkhd->bhqk', q, k).astype(F32) * dh ** -0.5
    p = jax.nn.softmax(s, axis=-1).astype(v.dtype)
    return jnp.einsum('bhqk,bkhd->bqhd', p, v).reshape(B, L, H * dh)


def merge_branches(ya, yb, yc, gate_raw, w_branch, w_out):
    ys = jnp.stack([ya, yb, yc], axis=-2)
    proj = jnp.einsum('btnw,nwd->btnd', ys, w_branch)
    g = jax.nn.sigmoid(gate_raw.reshape(gate_raw.shape[:-1] + (N_BRANCH, D_MODEL)))
    return jnp.sum(g * proj, axis=-2) @ w_out


def sq_relu_ffn(u, w1, w2):
    return jnp.square(jax.nn.relu(u @ w1)) @ w2


def setup_inputs(seed: int = 0) -> dict:
    key = jax.random.key(seed)
    ks = jax.random.split(key, 26)

    def nrm(k, shape, s):
        return jax.random.normal(k, shape, F32) * s

    a0 = jax.random.uniform(ks[15], (DEPTH, 2, LRU_WIDTH), F32, 0.9, 0.999)
    root = a0 ** (1.0 / LRU_C)
    lru_lambda = jnp.log(root) - jnp.log1p(-root)
    return {
        'x': nrm(ks[0], (BATCH, SEQ, D_MODEL), 1.0),
        'c': nrm(ks[1], (BATCH, D_MODEL), 1.0),
        'ctx': nrm(ks[2], (BATCH, CTX_LEN, D_MODEL), 1.0),
        'c_ctx': nrm(ks[3], (D_MODEL,), 1.0),
        'ada_w': nrm(ks[4], (DEPTH, D_MODEL, 6 * D_MODEL), 0.5 * D_MODEL ** -0.5),
        'ada_b': nrm(ks[5], (DEPTH, 6 * D_MODEL), 0.02),
        'norm1_g': 1.0 + nrm(ks[6], (DEPTH, D_MODEL), 0.02),
        'norm2_g': 1.0 + nrm(ks[7], (DEPTH, D_MODEL), 0.02),
        'w_in': nrm(ks[8], (DEPTH, D_MODEL, D_IN), D_MODEL ** -0.5),
        'conv_w': nrm(ks[9], (DEPTH, CONV_W, LRU_WIDTH), CONV_W ** -0.5),
        'conv_b': nrm(ks[10], (DEPTH, LRU_WIDTH), 0.02),
        'lru_wa': nrm(ks[11], (DEPTH, 2, LRU_BLOCKS, LRU_BLOCK, LRU_BLOCK), LRU_BLOCK ** -0.5),
        'lru_ba': nrm(ks[12], (DEPTH, 2, LRU_WIDTH), 0.02),
        'lru_wx': nrm(ks[13], (DEPTH, 2, LRU_BLOCKS, LRU_BLOCK, LRU_BLOCK), LRU_BLOCK ** -0.5),
        'lru_bx': nrm(ks[14], (DEPTH, 2, LRU_WIDTH), 0.02),
        'lru_lambda': lru_lambda,
        'hg_lb_logits': nrm(ks[16], (2, DEPTH, HG_QK), 0.1),
        'hg_norm_g': 1.0 + nrm(ks[17], (DEPTH, HG_DV), 0.02),
        'na_q_norm_g': 1.0 + nrm(ks[18], (DEPTH, NA_DH), 0.02),
        'na_k_norm_g': 1.0 + nrm(ks[19], (DEPTH, NA_DH), 0.02),
        'na_rpb': nrm(ks[20], (DEPTH, NA_HEADS, 2 * WIN_R - 1, 2 * WIN_C - 1), 0.1),
        'w_branch': nrm(ks[21], (DEPTH, N_BRANCH, BRANCH_WIDTH, D_MODEL), BRANCH_WIDTH ** -0.5),
        'w_out': nrm(ks[22], (DEPTH, D_MODEL, D_MODEL), D_MODEL ** -0.5),
        'ffn_w1': nrm(ks[23], (DEPTH, D_MODEL, D_FF), D_MODEL ** -0.5),
        'ffn_w2': nrm(ks[24], (DEPTH, D_FF, D_MODEL), D_FF ** -0.5),
    }


def reference(x, c, ctx, c_ctx, ada_w, ada_b, norm1_g, norm2_g, w_in, conv_w, conv_b,
              lru_wa, lru_ba, lru_wx, lru_bx, lru_lambda, hg_lb_logits, hg_norm_g,
              na_q_norm_g, na_k_norm_g, na_rpb, w_branch, w_out, ffn_w1, ffn_w2):
    lb_soft = jax.nn.softmax(hg_lb_logits.astype(F32), axis=1)
    lower_bounds = jnp.cumsum(lb_soft, axis=1) - lb_soft[:, :1]
    h, hc = x, ctx
    for l in range(DEPTH):
        ctx_needed = l < DEPTH - 1
        sh1, sc1, gt1, sh2, sc2, gt2 = modulation(c, ada_w[l], ada_b[l])
        sh1c, sc1c, gt1c, sh2c, sc2c, gt2c = modulation(c_ctx, ada_w[l], ada_b[l])
        u = rms_norm(h, norm1_g[l]) * (1.0 + sc1) + sh1
        uc = rms_norm(hc, norm1_g[l]) * (1.0 + sc1c) + sh1c
        a_x, a_g, b_q, b_f, b_i, b_o, c_qkv, m_g = split_projection(u @ w_in[l])
        a_xc, a_gc, b_qc, b_fc, b_ic, b_oc, c_qkvc, m_gc = split_projection(uc @ w_in[l])

        lru_p = (conv_w[l], conv_b[l], lru_wa[l], lru_ba[l], lru_wx[l], lru_bx[l], lru_lambda[l])
        ya_c, lru_state = rglru_branch(a_xc, a_gc, *lru_p, None)
        ya, _ = rglru_branch(a_x, a_g, *lru_p, lru_state)

        lb = lower_bounds[:, l]
        yb_c, hg_state = hgrn2_branch(b_qc, b_fc, b_ic, b_oc, lb, hg_norm_g[l], None)
        yb, _ = hgrn2_branch(b_q, b_f, b_i, b_o, lb, hg_norm_g[l], hg_state)

        q_c, k_c, v_c = na_heads(c_qkvc, na_q_norm_g[l], na_k_norm_g[l])
        q_l, k_l, v_l = na_heads(c_qkv, na_q_norm_g[l], na_k_norm_g[l])
        yc = neighbourhood_attention(axial_rope(q_l), axial_rope(k_l), v_l, q_l, k_c, v_c, na_rpb[l])

        h = h + gt1 * merge_branches(ya, yb, yc, m_g, w_branch[l], w_out[l])
        h = h + gt2 * sq_relu_ffn(rms_norm(h, norm2_g[l]) * (1.0 + sc2) + sh2, ffn_w1[l], ffn_w2[l])
        if ctx_needed:
            yc_c = context_attention(q_c, k_c, v_c)
            hc = hc + gt1c * merge_branches(ya_c, yb_c, yc_c, m_gc, w_branch[l], w_out[l])
            hc = hc + gt2c * sq_relu_ffn(rms_norm(hc, norm2_g[l]) * (1.0 + sc2c) + sh2c, ffn_w1[l], ffn_w2[l])
    return h
```

```cpp
#include <hip/hip_runtime.h>
#include <hip/hip_cooperative_groups.h>
#include <stdint.h>
#include <stdio.h>
namespace cg = cooperative_groups;

#define DBG_HG 0
#define LAS __attribute__((address_space(3)))
typedef unsigned short bf16_t;
typedef short bf16x8 __attribute__((ext_vector_type(8)));
typedef float f32x4 __attribute__((ext_vector_type(4)));
typedef unsigned u32x4 __attribute__((ext_vector_type(4)));
typedef unsigned u32x2 __attribute__((ext_vector_type(2)));

constexpr int DM = 1024, NB = 8, SEQ = 2048, CTXL = 256, NLAT = NB * SEQ, NCTX = NB * CTXL, NTOK = NLAT + NCTX;
constexpr int PW = 5120, DIN = 8192, DFF = 4096;
constexpr int C_AX = 0, C_AG = 512, C_BQ = 1024, C_BF = 1536, C_BI = 2560, C_BO = 3072, C_CQ = 3584, C_CK = 4096, C_CV = 4608;
constexpr int LDS_BYTES = 131072;
constexpr size_t WS_WIN = 0;
constexpr size_t WS_WB = WS_WIN + (size_t)DIN * DM * 2;
constexpr size_t WS_WO = WS_WB + (size_t)3 * DM * 512 * 2;
constexpr size_t WS_W1 = WS_WO + (size_t)DM * DM * 2;
constexpr size_t WS_W2 = WS_W1 + (size_t)DFF * DM * 2;
constexpr size_t WS_U = WS_W2 + (size_t)DM * DFF * 2;
constexpr size_t WS_P = WS_U + (size_t)NTOK * DM * 2;
constexpr size_t WS_HC = WS_P + (size_t)NTOK * PW * 2;
constexpr size_t WS_MOD = WS_HC + (size_t)NCTX * DM * 4;
constexpr size_t WS_AGG = WS_MOD + (size_t)2 * 9 * 6144 * 4;
constexpr size_t WS_ROPE = WS_AGG + (size_t)NB * 36 * 2 * 2 * 512 * 4;
constexpr size_t WS_END = WS_ROPE + 2048 * 4;

struct Params {
    const float *x, *c, *ctx, *c_ctx, *ada_w, *ada_b, *norm1_g, *norm2_g, *w_in, *conv_w, *conv_b, *lru_wa, *lru_ba, *lru_wx, *lru_bx, *lru_lambda,
        *hg_lb, *hg_norm_g, *na_qg, *na_kg, *na_rpb, *w_branch, *w_out, *ffn_w1, *ffn_w2;
    float* out; unsigned char* ws;
};


__device__ __forceinline__ unsigned long long ldkarg(int off) { unsigned long long v = 0;
#if defined(__HIP_DEVICE_COMPILE__)
    auto kp = __builtin_amdgcn_kernarg_segment_ptr();
    asm volatile("s_load_dwordx2 %0, %1, %2\n\ts_waitcnt lgkmcnt(0)" : "=s"(v) : "s"(kp), "s"(off));
#endif
    return v; }
#define PF(f) ((decltype(Params::f))ldkarg((int)__builtin_offsetof(Params, f)))

template <class T> __device__ __forceinline__ T* lnd(T* p) { asm volatile("" : "+v"(p)); return p; }
__device__ __forceinline__ int tid_() { int t = threadIdx.x; asm volatile("" : "+v"(t)); return t; }
__device__ __forceinline__ float bf2f(unsigned v) { return __uint_as_float(v << 16); }
__device__ __forceinline__ float bflo(unsigned w) { return __uint_as_float(w << 16); }
__device__ __forceinline__ float bfhi(unsigned w) { return __uint_as_float(w & 0xffff0000u); }
__device__ __forceinline__ unsigned f2bf(float f) { unsigned u = __float_as_uint(f); u += 0x7fffu + ((u >> 16) & 1u); return u >> 16; }
typedef __bf16 bf16x2_t __attribute__((ext_vector_type(2)));
typedef float f32x2_t __attribute__((ext_vector_type(2)));
__device__ __forceinline__ unsigned pack2(float lo, float hi) { f32x2_t v = {lo, hi}; bf16x2_t b = __builtin_convertvector(v, bf16x2_t); union { bf16x2_t b; unsigned u; } t; t.b = b; return t.u; }
__device__ __forceinline__ float sigmoidf_(float x) { return 1.0f / (1.0f + __expf(-x)); }
__device__ __forceinline__ f32x4 mfma16(bf16x8 a, bf16x8 b, f32x4 c) { return __builtin_amdgcn_mfma_f32_16x16x32_bf16(a, b, c, 0, 0, 0); }
__device__ __forceinline__ bf16x8 as_bf16x8(u32x4 v) { union { u32x4 u; bf16x8 b; } t; t.u = v; return t.b; }
__device__ __forceinline__ void unpack8(u32x4 w, float* o) { o[0] = bflo(w.x); o[1] = bfhi(w.x); o[2] = bflo(w.y); o[3] = bfhi(w.y); o[4] = bflo(w.z); o[5] = bfhi(w.z); o[6] = bflo(w.w); o[7] = bfhi(w.w); }
__device__ __forceinline__ u32x4 pack8(const float* v) { u32x4 w; w.x = pack2(v[0], v[1]); w.y = pack2(v[2], v[3]); w.z = pack2(v[4], v[5]); w.w = pack2(v[6], v[7]); return w; }

namespace pg8 {
constexpr int BM = 256, BK = 64, HALF = 128, HTB = HALF * BK * 2, NXCD = 8, WGM = 8;
__device__ __forceinline__ int lds_byte(int r, int c) { const int st = (r >> 4) * 2 + (c >> 5), rr = r & 15, cc = c & 31, ob = rr * 64 + cc * 2; return st * 1024 + (ob ^ (((ob >> 9) & 1) << 5)); }
__device__ __forceinline__ void stage_rc(int b, int& R, int& C) { const int st = b / 1024, sb = b % 1024, swz = sb ^ (((sb >> 9) & 1) << 5); R = (st >> 1) * 16 + swz / 64; C = (st & 1) * 32 + (swz % 64) / 2; }
__device__ __forceinline__ int perm32(int rho) { const int n = rho >> 4, i = rho & 15; return 8 * (i >> 2) + 4 * n + (i & 3); }

struct Unit { int pm, pn; size_t aoff, boff; };
struct Gemm { const bf16_t* A; const bf16_t* Bt; int lda, ldb, K; };
struct Sched {
    int nM, nN, nwg, G, c, lda, ldb;
    __device__ void init(int M, int N, int G_, int c_, int lda_, int ldb_) { nM = M / BM; nN = N / BM; nwg = nM * nN; G = G_; c = c_; lda = lda_; ldb = ldb_; }
    __device__ bool next(int i, Unit& u) const {
        const long L = (long)i * G + c; if (L >= nwg) return false;
        int wgid = (int)L; { const int q = nwg / NXCD, r = nwg % NXCD, xcd = wgid % NXCD, off = wgid / NXCD; wgid = (xcd < r ? xcd * (q + 1) : r * (q + 1) + (xcd - r) * q) + off; }
        const int nig = WGM * nN, gid = wgid / nig, fm = gid * WGM, gsz = (nM - fm) < WGM ? (nM - fm) : WGM;
        u.pm = fm + ((wgid % nig) % gsz); u.pn = (wgid % nig) / gsz;
        u.aoff = (size_t)u.pm * BM * lda * 2;
        u.boff = (size_t)u.pn * BM * ldb * 2;
        return true;
    }
};

template <int ACT> struct EpiStore {
    static constexpr bool PERM = true;
    bf16_t* O; int ldc;
    __device__ __forceinline__ void operator()(const f32x4 (&acc)[2][2][4][2], const Unit& u, int wr, int wc, int fr, int fq) const {
        const int row0 = u.pm * BM + wr * 64 + fr; int colt = u.pn * BM;
        if (ACT == 1) colt = (colt < 2048) ? (1024 + colt) : (2048 + colt);
        const int col0 = colt + wc * 32 + 8 * fq;
#pragma unroll
        for (int ai = 0; ai < 2; ++ai)
#pragma unroll
            for (int m = 0; m < 4; ++m) { bf16_t* rowp = lnd(O + (size_t)(row0 + ai * HALF + m * 16) * ldc + col0);
#pragma unroll
                for (int bj = 0; bj < 2; ++bj) { f32x4 v0 = acc[ai][bj][m][0], v1 = acc[ai][bj][m][1];
                    if (ACT == 1) {
#pragma unroll
                        for (int j = 0; j < 4; ++j) { v0[j] = sigmoidf_(v0[j]); v1[j] = sigmoidf_(v1[j]); } }
                    if (ACT == 2) {
#pragma unroll
                        for (int j = 0; j < 4; ++j) { float a = fmaxf(v0[j], 0.f), b = fmaxf(v1[j], 0.f); v0[j] = a * a; v1[j] = b * b; } }
                    u32x4 w; w.x = pack2(v0[0], v0[1]); w.y = pack2(v0[2], v0[3]); w.z = pack2(v1[0], v1[1]); w.w = pack2(v1[2], v1[3]);
                    *(u32x4*)(rowp + bj * HALF) = w; } }
    }
};
struct EpiMerge {
    static constexpr bool PERM = true;
    const bf16_t* P; bf16_t* U; int sub;
    __device__ __forceinline__ void operator()(const f32x4 (&acc)[2][2][4][2], const Unit& u, int wr, int wc, int fr, int fq) const {
        const int row0 = u.pm * BM + wr * 64 + fr; const int col0 = u.pn * BM + wc * 32 + 8 * fq;
        const int gcol = sub * 1024 + u.pn * BM; const int gd = ((gcol < 2048) ? (1024 + gcol) : (2048 + gcol)) + wc * 32 + 8 * fq;
        const bool addp = sub > 0;
#pragma unroll
        for (int ai = 0; ai < 2; ++ai)
#pragma unroll
            for (int m = 0; m < 4; ++m) { const size_t row = (size_t)(row0 + ai * HALF + m * 16); const bf16_t* gp = lnd(P + row * PW + gd); bf16_t* up = lnd(U + row * DM + col0);
#pragma unroll
                for (int bj = 0; bj < 2; ++bj)
#pragma unroll
                    for (int n = 0; n < 2; ++n) { const u32x2 gw = *(const u32x2*)(gp + bj * HALF + 4 * n);
                        float v0 = acc[ai][bj][m][n][0] * bflo(gw.x), v1 = acc[ai][bj][m][n][1] * bfhi(gw.x), v2 = acc[ai][bj][m][n][2] * bflo(gw.y), v3 = acc[ai][bj][m][n][3] * bfhi(gw.y);
                        if (addp) { const u32x2 pw = *(const u32x2*)(up + bj * HALF + 4 * n); v0 += bflo(pw.x); v1 += bfhi(pw.x); v2 += bflo(pw.y); v3 += bfhi(pw.y); }
                        u32x2 o; o.x = pack2(v0, v1); o.y = pack2(v2, v3); *(u32x2*)(up + bj * HALF + 4 * n) = o; } }
    }
};
struct EpiResid {
    static constexpr bool PERM = false;
    const float* inL; const float* inC; float* outL; float* outC; const float* mod;
    __device__ __forceinline__ void operator()(const f32x4 (&acc)[2][2][4][2], const Unit& u, int wr, int wc, int fr, int fq) const {
        const bool lat = u.pm < 64; const int rbase = lat ? u.pm * BM : (u.pm - 64) * BM;
        const float* in = lat ? inL : inC; float* out = lat ? outL : outC;
        const int row0 = rbase + wr * 64 + fr, col0 = u.pn * BM + wc * 32 + 4 * fq;
        const float* gt = mod + (size_t)(lat ? (u.pm >> 3) : 8) * 6144 + col0;
#pragma unroll
        for (int bj = 0; bj < 2; ++bj)
#pragma unroll
            for (int n = 0; n < 2; ++n) { const f32x4 gv = *(const f32x4*)(gt + bj * HALF + n * 16);
#pragma unroll
                for (int ai = 0; ai < 2; ++ai)
#pragma unroll
                    for (int m = 0; m < 4; ++m) { const size_t ro = (size_t)(row0 + ai * HALF + m * 16) * DM + col0 + bj * HALF + n * 16;
                        const float* ip = lnd(in + ro); float* op = lnd(out + ro); const f32x4 iv = *(const f32x4*)ip; *(f32x4*)op = iv + gv * acc[ai][bj][m][n]; } }
    }
};

template <class Epi>
__device__ __forceinline__ void gemm_phase(LAS unsigned char* lds, const Gemm g, const Sched& S, const Epi& E) {
    const int tid = tid_(), wid = __builtin_amdgcn_readfirstlane(tid >> 6), lane = tid & 63, wr = wid >> 2, wc = wid & 3, fr = lane & 15, fq = lane >> 4;
    const int K = g.K, nt = K / BK;
    unsigned voffA[2], voffB[2];
#pragma unroll
    for (int i = 0; i < 2; ++i) { int R, C; stage_rc(tid * 16 + i * 8192, R, C); const int Rb = Epi::PERM ? ((R & ~31) + perm32(R & 31)) : R;
        voffA[i] = (unsigned)(R * g.lda + C) * 2u; voffB[i] = (unsigned)(Rb * g.ldb + C) * 2u; }
    const size_t kstep = (size_t)(BK * 2);
    const size_t hstepA = (size_t)HALF * g.lda * 2, hstepB = (size_t)HALF * g.ldb * 2;
    const unsigned ldsw = (unsigned)wid * 1024u;
    const int aoff = lds_byte(wr * 64 + fr, fq * 8), boff = lds_byte(wc * 32 + fr, fq * 8);
#define PG8_SA(b, h) (((b) * 2 + (h)) * HTB)
#define PG8_SB(b, h) ((4 + (b) * 2 + (h)) * HTB)
#define PG8_STAGE(bufoff, gbase, voff) do { _Pragma("unroll") for (int _i = 0; _i < 2; ++_i) \
        __builtin_amdgcn_global_load_lds((const unsigned*)((const char*)(gbase) + (voff)[_i]), (LAS unsigned*)(lds + (bufoff) + ldsw + _i * 8192), 16, 0, 0); } while (0)
#define PG8_LDA(dst, b, h) do { _Pragma("unroll") for (int m = 0; m < 4; ++m) _Pragma("unroll") for (int k = 0; k < 2; ++k) dst[m][k] = *(const LAS bf16x8*)(lds + PG8_SA(b, h) + aoff + m * 2048 + k * 1024); } while (0)
#define PG8_LDB(dst, b, h) do { _Pragma("unroll") for (int n = 0; n < 2; ++n) _Pragma("unroll") for (int k = 0; k < 2; ++k) dst[n][k] = *(const LAS bf16x8*)(lds + PG8_SB(b, h) + boff + n * 2048 + k * 1024); } while (0)
#define PG8_MMA(ai, bj, At, Bt) do { __builtin_amdgcn_s_setprio(1); _Pragma("unroll") for (int m = 0; m < 4; ++m) _Pragma("unroll") for (int n = 0; n < 2; ++n) _Pragma("unroll") for (int k = 0; k < 2; ++k) \
        acc[ai][bj][m][n] = __builtin_amdgcn_mfma_f32_16x16x32_bf16(Bt[n][k], At[m][k], acc[ai][bj][m][n], 0, 0, 0); __builtin_amdgcn_s_setprio(0); } while (0)
#define PG8_WAIT_V(n) asm volatile("s_waitcnt vmcnt(" #n ")" ::: "memory")
#define PG8_WAIT_L(n) asm volatile("s_waitcnt lgkmcnt(" #n ")" ::: "memory")
#define PG8_BAR __builtin_amdgcn_s_barrier()
#define PG8_SCHED __builtin_amdgcn_sched_barrier(0)
    Unit cur, nxt; int ui = 0;
    if (!S.next(0, cur)) return;
    f32x4 acc[2][2][4][2];
#pragma unroll
    for (int a = 0; a < 2; ++a)
#pragma unroll
        for (int b = 0; b < 2; ++b)
#pragma unroll
            for (int m = 0; m < 4; ++m)
#pragma unroll
                for (int n = 0; n < 2; ++n) acc[a][b][m][n] = (f32x4){0.f, 0.f, 0.f, 0.f};
    bf16x8 At[4][2], B0[2][2], B1[2][2];
    const char* cA = (const char*)g.A + cur.aoff; const char* cB = (const char*)g.Bt + cur.boff;
    PG8_STAGE(PG8_SB(0, 0), cB, voffB); PG8_STAGE(PG8_SA(0, 0), cA, voffA); PG8_STAGE(PG8_SB(0, 1), cB + hstepB, voffB); PG8_STAGE(PG8_SA(0, 1), cA + hstepA, voffA);
    if (wr == 1) PG8_BAR;
    PG8_WAIT_V(4); PG8_BAR;
    PG8_STAGE(PG8_SB(1, 0), cB + kstep, voffB); PG8_STAGE(PG8_SA(1, 0), cA + kstep, voffA); PG8_STAGE(PG8_SB(1, 1), cB + hstepB + kstep, voffB);
    PG8_WAIT_V(6); PG8_BAR;
    for (;;) {
        const bool has_next = S.next(ui + 1, nxt);
        const char* nA = has_next ? (const char*)g.A + nxt.aoff : cA; const char* nB = has_next ? (const char*)g.Bt + nxt.boff : cB;
        for (int t = 0; t < nt; t += 2) {
            const bool last = (t == nt - 2);
            const char* a1 = cA + (size_t)(t + 1) * kstep;
            const char* a2 = last ? nA : cA + (size_t)(t + 2) * kstep; const char* b2 = last ? nB : cB + (size_t)(t + 2) * kstep;
            const char* a3 = a2 + kstep; const char* b3 = b2 + kstep;
            PG8_LDB(B0, 0, 0); PG8_SCHED; PG8_LDA(At, 0, 0); PG8_STAGE(PG8_SA(1, 1), a1 + hstepA, voffA);
            PG8_WAIT_L(8); PG8_BAR; PG8_WAIT_L(0); PG8_MMA(0, 0, At, B0); PG8_BAR; PG8_SCHED;
            PG8_LDB(B1, 0, 1); PG8_STAGE(PG8_SB(0, 0), b2, voffB);
            PG8_BAR; PG8_WAIT_L(0); PG8_MMA(0, 1, At, B1); PG8_BAR;
            PG8_LDA(At, 0, 1); PG8_STAGE(PG8_SA(0, 0), a2, voffA);
            PG8_BAR; PG8_WAIT_L(0); PG8_MMA(1, 0, At, B0); PG8_BAR; PG8_SCHED;
            PG8_STAGE(PG8_SB(0, 1), b2 + hstepB, voffB);
            PG8_WAIT_V(6); PG8_BAR; PG8_MMA(1, 1, At, B1); PG8_BAR;
            PG8_LDB(B0, 1, 0); PG8_SCHED; PG8_LDA(At, 1, 0); PG8_STAGE(PG8_SA(0, 1), a2 + hstepA, voffA);
            PG8_WAIT_L(8); PG8_BAR; PG8_WAIT_L(0); PG8_MMA(0, 0, At, B0); PG8_BAR; PG8_SCHED;
            PG8_LDB(B1, 1, 1); PG8_STAGE(PG8_SB(1, 0), b3, voffB);
            PG8_BAR; PG8_WAIT_L(0); PG8_MMA(0, 1, At, B1); PG8_BAR;
            PG8_LDA(At, 1, 1); PG8_STAGE(PG8_SA(1, 0), a3, voffA);
            PG8_BAR; PG8_WAIT_L(0); PG8_MMA(1, 0, At, B0); PG8_BAR; PG8_SCHED;
            PG8_STAGE(PG8_SB(1, 1), b3 + hstepB, voffB);
            PG8_WAIT_V(6); PG8_BAR; PG8_MMA(1, 1, At, B1); PG8_BAR;
        }
        E(acc, cur, wr, wc, fr, fq);
        if (!has_next) break;
#pragma unroll
        for (int a = 0; a < 2; ++a)
#pragma unroll
            for (int b = 0; b < 2; ++b)
#pragma unroll
                for (int m = 0; m < 4; ++m)
#pragma unroll
                    for (int n = 0; n < 2; ++n) acc[a][b][m][n] = (f32x4){0.f, 0.f, 0.f, 0.f};
        cur = nxt; cA = nA; cB = nB; ++ui;
    }
    PG8_WAIT_V(0);
    if (wr == 0) PG8_BAR;
    PG8_BAR;
#undef PG8_SA
#undef PG8_SB
#undef PG8_STAGE
#undef PG8_LDA
#undef PG8_LDB
#undef PG8_MMA
#undef PG8_WAIT_V
#undef PG8_WAIT_L
#undef PG8_BAR
#undef PG8_SCHED
}
}

__device__ __forceinline__ void phase_mod(const Params& p, LAS unsigned char* lds) {
    LAS float* sc = (LAS float*)lds;
    LAS float* part = sc + 9 * 1024;
    float* mod = (float*)(PF(ws) + WS_MOD);
    const int tid = tid_(), w = tid >> 6, lane = tid & 63;
    if ((int)blockIdx.x >= 192) return;
    const float* pc = PF(c); const float* pcc = PF(c_ctx); const float* padaw = PF(ada_w); const float* padab = PF(ada_b);
    for (int i = tid; i < 9 * 1024; i += 512) { const int r = i >> 10, k = i & 1023; const float v = (r < 8) ? pc[r * 1024 + k] : pcc[k]; sc[i] = v / (1.0f + expf(-v)); }
    __syncthreads();
    for (int item = blockIdx.x; item < 192; item += gridDim.x) {
        const int l = item / 96, cb = item % 96;
        const float* W = padaw + (size_t)l * 1024 * 6144 + cb * 64 + lane;
        float acc[9];
#pragma unroll
        for (int r = 0; r < 9; ++r) acc[r] = 0.f;
        for (int k = w * 128; k < w * 128 + 128; ++k) { const float wv = W[(size_t)k * 6144];
#pragma unroll
            for (int r = 0; r < 9; ++r) acc[r] += sc[r * 1024 + k] * wv; }
#pragma unroll
        for (int r = 0; r < 9; ++r) part[(w * 9 + r) * 64 + lane] = acc[r];
        __syncthreads();
        for (int i = tid; i < 576; i += 512) { const int r = i >> 6, ln = i & 63; float s = 0.f;
#pragma unroll
            for (int ww = 0; ww < 8; ++ww) s += part[(ww * 9 + r) * 64 + ln];
            mod[(size_t)(l * 9 + r) * 6144 + cb * 64 + ln] = s + padab[l * 6144 + cb * 64 + ln]; }
        __syncthreads();
    }
}
__device__ __forceinline__ void phase_rope(const Params& p) {
    if (blockIdx.x != gridDim.x - 1) return;
    float* rope = (float*)(PF(ws) + WS_ROPE);
    for (int i = tid_(); i < 1024; i += 512) { const int pos = i >> 4, fi = i & 15; const float invf = powf(10000.0f, -(float)fi / 16.0f); const float ang = (float)pos * invf; rope[i] = cosf(ang); rope[1024 + i] = sinf(ang); }
}
__device__ __forceinline__ void convert_tile(const float* src, int K, int N, bf16_t* dst, int tile, LAS bf16_t* T) {
    const int tid = tid_(), tilesN = N >> 6, tk = tile / tilesN, tn = tile - tk * tilesN, k0 = tk * 64, n0 = tn * 64;
    const int r = tid >> 3, c8 = (tid & 7) * 8;
    const float* s = src + (size_t)(k0 + r) * N + n0 + c8;
    const f32x4 a = *(const f32x4*)s, b = *(const f32x4*)(s + 4);
#pragma unroll
    for (int j = 0; j < 4; ++j) { T[(c8 + j) * 72 + r] = (bf16_t)f2bf(a[j]); T[(c8 + 4 + j) * 72 + r] = (bf16_t)f2bf(b[j]); }
    __syncthreads();
    const u32x4 v = *(const LAS u32x4*)(T + r * 72 + c8);
    *(u32x4*)(dst + (size_t)(n0 + r) * K + k0 + c8) = v;
    __syncthreads();
}
__device__ __forceinline__ void phase_convert(const Params& p, int l, LAS unsigned char* lds) {
    LAS bf16_t* T = (LAS bf16_t*)lds;
    bf16_t* WIN = (bf16_t*)(PF(ws) + WS_WIN); bf16_t* WB = (bf16_t*)(PF(ws) + WS_WB); bf16_t* WO = (bf16_t*)(PF(ws) + WS_WO); bf16_t* W1 = (bf16_t*)(PF(ws) + WS_W1); bf16_t* W2 = (bf16_t*)(PF(ws) + WS_W2);
    for (int it = blockIdx.x; it < 4736; it += gridDim.x) {
        if (it < 2048) convert_tile(PF(w_in) + (size_t)l * DM * DIN, DM, DIN, WIN, it, T);
        else if (it < 2432) { const int n = (it - 2048) / 128, tl = (it - 2048) % 128; convert_tile(PF(w_branch) + (size_t)(l * 3 + n) * 512 * DM, 512, DM, WB + (size_t)n * DM * 512, tl, T); }
        else if (it < 2688) convert_tile(PF(w_out) + (size_t)l * DM * DM, DM, DM, WO, it - 2432, T);
        else if (it < 3712) convert_tile(PF(ffn_w1) + (size_t)l * DM * DFF, DM, DFF, W1, it - 2688, T);
        else convert_tile(PF(ffn_w2) + (size_t)l * DFF * DM, DFF, DM, W2, it - 3712, T);
    }
}
__device__ __forceinline__ void phase_norm(const Params& p, int l, const float* hlat, const float* hctx, const float* g, int modoff, int nrows) {
    const int tid = tid_(); const int w = tid >> 6, lane = tid & 63;
    bf16_t* U = (bf16_t*)(PF(ws) + WS_U); const float* mod = (const float*)(PF(ws) + WS_MOD);
    for (int row = blockIdx.x * 8 + w; row < nrows; row += gridDim.x * 8) {
        const float* src = row < NLAT ? hlat + (size_t)row * DM : hctx + (size_t)(row - NLAT) * DM;
        const int mr = row < NLAT ? (row >> 11) : 8;
        const float* md = mod + (size_t)(l * 9 + mr) * 6144 + modoff;
        f32x4 v[4]; float ss = 0.f;
#pragma unroll
        for (int i = 0; i < 4; ++i) { v[i] = *(const f32x4*)(src + i * 256 + lane * 4); ss += v[i][0] * v[i][0] + v[i][1] * v[i][1] + v[i][2] * v[i][2] + v[i][3] * v[i][3]; }
#pragma unroll
        for (int o = 32; o >= 1; o >>= 1) ss += __shfl_xor(ss, o);
        const float rstd = rsqrtf(ss * (1.0f / 1024.0f) + 1e-6f);
#pragma unroll
        for (int i = 0; i < 4; ++i) { const int cidx = i * 256 + lane * 4; const f32x4 gg = *(const f32x4*)(g + cidx), sh = *(const f32x4*)(md + cidx), scv = *(const f32x4*)(md + 1024 + cidx);
            float o4[4];
#pragma unroll
            for (int j = 0; j < 4; ++j) o4[j] = (v[i][j] * rstd * gg[j]) * (1.0f + scv[j]) + sh[j];
            u32x2 wv; wv.x = pack2(o4[0], o4[1]); wv.y = pack2(o4[2], o4[3]);
            *(u32x2*)(U + (size_t)row * DM + cidx) = wv; }
    }
}
__device__ __forceinline__ void phase_hg_final(const Params& p, int l, int nrows) {
    const int tid = tid_(); const int w = tid >> 6, lane = tid & 63; bf16_t* P = (bf16_t*)(PF(ws) + WS_P);
    const int hd = lane >> 4, e8 = (lane & 15) * 8; const float* png = PF(hg_norm_g);
    float ng[8];
#pragma unroll
    for (int i = 0; i < 8; ++i) ng[i] = png[l * 128 + e8 + i];
    for (int row = blockIdx.x * 8 + w; row < nrows; row += gridDim.x * 8) {
        bf16_t* rp = P + (size_t)row * PW;
        float a[8], b[8], og[8]; unpack8(*(const u32x4*)(rp + C_BF + hd * 128 + e8), a); unpack8(*(const u32x4*)(rp + C_BF + 512 + hd * 128 + e8), b); unpack8(*(const u32x4*)(rp + C_BO + hd * 128 + e8), og);
        float ss = 0.f;
#pragma unroll
        for (int i = 0; i < 8; ++i) { a[i] += b[i]; ss += a[i] * a[i]; }
        ss += __shfl_xor(ss, 1); ss += __shfl_xor(ss, 2); ss += __shfl_xor(ss, 4); ss += __shfl_xor(ss, 8);
        const float rstd = rsqrtf(ss * (1.0f / 128.0f) + 1e-6f);
        float y[8];
#pragma unroll
        for (int i = 0; i < 8; ++i) y[i] = a[i] * rstd * ng[i] * sigmoidf_(og[i]);
        *(u32x4*)(rp + C_BO + hd * 128 + e8) = pack8(y);
    }
}

__device__ __forceinline__ size_t agg_idx(int b, int gch, int dir, int which, int ch) { return ((((size_t)b * 36 + gch) * 2 + dir) * 2 + which) * 512 + ch; }
__device__ __forceinline__ float gelu_tanh(float x) { const float u = 0.7978845608028654f * (x + 0.044715f * x * x * x); const float th = 1.0f - 2.0f / (1.0f + __expf(2.0f * u)); return 0.5f * x * (1.0f + th); }
__device__ __forceinline__ void lru_tile(const Params& p, int l, LAS unsigned char* lds, int item, int mode, int& staged_nb) {
    LAS bf16_t* Wl = (LAS bf16_t*)lds;
    LAS bf16_t* Xb = Wl + 256 * 72;
    LAS float* Xf = (LAS float*)(lds + 46080);
    LAS float* Av = Xf + 4096;
    LAS float* Bv = Av + 8192;
    bf16_t* P = (bf16_t*)(PF(ws) + WS_P); float* AGG = (float*)(PF(ws) + WS_AGG);
    const int tid = tid_(), w = tid >> 6, lane = tid & 63, l16 = lane & 15, q4 = lane >> 4;
    const int nb = item & 7, rest = item >> 3, gch = rest % 36, b = rest / 36;
    const bool isctx = gch < 4; const int chunk = isctx ? gch : gch - 4, L = isctx ? CTXL : SEQ;
    const size_t seqrow0 = isctx ? (size_t)NLAT + b * CTXL : (size_t)b * SEQ; const int t0 = chunk * 64;
    if (staged_nb != nb) { const float* pwx = PF(lru_wx); const float* pwa = PF(lru_wa);
        for (int e = tid; e < 4 * 64 * 64; e += 512) { const int mat = e >> 12, i = (e >> 6) & 63, c = e & 63; const int dir = mat >> 1, kind = mat & 1;
            const float* W = kind ? pwx : pwa; const float v = W[((size_t)((l * 2 + dir) * 8 + nb) * 64 + i) * 64 + c];
            const int op = dir * 128 + (c >> 4) * 32 + kind * 16 + (c & 15);
            Wl[op * 72 + i] = (bf16_t)f2bf(v); }
        staged_nb = nb;
    }
    {
        const int t = tid >> 3, c8 = (tid & 7) * 8, ch = nb * 64 + c8, tt = t0 + t;
        float a8[8]; const float* pcb = PF(conv_b); const float* pcw = PF(conv_w);
        { const f32x4 b0 = *(const f32x4*)(pcb + l * 512 + ch), b1 = *(const f32x4*)(pcb + l * 512 + ch + 4);
#pragma unroll
          for (int i = 0; i < 4; ++i) { a8[i] = b0[i]; a8[4 + i] = b1[i]; } }
#pragma unroll
        for (int j = 0; j < 4; ++j) { const int ts = tt + j - 2;
            if (ts >= 0 && ts < L) { float xv[8]; unpack8(*(const u32x4*)(P + (seqrow0 + ts) * PW + C_AX + ch), xv);
                const f32x4 w0 = *(const f32x4*)(pcw + (l * 4 + j) * 512 + ch), w1 = *(const f32x4*)(pcw + (l * 4 + j) * 512 + ch + 4);
#pragma unroll
                for (int i = 0; i < 4; ++i) { a8[i] += xv[i] * w0[i]; a8[4 + i] += xv[4 + i] * w1[i]; } } }
#pragma unroll
        for (int i = 0; i < 8; ++i) Xf[t * 64 + c8 + i] = a8[i];
        *(LAS u32x4*)(Xb + t * 72 + c8) = pack8(a8);
    }
    __syncthreads();
    {
        const int dir = w >> 2, c = (w & 3) * 16 + l16, ch = nb * 64 + c;
        f32x4 acc[4][2];
#pragma unroll
        for (int mg = 0; mg < 4; ++mg) { acc[mg][0] = (f32x4){0.f, 0.f, 0.f, 0.f}; acc[mg][1] = (f32x4){0.f, 0.f, 0.f, 0.f}; }
#pragma unroll
        for (int ks = 0; ks < 2; ++ks) {
            const bf16x8 B0 = *(const LAS bf16x8*)(Wl + (w * 32 + l16) * 72 + ks * 32 + q4 * 8), B1 = *(const LAS bf16x8*)(Wl + (w * 32 + 16 + l16) * 72 + ks * 32 + q4 * 8);
#pragma unroll
            for (int mg = 0; mg < 4; ++mg) { const bf16x8 A = *(const LAS bf16x8*)(Xb + (mg * 16 + l16) * 72 + ks * 32 + q4 * 8);
                acc[mg][0] = mfma16(A, B0, acc[mg][0]); acc[mg][1] = mfma16(A, B1, acc[mg][1]); }
        }
        const float ba = PF(lru_ba)[(l * 2 + dir) * 512 + ch], bx = PF(lru_bx)[(l * 2 + dir) * 512 + ch], lam = PF(lru_lambda)[(l * 2 + dir) * 512 + ch];
        const float sp = log1pf(expf(-lam));
#pragma unroll
        for (int mg = 0; mg < 4; ++mg)
#pragma unroll
            for (int j = 0; j < 4; ++j) { const int t = mg * 16 + q4 * 4 + j;
                const float r = 1.0f / (1.0f + expf(-(acc[mg][0][j] + ba))), ig = 1.0f / (1.0f + expf(-(acc[mg][1][j] + bx)));
                const float la = -8.0f * r * sp; const float a = expf(la); const float bb = sqrtf(fmaxf(-expm1f(2.0f * la), 0.f)) * ig * Xf[t * 64 + c];
                Av[(dir * 64 + t) * 64 + c] = a; Bv[(dir * 64 + t) * 64 + c] = bb; }
    }
    __syncthreads();
    if (tid < 128) {
        const int d2 = tid >> 6, c = tid & 63, ch = nb * 64 + c;
        float h = 0.f, ap = 1.f;
        if (mode == 1) {
            if (d2 == 0) { for (int g = 0; g < gch; ++g) h = AGG[agg_idx(b, g, 0, 0, ch)] * h + AGG[agg_idx(b, g, 0, 1, ch)]; }
            else {
                if (gch < 4) { for (int g = 3; g > gch; --g) h = AGG[agg_idx(b, g, 1, 0, ch)] * h + AGG[agg_idx(b, g, 1, 1, ch)]; }
                else { for (int g = 3; g >= 0; --g) h = AGG[agg_idx(b, g, 1, 0, ch)] * h + AGG[agg_idx(b, g, 1, 1, ch)];
                       for (int g = 35; g > gch; --g) h = AGG[agg_idx(b, g, 1, 0, ch)] * h + AGG[agg_idx(b, g, 1, 1, ch)]; }
            }
        }
        for (int s = 0; s < 64; ++s) { const int t = d2 ? 63 - s : s; const int ix = (d2 * 64 + t) * 64 + c; const float a = Av[ix], bb = Bv[ix]; h = a * h + bb; ap *= a; if (mode == 1) Bv[ix] = h; }
        if (mode == 0) { AGG[agg_idx(b, gch, d2, 0, ch)] = ap; AGG[agg_idx(b, gch, d2, 1, ch)] = h; }
    }
    __syncthreads();
    if (mode == 1) {
        const int t = tid >> 3, c8 = (tid & 7) * 8; bf16_t* gp = P + (seqrow0 + t0 + t) * PW + C_AG + nb * 64 + c8;
        float gt[8]; unpack8(*(const u32x4*)gp, gt); float y[8];
#pragma unroll
        for (int i = 0; i < 8; ++i) y[i] = (Bv[t * 64 + c8 + i] + Bv[(64 + t) * 64 + c8 + i]) * gelu_tanh(gt[i]);
        *(u32x4*)gp = pack8(y);
        __syncthreads();
    }
}

__device__ __forceinline__ void attn_item(const Params& p, int l, LAS unsigned char* lds, int item) {
    LAS bf16_t* Kt = (LAS bf16_t*)lds;
    LAS bf16_t* Vt = Kt + 2 * 64 * 72;
    LAS float* rpbL = (LAS float*)(lds + 36864);
    LAS float* cosT = rpbL + 960;
    LAS float* sinT = cosT + 1024;
    LAS float* gq = sinT + 1024; LAS float* gk = gq + 64;
    bf16_t* P = (bf16_t*)(PF(ws) + WS_P); const float* rope = (const float*)(PF(ws) + WS_ROPE);
    const int tid = tid_(), w = tid >> 6, lane = tid & 63, l16 = lane & 15, q4 = lane >> 4, hh = w >> 2, qg4 = w & 3;
    const bool isctx = item >= 1024;
    int b, r, hp, nloc, kr0; size_t qrow0;
    if (!isctx) { hp = item & 3; r = (item >> 2) & 31; b = item >> 7; qrow0 = (size_t)b * SEQ + r * 64; nloc = 8; kr0 = min(max(r - 4, 0), 24); }
    else { const int it = item - 1024; hp = it & 3; const int qt = (it >> 2) & 3; b = it >> 4; qrow0 = (size_t)NLAT + b * CTXL + qt * 64; nloc = 0; r = 0; kr0 = 0; }
    const int h = hp * 2 + hh;
    const float* prpb = PF(na_rpb);
    for (int i = tid; i < 2 * 465; i += 512) { const int h2 = i / 465, j = i - h2 * 465; rpbL[h2 * 480 + j] = prpb[(size_t)((l * 8 + hp * 2 + h2) * 465) + j]; }
    for (int i = tid; i < 1024; i += 512) { cosT[i] = rope[i]; sinT[i] = rope[1024 + i]; }
    if (tid < 64) { gq[tid] = PF(na_qg)[l * 64 + tid]; gk[tid] = PF(na_kg)[l * 64 + tid]; }
    __syncthreads();
    const int qc = qg4 * 16 + l16; const size_t qrow = qrow0 + qc;
    bf16x8 qpl[2], qrt[2];
    {
        const bf16_t* qp = P + qrow * PW + C_CQ + h * 64;
        float xq[16]; unpack8(*(const u32x4*)(qp + q4 * 8), xq); unpack8(*(const u32x4*)(qp + 32 + q4 * 8), xq + 8);
        float ss = 0.f;
#pragma unroll
        for (int i = 0; i < 16; ++i) ss += xq[i] * xq[i];
        ss += __shfl_xor(ss, 16); ss += __shfl_xor(ss, 32);
        const float rs = rsqrtf(ss * (1.0f / 64.0f) + 1e-6f) * 0.125f;
#pragma unroll
        for (int i = 0; i < 8; ++i) { xq[i] *= rs * gq[q4 * 8 + i]; xq[8 + i] *= rs * gq[32 + q4 * 8 + i]; }
        qpl[0] = as_bf16x8(pack8(xq)); qpl[1] = as_bf16x8(pack8(xq + 8));
        float xr[16];
#pragma unroll
        for (int ks = 0; ks < 2; ++ks) { const int pos = ks == 0 ? r : qc;
#pragma unroll
            for (int jj = 0; jj < 8; ++jj) { const int fi = (q4 & 1) * 8 + jj; const float cs = cosT[pos * 16 + fi], sn = sinT[pos * 16 + fi]; const float xv = xq[ks * 8 + jj]; const float pr = __shfl_xor(xv, 32);
                xr[ks * 8 + jj] = (q4 < 2) ? (xv * cs - pr * sn) : (xv * cs + pr * sn); } }
        qrt[0] = as_bf16x8(pack8(xr)); qrt[1] = as_bf16x8(pack8(xr + 8));
    }
    f32x4 O[4];
#pragma unroll
    for (int i = 0; i < 4; ++i) O[i] = (f32x4){0.f, 0.f, 0.f, 0.f};
    float mrun = -1e30f, lsum = 0.f;
#pragma unroll
    for (int ph = 0; ph < 2; ++ph) {
    const bool loc = (ph == 0); const int ntile = loc ? nloc : 4;
    for (int kt = 0; kt < ntile; ++kt) {
        const int kr = kr0 + kt;
        const size_t krow0 = loc ? (size_t)b * SEQ + kr * 64 : (size_t)NLAT + b * CTXL + kt * 64;
        {
            const int hh2 = tid >> 8, key = (tid & 255) >> 2, seg = tid & 3, h2 = hp * 2 + hh2;
            const bf16_t* kp = P + (krow0 + key) * PW + C_CK + h2 * 64 + seg * 16;
            float xk[16]; unpack8(*(const u32x4*)kp, xk); unpack8(*(const u32x4*)(kp + 8), xk + 8);
            float ss = 0.f;
#pragma unroll
            for (int i = 0; i < 16; ++i) ss += xk[i] * xk[i];
            ss += __shfl_xor(ss, 1); ss += __shfl_xor(ss, 2);
            const float rs = rsqrtf(ss * (1.0f / 64.0f) + 1e-6f);
#pragma unroll
            for (int i = 0; i < 16; ++i) xk[i] *= rs * gk[seg * 16 + i];
            if (loc) { const int pos = seg < 2 ? kr : key;
#pragma unroll
                for (int i = 0; i < 16; ++i) { const float pr = __shfl_xor(xk[i], 1); const float cs = cosT[pos * 16 + i], sn = sinT[pos * 16 + i]; xk[i] = (seg & 1) ? (xk[i] * cs + pr * sn) : (xk[i] * cs - pr * sn); } }
            LAS bf16_t* kd = Kt + (hh2 * 64 + key) * 72 + seg * 16;
            *(LAS u32x4*)kd = pack8(xk); *(LAS u32x4*)(kd + 8) = pack8(xk + 8);
        }
        {
            const int hh2 = tid >> 8, seg = (tid & 255) >> 6, key = tid & 63, h2 = hp * 2 + hh2;
            const bf16_t* vp = P + (krow0 + key) * PW + C_CV + h2 * 64 + seg * 16;
            const u32x4 a = *(const u32x4*)vp, c = *(const u32x4*)(vp + 8);
            LAS bf16_t* vd = Vt + (hh2 * 64 + seg * 16) * 72 + key;
            vd[0 * 72] = (bf16_t)(a.x & 0xffff); vd[1 * 72] = (bf16_t)(a.x >> 16); vd[2 * 72] = (bf16_t)(a.y & 0xffff); vd[3 * 72] = (bf16_t)(a.y >> 16);
            vd[4 * 72] = (bf16_t)(a.z & 0xffff); vd[5 * 72] = (bf16_t)(a.z >> 16); vd[6 * 72] = (bf16_t)(a.w & 0xffff); vd[7 * 72] = (bf16_t)(a.w >> 16);
            vd[8 * 72] = (bf16_t)(c.x & 0xffff); vd[9 * 72] = (bf16_t)(c.x >> 16); vd[10 * 72] = (bf16_t)(c.y & 0xffff); vd[11 * 72] = (bf16_t)(c.y >> 16);
            vd[12 * 72] = (bf16_t)(c.z & 0xffff); vd[13 * 72] = (bf16_t)(c.z >> 16); vd[14 * 72] = (bf16_t)(c.w & 0xffff); vd[15 * 72] = (bf16_t)(c.w >> 16);
        }
        __syncthreads();
        f32x4 st[4];
#pragma unroll
        for (int g = 0; g < 4; ++g) { st[g] = (f32x4){0.f, 0.f, 0.f, 0.f};
#pragma unroll
            for (int ks = 0; ks < 2; ++ks) { const bf16x8 A = *(const LAS bf16x8*)(Kt + (hh * 64 + g * 16 + l16) * 72 + ks * 32 + q4 * 8); st[g] = mfma16(A, loc ? qrt[ks] : qpl[ks], st[g]); } }
        if (loc) { const int cs0 = min(max(qc - 8, 0), 48); const int drow = kr - r + 7;
#pragma unroll
            for (int g = 0; g < 4; ++g)
#pragma unroll
                for (int j = 0; j < 4; ++j) { const int kc = g * 16 + q4 * 4 + j; const int dcol = min(max(kc - qc, -15), 15) + 15;
                    const float sv = st[g][j] + rpbL[hh * 480 + drow * 31 + dcol]; st[g][j] = (kc < cs0 || kc >= cs0 + 16) ? -1e30f : sv; } }
        float tmax = -1e30f;
#pragma unroll
        for (int g = 0; g < 4; ++g)
#pragma unroll
            for (int j = 0; j < 4; ++j) tmax = fmaxf(tmax, st[g][j]);
        tmax = fmaxf(tmax, __shfl_xor(tmax, 16)); tmax = fmaxf(tmax, __shfl_xor(tmax, 32));
        const float mnew = fmaxf(mrun, tmax); const float alpha = __expf(mrun - mnew); mrun = mnew;
        float psum = 0.f;
#pragma unroll
        for (int g = 0; g < 4; ++g)
#pragma unroll
            for (int j = 0; j < 4; ++j) { const float pv = __expf(st[g][j] - mnew); st[g][j] = pv; psum += pv; }
        lsum = lsum * alpha + psum;
#pragma unroll
        for (int i = 0; i < 4; ++i) O[i] *= alpha;
        bf16x8 pb[2];
#pragma unroll
        for (int ks = 0; ks < 2; ++ks) { u32x4 wv; wv.x = pack2(st[2 * ks][0], st[2 * ks][1]); wv.y = pack2(st[2 * ks][2], st[2 * ks][3]); wv.z = pack2(st[2 * ks + 1][0], st[2 * ks + 1][1]); wv.w = pack2(st[2 * ks + 1][2], st[2 * ks + 1][3]); pb[ks] = as_bf16x8(wv); }
#pragma unroll
        for (int dg = 0; dg < 4; ++dg)
#pragma unroll
            for (int ks = 0; ks < 2; ++ks) { const LAS bf16_t* vr = Vt + (hh * 64 + dg * 16 + l16) * 72 + ks * 32 + q4 * 4;
                const u32x2 lo = *(const LAS u32x2*)vr, hi = *(const LAS u32x2*)(vr + 16); u32x4 av; av.x = lo.x; av.y = lo.y; av.z = hi.x; av.w = hi.y;
                O[dg] = mfma16(as_bf16x8(av), pb[ks], O[dg]); }
        __syncthreads();
    }
    }
    lsum += __shfl_xor(lsum, 16); lsum += __shfl_xor(lsum, 32);
    const float inv = 1.0f / lsum;
    bf16_t* op = P + qrow * PW + C_CQ + h * 64;
#pragma unroll
    for (int dg = 0; dg < 4; ++dg) { u32x2 wv; wv.x = pack2(O[dg][0] * inv, O[dg][1] * inv); wv.y = pack2(O[dg][2] * inv, O[dg][3] * inv); *(u32x2*)(op + dg * 16 + q4 * 4) = wv; }
    __syncthreads();
}

__device__ __forceinline__ void hgrn_chain(const Params& p, int l, LAS unsigned char* lds, int chain) {
    LAS bf16_t* QV = (LAS bf16_t*)lds;
    LAS bf16_t* KE = (LAS bf16_t*)(lds + 43520);
    LAS bf16_t* KB = (LAS bf16_t*)(lds + 60928);
    LAS bf16_t* SB = (LAS bf16_t*)(lds + 43520);
    LAS bf16_t* KDT = (LAS bf16_t*)(lds + 78336);
    LAS bf16_t* VT = (LAS bf16_t*)(lds + 96768);
    LAS bf16_t* ATT = (LAS bf16_t*)(lds + 115200);
    LAS float* TOT = (LAS float*)(lds + 124416);
    LAS float* DD = (LAS float*)(lds + 126464);
    bf16_t* P = (bf16_t*)(PF(ws) + WS_P);
    const int tid = tid_(), w = tid >> 6, lane = tid & 63, l16 = lane & 15, q4 = lane >> 4;
    const int dir = chain & 1, h = (chain >> 1) & 3, b = chain >> 3;
    const int d = tid & 127, sb = tid >> 7;
    float lbv = 0.f;
    if (l > 0) { const float x0 = PF(hg_lb)[(dir * 2 + 0) * 512 + h * 128 + d], x1 = PF(hg_lb)[(dir * 2 + 1) * 512 + h * 128 + d]; lbv = 1.0f / (1.0f + expf(x0 - x1)); }
    for (int i = tid; i < 64 * 72 / 2; i += 512) ((LAS unsigned*)ATT)[i] = 0u;
    f32x4 S[8];
#pragma unroll
    for (int i = 0; i < 8; ++i) S[i] = (f32x4){0.f, 0.f, 0.f, 0.f};
    __syncthreads();
    for (int ci = 0; ci < 36; ++ci) {
        const int gch = dir == 0 ? ci : (ci < 4 ? 3 - ci : 39 - ci);
        const bool isctx = gch < 4; const int chunk = isctx ? gch : gch - 4;
        const size_t row0 = isctx ? (size_t)NLAT + b * CTXL + chunk * 64 : (size_t)b * SEQ + chunk * 64;
        float bl[16], qv[16], kv[16]; float run = 0.f;
        {
            unsigned vraw[16];
#pragma unroll
            for (int ii = 0; ii < 16; ++ii) { const int t = sb * 16 + ii; const bf16_t* rp = P + (row0 + (dir ? 63 - t : t)) * PW;
                const float fr = bf2f(rp[C_BF + dir * 512 + h * 128 + d]), qr = bf2f(rp[C_BQ + h * 128 + d]); vraw[ii] = rp[C_BI + h * 128 + d];
                const float sg = 1.0f / (1.0f + __expf(-fr)); const float f = lbv + (1.0f - lbv) * sg; run += __logf(f); bl[ii] = run; kv[ii] = 1.0f - f; qv[ii] = qr / (1.0f + __expf(-qr)); }
            TOT[sb * 128 + d] = run;
            u32x4 v0, v1; v0.x = vraw[0] | (vraw[1] << 16); v0.y = vraw[2] | (vraw[3] << 16); v0.z = vraw[4] | (vraw[5] << 16); v0.w = vraw[6] | (vraw[7] << 16);
            v1.x = vraw[8] | (vraw[9] << 16); v1.y = vraw[10] | (vraw[11] << 16); v1.z = vraw[12] | (vraw[13] << 16); v1.w = vraw[14] | (vraw[15] << 16);
            *(LAS u32x4*)(VT + d * 72 + sb * 16) = v0; *(LAS u32x4*)(VT + d * 72 + sb * 16 + 8) = v1;
        }
        __syncthreads();
        {
            const float t0 = TOT[d], t1 = TOT[128 + d], t2 = TOT[256 + d], t3 = TOT[384 + d];
            const float Bs1 = t0, Bs2 = t0 + t1, Bs3 = Bs2 + t2, total = Bs3 + t3;
            const float Bsb = sb == 0 ? 0.f : (sb == 1 ? Bs1 : (sb == 2 ? Bs2 : Bs3));
            float e0[16];
#pragma unroll
            for (int ii = 0; ii < 16; ++ii) e0[ii] = __expf(bl[ii]);
#pragma unroll
            for (int r = 0; r < 4; ++r) if (r <= sb) { const float Bsr = r == 0 ? 0.f : (r == 1 ? Bs1 : (r == 2 ? Bs2 : Bs3)); const float F = __expf(Bsb - Bsr); const int base = (sb * (sb + 1) / 2 + r) * 16;
#pragma unroll
                for (int ii = 0; ii < 16; ++ii) QV[(base + ii) * 136 + d] = (bf16_t)f2bf(qv[ii] * e0[ii] * F); }
            const float Fd = __expf(total - Bsb - run);
            float kd[16];
#pragma unroll
            for (int ii = 0; ii < 16; ++ii) { const float ke = kv[ii] * __expf(run - bl[ii]); KE[(sb * 16 + ii) * 136 + d] = (bf16_t)f2bf(ke); KB[(sb * 16 + ii) * 136 + d] = (bf16_t)f2bf(kv[ii] * __expf(fminf(-bl[ii], 80.f))); kd[ii] = ke * Fd; }
            *(LAS u32x4*)(KDT + d * 72 + sb * 16) = pack8(kd); *(LAS u32x4*)(KDT + d * 72 + sb * 16 + 8) = pack8(kd + 8);
            if (sb == 0) DD[d] = __expf(total);
        }
        __syncthreads();
        f32x4 sc[2]; int bi[2], bj[2];
#pragma unroll
        for (int k2 = 0; k2 < 2; ++k2) { const int idx = w + 8 * k2; sc[k2] = (f32x4){0.f, 0.f, 0.f, 0.f};
            const int i = idx < 1 ? 0 : (idx < 3 ? 1 : (idx < 6 ? 2 : 3)); const int j = idx - i * (i + 1) / 2; bi[k2] = i; bj[k2] = j;
            if (idx < 10) { const int r = (j < i) ? j + 1 : i; const LAS bf16_t* qb = QV + ((i * (i + 1) / 2 + r) * 16 + l16) * 136 + q4 * 8; const LAS bf16_t* kb = ((j < i) ? KE : KB) + (j * 16 + l16) * 136 + q4 * 8;
#pragma unroll
                for (int ks = 0; ks < 4; ++ks) sc[k2] = mfma16(*(const LAS bf16x8*)(qb + ks * 32), *(const LAS bf16x8*)(kb + ks * 32), sc[k2]);
                if (i == j) {
#pragma unroll
                    for (int jj = 0; jj < 4; ++jj) if (l16 > q4 * 4 + jj) sc[k2][jj] = 0.f; } } }
        __syncthreads();
#pragma unroll
        for (int k2 = 0; k2 < 2; ++k2) if (w + 8 * k2 < 10) {
#pragma unroll
            for (int jj = 0; jj < 4; ++jj) ATT[(bi[k2] * 16 + q4 * 4 + jj) * 72 + bj[k2] * 16 + l16] = (bf16_t)f2bf(sc[k2][jj]); }
#pragma unroll
        for (int eg = 0; eg < 8; ++eg) { u32x2 wv; wv.x = pack2(S[eg][0], S[eg][1]); wv.y = pack2(S[eg][2], S[eg][3]); *(LAS u32x2*)(SB + (eg * 16 + l16) * 136 + w * 16 + q4 * 4) = wv; }
        __syncthreads();
        {
            bf16x8 SBf[4], VTf[2];
#pragma unroll
            for (int ks = 0; ks < 4; ++ks) SBf[ks] = *(const LAS bf16x8*)(SB + (w * 16 + l16) * 136 + ks * 32 + q4 * 8);
#pragma unroll
            for (int ks = 0; ks < 2; ++ks) VTf[ks] = *(const LAS bf16x8*)(VT + (w * 16 + l16) * 72 + ks * 32 + q4 * 8);
#pragma unroll
            for (int i = 0; i < 4; ++i) { f32x4 oa = (f32x4){0.f, 0.f, 0.f, 0.f};
#pragma unroll
                for (int ks = 0; ks < 4; ++ks) if (!(DBG_HG & 4)) oa = mfma16(SBf[ks], *(const LAS bf16x8*)(QV + ((i * (i + 1) / 2) * 16 + l16) * 136 + ks * 32 + q4 * 8), oa);
#pragma unroll
                for (int ks = 0; ks < 2; ++ks) if (!(DBG_HG & 2)) oa = mfma16(VTf[ks], *(const LAS bf16x8*)(ATT + (i * 16 + l16) * 72 + ks * 32 + q4 * 8), oa);
                const int t = i * 16 + l16; u32x2 wv; wv.x = pack2(oa[0], oa[1]); wv.y = pack2(oa[2], oa[3]);
                *(u32x2*)(P + (row0 + (dir ? 63 - t : t)) * PW + C_BF + dir * 512 + h * 128 + w * 16 + q4 * 4) = wv; }
        }
        {
            const f32x4 dd = *(const LAS f32x4*)(DD + w * 16 + q4 * 4);
#pragma unroll
            for (int eg = 0; eg < 8; ++eg) S[eg] *= dd;
#pragma unroll
            for (int ks = 0; ks < 2; ++ks) { const bf16x8 A = *(const LAS bf16x8*)(KDT + (w * 16 + l16) * 72 + ks * 32 + q4 * 8);
#pragma unroll
                for (int eg = 0; eg < 8; ++eg) S[eg] = mfma16(A, *(const LAS bf16x8*)(VT + (eg * 16 + l16) * 72 + ks * 32 + q4 * 8), S[eg]); }
        }
        __syncthreads();
    }
}


__device__ __forceinline__ void dbg_dump() {
    const bf16_t* P = (const bf16_t*)(PF(ws) + WS_P); const bf16_t* U = (const bf16_t*)(PF(ws) + WS_U); const float* AGG = (const float*)(PF(ws) + WS_AGG); float* out = PF(out);
    const size_t n = (size_t)NLAT * DM;
    for (size_t i = (size_t)blockIdx.x * 512 + threadIdx.x; i < n; i += (size_t)gridDim.x * 512) {
        float s = 0.f;
#pragma unroll
        for (int k = 0; k < 5; ++k) s += bf2f(P[i + k * n]);
        s += bf2f(P[(i % ((size_t)NTOK * PW - 5 * n)) + 5 * n]);
        s += bf2f(U[i]) + bf2f(U[(i % ((size_t)NCTX * DM)) + n]);
        s += AGG[i % ((size_t)NB * 36 * 2 * 2 * 512)];
        if (!(s == s)) s = 7777.f; if (fabsf(s) > 1e30f) s = 8888.f; out[i] = s + 1000.0f;
    }
}
#ifndef STAGE_STOP
#define STAGE_STOP 0
#define DBG_SKIP 0
#define STAGE_L 0
#endif
__global__ void __launch_bounds__(512, 2) fwd_megakernel(Params p) {
    extern __shared__ __attribute__((aligned(16))) unsigned char lds_raw[];
    LAS unsigned char* lds = (LAS unsigned char*)lds_raw;
    cg::grid_group grid = cg::this_grid();
    const int G = gridDim.x, c = blockIdx.x;

    phase_mod(p, lds); __syncthreads();
    phase_rope(p);
    phase_convert(p, 0, lds);
    grid.sync(); if (STAGE_STOP == 1) return;
#define WSP(T, off) ((T*)(PF(ws) + (off)))
    for (int l = 0; l < 2; ++l) {
        const bool lastl = (l == 1);
        const int Mrest = lastl ? NLAT : NTOK;
        if (l > 0) phase_convert(p, l, lds);
        phase_norm(p, l, l == 0 ? PF(x) : PF(out), l == 0 ? PF(ctx) : WSP(const float, WS_HC), PF(norm1_g) + l * DM, 0, NTOK);
        grid.sync(); if (l == STAGE_L && STAGE_STOP == 2) { dbg_dump(); return; }
        { pg8::Gemm g{WSP(bf16_t, WS_U), WSP(bf16_t, WS_WIN), DM, DM, DM}; pg8::Sched S; S.init(NTOK, PW, G, c, DM, DM); pg8::EpiStore<0> E{WSP(bf16_t, WS_P), PW}; pg8::gemm_phase(lds, g, S, E); }
        grid.sync(); if (l == STAGE_L && STAGE_STOP == 3) { dbg_dump(); return; }
        if (c < 64) { if (!(DBG_SKIP & 1)) hgrn_chain(p, l, lds, c); }
        else { const int cc = c - 64, GG = G - 64; const int nA = lastl ? 1024 : 1152;
            if (!(DBG_SKIP & 2)) for (int it = cc; it < nA; it += GG) attn_item(p, l, lds, it);
            int staged = -1;
            if (!(DBG_SKIP & 4)) for (int it = cc; it < 2304; it += GG) lru_tile(p, l, lds, it, 0, staged); }
        grid.sync(); if (l == STAGE_L && STAGE_STOP == 4) { dbg_dump(); return; }
        { int staged = -1; for (int it = c; it < 2304; it += G) lru_tile(p, l, lds, it, 1, staged); }
        phase_hg_final(p, l, NTOK);
        grid.sync(); if (l == STAGE_L && STAGE_STOP == 5) { dbg_dump(); return; }
        { pg8::Gemm g{WSP(bf16_t, WS_U), WSP(bf16_t, WS_WIN) + (size_t)PW * DM, DM, DM, DM}; pg8::Sched S; S.init(Mrest, 3072, G, c, DM, DM); pg8::EpiStore<1> E{WSP(bf16_t, WS_P), PW}; pg8::gemm_phase(lds, g, S, E); }
        grid.sync(); if (l == STAGE_L && STAGE_STOP == 6) { dbg_dump(); return; }
        for (int n = 0; n < 3; ++n) {
          const int ycol = n == 0 ? C_AG : (n == 1 ? C_BO : C_CQ);
          pg8::Gemm g{WSP(bf16_t, WS_P) + ycol, WSP(bf16_t, WS_WB) + (size_t)n * DM * 512, PW, 512, 512}; pg8::Sched S; S.init(Mrest, DM, G, c, PW, 512);
          pg8::EpiMerge E{WSP(bf16_t, WS_P), WSP(bf16_t, WS_U), n}; pg8::gemm_phase(lds, g, S, E); __syncthreads(); }
        grid.sync(); if (l == STAGE_L && STAGE_STOP == 7) { dbg_dump(); return; }
        { pg8::Gemm g{WSP(bf16_t, WS_U), WSP(bf16_t, WS_WO), DM, DM, DM}; pg8::Sched S; S.init(Mrest, DM, G, c, DM, DM);
          pg8::EpiResid E{l == 0 ? PF(x) : PF(out), l == 0 ? PF(ctx) : WSP(const float, WS_HC), PF(out), WSP(float, WS_HC), WSP(const float, WS_MOD) + (size_t)l * 9 * 6144 + 2048}; pg8::gemm_phase(lds, g, S, E); }
        grid.sync(); if (l == STAGE_L && STAGE_STOP == 8) { dbg_dump(); return; }
        phase_norm(p, l, PF(out), WSP(const float, WS_HC), PF(norm2_g) + l * DM, 3072, Mrest);
        grid.sync(); if (l == STAGE_L && STAGE_STOP == 9) { dbg_dump(); return; }
        { pg8::Gemm g{WSP(bf16_t, WS_U), WSP(bf16_t, WS_W1), DM, DM, DM}; pg8::Sched S; S.init(Mrest, DFF, G, c, DM, DM); pg8::EpiStore<2> E{WSP(bf16_t, WS_P), DFF}; pg8::gemm_phase(lds, g, S, E); }
        grid.sync(); if (l == STAGE_L && STAGE_STOP == 10) { dbg_dump(); return; }
        { pg8::Gemm g{WSP(bf16_t, WS_P), WSP(bf16_t, WS_W2), DFF, DFF, DFF}; pg8::Sched S; S.init(Mrest, DM, G, c, DFF, DFF);
          pg8::EpiResid E{PF(out), WSP(const float, WS_HC), PF(out), WSP(float, WS_HC), WSP(const float, WS_MOD) + (size_t)l * 9 * 6144 + 5120}; pg8::gemm_phase(lds, g, S, E); }
        if (!lastl) grid.sync(); if (l == STAGE_L && STAGE_STOP == 11) { dbg_dump(); return; }
    }
}

extern "C" void kernel_launch(void* const* d_in, const int* in_sizes, int n_in, void* d_out, int out_size, void* d_ws, size_t ws_size, hipStream_t stream) {
    static int grid_blocks = 0;
    if (grid_blocks == 0) {
        int dev = 0, cus = 0, per_cu = 0;
        hipGetDevice(&dev);
        hipDeviceGetAttribute(&cus, hipDeviceAttributeMultiprocessorCount, dev);
        hipFuncSetAttribute((const void*)fwd_megakernel, hipFuncAttributeMaxDynamicSharedMemorySize, LDS_BYTES);
        hipOccupancyMaxActiveBlocksPerMultiprocessor(&per_cu, (const void*)fwd_megakernel, 512, LDS_BYTES);
        if (per_cu < 1 || n_in != 25 || ws_size < WS_END) { fprintf(stderr, "kernel_launch: cannot launch (per_cu %d, n_in %d, ws %zu need %zu)\n", per_cu, n_in, ws_size, (size_t)WS_END); grid_blocks = -1; }
        else grid_blocks = cus;
    }
    if (grid_blocks < 0) return;
    Params p{};
    const float** pp = (const float**)&p;
    for (int i = 0; i < 25; ++i) pp[i] = (const float*)d_in[i];
    p.out = (float*)d_out; p.ws = (unsigned char*)d_ws;
    void* args[] = {&p};
    hipError_t e = hipLaunchCooperativeKernel((const void*)fwd_megakernel, dim3(grid_blocks), dim3(512), args, LDS_BYTES, stream);
    if (e != hipSuccess) fprintf(stderr, "cooperative launch failed: %s (grid %d)\n", hipGetErrorString(e), grid_blocks);
}
```

```cpp
#include <hip/hip_runtime.h>
#include <hip/hip_cooperative_groups.h>
#include <stdint.h>
#include <stdio.h>
namespace cg = cooperative_groups;

#define DBG_HG 0
#define EXPERIMENT 0
#define LAS __attribute__((address_space(3)))
typedef unsigned short bf16_t;
typedef short bf16x8 __attribute__((ext_vector_type(8)));
typedef float f32x4 __attribute__((ext_vector_type(4)));
typedef unsigned u32x4 __attribute__((ext_vector_type(4)));
typedef unsigned u32x2 __attribute__((ext_vector_type(2)));

constexpr int DM = 1024, NB = 8, SEQ = 2048, CTXL = 256, NLAT = NB * SEQ, NCTX = NB * CTXL, NTOK = NLAT + NCTX;
constexpr int PW = 5120, DIN = 8192, DFF = 4096;
constexpr int C_AX = 0, C_AG = 512, C_BQ = 1024, C_BF = 1536, C_BI = 2560, C_BO = 3072, C_CQ = 3584, C_CK = 4096, C_CV = 4608;
constexpr int LDS_BYTES = 131072 + 16;
constexpr size_t WS_WIN = 0;
constexpr size_t WS_WB = WS_WIN + (size_t)DIN * DM * 2;
constexpr size_t WS_WO = WS_WB + (size_t)3 * DM * 512 * 2;
constexpr size_t WS_W1 = WS_WO + (size_t)DM * DM * 2;
constexpr size_t WS_W2 = WS_W1 + (size_t)DFF * DM * 2;
constexpr size_t WS_U = WS_W2 + (size_t)DM * DFF * 2;
constexpr size_t WS_P = WS_U + (size_t)NTOK * DM * 2;
constexpr size_t WS_HC = WS_P + (size_t)NTOK * PW * 2;
constexpr size_t WS_MOD = WS_HC + (size_t)NCTX * DM * 4;
constexpr size_t WS_AGG = WS_MOD + (size_t)2 * 9 * 6144 * 4;
constexpr size_t WS_ROPE = WS_AGG + (size_t)NB * 36 * 2 * 2 * 512 * 4;
constexpr size_t WS_DUMMY = WS_ROPE + 2048 * 4;
constexpr size_t WS_BAR = WS_DUMMY + (2u << 20);
constexpr size_t WS_END = WS_BAR + 16384;

struct Params {
    const float *x, *c, *ctx, *c_ctx, *ada_w, *ada_b, *norm1_g, *norm2_g, *w_in, *conv_w, *conv_b, *lru_wa, *lru_ba, *lru_wx, *lru_bx, *lru_lambda,
        *hg_lb, *hg_norm_g, *na_qg, *na_kg, *na_rpb, *w_branch, *w_out, *ffn_w1, *ffn_w2;
    float* out; unsigned char* ws;
};


__device__ __forceinline__ unsigned long long ldkarg(int off) { unsigned long long v = 0;
#if defined(__HIP_DEVICE_COMPILE__)
    auto kp = __builtin_amdgcn_kernarg_segment_ptr();
    asm volatile("s_load_dwordx2 %0, %1, %2\n\ts_waitcnt lgkmcnt(0)" : "=s"(v) : "s"(kp), "s"(off));
#endif
    return v; }
#define PF(f) ((decltype(Params::f))ldkarg((int)__builtin_offsetof(Params, f)))

template <class T> __device__ __forceinline__ T* lnd(T* p) { asm volatile("" : "+v"(p)); return p; }
__device__ __forceinline__ int tid_() { int t = threadIdx.x; asm volatile("" : "+v"(t)); return t; }
__device__ __forceinline__ float bf2f(unsigned v) { return __uint_as_float(v << 16); }
__device__ __forceinline__ float bflo(unsigned w) { return __uint_as_float(w << 16); }
__device__ __forceinline__ float bfhi(unsigned w) { return __uint_as_float(w & 0xffff0000u); }
__device__ __forceinline__ unsigned f2bf(float f) { unsigned u = __float_as_uint(f); u += 0x7fffu + ((u >> 16) & 1u); return u >> 16; }
typedef __bf16 bf16x2_t __attribute__((ext_vector_type(2)));
typedef float f32x2_t __attribute__((ext_vector_type(2)));
__device__ __forceinline__ unsigned pack2(float lo, float hi) { f32x2_t v = {lo, hi}; bf16x2_t b = __builtin_convertvector(v, bf16x2_t); union { bf16x2_t b; unsigned u; } t; t.b = b; return t.u; }
__device__ __forceinline__ float sigmoidf_(float x) { return 1.0f / (1.0f + __expf(-x)); }
__device__ __forceinline__ f32x4 mfma16(bf16x8 a, bf16x8 b, f32x4 c) { return __builtin_amdgcn_mfma_f32_16x16x32_bf16(a, b, c, 0, 0, 0); }
__device__ __forceinline__ bf16x8 as_bf16x8(u32x4 v) { union { u32x4 u; bf16x8 b; } t; t.u = v; return t.b; }
__device__ __forceinline__ void unpack8(u32x4 w, float* o) { o[0] = bflo(w.x); o[1] = bfhi(w.x); o[2] = bflo(w.y); o[3] = bfhi(w.y); o[4] = bflo(w.z); o[5] = bfhi(w.z); o[6] = bflo(w.w); o[7] = bfhi(w.w); }
__device__ __forceinline__ u32x4 pack8(const float* v) { u32x4 w; w.x = pack2(v[0], v[1]); w.y = pack2(v[2], v[3]); w.z = pack2(v[4], v[5]); w.w = pack2(v[6], v[7]); return w; }

namespace pg8 {
constexpr int BM = 256, BK = 64, HALF = 128, HTB = HALF * BK * 2, NXCD = 8, WGM = 8;
__device__ __forceinline__ int lds_byte(int r, int c) { const int st = (r >> 4) * 2 + (c >> 5), rr = r & 15, cc = c & 31, ob = rr * 64 + cc * 2; return st * 1024 + (ob ^ (((ob >> 9) & 1) << 5)); }
__device__ __forceinline__ void stage_rc(int b, int& R, int& C) { const int st = b / 1024, sb = b % 1024, swz = sb ^ (((sb >> 9) & 1) << 5); R = (st >> 1) * 16 + swz / 64; C = (st & 1) * 32 + (swz % 64) / 2; }
__device__ __forceinline__ int perm32(int rho) { const int n = rho >> 4, i = rho & 15; return 8 * (i >> 2) + 4 * n + (i & 3); }

struct Unit { int pm, pn; size_t aoff, boff; };
struct Gemm { const bf16_t* A; const bf16_t* Bt; int lda, ldb, K; };
struct Sched {
    int nM, nN, nwg, G, c, lda, ldb;
    __device__ void init(int M, int N, int G_, int c_, int lda_, int ldb_) { nM = M / BM; nN = N / BM; nwg = nM * nN; G = G_; c = c_; lda = lda_; ldb = ldb_; }
    __device__ bool next(int i, Unit& u) const {
        const long L = (long)i * G + c; if (L >= nwg) return false;
        int wgid = (int)L; { const int q = nwg / NXCD, r = nwg % NXCD, xcd = wgid % NXCD, off = wgid / NXCD; wgid = (xcd < r ? xcd * (q + 1) : r * (q + 1) + (xcd - r) * q) + off; }
        const int nig = WGM * nN, gid = wgid / nig, fm = gid * WGM, gsz = (nM - fm) < WGM ? (nM - fm) : WGM;
        u.pm = fm + ((wgid % nig) % gsz); u.pn = (wgid % nig) / gsz;
        u.aoff = (size_t)u.pm * BM * lda * 2;
        u.boff = (size_t)u.pn * BM * ldb * 2;
        return true;
    }
};

template <int ACT> struct EpiStore {
    static constexpr bool PERM = true;
    bf16_t* O; int ldc;
    __device__ __forceinline__ void operator()(const f32x4 (&acc)[2][2][4][2], const Unit& u, int wr, int wc, int fr, int fq) const {
        const int row0 = u.pm * BM + wr * 64 + fr; int colt = u.pn * BM;
        if (ACT == 1) colt = (colt < 2048) ? (1024 + colt) : (2048 + colt);
        const int col0 = colt + wc * 32 + 8 * fq;
#pragma unroll
        for (int ai = 0; ai < 2; ++ai)
#pragma unroll
            for (int m = 0; m < 4; ++m) { bf16_t* rowp = lnd(O + (size_t)(row0 + ai * HALF + m * 16) * ldc + col0);
#pragma unroll
                for (int bj = 0; bj < 2; ++bj) { f32x4 v0 = acc[ai][bj][m][0], v1 = acc[ai][bj][m][1];
                    if (ACT == 1) {
#pragma unroll
                        for (int j = 0; j < 4; ++j) { v0[j] = sigmoidf_(v0[j]); v1[j] = sigmoidf_(v1[j]); } }
                    if (ACT == 2) {
#pragma unroll
                        for (int j = 0; j < 4; ++j) { float a = fmaxf(v0[j], 0.f), b = fmaxf(v1[j], 0.f); v0[j] = a * a; v1[j] = b * b; } }
                    u32x4 w; w.x = pack2(v0[0], v0[1]); w.y = pack2(v0[2], v0[3]); w.z = pack2(v1[0], v1[1]); w.w = pack2(v1[2], v1[3]);
                    *(u32x4*)(rowp + bj * HALF) = w; } }
    }
};
struct EpiMerge {
    static constexpr bool PERM = true;
    const bf16_t* P; bf16_t* U; int sub;
    __device__ __forceinline__ void operator()(const f32x4 (&acc)[2][2][4][2], const Unit& u, int wr, int wc, int fr, int fq) const {
        const int row0 = u.pm * BM + wr * 64 + fr; const int col0 = u.pn * BM + wc * 32 + 8 * fq;
        const int gcol = sub * 1024 + u.pn * BM; const int gd = ((gcol < 2048) ? (1024 + gcol) : (2048 + gcol)) + wc * 32 + 8 * fq;
        const bool addp = sub > 0;
#pragma unroll
        for (int ai = 0; ai < 2; ++ai)
#pragma unroll
            for (int m = 0; m < 4; ++m) { const size_t row = (size_t)(row0 + ai * HALF + m * 16); const bf16_t* gp = lnd(P + row * PW + gd); bf16_t* up = lnd(U + row * DM + col0);
#pragma unroll
                for (int bj = 0; bj < 2; ++bj)
#pragma unroll
                    for (int n = 0; n < 2; ++n) { const u32x2 gw = *(const u32x2*)(gp + bj * HALF + 4 * n);
                        float v0 = acc[ai][bj][m][n][0] * bflo(gw.x), v1 = acc[ai][bj][m][n][1] * bfhi(gw.x), v2 = acc[ai][bj][m][n][2] * bflo(gw.y), v3 = acc[ai][bj][m][n][3] * bfhi(gw.y);
                        if (addp) { const u32x2 pw = *(const u32x2*)(up + bj * HALF + 4 * n); v0 += bflo(pw.x); v1 += bfhi(pw.x); v2 += bflo(pw.y); v3 += bfhi(pw.y); }
                        u32x2 o; o.x = pack2(v0, v1); o.y = pack2(v2, v3); *(u32x2*)(up + bj * HALF + 4 * n) = o; } }
    }
};
struct EpiResid {
    static constexpr bool PERM = false;
    const float* inL; const float* inC; float* outL; float* outC; const float* mod;
    __device__ __forceinline__ void operator()(const f32x4 (&acc)[2][2][4][2], const Unit& u, int wr, int wc, int fr, int fq) const {
        const bool lat = u.pm < 64; const int rbase = lat ? u.pm * BM : (u.pm - 64) * BM;
        const float* in = lat ? inL : inC; float* out = lat ? outL : outC;
        const int row0 = rbase + wr * 64 + fr, col0 = u.pn * BM + wc * 32 + 4 * fq;
        const float* gt = mod + (size_t)(lat ? (u.pm >> 3) : 8) * 6144 + col0;
#pragma unroll
        for (int bj = 0; bj < 2; ++bj)
#pragma unroll
            for (int n = 0; n < 2; ++n) { const f32x4 gv = *(const f32x4*)(gt + bj * HALF + n * 16);
#pragma unroll
                for (int ai = 0; ai < 2; ++ai)
#pragma unroll
                    for (int m = 0; m < 4; ++m) { const size_t ro = (size_t)(row0 + ai * HALF + m * 16) * DM + col0 + bj * HALF + n * 16;
                        const float* ip = lnd(in + ro); float* op = lnd(out + ro); const f32x4 iv = *(const f32x4*)ip; *(f32x4*)op = iv + gv * acc[ai][bj][m][n]; } }
    }
};

template <class Epi>
__device__ __forceinline__ void gemm_phase(LAS unsigned char* lds, const Gemm g, const Sched& S, const Epi& E) {
    const int tid = tid_(), wid = __builtin_amdgcn_readfirstlane(tid >> 6), lane = tid & 63, wr = wid >> 2, wc = wid & 3, fr = lane & 15, fq = lane >> 4;
    const int K = g.K, nt = K / BK;
    unsigned voffA[2], voffB[2];
#pragma unroll
    for (int i = 0; i < 2; ++i) { int R, C; stage_rc(tid * 16 + i * 8192, R, C); const int Rb = Epi::PERM ? ((R & ~31) + perm32(R & 31)) : R;
        voffA[i] = (unsigned)(R * g.lda + C) * 2u; voffB[i] = (unsigned)(Rb * g.ldb + C) * 2u; }
    const size_t kstep = (size_t)(BK * 2);
    const size_t hstepA = (size_t)HALF * g.lda * 2, hstepB = (size_t)HALF * g.ldb * 2;
    const unsigned ldsw = (unsigned)wid * 1024u;
    const int aoff = lds_byte(wr * 64 + fr, fq * 8), boff = lds_byte(wc * 32 + fr, fq * 8);
#define PG8_SA(b, h) (((b) * 2 + (h)) * HTB)
#define PG8_SB(b, h) ((4 + (b) * 2 + (h)) * HTB)
#define PG8_STAGE(bufoff, gbase, voff) do { _Pragma("unroll") for (int _i = 0; _i < 2; ++_i) \
        __builtin_amdgcn_global_load_lds((const unsigned*)((const char*)(gbase) + (voff)[_i]), (LAS unsigned*)(lds + (bufoff) + ldsw + _i * 8192), 16, 0, 0); } while (0)
#define PG8_LDA(dst, b, h) do { _Pragma("unroll") for (int m = 0; m < 4; ++m) _Pragma("unroll") for (int k = 0; k < 2; ++k) dst[m][k] = *(const LAS bf16x8*)(lds + PG8_SA(b, h) + aoff + m * 2048 + k * 1024); } while (0)
#define PG8_LDB(dst, b, h) do { _Pragma("unroll") for (int n = 0; n < 2; ++n) _Pragma("unroll") for (int k = 0; k < 2; ++k) dst[n][k] = *(const LAS bf16x8*)(lds + PG8_SB(b, h) + boff + n * 2048 + k * 1024); } while (0)
#define PG8_MMA(ai, bj, At, Bt) do { __builtin_amdgcn_s_setprio(1); _Pragma("unroll") for (int m = 0; m < 4; ++m) _Pragma("unroll") for (int n = 0; n < 2; ++n) _Pragma("unroll") for (int k = 0; k < 2; ++k) \
        acc[ai][bj][m][n] = __builtin_amdgcn_mfma_f32_16x16x32_bf16(Bt[n][k], At[m][k], acc[ai][bj][m][n], 0, 0, 0); __builtin_amdgcn_s_setprio(0); } while (0)
#define PG8_WAIT_V(n) asm volatile("s_waitcnt vmcnt(" #n ")" ::: "memory")
#define PG8_WAIT_L(n) asm volatile("s_waitcnt lgkmcnt(" #n ")" ::: "memory")
#define PG8_BAR __builtin_amdgcn_s_barrier()
#define PG8_SCHED __builtin_amdgcn_sched_barrier(0)
    Unit cur, nxt; int ui = 0;
    if (!S.next(0, cur)) return;
    f32x4 acc[2][2][4][2];
#pragma unroll
    for (int a = 0; a < 2; ++a)
#pragma unroll
        for (int b = 0; b < 2; ++b)
#pragma unroll
            for (int m = 0; m < 4; ++m)
#pragma unroll
                for (int n = 0; n < 2; ++n) acc[a][b][m][n] = (f32x4){0.f, 0.f, 0.f, 0.f};
    bf16x8 At[4][2], B0[2][2], B1[2][2];
    const char* cA = (const char*)g.A + cur.aoff; const char* cB = (const char*)g.Bt + cur.boff;
    PG8_STAGE(PG8_SB(0, 0), cB, voffB); PG8_STAGE(PG8_SA(0, 0), cA, voffA); PG8_STAGE(PG8_SB(0, 1), cB + hstepB, voffB); PG8_STAGE(PG8_SA(0, 1), cA + hstepA, voffA);
    if (wr == 1) PG8_BAR;
    PG8_WAIT_V(4); PG8_BAR;
    PG8_STAGE(PG8_SB(1, 0), cB + kstep, voffB); PG8_STAGE(PG8_SA(1, 0), cA + kstep, voffA); PG8_STAGE(PG8_SB(1, 1), cB + hstepB + kstep, voffB);
    PG8_WAIT_V(6); PG8_BAR;
    for (;;) {
        const bool has_next = S.next(ui + 1, nxt);
        const char* nA = has_next ? (const char*)g.A + nxt.aoff : cA; const char* nB = has_next ? (const char*)g.Bt + nxt.boff : cB;
        for (int t = 0; t < nt; t += 2) {
            const bool last = (t == nt - 2);
            const char* a1 = cA + (size_t)(t + 1) * kstep;
            const char* a2 = last ? nA : cA + (size_t)(t + 2) * kstep; const char* b2 = last ? nB : cB + (size_t)(t + 2) * kstep;
            const char* a3 = a2 + kstep; const char* b3 = b2 + kstep;
            PG8_LDB(B0, 0, 0); PG8_SCHED; PG8_LDA(At, 0, 0); PG8_STAGE(PG8_SA(1, 1), a1 + hstepA, voffA);
            PG8_WAIT_L(8); PG8_BAR; PG8_WAIT_L(0); PG8_MMA(0, 0, At, B0); PG8_BAR; PG8_SCHED;
            PG8_LDB(B1, 0, 1); PG8_STAGE(PG8_SB(0, 0), b2, voffB);
            PG8_BAR; PG8_WAIT_L(0); PG8_MMA(0, 1, At, B1); PG8_BAR;
            PG8_LDA(At, 0, 1); PG8_STAGE(PG8_SA(0, 0), a2, voffA);
            PG8_BAR; PG8_WAIT_L(0); PG8_MMA(1, 0, At, B0); PG8_BAR; PG8_SCHED;
            PG8_STAGE(PG8_SB(0, 1), b2 + hstepB, voffB);
            PG8_WAIT_V(6); PG8_BAR; PG8_MMA(1, 1, At, B1); PG8_BAR;
            PG8_LDB(B0, 1, 0); PG8_SCHED; PG8_LDA(At, 1, 0); PG8_STAGE(PG8_SA(0, 1), a2 + hstepA, voffA);
            PG8_WAIT_L(8); PG8_BAR; PG8_WAIT_L(0); PG8_MMA(0, 0, At, B0); PG8_BAR; PG8_SCHED;
            PG8_LDB(B1, 1, 1); PG8_STAGE(PG8_SB(1, 0), b3, voffB);
            PG8_BAR; PG8_WAIT_L(0); PG8_MMA(0, 1, At, B1); PG8_BAR;
            PG8_LDA(At, 1, 1); PG8_STAGE(PG8_SA(1, 0), a3, voffA);
            PG8_BAR; PG8_WAIT_L(0); PG8_MMA(1, 0, At, B0); PG8_BAR; PG8_SCHED;
            PG8_STAGE(PG8_SB(1, 1), b3 + hstepB, voffB);
            PG8_WAIT_V(6); PG8_BAR; PG8_MMA(1, 1, At, B1); PG8_BAR;
        }
        E(acc, cur, wr, wc, fr, fq);
        if (!has_next) break;
#pragma unroll
        for (int a = 0; a < 2; ++a)
#pragma unroll
            for (int b = 0; b < 2; ++b)
#pragma unroll
                for (int m = 0; m < 4; ++m)
#pragma unroll
                    for (int n = 0; n < 2; ++n) acc[a][b][m][n] = (f32x4){0.f, 0.f, 0.f, 0.f};
        cur = nxt; cA = nA; cB = nB; ++ui;
    }
    PG8_WAIT_V(0);
    if (wr == 0) PG8_BAR;
    PG8_BAR;
#undef PG8_SA
#undef PG8_SB
#undef PG8_STAGE
#undef PG8_LDA
#undef PG8_LDB
#undef PG8_MMA
#undef PG8_WAIT_V
#undef PG8_WAIT_L
#undef PG8_BAR
#undef PG8_SCHED
}
}


#define XB_TMO      128
#define XB_XCNT(j)  (256  + 64 * (j))
#define XB_XSUB(j)  (1280 + 64 * (j))
#define XB_XGEN(j)  (2304 + 64 * (j))
#define XB_TOP      3328
#define XB_TOPGEN   3392
#define XCD_BAR_WORDS 3456
#define XB_SPIN_CAP (1u << 20)
__device__ __forceinline__ unsigned xb_ld(unsigned* p)              { return __hip_atomic_load(p, __ATOMIC_RELAXED, __HIP_MEMORY_SCOPE_AGENT); }
__device__ __forceinline__ unsigned xb_add(unsigned* p, unsigned v) { return __hip_atomic_fetch_add(p, v, __ATOMIC_RELAXED, __HIP_MEMORY_SCOPE_AGENT); }
__device__ __forceinline__ unsigned xb_xcc_id() { return (unsigned)__builtin_amdgcn_s_getreg((3 << 11) | 20) & 0xFu; }
#define XB_SPIN(cond, bar) do { unsigned _sp = 0; while (cond) { __builtin_amdgcn_s_sleep(1); \
    if ((++_sp & 255u) == 0u) { if (xb_ld(&(bar)[XB_TMO])) break; if (_sp > XB_SPIN_CAP) { atomicAdd(&(bar)[XB_TMO], 1u); break; } } } } while (0)
struct XcdBarrier { unsigned* bar; unsigned x; volatile LAS unsigned* st; };
__device__ __forceinline__ XcdBarrier xcd_barrier_post(unsigned* bar, volatile LAS unsigned* st) {
    XcdBarrier b; b.bar = bar; b.x = xb_xcc_id(); b.st = st;
    if (threadIdx.x == 0) (void)xb_add(&bar[XB_XCNT(b.x)], 1u);
    return b;
}
__device__ __forceinline__ void xcd_barrier_complete(unsigned* bar, unsigned x, unsigned& nloc, unsigned& nx) {
    const unsigned G = gridDim.x * gridDim.y * gridDim.z;
    unsigned sum, cnt, mine, sp = 0u;
    for (;;) {
        sum = 0u; cnt = 0u; mine = 0u;
#pragma unroll
        for (unsigned j = 0; j < 16; ++j) { const unsigned c = xb_ld(&bar[XB_XCNT(j)]); sum += c; cnt += (c > 0u) ? 1u : 0u; mine = (j == x) ? c : mine; }
        if (sum == G) break;
        __builtin_amdgcn_s_sleep(1);
        if ((++sp & 255u) == 0u) { if (xb_ld(&bar[XB_TMO])) break; if (sp > XB_SPIN_CAP) { atomicAdd(&bar[XB_TMO], 1u); break; } }
    }
    nloc = mine > 0u ? mine : 1u; nx = cnt > 0u ? cnt : 1u;
}
__device__ __forceinline__ void xcd_barrier(const XcdBarrier& b) {
    asm volatile("s_waitcnt vmcnt(0)" ::: "memory");
    __syncthreads();
    if (threadIdx.x == 0) {
        unsigned* bar = b.bar;
        __builtin_amdgcn_s_waitcnt(0);
        unsigned nloc = b.st[0], nx = b.st[1];
        if (nloc == 0u) { xcd_barrier_complete(bar, b.x, nloc, nx); b.st[0] = nloc; b.st[1] = nx; }
        const unsigned old = xb_add(&bar[XB_XSUB(b.x)], 1u);
        const unsigned gen = old / nloc;
        if (old + 1u == (gen + 1u) * nloc) {
            __builtin_amdgcn_fence(__ATOMIC_RELEASE, "agent");
            asm volatile("s_waitcnt vmcnt(0)" ::: "memory");
            const unsigned og = xb_add(&bar[XB_TOP], 1u);
            const unsigned tg = og / nx;
            if (og + 1u == (tg + 1u) * nx) xb_add(&bar[XB_TOPGEN], 1u);
            else XB_SPIN(xb_ld(&bar[XB_TOPGEN]) == tg, bar);
            __builtin_amdgcn_fence(__ATOMIC_ACQUIRE, "agent");
            xb_add(&bar[XB_XGEN(b.x)], 1u);
            asm volatile("s_waitcnt vmcnt(0)" ::: "memory");
        } else {
            XB_SPIN(xb_ld(&bar[XB_XGEN(b.x)]) == gen, bar);
            __builtin_amdgcn_fence(__ATOMIC_ACQUIRE, "agent");
            asm volatile("s_waitcnt vmcnt(0)" ::: "memory");
        }
    }
    __syncthreads();
}

__device__ __forceinline__ void phase_mod(const Params& p, LAS unsigned char* lds) {
    LAS float* sc = (LAS float*)lds;
    LAS float* part = sc + 9 * 1024;
    float* mod = (float*)(PF(ws) + WS_MOD);
    const int tid = tid_(), w = tid >> 6, lane = tid & 63;
    if ((int)blockIdx.x >= 192) return;
    const float* pc = PF(c); const float* pcc = PF(c_ctx); const float* padaw = PF(ada_w); const float* padab = PF(ada_b);
    for (int i = tid; i < 9 * 1024; i += 512) { const int r = i >> 10, k = i & 1023; const float v = (r < 8) ? pc[r * 1024 + k] : pcc[k]; sc[i] = v / (1.0f + expf(-v)); }
    __syncthreads();
    for (int item = blockIdx.x; item < 192; item += gridDim.x) {
        const int l = item / 96, cb = item % 96;
        const float* W = padaw + (size_t)l * 1024 * 6144 + cb * 64 + lane;
        float acc[9];
#pragma unroll
        for (int r = 0; r < 9; ++r) acc[r] = 0.f;
        for (int k = w * 128; k < w * 128 + 128; ++k) { const float wv = W[(size_t)k * 6144];
#pragma unroll
            for (int r = 0; r < 9; ++r) acc[r] += sc[r * 1024 + k] * wv; }
#pragma unroll
        for (int r = 0; r < 9; ++r) part[(w * 9 + r) * 64 + lane] = acc[r];
        __syncthreads();
        for (int i = tid; i < 576; i += 512) { const int r = i >> 6, ln = i & 63; float s = 0.f;
#pragma unroll
            for (int ww = 0; ww < 8; ++ww) s += part[(ww * 9 + r) * 64 + ln];
            mod[(size_t)(l * 9 + r) * 6144 + cb * 64 + ln] = s + padab[l * 6144 + cb * 64 + ln]; }
        __syncthreads();
    }
}
__device__ __forceinline__ void phase_rope(const Params& p) {
    if (blockIdx.x != gridDim.x - 1) return;
    float* rope = (float*)(PF(ws) + WS_ROPE);
    for (int i = tid_(); i < 1024; i += 512) { const int pos = i >> 4, fi = i & 15; const float invf = powf(10000.0f, -(float)fi / 16.0f); const float ang = (float)pos * invf; rope[i] = cosf(ang); rope[1024 + i] = sinf(ang); }
}
__device__ __forceinline__ void convert_tile(const float* src, int K, int N, bf16_t* dst, int tile, LAS bf16_t* T) {
    const int tid = tid_(), tilesN = N >> 6, tk = tile / tilesN, tn = tile - tk * tilesN, k0 = tk * 64, n0 = tn * 64;
    const int r = tid >> 3, c8 = (tid & 7) * 8;
    const float* s = src + (size_t)(k0 + r) * N + n0 + c8;
    const f32x4 a = *(const f32x4*)s, b = *(const f32x4*)(s + 4);
#pragma unroll
    for (int j = 0; j < 4; ++j) { T[(c8 + j) * 72 + r] = (bf16_t)f2bf(a[j]); T[(c8 + 4 + j) * 72 + r] = (bf16_t)f2bf(b[j]); }
    __syncthreads();
    const u32x4 v = *(const LAS u32x4*)(T + r * 72 + c8);
    *(u32x4*)(dst + (size_t)(n0 + r) * K + k0 + c8) = v;
    __syncthreads();
}
__device__ __forceinline__ void phase_convert(const Params& p, int l, LAS unsigned char* lds) {
    LAS bf16_t* T = (LAS bf16_t*)lds;
    bf16_t* WIN = (bf16_t*)(PF(ws) + WS_WIN); bf16_t* WB = (bf16_t*)(PF(ws) + WS_WB); bf16_t* WO = (bf16_t*)(PF(ws) + WS_WO); bf16_t* W1 = (bf16_t*)(PF(ws) + WS_W1); bf16_t* W2 = (bf16_t*)(PF(ws) + WS_W2);
    for (int it = blockIdx.x; it < 4736; it += gridDim.x) {
        if (it < 2048) convert_tile(PF(w_in) + (size_t)l * DM * DIN, DM, DIN, WIN, it, T);
        else if (it < 2432) { const int n = (it - 2048) / 128, tl = (it - 2048) % 128; convert_tile(PF(w_branch) + (size_t)(l * 3 + n) * 512 * DM, 512, DM, WB + (size_t)n * DM * 512, tl, T); }
        else if (it < 2688) convert_tile(PF(w_out) + (size_t)l * DM * DM, DM, DM, WO, it - 2432, T);
        else if (it < 3712) convert_tile(PF(ffn_w1) + (size_t)l * DM * DFF, DM, DFF, W1, it - 2688, T);
        else convert_tile(PF(ffn_w2) + (size_t)l * DFF * DM, DFF, DM, W2, it - 3712, T);
    }
}
__device__ __forceinline__ void phase_norm(const Params& p, int l, const float* hlat, const float* hctx, const float* g, int modoff, int nrows) {
    const int tid = tid_(); const int w = tid >> 6, lane = tid & 63;
    bf16_t* U = (bf16_t*)(PF(ws) + WS_U); const float* mod = (const float*)(PF(ws) + WS_MOD);
    for (int row = blockIdx.x * 8 + w; row < nrows; row += gridDim.x * 8) {
        const float* src = row < NLAT ? hlat + (size_t)row * DM : hctx + (size_t)(row - NLAT) * DM;
        const int mr = row < NLAT ? (row >> 11) : 8;
        const float* md = mod + (size_t)(l * 9 + mr) * 6144 + modoff;
        f32x4 v[4]; float ss = 0.f;
#pragma unroll
        for (int i = 0; i < 4; ++i) { v[i] = *(const f32x4*)(src + i * 256 + lane * 4); ss += v[i][0] * v[i][0] + v[i][1] * v[i][1] + v[i][2] * v[i][2] + v[i][3] * v[i][3]; }
#pragma unroll
        for (int o = 32; o >= 1; o >>= 1) ss += __shfl_xor(ss, o);
        const float rstd = rsqrtf(ss * (1.0f / 1024.0f) + 1e-6f);
#pragma unroll
        for (int i = 0; i < 4; ++i) { const int cidx = i * 256 + lane * 4; const f32x4 gg = *(const f32x4*)(g + cidx), sh = *(const f32x4*)(md + cidx), scv = *(const f32x4*)(md + 1024 + cidx);
            float o4[4];
#pragma unroll
            for (int j = 0; j < 4; ++j) o4[j] = (v[i][j] * rstd * gg[j]) * (1.0f + scv[j]) + sh[j];
            u32x2 wv; wv.x = pack2(o4[0], o4[1]); wv.y = pack2(o4[2], o4[3]);
            *(u32x2*)(U + (size_t)row * DM + cidx) = wv; }
    }
}
__device__ __forceinline__ void phase_hg_final(const Params& p, int l, int nrows) {
    const int tid = tid_(); const int w = tid >> 6, lane = tid & 63; bf16_t* P = (bf16_t*)(PF(ws) + WS_P);
    const int hd = lane >> 4, e8 = (lane & 15) * 8; const float* png = PF(hg_norm_g);
    float ng[8];
#pragma unroll
    for (int i = 0; i < 8; ++i) ng[i] = png[l * 128 + e8 + i];
    for (int row = blockIdx.x * 8 + w; row < nrows; row += gridDim.x * 8) {
        bf16_t* rp = P + (size_t)row * PW;
        float a[8], b[8], og[8]; unpack8(*(const u32x4*)(rp + C_BF + hd * 128 + e8), a); unpack8(*(const u32x4*)(rp + C_BF + 512 + hd * 128 + e8), b); unpack8(*(const u32x4*)(rp + C_BO + hd * 128 + e8), og);
        float ss = 0.f;
#pragma unroll
        for (int i = 0; i < 8; ++i) { a[i] += b[i]; ss += a[i] * a[i]; }
        ss += __shfl_xor(ss, 1); ss += __shfl_xor(ss, 2); ss += __shfl_xor(ss, 4); ss += __shfl_xor(ss, 8);
        const float rstd = rsqrtf(ss * (1.0f / 128.0f) + 1e-6f);
        float y[8];
#pragma unroll
        for (int i = 0; i < 8; ++i) y[i] = a[i] * rstd * ng[i] * sigmoidf_(og[i]);
        *(u32x4*)(rp + C_BO + hd * 128 + e8) = pack8(y);
    }
}

__device__ __forceinline__ size_t agg_idx(int b, int gch, int dir, int which, int ch) { return ((((size_t)b * 36 + gch) * 2 + dir) * 2 + which) * 512 + ch; }
__device__ __forceinline__ float gelu_tanh(float x) { const float u = 0.7978845608028654f * (x + 0.044715f * x * x * x); const float th = 1.0f - 2.0f / (1.0f + __expf(2.0f * u)); return 0.5f * x * (1.0f + th); }
__device__ __forceinline__ void lru_tile(const Params& p, int l, LAS unsigned char* lds, int item, int mode, int& staged_nb) {
    LAS bf16_t* Wl = (LAS bf16_t*)lds;
    LAS bf16_t* Xb = Wl + 256 * 72;
    LAS float* Xf = (LAS float*)(lds + 46080);
    LAS float* Av = Xf + 4096;
    LAS float* Bv = Av + 8192;
    bf16_t* P = (bf16_t*)(PF(ws) + WS_P); float* AGG = (float*)(PF(ws) + WS_AGG);
    const int tid = tid_(), w = tid >> 6, lane = tid & 63, l16 = lane & 15, q4 = lane >> 4;
    const int nb = item & 7, rest = item >> 3, gch = rest % 36, b = rest / 36;
    const bool isctx = gch < 4; const int chunk = isctx ? gch : gch - 4, L = isctx ? CTXL : SEQ;
    const size_t seqrow0 = isctx ? (size_t)NLAT + b * CTXL : (size_t)b * SEQ; const int t0 = chunk * 64;
    if (staged_nb != nb) { const float* pwx = PF(lru_wx); const float* pwa = PF(lru_wa);
        for (int e = tid; e < 4 * 64 * 64; e += 512) { const int mat = e >> 12, i = (e >> 6) & 63, c = e & 63; const int dir = mat >> 1, kind = mat & 1;
            const float* W = kind ? pwx : pwa; const float v = W[((size_t)((l * 2 + dir) * 8 + nb) * 64 + i) * 64 + c];
            const int op = dir * 128 + (c >> 4) * 32 + kind * 16 + (c & 15);
            Wl[op * 72 + i] = (bf16_t)f2bf(v); }
        staged_nb = nb;
    }
    {
        const int t = tid >> 3, c8 = (tid & 7) * 8, ch = nb * 64 + c8, tt = t0 + t;
        float a8[8]; const float* pcb = PF(conv_b); const float* pcw = PF(conv_w);
        { const f32x4 b0 = *(const f32x4*)(pcb + l * 512 + ch), b1 = *(const f32x4*)(pcb + l * 512 + ch + 4);
#pragma unroll
          for (int i = 0; i < 4; ++i) { a8[i] = b0[i]; a8[4 + i] = b1[i]; } }
#pragma unroll
        for (int j = 0; j < 4; ++j) { const int ts = tt + j - 2;
            if (ts >= 0 && ts < L) { float xv[8]; unpack8(*(const u32x4*)(P + (seqrow0 + ts) * PW + C_AX + ch), xv);
                const f32x4 w0 = *(const f32x4*)(pcw + (l * 4 + j) * 512 + ch), w1 = *(const f32x4*)(pcw + (l * 4 + j) * 512 + ch + 4);
#pragma unroll
                for (int i = 0; i < 4; ++i) { a8[i] += xv[i] * w0[i]; a8[4 + i] += xv[4 + i] * w1[i]; } } }
#pragma unroll
        for (int i = 0; i < 8; ++i) Xf[t * 64 + c8 + i] = a8[i];
        *(LAS u32x4*)(Xb + t * 72 + c8) = pack8(a8);
    }
    __syncthreads();
    {
        const int dir = w >> 2, c = (w & 3) * 16 + l16, ch = nb * 64 + c;
        f32x4 acc[4][2];
#pragma unroll
        for (int mg = 0; mg < 4; ++mg) { acc[mg][0] = (f32x4){0.f, 0.f, 0.f, 0.f}; acc[mg][1] = (f32x4){0.f, 0.f, 0.f, 0.f}; }
#pragma unroll
        for (int ks = 0; ks < 2; ++ks) {
            const bf16x8 B0 = *(const LAS bf16x8*)(Wl + (w * 32 + l16) * 72 + ks * 32 + q4 * 8), B1 = *(const LAS bf16x8*)(Wl + (w * 32 + 16 + l16) * 72 + ks * 32 + q4 * 8);
#pragma unroll
            for (int mg = 0; mg < 4; ++mg) { const bf16x8 A = *(const LAS bf16x8*)(Xb + (mg * 16 + l16) * 72 + ks * 32 + q4 * 8);
                acc[mg][0] = mfma16(A, B0, acc[mg][0]); acc[mg][1] = mfma16(A, B1, acc[mg][1]); }
        }
        const float ba = PF(lru_ba)[(l * 2 + dir) * 512 + ch], bx = PF(lru_bx)[(l * 2 + dir) * 512 + ch], lam = PF(lru_lambda)[(l * 2 + dir) * 512 + ch];
        const float sp = log1pf(expf(-lam));
#pragma unroll
        for (int mg = 0; mg < 4; ++mg)
#pragma unroll
            for (int j = 0; j < 4; ++j) { const int t = mg * 16 + q4 * 4 + j;
                const float r = 1.0f / (1.0f + expf(-(acc[mg][0][j] + ba))), ig = 1.0f / (1.0f + expf(-(acc[mg][1][j] + bx)));
                const float la = -8.0f * r * sp; const float a = expf(la); const float bb = sqrtf(fmaxf(-expm1f(2.0f * la), 0.f)) * ig * Xf[t * 64 + c];
                Av[(dir * 64 + t) * 64 + c] = a; Bv[(dir * 64 + t) * 64 + c] = bb; }
    }
    __syncthreads();
    if (tid < 128) {
        const int d2 = tid >> 6, c = tid & 63, ch = nb * 64 + c;
        float h = 0.f, ap = 1.f;
        if (mode == 1) {
            if (d2 == 0) { for (int g = 0; g < gch; ++g) h = AGG[agg_idx(b, g, 0, 0, ch)] * h + AGG[agg_idx(b, g, 0, 1, ch)]; }
            else {
                if (gch < 4) { for (int g = 3; g > gch; --g) h = AGG[agg_idx(b, g, 1, 0, ch)] * h + AGG[agg_idx(b, g, 1, 1, ch)]; }
                else { for (int g = 3; g >= 0; --g) h = AGG[agg_idx(b, g, 1, 0, ch)] * h + AGG[agg_idx(b, g, 1, 1, ch)];
                       for (int g = 35; g > gch; --g) h = AGG[agg_idx(b, g, 1, 0, ch)] * h + AGG[agg_idx(b, g, 1, 1, ch)]; }
            }
        }
        for (int s = 0; s < 64; ++s) { const int t = d2 ? 63 - s : s; const int ix = (d2 * 64 + t) * 64 + c; const float a = Av[ix], bb = Bv[ix]; h = a * h + bb; ap *= a; if (mode == 1) Bv[ix] = h; }
        if (mode == 0) { AGG[agg_idx(b, gch, d2, 0, ch)] = ap; AGG[agg_idx(b, gch, d2, 1, ch)] = h; }
    }
    __syncthreads();
    if (mode == 1) {
        const int t = tid >> 3, c8 = (tid & 7) * 8; bf16_t* gp = P + (seqrow0 + t0 + t) * PW + C_AG + nb * 64 + c8;
        float gt[8]; unpack8(*(const u32x4*)gp, gt); float y[8];
#pragma unroll
        for (int i = 0; i < 8; ++i) y[i] = (Bv[t * 64 + c8 + i] + Bv[(64 + t) * 64 + c8 + i]) * gelu_tanh(gt[i]);
        *(u32x4*)gp = pack8(y);
        __syncthreads();
    }
}

__device__ __forceinline__ void attn_item(const Params& p, int l, LAS unsigned char* lds, int item, int dry = 0) {
    LAS bf16_t* Kt = (LAS bf16_t*)lds;
    LAS bf16_t* Vt = Kt + 2 * 64 * 72;
    LAS float* rpbL = (LAS float*)(lds + 36864);
    LAS float* cosT = rpbL + 960;
    LAS float* sinT = cosT + 1024;
    LAS float* gq = sinT + 1024; LAS float* gk = gq + 64;
    bf16_t* P = (bf16_t*)(PF(ws) + WS_P); const float* rope = (const float*)(PF(ws) + WS_ROPE);
    const int tid = tid_(), w = tid >> 6, lane = tid & 63, l16 = lane & 15, q4 = lane >> 4, hh = w >> 2, qg4 = w & 3;
    const bool isctx = item >= 1024;
    int b, r, hp, nloc, kr0; size_t qrow0;
    if (!isctx) { hp = item & 3; r = (item >> 2) & 31; b = item >> 7; qrow0 = (size_t)b * SEQ + r * 64; nloc = 8; kr0 = min(max(r - 4, 0), 24); }
    else { const int it = item - 1024; hp = it & 3; const int qt = (it >> 2) & 3; b = it >> 4; qrow0 = (size_t)NLAT + b * CTXL + qt * 64; nloc = 0; r = 0; kr0 = 0; }
    const int h = hp * 2 + hh;
    const float* prpb = PF(na_rpb);
    for (int i = tid; i < 2 * 465; i += 512) { const int h2 = i / 465, j = i - h2 * 465; rpbL[h2 * 480 + j] = prpb[(size_t)((l * 8 + hp * 2 + h2) * 465) + j]; }
    for (int i = tid; i < 1024; i += 512) { cosT[i] = rope[i]; sinT[i] = rope[1024 + i]; }
    if (tid < 64) { gq[tid] = PF(na_qg)[l * 64 + tid]; gk[tid] = PF(na_kg)[l * 64 + tid]; }
    __syncthreads();
    const int qc = qg4 * 16 + l16; const size_t qrow = qrow0 + qc;
    bf16x8 qpl[2], qrt[2];
    {
        const bf16_t* qp = P + qrow * PW + C_CQ + h * 64;
        float xq[16]; unpack8(*(const u32x4*)(qp + q4 * 8), xq); unpack8(*(const u32x4*)(qp + 32 + q4 * 8), xq + 8);
        float ss = 0.f;
#pragma unroll
        for (int i = 0; i < 16; ++i) ss += xq[i] * xq[i];
        ss += __shfl_xor(ss, 16); ss += __shfl_xor(ss, 32);
        const float rs = rsqrtf(ss * (1.0f / 64.0f) + 1e-6f) * 0.125f;
#pragma unroll
        for (int i = 0; i < 8; ++i) { xq[i] *= rs * gq[q4 * 8 + i]; xq[8 + i] *= rs * gq[32 + q4 * 8 + i]; }
        qpl[0] = as_bf16x8(pack8(xq)); qpl[1] = as_bf16x8(pack8(xq + 8));
        float xr[16];
#pragma unroll
        for (int ks = 0; ks < 2; ++ks) { const int pos = ks == 0 ? r : qc;
#pragma unroll
            for (int jj = 0; jj < 8; ++jj) { const int fi = (q4 & 1) * 8 + jj; const float cs = cosT[pos * 16 + fi], sn = sinT[pos * 16 + fi]; const float xv = xq[ks * 8 + jj]; const float pr = __shfl_xor(xv, 32);
                xr[ks * 8 + jj] = (q4 < 2) ? (xv * cs - pr * sn) : (xv * cs + pr * sn); } }
        qrt[0] = as_bf16x8(pack8(xr)); qrt[1] = as_bf16x8(pack8(xr + 8));
    }
    f32x4 O[4];
#pragma unroll
    for (int i = 0; i < 4; ++i) O[i] = (f32x4){0.f, 0.f, 0.f, 0.f};
    float mrun = -1e30f, lsum = 0.f;
#pragma unroll
    for (int ph = 0; ph < 2; ++ph) {
    const bool loc = (ph == 0); const int ntile = loc ? nloc : 4;
    for (int kt = 0; kt < ntile; ++kt) {
        const int kr = kr0 + kt;
        const size_t krow0 = loc ? (size_t)b * SEQ + kr * 64 : (size_t)NLAT + b * CTXL + kt * 64;
        {
            const int hh2 = tid >> 8, key = (tid & 255) >> 2, seg = tid & 3, h2 = hp * 2 + hh2;
            const bf16_t* kp = P + (krow0 + key) * PW + C_CK + h2 * 64 + seg * 16;
            float xk[16]; unpack8(*(const u32x4*)kp, xk); unpack8(*(const u32x4*)(kp + 8), xk + 8);
            float ss = 0.f;
#pragma unroll
            for (int i = 0; i < 16; ++i) ss += xk[i] * xk[i];
            ss += __shfl_xor(ss, 1); ss += __shfl_xor(ss, 2);
            const float rs = rsqrtf(ss * (1.0f / 64.0f) + 1e-6f);
#pragma unroll
            for (int i = 0; i < 16; ++i) xk[i] *= rs * gk[seg * 16 + i];
            if (loc) { const int pos = seg < 2 ? kr : key;
#pragma unroll
                for (int i = 0; i < 16; ++i) { const float pr = __shfl_xor(xk[i], 1); const float cs = cosT[pos * 16 + i], sn = sinT[pos * 16 + i]; xk[i] = (seg & 1) ? (xk[i] * cs + pr * sn) : (xk[i] * cs - pr * sn); } }
            LAS bf16_t* kd = Kt + (hh2 * 64 + key) * 72 + seg * 16;
            *(LAS u32x4*)kd = pack8(xk); *(LAS u32x4*)(kd + 8) = pack8(xk + 8);
        }
        {
            const int hh2 = tid >> 8, seg = (tid & 255) >> 6, key = tid & 63, h2 = hp * 2 + hh2;
            const bf16_t* vp = P + (krow0 + key) * PW + C_CV + h2 * 64 + seg * 16;
            const u32x4 a = *(const u32x4*)vp, c = *(const u32x4*)(vp + 8);
            LAS bf16_t* vd = Vt + (hh2 * 64 + seg * 16) * 72 + key;
            vd[0 * 72] = (bf16_t)(a.x & 0xffff); vd[1 * 72] = (bf16_t)(a.x >> 16); vd[2 * 72] = (bf16_t)(a.y & 0xffff); vd[3 * 72] = (bf16_t)(a.y >> 16);
            vd[4 * 72] = (bf16_t)(a.z & 0xffff); vd[5 * 72] = (bf16_t)(a.z >> 16); vd[6 * 72] = (bf16_t)(a.w & 0xffff); vd[7 * 72] = (bf16_t)(a.w >> 16);
            vd[8 * 72] = (bf16_t)(c.x & 0xffff); vd[9 * 72] = (bf16_t)(c.x >> 16); vd[10 * 72] = (bf16_t)(c.y & 0xffff); vd[11 * 72] = (bf16_t)(c.y >> 16);
            vd[12 * 72] = (bf16_t)(c.z & 0xffff); vd[13 * 72] = (bf16_t)(c.z >> 16); vd[14 * 72] = (bf16_t)(c.w & 0xffff); vd[15 * 72] = (bf16_t)(c.w >> 16);
        }
        __syncthreads();
        f32x4 st[4];
#pragma unroll
        for (int g = 0; g < 4; ++g) { st[g] = (f32x4){0.f, 0.f, 0.f, 0.f};
#pragma unroll
            for (int ks = 0; ks < 2; ++ks) { const bf16x8 A = *(const LAS bf16x8*)(Kt + (hh * 64 + g * 16 + l16) * 72 + ks * 32 + q4 * 8); st[g] = mfma16(A, loc ? qrt[ks] : qpl[ks], st[g]); } }
        if (loc) { const int cs0 = min(max(qc - 8, 0), 48); const int drow = kr - r + 7;
#pragma unroll
            for (int g = 0; g < 4; ++g)
#pragma unroll
                for (int j = 0; j < 4; ++j) { const int kc = g * 16 + q4 * 4 + j; const int dcol = min(max(kc - qc, -15), 15) + 15;
                    const float sv = st[g][j] + rpbL[hh * 480 + drow * 31 + dcol]; st[g][j] = (kc < cs0 || kc >= cs0 + 16) ? -1e30f : sv; } }
        float tmax = -1e30f;
#pragma unroll
        for (int g = 0; g < 4; ++g)
#pragma unroll
            for (int j = 0; j < 4; ++j) tmax = fmaxf(tmax, st[g][j]);
        tmax = fmaxf(tmax, __shfl_xor(tmax, 16)); tmax = fmaxf(tmax, __shfl_xor(tmax, 32));
        const float mnew = fmaxf(mrun, tmax); const float alpha = __expf(mrun - mnew); mrun = mnew;
        float psum = 0.f;
#pragma unroll
        for (int g = 0; g < 4; ++g)
#pragma unroll
            for (int j = 0; j < 4; ++j) { const float pv = __expf(st[g][j] - mnew); st[g][j] = pv; psum += pv; }
        lsum = lsum * alpha + psum;
#pragma unroll
        for (int i = 0; i < 4; ++i) O[i] *= alpha;
        bf16x8 pb[2];
#pragma unroll
        for (int ks = 0; ks < 2; ++ks) { u32x4 wv; wv.x = pack2(st[2 * ks][0], st[2 * ks][1]); wv.y = pack2(st[2 * ks][2], st[2 * ks][3]); wv.z = pack2(st[2 * ks + 1][0], st[2 * ks + 1][1]); wv.w = pack2(st[2 * ks + 1][2], st[2 * ks + 1][3]); pb[ks] = as_bf16x8(wv); }
#pragma unroll
        for (int dg = 0; dg < 4; ++dg)
#pragma unroll
            for (int ks = 0; ks < 2; ++ks) { const LAS bf16_t* vr = Vt + (hh * 64 + dg * 16 + l16) * 72 + ks * 32 + q4 * 4;
                const u32x2 lo = *(const LAS u32x2*)vr, hi = *(const LAS u32x2*)(vr + 16); u32x4 av; av.x = lo.x; av.y = lo.y; av.z = hi.x; av.w = hi.y;
                O[dg] = mfma16(as_bf16x8(av), pb[ks], O[dg]); }
        __syncthreads();
    }
    }
    lsum += __shfl_xor(lsum, 16); lsum += __shfl_xor(lsum, 32);
    const float inv = 1.0f / lsum;
    bf16_t* op = dry ? ((bf16_t*)(PF(ws) + WS_DUMMY) + (size_t)blockIdx.x * 4096 + (w * 16 + l16) * 64) : (P + qrow * PW + C_CQ + h * 64);
#pragma unroll
    for (int dg = 0; dg < 4; ++dg) { u32x2 wv; wv.x = pack2(O[dg][0] * inv, O[dg][1] * inv); wv.y = pack2(O[dg][2] * inv, O[dg][3] * inv); *(u32x2*)(op + dg * 16 + q4 * 4) = wv; }
    __syncthreads();
}

__device__ __forceinline__ void hgrn_chain(const Params& p, int l, LAS unsigned char* lds, int chain, int dry = 0) {
    LAS bf16_t* QV = (LAS bf16_t*)lds;
    LAS bf16_t* KE = (LAS bf16_t*)(lds + 43520);
    LAS bf16_t* KB = (LAS bf16_t*)(lds + 60928);
    LAS bf16_t* SB = (LAS bf16_t*)(lds + 43520);
    LAS bf16_t* KDT = (LAS bf16_t*)(lds + 78336);
    LAS bf16_t* VT = (LAS bf16_t*)(lds + 96768);
    LAS bf16_t* ATT = (LAS bf16_t*)(lds + 115200);
    LAS float* TOT = (LAS float*)(lds + 124416);
    LAS float* DD = (LAS float*)(lds + 126464);
    bf16_t* P = (bf16_t*)(PF(ws) + WS_P);
    const int tid = tid_(), w = tid >> 6, lane = tid & 63, l16 = lane & 15, q4 = lane >> 4;
    const int dir = chain & 1, h = (chain >> 1) & 3, b = chain >> 3;
    const int d = tid & 127, sb = tid >> 7;
    float lbv = 0.f;
    if (l > 0) { const float x0 = PF(hg_lb)[(dir * 2 + 0) * 512 + h * 128 + d], x1 = PF(hg_lb)[(dir * 2 + 1) * 512 + h * 128 + d]; lbv = 1.0f / (1.0f + expf(x0 - x1)); }
    for (int i = tid; i < 64 * 72 / 2; i += 512) ((LAS unsigned*)ATT)[i] = 0u;
    f32x4 S[8];
#pragma unroll
    for (int i = 0; i < 8; ++i) S[i] = (f32x4){0.f, 0.f, 0.f, 0.f};
    __syncthreads();
    for (int ci = 0; ci < 36; ++ci) {
        const int gch = dir == 0 ? ci : (ci < 4 ? 3 - ci : 39 - ci);
        const bool isctx = gch < 4; const int chunk = isctx ? gch : gch - 4;
        const size_t row0 = isctx ? (size_t)NLAT + b * CTXL + chunk * 64 : (size_t)b * SEQ + chunk * 64;
        float bl[16], qv[16], kv[16]; float run = 0.f;
        {
            unsigned vraw[16];
#pragma unroll
            for (int ii = 0; ii < 16; ++ii) { const int t = sb * 16 + ii; const bf16_t* rp = P + (row0 + (dir ? 63 - t : t)) * PW;
                const float fr = bf2f(rp[C_BF + dir * 512 + h * 128 + d]), qr = bf2f(rp[C_BQ + h * 128 + d]); vraw[ii] = rp[C_BI + h * 128 + d];
                const float sg = 1.0f / (1.0f + __expf(-fr)); const float f = lbv + (1.0f - lbv) * sg; run += __logf(f); bl[ii] = run; kv[ii] = 1.0f - f; qv[ii] = qr / (1.0f + __expf(-qr)); }
            TOT[sb * 128 + d] = run;
            u32x4 v0, v1; v0.x = vraw[0] | (vraw[1] << 16); v0.y = vraw[2] | (vraw[3] << 16); v0.z = vraw[4] | (vraw[5] << 16); v0.w = vraw[6] | (vraw[7] << 16);
            v1.x = vraw[8] | (vraw[9] << 16); v1.y = vraw[10] | (vraw[11] << 16); v1.z = vraw[12] | (vraw[13] << 16); v1.w = vraw[14] | (vraw[15] << 16);
            *(LAS u32x4*)(VT + d * 72 + sb * 16) = v0; *(LAS u32x4*)(VT + d * 72 + sb * 16 + 8) = v1;
        }
        __syncthreads();
        {
            const float t0 = TOT[d], t1 = TOT[128 + d], t2 = TOT[256 + d], t3 = TOT[384 + d];
            const float Bs1 = t0, Bs2 = t0 + t1, Bs3 = Bs2 + t2, total = Bs3 + t3;
            const float Bsb = sb == 0 ? 0.f : (sb == 1 ? Bs1 : (sb == 2 ? Bs2 : Bs3));
            float e0[16];
#pragma unroll
            for (int ii = 0; ii < 16; ++ii) e0[ii] = __expf(bl[ii]);
#pragma unroll
            for (int r = 0; r < 4; ++r) if (r <= sb) { const float Bsr = r == 0 ? 0.f : (r == 1 ? Bs1 : (r == 2 ? Bs2 : Bs3)); const float F = __expf(Bsb - Bsr); const int base = (sb * (sb + 1) / 2 + r) * 16;
#pragma unroll
                for (int ii = 0; ii < 16; ++ii) QV[(base + ii) * 136 + d] = (bf16_t)f2bf(qv[ii] * e0[ii] * F); }
            const float Fd = __expf(total - Bsb - run);
            float kd[16];
#pragma unroll
            for (int ii = 0; ii < 16; ++ii) { const float ke = kv[ii] * __expf(run - bl[ii]); KE[(sb * 16 + ii) * 136 + d] = (bf16_t)f2bf(ke); KB[(sb * 16 + ii) * 136 + d] = (bf16_t)f2bf(kv[ii] * __expf(fminf(-bl[ii], 80.f))); kd[ii] = ke * Fd; }
            *(LAS u32x4*)(KDT + d * 72 + sb * 16) = pack8(kd); *(LAS u32x4*)(KDT + d * 72 + sb * 16 + 8) = pack8(kd + 8);
            if (sb == 0) DD[d] = __expf(total);
        }
        __syncthreads();
        f32x4 sc[2]; int bi[2], bj[2];
#pragma unroll
        for (int k2 = 0; k2 < 2; ++k2) { const int idx = w + 8 * k2; sc[k2] = (f32x4){0.f, 0.f, 0.f, 0.f};
            const int i = idx < 1 ? 0 : (idx < 3 ? 1 : (idx < 6 ? 2 : 3)); const int j = idx - i * (i + 1) / 2; bi[k2] = i; bj[k2] = j;
            if (idx < 10) { const int r = (j < i) ? j + 1 : i; const LAS bf16_t* qb = QV + ((i * (i + 1) / 2 + r) * 16 + l16) * 136 + q4 * 8; const LAS bf16_t* kb = ((j < i) ? KE : KB) + (j * 16 + l16) * 136 + q4 * 8;
#pragma unroll
                for (int ks = 0; ks < 4; ++ks) sc[k2] = mfma16(*(const LAS bf16x8*)(qb + ks * 32), *(const LAS bf16x8*)(kb + ks * 32), sc[k2]);
                if (i == j) {
#pragma unroll
                    for (int jj = 0; jj < 4; ++jj) if (l16 > q4 * 4 + jj) sc[k2][jj] = 0.f; } } }
        __syncthreads();
#pragma unroll
        for (int k2 = 0; k2 < 2; ++k2) if (w + 8 * k2 < 10) {
#pragma unroll
            for (int jj = 0; jj < 4; ++jj) ATT[(bi[k2] * 16 + q4 * 4 + jj) * 72 + bj[k2] * 16 + l16] = (bf16_t)f2bf(sc[k2][jj]); }
#pragma unroll
        for (int eg = 0; eg < 8; ++eg) { u32x2 wv; wv.x = pack2(S[eg][0], S[eg][1]); wv.y = pack2(S[eg][2], S[eg][3]); *(LAS u32x2*)(SB + (eg * 16 + l16) * 136 + w * 16 + q4 * 4) = wv; }
        __syncthreads();
        {
            bf16x8 SBf[4], VTf[2];
#pragma unroll
            for (int ks = 0; ks < 4; ++ks) SBf[ks] = *(const LAS bf16x8*)(SB + (w * 16 + l16) * 136 + ks * 32 + q4 * 8);
#pragma unroll
            for (int ks = 0; ks < 2; ++ks) VTf[ks] = *(const LAS bf16x8*)(VT + (w * 16 + l16) * 72 + ks * 32 + q4 * 8);
#pragma unroll
            for (int i = 0; i < 4; ++i) { f32x4 oa = (f32x4){0.f, 0.f, 0.f, 0.f};
#pragma unroll
                for (int ks = 0; ks < 4; ++ks) if (!(DBG_HG & 4)) oa = mfma16(SBf[ks], *(const LAS bf16x8*)(QV + ((i * (i + 1) / 2) * 16 + l16) * 136 + ks * 32 + q4 * 8), oa);
#pragma unroll
                for (int ks = 0; ks < 2; ++ks) if (!(DBG_HG & 2)) oa = mfma16(VTf[ks], *(const LAS bf16x8*)(ATT + (i * 16 + l16) * 72 + ks * 32 + q4 * 8), oa);
                const int t = i * 16 + l16; u32x2 wv; wv.x = pack2(oa[0], oa[1]); wv.y = pack2(oa[2], oa[3]);
                bf16_t* od = dry ? ((bf16_t*)(PF(ws) + WS_DUMMY) + (size_t)chain * 8192 + t * 128 + w * 16 + q4 * 4) : (P + (row0 + (dir ? 63 - t : t)) * PW + C_BF + dir * 512 + h * 128 + w * 16 + q4 * 4);
                *(u32x2*)od = wv; }
        }
        {
            const f32x4 dd = *(const LAS f32x4*)(DD + w * 16 + q4 * 4);
#pragma unroll
            for (int eg = 0; eg < 8; ++eg) S[eg] *= dd;
#pragma unroll
            for (int ks = 0; ks < 2; ++ks) { const bf16x8 A = *(const LAS bf16x8*)(KDT + (w * 16 + l16) * 72 + ks * 32 + q4 * 8);
#pragma unroll
                for (int eg = 0; eg < 8; ++eg) S[eg] = mfma16(A, *(const LAS bf16x8*)(VT + (eg * 16 + l16) * 72 + ks * 32 + q4 * 8), S[eg]); }
        }
        __syncthreads();
    }
}


__device__ __forceinline__ void dbg_dump() {
    const bf16_t* P = (const bf16_t*)(PF(ws) + WS_P); const bf16_t* U = (const bf16_t*)(PF(ws) + WS_U); const float* AGG = (const float*)(PF(ws) + WS_AGG); float* out = PF(out);
    const size_t n = (size_t)NLAT * DM;
    for (size_t i = (size_t)blockIdx.x * 512 + threadIdx.x; i < n; i += (size_t)gridDim.x * 512) {
        float s = 0.f;
#pragma unroll
        for (int k = 0; k < 5; ++k) s += bf2f(P[i + k * n]);
        s += bf2f(P[(i % ((size_t)NTOK * PW - 5 * n)) + 5 * n]);
        s += bf2f(U[i]) + bf2f(U[(i % ((size_t)NCTX * DM)) + n]);
        s += AGG[i % ((size_t)NB * 36 * 2 * 2 * 512)];
        if (!(s == s)) s = 7777.f; if (fabsf(s) > 1e30f) s = 8888.f; out[i] = s + 1000.0f;
    }
}
#ifndef STAGE_STOP
#define STAGE_STOP 0
#define DBG_SKIP 0
#define STAGE_L 0
#endif
__global__ void __launch_bounds__(512, 2) fwd_megakernel(Params p) {
    extern __shared__ __attribute__((aligned(16))) unsigned char lds_raw[];
    LAS unsigned char* lds = (LAS unsigned char*)lds_raw;
    cg::grid_group grid = cg::this_grid();
    volatile LAS unsigned* xst = (volatile LAS unsigned*)(lds + 131072);
    if (threadIdx.x == 0) { xst[0] = 0u; xst[1] = 0u; xst[2] = 0u; xst[3] = 0u; }
    __syncthreads();
    const XcdBarrier xbar = xcd_barrier_post((unsigned*)(PF(ws) + WS_BAR), xst);
    const int G = gridDim.x, c = blockIdx.x;

    phase_mod(p, lds); __syncthreads();
    phase_rope(p);
    phase_convert(p, 0, lds);
    grid.sync();
#define WSP(T, off) ((T*)(PF(ws) + (off)))
    for (int l = 0; l < 2; ++l) {
        const bool lastl = (l == 1);
        const int Mrest = lastl ? NLAT : NTOK;
        if (l > 0) phase_convert(p, l, lds);
        phase_norm(p, l, l == 0 ? PF(x) : PF(out), l == 0 ? PF(ctx) : WSP(const float, WS_HC), PF(norm1_g) + l * DM, 0, NTOK);
        xcd_barrier(xbar);
        { pg8::Gemm g{WSP(bf16_t, WS_U), WSP(bf16_t, WS_WIN), DM, DM, DM}; pg8::Sched S; S.init(NTOK, PW, G, c, DM, DM); pg8::EpiStore<0> E{WSP(bf16_t, WS_P), PW}; pg8::gemm_phase(lds, g, S, E); }
        xcd_barrier(xbar);
#if EXPERIMENT == 1
        if (c < 64) hgrn_chain(p, l, lds, c, 1);
        xcd_barrier(xbar);
#elif EXPERIMENT == 2
        if (c >= 64) { const int cc = c - 64, GG = G - 64; const int nA = lastl ? 1024 : 1152;
            for (int it = cc; it < nA; it += GG) attn_item(p, l, lds, it, 1); }
        xcd_barrier(xbar);
#elif EXPERIMENT == 3
        if (c >= 64) { const int cc = c - 64, GG = G - 64; int staged = -1;
            for (int it = cc; it < 2304; it += GG) lru_tile(p, l, lds, it, 0, staged); }
        xcd_barrier(xbar);
#elif EXPERIMENT == 5
        for (int q = 0; q < 10; ++q) xcd_barrier(xbar);
#elif EXPERIMENT == 6
        phase_convert(p, l, lds);
        xcd_barrier(xbar);
#elif EXPERIMENT == 7
        phase_norm(p, l, PF(out), WSP(const float, WS_HC), PF(norm2_g) + l * DM, 3072, NTOK);
        xcd_barrier(xbar);
#elif EXPERIMENT == 4
        { pg8::Gemm g{WSP(bf16_t, WS_U), WSP(bf16_t, WS_WIN), DM, DM, DM}; pg8::Sched S; S.init(NTOK, PW, G, c, DM, DM); pg8::EpiStore<0> E{WSP(bf16_t, WS_P), PW}; pg8::gemm_phase(lds, g, S, E); }
        xcd_barrier(xbar);
#endif
        if (c < 64) { if (!(DBG_SKIP & 1)) hgrn_chain(p, l, lds, c); }
        else { const int cc = c - 64, GG = G - 64; const int nA = lastl ? 1024 : 1152;
            if (!(DBG_SKIP & 2)) for (int it = cc; it < nA; it += GG) attn_item(p, l, lds, it);
            int staged = -1;
            if (!(DBG_SKIP & 4)) for (int it = cc; it < 2304; it += GG) lru_tile(p, l, lds, it, 0, staged); }
        xcd_barrier(xbar);
        { int staged = -1; for (int it = c; it < 2304; it += G) lru_tile(p, l, lds, it, 1, staged); }
        phase_hg_final(p, l, NTOK);
        xcd_barrier(xbar);
        { pg8::Gemm g{WSP(bf16_t, WS_U), WSP(bf16_t, WS_WIN) + (size_t)PW * DM, DM, DM, DM}; pg8::Sched S; S.init(Mrest, 3072, G, c, DM, DM); pg8::EpiStore<1> E{WSP(bf16_t, WS_P), PW}; pg8::gemm_phase(lds, g, S, E); }
        xcd_barrier(xbar);
        for (int n = 0; n < 3; ++n) {
          const int ycol = n == 0 ? C_AG : (n == 1 ? C_BO : C_CQ);
          pg8::Gemm g{WSP(bf16_t, WS_P) + ycol, WSP(bf16_t, WS_WB) + (size_t)n * DM * 512, PW, 512, 512}; pg8::Sched S; S.init(Mrest, DM, G, c, PW, 512);
          pg8::EpiMerge E{WSP(bf16_t, WS_P), WSP(bf16_t, WS_U), n}; pg8::gemm_phase(lds, g, S, E); __syncthreads(); }
        xcd_barrier(xbar);
        { pg8::Gemm g{WSP(bf16_t, WS_U), WSP(bf16_t, WS_WO), DM, DM, DM}; pg8::Sched S; S.init(Mrest, DM, G, c, DM, DM);
          pg8::EpiResid E{l == 0 ? PF(x) : PF(out), l == 0 ? PF(ctx) : WSP(const float, WS_HC), PF(out), WSP(float, WS_HC), WSP(const float, WS_MOD) + (size_t)l * 9 * 6144 + 2048}; pg8::gemm_phase(lds, g, S, E); }
        xcd_barrier(xbar);
        phase_norm(p, l, PF(out), WSP(const float, WS_HC), PF(norm2_g) + l * DM, 3072, Mrest);
        xcd_barrier(xbar);
        { pg8::Gemm g{WSP(bf16_t, WS_U), WSP(bf16_t, WS_W1), DM, DM, DM}; pg8::Sched S; S.init(Mrest, DFF, G, c, DM, DM); pg8::EpiStore<2> E{WSP(bf16_t, WS_P), DFF}; pg8::gemm_phase(lds, g, S, E); }
        xcd_barrier(xbar);
        { pg8::Gemm g{WSP(bf16_t, WS_P), WSP(bf16_t, WS_W2), DFF, DFF, DFF}; pg8::Sched S; S.init(Mrest, DM, G, c, DFF, DFF);
          pg8::EpiResid E{PF(out), WSP(const float, WS_HC), PF(out), WSP(float, WS_HC), WSP(const float, WS_MOD) + (size_t)l * 9 * 6144 + 5120}; pg8::gemm_phase(lds, g, S, E); }
        if (!lastl) xcd_barrier(xbar);
    }
}

extern "C" void kernel_launch(void* const* d_in, const int* in_sizes, int n_in, void* d_out, int out_size, void* d_ws, size_t ws_size, hipStream_t stream) {
    static int grid_blocks = 0;
    if (grid_blocks == 0) {
        int dev = 0, cus = 0, per_cu = 0;
        hipGetDevice(&dev);
        hipDeviceGetAttribute(&cus, hipDeviceAttributeMultiprocessorCount, dev);
        hipFuncSetAttribute((const void*)fwd_megakernel, hipFuncAttributeMaxDynamicSharedMemorySize, LDS_BYTES);
        hipOccupancyMaxActiveBlocksPerMultiprocessor(&per_cu, (const void*)fwd_megakernel, 512, LDS_BYTES);
        if (per_cu < 1 || n_in != 25 || ws_size < WS_END) { fprintf(stderr, "kernel_launch: cannot launch (per_cu %d, n_in %d, ws %zu need %zu)\n", per_cu, n_in, ws_size, (size_t)WS_END); grid_blocks = -1; }
        else grid_blocks = cus;
    }
    if (grid_blocks < 0) return;
    hipMemsetAsync((char*)d_ws + WS_BAR, 0, 16384, stream);
    Params p{};
    const float** pp = (const float**)&p;
    for (int i = 0; i < 25; ++i) pp[i] = (const float*)d_in[i];
    p.out = (float*)d_out; p.ws = (unsigned char*)d_ws;
    void* args[] = {&p};
    hipError_t e = hipLaunchCooperativeKernel((const void*)fwd_megakernel, dim3(grid_blocks), dim3(512), args, LDS_BYTES, stream);
    if (e != hipSuccess) fprintf(stderr, "cooperative launch failed: %s (grid %d)\n", hipGetErrorString(e), grid_blocks);
}
```

```cpp
#include <hip/hip_runtime.h>
#include <hip/hip_cooperative_groups.h>
#include <stdint.h>
#include <stdio.h>
namespace cg = cooperative_groups;

#define DBG_HG 0
#define EXPERIMENT 0
#define LAS __attribute__((address_space(3)))
typedef unsigned short bf16_t;
typedef short bf16x8 __attribute__((ext_vector_type(8)));
typedef float f32x4 __attribute__((ext_vector_type(4)));
typedef unsigned u32x4 __attribute__((ext_vector_type(4)));
typedef unsigned u32x2 __attribute__((ext_vector_type(2)));

constexpr int DM = 1024, NB = 8, SEQ = 2048, CTXL = 256, NLAT = NB * SEQ, NCTX = NB * CTXL, NTOK = NLAT + NCTX;
constexpr int PW = 5120, DIN = 8192, DFF = 4096;
constexpr int C_AX = 0, C_AG = 512, C_BQ = 1024, C_BF = 1536, C_BI = 2560, C_BO = 3072, C_CQ = 3584, C_CK = 4096, C_CV = 4608;
constexpr int LDS_BYTES = 163840;
constexpr size_t WS_WIN = 0;
constexpr size_t WS_WB = WS_WIN + (size_t)DIN * DM * 2;
constexpr size_t WS_WO = WS_WB + (size_t)3 * DM * 512 * 2;
constexpr size_t WS_W1 = WS_WO + (size_t)DM * DM * 2;
constexpr size_t WS_W2 = WS_W1 + (size_t)DFF * DM * 2;
constexpr size_t WS_U = WS_W2 + (size_t)DM * DFF * 2;
constexpr size_t WS_P = WS_U + (size_t)NTOK * DM * 2;
constexpr size_t WS_HC = WS_P + (size_t)NTOK * PW * 2;
constexpr size_t WS_MOD = WS_HC + (size_t)NCTX * DM * 4;
constexpr size_t WS_AGG = WS_MOD + (size_t)2 * 9 * 6144 * 4;
constexpr size_t WS_ROPE = WS_AGG + (size_t)NB * 36 * 2 * 2 * 512 * 4;
constexpr size_t WS_DUMMY = WS_ROPE + 2048 * 4;
constexpr size_t WS_BAR = WS_DUMMY + (2u << 20);
constexpr size_t WS_END = WS_BAR + 16384;

struct Params {
    const float *x, *c, *ctx, *c_ctx, *ada_w, *ada_b, *norm1_g, *norm2_g, *w_in, *conv_w, *conv_b, *lru_wa, *lru_ba, *lru_wx, *lru_bx, *lru_lambda,
        *hg_lb, *hg_norm_g, *na_qg, *na_kg, *na_rpb, *w_branch, *w_out, *ffn_w1, *ffn_w2;
    float* out; unsigned char* ws;
};


__device__ __forceinline__ unsigned long long ldkarg(int off) { unsigned long long v = 0;
#if defined(__HIP_DEVICE_COMPILE__)
    auto kp = __builtin_amdgcn_kernarg_segment_ptr();
    asm volatile("s_load_dwordx2 %0, %1, %2\n\ts_waitcnt lgkmcnt(0)" : "=s"(v) : "s"(kp), "s"(off));
#endif
    return v; }
#define PF(f) ((decltype(Params::f))ldkarg((int)__builtin_offsetof(Params, f)))

template <class T> __device__ __forceinline__ T* lnd(T* p) { asm volatile("" : "+v"(p)); return p; }
__device__ __forceinline__ int tid_() { int t = threadIdx.x; asm volatile("" : "+v"(t)); return t; }
__device__ __forceinline__ float bf2f(unsigned v) { return __uint_as_float(v << 16); }
__device__ __forceinline__ float bflo(unsigned w) { return __uint_as_float(w << 16); }
__device__ __forceinline__ float bfhi(unsigned w) { return __uint_as_float(w & 0xffff0000u); }
__device__ __forceinline__ unsigned f2bf(float f) { unsigned u = __float_as_uint(f); u += 0x7fffu + ((u >> 16) & 1u); return u >> 16; }
typedef __bf16 bf16x2_t __attribute__((ext_vector_type(2)));
typedef float f32x2_t __attribute__((ext_vector_type(2)));
__device__ __forceinline__ unsigned pack2(float lo, float hi) { f32x2_t v = {lo, hi}; bf16x2_t b = __builtin_convertvector(v, bf16x2_t); union { bf16x2_t b; unsigned u; } t; t.b = b; return t.u; }
__device__ __forceinline__ float sigmoidf_(float x) { return 1.0f / (1.0f + __expf(-x)); }
__device__ __forceinline__ f32x4 mfma16(bf16x8 a, bf16x8 b, f32x4 c) { return __builtin_amdgcn_mfma_f32_16x16x32_bf16(a, b, c, 0, 0, 0); }
__device__ __forceinline__ bf16x8 as_bf16x8(u32x4 v) { union { u32x4 u; bf16x8 b; } t; t.u = v; return t.b; }
__device__ __forceinline__ void unpack8(u32x4 w, float* o) { o[0] = bflo(w.x); o[1] = bfhi(w.x); o[2] = bflo(w.y); o[3] = bfhi(w.y); o[4] = bflo(w.z); o[5] = bfhi(w.z); o[6] = bflo(w.w); o[7] = bfhi(w.w); }
__device__ __forceinline__ u32x4 pack8(const float* v) { u32x4 w; w.x = pack2(v[0], v[1]); w.y = pack2(v[2], v[3]); w.z = pack2(v[4], v[5]); w.w = pack2(v[6], v[7]); return w; }

namespace pg8 {
constexpr int BM = 256, BK = 64, HALF = 128, HTB = HALF * BK * 2, NXCD = 8, WGM = 8;
__device__ __forceinline__ int lds_byte(int r, int c) { const int st = (r >> 4) * 2 + (c >> 5), rr = r & 15, cc = c & 31, ob = rr * 64 + cc * 2; return st * 1024 + (ob ^ (((ob >> 9) & 1) << 5)); }
__device__ __forceinline__ void stage_rc(int b, int& R, int& C) { const int st = b / 1024, sb = b % 1024, swz = sb ^ (((sb >> 9) & 1) << 5); R = (st >> 1) * 16 + swz / 64; C = (st & 1) * 32 + (swz % 64) / 2; }
__device__ __forceinline__ int perm32(int rho) { const int n = rho >> 4, i = rho & 15; return 8 * (i >> 2) + 4 * n + (i & 3); }

struct Unit { int pm, pn, sub, nt; size_t aoff, boff; };
struct Gemm { const bf16_t* A; const bf16_t* Bt; int lda, ldb, K; };
struct Sched {
    int nM, nN, nwg, G, c, lda, ldb, nt;
    __device__ void init(int M, int N, int G_, int c_, int lda_, int ldb_) { nM = M / BM; nN = N / BM; nwg = nM * nN; G = G_; c = c_; lda = lda_; ldb = ldb_; nt = 0; }
    __device__ bool next(int i, Unit& u) const {
        const long L = (long)i * G + c; if (L >= nwg) return false;
        int wgid = (int)L; { const int q = nwg / NXCD, r = nwg % NXCD, xcd = wgid % NXCD, off = wgid / NXCD; wgid = (xcd < r ? xcd * (q + 1) : r * (q + 1) + (xcd - r) * q) + off; }
        const int nig = WGM * nN, gid = wgid / nig, fm = gid * WGM, gsz = (nM - fm) < WGM ? (nM - fm) : WGM;
        u.pm = fm + ((wgid % nig) % gsz); u.pn = (wgid % nig) / gsz; u.sub = 0; u.nt = nt;
        u.aoff = (size_t)u.pm * BM * lda * 2;
        u.boff = (size_t)u.pn * BM * ldb * 2;
        return true;
    }
};

template <int ACT> struct EpiStore {
    static constexpr bool PERM = true;
    bf16_t* O; int ldc;
    __device__ __forceinline__ void operator()(const f32x4 (&acc)[2][2][4][2], const Unit& u, int wr, int wc, int fr, int fq) const {
        const int row0 = u.pm * BM + wr * 64 + fr; int colt = u.pn * BM;
        if (ACT == 1) colt = (colt < 2048) ? (1024 + colt) : (2048 + colt);
        const int col0 = colt + wc * 32 + 8 * fq;
#pragma unroll
        for (int ai = 0; ai < 2; ++ai)
#pragma unroll
            for (int m = 0; m < 4; ++m) { bf16_t* rowp = lnd(O + (size_t)(row0 + ai * HALF + m * 16) * ldc + col0);
#pragma unroll
                for (int bj = 0; bj < 2; ++bj) { f32x4 v0 = acc[ai][bj][m][0], v1 = acc[ai][bj][m][1];
                    if (ACT == 1) {
#pragma unroll
                        for (int j = 0; j < 4; ++j) { v0[j] = sigmoidf_(v0[j]); v1[j] = sigmoidf_(v1[j]); } }
                    if (ACT == 2) {
#pragma unroll
                        for (int j = 0; j < 4; ++j) { float a = fmaxf(v0[j], 0.f), b = fmaxf(v1[j], 0.f); v0[j] = a * a; v1[j] = b * b; } }
                    u32x4 w; w.x = pack2(v0[0], v0[1]); w.y = pack2(v0[2], v0[3]); w.z = pack2(v1[0], v1[1]); w.w = pack2(v1[2], v1[3]);
                    *(u32x4*)(rowp + bj * HALF) = w; } }
    }
};
struct EpiMerge {
    static constexpr bool PERM = true;
    const bf16_t* P; bf16_t* U;
    __device__ __forceinline__ void operator()(const f32x4 (&acc)[2][2][4][2], const Unit& u, int wr, int wc, int fr, int fq) const {
        const int row0 = u.pm * BM + wr * 64 + fr; const int col0 = u.pn * BM + wc * 32 + 8 * fq;
        const int sub = u.sub; const int gcol = sub * 1024 + u.pn * BM; const int gd = ((gcol < 2048) ? (1024 + gcol) : (2048 + gcol)) + wc * 32 + 8 * fq;
        const bool addp = sub > 0;
#pragma unroll
        for (int ai = 0; ai < 2; ++ai)
#pragma unroll
            for (int m = 0; m < 4; ++m) { const size_t row = (size_t)(row0 + ai * HALF + m * 16); const bf16_t* gp = lnd(P + row * PW + gd); bf16_t* up = lnd(U + row * DM + col0);
#pragma unroll
                for (int bj = 0; bj < 2; ++bj)
#pragma unroll
                    for (int n = 0; n < 2; ++n) { const u32x2 gw = *(const u32x2*)(gp + bj * HALF + 4 * n);
                        float v0 = acc[ai][bj][m][n][0] * bflo(gw.x), v1 = acc[ai][bj][m][n][1] * bfhi(gw.x), v2 = acc[ai][bj][m][n][2] * bflo(gw.y), v3 = acc[ai][bj][m][n][3] * bfhi(gw.y);
                        if (addp) { const u32x2 pw = *(const u32x2*)(up + bj * HALF + 4 * n); v0 += bflo(pw.x); v1 += bfhi(pw.x); v2 += bflo(pw.y); v3 += bfhi(pw.y); }
                        u32x2 o; o.x = pack2(v0, v1); o.y = pack2(v2, v3); *(u32x2*)(up + bj * HALF + 4 * n) = o; } }
    }
};
struct EpiResid {
    static constexpr bool PERM = true;
    const float* inL; const float* inC; float* outL; float* outC; const float* mod;
    float* slab;
    __device__ __forceinline__ void operator()(const f32x4 (&acc)[2][2][4][2], const Unit& u, int wr, int wc, int fr, int fq) const {
        if (u.sub >= 1) {
            const int row0 = (u.pm - 64) * BM + wr * 64 + fr, col0 = u.pn * BM + wc * 32 + 8 * fq; float* sl = slab + (size_t)(u.sub - 1) * NCTX * DM;
#pragma unroll
            for (int ai = 0; ai < 2; ++ai)
#pragma unroll
                for (int m = 0; m < 4; ++m)
#pragma unroll
                    for (int bj = 0; bj < 2; ++bj) { float* op = lnd(sl + (size_t)(row0 + ai * HALF + m * 16) * DM + col0 + bj * HALF); *(f32x4*)op = acc[ai][bj][m][0]; *(f32x4*)(op + 4) = acc[ai][bj][m][1]; }
            return;
        }
        const bool lat = u.pm < 64; const int rbase = lat ? u.pm * BM : (u.pm - 64) * BM;
        const float* in = lat ? inL : inC; float* out = lat ? outL : outC;
        const int row0 = rbase + wr * 64 + fr, col0 = u.pn * BM + wc * 32 + 8 * fq;
        const float* gt = mod + (size_t)(lat ? (u.pm >> 3) : 8) * 6144 + col0;
#pragma unroll
        for (int bj = 0; bj < 2; ++bj) { const f32x4 g0 = *(const f32x4*)(gt + bj * HALF), g1 = *(const f32x4*)(gt + bj * HALF + 4);
#pragma unroll
            for (int ai = 0; ai < 2; ++ai)
#pragma unroll
                for (int m = 0; m < 4; ++m) { const size_t ro = (size_t)(row0 + ai * HALF + m * 16) * DM + col0 + bj * HALF;
                    const float* ip = lnd(in + ro); float* op = lnd(out + ro); const f32x4 i0 = *(const f32x4*)ip, i1 = *(const f32x4*)(ip + 4);
                    *(f32x4*)op = i0 + g0 * acc[ai][bj][m][0]; *(f32x4*)(op + 4) = i1 + g1 * acc[ai][bj][m][1]; } }
    }
};

struct MergeSched {
    Sched base;
    __device__ bool next(int i, Unit& u) const {
        const int r = i / 3, n = i - 3 * r;
        if (!base.next(r, u)) return false;
        u.sub = n; u.aoff += (size_t)(n == 0 ? C_AG : C_BO + (n - 1) * 512) * 2; u.boff += (size_t)n * DM * 512 * 2;
        return true;
    }
};
struct SplitSched {
    Sched base;
    __device__ bool next(int i, Unit& u) const {
        if (base.next(i, u)) return true;
        const int nfull = (base.nwg - base.c + base.G - 1) / base.G;
        const int k = i - nfull; const int un = k * base.G + base.c; if (k < 0 || un >= 128) return false;
        const int ct = un >> 2, sl = un & 3; u.pm = 64 + (ct >> 2); u.pn = ct & 3; u.sub = 1 + sl; u.nt = 16;
        u.aoff = (size_t)u.pm * BM * base.lda * 2 + (size_t)sl * 1024 * 2; u.boff = (size_t)u.pn * BM * base.ldb * 2 + (size_t)sl * 1024 * 2;
        return true;
    }
};
template <class Epi, class Sch>
__device__ __forceinline__ void gemm_phase(LAS unsigned char* lds, const Gemm g, const Sch& S, const Epi& E) {
    const int tid = tid_(), wid = __builtin_amdgcn_readfirstlane(tid >> 6), lane = tid & 63, wr = wid >> 2, wc = wid & 3, fr = lane & 15, fq = lane >> 4;
    const int K = g.K;
    unsigned voffA[2], voffB[2];
#pragma unroll
    for (int i = 0; i < 2; ++i) { int R, C; stage_rc(tid * 16 + i * 8192, R, C); const int Rb = Epi::PERM ? ((R & ~31) + perm32(R & 31)) : R;
        voffA[i] = (unsigned)(R * g.lda + C) * 2u; voffB[i] = (unsigned)(Rb * g.ldb + C) * 2u; }
    const size_t kstep = (size_t)(BK * 2);
    const size_t hstepA = (size_t)HALF * g.lda * 2, hstepB = (size_t)HALF * g.ldb * 2;
    const unsigned ldsw = (unsigned)wid * 1024u;
    const int aoff = lds_byte(wr * 64 + fr, fq * 8), boff = lds_byte(wc * 32 + fr, fq * 8);
#define PG8_SA(b, h) (((b) * 2 + (h)) * HTB)
#define PG8_SB(b, h) ((4 + (b) * 2 + (h)) * HTB)
#define PG8_STAGE(bufoff, gbase, voff) do { _Pragma("unroll") for (int _i = 0; _i < 2; ++_i) \
        __builtin_amdgcn_global_load_lds((const unsigned*)((const char*)(gbase) + (voff)[_i]), (LAS unsigned*)(lds + (bufoff) + ldsw + _i * 8192), 16, 0, 0); } while (0)
#define PG8_LDA(dst, b, h) do { _Pragma("unroll") for (int m = 0; m < 4; ++m) _Pragma("unroll") for (int k = 0; k < 2; ++k) dst[m][k] = *(const LAS bf16x8*)(lds + PG8_SA(b, h) + aoff + m * 2048 + k * 1024); } while (0)
#define PG8_LDB(dst, b, h) do { _Pragma("unroll") for (int n = 0; n < 2; ++n) _Pragma("unroll") for (int k = 0; k < 2; ++k) dst[n][k] = *(const LAS bf16x8*)(lds + PG8_SB(b, h) + boff + n * 2048 + k * 1024); } while (0)
#define PG8_MMA(ai, bj, At, Bt) do { __builtin_amdgcn_s_setprio(1); _Pragma("unroll") for (int m = 0; m < 4; ++m) _Pragma("unroll") for (int n = 0; n < 2; ++n) _Pragma("unroll") for (int k = 0; k < 2; ++k) \
        acc[ai][bj][m][n] = __builtin_amdgcn_mfma_f32_16x16x32_bf16(Bt[n][k], At[m][k], acc[ai][bj][m][n], 0, 0, 0); __builtin_amdgcn_s_setprio(0); } while (0)
#define PG8_WAIT_V(n) asm volatile("s_waitcnt vmcnt(" #n ")" ::: "memory")
#define PG8_WAIT_L(n) asm volatile("s_waitcnt lgkmcnt(" #n ")" ::: "memory")
#define PG8_BAR __builtin_amdgcn_s_barrier()
#define PG8_SCHED __builtin_amdgcn_sched_barrier(0)
    Unit cur, nxt; int ui = 0;
    if (!S.next(0, cur)) return;
    f32x4 acc[2][2][4][2];
#pragma unroll
    for (int a = 0; a < 2; ++a)
#pragma unroll
        for (int b = 0; b < 2; ++b)
#pragma unroll
            for (int m = 0; m < 4; ++m)
#pragma unroll
                for (int n = 0; n < 2; ++n) acc[a][b][m][n] = (f32x4){0.f, 0.f, 0.f, 0.f};
    bf16x8 At[4][2], B0[2][2], B1[2][2];
    const char* cA = (const char*)g.A + cur.aoff; const char* cB = (const char*)g.Bt + cur.boff;
    PG8_STAGE(PG8_SB(0, 0), cB, voffB); PG8_STAGE(PG8_SA(0, 0), cA, voffA); PG8_STAGE(PG8_SB(0, 1), cB + hstepB, voffB); PG8_STAGE(PG8_SA(0, 1), cA + hstepA, voffA);
    if (wr == 1) PG8_BAR;
    PG8_WAIT_V(4); PG8_BAR;
    PG8_STAGE(PG8_SB(1, 0), cB + kstep, voffB); PG8_STAGE(PG8_SA(1, 0), cA + kstep, voffA); PG8_STAGE(PG8_SB(1, 1), cB + hstepB + kstep, voffB);
    PG8_WAIT_V(6); PG8_BAR;
    for (;;) {
        const bool has_next = S.next(ui + 1, nxt);
        const char* nA = has_next ? (const char*)g.A + nxt.aoff : cA; const char* nB = has_next ? (const char*)g.Bt + nxt.boff : cB;
        const int nt = cur.nt ? cur.nt : K / BK;
        for (int t = 0; t < nt; t += 2) {
            const bool last = (t == nt - 2);
            const char* a1 = cA + (size_t)(t + 1) * kstep;
            const char* a2 = last ? nA : cA + (size_t)(t + 2) * kstep; const char* b2 = last ? nB : cB + (size_t)(t + 2) * kstep;
            const char* a3 = a2 + kstep; const char* b3 = b2 + kstep;
            PG8_LDB(B0, 0, 0); PG8_SCHED; PG8_LDA(At, 0, 0); PG8_STAGE(PG8_SA(1, 1), a1 + hstepA, voffA);
            PG8_WAIT_L(8); PG8_BAR; PG8_WAIT_L(0); PG8_MMA(0, 0, At, B0); PG8_BAR; PG8_SCHED;
            PG8_LDB(B1, 0, 1); PG8_STAGE(PG8_SB(0, 0), b2, voffB);
            PG8_BAR; PG8_WAIT_L(0); PG8_MMA(0, 1, At, B1); PG8_BAR;
            PG8_LDA(At, 0, 1); PG8_STAGE(PG8_SA(0, 0), a2, voffA);
            PG8_BAR; PG8_WAIT_L(0); PG8_MMA(1, 0, At, B0); PG8_BAR; PG8_SCHED;
            PG8_STAGE(PG8_SB(0, 1), b2 + hstepB, voffB);
            PG8_WAIT_V(6); PG8_BAR; PG8_MMA(1, 1, At, B1); PG8_BAR;
            PG8_LDB(B0, 1, 0); PG8_SCHED; PG8_LDA(At, 1, 0); PG8_STAGE(PG8_SA(0, 1), a2 + hstepA, voffA);
            PG8_WAIT_L(8); PG8_BAR; PG8_WAIT_L(0); PG8_MMA(0, 0, At, B0); PG8_BAR; PG8_SCHED;
            PG8_LDB(B1, 1, 1); PG8_STAGE(PG8_SB(1, 0), b3, voffB);
            PG8_BAR; PG8_WAIT_L(0); PG8_MMA(0, 1, At, B1); PG8_BAR;
            PG8_LDA(At, 1, 1); PG8_STAGE(PG8_SA(1, 0), a3, voffA);
            PG8_BAR; PG8_WAIT_L(0); PG8_MMA(1, 0, At, B0); PG8_BAR; PG8_SCHED;
            PG8_STAGE(PG8_SB(1, 1), b3 + hstepB, voffB);
            PG8_WAIT_V(6); PG8_BAR; PG8_MMA(1, 1, At, B1); PG8_BAR;
        }
        E(acc, cur, wr, wc, fr, fq);
        if (!has_next) break;
#pragma unroll
        for (int a = 0; a < 2; ++a)
#pragma unroll
            for (int b = 0; b < 2; ++b)
#pragma unroll
                for (int m = 0; m < 4; ++m)
#pragma unroll
                    for (int n = 0; n < 2; ++n) acc[a][b][m][n] = (f32x4){0.f, 0.f, 0.f, 0.f};
        cur = nxt; cA = nA; cB = nB; ++ui;
    }
    PG8_WAIT_V(0);
    if (wr == 0) PG8_BAR;
    PG8_BAR;
#undef PG8_SA
#undef PG8_SB
#undef PG8_STAGE
#undef PG8_LDA
#undef PG8_LDB
#undef PG8_MMA
#undef PG8_WAIT_V
#undef PG8_WAIT_L
#undef PG8_BAR
#undef PG8_SCHED
}
}


#define XB_TMO      128
#define XB_XCNT(j)  (256  + 64 * (j))
#define XB_XSUB(j)  (1280 + 64 * (j))
#define XB_XGEN(j)  (2304 + 64 * (j))
#define XB_TOP      3328
#define XB_TOPGEN   3392
#define XCD_BAR_WORDS 3456
#define XB_SPIN_CAP (1u << 20)
__device__ __forceinline__ unsigned xb_ld(unsigned* p)              { return __hip_atomic_load(p, __ATOMIC_RELAXED, __HIP_MEMORY_SCOPE_AGENT); }
__device__ __forceinline__ unsigned xb_add(unsigned* p, unsigned v) { return __hip_atomic_fetch_add(p, v, __ATOMIC_RELAXED, __HIP_MEMORY_SCOPE_AGENT); }
__device__ __forceinline__ unsigned xb_xcc_id() { return (unsigned)__builtin_amdgcn_s_getreg((3 << 11) | 20) & 0xFu; }
#define XB_SPIN(cond, bar) do { unsigned _sp = 0; while (cond) { __builtin_amdgcn_s_sleep(1); \
    if ((++_sp & 255u) == 0u) { if (xb_ld(&(bar)[XB_TMO])) break; if (_sp > XB_SPIN_CAP) { atomicAdd(&(bar)[XB_TMO], 1u); break; } } } } while (0)
struct XcdBarrier { unsigned* bar; unsigned x; volatile LAS unsigned* st; };
__device__ __forceinline__ XcdBarrier xcd_barrier_post(unsigned* bar, volatile LAS unsigned* st) {
    XcdBarrier b; b.bar = bar; b.x = xb_xcc_id(); b.st = st;
    if (threadIdx.x == 0) (void)xb_add(&bar[XB_XCNT(b.x)], 1u);
    return b;
}
__device__ __forceinline__ void xcd_barrier_complete(unsigned* bar, unsigned x, unsigned& nloc, unsigned& nx) {
    const unsigned G = gridDim.x * gridDim.y * gridDim.z;
    unsigned sum, cnt, mine, sp = 0u;
    for (;;) {
        sum = 0u; cnt = 0u; mine = 0u;
#pragma unroll
        for (unsigned j = 0; j < 16; ++j) { const unsigned c = xb_ld(&bar[XB_XCNT(j)]); sum += c; cnt += (c > 0u) ? 1u : 0u; mine = (j == x) ? c : mine; }
        if (sum == G) break;
        __builtin_amdgcn_s_sleep(1);
        if ((++sp & 255u) == 0u) { if (xb_ld(&bar[XB_TMO])) break; if (sp > XB_SPIN_CAP) { atomicAdd(&bar[XB_TMO], 1u); break; } }
    }
    nloc = mine > 0u ? mine : 1u; nx = cnt > 0u ? cnt : 1u;
}
__device__ __forceinline__ void xcd_barrier(const XcdBarrier& b) {
    asm volatile("s_waitcnt vmcnt(0)" ::: "memory");
    __syncthreads();
    if (threadIdx.x == 0) {
        unsigned* bar = b.bar;
        __builtin_amdgcn_s_waitcnt(0);
        unsigned nloc = b.st[0], nx = b.st[1];
        if (nloc == 0u) { xcd_barrier_complete(bar, b.x, nloc, nx); b.st[0] = nloc; b.st[1] = nx; }
        const unsigned old = xb_add(&bar[XB_XSUB(b.x)], 1u);
        const unsigned gen = old / nloc;
        if (old + 1u == (gen + 1u) * nloc) {
            __builtin_amdgcn_fence(__ATOMIC_RELEASE, "agent");
            asm volatile("s_waitcnt vmcnt(0)" ::: "memory");
            const unsigned og = xb_add(&bar[XB_TOP], 1u);
            const unsigned tg = og / nx;
            if (og + 1u == (tg + 1u) * nx) xb_add(&bar[XB_TOPGEN], 1u);
            else XB_SPIN(xb_ld(&bar[XB_TOPGEN]) == tg, bar);
            __builtin_amdgcn_fence(__ATOMIC_ACQUIRE, "agent");
            xb_add(&bar[XB_XGEN(b.x)], 1u);
            asm volatile("s_waitcnt vmcnt(0)" ::: "memory");
        } else {
            XB_SPIN(xb_ld(&bar[XB_XGEN(b.x)]) == gen, bar);
            __builtin_amdgcn_fence(__ATOMIC_ACQUIRE, "agent");
            asm volatile("s_waitcnt vmcnt(0)" ::: "memory");
        }
    }
    __syncthreads();
}

__device__ __forceinline__ void sub_barrier(unsigned* word, unsigned n) {
    asm volatile("s_waitcnt vmcnt(0)" ::: "memory");
    __syncthreads();
    if (threadIdx.x == 0) {
        __builtin_amdgcn_fence(__ATOMIC_RELEASE, "agent");
        asm volatile("s_waitcnt vmcnt(0)" ::: "memory");
        xb_add(word, 1u);
        unsigned sp = 0;
        while (xb_ld(word) < n) { __builtin_amdgcn_s_sleep(1); if (++sp > (1u << 22)) break; }
        __builtin_amdgcn_fence(__ATOMIC_ACQUIRE, "agent");
        asm volatile("s_waitcnt vmcnt(0)" ::: "memory");
    }
    __syncthreads();
}

__device__ __forceinline__ void phase_mod(const Params& p, LAS unsigned char* lds) {
    LAS float* sc = (LAS float*)lds;
    LAS float* part = sc + 9 * 1024;
    float* mod = (float*)(PF(ws) + WS_MOD);
    const int tid = tid_(), w = tid >> 6, lane = tid & 63;
    if ((int)blockIdx.x >= 192) return;
    const float* pc = PF(c); const float* pcc = PF(c_ctx); const float* padaw = PF(ada_w); const float* padab = PF(ada_b);
    for (int i = tid; i < 9 * 1024; i += 512) { const int r = i >> 10, k = i & 1023; const float v = (r < 8) ? pc[r * 1024 + k] : pcc[k]; sc[i] = v / (1.0f + expf(-v)); }
    __syncthreads();
    for (int item = blockIdx.x; item < 192; item += gridDim.x) {
        const int l = item / 96, cb = item % 96;
        const float* W = padaw + (size_t)l * 1024 * 6144 + cb * 64 + lane;
        float acc[9];
#pragma unroll
        for (int r = 0; r < 9; ++r) acc[r] = 0.f;
        for (int k = w * 128; k < w * 128 + 128; ++k) { const float wv = W[(size_t)k * 6144];
#pragma unroll
            for (int r = 0; r < 9; ++r) acc[r] += sc[r * 1024 + k] * wv; }
#pragma unroll
        for (int r = 0; r < 9; ++r) part[(w * 9 + r) * 64 + lane] = acc[r];
        __syncthreads();
        for (int i = tid; i < 576; i += 512) { const int r = i >> 6, ln = i & 63; float s = 0.f;
#pragma unroll
            for (int ww = 0; ww < 8; ++ww) s += part[(ww * 9 + r) * 64 + ln];
            mod[(size_t)(l * 9 + r) * 6144 + cb * 64 + ln] = s + padab[l * 6144 + cb * 64 + ln]; }
        __syncthreads();
    }
}
__device__ __forceinline__ void phase_rope(const Params& p) {
    if (blockIdx.x != gridDim.x - 1) return;
    float* rope = (float*)(PF(ws) + WS_ROPE);
    for (int i = tid_(); i < 1024; i += 512) { const int pos = i >> 4, fi = i & 15; const float invf = powf(10000.0f, -(float)fi / 16.0f); const float ang = (float)pos * invf; rope[i] = cosf(ang); rope[1024 + i] = sinf(ang); }
}
__device__ __forceinline__ void convert_tile(const float* src, int K, int N, bf16_t* dst, int tile, LAS bf16_t* T) {
    const int tid = tid_(), tilesN = N >> 7, tk = tile / tilesN, tn = tile - tk * tilesN, k0 = tk * 128, n0 = tn * 128;
    const int r = tid >> 4, c8 = (tid & 15) * 8;
    f32x4 a[4], b[4];
#pragma unroll
    for (int i = 0; i < 4; ++i) { const float* s = src + (size_t)(k0 + r + 32 * i) * N + n0 + c8; a[i] = *(const f32x4*)s; b[i] = *(const f32x4*)(s + 4); }
#pragma unroll
    for (int i = 0; i < 4; ++i)
#pragma unroll
        for (int j = 0; j < 4; ++j) { T[(c8 + j) * 136 + r + 32 * i] = (bf16_t)f2bf(a[i][j]); T[(c8 + 4 + j) * 136 + r + 32 * i] = (bf16_t)f2bf(b[i][j]); }
    __syncthreads();
    const int n = tid >> 2, ks = (tid & 3) * 8;
#pragma unroll
    for (int i = 0; i < 4; ++i) { const u32x4 v = *(const LAS u32x4*)(T + n * 136 + ks + 32 * i); *(u32x4*)(dst + (size_t)(n0 + n) * K + k0 + ks + 32 * i) = v; }
    __syncthreads();
}
__device__ __forceinline__ void phase_convert(const Params& p, int l, LAS unsigned char* lds) {
    LAS bf16_t* T = (LAS bf16_t*)lds;
    bf16_t* WIN = (bf16_t*)(PF(ws) + WS_WIN); bf16_t* WB = (bf16_t*)(PF(ws) + WS_WB); bf16_t* WO = (bf16_t*)(PF(ws) + WS_WO); bf16_t* W1 = (bf16_t*)(PF(ws) + WS_W1); bf16_t* W2 = (bf16_t*)(PF(ws) + WS_W2);
    for (int it = blockIdx.x; it < 1184; it += gridDim.x) {
        if (it < 512) convert_tile(PF(w_in) + (size_t)l * DM * DIN, DM, DIN, WIN, it, T);
        else if (it < 608) { const int n = (it - 512) / 32, tl = (it - 512) % 32; convert_tile(PF(w_branch) + (size_t)(l * 3 + n) * 512 * DM, 512, DM, WB + (size_t)n * DM * 512, tl, T); }
        else if (it < 672) convert_tile(PF(w_out) + (size_t)l * DM * DM, DM, DM, WO, it - 608, T);
        else if (it < 928) convert_tile(PF(ffn_w1) + (size_t)l * DM * DFF, DM, DFF, W1, it - 672, T);
        else convert_tile(PF(ffn_w2) + (size_t)l * DFF * DM, DFF, DM, W2, it - 928, T);
    }
}
__device__ __forceinline__ void phase_norm(const Params& p, int l, const float* hlat, const float* hctx, const float* g, int modoff, int nrows, const float* slab = nullptr, const float* slabgate = nullptr) {
    const int tid = tid_(); const int w = tid >> 6, lane = tid & 63;
    bf16_t* U = (bf16_t*)(PF(ws) + WS_U); const float* mod = (const float*)(PF(ws) + WS_MOD);
    for (int row = blockIdx.x * 8 + w; row < nrows; row += gridDim.x * 8) {
        const float* src = row < NLAT ? hlat + (size_t)row * DM : hctx + (size_t)(row - NLAT) * DM;
        const int mr = row < NLAT ? (row >> 11) : 8;
        const float* md = mod + (size_t)(l * 9 + mr) * 6144 + modoff;
        f32x4 v[4]; float ss = 0.f;
#pragma unroll
        for (int i = 0; i < 4; ++i) { v[i] = *(const f32x4*)(src + i * 256 + lane * 4);
            if (slab != nullptr && row >= NLAT) { const size_t o = (size_t)(row - NLAT) * DM + i * 256 + lane * 4; const f32x4 gg = *(const f32x4*)(slabgate + i * 256 + lane * 4);
                const f32x4 s4 = (*(const f32x4*)(slab + o) + *(const f32x4*)(slab + o + (size_t)NCTX * DM)) + (*(const f32x4*)(slab + o + (size_t)2 * NCTX * DM) + *(const f32x4*)(slab + o + (size_t)3 * NCTX * DM));
                v[i] += gg * s4; }
            ss += v[i][0] * v[i][0] + v[i][1] * v[i][1] + v[i][2] * v[i][2] + v[i][3] * v[i][3]; }
#pragma unroll
        for (int o = 32; o >= 1; o >>= 1) ss += __shfl_xor(ss, o);
        const float rstd = rsqrtf(ss * (1.0f / 1024.0f) + 1e-6f);
#pragma unroll
        for (int i = 0; i < 4; ++i) { const int cidx = i * 256 + lane * 4; const f32x4 gg = *(const f32x4*)(g + cidx), sh = *(const f32x4*)(md + cidx), scv = *(const f32x4*)(md + 1024 + cidx);
            float o4[4];
#pragma unroll
            for (int j = 0; j < 4; ++j) o4[j] = (v[i][j] * rstd * gg[j]) * (1.0f + scv[j]) + sh[j];
            u32x2 wv; wv.x = pack2(o4[0], o4[1]); wv.y = pack2(o4[2], o4[3]);
            *(u32x2*)(U + (size_t)row * DM + cidx) = wv; }
    }
}
__device__ __forceinline__ void phase_hg_final(const Params& p, int l, int nrows, int wg, int nwg) {
    const int tid = tid_(); const int w = tid >> 6, lane = tid & 63; bf16_t* P = (bf16_t*)(PF(ws) + WS_P);
    const int hd = lane >> 4, e8 = (lane & 15) * 8; const float* png = PF(hg_norm_g);
    float ng[8];
#pragma unroll
    for (int i = 0; i < 8; ++i) ng[i] = png[l * 128 + e8 + i];
    for (int row = wg * 8 + w; row < nrows; row += nwg * 8) {
        bf16_t* rp = P + (size_t)row * PW;
        float a[8], b[8], og[8]; unpack8(*(const u32x4*)(rp + C_BF + hd * 128 + e8), a); unpack8(*(const u32x4*)(rp + C_BF + 512 + hd * 128 + e8), b); unpack8(*(const u32x4*)(rp + C_BO + hd * 128 + e8), og);
        float ss = 0.f;
#pragma unroll
        for (int i = 0; i < 8; ++i) { a[i] += b[i]; ss += a[i] * a[i]; }
        ss += __shfl_xor(ss, 1); ss += __shfl_xor(ss, 2); ss += __shfl_xor(ss, 4); ss += __shfl_xor(ss, 8);
        const float rstd = rsqrtf(ss * (1.0f / 128.0f) + 1e-6f);
        float y[8];
#pragma unroll
        for (int i = 0; i < 8; ++i) y[i] = a[i] * rstd * ng[i] * sigmoidf_(og[i]);
        *(u32x4*)(rp + C_BO + hd * 128 + e8) = pack8(y);
    }
}

__device__ __forceinline__ size_t agg_idx(int b, int gch, int dir, int which, int ch) { return ((((size_t)b * 36 + gch) * 2 + dir) * 2 + which) * 512 + ch; }
__device__ __forceinline__ float gelu_tanh(float x) { const float u = 0.7978845608028654f * (x + 0.044715f * x * x * x); const float th = 1.0f - 2.0f / (1.0f + __expf(2.0f * u)); return 0.5f * x * (1.0f + th); }
__device__ __forceinline__ void lru_tile(const Params& p, int l, LAS unsigned char* lds, int item, int mode, int& staged_nb) {
    LAS bf16_t* Wl = (LAS bf16_t*)lds;
    LAS bf16_t* Xb = Wl + 256 * 72;
    LAS float* Xf = (LAS float*)(lds + 46080);
    LAS float* Av = Xf + 4096;
    LAS float* Bv = Av + 8192;
    bf16_t* P = (bf16_t*)(PF(ws) + WS_P); float* AGG = (float*)(PF(ws) + WS_AGG);
    const int tid = tid_(), w = tid >> 6, lane = tid & 63, l16 = lane & 15, q4 = lane >> 4;
    const int nb = item & 7, rest = item >> 3, gch = rest % 36, b = rest / 36;
    const bool isctx = gch < 4; const int chunk = isctx ? gch : gch - 4, L = isctx ? CTXL : SEQ;
    const size_t seqrow0 = isctx ? (size_t)NLAT + b * CTXL : (size_t)b * SEQ; const int t0 = chunk * 64;
    if (staged_nb != nb) { const float* pwx = PF(lru_wx); const float* pwa = PF(lru_wa);
        for (int e = tid; e < 4 * 64 * 64; e += 512) { const int mat = e >> 12, i = (e >> 6) & 63, c = e & 63; const int dir = mat >> 1, kind = mat & 1;
            const float* W = kind ? pwx : pwa; const float v = W[((size_t)((l * 2 + dir) * 8 + nb) * 64 + i) * 64 + c];
            const int op = dir * 128 + (c >> 4) * 32 + kind * 16 + (c & 15);
            Wl[op * 72 + i] = (bf16_t)f2bf(v); }
        staged_nb = nb;
    }
    {
        const int t = tid >> 3, c8 = (tid & 7) * 8, ch = nb * 64 + c8, tt = t0 + t;
        float a8[8]; const float* pcb = PF(conv_b); const float* pcw = PF(conv_w);
        { const f32x4 b0 = *(const f32x4*)(pcb + l * 512 + ch), b1 = *(const f32x4*)(pcb + l * 512 + ch + 4);
#pragma unroll
          for (int i = 0; i < 4; ++i) { a8[i] = b0[i]; a8[4 + i] = b1[i]; } }
#pragma unroll
        for (int j = 0; j < 4; ++j) { const int ts = tt + j - 2;
            if (ts >= 0 && ts < L) { float xv[8]; unpack8(*(const u32x4*)(P + (seqrow0 + ts) * PW + C_AX + ch), xv);
                const f32x4 w0 = *(const f32x4*)(pcw + (l * 4 + j) * 512 + ch), w1 = *(const f32x4*)(pcw + (l * 4 + j) * 512 + ch + 4);
#pragma unroll
                for (int i = 0; i < 4; ++i) { a8[i] += xv[i] * w0[i]; a8[4 + i] += xv[4 + i] * w1[i]; } } }
#pragma unroll
        for (int i = 0; i < 8; ++i) Xf[t * 64 + c8 + i] = a8[i];
        *(LAS u32x4*)(Xb + t * 72 + c8) = pack8(a8);
    }
    __syncthreads();
    {
        const int dir = w >> 2, c = (w & 3) * 16 + l16, ch = nb * 64 + c;
        f32x4 acc[4][2];
#pragma unroll
        for (int mg = 0; mg < 4; ++mg) { acc[mg][0] = (f32x4){0.f, 0.f, 0.f, 0.f}; acc[mg][1] = (f32x4){0.f, 0.f, 0.f, 0.f}; }
#pragma unroll
        for (int ks = 0; ks < 2; ++ks) {
            const bf16x8 B0 = *(const LAS bf16x8*)(Wl + (w * 32 + l16) * 72 + ks * 32 + q4 * 8), B1 = *(const LAS bf16x8*)(Wl + (w * 32 + 16 + l16) * 72 + ks * 32 + q4 * 8);
#pragma unroll
            for (int mg = 0; mg < 4; ++mg) { const bf16x8 A = *(const LAS bf16x8*)(Xb + (mg * 16 + l16) * 72 + ks * 32 + q4 * 8);
                acc[mg][0] = mfma16(A, B0, acc[mg][0]); acc[mg][1] = mfma16(A, B1, acc[mg][1]); }
        }
        const float ba = PF(lru_ba)[(l * 2 + dir) * 512 + ch], bx = PF(lru_bx)[(l * 2 + dir) * 512 + ch], lam = PF(lru_lambda)[(l * 2 + dir) * 512 + ch];
        const float sp = log1pf(expf(-lam));
#pragma unroll
        for (int mg = 0; mg < 4; ++mg)
#pragma unroll
            for (int j = 0; j < 4; ++j) { const int t = mg * 16 + q4 * 4 + j;
                const float ea = 1.0f + __expf(-(acc[mg][0][j] + ba)), ex = 1.0f + __expf(-(acc[mg][1][j] + bx)); const float inv = __builtin_amdgcn_rcpf(ea * ex);
                const float r = inv * ex, ig = inv * ea;
                const float la = -8.0f * r * sp; const float a = __expf(la); const float x2 = 2.0f * la;
                float om = -x2 * (1.0f + x2 * (0.5f + x2 * (0.16666667f + x2 * (0.041666668f + x2 * 0.0083333338f))));
                if (x2 < -0.35f) om = 1.0f - a * a;
                const float bb = sqrtf(fmaxf(om, 0.f)) * ig * Xf[t * 64 + c];
                Av[(dir * 64 + t) * 64 + c] = a; Bv[(dir * 64 + t) * 64 + c] = bb; }
    }
    __syncthreads();
    {
        LAS float* SegA = Xf;
        LAS float* SegB = Xf + 512;
        const int d2 = tid >> 8, seg = (tid >> 6) & 3, c = tid & 63, ch = nb * 64 + c;
        float av[16], bv[16];
#pragma unroll
        for (int k = 0; k < 16; ++k) { const int s = seg * 16 + k; const int t = d2 ? 63 - s : s; const int ix = (d2 * 64 + t) * 64 + c; av[k] = Av[ix]; bv[k] = Bv[ix]; }
        float h = 0.f, ap = 1.f;
#pragma unroll
        for (int k = 0; k < 16; ++k) { h = av[k] * h + bv[k]; ap *= av[k]; }
        SegA[(d2 * 4 + seg) * 64 + c] = ap; SegB[(d2 * 4 + seg) * 64 + c] = h;
        float hin = 0.f;
        if (mode == 1) {
            if (d2 == 0) { for (int g = 0; g < gch; ++g) hin = AGG[agg_idx(b, g, 0, 0, ch)] * hin + AGG[agg_idx(b, g, 0, 1, ch)]; }
            else {
                if (gch < 4) { for (int g = 3; g > gch; --g) hin = AGG[agg_idx(b, g, 1, 0, ch)] * hin + AGG[agg_idx(b, g, 1, 1, ch)]; }
                else { for (int g = 3; g >= 0; --g) hin = AGG[agg_idx(b, g, 1, 0, ch)] * hin + AGG[agg_idx(b, g, 1, 1, ch)];
                       for (int g = 35; g > gch; --g) hin = AGG[agg_idx(b, g, 1, 0, ch)] * hin + AGG[agg_idx(b, g, 1, 1, ch)]; }
            }
        }
        __syncthreads();
        if (mode == 0) {
            if (seg == 3) { float A = 1.f, B = 0.f;
#pragma unroll
                for (int s2 = 0; s2 < 4; ++s2) { const float sa = SegA[(d2 * 4 + s2) * 64 + c], sb2 = SegB[(d2 * 4 + s2) * 64 + c]; B = sa * B + sb2; A *= sa; }
                AGG[agg_idx(b, gch, d2, 0, ch)] = A; AGG[agg_idx(b, gch, d2, 1, ch)] = B; }
        } else {
#pragma unroll
            for (int s2 = 0; s2 < 3; ++s2) if (s2 < seg) hin = SegA[(d2 * 4 + s2) * 64 + c] * hin + SegB[(d2 * 4 + s2) * 64 + c];
            float hh2 = hin;
#pragma unroll
            for (int k = 0; k < 16; ++k) { const int s = seg * 16 + k; const int t = d2 ? 63 - s : s; hh2 = av[k] * hh2 + bv[k]; Bv[(d2 * 64 + t) * 64 + c] = hh2; }
        }
    }
    __syncthreads();
    if (mode == 1) {
        const int t = tid >> 3, c8 = (tid & 7) * 8; bf16_t* gp = P + (seqrow0 + t0 + t) * PW + C_AG + nb * 64 + c8;
        float gt[8]; unpack8(*(const u32x4*)gp, gt); float y[8];
#pragma unroll
        for (int i = 0; i < 8; ++i) y[i] = (Bv[t * 64 + c8 + i] + Bv[(64 + t) * 64 + c8 + i]) * gelu_tanh(gt[i]);
        *(u32x4*)gp = pack8(y);
        __syncthreads();
    }
}

__device__ __forceinline__ void attn_item(const Params& p, int l, LAS unsigned char* lds, int item, int dry = 0) {
    LAS bf16_t* Kt = (LAS bf16_t*)lds;
    LAS bf16_t* Vt = Kt + 2 * 64 * 72;
    LAS float* rpbL = (LAS float*)(lds + 36864);
    LAS float* cosT = rpbL + 960;
    LAS float* sinT = cosT + 1024;
    LAS float* gq = sinT + 1024; LAS float* gk = gq + 64;
    bf16_t* P = (bf16_t*)(PF(ws) + WS_P); const float* rope = (const float*)(PF(ws) + WS_ROPE);
    const int tid = tid_(), w = tid >> 6, lane = tid & 63, l16 = lane & 15, q4 = lane >> 4, hh = w >> 2, qg4 = w & 3;
    const bool isctx = item >= 1024;
    int b, r, hp, nloc, kr0; size_t qrow0;
    if (!isctx) { hp = item & 3; r = (item >> 2) & 31; b = item >> 7; qrow0 = (size_t)b * SEQ + r * 64; nloc = 8; kr0 = min(max(r - 4, 0), 24); }
    else { const int it = item - 1024; hp = it & 3; const int qt = (it >> 2) & 3; b = it >> 4; qrow0 = (size_t)NLAT + b * CTXL + qt * 64; nloc = 0; r = 0; kr0 = 0; }
    const int h = hp * 2 + hh;
    const float* prpb = PF(na_rpb);
    for (int i = tid; i < 2 * 465; i += 512) { const int h2 = i / 465, j = i - h2 * 465; rpbL[h2 * 480 + j] = prpb[(size_t)((l * 8 + hp * 2 + h2) * 465) + j]; }
    for (int i = tid; i < 1024; i += 512) { cosT[i] = rope[i]; sinT[i] = rope[1024 + i]; }
    if (tid < 64) { gq[tid] = PF(na_qg)[l * 64 + tid]; gk[tid] = PF(na_kg)[l * 64 + tid]; }
    __syncthreads();
    const int qc = qg4 * 16 + l16; const size_t qrow = qrow0 + qc;
    bf16x8 qpl[2], qrt[2];
    {
        const bf16_t* qp = P + qrow * PW + C_CQ + h * 64;
        float xq[16]; unpack8(*(const u32x4*)(qp + q4 * 8), xq); unpack8(*(const u32x4*)(qp + 32 + q4 * 8), xq + 8);
        float ss = 0.f;
#pragma unroll
        for (int i = 0; i < 16; ++i) ss += xq[i] * xq[i];
        ss += __shfl_xor(ss, 16); ss += __shfl_xor(ss, 32);
        const float rs = rsqrtf(ss * (1.0f / 64.0f) + 1e-6f) * 0.125f;
#pragma unroll
        for (int i = 0; i < 8; ++i) { xq[i] *= rs * gq[q4 * 8 + i]; xq[8 + i] *= rs * gq[32 + q4 * 8 + i]; }
        qpl[0] = as_bf16x8(pack8(xq)); qpl[1] = as_bf16x8(pack8(xq + 8));
        float xr[16];
#pragma unroll
        for (int ks = 0; ks < 2; ++ks) { const int pos = ks == 0 ? r : qc;
#pragma unroll
            for (int jj = 0; jj < 8; ++jj) { const int fi = (q4 & 1) * 8 + jj; const float cs = cosT[pos * 16 + fi], sn = sinT[pos * 16 + fi]; const float xv = xq[ks * 8 + jj]; const float pr = __shfl_xor(xv, 32);
                xr[ks * 8 + jj] = (q4 < 2) ? (xv * cs - pr * sn) : (xv * cs + pr * sn); } }
        qrt[0] = as_bf16x8(pack8(xr)); qrt[1] = as_bf16x8(pack8(xr + 8));
    }
    f32x4 O[4];
#pragma unroll
    for (int i = 0; i < 4; ++i) O[i] = (f32x4){0.f, 0.f, 0.f, 0.f};
    float mrun = -1e30f, lsum = 0.f;
    const int pf_hh2 = tid >> 8, pf_h2 = hp * 2 + pf_hh2, pf_key = (tid & 255) >> 2, pf_seg = tid & 3, pf_vseg = (tid & 255) >> 6, pf_vkey = tid & 63;
    u32x4 pk0, pk1, pv0, pv1;
    { const size_t r0 = nloc ? (size_t)b * SEQ + kr0 * 64 : (size_t)NLAT + b * CTXL;
      const bf16_t* kp = P + (r0 + pf_key) * PW + C_CK + pf_h2 * 64 + pf_seg * 16; pk0 = *(const u32x4*)kp; pk1 = *(const u32x4*)(kp + 8);
      const bf16_t* vp = P + (r0 + pf_vkey) * PW + C_CV + pf_h2 * 64 + pf_vseg * 16; pv0 = *(const u32x4*)vp; pv1 = *(const u32x4*)(vp + 8); }
    const int ntot = nloc + 4; int Tn = 0;
#pragma unroll
    for (int ph = 0; ph < 2; ++ph) {
    const bool loc = (ph == 0); const int ntile = loc ? nloc : 4;
    for (int kt = 0; kt < ntile; ++kt) {
        const int kr = kr0 + kt; ++Tn;
        {
            const int hh2 = pf_hh2, key = pf_key, seg = pf_seg;
            float xk[16]; unpack8(pk0, xk); unpack8(pk1, xk + 8);
            float ss = 0.f;
#pragma unroll
            for (int i = 0; i < 16; ++i) ss += xk[i] * xk[i];
            ss += __shfl_xor(ss, 1); ss += __shfl_xor(ss, 2);
            const float rs = rsqrtf(ss * (1.0f / 64.0f) + 1e-6f);
#pragma unroll
            for (int i = 0; i < 16; ++i) xk[i] *= rs * gk[seg * 16 + i];
            if (loc) { const int pos = seg < 2 ? kr : key;
#pragma unroll
                for (int i = 0; i < 16; ++i) { const float pr = __shfl_xor(xk[i], 1); const float cs = cosT[pos * 16 + i], sn = sinT[pos * 16 + i]; xk[i] = (seg & 1) ? (xk[i] * cs + pr * sn) : (xk[i] * cs - pr * sn); } }
            LAS bf16_t* kd = Kt + (hh2 * 64 + key) * 72 + seg * 16;
            *(LAS u32x4*)kd = pack8(xk); *(LAS u32x4*)(kd + 8) = pack8(xk + 8);
        }
        {
            const int hh2 = pf_hh2, seg = pf_vseg, key = pf_vkey;
            const u32x4 a = pv0, c = pv1;
            LAS bf16_t* vd = Vt + (hh2 * 64 + seg * 16) * 72 + key;
            vd[0 * 72] = (bf16_t)(a.x & 0xffff); vd[1 * 72] = (bf16_t)(a.x >> 16); vd[2 * 72] = (bf16_t)(a.y & 0xffff); vd[3 * 72] = (bf16_t)(a.y >> 16);
            vd[4 * 72] = (bf16_t)(a.z & 0xffff); vd[5 * 72] = (bf16_t)(a.z >> 16); vd[6 * 72] = (bf16_t)(a.w & 0xffff); vd[7 * 72] = (bf16_t)(a.w >> 16);
            vd[8 * 72] = (bf16_t)(c.x & 0xffff); vd[9 * 72] = (bf16_t)(c.x >> 16); vd[10 * 72] = (bf16_t)(c.y & 0xffff); vd[11 * 72] = (bf16_t)(c.y >> 16);
            vd[12 * 72] = (bf16_t)(c.z & 0xffff); vd[13 * 72] = (bf16_t)(c.z >> 16); vd[14 * 72] = (bf16_t)(c.w & 0xffff); vd[15 * 72] = (bf16_t)(c.w >> 16);
        }
        if (Tn < ntot) { const size_t r0 = (Tn < nloc) ? (size_t)b * SEQ + (kr0 + Tn) * 64 : (size_t)NLAT + b * CTXL + (Tn - nloc) * 64;
            const bf16_t* kp = P + (r0 + pf_key) * PW + C_CK + pf_h2 * 64 + pf_seg * 16; pk0 = *(const u32x4*)kp; pk1 = *(const u32x4*)(kp + 8);
            const bf16_t* vp = P + (r0 + pf_vkey) * PW + C_CV + pf_h2 * 64 + pf_vseg * 16; pv0 = *(const u32x4*)vp; pv1 = *(const u32x4*)(vp + 8); }
        __syncthreads();
        f32x4 st[4];
#pragma unroll
        for (int g = 0; g < 4; ++g) { st[g] = (f32x4){0.f, 0.f, 0.f, 0.f};
#pragma unroll
            for (int ks = 0; ks < 2; ++ks) { const bf16x8 A = *(const LAS bf16x8*)(Kt + (hh * 64 + g * 16 + l16) * 72 + ks * 32 + q4 * 8); st[g] = mfma16(A, loc ? qrt[ks] : qpl[ks], st[g]); } }
        if (loc) { const int cs0 = min(max(qc - 8, 0), 48); const int drow = kr - r + 7;
#pragma unroll
            for (int g = 0; g < 4; ++g)
#pragma unroll
                for (int j = 0; j < 4; ++j) { const int kc = g * 16 + q4 * 4 + j; const int dcol = min(max(kc - qc, -15), 15) + 15;
                    const float sv = st[g][j] + rpbL[hh * 480 + drow * 31 + dcol]; st[g][j] = (kc < cs0 || kc >= cs0 + 16) ? -1e30f : sv; } }
        float tmax = -1e30f;
#pragma unroll
        for (int g = 0; g < 4; ++g)
#pragma unroll
            for (int j = 0; j < 4; ++j) tmax = fmaxf(tmax, st[g][j]);
        tmax = fmaxf(tmax, __shfl_xor(tmax, 16)); tmax = fmaxf(tmax, __shfl_xor(tmax, 32));
        const float mnew = fmaxf(mrun, tmax); const float alpha = __expf(mrun - mnew); mrun = mnew;
        float psum = 0.f;
#pragma unroll
        for (int g = 0; g < 4; ++g)
#pragma unroll
            for (int j = 0; j < 4; ++j) { const float pv = __expf(st[g][j] - mnew); st[g][j] = pv; psum += pv; }
        lsum = lsum * alpha + psum;
#pragma unroll
        for (int i = 0; i < 4; ++i) O[i] *= alpha;
        bf16x8 pb[2];
#pragma unroll
        for (int ks = 0; ks < 2; ++ks) { u32x4 wv; wv.x = pack2(st[2 * ks][0], st[2 * ks][1]); wv.y = pack2(st[2 * ks][2], st[2 * ks][3]); wv.z = pack2(st[2 * ks + 1][0], st[2 * ks + 1][1]); wv.w = pack2(st[2 * ks + 1][2], st[2 * ks + 1][3]); pb[ks] = as_bf16x8(wv); }
#pragma unroll
        for (int dg = 0; dg < 4; ++dg)
#pragma unroll
            for (int ks = 0; ks < 2; ++ks) { const LAS bf16_t* vr = Vt + (hh * 64 + dg * 16 + l16) * 72 + ks * 32 + q4 * 4;
                const u32x2 lo = *(const LAS u32x2*)vr, hi = *(const LAS u32x2*)(vr + 16); u32x4 av; av.x = lo.x; av.y = lo.y; av.z = hi.x; av.w = hi.y;
                O[dg] = mfma16(as_bf16x8(av), pb[ks], O[dg]); }
        __syncthreads();
    }
    }
    lsum += __shfl_xor(lsum, 16); lsum += __shfl_xor(lsum, 32);
    const float inv = 1.0f / lsum;
    bf16_t* op = dry ? ((bf16_t*)(PF(ws) + WS_DUMMY) + (size_t)(blockIdx.x & 127) * 8192 + (w * 16 + l16) * 64) : (P + qrow * PW + C_CQ + h * 64);
#pragma unroll
    for (int dg = 0; dg < 4; ++dg) { u32x2 wv; wv.x = pack2(O[dg][0] * inv, O[dg][1] * inv); wv.y = pack2(O[dg][2] * inv, O[dg][3] * inv); *(u32x2*)(op + dg * 16 + q4 * 4) = wv; }
    __syncthreads();
}

__device__ __forceinline__ void hgrn_stage(const bf16_t* P, LAS unsigned char* lds, int w, int lane, size_t row0, int dir, int h) {
#pragma unroll
    for (int i = 0; i < 2; ++i) { const int blk = i * 8 + w; const int t = blk * 4 + (lane >> 4); const bf16_t* rp = P + (row0 + (dir ? 63 - t : t)) * PW + (lane & 15) * 8;
        __builtin_amdgcn_global_load_lds((const unsigned*)(rp + C_BQ + h * 128), (LAS unsigned*)(lds + 118784 + blk * 1024), 16, 0, 0);
        __builtin_amdgcn_global_load_lds((const unsigned*)(rp + C_BF + dir * 512 + h * 128), (LAS unsigned*)(lds + 135168 + blk * 1024), 16, 0, 0); }
}
__device__ __forceinline__ void hgrn_chain(const Params& p, int l, LAS unsigned char* lds, int chain, int dry = 0) {
    LAS bf16_t* Q0 = (LAS bf16_t*)lds;
    LAS bf16_t* KP = (LAS bf16_t*)(lds + 17408);
    LAS bf16_t* SB = (LAS bf16_t*)(lds + 34816);
    LAS bf16_t* KDT = (LAS bf16_t*)(lds + 69632);
    LAS bf16_t* VT = (LAS bf16_t*)(lds + 88064);
    LAS bf16_t* ATT = (LAS bf16_t*)(lds + 106496);
    LAS float* TOT = (LAS float*)(lds + 115712);
    LAS float* DD = (LAS float*)(lds + 117760);
    const LAS bf16_t* SQ = (const LAS bf16_t*)(lds + 118784);
    const LAS bf16_t* SF = (const LAS bf16_t*)(lds + 135168);
    bf16_t* P = (bf16_t*)(PF(ws) + WS_P);
    const int tid = tid_(), w = __builtin_amdgcn_readfirstlane(tid >> 6), lane = tid & 63, l16 = lane & 15, q4 = lane >> 4;
    const int dir = chain & 1, h = (chain >> 1) & 3, b = chain >> 3;
    const int d = tid & 127, sb = tid >> 7;
    float lbv = 0.f;
    if (l > 0) { const float x0 = PF(hg_lb)[(dir * 2 + 0) * 512 + h * 128 + d], x1 = PF(hg_lb)[(dir * 2 + 1) * 512 + h * 128 + d]; lbv = 1.0f / (1.0f + expf(x0 - x1)); }
    for (int i = tid; i < 64 * 72 / 2; i += 512) ((LAS unsigned*)ATT)[i] = 0u;
    f32x4 S[8];
#pragma unroll
    for (int i = 0; i < 8; ++i) S[i] = (f32x4){0.f, 0.f, 0.f, 0.f};
    { const int gch0 = dir == 0 ? 0 : 3; hgrn_stage(P, lds, w, lane, (size_t)NLAT + b * CTXL + gch0 * 64, dir, h); }
    asm volatile("s_waitcnt vmcnt(0)" ::: "memory");
    __syncthreads();
    for (int ci = 0; ci < 36; ++ci) {
        const int gch = dir == 0 ? ci : (ci < 4 ? 3 - ci : 39 - ci);
        const bool isctx = gch < 4; const int chunk = isctx ? gch : gch - 4;
        const size_t row0 = isctx ? (size_t)NLAT + b * CTXL + chunk * 64 : (size_t)b * SEQ + chunk * 64;
        float bl[16], qv[16], kv[16]; float run = 0.f;
        {
            unsigned vraw[16];
#pragma unroll
            for (int ii = 0; ii < 16; ++ii) { const int t = sb * 16 + ii; vraw[ii] = P[(row0 + (dir ? 63 - t : t)) * PW + C_BI + h * 128 + d]; }
#pragma unroll
            for (int eg = 0; eg < 8; ++eg) { u32x2 wv; wv.x = pack2(S[eg][0], S[eg][1]); wv.y = pack2(S[eg][2], S[eg][3]); *(LAS u32x2*)(SB + (eg * 16 + l16) * 136 + w * 16 + q4 * 4) = wv; }
#pragma unroll
            for (int ii = 0; ii < 16; ++ii) { const int t = sb * 16 + ii;
                const float fr = bf2f(SF[t * 128 + d]), qr = bf2f(SQ[t * 128 + d]);
                const float sg = 1.0f / (1.0f + __expf(-fr)); const float f = lbv + (1.0f - lbv) * sg; run += __logf(f); bl[ii] = run; kv[ii] = 1.0f - f; qv[ii] = qr / (1.0f + __expf(-qr)); }
            TOT[sb * 128 + d] = run;
            u32x4 v0, v1; v0.x = vraw[0] | (vraw[1] << 16); v0.y = vraw[2] | (vraw[3] << 16); v0.z = vraw[4] | (vraw[5] << 16); v0.w = vraw[6] | (vraw[7] << 16);
            v1.x = vraw[8] | (vraw[9] << 16); v1.y = vraw[10] | (vraw[11] << 16); v1.z = vraw[12] | (vraw[13] << 16); v1.w = vraw[14] | (vraw[15] << 16);
            *(LAS u32x4*)(VT + d * 72 + sb * 16) = v0; *(LAS u32x4*)(VT + d * 72 + sb * 16 + 8) = v1;
        }
        __syncthreads();
        if (ci < 35) { const int cn = ci + 1; const int gn = dir == 0 ? cn : (cn < 4 ? 3 - cn : 39 - cn); const bool cx = gn < 4; const int ck = cx ? gn : gn - 4;
            hgrn_stage(P, lds, w, lane, cx ? (size_t)NLAT + b * CTXL + ck * 64 : (size_t)b * SEQ + ck * 64, dir, h); }
        {
            const float t0 = TOT[d], t1 = TOT[128 + d], t2 = TOT[256 + d], t3 = TOT[384 + d];
            const float Bs1 = t0, Bs2 = t0 + t1, Bs3 = Bs2 + t2, total = Bs3 + t3;
            const float Bsb = sb == 0 ? 0.f : (sb == 1 ? Bs1 : (sb == 2 ? Bs2 : Bs3));
            const float eB = __expf(Bsb), eT = __expf(total);
            float kd[16];
#pragma unroll
            for (int ii = 0; ii < 16; ++ii) { const float e0 = __expf(bl[ii]); Q0[(sb * 16 + ii) * 136 + d] = (bf16_t)f2bf(qv[ii] * e0 * eB);
                const float kp = kv[ii] * __expf(fminf(-(Bsb + bl[ii]), 80.f)); KP[(sb * 16 + ii) * 136 + d] = (bf16_t)f2bf(kp); kd[ii] = kp * eT; }
            *(LAS u32x4*)(KDT + d * 72 + sb * 16) = pack8(kd); *(LAS u32x4*)(KDT + d * 72 + sb * 16 + 8) = pack8(kd + 8);
            if (sb == 0) DD[d] = eT;
        }
        __syncthreads();
#pragma unroll
        for (int k2 = 0; k2 < 2; ++k2) { const int idx = w + 8 * k2;
            if (idx < 10) { const int i = idx < 1 ? 0 : (idx < 3 ? 1 : (idx < 6 ? 2 : 3)); const int j = idx - i * (i + 1) / 2;
                f32x4 sc = (f32x4){0.f, 0.f, 0.f, 0.f};
                const LAS bf16_t* qb = Q0 + (i * 16 + l16) * 136 + q4 * 8; const LAS bf16_t* kb = KP + (j * 16 + l16) * 136 + q4 * 8;
#pragma unroll
                for (int ks = 0; ks < 4; ++ks) sc = mfma16(*(const LAS bf16x8*)(qb + ks * 32), *(const LAS bf16x8*)(kb + ks * 32), sc);
#pragma unroll
                for (int jj = 0; jj < 4; ++jj) { const float v = (i == j && l16 > q4 * 4 + jj) ? 0.f : sc[jj]; ATT[(i * 16 + q4 * 4 + jj) * 72 + j * 16 + l16] = (bf16_t)f2bf(v); } } }
        __syncthreads();
        {
            bf16x8 SBf[4], VTf[2];
#pragma unroll
            for (int ks = 0; ks < 4; ++ks) SBf[ks] = *(const LAS bf16x8*)(SB + (w * 16 + l16) * 136 + ks * 32 + q4 * 8);
#pragma unroll
            for (int ks = 0; ks < 2; ++ks) VTf[ks] = *(const LAS bf16x8*)(VT + (w * 16 + l16) * 72 + ks * 32 + q4 * 8);
#pragma unroll
            for (int i = 0; i < 4; ++i) { f32x4 oa = (f32x4){0.f, 0.f, 0.f, 0.f};
#pragma unroll
                for (int ks = 0; ks < 4; ++ks) oa = mfma16(SBf[ks], *(const LAS bf16x8*)(Q0 + (i * 16 + l16) * 136 + ks * 32 + q4 * 8), oa);
#pragma unroll
                for (int ks = 0; ks < 2; ++ks) oa = mfma16(VTf[ks], *(const LAS bf16x8*)(ATT + (i * 16 + l16) * 72 + ks * 32 + q4 * 8), oa);
                const int t = i * 16 + l16; u32x2 wv; wv.x = pack2(oa[0], oa[1]); wv.y = pack2(oa[2], oa[3]);
                bf16_t* od = dry ? ((bf16_t*)(PF(ws) + WS_DUMMY) + (size_t)chain * 8192 + t * 128 + w * 16 + q4 * 4) : (P + (row0 + (dir ? 63 - t : t)) * PW + C_BF + dir * 512 + h * 128 + w * 16 + q4 * 4);
                *(u32x2*)od = wv; }
        }
        {
            const f32x4 dd = *(const LAS f32x4*)(DD + w * 16 + q4 * 4);
#pragma unroll
            for (int eg = 0; eg < 8; ++eg) S[eg] *= dd;
#pragma unroll
            for (int ks = 0; ks < 2; ++ks) { const bf16x8 A = *(const LAS bf16x8*)(KDT + (w * 16 + l16) * 72 + ks * 32 + q4 * 8);
#pragma unroll
                for (int eg = 0; eg < 8; ++eg) S[eg] = mfma16(A, *(const LAS bf16x8*)(VT + (eg * 16 + l16) * 72 + ks * 32 + q4 * 8), S[eg]); }
        }
        asm volatile("s_waitcnt vmcnt(0)" ::: "memory");
        __syncthreads();
    }
}

__device__ __forceinline__ void dbg_dump() {
    const bf16_t* P = (const bf16_t*)(PF(ws) + WS_P); const bf16_t* U = (const bf16_t*)(PF(ws) + WS_U); const float* AGG = (const float*)(PF(ws) + WS_AGG); float* out = PF(out);
    const size_t n = (size_t)NLAT * DM;
    for (size_t i = (size_t)blockIdx.x * 512 + threadIdx.x; i < n; i += (size_t)gridDim.x * 512) {
        float s = 0.f;
#pragma unroll
        for (int k = 0; k < 5; ++k) s += bf2f(P[i + k * n]);
        s += bf2f(P[(i % ((size_t)NTOK * PW - 5 * n)) + 5 * n]);
        s += bf2f(U[i]) + bf2f(U[(i % ((size_t)NCTX * DM)) + n]);
        s += AGG[i % ((size_t)NB * 36 * 2 * 2 * 512)];
        if (!(s == s)) s = 7777.f; if (fabsf(s) > 1e30f) s = 8888.f; out[i] = s + 1000.0f;
    }
}
#ifndef STAGE_STOP
#define STAGE_STOP 0
#define DBG_SKIP 0
#define STAGE_L 0
#endif
__global__ void __launch_bounds__(512, 2) fwd_megakernel(Params p) {
    extern __shared__ __attribute__((aligned(16))) unsigned char lds_raw[];
    LAS unsigned char* lds = (LAS unsigned char*)lds_raw;
    cg::grid_group grid = cg::this_grid();
    volatile LAS unsigned* xst = (volatile LAS unsigned*)(lds + LDS_BYTES - 16);
    if (threadIdx.x == 0) { xst[0] = 0u; xst[1] = 0u; xst[2] = 0u; xst[3] = 0u; }
    __syncthreads();
    const XcdBarrier xbar = xcd_barrier_post((unsigned*)(PF(ws) + WS_BAR), xst);
    const int G = gridDim.x, c = blockIdx.x;

    phase_mod(p, lds); __syncthreads();
    phase_rope(p);
    phase_convert(p, 0, lds);
    grid.sync();
#define WSP(T, off) ((T*)(PF(ws) + (off)))
    for (int l = 0; l < 2; ++l) {
        const bool lastl = (l == 1);
        const int Mrest = lastl ? NLAT : NTOK;
        if (l > 0) phase_convert(p, l, lds);
        phase_norm(p, l, l == 0 ? PF(x) : PF(out), l == 0 ? PF(ctx) : WSP(const float, WS_HC), PF(norm1_g) + l * DM, 0, NTOK,
                   (l > 0 && G == 256) ? (const float*)(PF(ws) + WS_P + (size_t)NTOK * DFF * 2) : nullptr, WSP(const float, WS_MOD) + (size_t)((l > 0 ? l - 1 : 0) * 9 + 8) * 6144 + 5120);
        xcd_barrier(xbar);
        { pg8::Gemm g{WSP(bf16_t, WS_U), WSP(bf16_t, WS_WIN), DM, DM, DM}; pg8::Sched S; S.init(NTOK, PW, G, c, DM, DM); pg8::EpiStore<0> E{WSP(bf16_t, WS_P), PW}; pg8::gemm_phase(lds, g, S, E); }
        xcd_barrier(xbar);
#if EXPERIMENT == 1
        if (c < 64) hgrn_chain(p, l, lds, c, 1);
        xcd_barrier(xbar);
#elif EXPERIMENT == 2
        if (c >= 64) { const int cc = c - 64, GG = G - 64; const int nA = lastl ? 1024 : 1152;
            for (int it = cc; it < nA; it += GG) attn_item(p, l, lds, it, 1); }
        xcd_barrier(xbar);
#elif EXPERIMENT == 3
        if (c >= 64) { const int cc = c - 64, GG = G - 64; int staged = -1;
            for (int it = cc; it < 2304; it += GG) lru_tile(p, l, lds, it, 0, staged); }
        xcd_barrier(xbar);
#elif EXPERIMENT == 5
        for (int q = 0; q < 10; ++q) xcd_barrier(xbar);
#elif EXPERIMENT == 6
        phase_convert(p, l, lds);
        xcd_barrier(xbar);
#elif EXPERIMENT == 7
        phase_norm(p, l, PF(out), WSP(const float, WS_HC), PF(norm2_g) + l * DM, 3072, NTOK);
        xcd_barrier(xbar);
#elif EXPERIMENT == 4
        { pg8::Gemm g{WSP(bf16_t, WS_U), WSP(bf16_t, WS_WIN), DM, DM, DM}; pg8::Sched S; S.init(NTOK, PW, G, c, DM, DM); pg8::EpiStore<0> E{WSP(bf16_t, WS_P), PW}; pg8::gemm_phase(lds, g, S, E); }
        xcd_barrier(xbar);
#endif
        if (c < 64) { hgrn_chain(p, l, lds, c); sub_barrier((unsigned*)(PF(ws) + WS_BAR) + 3520 + 64 * (2 * l), 64u); phase_hg_final(p, l, NTOK, c, 64); }
        else { const int cc = c - 64, GG = G - 64; const int nA = lastl ? 1024 : 1152;
            for (int it = cc; it < nA; it += GG) attn_item(p, l, lds, it);
            int staged = -1;
            for (int it = cc; it < 2304; it += GG) lru_tile(p, l, lds, it, 0, staged);
            sub_barrier((unsigned*)(PF(ws) + WS_BAR) + 3520 + 64 * (2 * l + 1), (unsigned)GG);
            for (int it = cc; it < 2304; it += GG) lru_tile(p, l, lds, it, 1, staged); }
        xcd_barrier(xbar);
        { pg8::Gemm g{WSP(bf16_t, WS_U), WSP(bf16_t, WS_WIN) + (size_t)PW * DM, DM, DM, DM}; pg8::Sched S; S.init(Mrest, 3072, G, c, DM, DM); pg8::EpiStore<1> E{WSP(bf16_t, WS_P), PW}; pg8::gemm_phase(lds, g, S, E); }
        xcd_barrier(xbar);
#if EXPERIMENT == 8
        { pg8::Gemm g{WSP(bf16_t, WS_U), WSP(bf16_t, WS_WIN) + (size_t)PW * DM, DM, DM, DM}; pg8::Sched S; S.init(Mrest, 3072, G, c, DM, DM); pg8::EpiStore<1> E{WSP(bf16_t, WS_P), PW}; pg8::gemm_phase(lds, g, S, E); }
        xcd_barrier(xbar);
#endif
        { pg8::Gemm g{WSP(bf16_t, WS_P), WSP(bf16_t, WS_WB), PW, 512, 512}; pg8::MergeSched S; S.base.init(Mrest, DM, G, c, PW, 512);
          pg8::EpiMerge E{WSP(bf16_t, WS_P), WSP(bf16_t, WS_U)}; pg8::gemm_phase(lds, g, S, E); }
        xcd_barrier(xbar);
        { pg8::Gemm g{WSP(bf16_t, WS_U), WSP(bf16_t, WS_WO), DM, DM, DM}; pg8::Sched S; S.init(Mrest, DM, G, c, DM, DM);
          pg8::EpiResid E{l == 0 ? PF(x) : PF(out), l == 0 ? PF(ctx) : WSP(const float, WS_HC), PF(out), WSP(float, WS_HC), WSP(const float, WS_MOD) + (size_t)l * 9 * 6144 + 2048}; pg8::gemm_phase(lds, g, S, E); }
        xcd_barrier(xbar);
#if EXPERIMENT == 11
        if (l == 0) {
        { pg8::Gemm g{WSP(bf16_t, WS_U), WSP(bf16_t, WS_WO), DM, DM, DM}; pg8::Sched S; S.init(Mrest, DM, G, c, DM, DM);
          pg8::EpiResid E{l == 0 ? PF(x) : PF(out), l == 0 ? PF(ctx) : WSP(const float, WS_HC), PF(out), WSP(float, WS_HC), WSP(const float, WS_MOD) + (size_t)l * 9 * 6144 + 2048}; pg8::gemm_phase(lds, g, S, E); }
        xcd_barrier(xbar);
        }
#endif
        phase_norm(p, l, PF(out), WSP(const float, WS_HC), PF(norm2_g) + l * DM, 3072, Mrest);
        xcd_barrier(xbar);
        { pg8::Gemm g{WSP(bf16_t, WS_U), WSP(bf16_t, WS_W1), DM, DM, DM}; pg8::Sched S; S.init(Mrest, DFF, G, c, DM, DM); pg8::EpiStore<2> E{WSP(bf16_t, WS_P), DFF}; pg8::gemm_phase(lds, g, S, E); }
        xcd_barrier(xbar);
#if EXPERIMENT == 9
        { pg8::Gemm g{WSP(bf16_t, WS_U), WSP(bf16_t, WS_W1), DM, DM, DM}; pg8::Sched S; S.init(Mrest, DFF, G, c, DM, DM); pg8::EpiStore<2> E{WSP(bf16_t, WS_P), DFF}; pg8::gemm_phase(lds, g, S, E); }
        xcd_barrier(xbar);
#endif
        { pg8::Gemm g{WSP(bf16_t, WS_P), WSP(bf16_t, WS_W2), DFF, DFF, DFF};
          float* slab = (float*)(PF(ws) + WS_P + (size_t)NTOK * DFF * 2);
          pg8::EpiResid E{PF(out), WSP(const float, WS_HC), PF(out), WSP(float, WS_HC), WSP(const float, WS_MOD) + (size_t)l * 9 * 6144 + 5120, slab};
          if (!lastl && G == 256) { pg8::SplitSched S; S.base.init(NLAT, DM, G, c, DFF, DFF); pg8::gemm_phase(lds, g, S, E); }
          else { pg8::Sched S; S.init(Mrest, DM, G, c, DFF, DFF); pg8::gemm_phase(lds, g, S, E); } }
        if (!lastl) xcd_barrier(xbar);
    }
}

extern "C" void kernel_launch(void* const* d_in, const int* in_sizes, int n_in, void* d_out, int out_size, void* d_ws, size_t ws_size, hipStream_t stream) {
    static int grid_blocks = 0;
    if (grid_blocks == 0) {
        int dev = 0, cus = 0, per_cu = 0;
        hipGetDevice(&dev);
        hipDeviceGetAttribute(&cus, hipDeviceAttributeMultiprocessorCount, dev);
        hipFuncSetAttribute((const void*)fwd_megakernel, hipFuncAttributeMaxDynamicSharedMemorySize, LDS_BYTES);
        hipOccupancyMaxActiveBlocksPerMultiprocessor(&per_cu, (const void*)fwd_megakernel, 512, LDS_BYTES);
        if (per_cu < 1 || n_in != 25 || ws_size < WS_END) { fprintf(stderr, "kernel_launch: cannot launch (per_cu %d, n_in %d, ws %zu need %zu)\n", per_cu, n_in, ws_size, (size_t)WS_END); grid_blocks = -1; }
        else grid_blocks = cus;
    }
    if (grid_blocks < 0) return;
    hipMemsetAsync((char*)d_ws + WS_BAR, 0, 16384, stream);
    Params p{};
    const float** pp = (const float**)&p;
    for (int i = 0; i < 25; ++i) pp[i] = (const float*)d_in[i];
    p.out = (float*)d_out; p.ws = (unsigned char*)d_ws;
    void* args[] = {&p};
    hipError_t e = hipLaunchCooperativeKernel((const void*)fwd_megakernel, dim3(grid_blocks), dim3(512), args, LDS_BYTES, stream);
    if (e != hipSuccess) fprintf(stderr, "cooperative launch failed: %s (grid %d)\n", hipGetErrorString(e), grid_blocks);
}
```

```cpp
#include <hip/hip_runtime.h>
#include <hip/hip_cooperative_groups.h>
#include <stdint.h>
#include <stdio.h>
namespace cg = cooperative_groups;

#define DBG_HG 0
#define EXPERIMENT 0
#define LAS __attribute__((address_space(3)))
typedef unsigned short bf16_t;
typedef short bf16x8 __attribute__((ext_vector_type(8)));
typedef float f32x4 __attribute__((ext_vector_type(4)));
typedef unsigned u32x4 __attribute__((ext_vector_type(4)));
typedef unsigned u32x2 __attribute__((ext_vector_type(2)));

constexpr int DM = 1024, NB = 8, SEQ = 2048, CTXL = 256, NLAT = NB * SEQ, NCTX = NB * CTXL, NTOK = NLAT + NCTX;
constexpr int PW = 5120, DIN = 8192, DFF = 4096;
constexpr int C_AX = 0, C_AG = 512, C_BQ = 1024, C_BF = 1536, C_BI = 2560, C_BO = 3072, C_CQ = 3584, C_CK = 4096, C_CV = 4608;
constexpr int LDS_BYTES = 163840;
constexpr size_t WS_WIN = 0;
constexpr size_t WS_WB = WS_WIN + (size_t)DIN * DM * 2;
constexpr size_t WS_WO = WS_WB + (size_t)3 * DM * 512 * 2;
constexpr size_t WS_W1 = WS_WO + (size_t)DM * DM * 2;
constexpr size_t WS_W2 = WS_W1 + (size_t)DFF * DM * 2;
constexpr size_t WS_U = WS_W2 + (size_t)DM * DFF * 2;
constexpr size_t WS_P = WS_U + (size_t)NTOK * DM * 2;
constexpr size_t WS_HC = WS_P + (size_t)NTOK * PW * 2;
constexpr size_t WS_MOD = WS_HC + (size_t)NCTX * DM * 4;
constexpr size_t WS_AGG = WS_MOD + (size_t)2 * 9 * 6144 * 4;
constexpr size_t WS_ROPE = WS_AGG + (size_t)NB * 36 * 2 * 2 * 512 * 4;
constexpr size_t WS_DUMMY = WS_ROPE + 2048 * 4;
constexpr size_t WS_BAR = WS_DUMMY + (2u << 20);
constexpr size_t WS_END = WS_BAR + 16384;

struct Params {
    const float *x, *c, *ctx, *c_ctx, *ada_w, *ada_b, *norm1_g, *norm2_g, *w_in, *conv_w, *conv_b, *lru_wa, *lru_ba, *lru_wx, *lru_bx, *lru_lambda,
        *hg_lb, *hg_norm_g, *na_qg, *na_kg, *na_rpb, *w_branch, *w_out, *ffn_w1, *ffn_w2;
    float* out; unsigned char* ws;
};


__device__ __forceinline__ unsigned long long ldkarg(int off) { unsigned long long v = 0;
#if defined(__HIP_DEVICE_COMPILE__)
    auto kp = __builtin_amdgcn_kernarg_segment_ptr();
    asm volatile("s_load_dwordx2 %0, %1, %2\n\ts_waitcnt lgkmcnt(0)" : "=s"(v) : "s"(kp), "s"(off));
#endif
    return v; }
#define PF(f) ((decltype(Params::f))ldkarg((int)__builtin_offsetof(Params, f)))

template <class T> __device__ __forceinline__ T* lnd(T* p) { asm volatile("" : "+v"(p)); return p; }
__device__ __forceinline__ int tid_() { int t = threadIdx.x; asm volatile("" : "+v"(t)); return t; }
__device__ __forceinline__ float bf2f(unsigned v) { return __uint_as_float(v << 16); }
__device__ __forceinline__ float bflo(unsigned w) { return __uint_as_float(w << 16); }
__device__ __forceinline__ float bfhi(unsigned w) { return __uint_as_float(w & 0xffff0000u); }
__device__ __forceinline__ unsigned f2bf(float f) { unsigned u = __float_as_uint(f); u += 0x7fffu + ((u >> 16) & 1u); return u >> 16; }
typedef __bf16 bf16x2_t __attribute__((ext_vector_type(2)));
typedef float f32x2_t __attribute__((ext_vector_type(2)));
__device__ __forceinline__ unsigned pack2(float lo, float hi) { f32x2_t v = {lo, hi}; bf16x2_t b = __builtin_convertvector(v, bf16x2_t); union { bf16x2_t b; unsigned u; } t; t.b = b; return t.u; }
__device__ __forceinline__ float sigmoidf_(float x) { return 1.0f / (1.0f + __expf(-x)); }
__device__ __forceinline__ f32x4 mfma16(bf16x8 a, bf16x8 b, f32x4 c) { return __builtin_amdgcn_mfma_f32_16x16x32_bf16(a, b, c, 0, 0, 0); }
__device__ __forceinline__ bf16x8 as_bf16x8(u32x4 v) { union { u32x4 u; bf16x8 b; } t; t.u = v; return t.b; }
__device__ __forceinline__ void unpack8(u32x4 w, float* o) { o[0] = bflo(w.x); o[1] = bfhi(w.x); o[2] = bflo(w.y); o[3] = bfhi(w.y); o[4] = bflo(w.z); o[5] = bfhi(w.z); o[6] = bflo(w.w); o[7] = bfhi(w.w); }
__device__ __forceinline__ u32x4 pack8(const float* v) { u32x4 w; w.x = pack2(v[0], v[1]); w.y = pack2(v[2], v[3]); w.z = pack2(v[4], v[5]); w.w = pack2(v[6], v[7]); return w; }

namespace pg8 {
constexpr int BM = 256, BK = 64, HALF = 128, HTB = HALF * BK * 2, NXCD = 8, WGM = 8;
__device__ __forceinline__ int lds_byte(int r, int c) { const int st = (r >> 4) * 2 + (c >> 5), rr = r & 15, cc = c & 31, ob = rr * 64 + cc * 2; return st * 1024 + (ob ^ (((ob >> 9) & 1) << 5)); }
__device__ __forceinline__ void stage_rc(int b, int& R, int& C) { const int st = b / 1024, sb = b % 1024, swz = sb ^ (((sb >> 9) & 1) << 5); R = (st >> 1) * 16 + swz / 64; C = (st & 1) * 32 + (swz % 64) / 2; }
__device__ __forceinline__ int perm32(int rho) { const int n = rho >> 4, i = rho & 15; return 8 * (i >> 2) + 4 * n + (i & 3); }

struct Unit { int pm, pn, sub, nt; size_t aoff, boff; };
struct Gemm { const bf16_t* A; const bf16_t* Bt; int lda, ldb, K; };
struct Sched {
    int nM, nN, nwg, G, c, lda, ldb, nt;
    __device__ void init(int M, int N, int G_, int c_, int lda_, int ldb_) { nM = M / BM; nN = N / BM; nwg = nM * nN; G = G_; c = c_; lda = lda_; ldb = ldb_; nt = 0; }
    __device__ bool next(int i, Unit& u) const {
        const long L = (long)i * G + c; if (L >= nwg) return false;
        int wgid = (int)L; { const int q = nwg / NXCD, r = nwg % NXCD, xcd = wgid % NXCD, off = wgid / NXCD; wgid = (xcd < r ? xcd * (q + 1) : r * (q + 1) + (xcd - r) * q) + off; }
        const int nig = WGM * nN, gid = wgid / nig, fm = gid * WGM, gsz = (nM - fm) < WGM ? (nM - fm) : WGM;
        u.pm = fm + ((wgid % nig) % gsz); u.pn = (wgid % nig) / gsz; u.sub = 0; u.nt = nt;
        u.aoff = (size_t)u.pm * BM * lda * 2;
        u.boff = (size_t)u.pn * BM * ldb * 2;
        return true;
    }
};

template <int ACT> struct EpiStore {
    static constexpr bool PERM = true;
    bf16_t* O; int ldc;
    __device__ __forceinline__ void operator()(const f32x4 (&acc)[2][2][4][2], const Unit& u, int wr, int wc, int fr, int fq) const {
        const int row0 = u.pm * BM + wr * 64 + fr; int colt = u.pn * BM;
        if (ACT == 1) colt = (colt < 2048) ? (1024 + colt) : (2048 + colt);
        const int col0 = colt + wc * 32 + 8 * fq;
#pragma unroll
        for (int ai = 0; ai < 2; ++ai)
#pragma unroll
            for (int m = 0; m < 4; ++m) { bf16_t* rowp = lnd(O + (size_t)(row0 + ai * HALF + m * 16) * ldc + col0);
#pragma unroll
                for (int bj = 0; bj < 2; ++bj) { f32x4 v0 = acc[ai][bj][m][0], v1 = acc[ai][bj][m][1];
                    if (ACT == 1) {
#pragma unroll
                        for (int j = 0; j < 4; ++j) { v0[j] = sigmoidf_(v0[j]); v1[j] = sigmoidf_(v1[j]); } }
                    if (ACT == 2) {
#pragma unroll
                        for (int j = 0; j < 4; ++j) { float a = fmaxf(v0[j], 0.f), b = fmaxf(v1[j], 0.f); v0[j] = a * a; v1[j] = b * b; } }
                    u32x4 w; w.x = pack2(v0[0], v0[1]); w.y = pack2(v0[2], v0[3]); w.z = pack2(v1[0], v1[1]); w.w = pack2(v1[2], v1[3]);
                    *(u32x4*)(rowp + bj * HALF) = w; } }
    }
};
struct EpiMerge {
    static constexpr bool PERM = true;
    const bf16_t* P; bf16_t* U;
    __device__ __forceinline__ void operator()(const f32x4 (&acc)[2][2][4][2], const Unit& u, int wr, int wc, int fr, int fq) const {
        const int row0 = u.pm * BM + wr * 64 + fr; const int col0 = u.pn * BM + wc * 32 + 8 * fq;
        const int sub = u.sub; const int gcol = sub * 1024 + u.pn * BM; const int gd = ((gcol < 2048) ? (1024 + gcol) : (2048 + gcol)) + wc * 32 + 8 * fq;
        const bool addp = sub > 0;
#pragma unroll
        for (int ai = 0; ai < 2; ++ai)
#pragma unroll
            for (int m = 0; m < 4; ++m) { const size_t row = (size_t)(row0 + ai * HALF + m * 16); const bf16_t* gp = lnd(P + row * PW + gd); bf16_t* up = lnd(U + row * DM + col0);
#pragma unroll
                for (int bj = 0; bj < 2; ++bj) { const u32x4 gw = *(const u32x4*)(gp + bj * HALF);
                    f32x4 a0 = acc[ai][bj][m][0], a1 = acc[ai][bj][m][1];
                    a0[0] *= bflo(gw.x); a0[1] *= bfhi(gw.x); a0[2] *= bflo(gw.y); a0[3] *= bfhi(gw.y); a1[0] *= bflo(gw.z); a1[1] *= bfhi(gw.z); a1[2] *= bflo(gw.w); a1[3] *= bfhi(gw.w);
                    if (addp) { const u32x4 pw = *(const u32x4*)(up + bj * HALF);
                        a0[0] += bflo(pw.x); a0[1] += bfhi(pw.x); a0[2] += bflo(pw.y); a0[3] += bfhi(pw.y); a1[0] += bflo(pw.z); a1[1] += bfhi(pw.z); a1[2] += bflo(pw.w); a1[3] += bfhi(pw.w); }
                    u32x4 o; o.x = pack2(a0[0], a0[1]); o.y = pack2(a0[2], a0[3]); o.z = pack2(a1[0], a1[1]); o.w = pack2(a1[2], a1[3]);
                    *(u32x4*)(up + bj * HALF) = o; } }
    }
};
struct EpiResid {
    static constexpr bool PERM = true;
    const float* inL; const float* inC; float* outL; float* outC; const float* mod;
    float* slab;
    __device__ __forceinline__ void operator()(const f32x4 (&acc)[2][2][4][2], const Unit& u, int wr, int wc, int fr, int fq) const {
        if (u.sub >= 1) {
            const int row0 = (u.pm - 64) * BM + wr * 64 + fr, col0 = u.pn * BM + wc * 32 + 8 * fq; float* sl = slab + (size_t)(u.sub - 1) * NCTX * DM;
#pragma unroll
            for (int ai = 0; ai < 2; ++ai)
#pragma unroll
                for (int m = 0; m < 4; ++m)
#pragma unroll
                    for (int bj = 0; bj < 2; ++bj) { float* op = lnd(sl + (size_t)(row0 + ai * HALF + m * 16) * DM + col0 + bj * HALF); *(f32x4*)op = acc[ai][bj][m][0]; *(f32x4*)(op + 4) = acc[ai][bj][m][1]; }
            return;
        }
        const bool lat = u.pm < 64; const int rbase = lat ? u.pm * BM : (u.pm - 64) * BM;
        const float* in = lat ? inL : inC; float* out = lat ? outL : outC;
        const int row0 = rbase + wr * 64 + fr, col0 = u.pn * BM + wc * 32 + 8 * fq;
        const float* gt = mod + (size_t)(lat ? (u.pm >> 3) : 8) * 6144 + col0;
#pragma unroll
        for (int bj = 0; bj < 2; ++bj) { const f32x4 g0 = *(const f32x4*)(gt + bj * HALF), g1 = *(const f32x4*)(gt + bj * HALF + 4);
#pragma unroll
            for (int ai = 0; ai < 2; ++ai)
#pragma unroll
                for (int m = 0; m < 4; ++m) { const size_t ro = (size_t)(row0 + ai * HALF + m * 16) * DM + col0 + bj * HALF;
                    const float* ip = lnd(in + ro); float* op = lnd(out + ro); const f32x4 i0 = *(const f32x4*)ip, i1 = *(const f32x4*)(ip + 4);
                    *(f32x4*)op = i0 + g0 * acc[ai][bj][m][0]; *(f32x4*)(op + 4) = i1 + g1 * acc[ai][bj][m][1]; } }
    }
};

struct MergeSched {
    Sched base;
    __device__ bool next(int i, Unit& u) const {
        const int r = i / 3, n = i - 3 * r;
        if (!base.next(r, u)) return false;
        u.sub = n; u.aoff += (size_t)(n == 0 ? C_AG : C_BO + (n - 1) * 512) * 2; u.boff += (size_t)n * DM * 512 * 2;
        return true;
    }
};
struct SplitSched {
    Sched base;
    __device__ bool next(int i, Unit& u) const {
        if (base.next(i, u)) return true;
        const int nfull = (base.nwg - base.c + base.G - 1) / base.G;
        const int k = i - nfull; const int un = k * base.G + base.c; if (k < 0 || un >= 128) return false;
        const int ct = un >> 2, sl = un & 3; u.pm = 64 + (ct >> 2); u.pn = ct & 3; u.sub = 1 + sl; u.nt = 16;
        u.aoff = (size_t)u.pm * BM * base.lda * 2 + (size_t)sl * 1024 * 2; u.boff = (size_t)u.pn * BM * base.ldb * 2 + (size_t)sl * 1024 * 2;
        return true;
    }
};
template <class Epi, class Sch>
__device__ __forceinline__ void gemm_phase(LAS unsigned char* lds, const Gemm g, const Sch& S, const Epi& E) {
    const int tid = tid_(), wid = __builtin_amdgcn_readfirstlane(tid >> 6), lane = tid & 63, wr = wid >> 2, wc = wid & 3, fr = lane & 15, fq = lane >> 4;
    const int K = g.K;
    unsigned voffA[2], voffB[2];
#pragma unroll
    for (int i = 0; i < 2; ++i) { int R, C; stage_rc(tid * 16 + i * 8192, R, C); const int Rb = Epi::PERM ? ((R & ~31) + perm32(R & 31)) : R;
        voffA[i] = (unsigned)(R * g.lda + C) * 2u; voffB[i] = (unsigned)(Rb * g.ldb + C) * 2u; }
    const size_t kstep = (size_t)(BK * 2);
    const size_t hstepA = (size_t)HALF * g.lda * 2, hstepB = (size_t)HALF * g.ldb * 2;
    const unsigned ldsw = (unsigned)wid * 1024u;
    const int aoff = lds_byte(wr * 64 + fr, fq * 8), boff = lds_byte(wc * 32 + fr, fq * 8);
#define PG8_SA(b, h) (((b) * 2 + (h)) * HTB)
#define PG8_SB(b, h) ((4 + (b) * 2 + (h)) * HTB)
#define PG8_STAGE(bufoff, gbase, voff) do { _Pragma("unroll") for (int _i = 0; _i < 2; ++_i) \
        __builtin_amdgcn_global_load_lds((const unsigned*)((const char*)(gbase) + (voff)[_i]), (LAS unsigned*)(lds + (bufoff) + ldsw + _i * 8192), 16, 0, 0); } while (0)
#define PG8_LDA(dst, b, h) do { _Pragma("unroll") for (int m = 0; m < 4; ++m) _Pragma("unroll") for (int k = 0; k < 2; ++k) dst[m][k] = *(const LAS bf16x8*)(lds + PG8_SA(b, h) + aoff + m * 2048 + k * 1024); } while (0)
#define PG8_LDB(dst, b, h) do { _Pragma("unroll") for (int n = 0; n < 2; ++n) _Pragma("unroll") for (int k = 0; k < 2; ++k) dst[n][k] = *(const LAS bf16x8*)(lds + PG8_SB(b, h) + boff + n * 2048 + k * 1024); } while (0)
#define PG8_MMA(ai, bj, At, Bt) do { __builtin_amdgcn_s_setprio(1); _Pragma("unroll") for (int m = 0; m < 4; ++m) _Pragma("unroll") for (int n = 0; n < 2; ++n) _Pragma("unroll") for (int k = 0; k < 2; ++k) \
        acc[ai][bj][m][n] = __builtin_amdgcn_mfma_f32_16x16x32_bf16(Bt[n][k], At[m][k], acc[ai][bj][m][n], 0, 0, 0); __builtin_amdgcn_s_setprio(0); } while (0)
#define PG8_WAIT_V(n) asm volatile("s_waitcnt vmcnt(" #n ")" ::: "memory")
#define PG8_WAIT_L(n) asm volatile("s_waitcnt lgkmcnt(" #n ")" ::: "memory")
#define PG8_BAR __builtin_amdgcn_s_barrier()
#define PG8_SCHED __builtin_amdgcn_sched_barrier(0)
    Unit cur, nxt; int ui = 0;
    if (!S.next(0, cur)) return;
    f32x4 acc[2][2][4][2];
#pragma unroll
    for (int a = 0; a < 2; ++a)
#pragma unroll
        for (int b = 0; b < 2; ++b)
#pragma unroll
            for (int m = 0; m < 4; ++m)
#pragma unroll
                for (int n = 0; n < 2; ++n) acc[a][b][m][n] = (f32x4){0.f, 0.f, 0.f, 0.f};
    bf16x8 At[4][2], B0[2][2], B1[2][2];
    const char* cA = (const char*)g.A + cur.aoff; const char* cB = (const char*)g.Bt + cur.boff;
    PG8_STAGE(PG8_SB(0, 0), cB, voffB); PG8_STAGE(PG8_SA(0, 0), cA, voffA); PG8_STAGE(PG8_SB(0, 1), cB + hstepB, voffB); PG8_STAGE(PG8_SA(0, 1), cA + hstepA, voffA);
    if (wr == 1) PG8_BAR;
    PG8_WAIT_V(4); PG8_BAR;
    PG8_STAGE(PG8_SB(1, 0), cB + kstep, voffB); PG8_STAGE(PG8_SA(1, 0), cA + kstep, voffA); PG8_STAGE(PG8_SB(1, 1), cB + hstepB + kstep, voffB);
    PG8_WAIT_V(6); PG8_BAR;
    for (;;) {
        const bool has_next = S.next(ui + 1, nxt);
        const char* nA = has_next ? (const char*)g.A + nxt.aoff : cA; const char* nB = has_next ? (const char*)g.Bt + nxt.boff : cB;
        const int nt = cur.nt ? cur.nt : K / BK;
        for (int t = 0; t < nt; t += 2) {
            const bool last = (t == nt - 2);
            const char* a1 = cA + (size_t)(t + 1) * kstep;
            const char* a2 = last ? nA : cA + (size_t)(t + 2) * kstep; const char* b2 = last ? nB : cB + (size_t)(t + 2) * kstep;
            const char* a3 = a2 + kstep; const char* b3 = b2 + kstep;
            PG8_LDB(B0, 0, 0); PG8_SCHED; PG8_LDA(At, 0, 0); PG8_STAGE(PG8_SA(1, 1), a1 + hstepA, voffA);
            PG8_WAIT_L(8); PG8_BAR; PG8_WAIT_L(0); PG8_MMA(0, 0, At, B0); PG8_BAR; PG8_SCHED;
            PG8_LDB(B1, 0, 1); PG8_STAGE(PG8_SB(0, 0), b2, voffB);
            PG8_BAR; PG8_WAIT_L(0); PG8_MMA(0, 1, At, B1); PG8_BAR;
            PG8_LDA(At, 0, 1); PG8_STAGE(PG8_SA(0, 0), a2, voffA);
            PG8_BAR; PG8_WAIT_L(0); PG8_MMA(1, 0, At, B0); PG8_BAR; PG8_SCHED;
            PG8_STAGE(PG8_SB(0, 1), b2 + hstepB, voffB);
            PG8_WAIT_V(6); PG8_BAR; PG8_MMA(1, 1, At, B1); PG8_BAR;
            PG8_LDB(B0, 1, 0); PG8_SCHED; PG8_LDA(At, 1, 0); PG8_STAGE(PG8_SA(0, 1), a2 + hstepA, voffA);
            PG8_WAIT_L(8); PG8_BAR; PG8_WAIT_L(0); PG8_MMA(0, 0, At, B0); PG8_BAR; PG8_SCHED;
            PG8_LDB(B1, 1, 1); PG8_STAGE(PG8_SB(1, 0), b3, voffB);
            PG8_BAR; PG8_WAIT_L(0); PG8_MMA(0, 1, At, B1); PG8_BAR;
            PG8_LDA(At, 1, 1); PG8_STAGE(PG8_SA(1, 0), a3, voffA);
            PG8_BAR; PG8_WAIT_L(0); PG8_MMA(1, 0, At, B0); PG8_BAR; PG8_SCHED;
            PG8_STAGE(PG8_SB(1, 1), b3 + hstepB, voffB);
            PG8_WAIT_V(6); PG8_BAR; PG8_MMA(1, 1, At, B1); PG8_BAR;
        }
        E(acc, cur, wr, wc, fr, fq);
        if (!has_next) break;
#pragma unroll
        for (int a = 0; a < 2; ++a)
#pragma unroll
            for (int b = 0; b < 2; ++b)
#pragma unroll
                for (int m = 0; m < 4; ++m)
#pragma unroll
                    for (int n = 0; n < 2; ++n) acc[a][b][m][n] = (f32x4){0.f, 0.f, 0.f, 0.f};
        cur = nxt; cA = nA; cB = nB; ++ui;
    }
    PG8_WAIT_V(0);
    if (wr == 0) PG8_BAR;
    PG8_BAR;
#undef PG8_SA
#undef PG8_SB
#undef PG8_STAGE
#undef PG8_LDA
#undef PG8_LDB
#undef PG8_MMA
#undef PG8_WAIT_V
#undef PG8_WAIT_L
#undef PG8_BAR
#undef PG8_SCHED
}
}


#define XB_TMO      128
#define XB_XCNT(j)  (256  + 64 * (j))
#define XB_XSUB(j)  (1280 + 64 * (j))
#define XB_XGEN(j)  (2304 + 64 * (j))
#define XB_TOP      3328
#define XB_TOPGEN   3392
#define XCD_BAR_WORDS 3456
#define XB_SPIN_CAP (1u << 20)
__device__ __forceinline__ unsigned xb_ld(unsigned* p)              { return __hip_atomic_load(p, __ATOMIC_RELAXED, __HIP_MEMORY_SCOPE_AGENT); }
__device__ __forceinline__ unsigned xb_add(unsigned* p, unsigned v) { return __hip_atomic_fetch_add(p, v, __ATOMIC_RELAXED, __HIP_MEMORY_SCOPE_AGENT); }
__device__ __forceinline__ unsigned xb_xcc_id() { return (unsigned)__builtin_amdgcn_s_getreg((3 << 11) | 20) & 0xFu; }
#define XB_SPIN(cond, bar) do { unsigned _sp = 0; while (cond) { __builtin_amdgcn_s_sleep(1); \
    if ((++_sp & 255u) == 0u) { if (xb_ld(&(bar)[XB_TMO])) break; if (_sp > XB_SPIN_CAP) { atomicAdd(&(bar)[XB_TMO], 1u); break; } } } } while (0)
struct XcdBarrier { unsigned* bar; unsigned x; volatile LAS unsigned* st; };
__device__ __forceinline__ XcdBarrier xcd_barrier_post(unsigned* bar, volatile LAS unsigned* st) {
    XcdBarrier b; b.bar = bar; b.x = xb_xcc_id(); b.st = st;
    if (threadIdx.x == 0) (void)xb_add(&bar[XB_XCNT(b.x)], 1u);
    return b;
}
__device__ __forceinline__ void xcd_barrier_complete(unsigned* bar, unsigned x, unsigned& nloc, unsigned& nx) {
    const unsigned G = gridDim.x * gridDim.y * gridDim.z;
    unsigned sum, cnt, mine, sp = 0u;
    for (;;) {
        sum = 0u; cnt = 0u; mine = 0u;
#pragma unroll
        for (unsigned j = 0; j < 16; ++j) { const unsigned c = xb_ld(&bar[XB_XCNT(j)]); sum += c; cnt += (c > 0u) ? 1u : 0u; mine = (j == x) ? c : mine; }
        if (sum == G) break;
        __builtin_amdgcn_s_sleep(1);
        if ((++sp & 255u) == 0u) { if (xb_ld(&bar[XB_TMO])) break; if (sp > XB_SPIN_CAP) { atomicAdd(&bar[XB_TMO], 1u); break; } }
    }
    nloc = mine > 0u ? mine : 1u; nx = cnt > 0u ? cnt : 1u;
}
__device__ __forceinline__ void xcd_barrier(const XcdBarrier& b) {
    asm volatile("s_waitcnt vmcnt(0)" ::: "memory");
    __syncthreads();
    if (threadIdx.x == 0) {
        unsigned* bar = b.bar;
        __builtin_amdgcn_s_waitcnt(0);
        unsigned nloc = b.st[0], nx = b.st[1];
        if (nloc == 0u) { xcd_barrier_complete(bar, b.x, nloc, nx); b.st[0] = nloc; b.st[1] = nx; }
        const unsigned old = xb_add(&bar[XB_XSUB(b.x)], 1u);
        const unsigned gen = old / nloc;
        if (old + 1u == (gen + 1u) * nloc) {
            __builtin_amdgcn_fence(__ATOMIC_RELEASE, "agent");
            asm volatile("s_waitcnt vmcnt(0)" ::: "memory");
            const unsigned og = xb_add(&bar[XB_TOP], 1u);
            const unsigned tg = og / nx;
            if (og + 1u == (tg + 1u) * nx) xb_add(&bar[XB_TOPGEN], 1u);
            else XB_SPIN(xb_ld(&bar[XB_TOPGEN]) == tg, bar);
            __builtin_amdgcn_fence(__ATOMIC_ACQUIRE, "agent");
            xb_add(&bar[XB_XGEN(b.x)], 1u);
            asm volatile("s_waitcnt vmcnt(0)" ::: "memory");
        } else {
            XB_SPIN(xb_ld(&bar[XB_XGEN(b.x)]) == gen, bar);
            __builtin_amdgcn_fence(__ATOMIC_ACQUIRE, "agent");
            asm volatile("s_waitcnt vmcnt(0)" ::: "memory");
        }
    }
    __syncthreads();
}

__device__ __forceinline__ void sub_barrier(unsigned* word, unsigned n) {
    asm volatile("s_waitcnt vmcnt(0)" ::: "memory");
    __syncthreads();
    if (threadIdx.x == 0) {
        __builtin_amdgcn_fence(__ATOMIC_RELEASE, "agent");
        asm volatile("s_waitcnt vmcnt(0)" ::: "memory");
        xb_add(word, 1u);
        unsigned sp = 0;
        while (xb_ld(word) < n) { __builtin_amdgcn_s_sleep(1); if (++sp > (1u << 22)) break; }
        __builtin_amdgcn_fence(__ATOMIC_ACQUIRE, "agent");
        asm volatile("s_waitcnt vmcnt(0)" ::: "memory");
    }
    __syncthreads();
}

__device__ __forceinline__ void phase_mod(const Params& p, LAS unsigned char* lds) {
    LAS float* sc = (LAS float*)lds;
    LAS float* part = sc + 9 * 1024;
    float* mod = (float*)(PF(ws) + WS_MOD);
    const int tid = tid_(), w = tid >> 6, lane = tid & 63;
    if ((int)blockIdx.x >= 192) return;
    const float* pc = PF(c); const float* pcc = PF(c_ctx); const float* padaw = PF(ada_w); const float* padab = PF(ada_b);
    for (int i = tid; i < 9 * 1024; i += 512) { const int r = i >> 10, k = i & 1023; const float v = (r < 8) ? pc[r * 1024 + k] : pcc[k]; sc[i] = v / (1.0f + expf(-v)); }
    __syncthreads();
    for (int item = blockIdx.x; item < 192; item += gridDim.x) {
        const int l = item / 96, cb = item % 96;
        const float* W = padaw + (size_t)l * 1024 * 6144 + cb * 64 + lane;
        float acc[9];
#pragma unroll
        for (int r = 0; r < 9; ++r) acc[r] = 0.f;
        for (int k = w * 128; k < w * 128 + 128; ++k) { const float wv = W[(size_t)k * 6144];
#pragma unroll
            for (int r = 0; r < 9; ++r) acc[r] += sc[r * 1024 + k] * wv; }
#pragma unroll
        for (int r = 0; r < 9; ++r) part[(w * 9 + r) * 64 + lane] = acc[r];
        __syncthreads();
        for (int i = tid; i < 576; i += 512) { const int r = i >> 6, ln = i & 63; float s = 0.f;
#pragma unroll
            for (int ww = 0; ww < 8; ++ww) s += part[(ww * 9 + r) * 64 + ln];
            mod[(size_t)(l * 9 + r) * 6144 + cb * 64 + ln] = s + padab[l * 6144 + cb * 64 + ln]; }
        __syncthreads();
    }
}
__device__ __forceinline__ void phase_rope(const Params& p) {
    if (blockIdx.x != gridDim.x - 1) return;
    float* rope = (float*)(PF(ws) + WS_ROPE);
    for (int i = tid_(); i < 1024; i += 512) { const int pos = i >> 4, fi = i & 15; const float invf = powf(10000.0f, -(float)fi / 16.0f); const float ang = (float)pos * invf; rope[i] = cosf(ang); rope[1024 + i] = sinf(ang); }
}
__device__ __forceinline__ void convert_tile(const float* src, int K, int N, bf16_t* dst, int tile, LAS bf16_t* T) {
    const int tid = tid_(), tilesN = N >> 7, tk = tile / tilesN, tn = tile - tk * tilesN, k0 = tk * 128, n0 = tn * 128;
    const int r = tid >> 4, c8 = (tid & 15) * 8;
    f32x4 a[4], b[4];
#pragma unroll
    for (int i = 0; i < 4; ++i) { const float* s = src + (size_t)(k0 + r + 32 * i) * N + n0 + c8; a[i] = *(const f32x4*)s; b[i] = *(const f32x4*)(s + 4); }
#pragma unroll
    for (int i = 0; i < 4; ++i)
#pragma unroll
        for (int j = 0; j < 4; ++j) { T[(c8 + j) * 136 + r + 32 * i] = (bf16_t)f2bf(a[i][j]); T[(c8 + 4 + j) * 136 + r + 32 * i] = (bf16_t)f2bf(b[i][j]); }
    __syncthreads();
    const int n = tid >> 2, ks = (tid & 3) * 8;
#pragma unroll
    for (int i = 0; i < 4; ++i) { const u32x4 v = *(const LAS u32x4*)(T + n * 136 + ks + 32 * i); *(u32x4*)(dst + (size_t)(n0 + n) * K + k0 + ks + 32 * i) = v; }
    __syncthreads();
}
__device__ __forceinline__ void phase_convert(const Params& p, int l, LAS unsigned char* lds) {
    LAS bf16_t* T = (LAS bf16_t*)lds;
    bf16_t* WIN = (bf16_t*)(PF(ws) + WS_WIN); bf16_t* WB = (bf16_t*)(PF(ws) + WS_WB); bf16_t* WO = (bf16_t*)(PF(ws) + WS_WO); bf16_t* W1 = (bf16_t*)(PF(ws) + WS_W1); bf16_t* W2 = (bf16_t*)(PF(ws) + WS_W2);
    for (int it = blockIdx.x; it < 1184; it += gridDim.x) {
        if (it < 512) convert_tile(PF(w_in) + (size_t)l * DM * DIN, DM, DIN, WIN, it, T);
        else if (it < 608) { const int n = (it - 512) / 32, tl = (it - 512) % 32; convert_tile(PF(w_branch) + (size_t)(l * 3 + n) * 512 * DM, 512, DM, WB + (size_t)n * DM * 512, tl, T); }
        else if (it < 672) convert_tile(PF(w_out) + (size_t)l * DM * DM, DM, DM, WO, it - 608, T);
        else if (it < 928) convert_tile(PF(ffn_w1) + (size_t)l * DM * DFF, DM, DFF, W1, it - 672, T);
        else convert_tile(PF(ffn_w2) + (size_t)l * DFF * DM, DFF, DM, W2, it - 928, T);
    }
}
__device__ __forceinline__ void phase_norm(const Params& p, int l, const float* hlat, const float* hctx, const float* g, int modoff, int nrows, const float* slab = nullptr, const float* slabgate = nullptr) {
    const int tid = tid_(); const int w = tid >> 6, lane = tid & 63;
    bf16_t* U = (bf16_t*)(PF(ws) + WS_U); const float* mod = (const float*)(PF(ws) + WS_MOD);
    for (int row = blockIdx.x * 8 + w; row < nrows; row += gridDim.x * 8) {
        const float* src = row < NLAT ? hlat + (size_t)row * DM : hctx + (size_t)(row - NLAT) * DM;
        const int mr = row < NLAT ? (row >> 11) : 8;
        const float* md = mod + (size_t)(l * 9 + mr) * 6144 + modoff;
        f32x4 v[4]; float ss = 0.f;
#pragma unroll
        for (int i = 0; i < 4; ++i) { v[i] = *(const f32x4*)(src + i * 256 + lane * 4);
            if (slab != nullptr && row >= NLAT) { const size_t o = (size_t)(row - NLAT) * DM + i * 256 + lane * 4; const f32x4 gg = *(const f32x4*)(slabgate + i * 256 + lane * 4);
                const f32x4 s4 = (*(const f32x4*)(slab + o) + *(const f32x4*)(slab + o + (size_t)NCTX * DM)) + (*(const f32x4*)(slab + o + (size_t)2 * NCTX * DM) + *(const f32x4*)(slab + o + (size_t)3 * NCTX * DM));
                v[i] += gg * s4; }
            ss += v[i][0] * v[i][0] + v[i][1] * v[i][1] + v[i][2] * v[i][2] + v[i][3] * v[i][3]; }
#pragma unroll
        for (int o = 32; o >= 1; o >>= 1) ss += __shfl_xor(ss, o);
        const float rstd = rsqrtf(ss * (1.0f / 1024.0f) + 1e-6f);
#pragma unroll
        for (int i = 0; i < 4; ++i) { const int cidx = i * 256 + lane * 4; const f32x4 gg = *(const f32x4*)(g + cidx), sh = *(const f32x4*)(md + cidx), scv = *(const f32x4*)(md + 1024 + cidx);
            float o4[4];
#pragma unroll
            for (int j = 0; j < 4; ++j) o4[j] = (v[i][j] * rstd * gg[j]) * (1.0f + scv[j]) + sh[j];
            u32x2 wv; wv.x = pack2(o4[0], o4[1]); wv.y = pack2(o4[2], o4[3]);
            *(u32x2*)(U + (size_t)row * DM + cidx) = wv; }
    }
}
__device__ __forceinline__ void phase_hg_final(const Params& p, int l, int nrows, int wg, int nwg) {
    const int tid = tid_(); const int w = tid >> 6, lane = tid & 63; bf16_t* P = (bf16_t*)(PF(ws) + WS_P);
    const int hd = lane >> 4, e8 = (lane & 15) * 8; const float* png = PF(hg_norm_g);
    float ng[8];
#pragma unroll
    for (int i = 0; i < 8; ++i) ng[i] = png[l * 128 + e8 + i];
    for (int row = wg * 8 + w; row < nrows; row += nwg * 8) {
        bf16_t* rp = P + (size_t)row * PW;
        float a[8], b[8], og[8]; unpack8(*(const u32x4*)(rp + C_BF + hd * 128 + e8), a); unpack8(*(const u32x4*)(rp + C_BF + 512 + hd * 128 + e8), b); unpack8(*(const u32x4*)(rp + C_BO + hd * 128 + e8), og);
        float ss = 0.f;
#pragma unroll
        for (int i = 0; i < 8; ++i) { a[i] += b[i]; ss += a[i] * a[i]; }
        ss += __shfl_xor(ss, 1); ss += __shfl_xor(ss, 2); ss += __shfl_xor(ss, 4); ss += __shfl_xor(ss, 8);
        const float rstd = rsqrtf(ss * (1.0f / 128.0f) + 1e-6f);
        float y[8];
#pragma unroll
        for (int i = 0; i < 8; ++i) y[i] = a[i] * rstd * ng[i] * sigmoidf_(og[i]);
        *(u32x4*)(rp + C_BO + hd * 128 + e8) = pack8(y);
    }
}

__device__ __forceinline__ size_t agg_idx(int b, int gch, int dir, int which, int ch) { return ((((size_t)b * 36 + gch) * 2 + dir) * 2 + which) * 512 + ch; }
__device__ __forceinline__ float gelu_tanh(float x) { const float u = 0.7978845608028654f * (x + 0.044715f * x * x * x); const float th = 1.0f - 2.0f / (1.0f + __expf(2.0f * u)); return 0.5f * x * (1.0f + th); }
__device__ __forceinline__ void lru_tile(const Params& p, int l, LAS unsigned char* lds, int item, int mode, int& staged_nb) {
    LAS bf16_t* Wl = (LAS bf16_t*)lds;
    LAS bf16_t* Xb = Wl + 256 * 72;
    LAS float* Xf = (LAS float*)(lds + 46080);
    LAS float* Av = Xf + 4096;
    LAS float* Bv = Av + 8192;
    bf16_t* P = (bf16_t*)(PF(ws) + WS_P); float* AGG = (float*)(PF(ws) + WS_AGG);
    const int tid = tid_(), w = tid >> 6, lane = tid & 63, l16 = lane & 15, q4 = lane >> 4;
    const int nb = item & 7, rest = item >> 3, gch = rest % 36, b = rest / 36;
    const bool isctx = gch < 4; const int chunk = isctx ? gch : gch - 4, L = isctx ? CTXL : SEQ;
    const size_t seqrow0 = isctx ? (size_t)NLAT + b * CTXL : (size_t)b * SEQ; const int t0 = chunk * 64;
    if (staged_nb != nb) { const float* pwx = PF(lru_wx); const float* pwa = PF(lru_wa);
        for (int e = tid; e < 4 * 64 * 64; e += 512) { const int mat = e >> 12, i = (e >> 6) & 63, c = e & 63; const int dir = mat >> 1, kind = mat & 1;
            const float* W = kind ? pwx : pwa; const float v = W[((size_t)((l * 2 + dir) * 8 + nb) * 64 + i) * 64 + c];
            const int op = dir * 128 + (c >> 4) * 32 + kind * 16 + (c & 15);
            Wl[op * 72 + i] = (bf16_t)f2bf(v); }
        staged_nb = nb;
    }
    {
        const int t = tid >> 3, c8 = (tid & 7) * 8, ch = nb * 64 + c8, tt = t0 + t;
        float a8[8]; const float* pcb = PF(conv_b); const float* pcw = PF(conv_w);
        { const f32x4 b0 = *(const f32x4*)(pcb + l * 512 + ch), b1 = *(const f32x4*)(pcb + l * 512 + ch + 4);
#pragma unroll
          for (int i = 0; i < 4; ++i) { a8[i] = b0[i]; a8[4 + i] = b1[i]; } }
#pragma unroll
        for (int j = 0; j < 4; ++j) { const int ts = tt + j - 2;
            if (ts >= 0 && ts < L) { float xv[8]; unpack8(*(const u32x4*)(P + (seqrow0 + ts) * PW + C_AX + ch), xv);
                const f32x4 w0 = *(const f32x4*)(pcw + (l * 4 + j) * 512 + ch), w1 = *(const f32x4*)(pcw + (l * 4 + j) * 512 + ch + 4);
#pragma unroll
                for (int i = 0; i < 4; ++i) { a8[i] += xv[i] * w0[i]; a8[4 + i] += xv[4 + i] * w1[i]; } } }
#pragma unroll
        for (int i = 0; i < 8; ++i) Xf[t * 64 + c8 + i] = a8[i];
        *(LAS u32x4*)(Xb + t * 72 + c8) = pack8(a8);
    }
    __syncthreads();
    {
        const int dir = w >> 2, c = (w & 3) * 16 + l16, ch = nb * 64 + c;
        f32x4 acc[4][2];
#pragma unroll
        for (int mg = 0; mg < 4; ++mg) { acc[mg][0] = (f32x4){0.f, 0.f, 0.f, 0.f}; acc[mg][1] = (f32x4){0.f, 0.f, 0.f, 0.f}; }
#pragma unroll
        for (int ks = 0; ks < 2; ++ks) {
            const bf16x8 B0 = *(const LAS bf16x8*)(Wl + (w * 32 + l16) * 72 + ks * 32 + q4 * 8), B1 = *(const LAS bf16x8*)(Wl + (w * 32 + 16 + l16) * 72 + ks * 32 + q4 * 8);
#pragma unroll
            for (int mg = 0; mg < 4; ++mg) { const bf16x8 A = *(const LAS bf16x8*)(Xb + (mg * 16 + l16) * 72 + ks * 32 + q4 * 8);
                acc[mg][0] = mfma16(A, B0, acc[mg][0]); acc[mg][1] = mfma16(A, B1, acc[mg][1]); }
        }
        const float ba = PF(lru_ba)[(l * 2 + dir) * 512 + ch], bx = PF(lru_bx)[(l * 2 + dir) * 512 + ch], lam = PF(lru_lambda)[(l * 2 + dir) * 512 + ch];
        const float sp = log1pf(expf(-lam));
#pragma unroll
        for (int mg = 0; mg < 4; ++mg)
#pragma unroll
            for (int j = 0; j < 4; ++j) { const int t = mg * 16 + q4 * 4 + j;
                const float ea = 1.0f + __expf(-(acc[mg][0][j] + ba)), ex = 1.0f + __expf(-(acc[mg][1][j] + bx)); const float inv = __builtin_amdgcn_rcpf(ea * ex);
                const float r = inv * ex, ig = inv * ea;
                const float la = -8.0f * r * sp; const float a = __expf(la); const float x2 = 2.0f * la;
                float om = -x2 * (1.0f + x2 * (0.5f + x2 * (0.16666667f + x2 * (0.041666668f + x2 * 0.0083333338f))));
                if (x2 < -0.35f) om = 1.0f - a * a;
                const float bb = sqrtf(fmaxf(om, 0.f)) * ig * Xf[t * 64 + c];
                Av[(dir * 64 + t) * 64 + c] = a; Bv[(dir * 64 + t) * 64 + c] = bb; }
    }
    __syncthreads();
    {
        LAS float* SegA = Xf;
        LAS float* SegB = Xf + 512;
        const int d2 = tid >> 8, seg = (tid >> 6) & 3, c = tid & 63, ch = nb * 64 + c;
        float av[16], bv[16];
#pragma unroll
        for (int k = 0; k < 16; ++k) { const int s = seg * 16 + k; const int t = d2 ? 63 - s : s; const int ix = (d2 * 64 + t) * 64 + c; av[k] = Av[ix]; bv[k] = Bv[ix]; }
        float h = 0.f, ap = 1.f;
#pragma unroll
        for (int k = 0; k < 16; ++k) { h = av[k] * h + bv[k]; ap *= av[k]; }
        SegA[(d2 * 4 + seg) * 64 + c] = ap; SegB[(d2 * 4 + seg) * 64 + c] = h;
        float hin = 0.f;
        if (mode == 1) {
            if (d2 == 0) { for (int g = 0; g < gch; ++g) hin = AGG[agg_idx(b, g, 0, 0, ch)] * hin + AGG[agg_idx(b, g, 0, 1, ch)]; }
            else {
                if (gch < 4) { for (int g = 3; g > gch; --g) hin = AGG[agg_idx(b, g, 1, 0, ch)] * hin + AGG[agg_idx(b, g, 1, 1, ch)]; }
                else { for (int g = 3; g >= 0; --g) hin = AGG[agg_idx(b, g, 1, 0, ch)] * hin + AGG[agg_idx(b, g, 1, 1, ch)];
                       for (int g = 35; g > gch; --g) hin = AGG[agg_idx(b, g, 1, 0, ch)] * hin + AGG[agg_idx(b, g, 1, 1, ch)]; }
            }
        }
        __syncthreads();
        if (mode == 0) {
            if (seg == 3) { float A = 1.f, B = 0.f;
#pragma unroll
                for (int s2 = 0; s2 < 4; ++s2) { const float sa = SegA[(d2 * 4 + s2) * 64 + c], sb2 = SegB[(d2 * 4 + s2) * 64 + c]; B = sa * B + sb2; A *= sa; }
                AGG[agg_idx(b, gch, d2, 0, ch)] = A; AGG[agg_idx(b, gch, d2, 1, ch)] = B; }
        } else {
#pragma unroll
            for (int s2 = 0; s2 < 3; ++s2) if (s2 < seg) hin = SegA[(d2 * 4 + s2) * 64 + c] * hin + SegB[(d2 * 4 + s2) * 64 + c];
            float hh2 = hin;
#pragma unroll
            for (int k = 0; k < 16; ++k) { const int s = seg * 16 + k; const int t = d2 ? 63 - s : s; hh2 = av[k] * hh2 + bv[k]; Bv[(d2 * 64 + t) * 64 + c] = hh2; }
        }
    }
    __syncthreads();
    if (mode == 1) {
        const int t = tid >> 3, c8 = (tid & 7) * 8; bf16_t* gp = P + (seqrow0 + t0 + t) * PW + C_AG + nb * 64 + c8;
        float gt[8]; unpack8(*(const u32x4*)gp, gt); float y[8];
#pragma unroll
        for (int i = 0; i < 8; ++i) y[i] = (Bv[t * 64 + c8 + i] + Bv[(64 + t) * 64 + c8 + i]) * gelu_tanh(gt[i]);
        *(u32x4*)gp = pack8(y);
        __syncthreads();
    }
}

__device__ __forceinline__ void attn_item(const Params& p, int l, LAS unsigned char* lds, int item, int dry = 0) {
    LAS bf16_t* Kt = (LAS bf16_t*)lds;
    LAS bf16_t* Vt = Kt + 2 * 64 * 72;
    LAS float* rpbL = (LAS float*)(lds + 36864);
    LAS float* cosT = rpbL + 960;
    LAS float* sinT = cosT + 1024;
    LAS float* gq = sinT + 1024; LAS float* gk = gq + 64;
    bf16_t* P = (bf16_t*)(PF(ws) + WS_P); const float* rope = (const float*)(PF(ws) + WS_ROPE);
    const int tid = tid_(), w = __builtin_amdgcn_readfirstlane(tid >> 6), lane = tid & 63, l16 = lane & 15, q4 = lane >> 4, hh = w >> 2, qg4 = w & 3;
    const bool isctx = item >= 512;
    int b, hp, nloc, krU; int rq[2], kq0[2]; size_t qrow0[2];
    if (!isctx) { hp = item & 3; const int rp = (item >> 2) & 15; b = item >> 6;
        rq[0] = 2 * rp; rq[1] = 2 * rp + 1; kq0[0] = min(max(rq[0] - 4, 0), 24); kq0[1] = min(max(rq[1] - 4, 0), 24);
        qrow0[0] = (size_t)b * SEQ + rq[0] * 64; qrow0[1] = qrow0[0] + 64; krU = kq0[0]; nloc = kq0[1] + 8 - kq0[0]; }
    else { const int it = item - 512; hp = it & 3; const int qt = (it >> 2) & 1; b = it >> 3; rq[0] = rq[1] = 0; kq0[0] = kq0[1] = 0; krU = 0; nloc = 0;
        qrow0[0] = (size_t)NLAT + b * CTXL + qt * 128; qrow0[1] = qrow0[0] + 64; }
    const int h = hp * 2 + hh;
    const float* prpb = PF(na_rpb);
    for (int i = tid; i < 2 * 465; i += 512) { const int h2 = i / 465, j = i - h2 * 465; rpbL[h2 * 480 + j] = prpb[(size_t)((l * 8 + hp * 2 + h2) * 465) + j]; }
    for (int i = tid; i < 1024; i += 512) { cosT[i] = rope[i]; sinT[i] = rope[1024 + i]; }
    if (tid < 64) { gq[tid] = PF(na_qg)[l * 64 + tid]; gk[tid] = PF(na_kg)[l * 64 + tid]; }
    __syncthreads();
    const int qc = qg4 * 16 + l16;
    const int glo = qg4 < 2 ? 0 : qg4 - 1, ghi = qg4 == 0 ? 1 : (qg4 == 3 ? 3 : qg4 + 1);
    int bidx[4][4]; unsigned mbits = 0u;
    { const int cs0 = min(max(qc - 8, 0), 48);
#pragma unroll
      for (int g = 0; g < 4; ++g)
#pragma unroll
          for (int j = 0; j < 4; ++j) { const int kc = g * 16 + q4 * 4 + j; bidx[g][j] = hh * 480 + min(max(kc - qc, -15), 15) + 15; if (kc < cs0 || kc >= cs0 + 16) mbits |= 1u << (g * 4 + j); } }
    bf16x8 qpl[2][2], qrt[2][2];
#pragma unroll
    for (int qi = 0; qi < 2; ++qi) {
        const bf16_t* qp = P + (qrow0[qi] + qc) * PW + C_CQ + h * 64;
        float xq[16]; unpack8(*(const u32x4*)(qp + q4 * 8), xq); unpack8(*(const u32x4*)(qp + 32 + q4 * 8), xq + 8);
        float ss = 0.f;
#pragma unroll
        for (int i = 0; i < 16; ++i) ss += xq[i] * xq[i];
        ss += __shfl_xor(ss, 16); ss += __shfl_xor(ss, 32);
        const float rs = rsqrtf(ss * (1.0f / 64.0f) + 1e-6f) * 0.125f;
#pragma unroll
        for (int i = 0; i < 8; ++i) { xq[i] *= rs * gq[q4 * 8 + i]; xq[8 + i] *= rs * gq[32 + q4 * 8 + i]; }
        qpl[qi][0] = as_bf16x8(pack8(xq)); qpl[qi][1] = as_bf16x8(pack8(xq + 8));
        float xr[16];
#pragma unroll
        for (int ks = 0; ks < 2; ++ks) { const int pos = ks == 0 ? rq[qi] : qc;
#pragma unroll
            for (int jj = 0; jj < 8; ++jj) { const int fi = (q4 & 1) * 8 + jj; const float cs = cosT[pos * 16 + fi], sn = sinT[pos * 16 + fi]; const float xv = xq[ks * 8 + jj]; const float pr = __shfl_xor(xv, 32);
                xr[ks * 8 + jj] = (q4 < 2) ? (xv * cs - pr * sn) : (xv * cs + pr * sn); } }
        qrt[qi][0] = as_bf16x8(pack8(xr)); qrt[qi][1] = as_bf16x8(pack8(xr + 8));
    }
    f32x4 O[2][4];
#pragma unroll
    for (int qi = 0; qi < 2; ++qi)
#pragma unroll
        for (int i = 0; i < 4; ++i) O[qi][i] = (f32x4){0.f, 0.f, 0.f, 0.f};
    float mrun[2] = {-1e30f, -1e30f}, lsum[2] = {0.f, 0.f};
    const int pf_hh2 = tid >> 8, pf_h2 = hp * 2 + pf_hh2, pf_key = (tid & 255) >> 2, pf_seg = tid & 3, pf_vseg = (tid & 255) >> 6, pf_vkey = tid & 63;
    u32x4 pk0, pk1, pv0, pv1;
    { const size_t r0 = nloc ? (size_t)b * SEQ + krU * 64 : (size_t)NLAT + b * CTXL;
      const bf16_t* kp = P + (r0 + pf_key) * PW + C_CK + pf_h2 * 64 + pf_seg * 16; pk0 = *(const u32x4*)kp; pk1 = *(const u32x4*)(kp + 8);
      const bf16_t* vp = P + (r0 + pf_vkey) * PW + C_CV + pf_h2 * 64 + pf_vseg * 16; pv0 = *(const u32x4*)vp; pv1 = *(const u32x4*)(vp + 8); }
    const int ntot = nloc + 4; int Tn = 0;
#pragma unroll
    for (int ph = 0; ph < 2; ++ph) {
    const bool loc = (ph == 0); const int ntile = loc ? nloc : 4;
    for (int kt = 0; kt < ntile; ++kt) {
        const int kr = krU + kt; ++Tn;
        {
            const int hh2 = pf_hh2, key = pf_key, seg = pf_seg;
            float xk[16]; unpack8(pk0, xk); unpack8(pk1, xk + 8);
            float ss = 0.f;
#pragma unroll
            for (int i = 0; i < 16; ++i) ss += xk[i] * xk[i];
            ss += __shfl_xor(ss, 1); ss += __shfl_xor(ss, 2);
            const float rs = rsqrtf(ss * (1.0f / 64.0f) + 1e-6f);
#pragma unroll
            for (int i = 0; i < 16; ++i) xk[i] *= rs * gk[seg * 16 + i];
            if (loc) { const int pos = seg < 2 ? kr : key;
#pragma unroll
                for (int i = 0; i < 16; ++i) { const float pr = __shfl_xor(xk[i], 1); const float cs = cosT[pos * 16 + i], sn = sinT[pos * 16 + i]; xk[i] = (seg & 1) ? (xk[i] * cs + pr * sn) : (xk[i] * cs - pr * sn); } }
            LAS bf16_t* kd = Kt + (hh2 * 64 + key) * 72 + seg * 16;
            *(LAS u32x4*)kd = pack8(xk); *(LAS u32x4*)(kd + 8) = pack8(xk + 8);
        }
        {
            const int hh2 = pf_hh2, seg = pf_vseg, key = pf_vkey;
            const u32x4 a = pv0, c = pv1;
            LAS bf16_t* vd = Vt + (hh2 * 64 + seg * 16) * 72 + key;
            vd[0 * 72] = (bf16_t)(a.x & 0xffff); vd[1 * 72] = (bf16_t)(a.x >> 16); vd[2 * 72] = (bf16_t)(a.y & 0xffff); vd[3 * 72] = (bf16_t)(a.y >> 16);
            vd[4 * 72] = (bf16_t)(a.z & 0xffff); vd[5 * 72] = (bf16_t)(a.z >> 16); vd[6 * 72] = (bf16_t)(a.w & 0xffff); vd[7 * 72] = (bf16_t)(a.w >> 16);
            vd[8 * 72] = (bf16_t)(c.x & 0xffff); vd[9 * 72] = (bf16_t)(c.x >> 16); vd[10 * 72] = (bf16_t)(c.y & 0xffff); vd[11 * 72] = (bf16_t)(c.y >> 16);
            vd[12 * 72] = (bf16_t)(c.z & 0xffff); vd[13 * 72] = (bf16_t)(c.z >> 16); vd[14 * 72] = (bf16_t)(c.w & 0xffff); vd[15 * 72] = (bf16_t)(c.w >> 16);
        }
        if (Tn < ntot) { const size_t r0 = (Tn < nloc) ? (size_t)b * SEQ + (krU + Tn) * 64 : (size_t)NLAT + b * CTXL + (Tn - nloc) * 64;
            const bf16_t* kp = P + (r0 + pf_key) * PW + C_CK + pf_h2 * 64 + pf_seg * 16; pk0 = *(const u32x4*)kp; pk1 = *(const u32x4*)(kp + 8);
            const bf16_t* vp = P + (r0 + pf_vkey) * PW + C_CV + pf_h2 * 64 + pf_vseg * 16; pv0 = *(const u32x4*)vp; pv1 = *(const u32x4*)(vp + 8); }
        __syncthreads();
#pragma unroll
        for (int qi = 0; qi < 2; ++qi) {
            if (loc && (kr < kq0[qi] || kr >= kq0[qi] + 8)) continue;
            f32x4 st[4];
#pragma unroll
            for (int g = 0; g < 4; ++g) { const bool use = !loc || (g >= glo && g <= ghi);
                st[g] = (f32x4){0.f, 0.f, 0.f, 0.f};
                if (use) {
#pragma unroll
                    for (int ks = 0; ks < 2; ++ks) st[g] = mfma16(*(const LAS bf16x8*)(Kt + (hh * 64 + g * 16 + l16) * 72 + ks * 32 + q4 * 8), loc ? qrt[qi][ks] : qpl[qi][ks], st[g]);
                    if (loc) { const int dr31 = (kr - rq[qi] + 7) * 31;
#pragma unroll
                        for (int j = 0; j < 4; ++j) { const float sv = st[g][j] + rpbL[bidx[g][j] + dr31]; st[g][j] = ((mbits >> (g * 4 + j)) & 1u) ? -1e30f : sv; } }
                } else st[g] = (f32x4){-1e30f, -1e30f, -1e30f, -1e30f};
            }
            float tmax = -1e30f;
#pragma unroll
            for (int g = 0; g < 4; ++g)
#pragma unroll
                for (int j = 0; j < 4; ++j) tmax = fmaxf(tmax, st[g][j]);
            tmax = fmaxf(tmax, __shfl_xor(tmax, 16)); tmax = fmaxf(tmax, __shfl_xor(tmax, 32));
            const float mnew = fmaxf(mrun[qi], tmax); const float alpha = __expf(mrun[qi] - mnew); mrun[qi] = mnew;
            float psum = 0.f;
#pragma unroll
            for (int g = 0; g < 4; ++g) { const bool use = !loc || (g >= glo && g <= ghi);
                if (use) {
#pragma unroll
                    for (int j = 0; j < 4; ++j) { const float pv = __expf(st[g][j] - mnew); st[g][j] = pv; psum += pv; }
                } else st[g] = (f32x4){0.f, 0.f, 0.f, 0.f}; }
            lsum[qi] = lsum[qi] * alpha + psum;
#pragma unroll
            for (int i = 0; i < 4; ++i) O[qi][i] *= alpha;
            bf16x8 pb[2];
#pragma unroll
            for (int ks = 0; ks < 2; ++ks) { u32x4 wv; wv.x = pack2(st[2 * ks][0], st[2 * ks][1]); wv.y = pack2(st[2 * ks][2], st[2 * ks][3]); wv.z = pack2(st[2 * ks + 1][0], st[2 * ks + 1][1]); wv.w = pack2(st[2 * ks + 1][2], st[2 * ks + 1][3]); pb[ks] = as_bf16x8(wv); }
#pragma unroll
            for (int ks = 0; ks < 2; ++ks) if (!loc || (2 * ks + 1 >= glo && 2 * ks <= ghi))
#pragma unroll
                for (int dg = 0; dg < 4; ++dg) { const LAS bf16_t* vr = Vt + (hh * 64 + dg * 16 + l16) * 72 + ks * 32 + q4 * 4;
                    const u32x2 lo = *(const LAS u32x2*)vr, hi = *(const LAS u32x2*)(vr + 16); u32x4 av; av.x = lo.x; av.y = lo.y; av.z = hi.x; av.w = hi.y;
                    O[qi][dg] = mfma16(as_bf16x8(av), pb[ks], O[qi][dg]); }
        }
        __syncthreads();
    }
    }
#pragma unroll
    for (int qi = 0; qi < 2; ++qi) {
        float ls = lsum[qi]; ls += __shfl_xor(ls, 16); ls += __shfl_xor(ls, 32);
        const float inv = 1.0f / ls;
        bf16_t* op = dry ? ((bf16_t*)(PF(ws) + WS_DUMMY) + (size_t)(blockIdx.x & 63) * 16384 + (size_t)((qi * 8 + w) * 16 + l16) * 64) : (P + (qrow0[qi] + qc) * PW + C_CQ + h * 64);
#pragma unroll
        for (int dg = 0; dg < 4; ++dg) { u32x2 wv; wv.x = pack2(O[qi][dg][0] * inv, O[qi][dg][1] * inv); wv.y = pack2(O[qi][dg][2] * inv, O[qi][dg][3] * inv); *(u32x2*)(op + dg * 16 + q4 * 4) = wv; }
    }
    __syncthreads();
}

__device__ __forceinline__ void hgrn_stage(const bf16_t* P, LAS unsigned char* lds, int w, int lane, size_t row0, int dir, int h) {
#pragma unroll
    for (int i = 0; i < 2; ++i) { const int blk = i * 8 + w; const int t = blk * 4 + (lane >> 4); const bf16_t* rp = P + (row0 + (dir ? 63 - t : t)) * PW + (lane & 15) * 8;
        __builtin_amdgcn_global_load_lds((const unsigned*)(rp + C_BQ + h * 128), (LAS unsigned*)(lds + 118784 + blk * 1024), 16, 0, 0);
        __builtin_amdgcn_global_load_lds((const unsigned*)(rp + C_BF + dir * 512 + h * 128), (LAS unsigned*)(lds + 135168 + blk * 1024), 16, 0, 0); }
}
__device__ __forceinline__ void hgrn_chain(const Params& p, int l, LAS unsigned char* lds, int chain, int dry = 0) {
    LAS bf16_t* Q0 = (LAS bf16_t*)lds;
    LAS bf16_t* KP = (LAS bf16_t*)(lds + 17408);
    LAS bf16_t* SB = (LAS bf16_t*)(lds + 34816);
    LAS bf16_t* KDT = (LAS bf16_t*)(lds + 69632);
    LAS bf16_t* VT = (LAS bf16_t*)(lds + 88064);
    LAS bf16_t* ATT = (LAS bf16_t*)(lds + 106496);
    LAS float* TOT = (LAS float*)(lds + 115712);
    LAS float* DD = (LAS float*)(lds + 117760);
    const LAS bf16_t* SQ = (const LAS bf16_t*)(lds + 118784);
    const LAS bf16_t* SF = (const LAS bf16_t*)(lds + 135168);
    bf16_t* P = (bf16_t*)(PF(ws) + WS_P);
    const int tid = tid_(), w = __builtin_amdgcn_readfirstlane(tid >> 6), lane = tid & 63, l16 = lane & 15, q4 = lane >> 4;
    const int dir = chain & 1, h = (chain >> 1) & 3, b = chain >> 3;
    const int d = tid & 127, sb = tid >> 7;
    float lbv = 0.f;
    if (l > 0) { const float x0 = PF(hg_lb)[(dir * 2 + 0) * 512 + h * 128 + d], x1 = PF(hg_lb)[(dir * 2 + 1) * 512 + h * 128 + d]; lbv = 1.0f / (1.0f + expf(x0 - x1)); }
    for (int i = tid; i < 64 * 72 / 2; i += 512) ((LAS unsigned*)ATT)[i] = 0u;
    f32x4 S[8];
#pragma unroll
    for (int i = 0; i < 8; ++i) S[i] = (f32x4){0.f, 0.f, 0.f, 0.f};
    { const int gch0 = dir == 0 ? 0 : 3; hgrn_stage(P, lds, w, lane, (size_t)NLAT + b * CTXL + gch0 * 64, dir, h); }
    asm volatile("s_waitcnt vmcnt(0)" ::: "memory");
    __syncthreads();
    for (int ci = 0; ci < 36; ++ci) {
        const int gch = dir == 0 ? ci : (ci < 4 ? 3 - ci : 39 - ci);
        const bool isctx = gch < 4; const int chunk = isctx ? gch : gch - 4;
        const size_t row0 = isctx ? (size_t)NLAT + b * CTXL + chunk * 64 : (size_t)b * SEQ + chunk * 64;
        float bl[16], qv[16], kv[16]; float run = 0.f;
        {
            unsigned vraw[16];
#pragma unroll
            for (int ii = 0; ii < 16; ++ii) { const int t = sb * 16 + ii; vraw[ii] = P[(row0 + (dir ? 63 - t : t)) * PW + C_BI + h * 128 + d]; }
#pragma unroll
            for (int eg = 0; eg < 8; ++eg) { u32x2 wv; wv.x = pack2(S[eg][0], S[eg][1]); wv.y = pack2(S[eg][2], S[eg][3]); *(LAS u32x2*)(SB + (eg * 16 + l16) * 136 + w * 16 + q4 * 4) = wv; }
#pragma unroll
            for (int ii = 0; ii < 16; ++ii) { const int t = sb * 16 + ii;
                const float fr = bf2f(SF[t * 128 + d]), qr = bf2f(SQ[t * 128 + d]);
                const float sg = 1.0f / (1.0f + __expf(-fr)); const float f = lbv + (1.0f - lbv) * sg; run += __logf(f); bl[ii] = run; kv[ii] = 1.0f - f; qv[ii] = qr / (1.0f + __expf(-qr)); }
            TOT[sb * 128 + d] = run;
            u32x4 v0, v1; v0.x = vraw[0] | (vraw[1] << 16); v0.y = vraw[2] | (vraw[3] << 16); v0.z = vraw[4] | (vraw[5] << 16); v0.w = vraw[6] | (vraw[7] << 16);
            v1.x = vraw[8] | (vraw[9] << 16); v1.y = vraw[10] | (vraw[11] << 16); v1.z = vraw[12] | (vraw[13] << 16); v1.w = vraw[14] | (vraw[15] << 16);
            *(LAS u32x4*)(VT + d * 72 + sb * 16) = v0; *(LAS u32x4*)(VT + d * 72 + sb * 16 + 8) = v1;
        }
        __syncthreads();
        if (ci < 35) { const int cn = ci + 1; const int gn = dir == 0 ? cn : (cn < 4 ? 3 - cn : 39 - cn); const bool cx = gn < 4; const int ck = cx ? gn : gn - 4;
            hgrn_stage(P, lds, w, lane, cx ? (size_t)NLAT + b * CTXL + ck * 64 : (size_t)b * SEQ + ck * 64, dir, h); }
        {
            const float t0 = TOT[d], t1 = TOT[128 + d], t2 = TOT[256 + d], t3 = TOT[384 + d];
            const float Bs1 = t0, Bs2 = t0 + t1, Bs3 = Bs2 + t2, total = Bs3 + t3;
            const float Bsb = sb == 0 ? 0.f : (sb == 1 ? Bs1 : (sb == 2 ? Bs2 : Bs3));
            const float eB = __expf(Bsb), eT = __expf(total);
            float kd[16];
#pragma unroll
            for (int ii = 0; ii < 16; ++ii) { const float e0 = __expf(bl[ii]); Q0[(sb * 16 + ii) * 136 + d] = (bf16_t)f2bf(qv[ii] * e0 * eB);
                const float kp = kv[ii] * __expf(fminf(-(Bsb + bl[ii]), 80.f)); KP[(sb * 16 + ii) * 136 + d] = (bf16_t)f2bf(kp); kd[ii] = kp * eT; }
            *(LAS u32x4*)(KDT + d * 72 + sb * 16) = pack8(kd); *(LAS u32x4*)(KDT + d * 72 + sb * 16 + 8) = pack8(kd + 8);
            if (sb == 0) DD[d] = eT;
        }
        __syncthreads();
#pragma unroll
        for (int k2 = 0; k2 < 2; ++k2) { const int idx = w + 8 * k2;
            if (idx < 10) { const int i = idx < 1 ? 0 : (idx < 3 ? 1 : (idx < 6 ? 2 : 3)); const int j = idx - i * (i + 1) / 2;
                f32x4 sc = (f32x4){0.f, 0.f, 0.f, 0.f};
                const LAS bf16_t* qb = Q0 + (i * 16 + l16) * 136 + q4 * 8; const LAS bf16_t* kb = KP + (j * 16 + l16) * 136 + q4 * 8;
#pragma unroll
                for (int ks = 0; ks < 4; ++ks) sc = mfma16(*(const LAS bf16x8*)(qb + ks * 32), *(const LAS bf16x8*)(kb + ks * 32), sc);
#pragma unroll
                for (int jj = 0; jj < 4; ++jj) { const float v = (i == j && l16 > q4 * 4 + jj) ? 0.f : sc[jj]; ATT[(i * 16 + q4 * 4 + jj) * 72 + j * 16 + l16] = (bf16_t)f2bf(v); } } }
        __syncthreads();
        {
            bf16x8 SBf[4], VTf[2];
#pragma unroll
            for (int ks = 0; ks < 4; ++ks) SBf[ks] = *(const LAS bf16x8*)(SB + (w * 16 + l16) * 136 + ks * 32 + q4 * 8);
#pragma unroll
            for (int ks = 0; ks < 2; ++ks) VTf[ks] = *(const LAS bf16x8*)(VT + (w * 16 + l16) * 72 + ks * 32 + q4 * 8);
#pragma unroll
            for (int i = 0; i < 4; ++i) { f32x4 oa = (f32x4){0.f, 0.f, 0.f, 0.f};
#pragma unroll
                for (int ks = 0; ks < 4; ++ks) oa = mfma16(SBf[ks], *(const LAS bf16x8*)(Q0 + (i * 16 + l16) * 136 + ks * 32 + q4 * 8), oa);
#pragma unroll
                for (int ks = 0; ks < 2; ++ks) oa = mfma16(VTf[ks], *(const LAS bf16x8*)(ATT + (i * 16 + l16) * 72 + ks * 32 + q4 * 8), oa);
                const int t = i * 16 + l16; u32x2 wv; wv.x = pack2(oa[0], oa[1]); wv.y = pack2(oa[2], oa[3]);
                bf16_t* od = dry ? ((bf16_t*)(PF(ws) + WS_DUMMY) + (size_t)chain * 8192 + t * 128 + w * 16 + q4 * 4) : (P + (row0 + (dir ? 63 - t : t)) * PW + C_BF + dir * 512 + h * 128 + w * 16 + q4 * 4);
                *(u32x2*)od = wv; }
        }
        {
            const f32x4 dd = *(const LAS f32x4*)(DD + w * 16 + q4 * 4);
#pragma unroll
            for (int eg = 0; eg < 8; ++eg) S[eg] *= dd;
#pragma unroll
            for (int ks = 0; ks < 2; ++ks) { const bf16x8 A = *(const LAS bf16x8*)(KDT + (w * 16 + l16) * 72 + ks * 32 + q4 * 8);
#pragma unroll
                for (int eg = 0; eg < 8; ++eg) S[eg] = mfma16(A, *(const LAS bf16x8*)(VT + (eg * 16 + l16) * 72 + ks * 32 + q4 * 8), S[eg]); }
        }
        asm volatile("s_waitcnt vmcnt(0)" ::: "memory");
        __syncthreads();
    }
}

__device__ __forceinline__ void dbg_dump() {
    const bf16_t* P = (const bf16_t*)(PF(ws) + WS_P); const bf16_t* U = (const bf16_t*)(PF(ws) + WS_U); const float* AGG = (const float*)(PF(ws) + WS_AGG); float* out = PF(out);
    const size_t n = (size_t)NLAT * DM;
    for (size_t i = (size_t)blockIdx.x * 512 + threadIdx.x; i < n; i += (size_t)gridDim.x * 512) {
        float s = 0.f;
#pragma unroll
        for (int k = 0; k < 5; ++k) s += bf2f(P[i + k * n]);
        s += bf2f(P[(i % ((size_t)NTOK * PW - 5 * n)) + 5 * n]);
        s += bf2f(U[i]) + bf2f(U[(i % ((size_t)NCTX * DM)) + n]);
        s += AGG[i % ((size_t)NB * 36 * 2 * 2 * 512)];
        if (!(s == s)) s = 7777.f; if (fabsf(s) > 1e30f) s = 8888.f; out[i] = s + 1000.0f;
    }
}
#ifndef STAGE_STOP
#define STAGE_STOP 0
#define DBG_SKIP 0
#define STAGE_L 0
#endif
__global__ void __launch_bounds__(512, 2) fwd_megakernel(Params p) {
    extern __shared__ __attribute__((aligned(16))) unsigned char lds_raw[];
    LAS unsigned char* lds = (LAS unsigned char*)lds_raw;
    cg::grid_group grid = cg::this_grid();
    volatile LAS unsigned* xst = (volatile LAS unsigned*)(lds + LDS_BYTES - 16);
    if (threadIdx.x == 0) { xst[0] = 0u; xst[1] = 0u; xst[2] = 0u; xst[3] = 0u; }
    __syncthreads();
    const XcdBarrier xbar = xcd_barrier_post((unsigned*)(PF(ws) + WS_BAR), xst);
    const int G = gridDim.x, c = blockIdx.x;

    phase_mod(p, lds); __syncthreads();
    phase_rope(p);
    phase_convert(p, 0, lds);
#if EXPERIMENT == 12
    __syncthreads(); phase_mod(p, lds); __syncthreads();
#elif EXPERIMENT == 13
    phase_convert(p, 0, lds);
#endif
    grid.sync();
#define WSP(T, off) ((T*)(PF(ws) + (off)))
    for (int l = 0; l < 2; ++l) {
        const bool lastl = (l == 1);
        const int Mrest = lastl ? NLAT : NTOK;
        if (l > 0) phase_convert(p, l, lds);
        phase_norm(p, l, l == 0 ? PF(x) : PF(out), l == 0 ? PF(ctx) : WSP(const float, WS_HC), PF(norm1_g) + l * DM, 0, NTOK,
                   (l > 0 && G == 256) ? (const float*)(PF(ws) + WS_P + (size_t)NTOK * DFF * 2) : nullptr, WSP(const float, WS_MOD) + (size_t)((l > 0 ? l - 1 : 0) * 9 + 8) * 6144 + 5120);
        xcd_barrier(xbar);
#if EXPERIMENT == 14
        phase_norm(p, l, l == 0 ? PF(x) : PF(out), l == 0 ? PF(ctx) : WSP(const float, WS_HC), PF(norm1_g) + l * DM, 0, NTOK,
                   (l > 0 && G == 256) ? (const float*)(PF(ws) + WS_P + (size_t)NTOK * DFF * 2) : nullptr, WSP(const float, WS_MOD) + (size_t)((l > 0 ? l - 1 : 0) * 9 + 8) * 6144 + 5120);
        xcd_barrier(xbar);
#endif

        { pg8::Gemm g{WSP(bf16_t, WS_U), WSP(bf16_t, WS_WIN), DM, DM, DM}; pg8::Sched S; S.init(NTOK, PW, G, c, DM, DM); pg8::EpiStore<0> E{WSP(bf16_t, WS_P), PW}; pg8::gemm_phase(lds, g, S, E); }
        xcd_barrier(xbar);
#if EXPERIMENT == 1
        if (c < 64) hgrn_chain(p, l, lds, c, 1);
        xcd_barrier(xbar);
#elif EXPERIMENT == 2
        if (c >= 64) { const int cc = c - 64, GG = G - 64; const int nA = lastl ? 512 : 576;
            for (int it = cc; it < nA; it += GG) attn_item(p, l, lds, it, 1); }
        xcd_barrier(xbar);
#elif EXPERIMENT == 3
        if (c >= 64) { const int cc = c - 64, GG = G - 64; int staged = -1;
            for (int it = cc; it < 2304; it += GG) lru_tile(p, l, lds, it, 0, staged); }
        xcd_barrier(xbar);
#elif EXPERIMENT == 5
        for (int q = 0; q < 10; ++q) xcd_barrier(xbar);
#elif EXPERIMENT == 6
        phase_convert(p, l, lds);
        xcd_barrier(xbar);
#elif EXPERIMENT == 7
        phase_norm(p, l, PF(out), WSP(const float, WS_HC), PF(norm2_g) + l * DM, 3072, NTOK);
        xcd_barrier(xbar);
#elif EXPERIMENT == 4
        { pg8::Gemm g{WSP(bf16_t, WS_U), WSP(bf16_t, WS_WIN), DM, DM, DM}; pg8::Sched S; S.init(NTOK, PW, G, c, DM, DM); pg8::EpiStore<0> E{WSP(bf16_t, WS_P), PW}; pg8::gemm_phase(lds, g, S, E); }
        xcd_barrier(xbar);
#endif
        if (c < 64) { hgrn_chain(p, l, lds, c); sub_barrier((unsigned*)(PF(ws) + WS_BAR) + 3520 + 64 * (2 * l), 64u); phase_hg_final(p, l, NTOK, c, 64); }
        else { const int cc = c - 64, GG = G - 64; const int nA = lastl ? 512 : 576;
            for (int it = cc; it < nA; it += GG) attn_item(p, l, lds, it);
            int staged = -1;
            for (int it = cc; it < 2304; it += GG) lru_tile(p, l, lds, it, 0, staged);
            sub_barrier((unsigned*)(PF(ws) + WS_BAR) + 3520 + 64 * (2 * l + 1), (unsigned)GG);
            for (int it = cc; it < 2304; it += GG) lru_tile(p, l, lds, it, 1, staged); }
        xcd_barrier(xbar);
        { pg8::Gemm g{WSP(bf16_t, WS_U), WSP(bf16_t, WS_WIN) + (size_t)PW * DM, DM, DM, DM}; pg8::Sched S; S.init(Mrest, 3072, G, c, DM, DM); pg8::EpiStore<1> E{WSP(bf16_t, WS_P), PW}; pg8::gemm_phase(lds, g, S, E); }
        xcd_barrier(xbar);
#if EXPERIMENT == 8
        { pg8::Gemm g{WSP(bf16_t, WS_U), WSP(bf16_t, WS_WIN) + (size_t)PW * DM, DM, DM, DM}; pg8::Sched S; S.init(Mrest, 3072, G, c, DM, DM); pg8::EpiStore<1> E{WSP(bf16_t, WS_P), PW}; pg8::gemm_phase(lds, g, S, E); }
        xcd_barrier(xbar);
#endif
        { pg8::Gemm g{WSP(bf16_t, WS_P), WSP(bf16_t, WS_WB), PW, 512, 512}; pg8::MergeSched S; S.base.init(Mrest, DM, G, c, PW, 512);
          pg8::EpiMerge E{WSP(bf16_t, WS_P), WSP(bf16_t, WS_U)}; pg8::gemm_phase(lds, g, S, E); }
        xcd_barrier(xbar);
#if EXPERIMENT == 10
        { pg8::Gemm g{WSP(bf16_t, WS_P), WSP(bf16_t, WS_WB), PW, 512, 512}; pg8::MergeSched S; S.base.init(Mrest, DM, G, c, PW, 512);
          pg8::EpiMerge E{WSP(bf16_t, WS_P), WSP(bf16_t, WS_U)}; pg8::gemm_phase(lds, g, S, E); }
        xcd_barrier(xbar);
#endif
        { pg8::Gemm g{WSP(bf16_t, WS_U), WSP(bf16_t, WS_WO), DM, DM, DM}; pg8::Sched S; S.init(Mrest, DM, G, c, DM, DM);
          pg8::EpiResid E{l == 0 ? PF(x) : PF(out), l == 0 ? PF(ctx) : WSP(const float, WS_HC), PF(out), WSP(float, WS_HC), WSP(const float, WS_MOD) + (size_t)l * 9 * 6144 + 2048}; pg8::gemm_phase(lds, g, S, E); }
        xcd_barrier(xbar);
#if EXPERIMENT == 11
        if (l == 0) {
        { pg8::Gemm g{WSP(bf16_t, WS_U), WSP(bf16_t, WS_WO), DM, DM, DM}; pg8::Sched S; S.init(Mrest, DM, G, c, DM, DM);
          pg8::EpiResid E{l == 0 ? PF(x) : PF(out), l == 0 ? PF(ctx) : WSP(const float, WS_HC), PF(out), WSP(float, WS_HC), WSP(const float, WS_MOD) + (size_t)l * 9 * 6144 + 2048}; pg8::gemm_phase(lds, g, S, E); }
        xcd_barrier(xbar);
        }
#endif
        phase_norm(p, l, PF(out), WSP(const float, WS_HC), PF(norm2_g) + l * DM, 3072, Mrest);
        xcd_barrier(xbar);
        { pg8::Gemm g{WSP(bf16_t, WS_U), WSP(bf16_t, WS_W1), DM, DM, DM}; pg8::Sched S; S.init(Mrest, DFF, G, c, DM, DM); pg8::EpiStore<2> E{WSP(bf16_t, WS_P), DFF}; pg8::gemm_phase(lds, g, S, E); }
        xcd_barrier(xbar);
#if EXPERIMENT == 9
        { pg8::Gemm g{WSP(bf16_t, WS_U), WSP(bf16_t, WS_W1), DM, DM, DM}; pg8::Sched S; S.init(Mrest, DFF, G, c, DM, DM); pg8::EpiStore<2> E{WSP(bf16_t, WS_P), DFF}; pg8::gemm_phase(lds, g, S, E); }
        xcd_barrier(xbar);
#endif
        { pg8::Gemm g{WSP(bf16_t, WS_P), WSP(bf16_t, WS_W2), DFF, DFF, DFF};
          float* slab = (float*)(PF(ws) + WS_P + (size_t)NTOK * DFF * 2);
          pg8::EpiResid E{PF(out), WSP(const float, WS_HC), PF(out), WSP(float, WS_HC), WSP(const float, WS_MOD) + (size_t)l * 9 * 6144 + 5120, slab};
          if (!lastl && G == 256) { pg8::SplitSched S; S.base.init(NLAT, DM, G, c, DFF, DFF); pg8::gemm_phase(lds, g, S, E); }
          else { pg8::Sched S; S.init(Mrest, DM, G, c, DFF, DFF); pg8::gemm_phase(lds, g, S, E); } }
        if (!lastl) xcd_barrier(xbar);
    }
}

extern "C" void kernel_launch(void* const* d_in, const int* in_sizes, int n_in, void* d_out, int out_size, void* d_ws, size_t ws_size, hipStream_t stream) {
    static int grid_blocks = 0;
    if (grid_blocks == 0) {
        int dev = 0, cus = 0, per_cu = 0;
        hipGetDevice(&dev);
        hipDeviceGetAttribute(&cus, hipDeviceAttributeMultiprocessorCount, dev);
        hipFuncSetAttribute((const void*)fwd_megakernel, hipFuncAttributeMaxDynamicSharedMemorySize, LDS_BYTES);
        hipOccupancyMaxActiveBlocksPerMultiprocessor(&per_cu, (const void*)fwd_megakernel, 512, LDS_BYTES);
        if (per_cu < 1 || n_in != 25 || ws_size < WS_END) { fprintf(stderr, "kernel_launch: cannot launch (per_cu %d, n_in %d, ws %zu need %zu)\n", per_cu, n_in, ws_size, (size_t)WS_END); grid_blocks = -1; }
        else grid_blocks = cus;
    }
    if (grid_blocks < 0) return;
    hipMemsetAsync((char*)d_ws + WS_BAR, 0, 16384, stream);
    Params p{};
    const float** pp = (const float**)&p;
    for (int i = 0; i < 25; ++i) pp[i] = (const float*)d_in[i];
    p.out = (float*)d_out; p.ws = (unsigned char*)d_ws;
    void* args[] = {&p};
    hipError_t e = hipLaunchCooperativeKernel((const void*)fwd_megakernel, dim3(grid_blocks), dim3(512), args, LDS_BYTES, stream);
    if (e != hipSuccess) fprintf(stderr, "cooperative launch failed: %s (grid %d)\n", hipGetErrorString(e), grid_blocks);
}
```

```cpp
#include <hip/hip_runtime.h>
#include <hip/hip_cooperative_groups.h>
#include <stdint.h>
#include <stdio.h>
namespace cg = cooperative_groups;

#define DBG_HG 0
#define EXPERIMENT 0
#define LAS __attribute__((address_space(3)))
typedef unsigned short bf16_t;
typedef short bf16x8 __attribute__((ext_vector_type(8)));
typedef float f32x4 __attribute__((ext_vector_type(4)));
typedef unsigned u32x4 __attribute__((ext_vector_type(4)));
typedef unsigned u32x2 __attribute__((ext_vector_type(2)));

constexpr int DM = 1024, NB = 8, SEQ = 2048, CTXL = 256, NLAT = NB * SEQ, NCTX = NB * CTXL, NTOK = NLAT + NCTX;
constexpr int PW = 5120, DIN = 8192, DFF = 4096;
constexpr int C_AX = 0, C_AG = 512, C_BQ = 1024, C_BF = 1536, C_BI = 2560, C_BO = 3072, C_CQ = 3584, C_CK = 4096, C_CV = 4608;
constexpr int LDS_BYTES = 163840;
constexpr size_t WS_WIN = 0;
constexpr size_t WS_WB = WS_WIN + (size_t)DIN * DM * 2;
constexpr size_t WS_WO = WS_WB + (size_t)3 * DM * 512 * 2;
constexpr size_t WS_W1 = WS_WO + (size_t)DM * DM * 2;
constexpr size_t WS_W2 = WS_W1 + (size_t)DFF * DM * 2;
constexpr size_t WS_U = WS_W2 + (size_t)DM * DFF * 2;
constexpr size_t WS_P = WS_U + (size_t)NTOK * DM * 2;
constexpr size_t WS_HC = WS_P + (size_t)NTOK * PW * 2;
constexpr size_t WS_MOD = WS_HC + (size_t)NCTX * DM * 4;
constexpr size_t WS_AGG = WS_MOD + (size_t)2 * 9 * 6144 * 4;
constexpr size_t WS_ROPE = WS_AGG + (size_t)NB * 36 * 2 * 2 * 512 * 4;
constexpr size_t WS_DUMMY = WS_ROPE + 2048 * 4;
constexpr size_t WS_BAR = WS_DUMMY + (2u << 20);
constexpr size_t WS_END = WS_BAR + 16384;

struct Params {
    const float *x, *c, *ctx, *c_ctx, *ada_w, *ada_b, *norm1_g, *norm2_g, *w_in, *conv_w, *conv_b, *lru_wa, *lru_ba, *lru_wx, *lru_bx, *lru_lambda,
        *hg_lb, *hg_norm_g, *na_qg, *na_kg, *na_rpb, *w_branch, *w_out, *ffn_w1, *ffn_w2;
    float* out; unsigned char* ws;
};


__device__ __forceinline__ unsigned long long ldkarg(int off) { unsigned long long v = 0;
#if defined(__HIP_DEVICE_COMPILE__)
    auto kp = __builtin_amdgcn_kernarg_segment_ptr();
    asm volatile("s_load_dwordx2 %0, %1, %2\n\ts_waitcnt lgkmcnt(0)" : "=s"(v) : "s"(kp), "s"(off));
#endif
    return v; }
template <class T> struct rm_ptr; template <class T> struct rm_ptr<T*> { typedef T type; };
template <class T> __device__ __forceinline__ T* as_global_ptr(unsigned long long v) { return (T*)(__attribute__((address_space(1))) T*)v; }
#define PF(f) (as_global_ptr<rm_ptr<decltype(Params::f)>::type>(ldkarg((int)__builtin_offsetof(Params, f))))

#define GAS __attribute__((address_space(1)))
template <class T> __device__ __forceinline__ GAS T* lnd(T* p) { asm volatile("" : "+v"(p)); return (GAS T*)p; }
__device__ __forceinline__ int tid_() { int t = threadIdx.x; asm volatile("" : "+v"(t)); return t; }
__device__ __forceinline__ float bf2f(unsigned v) { return __uint_as_float(v << 16); }
__device__ __forceinline__ float bflo(unsigned w) { return __uint_as_float(w << 16); }
__device__ __forceinline__ float bfhi(unsigned w) { return __uint_as_float(w & 0xffff0000u); }
__device__ __forceinline__ unsigned f2bf(float f) { unsigned u = __float_as_uint(f); u += 0x7fffu + ((u >> 16) & 1u); return u >> 16; }
typedef __bf16 bf16x2_t __attribute__((ext_vector_type(2)));
typedef float f32x2_t __attribute__((ext_vector_type(2)));
__device__ __forceinline__ unsigned pack2(float lo, float hi) { f32x2_t v = {lo, hi}; bf16x2_t b = __builtin_convertvector(v, bf16x2_t); union { bf16x2_t b; unsigned u; } t; t.b = b; return t.u; }
__device__ __forceinline__ float sigmoidf_(float x) { return 1.0f / (1.0f + __expf(-x)); }
__device__ __forceinline__ f32x4 mfma16(bf16x8 a, bf16x8 b, f32x4 c) { return __builtin_amdgcn_mfma_f32_16x16x32_bf16(a, b, c, 0, 0, 0); }
__device__ __forceinline__ bf16x8 as_bf16x8(u32x4 v) { union { u32x4 u; bf16x8 b; } t; t.u = v; return t.b; }
__device__ __forceinline__ void unpack8(u32x4 w, float* o) { o[0] = bflo(w.x); o[1] = bfhi(w.x); o[2] = bflo(w.y); o[3] = bfhi(w.y); o[4] = bflo(w.z); o[5] = bfhi(w.z); o[6] = bflo(w.w); o[7] = bfhi(w.w); }
__device__ __forceinline__ u32x4 pack8(const float* v) { u32x4 w; w.x = pack2(v[0], v[1]); w.y = pack2(v[2], v[3]); w.z = pack2(v[4], v[5]); w.w = pack2(v[6], v[7]); return w; }

namespace pg8 {
constexpr int BM = 256, BK = 64, HALF = 128, HTB = HALF * BK * 2, NXCD = 8, WGM = 8;
__device__ __forceinline__ int lds_byte(int r, int c) { const int st = (r >> 4) * 2 + (c >> 5), rr = r & 15, cc = c & 31, ob = rr * 64 + cc * 2; return st * 1024 + (ob ^ (((ob >> 9) & 1) << 5)); }
__device__ __forceinline__ void stage_rc(int b, int& R, int& C) { const int st = b / 1024, sb = b % 1024, swz = sb ^ (((sb >> 9) & 1) << 5); R = (st >> 1) * 16 + swz / 64; C = (st & 1) * 32 + (swz % 64) / 2; }
__device__ __forceinline__ int perm32(int rho) { const int n = rho >> 4, i = rho & 15; return 8 * (i >> 2) + 4 * n + (i & 3); }

struct Unit { int pm, pn, sub, nt; size_t aoff, boff; };
struct Gemm { const bf16_t* A; const bf16_t* Bt; int lda, ldb, K; };
struct Sched {
    int nM, nN, nwg, G, c, lda, ldb, nt;
    __device__ void init(int M, int N, int G_, int c_, int lda_, int ldb_) { nM = M / BM; nN = N / BM; nwg = nM * nN; G = G_; c = c_; lda = lda_; ldb = ldb_; nt = 0; }
    __device__ bool next(int i, Unit& u) const {
        const long L = (long)i * G + c; if (L >= nwg) return false;
        int wgid = (int)L; { const int q = nwg / NXCD, r = nwg % NXCD, xcd = wgid % NXCD, off = wgid / NXCD; wgid = (xcd < r ? xcd * (q + 1) : r * (q + 1) + (xcd - r) * q) + off; }
        const int nig = WGM * nN, gid = wgid / nig, fm = gid * WGM, gsz = (nM - fm) < WGM ? (nM - fm) : WGM;
        u.pm = fm + ((wgid % nig) % gsz); u.pn = (wgid % nig) / gsz; u.sub = 0; u.nt = nt;
        u.aoff = (size_t)u.pm * BM * lda * 2;
        u.boff = (size_t)u.pn * BM * ldb * 2;
        return true;
    }
};

template <int ACT> struct EpiStore {
    static constexpr bool PERM = true;
    bf16_t* O; int ldc;
    __device__ __forceinline__ void operator()(const f32x4 (&acc)[2][2][4][2], const Unit& u, int wr, int wc, int fr, int fq) const {
        const int row0 = u.pm * BM + wr * 64 + fr; int colt = u.pn * BM;
        if (ACT == 1) colt = (colt < 2048) ? (1024 + colt) : (2048 + colt);
        const int col0 = colt + wc * 32 + 8 * fq;
#pragma unroll
        for (int ai = 0; ai < 2; ++ai)
#pragma unroll
            for (int m = 0; m < 4; ++m) { GAS bf16_t* rowp = lnd(O + (size_t)(row0 + ai * HALF + m * 16) * ldc + col0);
#pragma unroll
                for (int bj = 0; bj < 2; ++bj) { f32x4 v0 = acc[ai][bj][m][0], v1 = acc[ai][bj][m][1];
                    if (ACT == 1) {
#pragma unroll
                        for (int j = 0; j < 4; ++j) { v0[j] = sigmoidf_(v0[j]); v1[j] = sigmoidf_(v1[j]); } }
                    if (ACT == 2) {
#pragma unroll
                        for (int j = 0; j < 4; ++j) { float a = fmaxf(v0[j], 0.f), b = fmaxf(v1[j], 0.f); v0[j] = a * a; v1[j] = b * b; } }
                    u32x4 w; w.x = pack2(v0[0], v0[1]); w.y = pack2(v0[2], v0[3]); w.z = pack2(v1[0], v1[1]); w.w = pack2(v1[2], v1[3]);
                    *(GAS u32x4*)(rowp + bj * HALF) = w; } }
    }
};
struct EpiMerge {
    static constexpr bool PERM = true;
    const bf16_t* P; bf16_t* U;
    __device__ __forceinline__ void operator()(const f32x4 (&acc)[2][2][4][2], const Unit& u, int wr, int wc, int fr, int fq) const {
        const int row0 = u.pm * BM + wr * 64 + fr; const int col0 = u.pn * BM + wc * 32 + 8 * fq;
        const int sub = u.sub; const int gcol = sub * 1024 + u.pn * BM; const int gd = ((gcol < 2048) ? (1024 + gcol) : (2048 + gcol)) + wc * 32 + 8 * fq;
        const bool addp = sub > 0;
#pragma unroll
        for (int ai = 0; ai < 2; ++ai)
#pragma unroll
            for (int m = 0; m < 4; ++m) { const size_t row = (size_t)(row0 + ai * HALF + m * 16); const GAS bf16_t* gp = lnd(P + row * PW + gd); GAS bf16_t* up = lnd(U + row * DM + col0);
#pragma unroll
                for (int bj = 0; bj < 2; ++bj) { const u32x4 gw = *(const GAS u32x4*)(gp + bj * HALF);
                    f32x4 a0 = acc[ai][bj][m][0], a1 = acc[ai][bj][m][1];
                    a0[0] *= bflo(gw.x); a0[1] *= bfhi(gw.x); a0[2] *= bflo(gw.y); a0[3] *= bfhi(gw.y); a1[0] *= bflo(gw.z); a1[1] *= bfhi(gw.z); a1[2] *= bflo(gw.w); a1[3] *= bfhi(gw.w);
                    if (addp) { const u32x4 pw = *(const GAS u32x4*)(up + bj * HALF);
                        a0[0] += bflo(pw.x); a0[1] += bfhi(pw.x); a0[2] += bflo(pw.y); a0[3] += bfhi(pw.y); a1[0] += bflo(pw.z); a1[1] += bfhi(pw.z); a1[2] += bflo(pw.w); a1[3] += bfhi(pw.w); }
                    u32x4 o; o.x = pack2(a0[0], a0[1]); o.y = pack2(a0[2], a0[3]); o.z = pack2(a1[0], a1[1]); o.w = pack2(a1[2], a1[3]);
                    *(GAS u32x4*)(up + bj * HALF) = o; } }
    }
};
struct EpiResid {
    static constexpr bool PERM = true;
    const float* inL; const float* inC; float* outL; float* outC; const float* mod;
    float* slab;
    __device__ __forceinline__ void operator()(const f32x4 (&acc)[2][2][4][2], const Unit& u, int wr, int wc, int fr, int fq) const {
        if (u.sub >= 1) {
            const int row0 = (u.pm - 64) * BM + wr * 64 + fr, col0 = u.pn * BM + wc * 32 + 8 * fq; float* sl = slab + (size_t)(u.sub - 1) * NCTX * DM;
#pragma unroll
            for (int ai = 0; ai < 2; ++ai)
#pragma unroll
                for (int m = 0; m < 4; ++m)
#pragma unroll
                    for (int bj = 0; bj < 2; ++bj) { GAS float* op = lnd(sl + (size_t)(row0 + ai * HALF + m * 16) * DM + col0 + bj * HALF); *(GAS f32x4*)op = acc[ai][bj][m][0]; *(GAS f32x4*)(op + 4) = acc[ai][bj][m][1]; }
            return;
        }
        const bool lat = u.pm < 64; const int rbase = lat ? u.pm * BM : (u.pm - 64) * BM;
        const float* in = lat ? inL : inC; float* out = lat ? outL : outC;
        const int row0 = rbase + wr * 64 + fr, col0 = u.pn * BM + wc * 32 + 8 * fq;
        const float* gt = mod + (size_t)(lat ? (u.pm >> 3) : 8) * 6144 + col0;
#pragma unroll
        for (int bj = 0; bj < 2; ++bj) { const f32x4 g0 = *(const f32x4*)(gt + bj * HALF), g1 = *(const f32x4*)(gt + bj * HALF + 4);
#pragma unroll
            for (int ai = 0; ai < 2; ++ai)
#pragma unroll
                for (int m = 0; m < 4; ++m) { const size_t ro = (size_t)(row0 + ai * HALF + m * 16) * DM + col0 + bj * HALF;
                    const GAS float* ip = lnd(in + ro); GAS float* op = lnd(out + ro); const f32x4 i0 = *(const GAS f32x4*)ip, i1 = *(const GAS f32x4*)(ip + 4);
                    *(GAS f32x4*)op = i0 + g0 * acc[ai][bj][m][0]; *(GAS f32x4*)(op + 4) = i1 + g1 * acc[ai][bj][m][1]; } }
    }
};

struct MergeSched {
    Sched base;
    __device__ bool next(int i, Unit& u) const {
        const int r = i / 3, n = i - 3 * r;
        if (!base.next(r, u)) return false;
        u.sub = n; u.aoff += (size_t)(n == 0 ? C_AG : C_BO + (n - 1) * 512) * 2; u.boff += (size_t)n * DM * 512 * 2;
        return true;
    }
};
struct SplitSched {
    Sched base;
    __device__ bool next(int i, Unit& u) const {
        if (base.next(i, u)) return true;
        const int nfull = (base.nwg - base.c + base.G - 1) / base.G;
        const int k = i - nfull; const int un = k * base.G + base.c; if (k < 0 || un >= 128) return false;
        const int ct = un >> 2, sl = un & 3; u.pm = 64 + (ct >> 2); u.pn = ct & 3; u.sub = 1 + sl; u.nt = 16;
        u.aoff = (size_t)u.pm * BM * base.lda * 2 + (size_t)sl * 1024 * 2; u.boff = (size_t)u.pn * BM * base.ldb * 2 + (size_t)sl * 1024 * 2;
        return true;
    }
};
template <class Epi, class Sch>
__device__ __forceinline__ void gemm_phase(LAS unsigned char* lds, const Gemm g, const Sch& S, const Epi& E) {
    const int tid = tid_(), wid = __builtin_amdgcn_readfirstlane(tid >> 6), lane = tid & 63, wr = wid >> 2, wc = wid & 3, fr = lane & 15, fq = lane >> 4;
    const int K = g.K;
    unsigned voffA[2], voffB[2];
#pragma unroll
    for (int i = 0; i < 2; ++i) { int R, C; stage_rc(tid * 16 + i * 8192, R, C); const int Rb = Epi::PERM ? ((R & ~31) + perm32(R & 31)) : R;
        voffA[i] = (unsigned)(R * g.lda + C) * 2u; voffB[i] = (unsigned)(Rb * g.ldb + C) * 2u; }
    const size_t kstep = (size_t)(BK * 2);
    const size_t hstepA = (size_t)HALF * g.lda * 2, hstepB = (size_t)HALF * g.ldb * 2;
    const unsigned ldsw = (unsigned)wid * 1024u;
    const int aoff = lds_byte(wr * 64 + fr, fq * 8), boff = lds_byte(wc * 32 + fr, fq * 8);
#define PG8_SA(b, h) (((b) * 2 + (h)) * HTB)
#define PG8_SB(b, h) ((4 + (b) * 2 + (h)) * HTB)
#define PG8_STAGE(bufoff, gbase, voff) do { _Pragma("unroll") for (int _i = 0; _i < 2; ++_i) \
        __builtin_amdgcn_global_load_lds((const unsigned*)((const char*)(gbase) + (voff)[_i]), (LAS unsigned*)(lds + (bufoff) + ldsw + _i * 8192), 16, 0, 0); } while (0)
#define PG8_LDA(dst, b, h) do { _Pragma("unroll") for (int m = 0; m < 4; ++m) _Pragma("unroll") for (int k = 0; k < 2; ++k) dst[m][k] = *(const LAS bf16x8*)(lds + PG8_SA(b, h) + aoff + m * 2048 + k * 1024); } while (0)
#define PG8_LDB(dst, b, h) do { _Pragma("unroll") for (int n = 0; n < 2; ++n) _Pragma("unroll") for (int k = 0; k < 2; ++k) dst[n][k] = *(const LAS bf16x8*)(lds + PG8_SB(b, h) + boff + n * 2048 + k * 1024); } while (0)
#define PG8_MMA(ai, bj, At, Bt) do { __builtin_amdgcn_s_setprio(1); _Pragma("unroll") for (int m = 0; m < 4; ++m) _Pragma("unroll") for (int n = 0; n < 2; ++n) _Pragma("unroll") for (int k = 0; k < 2; ++k) \
        acc[ai][bj][m][n] = __builtin_amdgcn_mfma_f32_16x16x32_bf16(Bt[n][k], At[m][k], acc[ai][bj][m][n], 0, 0, 0); __builtin_amdgcn_s_setprio(0); } while (0)
#define PG8_WAIT_V(n) asm volatile("s_waitcnt vmcnt(" #n ")" ::: "memory")
#define PG8_WAIT_L(n) asm volatile("s_waitcnt lgkmcnt(" #n ")" ::: "memory")
#define PG8_BAR __builtin_amdgcn_s_barrier()
#define PG8_SCHED __builtin_amdgcn_sched_barrier(0)
    Unit cur, nxt; int ui = 0;
    if (!S.next(0, cur)) return;
    f32x4 acc[2][2][4][2];
#pragma unroll
    for (int a = 0; a < 2; ++a)
#pragma unroll
        for (int b = 0; b < 2; ++b)
#pragma unroll
            for (int m = 0; m < 4; ++m)
#pragma unroll
                for (int n = 0; n < 2; ++n) acc[a][b][m][n] = (f32x4){0.f, 0.f, 0.f, 0.f};
    bf16x8 At[4][2], B0[2][2], B1[2][2];
    const char* cA = (const char*)g.A + cur.aoff; const char* cB = (const char*)g.Bt + cur.boff;
    PG8_STAGE(PG8_SB(0, 0), cB, voffB); PG8_STAGE(PG8_SA(0, 0), cA, voffA); PG8_STAGE(PG8_SB(0, 1), cB + hstepB, voffB); PG8_STAGE(PG8_SA(0, 1), cA + hstepA, voffA);
    if (wr == 1) PG8_BAR;
    PG8_WAIT_V(4); PG8_BAR;
    PG8_STAGE(PG8_SB(1, 0), cB + kstep, voffB); PG8_STAGE(PG8_SA(1, 0), cA + kstep, voffA); PG8_STAGE(PG8_SB(1, 1), cB + hstepB + kstep, voffB);
    PG8_WAIT_V(6); PG8_BAR;
    for (;;) {
        const bool has_next = S.next(ui + 1, nxt);
        const char* nA = has_next ? (const char*)g.A + nxt.aoff : cA; const char* nB = has_next ? (const char*)g.Bt + nxt.boff : cB;
        const int nt = cur.nt ? cur.nt : K / BK;
        for (int t = 0; t < nt; t += 2) {
            const bool last = (t == nt - 2);
            const char* a1 = cA + (size_t)(t + 1) * kstep;
            const char* a2 = last ? nA : cA + (size_t)(t + 2) * kstep; const char* b2 = last ? nB : cB + (size_t)(t + 2) * kstep;
            const char* a3 = a2 + kstep; const char* b3 = b2 + kstep;
            PG8_LDB(B0, 0, 0); PG8_SCHED; PG8_LDA(At, 0, 0); PG8_STAGE(PG8_SA(1, 1), a1 + hstepA, voffA);
            PG8_WAIT_L(8); PG8_BAR; PG8_WAIT_L(0); PG8_MMA(0, 0, At, B0); PG8_BAR; PG8_SCHED;
            PG8_LDB(B1, 0, 1); PG8_STAGE(PG8_SB(0, 0), b2, voffB);
            PG8_BAR; PG8_WAIT_L(0); PG8_MMA(0, 1, At, B1); PG8_BAR;
            PG8_LDA(At, 0, 1); PG8_STAGE(PG8_SA(0, 0), a2, voffA);
            PG8_BAR; PG8_WAIT_L(0); PG8_MMA(1, 0, At, B0); PG8_BAR; PG8_SCHED;
            PG8_STAGE(PG8_SB(0, 1), b2 + hstepB, voffB);
            PG8_WAIT_V(6); PG8_BAR; PG8_MMA(1, 1, At, B1); PG8_BAR;
            PG8_LDB(B0, 1, 0); PG8_SCHED; PG8_LDA(At, 1, 0); PG8_STAGE(PG8_SA(0, 1), a2 + hstepA, voffA);
            PG8_WAIT_L(8); PG8_BAR; PG8_WAIT_L(0); PG8_MMA(0, 0, At, B0); PG8_BAR; PG8_SCHED;
            PG8_LDB(B1, 1, 1); PG8_STAGE(PG8_SB(1, 0), b3, voffB);
            PG8_BAR; PG8_WAIT_L(0); PG8_MMA(0, 1, At, B1); PG8_BAR;
            PG8_LDA(At, 1, 1); PG8_STAGE(PG8_SA(1, 0), a3, voffA);
            PG8_BAR; PG8_WAIT_L(0); PG8_MMA(1, 0, At, B0); PG8_BAR; PG8_SCHED;
            PG8_STAGE(PG8_SB(1, 1), b3 + hstepB, voffB);
            PG8_WAIT_V(6); PG8_BAR; PG8_MMA(1, 1, At, B1); PG8_BAR;
        }
        E(acc, cur, wr, wc, fr, fq);
        if (!has_next) break;
#pragma unroll
        for (int a = 0; a < 2; ++a)
#pragma unroll
            for (int b = 0; b < 2; ++b)
#pragma unroll
                for (int m = 0; m < 4; ++m)
#pragma unroll
                    for (int n = 0; n < 2; ++n) acc[a][b][m][n] = (f32x4){0.f, 0.f, 0.f, 0.f};
        cur = nxt; cA = nA; cB = nB; ++ui;
    }
    PG8_WAIT_V(0);
    if (wr == 0) PG8_BAR;
    PG8_BAR;
#undef PG8_SA
#undef PG8_SB
#undef PG8_STAGE
#undef PG8_LDA
#undef PG8_LDB
#undef PG8_MMA
#undef PG8_WAIT_V
#undef PG8_WAIT_L
#undef PG8_BAR
#undef PG8_SCHED
}
}


#define XB_TMO      128
#define XB_XCNT(j)  (256  + 64 * (j))
#define XB_XSUB(j)  (1280 + 64 * (j))
#define XB_XGEN(j)  (2304 + 64 * (j))
#define XB_TOP      3328
#define XB_TOPGEN   3392
#define XCD_BAR_WORDS 3456
#define XB_SPIN_CAP (1u << 20)
__device__ __forceinline__ unsigned xb_ld(unsigned* p)              { return __hip_atomic_load(p, __ATOMIC_RELAXED, __HIP_MEMORY_SCOPE_AGENT); }
__device__ __forceinline__ unsigned xb_add(unsigned* p, unsigned v) { return __hip_atomic_fetch_add(p, v, __ATOMIC_RELAXED, __HIP_MEMORY_SCOPE_AGENT); }
__device__ __forceinline__ unsigned xb_xcc_id() { return (unsigned)__builtin_amdgcn_s_getreg((3 << 11) | 20) & 0xFu; }
#define XB_SPIN(cond, bar) do { unsigned _sp = 0; while (cond) { __builtin_amdgcn_s_sleep(1); \
    if ((++_sp & 255u) == 0u) { if (xb_ld(&(bar)[XB_TMO])) break; if (_sp > XB_SPIN_CAP) { atomicAdd(&(bar)[XB_TMO], 1u); break; } } } } while (0)
struct XcdBarrier { unsigned* bar; unsigned x; volatile LAS unsigned* st; };
__device__ __forceinline__ XcdBarrier xcd_barrier_post(unsigned* bar, volatile LAS unsigned* st) {
    XcdBarrier b; b.bar = bar; b.x = xb_xcc_id(); b.st = st;
    if (threadIdx.x == 0) (void)xb_add(&bar[XB_XCNT(b.x)], 1u);
    return b;
}
__device__ __forceinline__ void xcd_barrier_complete(unsigned* bar, unsigned x, unsigned& nloc, unsigned& nx) {
    const unsigned G = gridDim.x * gridDim.y * gridDim.z;
    unsigned sum, cnt, mine, sp = 0u;
    for (;;) {
        sum = 0u; cnt = 0u; mine = 0u;
#pragma unroll
        for (unsigned j = 0; j < 16; ++j) { const unsigned c = xb_ld(&bar[XB_XCNT(j)]); sum += c; cnt += (c > 0u) ? 1u : 0u; mine = (j == x) ? c : mine; }
        if (sum == G) break;
        __builtin_amdgcn_s_sleep(1);
        if ((++sp & 255u) == 0u) { if (xb_ld(&bar[XB_TMO])) break; if (sp > XB_SPIN_CAP) { atomicAdd(&bar[XB_TMO], 1u); break; } }
    }
    nloc = mine > 0u ? mine : 1u; nx = cnt > 0u ? cnt : 1u;
}
__device__ __forceinline__ void xcd_barrier(const XcdBarrier& b) {
    asm volatile("s_waitcnt vmcnt(0)" ::: "memory");
    __syncthreads();
    if (threadIdx.x == 0) {
        unsigned* bar = b.bar;
        __builtin_amdgcn_s_waitcnt(0);
        unsigned nloc = b.st[0], nx = b.st[1];
        if (nloc == 0u) { xcd_barrier_complete(bar, b.x, nloc, nx); b.st[0] = nloc; b.st[1] = nx; }
        const unsigned old = xb_add(&bar[XB_XSUB(b.x)], 1u);
        const unsigned gen = old / nloc;
        if (old + 1u == (gen + 1u) * nloc) {
            __builtin_amdgcn_fence(__ATOMIC_RELEASE, "agent");
            asm volatile("s_waitcnt vmcnt(0)" ::: "memory");
            const unsigned og = xb_add(&bar[XB_TOP], 1u);
            const unsigned tg = og / nx;
            if (og + 1u == (tg + 1u) * nx) xb_add(&bar[XB_TOPGEN], 1u);
            else XB_SPIN(xb_ld(&bar[XB_TOPGEN]) == tg, bar);
            __builtin_amdgcn_fence(__ATOMIC_ACQUIRE, "agent");
            xb_add(&bar[XB_XGEN(b.x)], 1u);
            asm volatile("s_waitcnt vmcnt(0)" ::: "memory");
        } else {
            XB_SPIN(xb_ld(&bar[XB_XGEN(b.x)]) == gen, bar);
            __builtin_amdgcn_fence(__ATOMIC_ACQUIRE, "agent");
            asm volatile("s_waitcnt vmcnt(0)" ::: "memory");
        }
    }
    __syncthreads();
}

__device__ __forceinline__ void sub_barrier(unsigned* word, unsigned n) {
    asm volatile("s_waitcnt vmcnt(0)" ::: "memory");
    __syncthreads();
    if (threadIdx.x == 0) {
        __builtin_amdgcn_fence(__ATOMIC_RELEASE, "agent");
        asm volatile("s_waitcnt vmcnt(0)" ::: "memory");
        xb_add(word, 1u);
        unsigned sp = 0;
        while (xb_ld(word) < n) { __builtin_amdgcn_s_sleep(1); if (++sp > (1u << 22)) break; }
        __builtin_amdgcn_fence(__ATOMIC_ACQUIRE, "agent");
        asm volatile("s_waitcnt vmcnt(0)" ::: "memory");
    }
    __syncthreads();
}

__device__ __forceinline__ void phase_mod(const Params& p, LAS unsigned char* lds) {
    LAS float* sc = (LAS float*)lds;
    LAS float* part = sc + 9 * 1024;
    float* mod = (float*)(PF(ws) + WS_MOD);
    const int tid = tid_(), w = tid >> 6, lane = tid & 63;
    if ((int)blockIdx.x >= 192) return;
    const float* pc = PF(c); const float* pcc = PF(c_ctx); const float* padaw = PF(ada_w); const float* padab = PF(ada_b);
    for (int i = tid; i < 9 * 1024; i += 512) { const int r = i >> 10, k = i & 1023; const float v = (r < 8) ? pc[r * 1024 + k] : pcc[k]; sc[i] = v / (1.0f + expf(-v)); }
    __syncthreads();
    for (int item = blockIdx.x; item < 192; item += gridDim.x) {
        const int l = item / 96, cb = item % 96;
        const float* W = padaw + (size_t)l * 1024 * 6144 + cb * 64 + lane;
        float acc[9];
#pragma unroll
        for (int r = 0; r < 9; ++r) acc[r] = 0.f;
        for (int k = w * 128; k < w * 128 + 128; ++k) { const float wv = W[(size_t)k * 6144];
#pragma unroll
            for (int r = 0; r < 9; ++r) acc[r] += sc[r * 1024 + k] * wv; }
#pragma unroll
        for (int r = 0; r < 9; ++r) part[(w * 9 + r) * 64 + lane] = acc[r];
        __syncthreads();
        for (int i = tid; i < 576; i += 512) { const int r = i >> 6, ln = i & 63; float s = 0.f;
#pragma unroll
            for (int ww = 0; ww < 8; ++ww) s += part[(ww * 9 + r) * 64 + ln];
            mod[(size_t)(l * 9 + r) * 6144 + cb * 64 + ln] = s + padab[l * 6144 + cb * 64 + ln]; }
        __syncthreads();
    }
}
__device__ __forceinline__ void phase_rope(const Params& p) {
    if (blockIdx.x != gridDim.x - 1) return;
    float* rope = (float*)(PF(ws) + WS_ROPE);
    for (int i = tid_(); i < 1024; i += 512) { const int pos = i >> 4, fi = i & 15; const float invf = powf(10000.0f, -(float)fi / 16.0f); const float ang = (float)pos * invf; rope[i] = cosf(ang); rope[1024 + i] = sinf(ang); }
}
__device__ __forceinline__ void convert_tile(const float* src, int K, int N, bf16_t* dst, int tile, LAS bf16_t* T) {
    const int tid = tid_(), tilesN = N >> 7, tk = tile / tilesN, tn = tile - tk * tilesN, k0 = tk * 128, n0 = tn * 128;
    const int r = tid >> 4, c8 = (tid & 15) * 8;
    f32x4 a[4], b[4];
#pragma unroll
    for (int i = 0; i < 4; ++i) { const float* s = src + (size_t)(k0 + r + 32 * i) * N + n0 + c8; a[i] = *(const f32x4*)s; b[i] = *(const f32x4*)(s + 4); }
#pragma unroll
    for (int i = 0; i < 4; ++i)
#pragma unroll
        for (int j = 0; j < 4; ++j) { T[(c8 + j) * 136 + r + 32 * i] = (bf16_t)f2bf(a[i][j]); T[(c8 + 4 + j) * 136 + r + 32 * i] = (bf16_t)f2bf(b[i][j]); }
    __syncthreads();
    const int n = tid >> 2, ks = (tid & 3) * 8;
#pragma unroll
    for (int i = 0; i < 4; ++i) { const u32x4 v = *(const LAS u32x4*)(T + n * 136 + ks + 32 * i); *(u32x4*)(dst + (size_t)(n0 + n) * K + k0 + ks + 32 * i) = v; }
    __syncthreads();
}
__device__ __forceinline__ void phase_convert(const Params& p, int l, LAS unsigned char* lds) {
    LAS bf16_t* T = (LAS bf16_t*)lds;
    bf16_t* WIN = (bf16_t*)(PF(ws) + WS_WIN); bf16_t* WB = (bf16_t*)(PF(ws) + WS_WB); bf16_t* WO = (bf16_t*)(PF(ws) + WS_WO); bf16_t* W1 = (bf16_t*)(PF(ws) + WS_W1); bf16_t* W2 = (bf16_t*)(PF(ws) + WS_W2);
    for (int it = blockIdx.x; it < 1184; it += gridDim.x) {
        if (it < 512) convert_tile(PF(w_in) + (size_t)l * DM * DIN, DM, DIN, WIN, it, T);
        else if (it < 608) { const int n = (it - 512) / 32, tl = (it - 512) % 32; convert_tile(PF(w_branch) + (size_t)(l * 3 + n) * 512 * DM, 512, DM, WB + (size_t)n * DM * 512, tl, T); }
        else if (it < 672) convert_tile(PF(w_out) + (size_t)l * DM * DM, DM, DM, WO, it - 608, T);
        else if (it < 928) convert_tile(PF(ffn_w1) + (size_t)l * DM * DFF, DM, DFF, W1, it - 672, T);
        else convert_tile(PF(ffn_w2) + (size_t)l * DFF * DM, DFF, DM, W2, it - 928, T);
    }
}
__device__ __forceinline__ void phase_norm(const Params& p, int l, const float* hlat, const float* hctx, const float* g, int modoff, int nrows, const float* slab = nullptr, const float* slabgate = nullptr) {
    const int tid = tid_(); const int w = tid >> 6, lane = tid & 63;
    bf16_t* U = (bf16_t*)(PF(ws) + WS_U); const float* mod = (const float*)(PF(ws) + WS_MOD);
    for (int row = blockIdx.x * 8 + w; row < nrows; row += gridDim.x * 8) {
        const float* src = row < NLAT ? hlat + (size_t)row * DM : hctx + (size_t)(row - NLAT) * DM;
        const int mr = row < NLAT ? (row >> 11) : 8;
        const float* md = mod + (size_t)(l * 9 + mr) * 6144 + modoff;
        f32x4 v[4]; float ss = 0.f;
#pragma unroll
        for (int i = 0; i < 4; ++i) { v[i] = *(const f32x4*)(src + i * 256 + lane * 4);
            if (slab != nullptr && row >= NLAT) { const size_t o = (size_t)(row - NLAT) * DM + i * 256 + lane * 4; const f32x4 gg = *(const f32x4*)(slabgate + i * 256 + lane * 4);
                const f32x4 s4 = (*(const f32x4*)(slab + o) + *(const f32x4*)(slab + o + (size_t)NCTX * DM)) + (*(const f32x4*)(slab + o + (size_t)2 * NCTX * DM) + *(const f32x4*)(slab + o + (size_t)3 * NCTX * DM));
                v[i] += gg * s4; }
            ss += v[i][0] * v[i][0] + v[i][1] * v[i][1] + v[i][2] * v[i][2] + v[i][3] * v[i][3]; }
#pragma unroll
        for (int o = 32; o >= 1; o >>= 1) ss += __shfl_xor(ss, o);
        const float rstd = rsqrtf(ss * (1.0f / 1024.0f) + 1e-6f);
#pragma unroll
        for (int i = 0; i < 4; ++i) { const int cidx = i * 256 + lane * 4; const f32x4 gg = *(const f32x4*)(g + cidx), sh = *(const f32x4*)(md + cidx), scv = *(const f32x4*)(md + 1024 + cidx);
            float o4[4];
#pragma unroll
            for (int j = 0; j < 4; ++j) o4[j] = (v[i][j] * rstd * gg[j]) * (1.0f + scv[j]) + sh[j];
            u32x2 wv; wv.x = pack2(o4[0], o4[1]); wv.y = pack2(o4[2], o4[3]);
            *(u32x2*)(U + (size_t)row * DM + cidx) = wv; }
    }
}
__device__ __forceinline__ void phase_hg_final(const Params& p, int l, int nrows, int wg, int nwg) {
    const int tid = tid_(); const int w = tid >> 6, lane = tid & 63; bf16_t* P = (bf16_t*)(PF(ws) + WS_P);
    const int hd = lane >> 4, e8 = (lane & 15) * 8; const float* png = PF(hg_norm_g);
    float ng[8];
#pragma unroll
    for (int i = 0; i < 8; ++i) ng[i] = png[l * 128 + e8 + i];
    for (int row = wg * 8 + w; row < nrows; row += nwg * 8) {
        bf16_t* rp = P + (size_t)row * PW;
        float a[8], b[8], og[8]; unpack8(*(const u32x4*)(rp + C_BF + hd * 128 + e8), a); unpack8(*(const u32x4*)(rp + C_BF + 512 + hd * 128 + e8), b); unpack8(*(const u32x4*)(rp + C_BO + hd * 128 + e8), og);
        float ss = 0.f;
#pragma unroll
        for (int i = 0; i < 8; ++i) { a[i] += b[i]; ss += a[i] * a[i]; }
        ss += __shfl_xor(ss, 1); ss += __shfl_xor(ss, 2); ss += __shfl_xor(ss, 4); ss += __shfl_xor(ss, 8);
        const float rstd = rsqrtf(ss * (1.0f / 128.0f) + 1e-6f);
        float y[8];
#pragma unroll
        for (int i = 0; i < 8; ++i) y[i] = a[i] * rstd * ng[i] * sigmoidf_(og[i]);
        *(u32x4*)(rp + C_BO + hd * 128 + e8) = pack8(y);
    }
}

__device__ __forceinline__ size_t agg_idx(int b, int gch, int dir, int which, int ch) { return ((((size_t)b * 36 + gch) * 2 + dir) * 2 + which) * 512 + ch; }
__device__ __forceinline__ float gelu_tanh(float x) { const float u = 0.7978845608028654f * (x + 0.044715f * x * x * x); const float th = 1.0f - 2.0f / (1.0f + __expf(2.0f * u)); return 0.5f * x * (1.0f + th); }
__device__ __forceinline__ void lru_tile(const Params& p, int l, LAS unsigned char* lds, int item, int mode, int& staged_nb) {
    LAS bf16_t* Wl = (LAS bf16_t*)lds;
    LAS bf16_t* Xb = Wl + 256 * 72;
    LAS float* Xf = (LAS float*)(lds + 46080);
    LAS float* Av = Xf + 4096;
    LAS float* Bv = Av + 8192;
    bf16_t* P = (bf16_t*)(PF(ws) + WS_P); float* AGG = (float*)(PF(ws) + WS_AGG);
    const int tid = tid_(), w = tid >> 6, lane = tid & 63, l16 = lane & 15, q4 = lane >> 4;
    const int nb = item & 7, rest = item >> 3, gch = rest % 36, b = rest / 36;
    const bool isctx = gch < 4; const int chunk = isctx ? gch : gch - 4, L = isctx ? CTXL : SEQ;
    const size_t seqrow0 = isctx ? (size_t)NLAT + b * CTXL : (size_t)b * SEQ; const int t0 = chunk * 64;
    if (staged_nb != nb) { const float* pwx = PF(lru_wx); const float* pwa = PF(lru_wa);
        for (int e = tid; e < 4 * 64 * 64; e += 512) { const int mat = e >> 12, i = (e >> 6) & 63, c = e & 63; const int dir = mat >> 1, kind = mat & 1;
            const float* W = kind ? pwx : pwa; const float v = W[((size_t)((l * 2 + dir) * 8 + nb) * 64 + i) * 64 + c];
            const int op = dir * 128 + (c >> 4) * 32 + kind * 16 + (c & 15);
            Wl[op * 72 + i] = (bf16_t)f2bf(v); }
        staged_nb = nb;
    }
    {
        const int t = tid >> 3, c8 = (tid & 7) * 8, ch = nb * 64 + c8, tt = t0 + t;
        float a8[8]; const float* pcb = PF(conv_b); const float* pcw = PF(conv_w);
        { const f32x4 b0 = *(const f32x4*)(pcb + l * 512 + ch), b1 = *(const f32x4*)(pcb + l * 512 + ch + 4);
#pragma unroll
          for (int i = 0; i < 4; ++i) { a8[i] = b0[i]; a8[4 + i] = b1[i]; } }
#pragma unroll
        for (int j = 0; j < 4; ++j) { const int ts = tt + j - 2;
            if (ts >= 0 && ts < L) { float xv[8]; unpack8(*(const u32x4*)(P + (seqrow0 + ts) * PW + C_AX + ch), xv);
                const f32x4 w0 = *(const f32x4*)(pcw + (l * 4 + j) * 512 + ch), w1 = *(const f32x4*)(pcw + (l * 4 + j) * 512 + ch + 4);
#pragma unroll
                for (int i = 0; i < 4; ++i) { a8[i] += xv[i] * w0[i]; a8[4 + i] += xv[4 + i] * w1[i]; } } }
#pragma unroll
        for (int i = 0; i < 8; ++i) Xf[t * 64 + c8 + i] = a8[i];
        *(LAS u32x4*)(Xb + t * 72 + c8) = pack8(a8);
    }
    __syncthreads();
    {
        const int dir = w >> 2, c = (w & 3) * 16 + l16, ch = nb * 64 + c;
        f32x4 acc[4][2];
#pragma unroll
        for (int mg = 0; mg < 4; ++mg) { acc[mg][0] = (f32x4){0.f, 0.f, 0.f, 0.f}; acc[mg][1] = (f32x4){0.f, 0.f, 0.f, 0.f}; }
#pragma unroll
        for (int ks = 0; ks < 2; ++ks) {
            const bf16x8 B0 = *(const LAS bf16x8*)(Wl + (w * 32 + l16) * 72 + ks * 32 + q4 * 8), B1 = *(const LAS bf16x8*)(Wl + (w * 32 + 16 + l16) * 72 + ks * 32 + q4 * 8);
#pragma unroll
            for (int mg = 0; mg < 4; ++mg) { const bf16x8 A = *(const LAS bf16x8*)(Xb + (mg * 16 + l16) * 72 + ks * 32 + q4 * 8);
                acc[mg][0] = mfma16(A, B0, acc[mg][0]); acc[mg][1] = mfma16(A, B1, acc[mg][1]); }
        }
        const float ba = PF(lru_ba)[(l * 2 + dir) * 512 + ch], bx = PF(lru_bx)[(l * 2 + dir) * 512 + ch], lam = PF(lru_lambda)[(l * 2 + dir) * 512 + ch];
        const float sp = log1pf(expf(-lam));
#pragma unroll
        for (int mg = 0; mg < 4; ++mg)
#pragma unroll
            for (int j = 0; j < 4; ++j) { const int t = mg * 16 + q4 * 4 + j;
                const float ea = 1.0f + __expf(-(acc[mg][0][j] + ba)), ex = 1.0f + __expf(-(acc[mg][1][j] + bx)); const float inv = __builtin_amdgcn_rcpf(ea * ex);
                const float r = inv * ex, ig = inv * ea;
                const float la = -8.0f * r * sp; const float a = __expf(la); const float x2 = 2.0f * la;
                float om = -x2 * (1.0f + x2 * (0.5f + x2 * (0.16666667f + x2 * (0.041666668f + x2 * 0.0083333338f))));
                if (x2 < -0.35f) om = 1.0f - a * a;
                const float bb = sqrtf(fmaxf(om, 0.f)) * ig * Xf[t * 64 + c];
                Av[(dir * 64 + t) * 64 + c] = a; Bv[(dir * 64 + t) * 64 + c] = bb; }
    }
    __syncthreads();
    {
        LAS float* SegA = Xf;
        LAS float* SegB = Xf + 512;
        const int d2 = tid >> 8, seg = (tid >> 6) & 3, c = tid & 63, ch = nb * 64 + c;
        float av[16], bv[16];
#pragma unroll
        for (int k = 0; k < 16; ++k) { const int s = seg * 16 + k; const int t = d2 ? 63 - s : s; const int ix = (d2 * 64 + t) * 64 + c; av[k] = Av[ix]; bv[k] = Bv[ix]; }
        float h = 0.f, ap = 1.f;
#pragma unroll
        for (int k = 0; k < 16; ++k) { h = av[k] * h + bv[k]; ap *= av[k]; }
        SegA[(d2 * 4 + seg) * 64 + c] = ap; SegB[(d2 * 4 + seg) * 64 + c] = h;
        float hin = 0.f;
        if (mode == 1) {
            const int mypos = d2 == 0 ? gch : (gch < 4 ? 3 - gch : 39 - gch);
            for (int p0 = 0; p0 < mypos; p0 += 6) { float Aa[6], Bb[6];
#pragma unroll
                for (int j = 0; j < 6; ++j) { const int pp = p0 + j; const int g = d2 == 0 ? pp : (pp < 4 ? 3 - pp : 39 - pp); const bool ok = pp < mypos;
                    Aa[j] = ok ? AGG[agg_idx(b, ok ? g : 0, d2, 0, ch)] : 1.0f; Bb[j] = ok ? AGG[agg_idx(b, ok ? g : 0, d2, 1, ch)] : 0.0f; }
#pragma unroll
                for (int j = 0; j < 6; ++j) hin = Aa[j] * hin + Bb[j]; }
        }
        __syncthreads();
        if (mode == 0) {
            if (seg == 3) { float A = 1.f, B = 0.f;
#pragma unroll
                for (int s2 = 0; s2 < 4; ++s2) { const float sa = SegA[(d2 * 4 + s2) * 64 + c], sb2 = SegB[(d2 * 4 + s2) * 64 + c]; B = sa * B + sb2; A *= sa; }
                AGG[agg_idx(b, gch, d2, 0, ch)] = A; AGG[agg_idx(b, gch, d2, 1, ch)] = B; }
        } else {
#pragma unroll
            for (int s2 = 0; s2 < 3; ++s2) if (s2 < seg) hin = SegA[(d2 * 4 + s2) * 64 + c] * hin + SegB[(d2 * 4 + s2) * 64 + c];
            float hh2 = hin;
#pragma unroll
            for (int k = 0; k < 16; ++k) { const int s = seg * 16 + k; const int t = d2 ? 63 - s : s; hh2 = av[k] * hh2 + bv[k]; Bv[(d2 * 64 + t) * 64 + c] = hh2; }
        }
    }
    __syncthreads();
    if (mode == 1) {
        const int t = tid >> 3, c8 = (tid & 7) * 8; bf16_t* gp = P + (seqrow0 + t0 + t) * PW + C_AG + nb * 64 + c8;
        float gt[8]; unpack8(*(const u32x4*)gp, gt); float y[8];
#pragma unroll
        for (int i = 0; i < 8; ++i) y[i] = (Bv[t * 64 + c8 + i] + Bv[(64 + t) * 64 + c8 + i]) * gelu_tanh(gt[i]);
        *(u32x4*)gp = pack8(y);
        __syncthreads();
    }
}

__device__ __forceinline__ void attn_item(const Params& p, int l, LAS unsigned char* lds, int item, int dry = 0) {
    LAS bf16_t* Kt = (LAS bf16_t*)lds;
    LAS bf16_t* Vt = Kt + 2 * 64 * 72;
    LAS float* rpbL = (LAS float*)(lds + 36864);
    LAS float* cosT = rpbL + 960;
    LAS float* sinT = cosT + 1024;
    LAS float* gq = sinT + 1024; LAS float* gk = gq + 64;
    bf16_t* P = (bf16_t*)(PF(ws) + WS_P); const float* rope = (const float*)(PF(ws) + WS_ROPE);
    const int tid = tid_(), w = __builtin_amdgcn_readfirstlane(tid >> 6), lane = tid & 63, l16 = lane & 15, q4 = lane >> 4, hh = w >> 2, qg4 = w & 3;
    const bool isctx = item >= 512;
    int b, hp, nloc, krU; int rq[2], kq0[2]; size_t qrow0[2];
    if (!isctx) { hp = item & 3; const int rp = (item >> 2) & 15; b = item >> 6;
        rq[0] = 2 * rp; rq[1] = 2 * rp + 1; kq0[0] = min(max(rq[0] - 4, 0), 24); kq0[1] = min(max(rq[1] - 4, 0), 24);
        qrow0[0] = (size_t)b * SEQ + rq[0] * 64; qrow0[1] = qrow0[0] + 64; krU = kq0[0]; nloc = kq0[1] + 8 - kq0[0]; }
    else { const int it = item - 512; hp = it & 3; const int qt = (it >> 2) & 1; b = it >> 3; rq[0] = rq[1] = 0; kq0[0] = kq0[1] = 0; krU = 0; nloc = 0;
        qrow0[0] = (size_t)NLAT + b * CTXL + qt * 128; qrow0[1] = qrow0[0] + 64; }
    const int h = hp * 2 + hh;
    const float* prpb = PF(na_rpb);
    for (int i = tid; i < 2 * 465; i += 512) { const int h2 = i / 465, j = i - h2 * 465; rpbL[h2 * 480 + j] = prpb[(size_t)((l * 8 + hp * 2 + h2) * 465) + j]; }
    for (int i = tid; i < 1024; i += 512) { cosT[i] = rope[i]; sinT[i] = rope[1024 + i]; }
    if (tid < 64) { gq[tid] = PF(na_qg)[l * 64 + tid]; gk[tid] = PF(na_kg)[l * 64 + tid]; }
    __syncthreads();
    const int qc = qg4 * 16 + l16;
    const int glo = qg4 < 2 ? 0 : qg4 - 1, ghi = qg4 == 0 ? 1 : (qg4 == 3 ? 3 : qg4 + 1);
    int bidx[4][4]; unsigned mbits = 0u;
    { const int cs0 = min(max(qc - 8, 0), 48);
#pragma unroll
      for (int g = 0; g < 4; ++g)
#pragma unroll
          for (int j = 0; j < 4; ++j) { const int kc = g * 16 + q4 * 4 + j; bidx[g][j] = hh * 480 + min(max(kc - qc, -15), 15) + 15; if (kc < cs0 || kc >= cs0 + 16) mbits |= 1u << (g * 4 + j); } }
    bf16x8 qpl[2][2], qrt[2][2];
#pragma unroll
    for (int qi = 0; qi < 2; ++qi) {
        const bf16_t* qp = P + (qrow0[qi] + qc) * PW + C_CQ + h * 64;
        float xq[16]; unpack8(*(const u32x4*)(qp + q4 * 8), xq); unpack8(*(const u32x4*)(qp + 32 + q4 * 8), xq + 8);
        float ss = 0.f;
#pragma unroll
        for (int i = 0; i < 16; ++i) ss += xq[i] * xq[i];
        ss += __shfl_xor(ss, 16); ss += __shfl_xor(ss, 32);
        const float rs = rsqrtf(ss * (1.0f / 64.0f) + 1e-6f) * 0.125f;
#pragma unroll
        for (int i = 0; i < 8; ++i) { xq[i] *= rs * gq[q4 * 8 + i]; xq[8 + i] *= rs * gq[32 + q4 * 8 + i]; }
        qpl[qi][0] = as_bf16x8(pack8(xq)); qpl[qi][1] = as_bf16x8(pack8(xq + 8));
        float xr[16];
#pragma unroll
        for (int ks = 0; ks < 2; ++ks) { const int pos = ks == 0 ? rq[qi] : qc;
#pragma unroll
            for (int jj = 0; jj < 8; ++jj) { const int fi = (q4 & 1) * 8 + jj; const float cs = cosT[pos * 16 + fi], sn = sinT[pos * 16 + fi]; const float xv = xq[ks * 8 + jj]; const float pr = __shfl_xor(xv, 32);
                xr[ks * 8 + jj] = (q4 < 2) ? (xv * cs - pr * sn) : (xv * cs + pr * sn); } }
        qrt[qi][0] = as_bf16x8(pack8(xr)); qrt[qi][1] = as_bf16x8(pack8(xr + 8));
    }
    f32x4 O[2][4];
#pragma unroll
    for (int qi = 0; qi < 2; ++qi)
#pragma unroll
        for (int i = 0; i < 4; ++i) O[qi][i] = (f32x4){0.f, 0.f, 0.f, 0.f};
    float mrun[2] = {-1e30f, -1e30f}, lsum[2] = {0.f, 0.f};
    const int pf_hh2 = tid >> 8, pf_h2 = hp * 2 + pf_hh2, pf_key = (tid & 255) >> 2, pf_seg = tid & 3, pf_vseg = (tid & 255) >> 6, pf_vkey = tid & 63;
    u32x4 pk0, pk1, pv0, pv1;
    { const size_t r0 = nloc ? (size_t)b * SEQ + krU * 64 : (size_t)NLAT + b * CTXL;
      const bf16_t* kp = P + (r0 + pf_key) * PW + C_CK + pf_h2 * 64 + pf_seg * 16; pk0 = *(const u32x4*)kp; pk1 = *(const u32x4*)(kp + 8);
      const bf16_t* vp = P + (r0 + pf_vkey) * PW + C_CV + pf_h2 * 64 + pf_vseg * 16; pv0 = *(const u32x4*)vp; pv1 = *(const u32x4*)(vp + 8); }
    const int ntot = nloc + 4; int Tn = 0;
#pragma unroll
    for (int ph = 0; ph < 2; ++ph) {
    const bool loc = (ph == 0); const int ntile = loc ? nloc : 4;
    for (int kt = 0; kt < ntile; ++kt) {
        const int kr = krU + kt; ++Tn;
        {
            const int hh2 = pf_hh2, key = pf_key, seg = pf_seg;
            float xk[16]; unpack8(pk0, xk); unpack8(pk1, xk + 8);
            float ss = 0.f;
#pragma unroll
            for (int i = 0; i < 16; ++i) ss += xk[i] * xk[i];
            ss += __shfl_xor(ss, 1); ss += __shfl_xor(ss, 2);
            const float rs = rsqrtf(ss * (1.0f / 64.0f) + 1e-6f);
#pragma unroll
            for (int i = 0; i < 16; ++i) xk[i] *= rs * gk[seg * 16 + i];
            if (loc) { const int pos = seg < 2 ? kr : key;
#pragma unroll
                for (int i = 0; i < 16; ++i) { const float pr = __shfl_xor(xk[i], 1); const float cs = cosT[pos * 16 + i], sn = sinT[pos * 16 + i]; xk[i] = (seg & 1) ? (xk[i] * cs + pr * sn) : (xk[i] * cs - pr * sn); } }
            LAS bf16_t* kd = Kt + (hh2 * 64 + key) * 72 + seg * 16;
            *(LAS u32x4*)kd = pack8(xk); *(LAS u32x4*)(kd + 8) = pack8(xk + 8);
        }
        {
            const int hh2 = pf_hh2, seg = pf_vseg, key = pf_vkey;
            const u32x4 a = pv0, c = pv1;
            LAS bf16_t* vd = Vt + (hh2 * 64 + seg * 16) * 72 + key;
            vd[0 * 72] = (bf16_t)(a.x & 0xffff); vd[1 * 72] = (bf16_t)(a.x >> 16); vd[2 * 72] = (bf16_t)(a.y & 0xffff); vd[3 * 72] = (bf16_t)(a.y >> 16);
            vd[4 * 72] = (bf16_t)(a.z & 0xffff); vd[5 * 72] = (bf16_t)(a.z >> 16); vd[6 * 72] = (bf16_t)(a.w & 0xffff); vd[7 * 72] = (bf16_t)(a.w >> 16);
            vd[8 * 72] = (bf16_t)(c.x & 0xffff); vd[9 * 72] = (bf16_t)(c.x >> 16); vd[10 * 72] = (bf16_t)(c.y & 0xffff); vd[11 * 72] = (bf16_t)(c.y >> 16);
            vd[12 * 72] = (bf16_t)(c.z & 0xffff); vd[13 * 72] = (bf16_t)(c.z >> 16); vd[14 * 72] = (bf16_t)(c.w & 0xffff); vd[15 * 72] = (bf16_t)(c.w >> 16);
        }
        if (Tn < ntot) { const size_t r0 = (Tn < nloc) ? (size_t)b * SEQ + (krU + Tn) * 64 : (size_t)NLAT + b * CTXL + (Tn - nloc) * 64;
            const bf16_t* kp = P + (r0 + pf_key) * PW + C_CK + pf_h2 * 64 + pf_seg * 16; pk0 = *(const u32x4*)kp; pk1 = *(const u32x4*)(kp + 8);
            const bf16_t* vp = P + (r0 + pf_vkey) * PW + C_CV + pf_h2 * 64 + pf_vseg * 16; pv0 = *(const u32x4*)vp; pv1 = *(const u32x4*)(vp + 8); }
        __syncthreads();
#pragma unroll
        for (int qi = 0; qi < 2; ++qi) {
            if (loc && (kr < kq0[qi] || kr >= kq0[qi] + 8)) continue;
            f32x4 st[4];
#pragma unroll
            for (int g = 0; g < 4; ++g) { const bool use = !loc || (g >= glo && g <= ghi);
                st[g] = (f32x4){0.f, 0.f, 0.f, 0.f};
                if (use) {
#pragma unroll
                    for (int ks = 0; ks < 2; ++ks) st[g] = mfma16(*(const LAS bf16x8*)(Kt + (hh * 64 + g * 16 + l16) * 72 + ks * 32 + q4 * 8), loc ? qrt[qi][ks] : qpl[qi][ks], st[g]);
                    if (loc) { const int dr31 = (kr - rq[qi] + 7) * 31;
#pragma unroll
                        for (int j = 0; j < 4; ++j) { const float sv = st[g][j] + rpbL[bidx[g][j] + dr31]; st[g][j] = ((mbits >> (g * 4 + j)) & 1u) ? -1e30f : sv; } }
                } else st[g] = (f32x4){-1e30f, -1e30f, -1e30f, -1e30f};
            }
            float tmax = -1e30f;
#pragma unroll
            for (int g = 0; g < 4; ++g)
#pragma unroll
                for (int j = 0; j < 4; ++j) tmax = fmaxf(tmax, st[g][j]);
            tmax = fmaxf(tmax, __shfl_xor(tmax, 16)); tmax = fmaxf(tmax, __shfl_xor(tmax, 32));
            const float mnew = fmaxf(mrun[qi], tmax); const float alpha = __expf(mrun[qi] - mnew); mrun[qi] = mnew;
            float psum = 0.f;
#pragma unroll
            for (int g = 0; g < 4; ++g) { const bool use = !loc || (g >= glo && g <= ghi);
                if (use) {
#pragma unroll
                    for (int j = 0; j < 4; ++j) { const float pv = __expf(st[g][j] - mnew); st[g][j] = pv; psum += pv; }
                } else st[g] = (f32x4){0.f, 0.f, 0.f, 0.f}; }
            lsum[qi] = lsum[qi] * alpha + psum;
#pragma unroll
            for (int i = 0; i < 4; ++i) O[qi][i] *= alpha;
            bf16x8 pb[2];
#pragma unroll
            for (int ks = 0; ks < 2; ++ks) { u32x4 wv; wv.x = pack2(st[2 * ks][0], st[2 * ks][1]); wv.y = pack2(st[2 * ks][2], st[2 * ks][3]); wv.z = pack2(st[2 * ks + 1][0], st[2 * ks + 1][1]); wv.w = pack2(st[2 * ks + 1][2], st[2 * ks + 1][3]); pb[ks] = as_bf16x8(wv); }
#pragma unroll
            for (int ks = 0; ks < 2; ++ks) if (!loc || (2 * ks + 1 >= glo && 2 * ks <= ghi))
#pragma unroll
                for (int dg = 0; dg < 4; ++dg) { const LAS bf16_t* vr = Vt + (hh * 64 + dg * 16 + l16) * 72 + ks * 32 + q4 * 4;
                    const u32x2 lo = *(const LAS u32x2*)vr, hi = *(const LAS u32x2*)(vr + 16); u32x4 av; av.x = lo.x; av.y = lo.y; av.z = hi.x; av.w = hi.y;
                    O[qi][dg] = mfma16(as_bf16x8(av), pb[ks], O[qi][dg]); }
        }
        __syncthreads();
    }
    }
#pragma unroll
    for (int qi = 0; qi < 2; ++qi) {
        float ls = lsum[qi]; ls += __shfl_xor(ls, 16); ls += __shfl_xor(ls, 32);
        const float inv = 1.0f / ls;
        bf16_t* op = dry ? ((bf16_t*)(PF(ws) + WS_DUMMY) + (size_t)(blockIdx.x & 63) * 16384 + (size_t)((qi * 8 + w) * 16 + l16) * 64) : (P + (qrow0[qi] + qc) * PW + C_CQ + h * 64);
#pragma unroll
        for (int dg = 0; dg < 4; ++dg) { u32x2 wv; wv.x = pack2(O[qi][dg][0] * inv, O[qi][dg][1] * inv); wv.y = pack2(O[qi][dg][2] * inv, O[qi][dg][3] * inv); *(u32x2*)(op + dg * 16 + q4 * 4) = wv; }
    }
    __syncthreads();
}

__device__ __forceinline__ void hgrn_stage(const bf16_t* P, LAS unsigned char* lds, int w, int lane, size_t row0, int dir, int h) {
#pragma unroll
    for (int i = 0; i < 2; ++i) { const int blk = i * 8 + w; const int t = blk * 4 + (lane >> 4); const bf16_t* rp = P + (row0 + (dir ? 63 - t : t)) * PW + (lane & 15) * 8;
        __builtin_amdgcn_global_load_lds((const unsigned*)(rp + C_BQ + h * 128), (LAS unsigned*)(lds + 118784 + blk * 1024), 16, 0, 0);
        __builtin_amdgcn_global_load_lds((const unsigned*)(rp + C_BF + dir * 512 + h * 128), (LAS unsigned*)(lds + 135168 + blk * 1024), 16, 0, 0); }
}
__device__ __forceinline__ void hgrn_chain(const Params& p, int l, LAS unsigned char* lds, int chain, int dry = 0) {
    LAS bf16_t* Q0 = (LAS bf16_t*)lds;
    LAS bf16_t* KP = (LAS bf16_t*)(lds + 17408);
    LAS bf16_t* SB = (LAS bf16_t*)(lds + 34816);
    LAS bf16_t* KDT = (LAS bf16_t*)(lds + 69632);
    LAS bf16_t* VT = (LAS bf16_t*)(lds + 88064);
    LAS bf16_t* ATT = (LAS bf16_t*)(lds + 106496);
    LAS float* TOT = (LAS float*)(lds + 115712);
    LAS float* DD = (LAS float*)(lds + 117760);
    const LAS bf16_t* SQ = (const LAS bf16_t*)(lds + 118784);
    const LAS bf16_t* SF = (const LAS bf16_t*)(lds + 135168);
    bf16_t* P = (bf16_t*)(PF(ws) + WS_P);
    const int tid = tid_(), w = __builtin_amdgcn_readfirstlane(tid >> 6), lane = tid & 63, l16 = lane & 15, q4 = lane >> 4;
    const int dir = chain & 1, h = (chain >> 1) & 3, b = chain >> 3;
    const int d = tid & 127, sb = tid >> 7;
    float lbv = 0.f;
    if (l > 0) { const float x0 = PF(hg_lb)[(dir * 2 + 0) * 512 + h * 128 + d], x1 = PF(hg_lb)[(dir * 2 + 1) * 512 + h * 128 + d]; lbv = 1.0f / (1.0f + expf(x0 - x1)); }
    for (int i = tid; i < 64 * 72 / 2; i += 512) ((LAS unsigned*)ATT)[i] = 0u;
    f32x4 S[8];
#pragma unroll
    for (int i = 0; i < 8; ++i) S[i] = (f32x4){0.f, 0.f, 0.f, 0.f};
    { const int gch0 = dir == 0 ? 0 : 3; hgrn_stage(P, lds, w, lane, (size_t)NLAT + b * CTXL + gch0 * 64, dir, h); }
    asm volatile("s_waitcnt vmcnt(0)" ::: "memory");
    __syncthreads();
    for (int ci = 0; ci < 36; ++ci) {
        const int gch = dir == 0 ? ci : (ci < 4 ? 3 - ci : 39 - ci);
        const bool isctx = gch < 4; const int chunk = isctx ? gch : gch - 4;
        const size_t row0 = isctx ? (size_t)NLAT + b * CTXL + chunk * 64 : (size_t)b * SEQ + chunk * 64;
        float bl[16], qv[16], kv[16]; float run = 0.f;
        {
            unsigned vraw[16];
#pragma unroll
            for (int ii = 0; ii < 16; ++ii) { const int t = sb * 16 + ii; vraw[ii] = P[(row0 + (dir ? 63 - t : t)) * PW + C_BI + h * 128 + d]; }
#pragma unroll
            for (int eg = 0; eg < 8; ++eg) { u32x2 wv; wv.x = pack2(S[eg][0], S[eg][1]); wv.y = pack2(S[eg][2], S[eg][3]); *(LAS u32x2*)(SB + (eg * 16 + l16) * 136 + w * 16 + q4 * 4) = wv; }
#pragma unroll
            for (int ii = 0; ii < 16; ++ii) { const int t = sb * 16 + ii;
                const float fr = bf2f(SF[t * 128 + d]), qr = bf2f(SQ[t * 128 + d]);
                const float sg = 1.0f / (1.0f + __expf(-fr)); const float f = lbv + (1.0f - lbv) * sg; run += __logf(f); bl[ii] = run; kv[ii] = 1.0f - f; qv[ii] = qr / (1.0f + __expf(-qr)); }
            TOT[sb * 128 + d] = run;
            u32x4 v0, v1; v0.x = vraw[0] | (vraw[1] << 16); v0.y = vraw[2] | (vraw[3] << 16); v0.z = vraw[4] | (vraw[5] << 16); v0.w = vraw[6] | (vraw[7] << 16);
            v1.x = vraw[8] | (vraw[9] << 16); v1.y = vraw[10] | (vraw[11] << 16); v1.z = vraw[12] | (vraw[13] << 16); v1.w = vraw[14] | (vraw[15] << 16);
            *(LAS u32x4*)(VT + d * 72 + sb * 16) = v0; *(LAS u32x4*)(VT + d * 72 + sb * 16 + 8) = v1;
        }
        __syncthreads();
        if (ci < 35) { const int cn = ci + 1; const int gn = dir == 0 ? cn : (cn < 4 ? 3 - cn : 39 - cn); const bool cx = gn < 4; const int ck = cx ? gn : gn - 4;
            hgrn_stage(P, lds, w, lane, cx ? (size_t)NLAT + b * CTXL + ck * 64 : (size_t)b * SEQ + ck * 64, dir, h); }
        {
            const float t0 = TOT[d], t1 = TOT[128 + d], t2 = TOT[256 + d], t3 = TOT[384 + d];
            const float Bs1 = t0, Bs2 = t0 + t1, Bs3 = Bs2 + t2, total = Bs3 + t3;
            const float Bsb = sb == 0 ? 0.f : (sb == 1 ? Bs1 : (sb == 2 ? Bs2 : Bs3));
            const float eB = __expf(Bsb), eT = __expf(total);
            float kd[16];
#pragma unroll
            for (int ii = 0; ii < 16; ++ii) { const float e0 = __expf(bl[ii]); Q0[(sb * 16 + ii) * 136 + d] = (bf16_t)pack2(qv[ii] * e0 * eB, 0.f);
                const float kp = kv[ii] * __expf(fminf(-(Bsb + bl[ii]), 80.f)); KP[(sb * 16 + ii) * 136 + d] = (bf16_t)pack2(kp, 0.f); kd[ii] = kp * eT; }
            *(LAS u32x4*)(KDT + d * 72 + sb * 16) = pack8(kd); *(LAS u32x4*)(KDT + d * 72 + sb * 16 + 8) = pack8(kd + 8);
            if (sb == 0) DD[d] = eT;
        }
        __syncthreads();
#pragma unroll
        for (int k2 = 0; k2 < 2; ++k2) { const int idx = w + 8 * k2;
            if (idx < 10) { const int i = idx < 1 ? 0 : (idx < 3 ? 1 : (idx < 6 ? 2 : 3)); const int j = idx - i * (i + 1) / 2;
                f32x4 sc = (f32x4){0.f, 0.f, 0.f, 0.f};
                const LAS bf16_t* qb = Q0 + (i * 16 + l16) * 136 + q4 * 8; const LAS bf16_t* kb = KP + (j * 16 + l16) * 136 + q4 * 8;
#pragma unroll
                for (int ks = 0; ks < 4; ++ks) sc = mfma16(*(const LAS bf16x8*)(qb + ks * 32), *(const LAS bf16x8*)(kb + ks * 32), sc);
#pragma unroll
                for (int jj = 0; jj < 4; ++jj) { const float v = (i == j && l16 > q4 * 4 + jj) ? 0.f : sc[jj]; ATT[(i * 16 + q4 * 4 + jj) * 72 + j * 16 + l16] = (bf16_t)pack2(v, 0.f); } } }
        __syncthreads();
        {
            bf16x8 SBf[4], VTf[2];
#pragma unroll
            for (int ks = 0; ks < 4; ++ks) SBf[ks] = *(const LAS bf16x8*)(SB + (w * 16 + l16) * 136 + ks * 32 + q4 * 8);
#pragma unroll
            for (int ks = 0; ks < 2; ++ks) VTf[ks] = *(const LAS bf16x8*)(VT + (w * 16 + l16) * 72 + ks * 32 + q4 * 8);
#pragma unroll
            for (int i = 0; i < 4; ++i) { f32x4 oa = (f32x4){0.f, 0.f, 0.f, 0.f};
#pragma unroll
                for (int ks = 0; ks < 4; ++ks) oa = mfma16(SBf[ks], *(const LAS bf16x8*)(Q0 + (i * 16 + l16) * 136 + ks * 32 + q4 * 8), oa);
#pragma unroll
                for (int ks = 0; ks < 2; ++ks) oa = mfma16(VTf[ks], *(const LAS bf16x8*)(ATT + (i * 16 + l16) * 72 + ks * 32 + q4 * 8), oa);
                const int t = i * 16 + l16; u32x2 wv; wv.x = pack2(oa[0], oa[1]); wv.y = pack2(oa[2], oa[3]);
                bf16_t* od = dry ? ((bf16_t*)(PF(ws) + WS_DUMMY) + (size_t)chain * 8192 + t * 128 + w * 16 + q4 * 4) : (P + (row0 + (dir ? 63 - t : t)) * PW + C_BF + dir * 512 + h * 128 + w * 16 + q4 * 4);
                *(u32x2*)od = wv; }
        }
        {
            const f32x4 dd = *(const LAS f32x4*)(DD + w * 16 + q4 * 4);
#pragma unroll
            for (int eg = 0; eg < 8; ++eg) S[eg] *= dd;
#pragma unroll
            for (int ks = 0; ks < 2; ++ks) { const bf16x8 A = *(const LAS bf16x8*)(KDT + (w * 16 + l16) * 72 + ks * 32 + q4 * 8);
#pragma unroll
                for (int eg = 0; eg < 8; ++eg) S[eg] = mfma16(A, *(const LAS bf16x8*)(VT + (eg * 16 + l16) * 72 + ks * 32 + q4 * 8), S[eg]); }
        }
        asm volatile("s_waitcnt vmcnt(0)" ::: "memory");
        __syncthreads();
    }
}

__device__ __forceinline__ void dbg_dump() {
    const bf16_t* P = (const bf16_t*)(PF(ws) + WS_P); const bf16_t* U = (const bf16_t*)(PF(ws) + WS_U); const float* AGG = (const float*)(PF(ws) + WS_AGG); float* out = PF(out);
    const size_t n = (size_t)NLAT * DM;
    for (size_t i = (size_t)blockIdx.x * 512 + threadIdx.x; i < n; i += (size_t)gridDim.x * 512) {
        float s = 0.f;
#pragma unroll
        for (int k = 0; k < 5; ++k) s += bf2f(P[i + k * n]);
        s += bf2f(P[(i % ((size_t)NTOK * PW - 5 * n)) + 5 * n]);
        s += bf2f(U[i]) + bf2f(U[(i % ((size_t)NCTX * DM)) + n]);
        s += AGG[i % ((size_t)NB * 36 * 2 * 2 * 512)];
        if (!(s == s)) s = 7777.f; if (fabsf(s) > 1e30f) s = 8888.f; out[i] = s + 1000.0f;
    }
}
#ifndef STAGE_STOP
#define STAGE_STOP 0
#define DBG_SKIP 0
#define STAGE_L 0
#endif
__global__ void __launch_bounds__(512, 2) fwd_megakernel(Params p) {
    extern __shared__ __attribute__((aligned(16))) unsigned char lds_raw[];
    LAS unsigned char* lds = (LAS unsigned char*)lds_raw;
    cg::grid_group grid = cg::this_grid();
    volatile LAS unsigned* xst = (volatile LAS unsigned*)(lds + LDS_BYTES - 16);
    if (threadIdx.x == 0) { xst[0] = 0u; xst[1] = 0u; xst[2] = 0u; xst[3] = 0u; }
    __syncthreads();
    const XcdBarrier xbar = xcd_barrier_post((unsigned*)(PF(ws) + WS_BAR), xst);
    const int G = gridDim.x, c = blockIdx.x;

    phase_mod(p, lds); __syncthreads();
    phase_rope(p);
    phase_convert(p, 0, lds);
    grid.sync();
#define WSP(T, off) ((T*)(PF(ws) + (off)))
    for (int l = 0; l < 2; ++l) {
        const bool lastl = (l == 1);
        const int Mrest = lastl ? NLAT : NTOK;
        if (l > 0) phase_convert(p, l, lds);
        phase_norm(p, l, l == 0 ? PF(x) : PF(out), l == 0 ? PF(ctx) : WSP(const float, WS_HC), PF(norm1_g) + l * DM, 0, NTOK,
                   (l > 0 && G == 256) ? (const float*)(PF(ws) + WS_P + (size_t)NTOK * DFF * 2) : nullptr, WSP(const float, WS_MOD) + (size_t)((l > 0 ? l - 1 : 0) * 9 + 8) * 6144 + 5120);
        xcd_barrier(xbar);

        { pg8::Gemm g{WSP(bf16_t, WS_U), WSP(bf16_t, WS_WIN), DM, DM, DM}; pg8::Sched S; S.init(NTOK, PW, G, c, DM, DM); pg8::EpiStore<0> E{WSP(bf16_t, WS_P), PW}; pg8::gemm_phase(lds, g, S, E); }
        xcd_barrier(xbar);
        if (c < 64) { hgrn_chain(p, l, lds, c); sub_barrier((unsigned*)(PF(ws) + WS_BAR) + 3520 + 64 * (2 * l), 64u); phase_hg_final(p, l, NTOK, c, 64); }
        else { const int cc = c - 64, GG = G - 64; const int nA = lastl ? 512 : 576;
            for (int it = cc; it < nA; it += GG) attn_item(p, l, lds, it);
            int staged = -1;
            for (int it = cc; it < 2304; it += GG) lru_tile(p, l, lds, it, 0, staged);
            sub_barrier((unsigned*)(PF(ws) + WS_BAR) + 3520 + 64 * (2 * l + 1), (unsigned)GG);
            for (int it = cc; it < 2304; it += GG) lru_tile(p, l, lds, it, 1, staged); }
        xcd_barrier(xbar);
        { pg8::Gemm g{WSP(bf16_t, WS_U), WSP(bf16_t, WS_WIN) + (size_t)PW * DM, DM, DM, DM}; pg8::Sched S; S.init(Mrest, 3072, G, c, DM, DM); pg8::EpiStore<1> E{WSP(bf16_t, WS_P), PW}; pg8::gemm_phase(lds, g, S, E); }
        xcd_barrier(xbar);
        { pg8::Gemm g{WSP(bf16_t, WS_P), WSP(bf16_t, WS_WB), PW, 512, 512}; pg8::MergeSched S; S.base.init(Mrest, DM, G, c, PW, 512);
          pg8::EpiMerge E{WSP(bf16_t, WS_P), WSP(bf16_t, WS_U)}; pg8::gemm_phase(lds, g, S, E); }
        xcd_barrier(xbar);
        { pg8::Gemm g{WSP(bf16_t, WS_U), WSP(bf16_t, WS_WO), DM, DM, DM}; pg8::Sched S; S.init(Mrest, DM, G, c, DM, DM);
          pg8::EpiResid E{l == 0 ? PF(x) : PF(out), l == 0 ? PF(ctx) : WSP(const float, WS_HC), PF(out), WSP(float, WS_HC), WSP(const float, WS_MOD) + (size_t)l * 9 * 6144 + 2048}; pg8::gemm_phase(lds, g, S, E); }
        xcd_barrier(xbar);
        phase_norm(p, l, PF(out), WSP(const float, WS_HC), PF(norm2_g) + l * DM, 3072, Mrest);
        xcd_barrier(xbar);
        { pg8::Gemm g{WSP(bf16_t, WS_U), WSP(bf16_t, WS_W1), DM, DM, DM}; pg8::Sched S; S.init(Mrest, DFF, G, c, DM, DM); pg8::EpiStore<2> E{WSP(bf16_t, WS_P), DFF}; pg8::gemm_phase(lds, g, S, E); }
        xcd_barrier(xbar);
        { pg8::Gemm g{WSP(bf16_t, WS_P), WSP(bf16_t, WS_W2), DFF, DFF, DFF};
          float* slab = (float*)(PF(ws) + WS_P + (size_t)NTOK * DFF * 2);
          pg8::EpiResid E{PF(out), WSP(const float, WS_HC), PF(out), WSP(float, WS_HC), WSP(const float, WS_MOD) + (size_t)l * 9 * 6144 + 5120, slab};
          if (!lastl && G == 256) { pg8::SplitSched S; S.base.init(NLAT, DM, G, c, DFF, DFF); pg8::gemm_phase(lds, g, S, E); }
          else { pg8::Sched S; S.init(Mrest, DM, G, c, DFF, DFF); pg8::gemm_phase(lds, g, S, E); } }
        if (!lastl) xcd_barrier(xbar);
    }
}

extern "C" void kernel_launch(void* const* d_in, const int* in_sizes, int n_in, void* d_out, int out_size, void* d_ws, size_t ws_size, hipStream_t stream) {
    static int grid_blocks = 0;
    if (grid_blocks == 0) {
        int dev = 0, cus = 0, per_cu = 0;
        hipGetDevice(&dev);
        hipDeviceGetAttribute(&cus, hipDeviceAttributeMultiprocessorCount, dev);
        hipFuncSetAttribute((const void*)fwd_megakernel, hipFuncAttributeMaxDynamicSharedMemorySize, LDS_BYTES);
        hipOccupancyMaxActiveBlocksPerMultiprocessor(&per_cu, (const void*)fwd_megakernel, 512, LDS_BYTES);
        if (per_cu < 1 || n_in != 25 || ws_size < WS_END) { fprintf(stderr, "kernel_launch: cannot launch (per_cu %d, n_in %d, ws %zu need %zu)\n", per_cu, n_in, ws_size, (size_t)WS_END); grid_blocks = -1; }
        else grid_blocks = cus;
    }
    if (grid_blocks < 0) return;
    hipMemsetAsync((char*)d_ws + WS_BAR, 0, 16384, stream);
    Params p{};
    const float** pp = (const float**)&p;
    for (int i = 0; i < 25; ++i) pp[i] = (const float*)d_in[i];
    p.out = (float*)d_out; p.ws = (unsigned char*)d_ws;
    void* args[] = {&p};
    hipError_t e = hipLaunchCooperativeKernel((const void*)fwd_megakernel, dim3(grid_blocks), dim3(512), args, LDS_BYTES, stream);
    if (e != hipSuccess) fprintf(stderr, "cooperative launch failed: %s (grid %d)\n", hipGetErrorString(e), grid_blocks);
}
```

```cpp
#include <hip/hip_runtime.h>
#include <hip/hip_cooperative_groups.h>
#include <stdint.h>
#include <stdio.h>
namespace cg = cooperative_groups;

#define LAS __attribute__((address_space(3)))
typedef unsigned short bf16_t;
typedef short bf16x8 __attribute__((ext_vector_type(8)));
typedef float f32x4 __attribute__((ext_vector_type(4)));
typedef unsigned u32x4 __attribute__((ext_vector_type(4)));
typedef unsigned u32x2 __attribute__((ext_vector_type(2)));

constexpr int DM = 1024, NB = 8, SEQ = 2048, CTXL = 256, NLAT = NB * SEQ, NCTX = NB * CTXL, NTOK = NLAT + NCTX;
constexpr int PW = 5120, DIN = 8192, DFF = 4096;
constexpr int C_AX = 0, C_AG = 512, C_BQ = 1024, C_BF = 1536, C_BI = 2560, C_BO = 3072, C_CQ = 3584, C_CK = 4096, C_CV = 4608;
constexpr int LDS_BYTES = 163840;
constexpr size_t WS_WIN = 0;
constexpr size_t WS_WB = WS_WIN + (size_t)DIN * DM * 2;
constexpr size_t WS_WO = WS_WB + (size_t)3 * DM * 512 * 2;
constexpr size_t WS_W1 = WS_WO + (size_t)DM * DM * 2;
constexpr size_t WS_W2 = WS_W1 + (size_t)DFF * DM * 2;
constexpr size_t WS_U = WS_W2 + (size_t)DM * DFF * 2;
constexpr size_t WS_P = WS_U + (size_t)NTOK * DM * 2;
constexpr size_t WS_HC = WS_P + (size_t)NTOK * PW * 2;
constexpr size_t WS_MOD = WS_HC + (size_t)NCTX * DM * 4;
constexpr size_t WS_AGG = WS_MOD + (size_t)2 * 9 * 6144 * 4;
constexpr size_t WS_ROPE = WS_AGG + (size_t)NB * 36 * 2 * 2 * 512 * 4;
constexpr size_t WS_DUMMY = WS_ROPE + 2048 * 4;
constexpr size_t WS_BAR = WS_DUMMY + (2u << 20);
constexpr size_t WS_END = WS_BAR + 16384;

struct Params {
    const float *x, *c, *ctx, *c_ctx, *ada_w, *ada_b, *norm1_g, *norm2_g, *w_in, *conv_w, *conv_b, *lru_wa, *lru_ba, *lru_wx, *lru_bx, *lru_lambda,
        *hg_lb, *hg_norm_g, *na_qg, *na_kg, *na_rpb, *w_branch, *w_out, *ffn_w1, *ffn_w2;
    float* out; unsigned char* ws;
};


__device__ __forceinline__ unsigned long long ldkarg(int off) { unsigned long long v = 0;
#if defined(__HIP_DEVICE_COMPILE__)
    auto kp = __builtin_amdgcn_kernarg_segment_ptr();
    asm volatile("s_load_dwordx2 %0, %1, %2\n\ts_waitcnt lgkmcnt(0)" : "=s"(v) : "s"(kp), "s"(off));
#endif
    return v; }
template <class T> struct rm_ptr; template <class T> struct rm_ptr<T*> { typedef T type; };
template <class T> __device__ __forceinline__ T* as_global_ptr(unsigned long long v) { return (T*)(__attribute__((address_space(1))) T*)v; }
#define PF(f) (as_global_ptr<rm_ptr<decltype(Params::f)>::type>(ldkarg((int)__builtin_offsetof(Params, f))))

#define GAS __attribute__((address_space(1)))
template <class T> __device__ __forceinline__ GAS T* lnd(T* p) { asm volatile("" : "+v"(p)); return (GAS T*)p; }
__device__ __forceinline__ int tid_() { int t = threadIdx.x; asm volatile("" : "+v"(t)); return t; }
__device__ __forceinline__ float bf2f(unsigned v) { return __uint_as_float(v << 16); }
__device__ __forceinline__ float bflo(unsigned w) { return __uint_as_float(w << 16); }
__device__ __forceinline__ float bfhi(unsigned w) { return __uint_as_float(w & 0xffff0000u); }
__device__ __forceinline__ unsigned f2bf(float f) { unsigned u = __float_as_uint(f); u += 0x7fffu + ((u >> 16) & 1u); return u >> 16; }
typedef __bf16 bf16x2_t __attribute__((ext_vector_type(2)));
typedef float f32x2_t __attribute__((ext_vector_type(2)));
__device__ __forceinline__ unsigned pack2(float lo, float hi) { f32x2_t v = {lo, hi}; bf16x2_t b = __builtin_convertvector(v, bf16x2_t); union { bf16x2_t b; unsigned u; } t; t.b = b; return t.u; }
__device__ __forceinline__ float sigmoidf_(float x) { return 1.0f / (1.0f + __expf(-x)); }
__device__ __forceinline__ f32x4 mfma16(bf16x8 a, bf16x8 b, f32x4 c) { return __builtin_amdgcn_mfma_f32_16x16x32_bf16(a, b, c, 0, 0, 0); }
__device__ __forceinline__ bf16x8 as_bf16x8(u32x4 v) { union { u32x4 u; bf16x8 b; } t; t.u = v; return t.b; }
__device__ __forceinline__ void unpack8(u32x4 w, float* o) { o[0] = bflo(w.x); o[1] = bfhi(w.x); o[2] = bflo(w.y); o[3] = bfhi(w.y); o[4] = bflo(w.z); o[5] = bfhi(w.z); o[6] = bflo(w.w); o[7] = bfhi(w.w); }
__device__ __forceinline__ u32x4 pack8(const float* v) { u32x4 w; w.x = pack2(v[0], v[1]); w.y = pack2(v[2], v[3]); w.z = pack2(v[4], v[5]); w.w = pack2(v[6], v[7]); return w; }

namespace pg8 {
constexpr int BM = 256, BK = 64, HALF = 128, HTB = HALF * BK * 2, NXCD = 8, WGM = 8;
__device__ __forceinline__ int lds_byte(int r, int c) { const int st = (r >> 4) * 2 + (c >> 5), rr = r & 15, cc = c & 31, ob = rr * 64 + cc * 2; return st * 1024 + (ob ^ (((ob >> 9) & 1) << 5)); }
__device__ __forceinline__ void stage_rc(int b, int& R, int& C) { const int st = b / 1024, sb = b % 1024, swz = sb ^ (((sb >> 9) & 1) << 5); R = (st >> 1) * 16 + swz / 64; C = (st & 1) * 32 + (swz % 64) / 2; }
__device__ __forceinline__ int perm32(int rho) { const int n = rho >> 4, i = rho & 15; return 8 * (i >> 2) + 4 * n + (i & 3); }

struct Unit { int pm, pn, sub, nt; size_t aoff, boff; };
struct Gemm { const bf16_t* A; const bf16_t* Bt; int lda, ldb, K; };
struct Sched {
    int nM, nN, nwg, G, c, lda, ldb, nt;
    __device__ void init(int M, int N, int G_, int c_, int lda_, int ldb_) { nM = M / BM; nN = N / BM; nwg = nM * nN; G = G_; c = c_; lda = lda_; ldb = ldb_; nt = 0; }
    __device__ bool next(int i, Unit& u) const {
        const long L = (long)i * G + c; if (L >= nwg) return false;
        int wgid = (int)L; { const int q = nwg / NXCD, r = nwg % NXCD, xcd = wgid % NXCD, off = wgid / NXCD; wgid = (xcd < r ? xcd * (q + 1) : r * (q + 1) + (xcd - r) * q) + off; }
        const int nig = WGM * nN, gid = wgid / nig, fm = gid * WGM, gsz = (nM - fm) < WGM ? (nM - fm) : WGM;
        u.pm = fm + ((wgid % nig) % gsz); u.pn = (wgid % nig) / gsz; u.sub = 0; u.nt = nt;
        u.aoff = (size_t)u.pm * BM * lda * 2;
        u.boff = (size_t)u.pn * BM * ldb * 2;
        return true;
    }
};

template <int ACT> struct EpiStore {
    static constexpr bool PERM = true;
    bf16_t* O; int ldc;
    __device__ __forceinline__ void operator()(const f32x4 (&acc)[2][2][4][2], const Unit& u, int wr, int wc, int fr, int fq) const {
        const int row0 = u.pm * BM + wr * 64 + fr; int colt = u.pn * BM;
        if (ACT == 1) colt = (colt < 2048) ? (1024 + colt) : (2048 + colt);
        const int col0 = colt + wc * 32 + 8 * fq;
#pragma unroll
        for (int ai = 0; ai < 2; ++ai)
#pragma unroll
            for (int m = 0; m < 4; ++m) { GAS bf16_t* rowp = lnd(O + (size_t)(row0 + ai * HALF + m * 16) * ldc + col0);
#pragma unroll
                for (int bj = 0; bj < 2; ++bj) { f32x4 v0 = acc[ai][bj][m][0], v1 = acc[ai][bj][m][1];
                    if (ACT == 1) {
#pragma unroll
                        for (int j = 0; j < 4; ++j) { v0[j] = sigmoidf_(v0[j]); v1[j] = sigmoidf_(v1[j]); } }
                    if (ACT == 2) {
#pragma unroll
                        for (int j = 0; j < 4; ++j) { float a = fmaxf(v0[j], 0.f), b = fmaxf(v1[j], 0.f); v0[j] = a * a; v1[j] = b * b; } }
                    u32x4 w; w.x = pack2(v0[0], v0[1]); w.y = pack2(v0[2], v0[3]); w.z = pack2(v1[0], v1[1]); w.w = pack2(v1[2], v1[3]);
                    *(GAS u32x4*)(rowp + bj * HALF) = w; } }
    }
};
struct EpiMerge {
    static constexpr bool PERM = true;
    const bf16_t* P; bf16_t* U;
    __device__ __forceinline__ void operator()(const f32x4 (&acc)[2][2][4][2], const Unit& u, int wr, int wc, int fr, int fq) const {
        const int row0 = u.pm * BM + wr * 64 + fr; const int col0 = u.pn * BM + wc * 32 + 8 * fq;
        const int sub = u.sub; const int gcol = sub * 1024 + u.pn * BM; const int gd = ((gcol < 2048) ? (1024 + gcol) : (2048 + gcol)) + wc * 32 + 8 * fq;
        const bool addp = sub > 0;
#pragma unroll
        for (int ai = 0; ai < 2; ++ai)
#pragma unroll
            for (int m = 0; m < 4; ++m) { const size_t row = (size_t)(row0 + ai * HALF + m * 16); const GAS bf16_t* gp = lnd(P + row * PW + gd); GAS bf16_t* up = lnd(U + row * DM + col0);
#pragma unroll
                for (int bj = 0; bj < 2; ++bj) { const u32x4 gw = *(const GAS u32x4*)(gp + bj * HALF);
                    f32x4 a0 = acc[ai][bj][m][0], a1 = acc[ai][bj][m][1];
                    a0[0] *= bflo(gw.x); a0[1] *= bfhi(gw.x); a0[2] *= bflo(gw.y); a0[3] *= bfhi(gw.y); a1[0] *= bflo(gw.z); a1[1] *= bfhi(gw.z); a1[2] *= bflo(gw.w); a1[3] *= bfhi(gw.w);
                    if (addp) { const u32x4 pw = *(const GAS u32x4*)(up + bj * HALF);
                        a0[0] += bflo(pw.x); a0[1] += bfhi(pw.x); a0[2] += bflo(pw.y); a0[3] += bfhi(pw.y); a1[0] += bflo(pw.z); a1[1] += bfhi(pw.z); a1[2] += bflo(pw.w); a1[3] += bfhi(pw.w); }
                    u32x4 o; o.x = pack2(a0[0], a0[1]); o.y = pack2(a0[2], a0[3]); o.z = pack2(a1[0], a1[1]); o.w = pack2(a1[2], a1[3]);
                    *(GAS u32x4*)(up + bj * HALF) = o; } }
    }
};
struct EpiResid {
    static constexpr bool PERM = true;
    const float* inL; const float* inC; float* outL; float* outC; const float* mod;
    float* slab;
    __device__ __forceinline__ void operator()(const f32x4 (&acc)[2][2][4][2], const Unit& u, int wr, int wc, int fr, int fq) const {
        if (u.sub >= 1) {
            const int row0 = (u.pm - 64) * BM + wr * 64 + fr, col0 = u.pn * BM + wc * 32 + 8 * fq; float* sl = slab + (size_t)(u.sub - 1) * NCTX * DM;
#pragma unroll
            for (int ai = 0; ai < 2; ++ai)
#pragma unroll
                for (int m = 0; m < 4; ++m)
#pragma unroll
                    for (int bj = 0; bj < 2; ++bj) { GAS float* op = lnd(sl + (size_t)(row0 + ai * HALF + m * 16) * DM + col0 + bj * HALF); *(GAS f32x4*)op = acc[ai][bj][m][0]; *(GAS f32x4*)(op + 4) = acc[ai][bj][m][1]; }
            return;
        }
        const bool lat = u.pm < 64; const int rbase = lat ? u.pm * BM : (u.pm - 64) * BM;
        const float* in = lat ? inL : inC; float* out = lat ? outL : outC;
        const int row0 = rbase + wr * 64 + fr, col0 = u.pn * BM + wc * 32 + 8 * fq;
        const float* gt = mod + (size_t)(lat ? (u.pm >> 3) : 8) * 6144 + col0;
#pragma unroll
        for (int bj = 0; bj < 2; ++bj) { const f32x4 g0 = *(const f32x4*)(gt + bj * HALF), g1 = *(const f32x4*)(gt + bj * HALF + 4);
#pragma unroll
            for (int ai = 0; ai < 2; ++ai)
#pragma unroll
                for (int m = 0; m < 4; ++m) { const size_t ro = (size_t)(row0 + ai * HALF + m * 16) * DM + col0 + bj * HALF;
                    const GAS float* ip = lnd(in + ro); GAS float* op = lnd(out + ro); const f32x4 i0 = *(const GAS f32x4*)ip, i1 = *(const GAS f32x4*)(ip + 4);
                    *(GAS f32x4*)op = i0 + g0 * acc[ai][bj][m][0]; *(GAS f32x4*)(op + 4) = i1 + g1 * acc[ai][bj][m][1]; } }
    }
};

struct MergeSched {
    Sched base;
    __device__ bool next(int i, Unit& u) const {
        const int r = i / 3, n = i - 3 * r;
        if (!base.next(r, u)) return false;
        u.sub = n; u.aoff += (size_t)(n == 0 ? C_AG : C_BO + (n - 1) * 512) * 2; u.boff += (size_t)n * DM * 512 * 2;
        return true;
    }
};
struct SplitSched {
    Sched base;
    __device__ bool next(int i, Unit& u) const {
        if (base.next(i, u)) return true;
        const int nfull = (base.nwg - base.c + base.G - 1) / base.G;
        const int k = i - nfull; const int un = k * base.G + base.c; if (k < 0 || un >= 128) return false;
        const int ct = un >> 2, sl = un & 3; u.pm = 64 + (ct >> 2); u.pn = ct & 3; u.sub = 1 + sl; u.nt = 16;
        u.aoff = (size_t)u.pm * BM * base.lda * 2 + (size_t)sl * 1024 * 2; u.boff = (size_t)u.pn * BM * base.ldb * 2 + (size_t)sl * 1024 * 2;
        return true;
    }
};
template <class Epi, class Sch>
__device__ __forceinline__ void gemm_phase(LAS unsigned char* lds, const Gemm g, const Sch& S, const Epi& E) {
    const int tid = tid_(), wid = __builtin_amdgcn_readfirstlane(tid >> 6), lane = tid & 63, wr = wid >> 2, wc = wid & 3, fr = lane & 15, fq = lane >> 4;
    const int K = g.K;
    unsigned voffA[2], voffB[2];
#pragma unroll
    for (int i = 0; i < 2; ++i) { int R, C; stage_rc(tid * 16 + i * 8192, R, C); const int Rb = Epi::PERM ? ((R & ~31) + perm32(R & 31)) : R;
        voffA[i] = (unsigned)(R * g.lda + C) * 2u; voffB[i] = (unsigned)(Rb * g.ldb + C) * 2u; }
    const size_t kstep = (size_t)(BK * 2);
    const size_t hstepA = (size_t)HALF * g.lda * 2, hstepB = (size_t)HALF * g.ldb * 2;
    const unsigned ldsw = (unsigned)wid * 1024u;
    const int aoff = lds_byte(wr * 64 + fr, fq * 8), boff = lds_byte(wc * 32 + fr, fq * 8);
#define PG8_SA(b, h) (((b) * 2 + (h)) * HTB)
#define PG8_SB(b, h) ((4 + (b) * 2 + (h)) * HTB)
#define PG8_STAGE(bufoff, gbase, voff) do { _Pragma("unroll") for (int _i = 0; _i < 2; ++_i) \
        __builtin_amdgcn_global_load_lds((const unsigned*)((const char*)(gbase) + (voff)[_i]), (LAS unsigned*)(lds + (bufoff) + ldsw + _i * 8192), 16, 0, 0); } while (0)
#define PG8_LDA(dst, b, h) do { _Pragma("unroll") for (int m = 0; m < 4; ++m) _Pragma("unroll") for (int k = 0; k < 2; ++k) dst[m][k] = *(const LAS bf16x8*)(lds + PG8_SA(b, h) + aoff + m * 2048 + k * 1024); } while (0)
#define PG8_LDB(dst, b, h) do { _Pragma("unroll") for (int n = 0; n < 2; ++n) _Pragma("unroll") for (int k = 0; k < 2; ++k) dst[n][k] = *(const LAS bf16x8*)(lds + PG8_SB(b, h) + boff + n * 2048 + k * 1024); } while (0)
#define PG8_MMA(ai, bj, At, Bt) do { __builtin_amdgcn_s_setprio(1); _Pragma("unroll") for (int m = 0; m < 4; ++m) _Pragma("unroll") for (int n = 0; n < 2; ++n) _Pragma("unroll") for (int k = 0; k < 2; ++k) \
        acc[ai][bj][m][n] = __builtin_amdgcn_mfma_f32_16x16x32_bf16(Bt[n][k], At[m][k], acc[ai][bj][m][n], 0, 0, 0); __builtin_amdgcn_s_setprio(0); } while (0)
#define PG8_WAIT_V(n) asm volatile("s_waitcnt vmcnt(" #n ")" ::: "memory")
#define PG8_WAIT_L(n) asm volatile("s_waitcnt lgkmcnt(" #n ")" ::: "memory")
#define PG8_BAR __builtin_amdgcn_s_barrier()
#define PG8_SCHED __builtin_amdgcn_sched_barrier(0)
    Unit cur, nxt; int ui = 0;
    if (!S.next(0, cur)) return;
    f32x4 acc[2][2][4][2];
#pragma unroll
    for (int a = 0; a < 2; ++a)
#pragma unroll
        for (int b = 0; b < 2; ++b)
#pragma unroll
            for (int m = 0; m < 4; ++m)
#pragma unroll
                for (int n = 0; n < 2; ++n) acc[a][b][m][n] = (f32x4){0.f, 0.f, 0.f, 0.f};
    bf16x8 At[4][2], B0[2][2], B1[2][2];
    const char* cA = (const char*)g.A + cur.aoff; const char* cB = (const char*)g.Bt + cur.boff;
    PG8_STAGE(PG8_SB(0, 0), cB, voffB); PG8_STAGE(PG8_SA(0, 0), cA, voffA); PG8_STAGE(PG8_SB(0, 1), cB + hstepB, voffB); PG8_STAGE(PG8_SA(0, 1), cA + hstepA, voffA);
    if (wr == 1) PG8_BAR;
    PG8_WAIT_V(4); PG8_BAR;
    PG8_STAGE(PG8_SB(1, 0), cB + kstep, voffB); PG8_STAGE(PG8_SA(1, 0), cA + kstep, voffA); PG8_STAGE(PG8_SB(1, 1), cB + hstepB + kstep, voffB);
    PG8_WAIT_V(6); PG8_BAR;
    for (;;) {
        const bool has_next = S.next(ui + 1, nxt);
        const char* nA = has_next ? (const char*)g.A + nxt.aoff : cA; const char* nB = has_next ? (const char*)g.Bt + nxt.boff : cB;
        const int nt = cur.nt ? cur.nt : K / BK;
        for (int t = 0; t < nt; t += 2) {
            const bool last = (t == nt - 2);
            const char* a1 = cA + (size_t)(t + 1) * kstep;
            const char* a2 = last ? nA : cA + (size_t)(t + 2) * kstep; const char* b2 = last ? nB : cB + (size_t)(t + 2) * kstep;
            const char* a3 = a2 + kstep; const char* b3 = b2 + kstep;
            PG8_LDB(B0, 0, 0); PG8_SCHED; PG8_LDA(At, 0, 0); PG8_STAGE(PG8_SA(1, 1), a1 + hstepA, voffA);
            PG8_WAIT_L(8); PG8_BAR; PG8_WAIT_L(0); PG8_MMA(0, 0, At, B0); PG8_BAR; PG8_SCHED;
            PG8_LDB(B1, 0, 1); PG8_STAGE(PG8_SB(0, 0), b2, voffB);
            PG8_BAR; PG8_WAIT_L(0); PG8_MMA(0, 1, At, B1); PG8_BAR;
            PG8_LDA(At, 0, 1); PG8_STAGE(PG8_SA(0, 0), a2, voffA);
            PG8_BAR; PG8_WAIT_L(0); PG8_MMA(1, 0, At, B0); PG8_BAR; PG8_SCHED;
            PG8_STAGE(PG8_SB(0, 1), b2 + hstepB, voffB);
            PG8_WAIT_V(6); PG8_BAR; PG8_MMA(1, 1, At, B1); PG8_BAR;
            PG8_LDB(B0, 1, 0); PG8_SCHED; PG8_LDA(At, 1, 0); PG8_STAGE(PG8_SA(0, 1), a2 + hstepA, voffA);
            PG8_WAIT_L(8); PG8_BAR; PG8_WAIT_L(0); PG8_MMA(0, 0, At, B0); PG8_BAR; PG8_SCHED;
            PG8_LDB(B1, 1, 1); PG8_STAGE(PG8_SB(1, 0), b3, voffB);
            PG8_BAR; PG8_WAIT_L(0); PG8_MMA(0, 1, At, B1); PG8_BAR;
            PG8_LDA(At, 1, 1); PG8_STAGE(PG8_SA(1, 0), a3, voffA);
            PG8_BAR; PG8_WAIT_L(0); PG8_MMA(1, 0, At, B0); PG8_BAR; PG8_SCHED;
            PG8_STAGE(PG8_SB(1, 1), b3 + hstepB, voffB);
            PG8_WAIT_V(6); PG8_BAR; PG8_MMA(1, 1, At, B1); PG8_BAR;
        }
        E(acc, cur, wr, wc, fr, fq);
        if (!has_next) break;
#pragma unroll
        for (int a = 0; a < 2; ++a)
#pragma unroll
            for (int b = 0; b < 2; ++b)
#pragma unroll
                for (int m = 0; m < 4; ++m)
#pragma unroll
                    for (int n = 0; n < 2; ++n) acc[a][b][m][n] = (f32x4){0.f, 0.f, 0.f, 0.f};
        cur = nxt; cA = nA; cB = nB; ++ui;
    }
    PG8_WAIT_V(0);
    if (wr == 0) PG8_BAR;
    PG8_BAR;
#undef PG8_SA
#undef PG8_SB
#undef PG8_STAGE
#undef PG8_LDA
#undef PG8_LDB
#undef PG8_MMA
#undef PG8_WAIT_V
#undef PG8_WAIT_L
#undef PG8_BAR
#undef PG8_SCHED
}
}


#define XB_TMO      128
#define XB_XCNT(j)  (256  + 64 * (j))
#define XB_XSUB(j)  (1280 + 64 * (j))
#define XB_XGEN(j)  (2304 + 64 * (j))
#define XB_TOP      3328
#define XB_TOPGEN   3392
#define XCD_BAR_WORDS 3456
#define XB_SPIN_CAP (1u << 20)
__device__ __forceinline__ unsigned xb_ld(unsigned* p)              { return __hip_atomic_load(p, __ATOMIC_RELAXED, __HIP_MEMORY_SCOPE_AGENT); }
__device__ __forceinline__ unsigned xb_add(unsigned* p, unsigned v) { return __hip_atomic_fetch_add(p, v, __ATOMIC_RELAXED, __HIP_MEMORY_SCOPE_AGENT); }
__device__ __forceinline__ unsigned xb_xcc_id() { return (unsigned)__builtin_amdgcn_s_getreg((3 << 11) | 20) & 0xFu; }
#define XB_SPIN(cond, bar) do { unsigned _sp = 0; while (cond) { __builtin_amdgcn_s_sleep(1); \
    if ((++_sp & 255u) == 0u) { if (xb_ld(&(bar)[XB_TMO])) break; if (_sp > XB_SPIN_CAP) { atomicAdd(&(bar)[XB_TMO], 1u); break; } } } } while (0)
struct XcdBarrier { unsigned* bar; unsigned x; volatile LAS unsigned* st; };
__device__ __forceinline__ XcdBarrier xcd_barrier_post(unsigned* bar, volatile LAS unsigned* st) {
    XcdBarrier b; b.bar = bar; b.x = xb_xcc_id(); b.st = st;
    if (threadIdx.x == 0) (void)xb_add(&bar[XB_XCNT(b.x)], 1u);
    return b;
}
__device__ __forceinline__ void xcd_barrier_complete(unsigned* bar, unsigned x, unsigned& nloc, unsigned& nx) {
    const unsigned G = gridDim.x * gridDim.y * gridDim.z;
    unsigned sum, cnt, mine, sp = 0u;
    for (;;) {
        sum = 0u; cnt = 0u; mine = 0u;
#pragma unroll
        for (unsigned j = 0; j < 16; ++j) { const unsigned c = xb_ld(&bar[XB_XCNT(j)]); sum += c; cnt += (c > 0u) ? 1u : 0u; mine = (j == x) ? c : mine; }
        if (sum == G) break;
        __builtin_amdgcn_s_sleep(1);
        if ((++sp & 255u) == 0u) { if (xb_ld(&bar[XB_TMO])) break; if (sp > XB_SPIN_CAP) { atomicAdd(&bar[XB_TMO], 1u); break; } }
    }
    nloc = mine > 0u ? mine : 1u; nx = cnt > 0u ? cnt : 1u;
}
__device__ __forceinline__ void xcd_barrier(const XcdBarrier& b) {
    asm volatile("s_waitcnt vmcnt(0)" ::: "memory");
    __syncthreads();
    if (threadIdx.x == 0) {
        unsigned* bar = b.bar;
        __builtin_amdgcn_s_waitcnt(0);
        unsigned nloc = b.st[0], nx = b.st[1];
        if (nloc == 0u) { xcd_barrier_complete(bar, b.x, nloc, nx); b.st[0] = nloc; b.st[1] = nx; }
        const unsigned old = xb_add(&bar[XB_XSUB(b.x)], 1u);
        const unsigned gen = old / nloc;
        if (old + 1u == (gen + 1u) * nloc) {
            __builtin_amdgcn_fence(__ATOMIC_RELEASE, "agent");
            asm volatile("s_waitcnt vmcnt(0)" ::: "memory");
            const unsigned og = xb_add(&bar[XB_TOP], 1u);
            const unsigned tg = og / nx;
            if (og + 1u == (tg + 1u) * nx) xb_add(&bar[XB_TOPGEN], 1u);
            else XB_SPIN(xb_ld(&bar[XB_TOPGEN]) == tg, bar);
            __builtin_amdgcn_fence(__ATOMIC_ACQUIRE, "agent");
            xb_add(&bar[XB_XGEN(b.x)], 1u);
            asm volatile("s_waitcnt vmcnt(0)" ::: "memory");
        } else {
            XB_SPIN(xb_ld(&bar[XB_XGEN(b.x)]) == gen, bar);
            __builtin_amdgcn_fence(__ATOMIC_ACQUIRE, "agent");
            asm volatile("s_waitcnt vmcnt(0)" ::: "memory");
        }
    }
    __syncthreads();
}

__device__ __forceinline__ void sub_barrier(unsigned* word, unsigned n) {
    asm volatile("s_waitcnt vmcnt(0)" ::: "memory");
    __syncthreads();
    if (threadIdx.x == 0) {
        __builtin_amdgcn_fence(__ATOMIC_RELEASE, "agent");
        asm volatile("s_waitcnt vmcnt(0)" ::: "memory");
        xb_add(word, 1u);
        unsigned sp = 0;
        while (xb_ld(word) < n) { __builtin_amdgcn_s_sleep(1); if (++sp > (1u << 22)) break; }
        __builtin_amdgcn_fence(__ATOMIC_ACQUIRE, "agent");
        asm volatile("s_waitcnt vmcnt(0)" ::: "memory");
    }
    __syncthreads();
}

__device__ __forceinline__ void phase_mod(const Params& p, LAS unsigned char* lds) {
    LAS float* sc = (LAS float*)lds;
    LAS float* part = sc + 9 * 1024;
    float* mod = (float*)(PF(ws) + WS_MOD);
    const int tid = tid_(), w = tid >> 6, lane = tid & 63;
    if ((int)blockIdx.x >= 192) return;
    const float* pc = PF(c); const float* pcc = PF(c_ctx); const float* padaw = PF(ada_w); const float* padab = PF(ada_b);
    for (int i = tid; i < 9 * 1024; i += 512) { const int r = i >> 10, k = i & 1023; const float v = (r < 8) ? pc[r * 1024 + k] : pcc[k]; sc[i] = v / (1.0f + expf(-v)); }
    __syncthreads();
    for (int item = blockIdx.x; item < 192; item += gridDim.x) {
        const int l = item / 96, cb = item % 96;
        const float* W = padaw + (size_t)l * 1024 * 6144 + cb * 64 + lane;
        float acc[9];
#pragma unroll
        for (int r = 0; r < 9; ++r) acc[r] = 0.f;
        for (int k = w * 128; k < w * 128 + 128; ++k) { const float wv = W[(size_t)k * 6144];
#pragma unroll
            for (int r = 0; r < 9; ++r) acc[r] += sc[r * 1024 + k] * wv; }
#pragma unroll
        for (int r = 0; r < 9; ++r) part[(w * 9 + r) * 64 + lane] = acc[r];
        __syncthreads();
        for (int i = tid; i < 576; i += 512) { const int r = i >> 6, ln = i & 63; float s = 0.f;
#pragma unroll
            for (int ww = 0; ww < 8; ++ww) s += part[(ww * 9 + r) * 64 + ln];
            mod[(size_t)(l * 9 + r) * 6144 + cb * 64 + ln] = s + padab[l * 6144 + cb * 64 + ln]; }
        __syncthreads();
    }
}
__device__ __forceinline__ void phase_rope(const Params& p) {
    if (blockIdx.x != gridDim.x - 1) return;
    float* rope = (float*)(PF(ws) + WS_ROPE);
    for (int i = tid_(); i < 1024; i += 512) { const int pos = i >> 4, fi = i & 15; const float invf = powf(10000.0f, -(float)fi / 16.0f); const float ang = (float)pos * invf; rope[i] = cosf(ang); rope[1024 + i] = sinf(ang); }
}
__device__ __forceinline__ void convert_tile(const float* src, int K, int N, bf16_t* dst, int tile, LAS bf16_t* T) {
    const int tid = tid_(), tilesN = N >> 7, tk = tile / tilesN, tn = tile - tk * tilesN, k0 = tk * 128, n0 = tn * 128;
    const int r = tid >> 4, c8 = (tid & 15) * 8;
    f32x4 a[4], b[4];
#pragma unroll
    for (int i = 0; i < 4; ++i) { const float* s = src + (size_t)(k0 + r + 32 * i) * N + n0 + c8; a[i] = *(const f32x4*)s; b[i] = *(const f32x4*)(s + 4); }
#pragma unroll
    for (int i = 0; i < 4; ++i)
#pragma unroll
        for (int j = 0; j < 4; ++j) { T[(c8 + j) * 136 + r + 32 * i] = (bf16_t)f2bf(a[i][j]); T[(c8 + 4 + j) * 136 + r + 32 * i] = (bf16_t)f2bf(b[i][j]); }
    __syncthreads();
    const int n = tid >> 2, ks = (tid & 3) * 8;
#pragma unroll
    for (int i = 0; i < 4; ++i) { const u32x4 v = *(const LAS u32x4*)(T + n * 136 + ks + 32 * i); *(u32x4*)(dst + (size_t)(n0 + n) * K + k0 + ks + 32 * i) = v; }
    __syncthreads();
}
__device__ __forceinline__ void phase_convert(const Params& p, int l, LAS unsigned char* lds) {
    LAS bf16_t* T = (LAS bf16_t*)lds;
    bf16_t* WIN = (bf16_t*)(PF(ws) + WS_WIN); bf16_t* WB = (bf16_t*)(PF(ws) + WS_WB); bf16_t* WO = (bf16_t*)(PF(ws) + WS_WO); bf16_t* W1 = (bf16_t*)(PF(ws) + WS_W1); bf16_t* W2 = (bf16_t*)(PF(ws) + WS_W2);
    for (int it = blockIdx.x; it < 1184; it += gridDim.x) {
        if (it < 512) convert_tile(PF(w_in) + (size_t)l * DM * DIN, DM, DIN, WIN, it, T);
        else if (it < 608) { const int n = (it - 512) / 32, tl = (it - 512) % 32; convert_tile(PF(w_branch) + (size_t)(l * 3 + n) * 512 * DM, 512, DM, WB + (size_t)n * DM * 512, tl, T); }
        else if (it < 672) convert_tile(PF(w_out) + (size_t)l * DM * DM, DM, DM, WO, it - 608, T);
        else if (it < 928) convert_tile(PF(ffn_w1) + (size_t)l * DM * DFF, DM, DFF, W1, it - 672, T);
        else convert_tile(PF(ffn_w2) + (size_t)l * DFF * DM, DFF, DM, W2, it - 928, T);
    }
}
__device__ __forceinline__ void phase_norm(const Params& p, int l, const float* hlat, const float* hctx, const float* g, int modoff, int nrows, const float* slab = nullptr, const float* slabgate = nullptr) {
    const int tid = tid_(); const int w = tid >> 6, lane = tid & 63;
    bf16_t* U = (bf16_t*)(PF(ws) + WS_U); const float* mod = (const float*)(PF(ws) + WS_MOD);
    for (int row = blockIdx.x * 8 + w; row < nrows; row += gridDim.x * 8) {
        const float* src = row < NLAT ? hlat + (size_t)row * DM : hctx + (size_t)(row - NLAT) * DM;
        const int mr = row < NLAT ? (row >> 11) : 8;
        const float* md = mod + (size_t)(l * 9 + mr) * 6144 + modoff;
        f32x4 v[4]; float ss = 0.f;
#pragma unroll
        for (int i = 0; i < 4; ++i) { v[i] = *(const f32x4*)(src + i * 256 + lane * 4);
            if (slab != nullptr && row >= NLAT) { const size_t o = (size_t)(row - NLAT) * DM + i * 256 + lane * 4; const f32x4 gg = *(const f32x4*)(slabgate + i * 256 + lane * 4);
                const f32x4 s4 = (*(const f32x4*)(slab + o) + *(const f32x4*)(slab + o + (size_t)NCTX * DM)) + (*(const f32x4*)(slab + o + (size_t)2 * NCTX * DM) + *(const f32x4*)(slab + o + (size_t)3 * NCTX * DM));
                v[i] += gg * s4; }
            ss += v[i][0] * v[i][0] + v[i][1] * v[i][1] + v[i][2] * v[i][2] + v[i][3] * v[i][3]; }
#pragma unroll
        for (int o = 32; o >= 1; o >>= 1) ss += __shfl_xor(ss, o);
        const float rstd = rsqrtf(ss * (1.0f / 1024.0f) + 1e-6f);
#pragma unroll
        for (int i = 0; i < 4; ++i) { const int cidx = i * 256 + lane * 4; const f32x4 gg = *(const f32x4*)(g + cidx), sh = *(const f32x4*)(md + cidx), scv = *(const f32x4*)(md + 1024 + cidx);
            float o4[4];
#pragma unroll
            for (int j = 0; j < 4; ++j) o4[j] = (v[i][j] * rstd * gg[j]) * (1.0f + scv[j]) + sh[j];
            u32x2 wv; wv.x = pack2(o4[0], o4[1]); wv.y = pack2(o4[2], o4[3]);
            *(u32x2*)(U + (size_t)row * DM + cidx) = wv; }
    }
}
__device__ __forceinline__ void phase_hg_final(const Params& p, int l, int nrows, int wg, int nwg) {
    const int tid = tid_(); const int w = tid >> 6, lane = tid & 63; bf16_t* P = (bf16_t*)(PF(ws) + WS_P);
    const int hd = lane >> 4, e8 = (lane & 15) * 8; const float* png = PF(hg_norm_g);
    float ng[8];
#pragma unroll
    for (int i = 0; i < 8; ++i) ng[i] = png[l * 128 + e8 + i];
    for (int row = wg * 8 + w; row < nrows; row += nwg * 8) {
        bf16_t* rp = P + (size_t)row * PW;
        float a[8], b[8], og[8]; unpack8(*(const u32x4*)(rp + C_BF + hd * 128 + e8), a); unpack8(*(const u32x4*)(rp + C_BF + 512 + hd * 128 + e8), b); unpack8(*(const u32x4*)(rp + C_BO + hd * 128 + e8), og);
        float ss = 0.f;
#pragma unroll
        for (int i = 0; i < 8; ++i) { a[i] += b[i]; ss += a[i] * a[i]; }
        ss += __shfl_xor(ss, 1); ss += __shfl_xor(ss, 2); ss += __shfl_xor(ss, 4); ss += __shfl_xor(ss, 8);
        const float rstd = rsqrtf(ss * (1.0f / 128.0f) + 1e-6f);
        float y[8];
#pragma unroll
        for (int i = 0; i < 8; ++i) y[i] = a[i] * rstd * ng[i] * sigmoidf_(og[i]);
        *(u32x4*)(rp + C_BO + hd * 128 + e8) = pack8(y);
    }
}

__device__ __forceinline__ size_t agg_idx(int b, int gch, int dir, int which, int ch) { return ((((size_t)b * 36 + gch) * 2 + dir) * 2 + which) * 512 + ch; }
__device__ __forceinline__ float gelu_tanh(float x) { const float u = 0.7978845608028654f * (x + 0.044715f * x * x * x); const float th = 1.0f - 2.0f / (1.0f + __expf(2.0f * u)); return 0.5f * x * (1.0f + th); }
__device__ __forceinline__ void lru_tile(const Params& p, int l, LAS unsigned char* lds, int item, int mode, int& staged_nb) {
    LAS bf16_t* Wl = (LAS bf16_t*)lds;
    LAS bf16_t* Xb = Wl + 256 * 72;
    LAS float* Xf = (LAS float*)(lds + 46080);
    LAS float* Av = Xf + 4096;
    LAS float* Bv = Av + 8192;
    bf16_t* P = (bf16_t*)(PF(ws) + WS_P); float* AGG = (float*)(PF(ws) + WS_AGG);
    const int tid = tid_(), w = tid >> 6, lane = tid & 63, l16 = lane & 15, q4 = lane >> 4;
    const int nb = item & 7, rest = item >> 3, gch = rest % 36, b = rest / 36;
    const bool isctx = gch < 4; const int chunk = isctx ? gch : gch - 4, L = isctx ? CTXL : SEQ;
    const size_t seqrow0 = isctx ? (size_t)NLAT + b * CTXL : (size_t)b * SEQ; const int t0 = chunk * 64;
    if (staged_nb != nb) { const float* pwx = PF(lru_wx); const float* pwa = PF(lru_wa);
        for (int e = tid; e < 4 * 64 * 64; e += 512) { const int mat = e >> 12, i = (e >> 6) & 63, c = e & 63; const int dir = mat >> 1, kind = mat & 1;
            const float* W = kind ? pwx : pwa; const float v = W[((size_t)((l * 2 + dir) * 8 + nb) * 64 + i) * 64 + c];
            const int op = dir * 128 + (c >> 4) * 32 + kind * 16 + (c & 15);
            Wl[op * 72 + i] = (bf16_t)f2bf(v); }
        staged_nb = nb;
    }
    {
        const int t = tid >> 3, c8 = (tid & 7) * 8, ch = nb * 64 + c8, tt = t0 + t;
        float a8[8]; const float* pcb = PF(conv_b); const float* pcw = PF(conv_w);
        { const f32x4 b0 = *(const f32x4*)(pcb + l * 512 + ch), b1 = *(const f32x4*)(pcb + l * 512 + ch + 4);
#pragma unroll
          for (int i = 0; i < 4; ++i) { a8[i] = b0[i]; a8[4 + i] = b1[i]; } }
#pragma unroll
        for (int j = 0; j < 4; ++j) { const int ts = tt + j - 2;
            if (ts >= 0 && ts < L) { float xv[8]; unpack8(*(const u32x4*)(P + (seqrow0 + ts) * PW + C_AX + ch), xv);
                const f32x4 w0 = *(const f32x4*)(pcw + (l * 4 + j) * 512 + ch), w1 = *(const f32x4*)(pcw + (l * 4 + j) * 512 + ch + 4);
#pragma unroll
                for (int i = 0; i < 4; ++i) { a8[i] += xv[i] * w0[i]; a8[4 + i] += xv[4 + i] * w1[i]; } } }
#pragma unroll
        for (int i = 0; i < 8; ++i) Xf[t * 64 + c8 + i] = a8[i];
        *(LAS u32x4*)(Xb + t * 72 + c8) = pack8(a8);
    }
    __syncthreads();
    {
        const int dir = w >> 2, c = (w & 3) * 16 + l16, ch = nb * 64 + c;
        f32x4 acc[4][2];
#pragma unroll
        for (int mg = 0; mg < 4; ++mg) { acc[mg][0] = (f32x4){0.f, 0.f, 0.f, 0.f}; acc[mg][1] = (f32x4){0.f, 0.f, 0.f, 0.f}; }
#pragma unroll
        for (int ks = 0; ks < 2; ++ks) {
            const bf16x8 B0 = *(const LAS bf16x8*)(Wl + (w * 32 + l16) * 72 + ks * 32 + q4 * 8), B1 = *(const LAS bf16x8*)(Wl + (w * 32 + 16 + l16) * 72 + ks * 32 + q4 * 8);
#pragma unroll
            for (int mg = 0; mg < 4; ++mg) { const bf16x8 A = *(const LAS bf16x8*)(Xb + (mg * 16 + l16) * 72 + ks * 32 + q4 * 8);
                acc[mg][0] = mfma16(A, B0, acc[mg][0]); acc[mg][1] = mfma16(A, B1, acc[mg][1]); }
        }
        const float ba = PF(lru_ba)[(l * 2 + dir) * 512 + ch], bx = PF(lru_bx)[(l * 2 + dir) * 512 + ch], lam = PF(lru_lambda)[(l * 2 + dir) * 512 + ch];
        const float sp = log1pf(expf(-lam));
#pragma unroll
        for (int mg = 0; mg < 4; ++mg)
#pragma unroll
            for (int j = 0; j < 4; ++j) { const int t = mg * 16 + q4 * 4 + j;
                const float ea = 1.0f + __expf(-(acc[mg][0][j] + ba)), ex = 1.0f + __expf(-(acc[mg][1][j] + bx)); const float inv = __builtin_amdgcn_rcpf(ea * ex);
                const float r = inv * ex, ig = inv * ea;
                const float la = -8.0f * r * sp; const float a = __expf(la); const float x2 = 2.0f * la;
                float om = -x2 * (1.0f + x2 * (0.5f + x2 * (0.16666667f + x2 * (0.041666668f + x2 * 0.0083333338f))));
                if (x2 < -0.35f) om = 1.0f - a * a;
                const float bb = sqrtf(fmaxf(om, 0.f)) * ig * Xf[t * 64 + c];
                Av[(dir * 64 + t) * 64 + c] = a; Bv[(dir * 64 + t) * 64 + c] = bb; }
    }
    __syncthreads();
    {
        LAS float* SegA = Xf;
        LAS float* SegB = Xf + 512;
        const int d2 = tid >> 8, seg = (tid >> 6) & 3, c = tid & 63, ch = nb * 64 + c;
        float av[16], bv[16];
#pragma unroll
        for (int k = 0; k < 16; ++k) { const int s = seg * 16 + k; const int t = d2 ? 63 - s : s; const int ix = (d2 * 64 + t) * 64 + c; av[k] = Av[ix]; bv[k] = Bv[ix]; }
        float h = 0.f, ap = 1.f;
#pragma unroll
        for (int k = 0; k < 16; ++k) { h = av[k] * h + bv[k]; ap *= av[k]; }
        SegA[(d2 * 4 + seg) * 64 + c] = ap; SegB[(d2 * 4 + seg) * 64 + c] = h;
        float hin = 0.f;
        if (mode == 1) {
            const int mypos = d2 == 0 ? gch : (gch < 4 ? 3 - gch : 39 - gch);
            for (int p0 = 0; p0 < mypos; p0 += 6) { float Aa[6], Bb[6];
#pragma unroll
                for (int j = 0; j < 6; ++j) { const int pp = p0 + j; const int g = d2 == 0 ? pp : (pp < 4 ? 3 - pp : 39 - pp); const bool ok = pp < mypos;
                    Aa[j] = ok ? AGG[agg_idx(b, ok ? g : 0, d2, 0, ch)] : 1.0f; Bb[j] = ok ? AGG[agg_idx(b, ok ? g : 0, d2, 1, ch)] : 0.0f; }
#pragma unroll
                for (int j = 0; j < 6; ++j) hin = Aa[j] * hin + Bb[j]; }
        }
        __syncthreads();
        if (mode == 0) {
            if (seg == 3) { float A = 1.f, B = 0.f;
#pragma unroll
                for (int s2 = 0; s2 < 4; ++s2) { const float sa = SegA[(d2 * 4 + s2) * 64 + c], sb2 = SegB[(d2 * 4 + s2) * 64 + c]; B = sa * B + sb2; A *= sa; }
                AGG[agg_idx(b, gch, d2, 0, ch)] = A; AGG[agg_idx(b, gch, d2, 1, ch)] = B; }
        } else {
#pragma unroll
            for (int s2 = 0; s2 < 3; ++s2) if (s2 < seg) hin = SegA[(d2 * 4 + s2) * 64 + c] * hin + SegB[(d2 * 4 + s2) * 64 + c];
            float hh2 = hin;
#pragma unroll
            for (int k = 0; k < 16; ++k) { const int s = seg * 16 + k; const int t = d2 ? 63 - s : s; hh2 = av[k] * hh2 + bv[k]; Bv[(d2 * 64 + t) * 64 + c] = hh2; }
        }
    }
    __syncthreads();
    if (mode == 1) {
        const int t = tid >> 3, c8 = (tid & 7) * 8; bf16_t* gp = P + (seqrow0 + t0 + t) * PW + C_AG + nb * 64 + c8;
        float gt[8]; unpack8(*(const u32x4*)gp, gt); float y[8];
#pragma unroll
        for (int i = 0; i < 8; ++i) y[i] = (Bv[t * 64 + c8 + i] + Bv[(64 + t) * 64 + c8 + i]) * gelu_tanh(gt[i]);
        *(u32x4*)gp = pack8(y);
        __syncthreads();
    }
}

__device__ __forceinline__ void attn_item(const Params& p, int l, LAS unsigned char* lds, int item, int dry = 0) {
    LAS bf16_t* Kt = (LAS bf16_t*)lds;
    LAS bf16_t* Vt = Kt + 2 * 64 * 72;
    LAS float* rpbL = (LAS float*)(lds + 36864);
    LAS float* cosT = rpbL + 960;
    LAS float* sinT = cosT + 1024;
    LAS float* gq = sinT + 1024; LAS float* gk = gq + 64;
    bf16_t* P = (bf16_t*)(PF(ws) + WS_P); const float* rope = (const float*)(PF(ws) + WS_ROPE);
    const int tid = tid_(), w = __builtin_amdgcn_readfirstlane(tid >> 6), lane = tid & 63, l16 = lane & 15, q4 = lane >> 4, hh = w >> 2, qg4 = w & 3;
    const bool isctx = item >= 512;
    int b, hp, nloc, krU; int rq[2], kq0[2]; size_t qrow0[2];
    if (!isctx) { hp = item & 3; const int rp = (item >> 2) & 15; b = item >> 6;
        rq[0] = 2 * rp; rq[1] = 2 * rp + 1; kq0[0] = min(max(rq[0] - 4, 0), 24); kq0[1] = min(max(rq[1] - 4, 0), 24);
        qrow0[0] = (size_t)b * SEQ + rq[0] * 64; qrow0[1] = qrow0[0] + 64; krU = kq0[0]; nloc = kq0[1] + 8 - kq0[0]; }
    else { const int it = item - 512; hp = it & 3; const int qt = (it >> 2) & 1; b = it >> 3; rq[0] = rq[1] = 0; kq0[0] = kq0[1] = 0; krU = 0; nloc = 0;
        qrow0[0] = (size_t)NLAT + b * CTXL + qt * 128; qrow0[1] = qrow0[0] + 64; }
    const int h = hp * 2 + hh;
    const float* prpb = PF(na_rpb);
    for (int i = tid; i < 2 * 465; i += 512) { const int h2 = i / 465, j = i - h2 * 465; rpbL[h2 * 480 + j] = prpb[(size_t)((l * 8 + hp * 2 + h2) * 465) + j]; }
    for (int i = tid; i < 1024; i += 512) { cosT[i] = rope[i]; sinT[i] = rope[1024 + i]; }
    if (tid < 64) { gq[tid] = PF(na_qg)[l * 64 + tid]; gk[tid] = PF(na_kg)[l * 64 + tid]; }
    __syncthreads();
    const int qc = qg4 * 16 + l16;
    const int glo = qg4 < 2 ? 0 : qg4 - 1, ghi = qg4 == 0 ? 1 : (qg4 == 3 ? 3 : qg4 + 1);
    int bidx[4][4]; unsigned mbits = 0u;
    { const int cs0 = min(max(qc - 8, 0), 48);
#pragma unroll
      for (int g = 0; g < 4; ++g)
#pragma unroll
          for (int j = 0; j < 4; ++j) { const int kc = g * 16 + q4 * 4 + j; bidx[g][j] = hh * 480 + min(max(kc - qc, -15), 15) + 15; if (kc < cs0 || kc >= cs0 + 16) mbits |= 1u << (g * 4 + j); } }
    bf16x8 qpl[2][2], qrt[2][2];
#pragma unroll
    for (int qi = 0; qi < 2; ++qi) {
        const bf16_t* qp = P + (qrow0[qi] + qc) * PW + C_CQ + h * 64;
        float xq[16]; unpack8(*(const u32x4*)(qp + q4 * 8), xq); unpack8(*(const u32x4*)(qp + 32 + q4 * 8), xq + 8);
        float ss = 0.f;
#pragma unroll
        for (int i = 0; i < 16; ++i) ss += xq[i] * xq[i];
        ss += __shfl_xor(ss, 16); ss += __shfl_xor(ss, 32);
        const float rs = rsqrtf(ss * (1.0f / 64.0f) + 1e-6f) * 0.125f;
#pragma unroll
        for (int i = 0; i < 8; ++i) { xq[i] *= rs * gq[q4 * 8 + i]; xq[8 + i] *= rs * gq[32 + q4 * 8 + i]; }
        qpl[qi][0] = as_bf16x8(pack8(xq)); qpl[qi][1] = as_bf16x8(pack8(xq + 8));
        float xr[16];
#pragma unroll
        for (int ks = 0; ks < 2; ++ks) { const int pos = ks == 0 ? rq[qi] : qc;
#pragma unroll
            for (int jj = 0; jj < 8; ++jj) { const int fi = (q4 & 1) * 8 + jj; const float cs = cosT[pos * 16 + fi], sn = sinT[pos * 16 + fi]; const float xv = xq[ks * 8 + jj]; const float pr = __shfl_xor(xv, 32);
                xr[ks * 8 + jj] = (q4 < 2) ? (xv * cs - pr * sn) : (xv * cs + pr * sn); } }
        qrt[qi][0] = as_bf16x8(pack8(xr)); qrt[qi][1] = as_bf16x8(pack8(xr + 8));
    }
    f32x4 O[2][4];
#pragma unroll
    for (int qi = 0; qi < 2; ++qi)
#pragma unroll
        for (int i = 0; i < 4; ++i) O[qi][i] = (f32x4){0.f, 0.f, 0.f, 0.f};
    float mrun[2] = {-1e30f, -1e30f}, lsum[2] = {0.f, 0.f};
    const int pf_hh2 = tid >> 8, pf_h2 = hp * 2 + pf_hh2, pf_key = (tid & 255) >> 2, pf_seg = tid & 3, pf_vseg = (tid & 255) >> 6, pf_vkey = tid & 63;
    u32x4 pk0, pk1, pv0, pv1;
    { const size_t r0 = nloc ? (size_t)b * SEQ + krU * 64 : (size_t)NLAT + b * CTXL;
      const bf16_t* kp = P + (r0 + pf_key) * PW + C_CK + pf_h2 * 64 + pf_seg * 16; pk0 = *(const u32x4*)kp; pk1 = *(const u32x4*)(kp + 8);
      const bf16_t* vp = P + (r0 + pf_vkey) * PW + C_CV + pf_h2 * 64 + pf_vseg * 16; pv0 = *(const u32x4*)vp; pv1 = *(const u32x4*)(vp + 8); }
    const int ntot = nloc + 4; int Tn = 0;
#pragma unroll
    for (int ph = 0; ph < 2; ++ph) {
    const bool loc = (ph == 0); const int ntile = loc ? nloc : 4;
    for (int kt = 0; kt < ntile; ++kt) {
        const int kr = krU + kt; ++Tn;
        {
            const int hh2 = pf_hh2, key = pf_key, seg = pf_seg;
            float xk[16]; unpack8(pk0, xk); unpack8(pk1, xk + 8);
            float ss = 0.f;
#pragma unroll
            for (int i = 0; i < 16; ++i) ss += xk[i] * xk[i];
            ss += __shfl_xor(ss, 1); ss += __shfl_xor(ss, 2);
            const float rs = rsqrtf(ss * (1.0f / 64.0f) + 1e-6f);
#pragma unroll
            for (int i = 0; i < 16; ++i) xk[i] *= rs * gk[seg * 16 + i];
            if (loc) { const int pos = seg < 2 ? kr : key;
#pragma unroll
                for (int i = 0; i < 16; ++i) { const float pr = __shfl_xor(xk[i], 1); const float cs = cosT[pos * 16 + i], sn = sinT[pos * 16 + i]; xk[i] = (seg & 1) ? (xk[i] * cs + pr * sn) : (xk[i] * cs - pr * sn); } }
            LAS bf16_t* kd = Kt + (hh2 * 64 + key) * 72 + seg * 16;
            *(LAS u32x4*)kd = pack8(xk); *(LAS u32x4*)(kd + 8) = pack8(xk + 8);
        }
        {
            const int hh2 = pf_hh2, seg = pf_vseg, key = pf_vkey;
            const u32x4 a = pv0, c = pv1;
            LAS bf16_t* vd = Vt + (hh2 * 64 + seg * 16) * 72 + key;
            vd[0 * 72] = (bf16_t)(a.x & 0xffff); vd[1 * 72] = (bf16_t)(a.x >> 16); vd[2 * 72] = (bf16_t)(a.y & 0xffff); vd[3 * 72] = (bf16_t)(a.y >> 16);
            vd[4 * 72] = (bf16_t)(a.z & 0xffff); vd[5 * 72] = (bf16_t)(a.z >> 16); vd[6 * 72] = (bf16_t)(a.w & 0xffff); vd[7 * 72] = (bf16_t)(a.w >> 16);
            vd[8 * 72] = (bf16_t)(c.x & 0xffff); vd[9 * 72] = (bf16_t)(c.x >> 16); vd[10 * 72] = (bf16_t)(c.y & 0xffff); vd[11 * 72] = (bf16_t)(c.y >> 16);
            vd[12 * 72] = (bf16_t)(c.z & 0xffff); vd[13 * 72] = (bf16_t)(c.z >> 16); vd[14 * 72] = (bf16_t)(c.w & 0xffff); vd[15 * 72] = (bf16_t)(c.w >> 16);
        }
        if (Tn < ntot) { const size_t r0 = (Tn < nloc) ? (size_t)b * SEQ + (krU + Tn) * 64 : (size_t)NLAT + b * CTXL + (Tn - nloc) * 64;
            const bf16_t* kp = P + (r0 + pf_key) * PW + C_CK + pf_h2 * 64 + pf_seg * 16; pk0 = *(const u32x4*)kp; pk1 = *(const u32x4*)(kp + 8);
            const bf16_t* vp = P + (r0 + pf_vkey) * PW + C_CV + pf_h2 * 64 + pf_vseg * 16; pv0 = *(const u32x4*)vp; pv1 = *(const u32x4*)(vp + 8); }
        __syncthreads();
#pragma unroll
        for (int qi = 0; qi < 2; ++qi) {
            if (loc && (kr < kq0[qi] || kr >= kq0[qi] + 8)) continue;
            f32x4 st[4];
#pragma unroll
            for (int g = 0; g < 4; ++g) { const bool use = !loc || (g >= glo && g <= ghi);
                st[g] = (f32x4){0.f, 0.f, 0.f, 0.f};
                if (use) {
#pragma unroll
                    for (int ks = 0; ks < 2; ++ks) st[g] = mfma16(*(const LAS bf16x8*)(Kt + (hh * 64 + g * 16 + l16) * 72 + ks * 32 + q4 * 8), loc ? qrt[qi][ks] : qpl[qi][ks], st[g]);
                    if (loc) { const int dr31 = (kr - rq[qi] + 7) * 31;
#pragma unroll
                        for (int j = 0; j < 4; ++j) { const float sv = st[g][j] + rpbL[bidx[g][j] + dr31]; st[g][j] = ((mbits >> (g * 4 + j)) & 1u) ? -1e30f : sv; } }
                } else st[g] = (f32x4){-1e30f, -1e30f, -1e30f, -1e30f};
            }
            float tmax = -1e30f;
#pragma unroll
            for (int g = 0; g < 4; ++g)
#pragma unroll
                for (int j = 0; j < 4; ++j) tmax = fmaxf(tmax, st[g][j]);
            tmax = fmaxf(tmax, __shfl_xor(tmax, 16)); tmax = fmaxf(tmax, __shfl_xor(tmax, 32));
            const float mnew = fmaxf(mrun[qi], tmax); const float alpha = __expf(mrun[qi] - mnew); mrun[qi] = mnew;
            float psum = 0.f;
#pragma unroll
            for (int g = 0; g < 4; ++g) { const bool use = !loc || (g >= glo && g <= ghi);
                if (use) {
#pragma unroll
                    for (int j = 0; j < 4; ++j) { const float pv = __expf(st[g][j] - mnew); st[g][j] = pv; psum += pv; }
                } else st[g] = (f32x4){0.f, 0.f, 0.f, 0.f}; }
            lsum[qi] = lsum[qi] * alpha + psum;
#pragma unroll
            for (int i = 0; i < 4; ++i) O[qi][i] *= alpha;
            bf16x8 pb[2];
#pragma unroll
            for (int ks = 0; ks < 2; ++ks) { u32x4 wv; wv.x = pack2(st[2 * ks][0], st[2 * ks][1]); wv.y = pack2(st[2 * ks][2], st[2 * ks][3]); wv.z = pack2(st[2 * ks + 1][0], st[2 * ks + 1][1]); wv.w = pack2(st[2 * ks + 1][2], st[2 * ks + 1][3]); pb[ks] = as_bf16x8(wv); }
#pragma unroll
            for (int ks = 0; ks < 2; ++ks) if (!loc || (2 * ks + 1 >= glo && 2 * ks <= ghi))
#pragma unroll
                for (int dg = 0; dg < 4; ++dg) { const LAS bf16_t* vr = Vt + (hh * 64 + dg * 16 + l16) * 72 + ks * 32 + q4 * 4;
                    const u32x2 lo = *(const LAS u32x2*)vr, hi = *(const LAS u32x2*)(vr + 16); u32x4 av; av.x = lo.x; av.y = lo.y; av.z = hi.x; av.w = hi.y;
                    O[qi][dg] = mfma16(as_bf16x8(av), pb[ks], O[qi][dg]); }
        }
        __syncthreads();
    }
    }
#pragma unroll
    for (int qi = 0; qi < 2; ++qi) {
        float ls = lsum[qi]; ls += __shfl_xor(ls, 16); ls += __shfl_xor(ls, 32);
        const float inv = 1.0f / ls;
        bf16_t* op = dry ? ((bf16_t*)(PF(ws) + WS_DUMMY) + (size_t)(blockIdx.x & 63) * 16384 + (size_t)((qi * 8 + w) * 16 + l16) * 64) : (P + (qrow0[qi] + qc) * PW + C_CQ + h * 64);
#pragma unroll
        for (int dg = 0; dg < 4; ++dg) { u32x2 wv; wv.x = pack2(O[qi][dg][0] * inv, O[qi][dg][1] * inv); wv.y = pack2(O[qi][dg][2] * inv, O[qi][dg][3] * inv); *(u32x2*)(op + dg * 16 + q4 * 4) = wv; }
    }
    __syncthreads();
}

__device__ __forceinline__ void hgrn_stage(const bf16_t* P, LAS unsigned char* lds, int w, int lane, size_t row0, int dir, int h) {
#pragma unroll
    for (int i = 0; i < 2; ++i) { const int blk = i * 8 + w; const int t = blk * 4 + (lane >> 4); const bf16_t* rp = P + (row0 + (dir ? 63 - t : t)) * PW + (lane & 15) * 8;
        __builtin_amdgcn_global_load_lds((const unsigned*)(rp + C_BQ + h * 128), (LAS unsigned*)(lds + 118784 + blk * 1024), 16, 0, 0);
        __builtin_amdgcn_global_load_lds((const unsigned*)(rp + C_BF + dir * 512 + h * 128), (LAS unsigned*)(lds + 135168 + blk * 1024), 16, 0, 0); }
}
__device__ __forceinline__ void hgrn_chain(const Params& p, int l, LAS unsigned char* lds, int chain, int dry = 0) {
    LAS bf16_t* Q0 = (LAS bf16_t*)lds;
    LAS bf16_t* KP = (LAS bf16_t*)(lds + 17408);
    LAS bf16_t* SB = (LAS bf16_t*)(lds + 34816);
    LAS bf16_t* KDT = (LAS bf16_t*)(lds + 69632);
    LAS bf16_t* VT = (LAS bf16_t*)(lds + 88064);
    LAS bf16_t* ATT = (LAS bf16_t*)(lds + 106496);
    LAS float* TOT = (LAS float*)(lds + 115712);
    LAS float* DD = (LAS float*)(lds + 117760);
    const LAS bf16_t* SQ = (const LAS bf16_t*)(lds + 118784);
    const LAS bf16_t* SF = (const LAS bf16_t*)(lds + 135168);
    bf16_t* P = (bf16_t*)(PF(ws) + WS_P);
    const int tid = tid_(), w = __builtin_amdgcn_readfirstlane(tid >> 6), lane = tid & 63, l16 = lane & 15, q4 = lane >> 4;
    const int dir = chain & 1, h = (chain >> 1) & 3, b = chain >> 3;
    const int d = tid & 127, sb = tid >> 7;
    float lbv = 0.f;
    if (l > 0) { const float x0 = PF(hg_lb)[(dir * 2 + 0) * 512 + h * 128 + d], x1 = PF(hg_lb)[(dir * 2 + 1) * 512 + h * 128 + d]; lbv = 1.0f / (1.0f + expf(x0 - x1)); }
    for (int i = tid; i < 64 * 72 / 2; i += 512) ((LAS unsigned*)ATT)[i] = 0u;
    f32x4 S[8];
#pragma unroll
    for (int i = 0; i < 8; ++i) S[i] = (f32x4){0.f, 0.f, 0.f, 0.f};
    { const int gch0 = dir == 0 ? 0 : 3; hgrn_stage(P, lds, w, lane, (size_t)NLAT + b * CTXL + gch0 * 64, dir, h); }
    asm volatile("s_waitcnt vmcnt(0)" ::: "memory");
    __syncthreads();
    for (int ci = 0; ci < 36; ++ci) {
        const int gch = dir == 0 ? ci : (ci < 4 ? 3 - ci : 39 - ci);
        const bool isctx = gch < 4; const int chunk = isctx ? gch : gch - 4;
        const size_t row0 = isctx ? (size_t)NLAT + b * CTXL + chunk * 64 : (size_t)b * SEQ + chunk * 64;
        float bl[16], qv[16], kv[16]; float run = 0.f;
        {
            unsigned vraw[16];
#pragma unroll
            for (int ii = 0; ii < 16; ++ii) { const int t = sb * 16 + ii; vraw[ii] = P[(row0 + (dir ? 63 - t : t)) * PW + C_BI + h * 128 + d]; }
#pragma unroll
            for (int eg = 0; eg < 8; ++eg) { u32x2 wv; wv.x = pack2(S[eg][0], S[eg][1]); wv.y = pack2(S[eg][2], S[eg][3]); *(LAS u32x2*)(SB + (eg * 16 + l16) * 136 + w * 16 + q4 * 4) = wv; }
#pragma unroll
            for (int ii = 0; ii < 16; ++ii) { const int t = sb * 16 + ii;
                const float fr = bf2f(SF[t * 128 + d]), qr = bf2f(SQ[t * 128 + d]);
                const float sg = 1.0f / (1.0f + __expf(-fr)); const float f = lbv + (1.0f - lbv) * sg; run += __logf(f); bl[ii] = run; kv[ii] = 1.0f - f; qv[ii] = qr / (1.0f + __expf(-qr)); }
            TOT[sb * 128 + d] = run;
            u32x4 v0, v1; v0.x = vraw[0] | (vraw[1] << 16); v0.y = vraw[2] | (vraw[3] << 16); v0.z = vraw[4] | (vraw[5] << 16); v0.w = vraw[6] | (vraw[7] << 16);
            v1.x = vraw[8] | (vraw[9] << 16); v1.y = vraw[10] | (vraw[11] << 16); v1.z = vraw[12] | (vraw[13] << 16); v1.w = vraw[14] | (vraw[15] << 16);
            *(LAS u32x4*)(VT + d * 72 + sb * 16) = v0; *(LAS u32x4*)(VT + d * 72 + sb * 16 + 8) = v1;
        }
        __syncthreads();
        if (ci < 35) { const int cn = ci + 1; const int gn = dir == 0 ? cn : (cn < 4 ? 3 - cn : 39 - cn); const bool cx = gn < 4; const int ck = cx ? gn : gn - 4;
            hgrn_stage(P, lds, w, lane, cx ? (size_t)NLAT + b * CTXL + ck * 64 : (size_t)b * SEQ + ck * 64, dir, h); }
        {
            const float t0 = TOT[d], t1 = TOT[128 + d], t2 = TOT[256 + d], t3 = TOT[384 + d];
            const float Bs1 = t0, Bs2 = t0 + t1, Bs3 = Bs2 + t2, total = Bs3 + t3;
            const float Bsb = sb == 0 ? 0.f : (sb == 1 ? Bs1 : (sb == 2 ? Bs2 : Bs3));
            const float eB = __expf(Bsb), eT = __expf(total);
            float kd[16];
#pragma unroll
            for (int ii = 0; ii < 16; ++ii) { const float e0 = __expf(bl[ii]); Q0[(sb * 16 + ii) * 136 + d] = (bf16_t)pack2(qv[ii] * e0 * eB, 0.f);
                const float kp = kv[ii] * __expf(fminf(-(Bsb + bl[ii]), 80.f)); KP[(sb * 16 + ii) * 136 + d] = (bf16_t)pack2(kp, 0.f); kd[ii] = kp * eT; }
            *(LAS u32x4*)(KDT + d * 72 + sb * 16) = pack8(kd); *(LAS u32x4*)(KDT + d * 72 + sb * 16 + 8) = pack8(kd + 8);
            if (sb == 0) DD[d] = eT;
        }
        __syncthreads();
#pragma unroll
        for (int k2 = 0; k2 < 2; ++k2) { const int idx = w + 8 * k2;
            if (idx < 10) { const int i = idx < 1 ? 0 : (idx < 3 ? 1 : (idx < 6 ? 2 : 3)); const int j = idx - i * (i + 1) / 2;
                f32x4 sc = (f32x4){0.f, 0.f, 0.f, 0.f};
                const LAS bf16_t* qb = Q0 + (i * 16 + l16) * 136 + q4 * 8; const LAS bf16_t* kb = KP + (j * 16 + l16) * 136 + q4 * 8;
#pragma unroll
                for (int ks = 0; ks < 4; ++ks) sc = mfma16(*(const LAS bf16x8*)(qb + ks * 32), *(const LAS bf16x8*)(kb + ks * 32), sc);
#pragma unroll
                for (int jj = 0; jj < 4; ++jj) { const float v = (i == j && l16 > q4 * 4 + jj) ? 0.f : sc[jj]; ATT[(i * 16 + q4 * 4 + jj) * 72 + j * 16 + l16] = (bf16_t)pack2(v, 0.f); } } }
        __syncthreads();
        {
            bf16x8 SBf[4], VTf[2];
#pragma unroll
            for (int ks = 0; ks < 4; ++ks) SBf[ks] = *(const LAS bf16x8*)(SB + (w * 16 + l16) * 136 + ks * 32 + q4 * 8);
#pragma unroll
            for (int ks = 0; ks < 2; ++ks) VTf[ks] = *(const LAS bf16x8*)(VT + (w * 16 + l16) * 72 + ks * 32 + q4 * 8);
#pragma unroll
            for (int i = 0; i < 4; ++i) { f32x4 oa = (f32x4){0.f, 0.f, 0.f, 0.f};
#pragma unroll
                for (int ks = 0; ks < 4; ++ks) oa = mfma16(SBf[ks], *(const LAS bf16x8*)(Q0 + (i * 16 + l16) * 136 + ks * 32 + q4 * 8), oa);
#pragma unroll
                for (int ks = 0; ks < 2; ++ks) oa = mfma16(VTf[ks], *(const LAS bf16x8*)(ATT + (i * 16 + l16) * 72 + ks * 32 + q4 * 8), oa);
                const int t = i * 16 + l16; u32x2 wv; wv.x = pack2(oa[0], oa[1]); wv.y = pack2(oa[2], oa[3]);
                bf16_t* od = dry ? ((bf16_t*)(PF(ws) + WS_DUMMY) + (size_t)chain * 8192 + t * 128 + w * 16 + q4 * 4) : (P + (row0 + (dir ? 63 - t : t)) * PW + C_BF + dir * 512 + h * 128 + w * 16 + q4 * 4);
                *(u32x2*)od = wv; }
        }
        {
            const f32x4 dd = *(const LAS f32x4*)(DD + w * 16 + q4 * 4);
#pragma unroll
            for (int eg = 0; eg < 8; ++eg) S[eg] *= dd;
#pragma unroll
            for (int ks = 0; ks < 2; ++ks) { const bf16x8 A = *(const LAS bf16x8*)(KDT + (w * 16 + l16) * 72 + ks * 32 + q4 * 8);
#pragma unroll
                for (int eg = 0; eg < 8; ++eg) S[eg] = mfma16(A, *(const LAS bf16x8*)(VT + (eg * 16 + l16) * 72 + ks * 32 + q4 * 8), S[eg]); }
        }
        asm volatile("s_waitcnt vmcnt(0)" ::: "memory");
        __syncthreads();
    }
}

__global__ void __launch_bounds__(512, 2) fwd_megakernel(Params p) {
    extern __shared__ __attribute__((aligned(16))) unsigned char lds_raw[];
    LAS unsigned char* lds = (LAS unsigned char*)lds_raw;
    cg::grid_group grid = cg::this_grid();
    volatile LAS unsigned* xst = (volatile LAS unsigned*)(lds + LDS_BYTES - 16);
    if (threadIdx.x == 0) { xst[0] = 0u; xst[1] = 0u; xst[2] = 0u; xst[3] = 0u; }
    __syncthreads();
    const XcdBarrier xbar = xcd_barrier_post((unsigned*)(PF(ws) + WS_BAR), xst);
    const int G = gridDim.x, c = blockIdx.x;

    phase_mod(p, lds); __syncthreads();
    phase_rope(p);
    phase_convert(p, 0, lds);
    grid.sync();
#define WSP(T, off) ((T*)(PF(ws) + (off)))
    for (int l = 0; l < 2; ++l) {
        const bool lastl = (l == 1);
        const int Mrest = lastl ? NLAT : NTOK;
        if (l > 0) phase_convert(p, l, lds);
        phase_norm(p, l, l == 0 ? PF(x) : PF(out), l == 0 ? PF(ctx) : WSP(const float, WS_HC), PF(norm1_g) + l * DM, 0, NTOK,
                   (l > 0 && G == 256) ? (const float*)(PF(ws) + WS_P + (size_t)NTOK * DFF * 2) : nullptr, WSP(const float, WS_MOD) + (size_t)((l > 0 ? l - 1 : 0) * 9 + 8) * 6144 + 5120);
        xcd_barrier(xbar);

        { pg8::Gemm g{WSP(bf16_t, WS_U), WSP(bf16_t, WS_WIN), DM, DM, DM}; pg8::Sched S; S.init(NTOK, PW, G, c, DM, DM); pg8::EpiStore<0> E{WSP(bf16_t, WS_P), PW}; pg8::gemm_phase(lds, g, S, E); }
        xcd_barrier(xbar);
        if (c < 64) { hgrn_chain(p, l, lds, c); sub_barrier((unsigned*)(PF(ws) + WS_BAR) + 3520 + 64 * (2 * l), 64u); phase_hg_final(p, l, NTOK, c, 64); }
        else { const int cc = c - 64, GG = G - 64; const int nA = lastl ? 512 : 576;
            for (int it = cc; it < nA; it += GG) attn_item(p, l, lds, it);
            int staged = -1;
            for (int it = cc; it < 2304; it += GG) lru_tile(p, l, lds, it, 0, staged);
            sub_barrier((unsigned*)(PF(ws) + WS_BAR) + 3520 + 64 * (2 * l + 1), (unsigned)GG);
            for (int it = cc; it < 2304; it += GG) lru_tile(p, l, lds, it, 1, staged); }
        xcd_barrier(xbar);
        { pg8::Gemm g{WSP(bf16_t, WS_U), WSP(bf16_t, WS_WIN) + (size_t)PW * DM, DM, DM, DM}; pg8::Sched S; S.init(Mrest, 3072, G, c, DM, DM); pg8::EpiStore<1> E{WSP(bf16_t, WS_P), PW}; pg8::gemm_phase(lds, g, S, E); }
        xcd_barrier(xbar);
        { pg8::Gemm g{WSP(bf16_t, WS_P), WSP(bf16_t, WS_WB), PW, 512, 512}; pg8::MergeSched S; S.base.init(Mrest, DM, G, c, PW, 512);
          pg8::EpiMerge E{WSP(bf16_t, WS_P), WSP(bf16_t, WS_U)}; pg8::gemm_phase(lds, g, S, E); }
        xcd_barrier(xbar);
        { pg8::Gemm g{WSP(bf16_t, WS_U), WSP(bf16_t, WS_WO), DM, DM, DM}; pg8::Sched S; S.init(Mrest, DM, G, c, DM, DM);
          pg8::EpiResid E{l == 0 ? PF(x) : PF(out), l == 0 ? PF(ctx) : WSP(const float, WS_HC), PF(out), WSP(float, WS_HC), WSP(const float, WS_MOD) + (size_t)l * 9 * 6144 + 2048}; pg8::gemm_phase(lds, g, S, E); }
        xcd_barrier(xbar);
        phase_norm(p, l, PF(out), WSP(const float, WS_HC), PF(norm2_g) + l * DM, 3072, Mrest);
        xcd_barrier(xbar);
        { pg8::Gemm g{WSP(bf16_t, WS_U), WSP(bf16_t, WS_W1), DM, DM, DM}; pg8::Sched S; S.init(Mrest, DFF, G, c, DM, DM); pg8::EpiStore<2> E{WSP(bf16_t, WS_P), DFF}; pg8::gemm_phase(lds, g, S, E); }
        xcd_barrier(xbar);
        { pg8::Gemm g{WSP(bf16_t, WS_P), WSP(bf16_t, WS_W2), DFF, DFF, DFF};
          float* slab = (float*)(PF(ws) + WS_P + (size_t)NTOK * DFF * 2);
          pg8::EpiResid E{PF(out), WSP(const float, WS_HC), PF(out), WSP(float, WS_HC), WSP(const float, WS_MOD) + (size_t)l * 9 * 6144 + 5120, slab};
          if (!lastl && G == 256) { pg8::SplitSched S; S.base.init(NLAT, DM, G, c, DFF, DFF); pg8::gemm_phase(lds, g, S, E); }
          else { pg8::Sched S; S.init(Mrest, DM, G, c, DFF, DFF); pg8::gemm_phase(lds, g, S, E); } }
        if (!lastl) xcd_barrier(xbar);
    }
}

extern "C" void kernel_launch(void* const* d_in, const int* in_sizes, int n_in, void* d_out, int out_size, void* d_ws, size_t ws_size, hipStream_t stream) {
    static int grid_blocks = 0;
    if (grid_blocks == 0) {
        int dev = 0, cus = 0, per_cu = 0;
        hipGetDevice(&dev);
        hipDeviceGetAttribute(&cus, hipDeviceAttributeMultiprocessorCount, dev);
        hipFuncSetAttribute((const void*)fwd_megakernel, hipFuncAttributeMaxDynamicSharedMemorySize, LDS_BYTES);
        hipOccupancyMaxActiveBlocksPerMultiprocessor(&per_cu, (const void*)fwd_megakernel, 512, LDS_BYTES);
        if (per_cu < 1 || n_in != 25 || ws_size < WS_END) { fprintf(stderr, "kernel_launch: cannot launch (per_cu %d, n_in %d, ws %zu need %zu)\n", per_cu, n_in, ws_size, (size_t)WS_END); grid_blocks = -1; }
        else grid_blocks = cus;
    }
    if (grid_blocks < 0) return;
    hipMemsetAsync((char*)d_ws + WS_BAR, 0, 16384, stream);
    Params p{};
    const float** pp = (const float**)&p;
    for (int i = 0; i < 25; ++i) pp[i] = (const float*)d_in[i];
    p.out = (float*)d_out; p.ws = (unsigned char*)d_ws;
    void* args[] = {&p};
    hipError_t e = hipLaunchCooperativeKernel((const void*)fwd_megakernel, dim3(grid_blocks), dim3(512), args, LDS_BYTES, stream);
    if (e != hipSuccess) fprintf(stderr, "cooperative launch failed: %s (grid %d)\n", hipGetErrorString(e), grid_blocks);
}
```

```cpp
#include <hip/hip_runtime.h>
#include <hip/hip_cooperative_groups.h>
#include <stdint.h>
#include <stdio.h>
namespace cg = cooperative_groups;

#define LAS __attribute__((address_space(3)))
typedef unsigned short bf16_t;
typedef short bf16x8 __attribute__((ext_vector_type(8)));
typedef float f32x4 __attribute__((ext_vector_type(4)));
typedef unsigned u32x4 __attribute__((ext_vector_type(4)));
typedef unsigned u32x2 __attribute__((ext_vector_type(2)));

constexpr int DM = 1024, NB = 8, SEQ = 2048, CTXL = 256, NLAT = NB * SEQ, NCTX = NB * CTXL, NTOK = NLAT + NCTX;
constexpr int PW = 5120, DIN = 8192, DFF = 4096;
constexpr int C_AX = 0, C_AG = 512, C_BQ = 1024, C_BF = 1536, C_BI = 2560, C_BO = 3072, C_CQ = 3584, C_CK = 4096, C_CV = 4608;
constexpr int LDS_BYTES = 163840;
constexpr size_t WS_WIN = 0;
constexpr size_t WS_WB = WS_WIN + (size_t)DIN * DM * 2;
constexpr size_t WS_WO = WS_WB + (size_t)3 * DM * 512 * 2;
constexpr size_t WS_W1 = WS_WO + (size_t)DM * DM * 2;
constexpr size_t WS_W2 = WS_W1 + (size_t)DFF * DM * 2;
constexpr size_t WS_U = WS_W2 + (size_t)DM * DFF * 2;
constexpr size_t WS_P = WS_U + (size_t)NTOK * DM * 2;
constexpr size_t WS_HC = WS_P + (size_t)NTOK * PW * 2;
constexpr size_t WS_MOD = WS_HC + (size_t)NCTX * DM * 4;
constexpr size_t WS_AGG = WS_MOD + (size_t)2 * 9 * 6144 * 4;
constexpr size_t WS_ROPE = WS_AGG + (size_t)NB * 36 * 2 * 2 * 512 * 4;
constexpr size_t WS_DUMMY = WS_ROPE + 2048 * 4;
constexpr size_t WS_BAR = WS_DUMMY + (2u << 20);
constexpr size_t WS_END = WS_BAR + 16384;

struct Params {
    const float *x, *c, *ctx, *c_ctx, *ada_w, *ada_b, *norm1_g, *norm2_g, *w_in, *conv_w, *conv_b, *lru_wa, *lru_ba, *lru_wx, *lru_bx, *lru_lambda,
        *hg_lb, *hg_norm_g, *na_qg, *na_kg, *na_rpb, *w_branch, *w_out, *ffn_w1, *ffn_w2;
    float* out; unsigned char* ws;
};


__device__ __forceinline__ unsigned long long ldkarg(int off) { unsigned long long v = 0;
#if defined(__HIP_DEVICE_COMPILE__)
    auto kp = __builtin_amdgcn_kernarg_segment_ptr();
    asm volatile("s_load_dwordx2 %0, %1, %2\n\ts_waitcnt lgkmcnt(0)" : "=s"(v) : "s"(kp), "s"(off));
#endif
    return v; }
template <class T> struct rm_ptr; template <class T> struct rm_ptr<T*> { typedef T type; };
template <class T> __device__ __forceinline__ T* as_global_ptr(unsigned long long v) { return (T*)(__attribute__((address_space(1))) T*)v; }
#define PF(f) (as_global_ptr<rm_ptr<decltype(Params::f)>::type>(ldkarg((int)__builtin_offsetof(Params, f))))

#define GAS __attribute__((address_space(1)))
template <class T> __device__ __forceinline__ GAS T* lnd(T* p) { asm volatile("" : "+v"(p)); return (GAS T*)p; }
__device__ __forceinline__ int tid_() { int t = threadIdx.x; asm volatile("" : "+v"(t)); return t; }
__device__ __forceinline__ float bf2f(unsigned v) { return __uint_as_float(v << 16); }
__device__ __forceinline__ float bflo(unsigned w) { return __uint_as_float(w << 16); }
__device__ __forceinline__ float bfhi(unsigned w) { return __uint_as_float(w & 0xffff0000u); }
__device__ __forceinline__ unsigned f2bf(float f) { unsigned u = __float_as_uint(f); u += 0x7fffu + ((u >> 16) & 1u); return u >> 16; }
typedef __bf16 bf16x2_t __attribute__((ext_vector_type(2)));
typedef float f32x2_t __attribute__((ext_vector_type(2)));
__device__ __forceinline__ unsigned pack2(float lo, float hi) { f32x2_t v = {lo, hi}; bf16x2_t b = __builtin_convertvector(v, bf16x2_t); union { bf16x2_t b; unsigned u; } t; t.b = b; return t.u; }
__device__ __forceinline__ float sigmoidf_(float x) { return 1.0f / (1.0f + __expf(-x)); }
__device__ __forceinline__ f32x4 mfma16(bf16x8 a, bf16x8 b, f32x4 c) { return __builtin_amdgcn_mfma_f32_16x16x32_bf16(a, b, c, 0, 0, 0); }
__device__ __forceinline__ bf16x8 as_bf16x8(u32x4 v) { union { u32x4 u; bf16x8 b; } t; t.u = v; return t.b; }
__device__ __forceinline__ void unpack8(u32x4 w, float* o) { o[0] = bflo(w.x); o[1] = bfhi(w.x); o[2] = bflo(w.y); o[3] = bfhi(w.y); o[4] = bflo(w.z); o[5] = bfhi(w.z); o[6] = bflo(w.w); o[7] = bfhi(w.w); }
__device__ __forceinline__ u32x4 pack8(const float* v) { u32x4 w; w.x = pack2(v[0], v[1]); w.y = pack2(v[2], v[3]); w.z = pack2(v[4], v[5]); w.w = pack2(v[6], v[7]); return w; }

namespace pg8 {
constexpr int BM = 256, BK = 64, HALF = 128, HTB = HALF * BK * 2, NXCD = 8, WGM = 8;
__device__ __forceinline__ int lds_byte(int r, int c) { const int st = (r >> 4) * 2 + (c >> 5), rr = r & 15, cc = c & 31, ob = rr * 64 + cc * 2; return st * 1024 + (ob ^ (((ob >> 9) & 1) << 5)); }
__device__ __forceinline__ void stage_rc(int b, int& R, int& C) { const int st = b / 1024, sb = b % 1024, swz = sb ^ (((sb >> 9) & 1) << 5); R = (st >> 1) * 16 + swz / 64; C = (st & 1) * 32 + (swz % 64) / 2; }
__device__ __forceinline__ int perm32(int rho) { const int n = rho >> 4, i = rho & 15; return 8 * (i >> 2) + 4 * n + (i & 3); }

struct Unit { int pm, pn, sub, nt; size_t aoff, boff; };
struct Gemm { const bf16_t* A; const bf16_t* Bt; int lda, ldb, K; };
struct Sched {
    int nM, nN, nwg, G, c, lda, ldb, nt;
    __device__ void init(int M, int N, int G_, int c_, int lda_, int ldb_) { nM = M / BM; nN = N / BM; nwg = nM * nN; G = G_; c = c_; lda = lda_; ldb = ldb_; nt = 0; }
    __device__ bool next(int i, Unit& u) const {
        const long L = (long)i * G + c; if (L >= nwg) return false;
        int wgid = (int)L; { const int q = nwg / NXCD, r = nwg % NXCD, xcd = wgid % NXCD, off = wgid / NXCD; wgid = (xcd < r ? xcd * (q + 1) : r * (q + 1) + (xcd - r) * q) + off; }
        const int nig = WGM * nN, gid = wgid / nig, fm = gid * WGM, gsz = (nM - fm) < WGM ? (nM - fm) : WGM;
        u.pm = fm + ((wgid % nig) % gsz); u.pn = (wgid % nig) / gsz; u.sub = 0; u.nt = nt;
        u.aoff = (size_t)u.pm * BM * lda * 2;
        u.boff = (size_t)u.pn * BM * ldb * 2;
        return true;
    }
};

template <int ACT> struct EpiStore {
    static constexpr bool PERM = true;
    bf16_t* O; int ldc;
    __device__ __forceinline__ void operator()(const f32x4 (&acc)[2][2][4][2], const Unit& u, int wr, int wc, int fr, int fq) const {
        const int row0 = u.pm * BM + wr * 64 + fr; int colt = u.pn * BM;
        if (ACT == 1) colt = (colt < 2048) ? (1024 + colt) : (2048 + colt);
        const int col0 = colt + wc * 32 + 8 * fq;
#pragma unroll
        for (int ai = 0; ai < 2; ++ai)
#pragma unroll
            for (int m = 0; m < 4; ++m) { GAS bf16_t* rowp = lnd(O + (size_t)(row0 + ai * HALF + m * 16) * ldc + col0);
#pragma unroll
                for (int bj = 0; bj < 2; ++bj) { f32x4 v0 = acc[ai][bj][m][0], v1 = acc[ai][bj][m][1];
                    if (ACT == 1) {
#pragma unroll
                        for (int j = 0; j < 4; ++j) { v0[j] = sigmoidf_(v0[j]); v1[j] = sigmoidf_(v1[j]); } }
                    if (ACT == 2) {
#pragma unroll
                        for (int j = 0; j < 4; ++j) { float a = fmaxf(v0[j], 0.f), b = fmaxf(v1[j], 0.f); v0[j] = a * a; v1[j] = b * b; } }
                    u32x4 w; w.x = pack2(v0[0], v0[1]); w.y = pack2(v0[2], v0[3]); w.z = pack2(v1[0], v1[1]); w.w = pack2(v1[2], v1[3]);
                    *(GAS u32x4*)(rowp + bj * HALF) = w; } }
    }
};
struct EpiMerge {
    static constexpr bool PERM = true;
    const bf16_t* P; bf16_t* U;
    __device__ __forceinline__ void operator()(const f32x4 (&acc)[2][2][4][2], const Unit& u, int wr, int wc, int fr, int fq) const {
        const int row0 = u.pm * BM + wr * 64 + fr; const int col0 = u.pn * BM + wc * 32 + 8 * fq;
        const int sub = u.sub; const int gcol = sub * 1024 + u.pn * BM; const int gd = ((gcol < 2048) ? (1024 + gcol) : (2048 + gcol)) + wc * 32 + 8 * fq;
        const bool addp = sub > 0;
#pragma unroll
        for (int ai = 0; ai < 2; ++ai)
#pragma unroll
            for (int m = 0; m < 4; ++m) { const size_t row = (size_t)(row0 + ai * HALF + m * 16); const GAS bf16_t* gp = lnd(P + row * PW + gd); GAS bf16_t* up = lnd(U + row * DM + col0);
#pragma unroll
                for (int bj = 0; bj < 2; ++bj) { const u32x4 gw = *(const GAS u32x4*)(gp + bj * HALF);
                    f32x4 a0 = acc[ai][bj][m][0], a1 = acc[ai][bj][m][1];
                    a0[0] *= bflo(gw.x); a0[1] *= bfhi(gw.x); a0[2] *= bflo(gw.y); a0[3] *= bfhi(gw.y); a1[0] *= bflo(gw.z); a1[1] *= bfhi(gw.z); a1[2] *= bflo(gw.w); a1[3] *= bfhi(gw.w);
                    if (addp) { const u32x4 pw = *(const GAS u32x4*)(up + bj * HALF);
                        a0[0] += bflo(pw.x); a0[1] += bfhi(pw.x); a0[2] += bflo(pw.y); a0[3] += bfhi(pw.y); a1[0] += bflo(pw.z); a1[1] += bfhi(pw.z); a1[2] += bflo(pw.w); a1[3] += bfhi(pw.w); }
                    u32x4 o; o.x = pack2(a0[0], a0[1]); o.y = pack2(a0[2], a0[3]); o.z = pack2(a1[0], a1[1]); o.w = pack2(a1[2], a1[3]);
                    *(GAS u32x4*)(up + bj * HALF) = o; } }
    }
};
struct EpiResid {
    static constexpr bool PERM = true;
    const float* inL; const float* inC; float* outL; float* outC; const float* mod;
    float* slab;
    __device__ __forceinline__ void operator()(const f32x4 (&acc)[2][2][4][2], const Unit& u, int wr, int wc, int fr, int fq) const {
        if (u.sub >= 1) {
            const int row0 = (u.pm - 64) * BM + wr * 64 + fr, col0 = u.pn * BM + wc * 32 + 8 * fq; float* sl = slab + (size_t)(u.sub - 1) * NCTX * DM;
#pragma unroll
            for (int ai = 0; ai < 2; ++ai)
#pragma unroll
                for (int m = 0; m < 4; ++m)
#pragma unroll
                    for (int bj = 0; bj < 2; ++bj) { GAS float* op = lnd(sl + (size_t)(row0 + ai * HALF + m * 16) * DM + col0 + bj * HALF); *(GAS f32x4*)op = acc[ai][bj][m][0]; *(GAS f32x4*)(op + 4) = acc[ai][bj][m][1]; }
            return;
        }
        const bool lat = u.pm < 64; const int rbase = lat ? u.pm * BM : (u.pm - 64) * BM;
        const float* in = lat ? inL : inC; float* out = lat ? outL : outC;
        const int row0 = rbase + wr * 64 + fr, col0 = u.pn * BM + wc * 32 + 8 * fq;
        const float* gt = mod + (size_t)(lat ? (u.pm >> 3) : 8) * 6144 + col0;
#pragma unroll
        for (int bj = 0; bj < 2; ++bj) { const f32x4 g0 = *(const f32x4*)(gt + bj * HALF), g1 = *(const f32x4*)(gt + bj * HALF + 4);
#pragma unroll
            for (int ai = 0; ai < 2; ++ai)
#pragma unroll
                for (int m = 0; m < 4; ++m) { const size_t ro = (size_t)(row0 + ai * HALF + m * 16) * DM + col0 + bj * HALF;
                    const GAS float* ip = lnd(in + ro); GAS float* op = lnd(out + ro); const f32x4 i0 = *(const GAS f32x4*)ip, i1 = *(const GAS f32x4*)(ip + 4);
                    *(GAS f32x4*)op = i0 + g0 * acc[ai][bj][m][0]; *(GAS f32x4*)(op + 4) = i1 + g1 * acc[ai][bj][m][1]; } }
    }
};

struct MergeSched {
    Sched base;
    __device__ bool next(int i, Unit& u) const {
        const int r = i / 3, n = i - 3 * r;
        if (!base.next(r, u)) return false;
        u.sub = n; u.aoff += (size_t)(n == 0 ? C_AG : C_BO + (n - 1) * 512) * 2; u.boff += (size_t)n * DM * 512 * 2;
        return true;
    }
};
struct SplitSched {
    Sched base;
    int sk;
    __device__ bool next(int i, Unit& u) const {
        if (base.next(i, u)) return true;
        const int nfull = (base.nwg - base.c + base.G - 1) / base.G;
        const int k = i - nfull; const int un = k * base.G + base.c; if (k < 0 || un >= 128) return false;
        const int ct = un >> 2, sl = un & 3; u.pm = 64 + (ct >> 2); u.pn = ct & 3; u.sub = 1 + sl; u.nt = sk / BK;
        u.aoff = (size_t)u.pm * BM * base.lda * 2 + (size_t)sl * sk * 2; u.boff = (size_t)u.pn * BM * base.ldb * 2 + (size_t)sl * sk * 2;
        return true;
    }
};
template <class Epi, class Sch>
__device__ __forceinline__ void gemm_phase(LAS unsigned char* lds, const Gemm g, const Sch& S, const Epi& E) {
    const int tid = tid_(), wid = __builtin_amdgcn_readfirstlane(tid >> 6), lane = tid & 63, wr = wid >> 2, wc = wid & 3, fr = lane & 15, fq = lane >> 4;
    const int K = g.K;
    unsigned voffA[2], voffB[2];
#pragma unroll
    for (int i = 0; i < 2; ++i) { int R, C; stage_rc(tid * 16 + i * 8192, R, C); const int Rb = Epi::PERM ? ((R & ~31) + perm32(R & 31)) : R;
        voffA[i] = (unsigned)(R * g.lda + C) * 2u; voffB[i] = (unsigned)(Rb * g.ldb + C) * 2u; }
    const size_t kstep = (size_t)(BK * 2);
    const size_t hstepA = (size_t)HALF * g.lda * 2, hstepB = (size_t)HALF * g.ldb * 2;
    const unsigned ldsw = (unsigned)wid * 1024u;
    const int aoff = lds_byte(wr * 64 + fr, fq * 8), boff = lds_byte(wc * 32 + fr, fq * 8);
#define PG8_SA(b, h) (((b) * 2 + (h)) * HTB)
#define PG8_SB(b, h) ((4 + (b) * 2 + (h)) * HTB)
#define PG8_STAGE(bufoff, gbase, voff) do { _Pragma("unroll") for (int _i = 0; _i < 2; ++_i) \
        __builtin_amdgcn_global_load_lds((const unsigned*)((const char*)(gbase) + (voff)[_i]), (LAS unsigned*)(lds + (bufoff) + ldsw + _i * 8192), 16, 0, 0); } while (0)
#define PG8_LDA(dst, b, h) do { _Pragma("unroll") for (int m = 0; m < 4; ++m) _Pragma("unroll") for (int k = 0; k < 2; ++k) dst[m][k] = *(const LAS bf16x8*)(lds + PG8_SA(b, h) + aoff + m * 2048 + k * 1024); } while (0)
#define PG8_LDB(dst, b, h) do { _Pragma("unroll") for (int n = 0; n < 2; ++n) _Pragma("unroll") for (int k = 0; k < 2; ++k) dst[n][k] = *(const LAS bf16x8*)(lds + PG8_SB(b, h) + boff + n * 2048 + k * 1024); } while (0)
#define PG8_MMA(ai, bj, At, Bt) do { __builtin_amdgcn_s_setprio(1); _Pragma("unroll") for (int m = 0; m < 4; ++m) _Pragma("unroll") for (int n = 0; n < 2; ++n) _Pragma("unroll") for (int k = 0; k < 2; ++k) \
        acc[ai][bj][m][n] = __builtin_amdgcn_mfma_f32_16x16x32_bf16(Bt[n][k], At[m][k], acc[ai][bj][m][n], 0, 0, 0); __builtin_amdgcn_s_setprio(0); } while (0)
#define PG8_WAIT_V(n) asm volatile("s_waitcnt vmcnt(" #n ")" ::: "memory")
#define PG8_WAIT_L(n) asm volatile("s_waitcnt lgkmcnt(" #n ")" ::: "memory")
#define PG8_BAR __builtin_amdgcn_s_barrier()
#define PG8_SCHED __builtin_amdgcn_sched_barrier(0)
    Unit cur, nxt; int ui = 0;
    if (!S.next(0, cur)) return;
    f32x4 acc[2][2][4][2];
#pragma unroll
    for (int a = 0; a < 2; ++a)
#pragma unroll
        for (int b = 0; b < 2; ++b)
#pragma unroll
            for (int m = 0; m < 4; ++m)
#pragma unroll
                for (int n = 0; n < 2; ++n) acc[a][b][m][n] = (f32x4){0.f, 0.f, 0.f, 0.f};
    bf16x8 At[4][2], B0[2][2], B1[2][2];
    const char* cA = (const char*)g.A + cur.aoff; const char* cB = (const char*)g.Bt + cur.boff;
    PG8_STAGE(PG8_SB(0, 0), cB, voffB); PG8_STAGE(PG8_SA(0, 0), cA, voffA); PG8_STAGE(PG8_SB(0, 1), cB + hstepB, voffB); PG8_STAGE(PG8_SA(0, 1), cA + hstepA, voffA);
    if (wr == 1) PG8_BAR;
    PG8_WAIT_V(4); PG8_BAR;
    PG8_STAGE(PG8_SB(1, 0), cB + kstep, voffB); PG8_STAGE(PG8_SA(1, 0), cA + kstep, voffA); PG8_STAGE(PG8_SB(1, 1), cB + hstepB + kstep, voffB);
    PG8_WAIT_V(6); PG8_BAR;
    for (;;) {
        const bool has_next = S.next(ui + 1, nxt);
        const char* nA = has_next ? (const char*)g.A + nxt.aoff : cA; const char* nB = has_next ? (const char*)g.Bt + nxt.boff : cB;
        const int nt = cur.nt ? cur.nt : K / BK;
        for (int t = 0; t < nt; t += 2) {
            const bool last = (t == nt - 2);
            const char* a1 = cA + (size_t)(t + 1) * kstep;
            const char* a2 = last ? nA : cA + (size_t)(t + 2) * kstep; const char* b2 = last ? nB : cB + (size_t)(t + 2) * kstep;
            const char* a3 = a2 + kstep; const char* b3 = b2 + kstep;
            PG8_LDB(B0, 0, 0); PG8_SCHED; PG8_LDA(At, 0, 0); PG8_STAGE(PG8_SA(1, 1), a1 + hstepA, voffA);
            PG8_WAIT_L(8); PG8_BAR; PG8_WAIT_L(0); PG8_MMA(0, 0, At, B0); PG8_BAR; PG8_SCHED;
            PG8_LDB(B1, 0, 1); PG8_STAGE(PG8_SB(0, 0), b2, voffB);
            PG8_BAR; PG8_WAIT_L(0); PG8_MMA(0, 1, At, B1); PG8_BAR;
            PG8_LDA(At, 0, 1); PG8_STAGE(PG8_SA(0, 0), a2, voffA);
            PG8_BAR; PG8_WAIT_L(0); PG8_MMA(1, 0, At, B0); PG8_BAR; PG8_SCHED;
            PG8_STAGE(PG8_SB(0, 1), b2 + hstepB, voffB);
            PG8_WAIT_V(6); PG8_BAR; PG8_MMA(1, 1, At, B1); PG8_BAR;
            PG8_LDB(B0, 1, 0); PG8_SCHED; PG8_LDA(At, 1, 0); PG8_STAGE(PG8_SA(0, 1), a2 + hstepA, voffA);
            PG8_WAIT_L(8); PG8_BAR; PG8_WAIT_L(0); PG8_MMA(0, 0, At, B0); PG8_BAR; PG8_SCHED;
            PG8_LDB(B1, 1, 1); PG8_STAGE(PG8_SB(1, 0), b3, voffB);
            PG8_BAR; PG8_WAIT_L(0); PG8_MMA(0, 1, At, B1); PG8_BAR;
            PG8_LDA(At, 1, 1); PG8_STAGE(PG8_SA(1, 0), a3, voffA);
            PG8_BAR; PG8_WAIT_L(0); PG8_MMA(1, 0, At, B0); PG8_BAR; PG8_SCHED;
            PG8_STAGE(PG8_SB(1, 1), b3 + hstepB, voffB);
            PG8_WAIT_V(6); PG8_BAR; PG8_MMA(1, 1, At, B1); PG8_BAR;
        }
        E(acc, cur, wr, wc, fr, fq);
        if (!has_next) break;
#pragma unroll
        for (int a = 0; a < 2; ++a)
#pragma unroll
            for (int b = 0; b < 2; ++b)
#pragma unroll
                for (int m = 0; m < 4; ++m)
#pragma unroll
                    for (int n = 0; n < 2; ++n) acc[a][b][m][n] = (f32x4){0.f, 0.f, 0.f, 0.f};
        cur = nxt; cA = nA; cB = nB; ++ui;
    }
    PG8_WAIT_V(0);
    if (wr == 0) PG8_BAR;
    PG8_BAR;
#undef PG8_SA
#undef PG8_SB
#undef PG8_STAGE
#undef PG8_LDA
#undef PG8_LDB
#undef PG8_MMA
#undef PG8_WAIT_V
#undef PG8_WAIT_L
#undef PG8_BAR
#undef PG8_SCHED
}
}


#define XB_TMO      128
#define XB_XCNT(j)  (256  + 64 * (j))
#define XB_XSUB(j)  (1280 + 64 * (j))
#define XB_XGEN(j)  (2304 + 64 * (j))
#define XB_TOP      3328
#define XB_TOPGEN   3392
#define XCD_BAR_WORDS 3456
#define XB_SPIN_CAP (1u << 20)
__device__ __forceinline__ unsigned xb_ld(unsigned* p)              { return __hip_atomic_load(p, __ATOMIC_RELAXED, __HIP_MEMORY_SCOPE_AGENT); }
__device__ __forceinline__ unsigned xb_add(unsigned* p, unsigned v) { return __hip_atomic_fetch_add(p, v, __ATOMIC_RELAXED, __HIP_MEMORY_SCOPE_AGENT); }
__device__ __forceinline__ unsigned xb_xcc_id() { return (unsigned)__builtin_amdgcn_s_getreg((3 << 11) | 20) & 0xFu; }
#define XB_SPIN(cond, bar) do { unsigned _sp = 0; while (cond) { __builtin_amdgcn_s_sleep(1); \
    if ((++_sp & 255u) == 0u) { if (xb_ld(&(bar)[XB_TMO])) break; if (_sp > XB_SPIN_CAP) { atomicAdd(&(bar)[XB_TMO], 1u); break; } } } } while (0)
struct XcdBarrier { unsigned* bar; unsigned x; volatile LAS unsigned* st; };
__device__ __forceinline__ XcdBarrier xcd_barrier_post(unsigned* bar, volatile LAS unsigned* st) {
    XcdBarrier b; b.bar = bar; b.x = xb_xcc_id(); b.st = st;
    if (threadIdx.x == 0) (void)xb_add(&bar[XB_XCNT(b.x)], 1u);
    return b;
}
__device__ __forceinline__ void xcd_barrier_complete(unsigned* bar, unsigned x, unsigned& nloc, unsigned& nx) {
    const unsigned G = gridDim.x * gridDim.y * gridDim.z;
    unsigned sum, cnt, mine, sp = 0u;
    for (;;) {
        sum = 0u; cnt = 0u; mine = 0u;
#pragma unroll
        for (unsigned j = 0; j < 16; ++j) { const unsigned c = xb_ld(&bar[XB_XCNT(j)]); sum += c; cnt += (c > 0u) ? 1u : 0u; mine = (j == x) ? c : mine; }
        if (sum == G) break;
        __builtin_amdgcn_s_sleep(1);
        if ((++sp & 255u) == 0u) { if (xb_ld(&bar[XB_TMO])) break; if (sp > XB_SPIN_CAP) { atomicAdd(&bar[XB_TMO], 1u); break; } }
    }
    nloc = mine > 0u ? mine : 1u; nx = cnt > 0u ? cnt : 1u;
}
__device__ __forceinline__ void xcd_barrier(const XcdBarrier& b) {
    asm volatile("s_waitcnt vmcnt(0)" ::: "memory");
    __syncthreads();
    if (threadIdx.x == 0) {
        unsigned* bar = b.bar;
        __builtin_amdgcn_s_waitcnt(0);
        unsigned nloc = b.st[0], nx = b.st[1];
        if (nloc == 0u) { xcd_barrier_complete(bar, b.x, nloc, nx); b.st[0] = nloc; b.st[1] = nx; }
        const unsigned old = xb_add(&bar[XB_XSUB(b.x)], 1u);
        const unsigned gen = old / nloc;
        if (old + 1u == (gen + 1u) * nloc) {
            __builtin_amdgcn_fence(__ATOMIC_RELEASE, "agent");
            asm volatile("s_waitcnt vmcnt(0)" ::: "memory");
            const unsigned og = xb_add(&bar[XB_TOP], 1u);
            const unsigned tg = og / nx;
            if (og + 1u == (tg + 1u) * nx) xb_add(&bar[XB_TOPGEN], 1u);
            else XB_SPIN(xb_ld(&bar[XB_TOPGEN]) == tg, bar);
            __builtin_amdgcn_fence(__ATOMIC_ACQUIRE, "agent");
            xb_add(&bar[XB_XGEN(b.x)], 1u);
            asm volatile("s_waitcnt vmcnt(0)" ::: "memory");
        } else {
            XB_SPIN(xb_ld(&bar[XB_XGEN(b.x)]) == gen, bar);
            __builtin_amdgcn_fence(__ATOMIC_ACQUIRE, "agent");
            asm volatile("s_waitcnt vmcnt(0)" ::: "memory");
        }
    }
    __syncthreads();
}

__device__ __forceinline__ void sub_barrier(unsigned* word, unsigned n) {
    asm volatile("s_waitcnt vmcnt(0)" ::: "memory");
    __syncthreads();
    if (threadIdx.x == 0) {
        __builtin_amdgcn_fence(__ATOMIC_RELEASE, "agent");
        asm volatile("s_waitcnt vmcnt(0)" ::: "memory");
        xb_add(word, 1u);
        unsigned sp = 0;
        while (xb_ld(word) < n) { __builtin_amdgcn_s_sleep(1); if (++sp > (1u << 22)) break; }
        __builtin_amdgcn_fence(__ATOMIC_ACQUIRE, "agent");
        asm volatile("s_waitcnt vmcnt(0)" ::: "memory");
    }
    __syncthreads();
}

__device__ __forceinline__ void phase_mod(const Params& p, LAS unsigned char* lds) {
    LAS float* sc = (LAS float*)lds;
    LAS float* part = sc + 9 * 1024;
    float* mod = (float*)(PF(ws) + WS_MOD);
    const int tid = tid_(), w = tid >> 6, lane = tid & 63;
    if ((int)blockIdx.x >= 192) return;
    const float* pc = PF(c); const float* pcc = PF(c_ctx); const float* padaw = PF(ada_w); const float* padab = PF(ada_b);
    for (int i = tid; i < 9 * 1024; i += 512) { const int r = i >> 10, k = i & 1023; const float v = (r < 8) ? pc[r * 1024 + k] : pcc[k]; sc[i] = v / (1.0f + expf(-v)); }
    __syncthreads();
    for (int item = blockIdx.x; item < 192; item += gridDim.x) {
        const int l = item / 96, cb = item % 96;
        const float* W = padaw + (size_t)l * 1024 * 6144 + cb * 64 + lane;
        float acc[9];
#pragma unroll
        for (int r = 0; r < 9; ++r) acc[r] = 0.f;
        for (int k = w * 128; k < w * 128 + 128; ++k) { const float wv = W[(size_t)k * 6144];
#pragma unroll
            for (int r = 0; r < 9; ++r) acc[r] += sc[r * 1024 + k] * wv; }
#pragma unroll
        for (int r = 0; r < 9; ++r) part[(w * 9 + r) * 64 + lane] = acc[r];
        __syncthreads();
        for (int i = tid; i < 576; i += 512) { const int r = i >> 6, ln = i & 63; float s = 0.f;
#pragma unroll
            for (int ww = 0; ww < 8; ++ww) s += part[(ww * 9 + r) * 64 + ln];
            mod[(size_t)(l * 9 + r) * 6144 + cb * 64 + ln] = s + padab[l * 6144 + cb * 64 + ln]; }
        __syncthreads();
    }
}
__device__ __forceinline__ void phase_rope(const Params& p) {
    if (blockIdx.x != gridDim.x - 1) return;
    float* rope = (float*)(PF(ws) + WS_ROPE);
    for (int i = tid_(); i < 1024; i += 512) { const int pos = i >> 4, fi = i & 15; const float invf = powf(10000.0f, -(float)fi / 16.0f); const float ang = (float)pos * invf; rope[i] = cosf(ang); rope[1024 + i] = sinf(ang); }
}
__device__ __forceinline__ void convert_tile(const float* src, int K, int N, bf16_t* dst, int tile, LAS bf16_t* T) {
    const int tid = tid_(), tilesN = N >> 7, tk = tile / tilesN, tn = tile - tk * tilesN, k0 = tk * 128, n0 = tn * 128;
    const int r = tid >> 4, c8 = (tid & 15) * 8;
    f32x4 a[4], b[4];
#pragma unroll
    for (int i = 0; i < 4; ++i) { const float* s = src + (size_t)(k0 + r + 32 * i) * N + n0 + c8; a[i] = *(const f32x4*)s; b[i] = *(const f32x4*)(s + 4); }
#pragma unroll
    for (int i = 0; i < 4; ++i)
#pragma unroll
        for (int j = 0; j < 4; ++j) { T[(c8 + j) * 136 + r + 32 * i] = (bf16_t)f2bf(a[i][j]); T[(c8 + 4 + j) * 136 + r + 32 * i] = (bf16_t)f2bf(b[i][j]); }
    __syncthreads();
    const int n = tid >> 2, ks = (tid & 3) * 8;
#pragma unroll
    for (int i = 0; i < 4; ++i) { const u32x4 v = *(const LAS u32x4*)(T + n * 136 + ks + 32 * i); *(u32x4*)(dst + (size_t)(n0 + n) * K + k0 + ks + 32 * i) = v; }
    __syncthreads();
}
__device__ __forceinline__ void phase_convert(const Params& p, int l, LAS unsigned char* lds) {
    LAS bf16_t* T = (LAS bf16_t*)lds;
    bf16_t* WIN = (bf16_t*)(PF(ws) + WS_WIN); bf16_t* WB = (bf16_t*)(PF(ws) + WS_WB); bf16_t* WO = (bf16_t*)(PF(ws) + WS_WO); bf16_t* W1 = (bf16_t*)(PF(ws) + WS_W1); bf16_t* W2 = (bf16_t*)(PF(ws) + WS_W2);
    for (int it = blockIdx.x; it < 1184; it += gridDim.x) {
        if (it < 512) convert_tile(PF(w_in) + (size_t)l * DM * DIN, DM, DIN, WIN, it, T);
        else if (it < 608) { const int n = (it - 512) / 32, tl = (it - 512) % 32; convert_tile(PF(w_branch) + (size_t)(l * 3 + n) * 512 * DM, 512, DM, WB + (size_t)n * DM * 512, tl, T); }
        else if (it < 672) convert_tile(PF(w_out) + (size_t)l * DM * DM, DM, DM, WO, it - 608, T);
        else if (it < 928) convert_tile(PF(ffn_w1) + (size_t)l * DM * DFF, DM, DFF, W1, it - 672, T);
        else convert_tile(PF(ffn_w2) + (size_t)l * DFF * DM, DFF, DM, W2, it - 928, T);
    }
}
__device__ __forceinline__ void phase_norm(const Params& p, int l, const float* hlat, const float* hctx, const float* g, int modoff, int nrows, const float* slab = nullptr, const float* slabgate = nullptr, float* hwrite = nullptr) {
    const int tid = tid_(); const int w = tid >> 6, lane = tid & 63;
    bf16_t* U = (bf16_t*)(PF(ws) + WS_U); const float* mod = (const float*)(PF(ws) + WS_MOD);
    for (int row = blockIdx.x * 8 + w; row < nrows; row += gridDim.x * 8) {
        const float* src = row < NLAT ? hlat + (size_t)row * DM : hctx + (size_t)(row - NLAT) * DM;
        const int mr = row < NLAT ? (row >> 11) : 8;
        const float* md = mod + (size_t)(l * 9 + mr) * 6144 + modoff;
        f32x4 v[4]; float ss = 0.f;
#pragma unroll
        for (int i = 0; i < 4; ++i) { v[i] = *(const f32x4*)(src + i * 256 + lane * 4);
            if (slab != nullptr && row >= NLAT) { const size_t o = (size_t)(row - NLAT) * DM + i * 256 + lane * 4; const f32x4 gg = *(const f32x4*)(slabgate + i * 256 + lane * 4);
                const f32x4 s4 = (*(const f32x4*)(slab + o) + *(const f32x4*)(slab + o + (size_t)NCTX * DM)) + (*(const f32x4*)(slab + o + (size_t)2 * NCTX * DM) + *(const f32x4*)(slab + o + (size_t)3 * NCTX * DM));
                v[i] += gg * s4; if (hwrite != nullptr) *(f32x4*)(hwrite + o) = v[i]; }
            ss += v[i][0] * v[i][0] + v[i][1] * v[i][1] + v[i][2] * v[i][2] + v[i][3] * v[i][3]; }
#pragma unroll
        for (int o = 32; o >= 1; o >>= 1) ss += __shfl_xor(ss, o);
        const float rstd = rsqrtf(ss * (1.0f / 1024.0f) + 1e-6f);
#pragma unroll
        for (int i = 0; i < 4; ++i) { const int cidx = i * 256 + lane * 4; const f32x4 gg = *(const f32x4*)(g + cidx), sh = *(const f32x4*)(md + cidx), scv = *(const f32x4*)(md + 1024 + cidx);
            float o4[4];
#pragma unroll
            for (int j = 0; j < 4; ++j) o4[j] = (v[i][j] * rstd * gg[j]) * (1.0f + scv[j]) + sh[j];
            u32x2 wv; wv.x = pack2(o4[0], o4[1]); wv.y = pack2(o4[2], o4[3]);
            *(u32x2*)(U + (size_t)row * DM + cidx) = wv; }
    }
}
__device__ __forceinline__ void phase_hg_final(const Params& p, int l, int nrows, int wg, int nwg) {
    const int tid = tid_(); const int w = tid >> 6, lane = tid & 63; bf16_t* P = (bf16_t*)(PF(ws) + WS_P);
    const int hd = lane >> 4, e8 = (lane & 15) * 8; const float* png = PF(hg_norm_g);
    float ng[8];
#pragma unroll
    for (int i = 0; i < 8; ++i) ng[i] = png[l * 128 + e8 + i];
    for (int row = wg * 8 + w; row < nrows; row += nwg * 8) {
        bf16_t* rp = P + (size_t)row * PW;
        float a[8], b[8], og[8]; unpack8(*(const u32x4*)(rp + C_BF + hd * 128 + e8), a); unpack8(*(const u32x4*)(rp + C_BF + 512 + hd * 128 + e8), b); unpack8(*(const u32x4*)(rp + C_BO + hd * 128 + e8), og);
        float ss = 0.f;
#pragma unroll
        for (int i = 0; i < 8; ++i) { a[i] += b[i]; ss += a[i] * a[i]; }
        ss += __shfl_xor(ss, 1); ss += __shfl_xor(ss, 2); ss += __shfl_xor(ss, 4); ss += __shfl_xor(ss, 8);
        const float rstd = rsqrtf(ss * (1.0f / 128.0f) + 1e-6f);
        float y[8];
#pragma unroll
        for (int i = 0; i < 8; ++i) y[i] = a[i] * rstd * ng[i] * sigmoidf_(og[i]);
        *(u32x4*)(rp + C_BO + hd * 128 + e8) = pack8(y);
    }
}

__device__ __forceinline__ size_t agg_idx(int b, int gch, int dir, int which, int ch) { return ((((size_t)b * 36 + gch) * 2 + dir) * 2 + which) * 512 + ch; }
__device__ __forceinline__ float gelu_tanh(float x) { const float u = 0.7978845608028654f * (x + 0.044715f * x * x * x); const float th = 1.0f - 2.0f / (1.0f + __expf(2.0f * u)); return 0.5f * x * (1.0f + th); }
__device__ __forceinline__ void lru_tile(const Params& p, int l, LAS unsigned char* lds, int item, int mode, int& staged_nb) {
    LAS bf16_t* Wl = (LAS bf16_t*)lds;
    LAS bf16_t* Xb = Wl + 256 * 72;
    LAS float* Xf = (LAS float*)(lds + 46080);
    LAS float* Av = Xf + 4096;
    LAS float* Bv = Av + 8192;
    bf16_t* P = (bf16_t*)(PF(ws) + WS_P); float* AGG = (float*)(PF(ws) + WS_AGG);
    const int tid = tid_(), w = tid >> 6, lane = tid & 63, l16 = lane & 15, q4 = lane >> 4;
    const int nb = item & 7, rest = item >> 3, gch = rest % 36, b = rest / 36;
    const bool isctx = gch < 4; const int chunk = isctx ? gch : gch - 4, L = isctx ? CTXL : SEQ;
    const size_t seqrow0 = isctx ? (size_t)NLAT + b * CTXL : (size_t)b * SEQ; const int t0 = chunk * 64;
    if (staged_nb != nb) { const float* pwx = PF(lru_wx); const float* pwa = PF(lru_wa);
        for (int e = tid; e < 4 * 64 * 64; e += 512) { const int mat = e >> 12, i = (e >> 6) & 63, c = e & 63; const int dir = mat >> 1, kind = mat & 1;
            const float* W = kind ? pwx : pwa; const float v = W[((size_t)((l * 2 + dir) * 8 + nb) * 64 + i) * 64 + c];
            const int op = dir * 128 + (c >> 4) * 32 + kind * 16 + (c & 15);
            Wl[op * 72 + i] = (bf16_t)f2bf(v); }
        staged_nb = nb;
    }
    {
        const int t = tid >> 3, c8 = (tid & 7) * 8, ch = nb * 64 + c8, tt = t0 + t;
        float a8[8]; const float* pcb = PF(conv_b); const float* pcw = PF(conv_w);
        { const f32x4 b0 = *(const f32x4*)(pcb + l * 512 + ch), b1 = *(const f32x4*)(pcb + l * 512 + ch + 4);
#pragma unroll
          for (int i = 0; i < 4; ++i) { a8[i] = b0[i]; a8[4 + i] = b1[i]; } }
#pragma unroll
        for (int j = 0; j < 4; ++j) { const int ts = tt + j - 2;
            if (ts >= 0 && ts < L) { float xv[8]; unpack8(*(const u32x4*)(P + (seqrow0 + ts) * PW + C_AX + ch), xv);
                const f32x4 w0 = *(const f32x4*)(pcw + (l * 4 + j) * 512 + ch), w1 = *(const f32x4*)(pcw + (l * 4 + j) * 512 + ch + 4);
#pragma unroll
                for (int i = 0; i < 4; ++i) { a8[i] += xv[i] * w0[i]; a8[4 + i] += xv[4 + i] * w1[i]; } } }
#pragma unroll
        for (int i = 0; i < 8; ++i) Xf[t * 64 + c8 + i] = a8[i];
        *(LAS u32x4*)(Xb + t * 72 + c8) = pack8(a8);
    }
    __syncthreads();
    {
        const int dir = w >> 2, c = (w & 3) * 16 + l16, ch = nb * 64 + c;
        f32x4 acc[4][2];
#pragma unroll
        for (int mg = 0; mg < 4; ++mg) { acc[mg][0] = (f32x4){0.f, 0.f, 0.f, 0.f}; acc[mg][1] = (f32x4){0.f, 0.f, 0.f, 0.f}; }
#pragma unroll
        for (int ks = 0; ks < 2; ++ks) {
            const bf16x8 B0 = *(const LAS bf16x8*)(Wl + (w * 32 + l16) * 72 + ks * 32 + q4 * 8), B1 = *(const LAS bf16x8*)(Wl + (w * 32 + 16 + l16) * 72 + ks * 32 + q4 * 8);
#pragma unroll
            for (int mg = 0; mg < 4; ++mg) { const bf16x8 A = *(const LAS bf16x8*)(Xb + (mg * 16 + l16) * 72 + ks * 32 + q4 * 8);
                acc[mg][0] = mfma16(A, B0, acc[mg][0]); acc[mg][1] = mfma16(A, B1, acc[mg][1]); }
        }
        const float ba = PF(lru_ba)[(l * 2 + dir) * 512 + ch], bx = PF(lru_bx)[(l * 2 + dir) * 512 + ch], lam = PF(lru_lambda)[(l * 2 + dir) * 512 + ch];
        const float sp = log1pf(expf(-lam));
#pragma unroll
        for (int mg = 0; mg < 4; ++mg)
#pragma unroll
            for (int j = 0; j < 4; ++j) { const int t = mg * 16 + q4 * 4 + j;
                const float ea = 1.0f + __expf(-(acc[mg][0][j] + ba)), ex = 1.0f + __expf(-(acc[mg][1][j] + bx)); const float inv = __builtin_amdgcn_rcpf(ea * ex);
                const float r = inv * ex, ig = inv * ea;
                const float la = -8.0f * r * sp; const float a = __expf(la); const float x2 = 2.0f * la;
                float om = -x2 * (1.0f + x2 * (0.5f + x2 * (0.16666667f + x2 * (0.041666668f + x2 * 0.0083333338f))));
                if (x2 < -0.35f) om = 1.0f - a * a;
                const float bb = sqrtf(fmaxf(om, 0.f)) * ig * Xf[t * 64 + c];
                Av[(dir * 64 + t) * 64 + c] = a; Bv[(dir * 64 + t) * 64 + c] = bb; }
    }
    __syncthreads();
    {
        LAS float* SegA = Xf;
        LAS float* SegB = Xf + 512;
        const int d2 = tid >> 8, seg = (tid >> 6) & 3, c = tid & 63, ch = nb * 64 + c;
        float av[16], bv[16];
#pragma unroll
        for (int k = 0; k < 16; ++k) { const int s = seg * 16 + k; const int t = d2 ? 63 - s : s; const int ix = (d2 * 64 + t) * 64 + c; av[k] = Av[ix]; bv[k] = Bv[ix]; }
        float h = 0.f, ap = 1.f;
#pragma unroll
        for (int k = 0; k < 16; ++k) { h = av[k] * h + bv[k]; ap *= av[k]; }
        SegA[(d2 * 4 + seg) * 64 + c] = ap; SegB[(d2 * 4 + seg) * 64 + c] = h;
        float hin = 0.f;
        if (mode == 1) {
            const int mypos = d2 == 0 ? gch : (gch < 4 ? 3 - gch : 39 - gch);
            for (int p0 = 0; p0 < mypos; p0 += 6) { float Aa[6], Bb[6];
#pragma unroll
                for (int j = 0; j < 6; ++j) { const int pp = p0 + j; const int g = d2 == 0 ? pp : (pp < 4 ? 3 - pp : 39 - pp); const bool ok = pp < mypos;
                    Aa[j] = ok ? AGG[agg_idx(b, ok ? g : 0, d2, 0, ch)] : 1.0f; Bb[j] = ok ? AGG[agg_idx(b, ok ? g : 0, d2, 1, ch)] : 0.0f; }
#pragma unroll
                for (int j = 0; j < 6; ++j) hin = Aa[j] * hin + Bb[j]; }
        }
        __syncthreads();
        if (mode == 0) {
            if (seg == 3) { float A = 1.f, B = 0.f;
#pragma unroll
                for (int s2 = 0; s2 < 4; ++s2) { const float sa = SegA[(d2 * 4 + s2) * 64 + c], sb2 = SegB[(d2 * 4 + s2) * 64 + c]; B = sa * B + sb2; A *= sa; }
                AGG[agg_idx(b, gch, d2, 0, ch)] = A; AGG[agg_idx(b, gch, d2, 1, ch)] = B; }
        } else {
#pragma unroll
            for (int s2 = 0; s2 < 3; ++s2) if (s2 < seg) hin = SegA[(d2 * 4 + s2) * 64 + c] * hin + SegB[(d2 * 4 + s2) * 64 + c];
            float hh2 = hin;
#pragma unroll
            for (int k = 0; k < 16; ++k) { const int s = seg * 16 + k; const int t = d2 ? 63 - s : s; hh2 = av[k] * hh2 + bv[k]; Bv[(d2 * 64 + t) * 64 + c] = hh2; }
        }
    }
    __syncthreads();
    if (mode == 1) {
        const int t = tid >> 3, c8 = (tid & 7) * 8; bf16_t* gp = P + (seqrow0 + t0 + t) * PW + C_AG + nb * 64 + c8;
        float gt[8]; unpack8(*(const u32x4*)gp, gt); float y[8];
#pragma unroll
        for (int i = 0; i < 8; ++i) y[i] = (Bv[t * 64 + c8 + i] + Bv[(64 + t) * 64 + c8 + i]) * gelu_tanh(gt[i]);
        *(u32x4*)gp = pack8(y);
        __syncthreads();
    }
}

__device__ __forceinline__ void attn_item(const Params& p, int l, LAS unsigned char* lds, int item, int dry = 0) {
    LAS bf16_t* Kt = (LAS bf16_t*)lds;
    LAS bf16_t* Vt = Kt + 2 * 64 * 72;
    LAS float* rpbL = (LAS float*)(lds + 36864);
    LAS float* cosT = rpbL + 960;
    LAS float* sinT = cosT + 1024;
    LAS float* gq = sinT + 1024; LAS float* gk = gq + 64;
    bf16_t* P = (bf16_t*)(PF(ws) + WS_P); const float* rope = (const float*)(PF(ws) + WS_ROPE);
    const int tid = tid_(), w = __builtin_amdgcn_readfirstlane(tid >> 6), lane = tid & 63, l16 = lane & 15, q4 = lane >> 4, hh = w >> 2, qg4 = w & 3;
    const bool isctx = item >= 512;
    int b, hp, nloc, krU; int rq[2], kq0[2]; size_t qrow0[2];
    if (!isctx) { hp = item & 3; const int rp = (item >> 2) & 15; b = item >> 6;
        rq[0] = 2 * rp; rq[1] = 2 * rp + 1; kq0[0] = min(max(rq[0] - 4, 0), 24); kq0[1] = min(max(rq[1] - 4, 0), 24);
        qrow0[0] = (size_t)b * SEQ + rq[0] * 64; qrow0[1] = qrow0[0] + 64; krU = kq0[0]; nloc = kq0[1] + 8 - kq0[0]; }
    else { const int it = item - 512; hp = it & 3; const int qt = (it >> 2) & 1; b = it >> 3; rq[0] = rq[1] = 0; kq0[0] = kq0[1] = 0; krU = 0; nloc = 0;
        qrow0[0] = (size_t)NLAT + b * CTXL + qt * 128; qrow0[1] = qrow0[0] + 64; }
    const int h = hp * 2 + hh;
    const float* prpb = PF(na_rpb);
    for (int i = tid; i < 2 * 465; i += 512) { const int h2 = i / 465, j = i - h2 * 465; rpbL[h2 * 480 + j] = prpb[(size_t)((l * 8 + hp * 2 + h2) * 465) + j]; }
    for (int i = tid; i < 1024; i += 512) { cosT[i] = rope[i]; sinT[i] = rope[1024 + i]; }
    if (tid < 64) { gq[tid] = PF(na_qg)[l * 64 + tid]; gk[tid] = PF(na_kg)[l * 64 + tid]; }
    __syncthreads();
    const int qc = qg4 * 16 + l16;
    const int glo = qg4 < 2 ? 0 : qg4 - 1, ghi = qg4 == 0 ? 1 : (qg4 == 3 ? 3 : qg4 + 1);
    int bidx[4][4]; unsigned mbits = 0u;
    { const int cs0 = min(max(qc - 8, 0), 48);
#pragma unroll
      for (int g = 0; g < 4; ++g)
#pragma unroll
          for (int j = 0; j < 4; ++j) { const int kc = g * 16 + q4 * 4 + j; bidx[g][j] = hh * 480 + min(max(kc - qc, -15), 15) + 15; if (kc < cs0 || kc >= cs0 + 16) mbits |= 1u << (g * 4 + j); } }
    bf16x8 qpl[2][2], qrt[2][2];
#pragma unroll
    for (int qi = 0; qi < 2; ++qi) {
        const bf16_t* qp = P + (qrow0[qi] + qc) * PW + C_CQ + h * 64;
        float xq[16]; unpack8(*(const u32x4*)(qp + q4 * 8), xq); unpack8(*(const u32x4*)(qp + 32 + q4 * 8), xq + 8);
        float ss = 0.f;
#pragma unroll
        for (int i = 0; i < 16; ++i) ss += xq[i] * xq[i];
        ss += __shfl_xor(ss, 16); ss += __shfl_xor(ss, 32);
        const float rs = rsqrtf(ss * (1.0f / 64.0f) + 1e-6f) * 0.125f;
#pragma unroll
        for (int i = 0; i < 8; ++i) { xq[i] *= rs * gq[q4 * 8 + i]; xq[8 + i] *= rs * gq[32 + q4 * 8 + i]; }
        qpl[qi][0] = as_bf16x8(pack8(xq)); qpl[qi][1] = as_bf16x8(pack8(xq + 8));
        float xr[16];
#pragma unroll
        for (int ks = 0; ks < 2; ++ks) { const int pos = ks == 0 ? rq[qi] : qc;
#pragma unroll
            for (int jj = 0; jj < 8; ++jj) { const int fi = (q4 & 1) * 8 + jj; const float cs = cosT[pos * 16 + fi], sn = sinT[pos * 16 + fi]; const float xv = xq[ks * 8 + jj]; const float pr = __shfl_xor(xv, 32);
                xr[ks * 8 + jj] = (q4 < 2) ? (xv * cs - pr * sn) : (xv * cs + pr * sn); } }
        qrt[qi][0] = as_bf16x8(pack8(xr)); qrt[qi][1] = as_bf16x8(pack8(xr + 8));
    }
    f32x4 O[2][4];
#pragma unroll
    for (int qi = 0; qi < 2; ++qi)
#pragma unroll
        for (int i = 0; i < 4; ++i) O[qi][i] = (f32x4){0.f, 0.f, 0.f, 0.f};
    float mrun[2] = {-1e30f, -1e30f}, lsum[2] = {0.f, 0.f};
    const int pf_hh2 = tid >> 8, pf_h2 = hp * 2 + pf_hh2, pf_key = (tid & 255) >> 2, pf_seg = tid & 3, pf_vseg = (tid & 255) >> 6, pf_vkey = tid & 63;
    u32x4 pk0, pk1, pv0, pv1;
    { const size_t r0 = nloc ? (size_t)b * SEQ + krU * 64 : (size_t)NLAT + b * CTXL;
      const bf16_t* kp = P + (r0 + pf_key) * PW + C_CK + pf_h2 * 64 + pf_seg * 16; pk0 = *(const u32x4*)kp; pk1 = *(const u32x4*)(kp + 8);
      const bf16_t* vp = P + (r0 + pf_vkey) * PW + C_CV + pf_h2 * 64 + pf_vseg * 16; pv0 = *(const u32x4*)vp; pv1 = *(const u32x4*)(vp + 8); }
    const int ntot = nloc + 4; int Tn = 0;
#pragma unroll
    for (int ph = 0; ph < 2; ++ph) {
    const bool loc = (ph == 0); const int ntile = loc ? nloc : 4;
    for (int kt = 0; kt < ntile; ++kt) {
        const int kr = krU + kt; ++Tn;
        {
            const int hh2 = pf_hh2, key = pf_key, seg = pf_seg;
            float xk[16]; unpack8(pk0, xk); unpack8(pk1, xk + 8);
            float ss = 0.f;
#pragma unroll
            for (int i = 0; i < 16; ++i) ss += xk[i] * xk[i];
            ss += __shfl_xor(ss, 1); ss += __shfl_xor(ss, 2);
            const float rs = rsqrtf(ss * (1.0f / 64.0f) + 1e-6f);
#pragma unroll
            for (int i = 0; i < 16; ++i) xk[i] *= rs * gk[seg * 16 + i];
            if (loc) { const int pos = seg < 2 ? kr : key;
#pragma unroll
                for (int i = 0; i < 16; ++i) { const float pr = __shfl_xor(xk[i], 1); const float cs = cosT[pos * 16 + i], sn = sinT[pos * 16 + i]; xk[i] = (seg & 1) ? (xk[i] * cs + pr * sn) : (xk[i] * cs - pr * sn); } }
            LAS bf16_t* kd = Kt + (hh2 * 64 + key) * 72 + seg * 16;
            *(LAS u32x4*)kd = pack8(xk); *(LAS u32x4*)(kd + 8) = pack8(xk + 8);
        }
        {
            const int hh2 = pf_hh2, seg = pf_vseg, key = pf_vkey;
            const u32x4 a = pv0, c = pv1;
            LAS bf16_t* vd = Vt + (hh2 * 64 + seg * 16) * 72 + key;
            vd[0 * 72] = (bf16_t)(a.x & 0xffff); vd[1 * 72] = (bf16_t)(a.x >> 16); vd[2 * 72] = (bf16_t)(a.y & 0xffff); vd[3 * 72] = (bf16_t)(a.y >> 16);
            vd[4 * 72] = (bf16_t)(a.z & 0xffff); vd[5 * 72] = (bf16_t)(a.z >> 16); vd[6 * 72] = (bf16_t)(a.w & 0xffff); vd[7 * 72] = (bf16_t)(a.w >> 16);
            vd[8 * 72] = (bf16_t)(c.x & 0xffff); vd[9 * 72] = (bf16_t)(c.x >> 16); vd[10 * 72] = (bf16_t)(c.y & 0xffff); vd[11 * 72] = (bf16_t)(c.y >> 16);
            vd[12 * 72] = (bf16_t)(c.z & 0xffff); vd[13 * 72] = (bf16_t)(c.z >> 16); vd[14 * 72] = (bf16_t)(c.w & 0xffff); vd[15 * 72] = (bf16_t)(c.w >> 16);
        }
        if (Tn < ntot) { const size_t r0 = (Tn < nloc) ? (size_t)b * SEQ + (krU + Tn) * 64 : (size_t)NLAT + b * CTXL + (Tn - nloc) * 64;
            const bf16_t* kp = P + (r0 + pf_key) * PW + C_CK + pf_h2 * 64 + pf_seg * 16; pk0 = *(const u32x4*)kp; pk1 = *(const u32x4*)(kp + 8);
            const bf16_t* vp = P + (r0 + pf_vkey) * PW + C_CV + pf_h2 * 64 + pf_vseg * 16; pv0 = *(const u32x4*)vp; pv1 = *(const u32x4*)(vp + 8); }
        __syncthreads();
#pragma unroll
        for (int qi = 0; qi < 2; ++qi) {
            if (loc && (kr < kq0[qi] || kr >= kq0[qi] + 8)) continue;
            f32x4 st[4];
#pragma unroll
            for (int g = 0; g < 4; ++g) { const bool use = !loc || (g >= glo && g <= ghi);
                st[g] = (f32x4){0.f, 0.f, 0.f, 0.f};
                if (use) {
#pragma unroll
                    for (int ks = 0; ks < 2; ++ks) st[g] = mfma16(*(const LAS bf16x8*)(Kt + (hh * 64 + g * 16 + l16) * 72 + ks * 32 + q4 * 8), loc ? qrt[qi][ks] : qpl[qi][ks], st[g]);
                    if (loc) { const int dr31 = (kr - rq[qi] + 7) * 31;
#pragma unroll
                        for (int j = 0; j < 4; ++j) { const float sv = st[g][j] + rpbL[bidx[g][j] + dr31]; st[g][j] = ((mbits >> (g * 4 + j)) & 1u) ? -1e30f : sv; } }
                } else st[g] = (f32x4){-1e30f, -1e30f, -1e30f, -1e30f};
            }
            float tmax = -1e30f;
#pragma unroll
            for (int g = 0; g < 4; ++g)
#pragma unroll
                for (int j = 0; j < 4; ++j) tmax = fmaxf(tmax, st[g][j]);
            tmax = fmaxf(tmax, __shfl_xor(tmax, 16)); tmax = fmaxf(tmax, __shfl_xor(tmax, 32));
            const float mnew = fmaxf(mrun[qi], tmax); const float alpha = __expf(mrun[qi] - mnew); mrun[qi] = mnew;
            float psum = 0.f;
#pragma unroll
            for (int g = 0; g < 4; ++g) { const bool use = !loc || (g >= glo && g <= ghi);
                if (use) {
#pragma unroll
                    for (int j = 0; j < 4; ++j) { const float pv = __expf(st[g][j] - mnew); st[g][j] = pv; psum += pv; }
                } else st[g] = (f32x4){0.f, 0.f, 0.f, 0.f}; }
            lsum[qi] = lsum[qi] * alpha + psum;
#pragma unroll
            for (int i = 0; i < 4; ++i) O[qi][i] *= alpha;
            bf16x8 pb[2];
#pragma unroll
            for (int ks = 0; ks < 2; ++ks) { u32x4 wv; wv.x = pack2(st[2 * ks][0], st[2 * ks][1]); wv.y = pack2(st[2 * ks][2], st[2 * ks][3]); wv.z = pack2(st[2 * ks + 1][0], st[2 * ks + 1][1]); wv.w = pack2(st[2 * ks + 1][2], st[2 * ks + 1][3]); pb[ks] = as_bf16x8(wv); }
#pragma unroll
            for (int ks = 0; ks < 2; ++ks) if (!loc || (2 * ks + 1 >= glo && 2 * ks <= ghi))
#pragma unroll
                for (int dg = 0; dg < 4; ++dg) { const LAS bf16_t* vr = Vt + (hh * 64 + dg * 16 + l16) * 72 + ks * 32 + q4 * 4;
                    const u32x2 lo = *(const LAS u32x2*)vr, hi = *(const LAS u32x2*)(vr + 16); u32x4 av; av.x = lo.x; av.y = lo.y; av.z = hi.x; av.w = hi.y;
                    O[qi][dg] = mfma16(as_bf16x8(av), pb[ks], O[qi][dg]); }
        }
        __syncthreads();
    }
    }
#pragma unroll
    for (int qi = 0; qi < 2; ++qi) {
        float ls = lsum[qi]; ls += __shfl_xor(ls, 16); ls += __shfl_xor(ls, 32);
        const float inv = 1.0f / ls;
        bf16_t* op = dry ? ((bf16_t*)(PF(ws) + WS_DUMMY) + (size_t)(blockIdx.x & 63) * 16384 + (size_t)((qi * 8 + w) * 16 + l16) * 64) : (P + (qrow0[qi] + qc) * PW + C_CQ + h * 64);
#pragma unroll
        for (int dg = 0; dg < 4; ++dg) { u32x2 wv; wv.x = pack2(O[qi][dg][0] * inv, O[qi][dg][1] * inv); wv.y = pack2(O[qi][dg][2] * inv, O[qi][dg][3] * inv); *(u32x2*)(op + dg * 16 + q4 * 4) = wv; }
    }
    __syncthreads();
}

__device__ __forceinline__ void hgrn_stage(const bf16_t* P, LAS unsigned char* lds, int w, int lane, size_t row0, int dir, int h) {
#pragma unroll
    for (int i = 0; i < 2; ++i) { const int blk = i * 8 + w; const int t = blk * 4 + (lane >> 4); const bf16_t* rp = P + (row0 + (dir ? 63 - t : t)) * PW + (lane & 15) * 8;
        __builtin_amdgcn_global_load_lds((const unsigned*)(rp + C_BQ + h * 128), (LAS unsigned*)(lds + 118784 + blk * 1024), 16, 0, 0);
        __builtin_amdgcn_global_load_lds((const unsigned*)(rp + C_BF + dir * 512 + h * 128), (LAS unsigned*)(lds + 135168 + blk * 1024), 16, 0, 0); }
}
__device__ __forceinline__ void hgrn_chain(const Params& p, int l, LAS unsigned char* lds, int chain, int dry = 0) {
    LAS bf16_t* Q0 = (LAS bf16_t*)lds;
    LAS bf16_t* KP = (LAS bf16_t*)(lds + 17408);
    LAS bf16_t* SB = (LAS bf16_t*)(lds + 34816);
    LAS bf16_t* KDT = (LAS bf16_t*)(lds + 69632);
    LAS bf16_t* VT = (LAS bf16_t*)(lds + 88064);
    LAS bf16_t* ATT = (LAS bf16_t*)(lds + 106496);
    LAS float* TOT = (LAS float*)(lds + 115712);
    LAS float* DD = (LAS float*)(lds + 117760);
    const LAS bf16_t* SQ = (const LAS bf16_t*)(lds + 118784);
    const LAS bf16_t* SF = (const LAS bf16_t*)(lds + 135168);
    bf16_t* P = (bf16_t*)(PF(ws) + WS_P);
    const int tid = tid_(), w = __builtin_amdgcn_readfirstlane(tid >> 6), lane = tid & 63, l16 = lane & 15, q4 = lane >> 4;
    const int dir = chain & 1, h = (chain >> 1) & 3, b = chain >> 3;
    const int d = tid & 127, sb = tid >> 7;
    float lbv = 0.f;
    if (l > 0) { const float x0 = PF(hg_lb)[(dir * 2 + 0) * 512 + h * 128 + d], x1 = PF(hg_lb)[(dir * 2 + 1) * 512 + h * 128 + d]; lbv = 1.0f / (1.0f + expf(x0 - x1)); }
    for (int i = tid; i < 64 * 72 / 2; i += 512) ((LAS unsigned*)ATT)[i] = 0u;
    f32x4 S[8];
#pragma unroll
    for (int i = 0; i < 8; ++i) S[i] = (f32x4){0.f, 0.f, 0.f, 0.f};
    { const int gch0 = dir == 0 ? 0 : 3; hgrn_stage(P, lds, w, lane, (size_t)NLAT + b * CTXL + gch0 * 64, dir, h); }
    asm volatile("s_waitcnt vmcnt(0)" ::: "memory");
    __syncthreads();
    for (int ci = 0; ci < 36; ++ci) {
        const int gch = dir == 0 ? ci : (ci < 4 ? 3 - ci : 39 - ci);
        const bool isctx = gch < 4; const int chunk = isctx ? gch : gch - 4;
        const size_t row0 = isctx ? (size_t)NLAT + b * CTXL + chunk * 64 : (size_t)b * SEQ + chunk * 64;
        float bl[16], qv[16], kv[16]; float run = 0.f;
        {
            unsigned vraw[16];
#pragma unroll
            for (int ii = 0; ii < 16; ++ii) { const int t = sb * 16 + ii; vraw[ii] = P[(row0 + (dir ? 63 - t : t)) * PW + C_BI + h * 128 + d]; }
#pragma unroll
            for (int eg = 0; eg < 8; ++eg) { u32x2 wv; wv.x = pack2(S[eg][0], S[eg][1]); wv.y = pack2(S[eg][2], S[eg][3]); *(LAS u32x2*)(SB + (eg * 16 + l16) * 136 + w * 16 + q4 * 4) = wv; }
#pragma unroll
            for (int ii = 0; ii < 16; ++ii) { const int t = sb * 16 + ii;
                const float fr = bf2f(SF[t * 128 + d]), qr = bf2f(SQ[t * 128 + d]);
                const float sg = 1.0f / (1.0f + __expf(-fr)); const float f = lbv + (1.0f - lbv) * sg; run += __logf(f); bl[ii] = run; kv[ii] = 1.0f - f; qv[ii] = qr / (1.0f + __expf(-qr)); }
            TOT[sb * 128 + d] = run;
            u32x4 v0, v1; v0.x = vraw[0] | (vraw[1] << 16); v0.y = vraw[2] | (vraw[3] << 16); v0.z = vraw[4] | (vraw[5] << 16); v0.w = vraw[6] | (vraw[7] << 16);
            v1.x = vraw[8] | (vraw[9] << 16); v1.y = vraw[10] | (vraw[11] << 16); v1.z = vraw[12] | (vraw[13] << 16); v1.w = vraw[14] | (vraw[15] << 16);
            *(LAS u32x4*)(VT + d * 72 + sb * 16) = v0; *(LAS u32x4*)(VT + d * 72 + sb * 16 + 8) = v1;
        }
        __syncthreads();
        if (ci < 35) { const int cn = ci + 1; const int gn = dir == 0 ? cn : (cn < 4 ? 3 - cn : 39 - cn); const bool cx = gn < 4; const int ck = cx ? gn : gn - 4;
            hgrn_stage(P, lds, w, lane, cx ? (size_t)NLAT + b * CTXL + ck * 64 : (size_t)b * SEQ + ck * 64, dir, h); }
        {
            const float t0 = TOT[d], t1 = TOT[128 + d], t2 = TOT[256 + d], t3 = TOT[384 + d];
            const float Bs1 = t0, Bs2 = t0 + t1, Bs3 = Bs2 + t2, total = Bs3 + t3;
            const float Bsb = sb == 0 ? 0.f : (sb == 1 ? Bs1 : (sb == 2 ? Bs2 : Bs3));
            const float eB = __expf(Bsb), eT = __expf(total);
            float kd[16];
#pragma unroll
            for (int ii = 0; ii < 16; ++ii) { const float e0 = __expf(bl[ii]); Q0[(sb * 16 + ii) * 136 + d] = (bf16_t)pack2(qv[ii] * e0 * eB, 0.f);
                const float kp = kv[ii] * __expf(fminf(-(Bsb + bl[ii]), 80.f)); KP[(sb * 16 + ii) * 136 + d] = (bf16_t)pack2(kp, 0.f); kd[ii] = kp * eT; }
            *(LAS u32x4*)(KDT + d * 72 + sb * 16) = pack8(kd); *(LAS u32x4*)(KDT + d * 72 + sb * 16 + 8) = pack8(kd + 8);
            if (sb == 0) DD[d] = eT;
        }
        __syncthreads();
#pragma unroll
        for (int k2 = 0; k2 < 2; ++k2) { const int idx = w + 8 * k2;
            if (idx < 10) { const int i = idx < 1 ? 0 : (idx < 3 ? 1 : (idx < 6 ? 2 : 3)); const int j = idx - i * (i + 1) / 2;
                f32x4 sc = (f32x4){0.f, 0.f, 0.f, 0.f};
                const LAS bf16_t* qb = Q0 + (i * 16 + l16) * 136 + q4 * 8; const LAS bf16_t* kb = KP + (j * 16 + l16) * 136 + q4 * 8;
#pragma unroll
                for (int ks = 0; ks < 4; ++ks) sc = mfma16(*(const LAS bf16x8*)(qb + ks * 32), *(const LAS bf16x8*)(kb + ks * 32), sc);
#pragma unroll
                for (int jj = 0; jj < 4; ++jj) { const float v = (i == j && l16 > q4 * 4 + jj) ? 0.f : sc[jj]; ATT[(i * 16 + q4 * 4 + jj) * 72 + j * 16 + l16] = (bf16_t)pack2(v, 0.f); } } }
        __syncthreads();
        {
            bf16x8 SBf[4], VTf[2];
#pragma unroll
            for (int ks = 0; ks < 4; ++ks) SBf[ks] = *(const LAS bf16x8*)(SB + (w * 16 + l16) * 136 + ks * 32 + q4 * 8);
#pragma unroll
            for (int ks = 0; ks < 2; ++ks) VTf[ks] = *(const LAS bf16x8*)(VT + (w * 16 + l16) * 72 + ks * 32 + q4 * 8);
#pragma unroll
            for (int i = 0; i < 4; ++i) { f32x4 oa = (f32x4){0.f, 0.f, 0.f, 0.f};
#pragma unroll
                for (int ks = 0; ks < 4; ++ks) oa = mfma16(SBf[ks], *(const LAS bf16x8*)(Q0 + (i * 16 + l16) * 136 + ks * 32 + q4 * 8), oa);
#pragma unroll
                for (int ks = 0; ks < 2; ++ks) oa = mfma16(VTf[ks], *(const LAS bf16x8*)(ATT + (i * 16 + l16) * 72 + ks * 32 + q4 * 8), oa);
                const int t = i * 16 + l16; u32x2 wv; wv.x = pack2(oa[0], oa[1]); wv.y = pack2(oa[2], oa[3]);
                bf16_t* od = dry ? ((bf16_t*)(PF(ws) + WS_DUMMY) + (size_t)chain * 8192 + t * 128 + w * 16 + q4 * 4) : (P + (row0 + (dir ? 63 - t : t)) * PW + C_BF + dir * 512 + h * 128 + w * 16 + q4 * 4);
                *(u32x2*)od = wv; }
        }
        {
            const f32x4 dd = *(const LAS f32x4*)(DD + w * 16 + q4 * 4);
#pragma unroll
            for (int eg = 0; eg < 8; ++eg) S[eg] *= dd;
#pragma unroll
            for (int ks = 0; ks < 2; ++ks) { const bf16x8 A = *(const LAS bf16x8*)(KDT + (w * 16 + l16) * 72 + ks * 32 + q4 * 8);
#pragma unroll
                for (int eg = 0; eg < 8; ++eg) S[eg] = mfma16(A, *(const LAS bf16x8*)(VT + (eg * 16 + l16) * 72 + ks * 32 + q4 * 8), S[eg]); }
        }
        asm volatile("s_waitcnt vmcnt(0)" ::: "memory");
        __syncthreads();
    }
}

__global__ void __launch_bounds__(512, 2) fwd_megakernel(Params p) {
    extern __shared__ __attribute__((aligned(16))) unsigned char lds_raw[];
    LAS unsigned char* lds = (LAS unsigned char*)lds_raw;
    cg::grid_group grid = cg::this_grid();
    volatile LAS unsigned* xst = (volatile LAS unsigned*)(lds + LDS_BYTES - 16);
    if (threadIdx.x == 0) { xst[0] = 0u; xst[1] = 0u; xst[2] = 0u; xst[3] = 0u; }
    __syncthreads();
    const XcdBarrier xbar = xcd_barrier_post((unsigned*)(PF(ws) + WS_BAR), xst);
    const int G = gridDim.x, c = blockIdx.x;

    phase_mod(p, lds); __syncthreads();
    phase_rope(p);
    phase_convert(p, 0, lds);
    grid.sync();
#define WSP(T, off) ((T*)(PF(ws) + (off)))
    for (int l = 0; l < 2; ++l) {
        const bool lastl = (l == 1);
        const int Mrest = lastl ? NLAT : NTOK;
        if (l > 0) phase_convert(p, l, lds);
        phase_norm(p, l, l == 0 ? PF(x) : PF(out), l == 0 ? PF(ctx) : WSP(const float, WS_HC), PF(norm1_g) + l * DM, 0, NTOK,
                   (l > 0 && G == 256) ? (const float*)(PF(ws) + WS_P + (size_t)NTOK * DFF * 2) : nullptr, WSP(const float, WS_MOD) + (size_t)((l > 0 ? l - 1 : 0) * 9 + 8) * 6144 + 5120);
        xcd_barrier(xbar);

        { pg8::Gemm g{WSP(bf16_t, WS_U), WSP(bf16_t, WS_WIN), DM, DM, DM}; pg8::Sched S; S.init(NTOK, PW, G, c, DM, DM); pg8::EpiStore<0> E{WSP(bf16_t, WS_P), PW}; pg8::gemm_phase(lds, g, S, E); }
        xcd_barrier(xbar);
        if (c < 64) { hgrn_chain(p, l, lds, c); sub_barrier((unsigned*)(PF(ws) + WS_BAR) + 3520 + 64 * (2 * l), 64u); phase_hg_final(p, l, NTOK, c, 64); }
        else { const int cc = c - 64, GG = G - 64; const int nA = lastl ? 512 : 576;
            for (int it = cc; it < nA; it += GG) attn_item(p, l, lds, it);
            int staged = -1;
            for (int it = cc; it < 2304; it += GG) lru_tile(p, l, lds, it, 0, staged);
            sub_barrier((unsigned*)(PF(ws) + WS_BAR) + 3520 + 64 * (2 * l + 1), (unsigned)GG);
            for (int it = cc; it < 2304; it += GG) lru_tile(p, l, lds, it, 1, staged); }
        xcd_barrier(xbar);
        { pg8::Gemm g{WSP(bf16_t, WS_U), WSP(bf16_t, WS_WIN) + (size_t)PW * DM, DM, DM, DM}; pg8::Sched S; S.init(Mrest, 3072, G, c, DM, DM); pg8::EpiStore<1> E{WSP(bf16_t, WS_P), PW}; pg8::gemm_phase(lds, g, S, E); }
        xcd_barrier(xbar);
        { pg8::Gemm g{WSP(bf16_t, WS_P), WSP(bf16_t, WS_WB), PW, 512, 512}; pg8::MergeSched S; S.base.init(Mrest, DM, G, c, PW, 512);
          pg8::EpiMerge E{WSP(bf16_t, WS_P), WSP(bf16_t, WS_U)}; pg8::gemm_phase(lds, g, S, E); }
        xcd_barrier(xbar);
        { pg8::Gemm g{WSP(bf16_t, WS_U), WSP(bf16_t, WS_WO), DM, DM, DM};
          pg8::EpiResid E{l == 0 ? PF(x) : PF(out), l == 0 ? PF(ctx) : WSP(const float, WS_HC), PF(out), WSP(float, WS_HC), WSP(const float, WS_MOD) + (size_t)l * 9 * 6144 + 2048, WSP(float, WS_P)};
          if (!lastl && G == 256) { pg8::SplitSched S; S.base.init(NLAT, DM, G, c, DM, DM); S.sk = 256; pg8::gemm_phase(lds, g, S, E); }
          else { pg8::Sched S; S.init(Mrest, DM, G, c, DM, DM); pg8::gemm_phase(lds, g, S, E); } }
        xcd_barrier(xbar);
        if (!lastl && G == 256) phase_norm(p, l, PF(out), l == 0 ? PF(ctx) : WSP(const float, WS_HC), PF(norm2_g) + l * DM, 3072, Mrest, WSP(const float, WS_P), WSP(const float, WS_MOD) + (size_t)(l * 9 + 8) * 6144 + 2048, WSP(float, WS_HC));
        else phase_norm(p, l, PF(out), WSP(const float, WS_HC), PF(norm2_g) + l * DM, 3072, Mrest);
        xcd_barrier(xbar);
        { pg8::Gemm g{WSP(bf16_t, WS_U), WSP(bf16_t, WS_W1), DM, DM, DM}; pg8::Sched S; S.init(Mrest, DFF, G, c, DM, DM); pg8::EpiStore<2> E{WSP(bf16_t, WS_P), DFF}; pg8::gemm_phase(lds, g, S, E); }
        xcd_barrier(xbar);
        { pg8::Gemm g{WSP(bf16_t, WS_P), WSP(bf16_t, WS_W2), DFF, DFF, DFF};
          float* slab = (float*)(PF(ws) + WS_P + (size_t)NTOK * DFF * 2);
          pg8::EpiResid E{PF(out), WSP(const float, WS_HC), PF(out), WSP(float, WS_HC), WSP(const float, WS_MOD) + (size_t)l * 9 * 6144 + 5120, slab};
          if (!lastl && G == 256) { pg8::SplitSched S; S.base.init(NLAT, DM, G, c, DFF, DFF); S.sk = 1024; pg8::gemm_phase(lds, g, S, E); }
          else { pg8::Sched S; S.init(Mrest, DM, G, c, DFF, DFF); pg8::gemm_phase(lds, g, S, E); } }
        if (!lastl) xcd_barrier(xbar);
    }
}

extern "C" void kernel_launch(void* const* d_in, const int* in_sizes, int n_in, void* d_out, int out_size, void* d_ws, size_t ws_size, hipStream_t stream) {
    static int grid_blocks = 0;
    if (grid_blocks == 0) {
        int dev = 0, cus = 0, per_cu = 0;
        hipGetDevice(&dev);
        hipDeviceGetAttribute(&cus, hipDeviceAttributeMultiprocessorCount, dev);
        hipFuncSetAttribute((const void*)fwd_megakernel, hipFuncAttributeMaxDynamicSharedMemorySize, LDS_BYTES);
        hipOccupancyMaxActiveBlocksPerMultiprocessor(&per_cu, (const void*)fwd_megakernel, 512, LDS_BYTES);
        if (per_cu < 1 || n_in != 25 || ws_size < WS_END) { fprintf(stderr, "kernel_launch: cannot launch (per_cu %d, n_in %d, ws %zu need %zu)\n", per_cu, n_in, ws_size, (size_t)WS_END); grid_blocks = -1; }
        else grid_blocks = cus;
    }
    if (grid_blocks < 0) return;
    hipMemsetAsync((char*)d_ws + WS_BAR, 0, 16384, stream);
    Params p{};
    const float** pp = (const float**)&p;
    for (int i = 0; i < 25; ++i) pp[i] = (const float*)d_in[i];
    p.out = (float*)d_out; p.ws = (unsigned char*)d_ws;
    void* args[] = {&p};
    hipError_t e = hipLaunchCooperativeKernel((const void*)fwd_megakernel, dim3(grid_blocks), dim3(512), args, LDS_BYTES, stream);
    if (e != hipSuccess) fprintf(stderr, "cooperative launch failed: %s (grid %d)\n", hipGetErrorString(e), grid_blocks);
}
```

```cpp
#include <hip/hip_runtime.h>
#include <hip/hip_cooperative_groups.h>
#include <stdint.h>
#include <stdio.h>
namespace cg = cooperative_groups;

#define LAS __attribute__((address_space(3)))
typedef unsigned short bf16_t;
typedef short bf16x8 __attribute__((ext_vector_type(8)));
typedef float f32x4 __attribute__((ext_vector_type(4)));
typedef unsigned u32x4 __attribute__((ext_vector_type(4)));
typedef unsigned u32x2 __attribute__((ext_vector_type(2)));

constexpr int DM = 1024, NB = 8, SEQ = 2048, CTXL = 256, NLAT = NB * SEQ, NCTX = NB * CTXL, NTOK = NLAT + NCTX;
constexpr int PW = 5120, DIN = 8192, DFF = 4096;
constexpr int C_AX = 0, C_AG = 512, C_BQ = 1024, C_BF = 1536, C_BI = 2560, C_BO = 3072, C_CQ = 3584, C_CK = 4096, C_CV = 4608;
constexpr int LDS_BYTES = 163840;
constexpr size_t WS_WIN = 0;
constexpr size_t WS_WB = WS_WIN + (size_t)DIN * DM * 2;
constexpr size_t WS_WO = WS_WB + (size_t)3 * DM * 512 * 2;
constexpr size_t WS_W1 = WS_WO + (size_t)DM * DM * 2;
constexpr size_t WS_W2 = WS_W1 + (size_t)DFF * DM * 2;
constexpr size_t WS_U = WS_W2 + (size_t)DM * DFF * 2;
constexpr size_t WS_P = WS_U + (size_t)NTOK * DM * 2;
constexpr size_t WS_HC = WS_P + (size_t)NTOK * PW * 2;
constexpr size_t WS_MOD = WS_HC + (size_t)NCTX * DM * 4;
constexpr size_t WS_AGG = WS_MOD + (size_t)2 * 9 * 6144 * 4;
constexpr size_t WS_ROPE = WS_AGG + (size_t)NB * 36 * 2 * 2 * 512 * 4;
constexpr size_t WS_DUMMY = WS_ROPE + 2048 * 4;
constexpr size_t WS_BAR = WS_DUMMY + (2u << 20);
constexpr size_t WS_END = WS_BAR + 16384;

struct Params {
    const float *x, *c, *ctx, *c_ctx, *ada_w, *ada_b, *norm1_g, *norm2_g, *w_in, *conv_w, *conv_b, *lru_wa, *lru_ba, *lru_wx, *lru_bx, *lru_lambda,
        *hg_lb, *hg_norm_g, *na_qg, *na_kg, *na_rpb, *w_branch, *w_out, *ffn_w1, *ffn_w2;
    float* out; unsigned char* ws;
};


__device__ __forceinline__ unsigned long long ldkarg(int off) { unsigned long long v = 0;
#if defined(__HIP_DEVICE_COMPILE__)
    auto kp = __builtin_amdgcn_kernarg_segment_ptr();
    asm volatile("s_load_dwordx2 %0, %1, %2\n\ts_waitcnt lgkmcnt(0)" : "=s"(v) : "s"(kp), "s"(off));
#endif
    return v; }
template <class T> struct rm_ptr; template <class T> struct rm_ptr<T*> { typedef T type; };
template <class T> __device__ __forceinline__ T* as_global_ptr(unsigned long long v) { return (T*)(__attribute__((address_space(1))) T*)v; }
#define PF(f) (as_global_ptr<rm_ptr<decltype(Params::f)>::type>(ldkarg((int)__builtin_offsetof(Params, f))))

#define GAS __attribute__((address_space(1)))
template <class T> __device__ __forceinline__ GAS T* lnd(T* p) { asm volatile("" : "+v"(p)); return (GAS T*)p; }
__device__ __forceinline__ int tid_() { int t = threadIdx.x; asm volatile("" : "+v"(t)); return t; }
__device__ __forceinline__ float bf2f(unsigned v) { return __uint_as_float(v << 16); }
__device__ __forceinline__ float bflo(unsigned w) { return __uint_as_float(w << 16); }
__device__ __forceinline__ float bfhi(unsigned w) { return __uint_as_float(w & 0xffff0000u); }
__device__ __forceinline__ unsigned f2bf(float f) { unsigned u = __float_as_uint(f); u += 0x7fffu + ((u >> 16) & 1u); return u >> 16; }
typedef __bf16 bf16x2_t __attribute__((ext_vector_type(2)));
typedef float f32x2_t __attribute__((ext_vector_type(2)));
__device__ __forceinline__ unsigned pack2(float lo, float hi) { f32x2_t v = {lo, hi}; bf16x2_t b = __builtin_convertvector(v, bf16x2_t); union { bf16x2_t b; unsigned u; } t; t.b = b; return t.u; }
__device__ __forceinline__ float sigmoidf_(float x) { return 1.0f / (1.0f + __expf(-x)); }
__device__ __forceinline__ f32x4 mfma16(bf16x8 a, bf16x8 b, f32x4 c) { return __builtin_amdgcn_mfma_f32_16x16x32_bf16(a, b, c, 0, 0, 0); }
__device__ __forceinline__ bf16x8 as_bf16x8(u32x4 v) { union { u32x4 u; bf16x8 b; } t; t.u = v; return t.b; }
__device__ __forceinline__ void unpack8(u32x4 w, float* o) { o[0] = bflo(w.x); o[1] = bfhi(w.x); o[2] = bflo(w.y); o[3] = bfhi(w.y); o[4] = bflo(w.z); o[5] = bfhi(w.z); o[6] = bflo(w.w); o[7] = bfhi(w.w); }
__device__ __forceinline__ u32x4 pack8(const float* v) { u32x4 w; w.x = pack2(v[0], v[1]); w.y = pack2(v[2], v[3]); w.z = pack2(v[4], v[5]); w.w = pack2(v[6], v[7]); return w; }

namespace pg8 {
constexpr int BM = 256, BK = 64, HALF = 128, HTB = HALF * BK * 2, NXCD = 8, WGM = 4;
__device__ __forceinline__ int lds_byte(int r, int c) { const int st = (r >> 4) * 2 + (c >> 5), rr = r & 15, cc = c & 31, ob = rr * 64 + cc * 2; return st * 1024 + (ob ^ (((ob >> 9) & 1) << 5)); }
__device__ __forceinline__ void stage_rc(int b, int& R, int& C) { const int st = b / 1024, sb = b % 1024, swz = sb ^ (((sb >> 9) & 1) << 5); R = (st >> 1) * 16 + swz / 64; C = (st & 1) * 32 + (swz % 64) / 2; }
__device__ __forceinline__ int perm32(int rho) { const int n = rho >> 4, i = rho & 15; return 8 * (i >> 2) + 4 * n + (i & 3); }

struct Unit { int pm, pn, sub, nt; size_t aoff, boff; };
struct Gemm { const bf16_t* A; const bf16_t* Bt; int lda, ldb, K; };
struct Sched {
    int nM, nN, nwg, G, c, lda, ldb, nt;
    __device__ void init(int M, int N, int G_, int c_, int lda_, int ldb_) { nM = M / BM; nN = N / BM; nwg = nM * nN; G = G_; c = c_; lda = lda_; ldb = ldb_; nt = 0; }
    __device__ bool next(int i, Unit& u) const {
        const long L = (long)i * G + c; if (L >= nwg) return false;
        int wgid = (int)L; { const int q = nwg / NXCD, r = nwg % NXCD, xcd = wgid % NXCD, off = wgid / NXCD; wgid = (xcd < r ? xcd * (q + 1) : r * (q + 1) + (xcd - r) * q) + off; }
        const int nig = WGM * nN, gid = wgid / nig, fm = gid * WGM, gsz = (nM - fm) < WGM ? (nM - fm) : WGM;
        u.pm = fm + ((wgid % nig) % gsz); u.pn = (wgid % nig) / gsz; u.sub = 0; u.nt = nt;
        u.aoff = (size_t)u.pm * BM * lda * 2;
        u.boff = (size_t)u.pn * BM * ldb * 2;
        return true;
    }
};

template <int ACT> struct EpiStore {
    static constexpr bool PERM = true;
    bf16_t* O; int ldc;
    __device__ __forceinline__ void operator()(const f32x4 (&acc)[2][2][4][2], const Unit& u, int wr, int wc, int fr, int fq) const {
        const int row0 = u.pm * BM + wr * 64 + fr; int colt = u.pn * BM;
        if (ACT == 1) colt = (colt < 2048) ? (1024 + colt) : (2048 + colt);
        const int col0 = colt + wc * 32 + 8 * fq;
#pragma unroll
        for (int ai = 0; ai < 2; ++ai)
#pragma unroll
            for (int m = 0; m < 4; ++m) { GAS bf16_t* rowp = lnd(O + (size_t)(row0 + ai * HALF + m * 16) * ldc + col0);
#pragma unroll
                for (int bj = 0; bj < 2; ++bj) { f32x4 v0 = acc[ai][bj][m][0], v1 = acc[ai][bj][m][1];
                    if (ACT == 1) {
#pragma unroll
                        for (int j = 0; j < 4; ++j) { v0[j] = sigmoidf_(v0[j]); v1[j] = sigmoidf_(v1[j]); } }
                    if (ACT == 2) {
#pragma unroll
                        for (int j = 0; j < 4; ++j) { float a = fmaxf(v0[j], 0.f), b = fmaxf(v1[j], 0.f); v0[j] = a * a; v1[j] = b * b; } }
                    u32x4 w; w.x = pack2(v0[0], v0[1]); w.y = pack2(v0[2], v0[3]); w.z = pack2(v1[0], v1[1]); w.w = pack2(v1[2], v1[3]);
                    *(GAS u32x4*)(rowp + bj * HALF) = w; } }
    }
};
struct EpiMerge {
    static constexpr bool PERM = true;
    const bf16_t* P; bf16_t* U;
    __device__ __forceinline__ void operator()(const f32x4 (&acc)[2][2][4][2], const Unit& u, int wr, int wc, int fr, int fq) const {
        const int row0 = u.pm * BM + wr * 64 + fr; const int col0 = u.pn * BM + wc * 32 + 8 * fq;
        const int sub = u.sub; const int gcol = sub * 1024 + u.pn * BM; const int gd = ((gcol < 2048) ? (1024 + gcol) : (2048 + gcol)) + wc * 32 + 8 * fq;
        const bool addp = sub > 0;
#pragma unroll
        for (int ai = 0; ai < 2; ++ai)
#pragma unroll
            for (int m = 0; m < 4; ++m) { const size_t row = (size_t)(row0 + ai * HALF + m * 16); const GAS bf16_t* gp = lnd(P + row * PW + gd); GAS bf16_t* up = lnd(U + row * DM + col0);
#pragma unroll
                for (int bj = 0; bj < 2; ++bj) { const u32x4 gw = *(const GAS u32x4*)(gp + bj * HALF);
                    f32x4 a0 = acc[ai][bj][m][0], a1 = acc[ai][bj][m][1];
                    a0[0] *= bflo(gw.x); a0[1] *= bfhi(gw.x); a0[2] *= bflo(gw.y); a0[3] *= bfhi(gw.y); a1[0] *= bflo(gw.z); a1[1] *= bfhi(gw.z); a1[2] *= bflo(gw.w); a1[3] *= bfhi(gw.w);
                    if (addp) { const u32x4 pw = *(const GAS u32x4*)(up + bj * HALF);
                        a0[0] += bflo(pw.x); a0[1] += bfhi(pw.x); a0[2] += bflo(pw.y); a0[3] += bfhi(pw.y); a1[0] += bflo(pw.z); a1[1] += bfhi(pw.z); a1[2] += bflo(pw.w); a1[3] += bfhi(pw.w); }
                    u32x4 o; o.x = pack2(a0[0], a0[1]); o.y = pack2(a0[2], a0[3]); o.z = pack2(a1[0], a1[1]); o.w = pack2(a1[2], a1[3]);
                    *(GAS u32x4*)(up + bj * HALF) = o; } }
    }
};
struct EpiResid {
    static constexpr bool PERM = true;
    const float* inL; const float* inC; float* outL; float* outC; const float* mod;
    float* slab;
    __device__ __forceinline__ void operator()(const f32x4 (&acc)[2][2][4][2], const Unit& u, int wr, int wc, int fr, int fq) const {
        if (u.sub >= 1) {
            const int row0 = (u.pm - 64) * BM + wr * 64 + fr, col0 = u.pn * BM + wc * 32 + 8 * fq; float* sl = slab + (size_t)(u.sub - 1) * NCTX * DM;
#pragma unroll
            for (int ai = 0; ai < 2; ++ai)
#pragma unroll
                for (int m = 0; m < 4; ++m)
#pragma unroll
                    for (int bj = 0; bj < 2; ++bj) { GAS float* op = lnd(sl + (size_t)(row0 + ai * HALF + m * 16) * DM + col0 + bj * HALF); *(GAS f32x4*)op = acc[ai][bj][m][0]; *(GAS f32x4*)(op + 4) = acc[ai][bj][m][1]; }
            return;
        }
        const bool lat = u.pm < 64; const int rbase = lat ? u.pm * BM : (u.pm - 64) * BM;
        const float* in = lat ? inL : inC; float* out = lat ? outL : outC;
        const int row0 = rbase + wr * 64 + fr, col0 = u.pn * BM + wc * 32 + 8 * fq;
        const float* gt = mod + (size_t)(lat ? (u.pm >> 3) : 8) * 6144 + col0;
#pragma unroll
        for (int bj = 0; bj < 2; ++bj) { const f32x4 g0 = *(const f32x4*)(gt + bj * HALF), g1 = *(const f32x4*)(gt + bj * HALF + 4);
#pragma unroll
            for (int ai = 0; ai < 2; ++ai)
#pragma unroll
                for (int m = 0; m < 4; ++m) { const size_t ro = (size_t)(row0 + ai * HALF + m * 16) * DM + col0 + bj * HALF;
                    const GAS float* ip = lnd(in + ro); GAS float* op = lnd(out + ro); const f32x4 i0 = *(const GAS f32x4*)ip, i1 = *(const GAS f32x4*)(ip + 4);
                    *(GAS f32x4*)op = i0 + g0 * acc[ai][bj][m][0]; *(GAS f32x4*)(op + 4) = i1 + g1 * acc[ai][bj][m][1]; } }
    }
};

struct MergeSched {
    Sched base;
    __device__ bool next(int i, Unit& u) const {
        const int r = i / 3, n = i - 3 * r;
        if (!base.next(r, u)) return false;
        u.sub = n; u.aoff += (size_t)(n == 0 ? C_AG : C_BO + (n - 1) * 512) * 2; u.boff += (size_t)n * DM * 512 * 2;
        return true;
    }
};
struct SplitSched {
    Sched base;
    int sk;
    __device__ bool next(int i, Unit& u) const {
        if (base.next(i, u)) return true;
        const int nfull = (base.nwg - base.c + base.G - 1) / base.G;
        const int k = i - nfull; const int un = k * base.G + base.c; if (k < 0 || un >= 128) return false;
        const int ct = un >> 2, sl = un & 3; u.pm = 64 + (ct >> 2); u.pn = ct & 3; u.sub = 1 + sl; u.nt = sk / BK;
        u.aoff = (size_t)u.pm * BM * base.lda * 2 + (size_t)sl * sk * 2; u.boff = (size_t)u.pn * BM * base.ldb * 2 + (size_t)sl * sk * 2;
        return true;
    }
};
template <class Epi, class Sch>
__device__ __forceinline__ void gemm_phase(LAS unsigned char* lds, const Gemm g, const Sch& S, const Epi& E) {
    const int tid = tid_(), wid = __builtin_amdgcn_readfirstlane(tid >> 6), lane = tid & 63, wr = wid >> 2, wc = wid & 3, fr = lane & 15, fq = lane >> 4;
    const int K = g.K;
    unsigned voffA[2], voffB[2];
#pragma unroll
    for (int i = 0; i < 2; ++i) { int R, C; stage_rc(tid * 16 + i * 8192, R, C); const int Rb = Epi::PERM ? ((R & ~31) + perm32(R & 31)) : R;
        voffA[i] = (unsigned)(R * g.lda + C) * 2u; voffB[i] = (unsigned)(Rb * g.ldb + C) * 2u; }
    const size_t kstep = (size_t)(BK * 2);
    const size_t hstepA = (size_t)HALF * g.lda * 2, hstepB = (size_t)HALF * g.ldb * 2;
    const unsigned ldsw = (unsigned)wid * 1024u;
    const int aoff = lds_byte(wr * 64 + fr, fq * 8), boff = lds_byte(wc * 32 + fr, fq * 8);
#define PG8_SA(b, h) (((b) * 2 + (h)) * HTB)
#define PG8_SB(b, h) ((4 + (b) * 2 + (h)) * HTB)
#define PG8_STAGE(bufoff, gbase, voff) do { _Pragma("unroll") for (int _i = 0; _i < 2; ++_i) \
        __builtin_amdgcn_global_load_lds((const unsigned*)((const char*)(gbase) + (voff)[_i]), (LAS unsigned*)(lds + (bufoff) + ldsw + _i * 8192), 16, 0, 0); } while (0)
#define PG8_LDA(dst, b, h) do { _Pragma("unroll") for (int m = 0; m < 4; ++m) _Pragma("unroll") for (int k = 0; k < 2; ++k) dst[m][k] = *(const LAS bf16x8*)(lds + PG8_SA(b, h) + aoff + m * 2048 + k * 1024); } while (0)
#define PG8_LDB(dst, b, h) do { _Pragma("unroll") for (int n = 0; n < 2; ++n) _Pragma("unroll") for (int k = 0; k < 2; ++k) dst[n][k] = *(const LAS bf16x8*)(lds + PG8_SB(b, h) + boff + n * 2048 + k * 1024); } while (0)
#define PG8_MMA(ai, bj, At, Bt) do { __builtin_amdgcn_s_setprio(1); _Pragma("unroll") for (int m = 0; m < 4; ++m) _Pragma("unroll") for (int n = 0; n < 2; ++n) _Pragma("unroll") for (int k = 0; k < 2; ++k) \
        acc[ai][bj][m][n] = __builtin_amdgcn_mfma_f32_16x16x32_bf16(Bt[n][k], At[m][k], acc[ai][bj][m][n], 0, 0, 0); __builtin_amdgcn_s_setprio(0); } while (0)
#define PG8_WAIT_V(n) asm volatile("s_waitcnt vmcnt(" #n ")" ::: "memory")
#define PG8_WAIT_L(n) asm volatile("s_waitcnt lgkmcnt(" #n ")" ::: "memory")
#define PG8_BAR __builtin_amdgcn_s_barrier()
#define PG8_SCHED __builtin_amdgcn_sched_barrier(0)
    Unit cur, nxt; int ui = 0;
    if (!S.next(0, cur)) return;
    f32x4 acc[2][2][4][2];
#pragma unroll
    for (int a = 0; a < 2; ++a)
#pragma unroll
        for (int b = 0; b < 2; ++b)
#pragma unroll
            for (int m = 0; m < 4; ++m)
#pragma unroll
                for (int n = 0; n < 2; ++n) acc[a][b][m][n] = (f32x4){0.f, 0.f, 0.f, 0.f};
    bf16x8 At[4][2], B0[2][2], B1[2][2];
    const char* cA = (const char*)g.A + cur.aoff; const char* cB = (const char*)g.Bt + cur.boff;
    PG8_STAGE(PG8_SB(0, 0), cB, voffB); PG8_STAGE(PG8_SA(0, 0), cA, voffA); PG8_STAGE(PG8_SB(0, 1), cB + hstepB, voffB); PG8_STAGE(PG8_SA(0, 1), cA + hstepA, voffA);
    if (wr == 1) PG8_BAR;
    PG8_WAIT_V(4); PG8_BAR;
    PG8_STAGE(PG8_SB(1, 0), cB + kstep, voffB); PG8_STAGE(PG8_SA(1, 0), cA + kstep, voffA); PG8_STAGE(PG8_SB(1, 1), cB + hstepB + kstep, voffB);
    PG8_WAIT_V(6); PG8_BAR;
    for (;;) {
        const bool has_next = S.next(ui + 1, nxt);
        const char* nA = has_next ? (const char*)g.A + nxt.aoff : cA; const char* nB = has_next ? (const char*)g.Bt + nxt.boff : cB;
        const int nt = cur.nt ? cur.nt : K / BK;
        for (int t = 0; t < nt; t += 2) {
            const bool last = (t == nt - 2);
            const char* a1 = cA + (size_t)(t + 1) * kstep;
            const char* a2 = last ? nA : cA + (size_t)(t + 2) * kstep; const char* b2 = last ? nB : cB + (size_t)(t + 2) * kstep;
            const char* a3 = a2 + kstep; const char* b3 = b2 + kstep;
            PG8_LDB(B0, 0, 0); PG8_SCHED; PG8_LDA(At, 0, 0); PG8_STAGE(PG8_SA(1, 1), a1 + hstepA, voffA);
            PG8_WAIT_L(8); PG8_BAR; PG8_WAIT_L(0); PG8_MMA(0, 0, At, B0); PG8_BAR; PG8_SCHED;
            PG8_LDB(B1, 0, 1); PG8_STAGE(PG8_SB(0, 0), b2, voffB);
            PG8_BAR; PG8_WAIT_L(0); PG8_MMA(0, 1, At, B1); PG8_BAR;
            PG8_LDA(At, 0, 1); PG8_STAGE(PG8_SA(0, 0), a2, voffA);
            PG8_BAR; PG8_WAIT_L(0); PG8_MMA(1, 0, At, B0); PG8_BAR; PG8_SCHED;
            PG8_STAGE(PG8_SB(0, 1), b2 + hstepB, voffB);
            PG8_WAIT_V(6); PG8_BAR; PG8_MMA(1, 1, At, B1); PG8_BAR;
            PG8_LDB(B0, 1, 0); PG8_SCHED; PG8_LDA(At, 1, 0); PG8_STAGE(PG8_SA(0, 1), a2 + hstepA, voffA);
            PG8_WAIT_L(8); PG8_BAR; PG8_WAIT_L(0); PG8_MMA(0, 0, At, B0); PG8_BAR; PG8_SCHED;
            PG8_LDB(B1, 1, 1); PG8_STAGE(PG8_SB(1, 0), b3, voffB);
            PG8_BAR; PG8_WAIT_L(0); PG8_MMA(0, 1, At, B1); PG8_BAR;
            PG8_LDA(At, 1, 1); PG8_STAGE(PG8_SA(1, 0), a3, voffA);
            PG8_BAR; PG8_WAIT_L(0); PG8_MMA(1, 0, At, B0); PG8_BAR; PG8_SCHED;
            PG8_STAGE(PG8_SB(1, 1), b3 + hstepB, voffB);
            PG8_WAIT_V(6); PG8_BAR; PG8_MMA(1, 1, At, B1); PG8_BAR;
        }
        E(acc, cur, wr, wc, fr, fq);
        if (!has_next) break;
#pragma unroll
        for (int a = 0; a < 2; ++a)
#pragma unroll
            for (int b = 0; b < 2; ++b)
#pragma unroll
                for (int m = 0; m < 4; ++m)
#pragma unroll
                    for (int n = 0; n < 2; ++n) acc[a][b][m][n] = (f32x4){0.f, 0.f, 0.f, 0.f};
        cur = nxt; cA = nA; cB = nB; ++ui;
    }
    PG8_WAIT_V(0);
    if (wr == 0) PG8_BAR;
    PG8_BAR;
#undef PG8_SA
#undef PG8_SB
#undef PG8_STAGE
#undef PG8_LDA
#undef PG8_LDB
#undef PG8_MMA
#undef PG8_WAIT_V
#undef PG8_WAIT_L
#undef PG8_BAR
#undef PG8_SCHED
}
}


#define XB_TMO      128
#define XB_XCNT(j)  (256  + 64 * (j))
#define XB_XSUB(j)  (1280 + 64 * (j))
#define XB_XGEN(j)  (2304 + 64 * (j))
#define XB_TOP      3328
#define XB_TOPGEN   3392
#define XCD_BAR_WORDS 3456
#define XB_SPIN_CAP (1u << 20)
__device__ __forceinline__ unsigned xb_ld(unsigned* p)              { return __hip_atomic_load(p, __ATOMIC_RELAXED, __HIP_MEMORY_SCOPE_AGENT); }
__device__ __forceinline__ unsigned xb_add(unsigned* p, unsigned v) { return __hip_atomic_fetch_add(p, v, __ATOMIC_RELAXED, __HIP_MEMORY_SCOPE_AGENT); }
__device__ __forceinline__ unsigned xb_xcc_id() { return (unsigned)__builtin_amdgcn_s_getreg((3 << 11) | 20) & 0xFu; }
#define XB_SPIN(cond, bar) do { unsigned _sp = 0; while (cond) { __builtin_amdgcn_s_sleep(0); \
    if ((++_sp & 255u) == 0u) { if (xb_ld(&(bar)[XB_TMO])) break; if (_sp > XB_SPIN_CAP) { atomicAdd(&(bar)[XB_TMO], 1u); break; } } } } while (0)
struct XcdBarrier { unsigned* bar; unsigned x; volatile LAS unsigned* st; };
__device__ __forceinline__ XcdBarrier xcd_barrier_post(unsigned* bar, volatile LAS unsigned* st) {
    XcdBarrier b; b.bar = bar; b.x = xb_xcc_id(); b.st = st;
    if (threadIdx.x == 0) (void)xb_add(&bar[XB_XCNT(b.x)], 1u);
    return b;
}
__device__ __forceinline__ void xcd_barrier_complete(unsigned* bar, unsigned x, unsigned& nloc, unsigned& nx) {
    const unsigned G = gridDim.x * gridDim.y * gridDim.z;
    unsigned sum, cnt, mine, sp = 0u;
    for (;;) {
        sum = 0u; cnt = 0u; mine = 0u;
#pragma unroll
        for (unsigned j = 0; j < 16; ++j) { const unsigned c = xb_ld(&bar[XB_XCNT(j)]); sum += c; cnt += (c > 0u) ? 1u : 0u; mine = (j == x) ? c : mine; }
        if (sum == G) break;
        __builtin_amdgcn_s_sleep(1);
        if ((++sp & 255u) == 0u) { if (xb_ld(&bar[XB_TMO])) break; if (sp > XB_SPIN_CAP) { atomicAdd(&bar[XB_TMO], 1u); break; } }
    }
    nloc = mine > 0u ? mine : 1u; nx = cnt > 0u ? cnt : 1u;
}
__device__ __forceinline__ void xcd_barrier(const XcdBarrier& b) {
    asm volatile("s_waitcnt vmcnt(0)" ::: "memory");
    __syncthreads();
    if (threadIdx.x == 0) {
        unsigned* bar = b.bar;
        __builtin_amdgcn_s_waitcnt(0);
        unsigned nloc = b.st[0], nx = b.st[1];
        if (nloc == 0u) { xcd_barrier_complete(bar, b.x, nloc, nx); b.st[0] = nloc; b.st[1] = nx; }
        const unsigned old = xb_add(&bar[XB_XSUB(b.x)], 1u);
        const unsigned gen = old / nloc;
        if (old + 1u == (gen + 1u) * nloc) {
            __builtin_amdgcn_fence(__ATOMIC_RELEASE, "agent");
            asm volatile("s_waitcnt vmcnt(0)" ::: "memory");
            const unsigned og = xb_add(&bar[XB_TOP], 1u);
            const unsigned tg = og / nx;
            if (og + 1u == (tg + 1u) * nx) xb_add(&bar[XB_TOPGEN], 1u);
            else XB_SPIN(xb_ld(&bar[XB_TOPGEN]) == tg, bar);
            __builtin_amdgcn_fence(__ATOMIC_ACQUIRE, "agent");
            xb_add(&bar[XB_XGEN(b.x)], 1u);
            asm volatile("s_waitcnt vmcnt(0)" ::: "memory");
        } else {
            XB_SPIN(xb_ld(&bar[XB_XGEN(b.x)]) == gen, bar);
            __builtin_amdgcn_fence(__ATOMIC_ACQUIRE, "agent");
            asm volatile("s_waitcnt vmcnt(0)" ::: "memory");
        }
    }
    __syncthreads();
}

__device__ __forceinline__ void sub_barrier(unsigned* word, unsigned n) {
    asm volatile("s_waitcnt vmcnt(0)" ::: "memory");
    __syncthreads();
    if (threadIdx.x == 0) {
        __builtin_amdgcn_fence(__ATOMIC_RELEASE, "agent");
        asm volatile("s_waitcnt vmcnt(0)" ::: "memory");
        xb_add(word, 1u);
        unsigned sp = 0;
        while (xb_ld(word) < n) { __builtin_amdgcn_s_sleep(0); if (++sp > (1u << 22)) break; }
        __builtin_amdgcn_fence(__ATOMIC_ACQUIRE, "agent");
        asm volatile("s_waitcnt vmcnt(0)" ::: "memory");
    }
    __syncthreads();
}

__device__ __forceinline__ void phase_mod(const Params& p, LAS unsigned char* lds) {
    LAS float* sc = (LAS float*)lds;
    LAS float* part = sc + 9 * 1024;
    float* mod = (float*)(PF(ws) + WS_MOD);
    const int tid = tid_(), w = tid >> 6, lane = tid & 63;
    if ((int)blockIdx.x >= 192) return;
    const float* pc = PF(c); const float* pcc = PF(c_ctx); const float* padaw = PF(ada_w); const float* padab = PF(ada_b);
    for (int i = tid; i < 9 * 1024; i += 512) { const int r = i >> 10, k = i & 1023; const float v = (r < 8) ? pc[r * 1024 + k] : pcc[k]; sc[i] = v / (1.0f + expf(-v)); }
    __syncthreads();
    for (int item = blockIdx.x; item < 192; item += gridDim.x) {
        const int l = item / 96, cb = item % 96;
        const float* W = padaw + (size_t)l * 1024 * 6144 + cb * 64 + lane;
        float acc[9];
#pragma unroll
        for (int r = 0; r < 9; ++r) acc[r] = 0.f;
        for (int k = w * 128; k < w * 128 + 128; ++k) { const float wv = W[(size_t)k * 6144];
#pragma unroll
            for (int r = 0; r < 9; ++r) acc[r] += sc[r * 1024 + k] * wv; }
#pragma unroll
        for (int r = 0; r < 9; ++r) part[(w * 9 + r) * 64 + lane] = acc[r];
        __syncthreads();
        for (int i = tid; i < 576; i += 512) { const int r = i >> 6, ln = i & 63; float s = 0.f;
#pragma unroll
            for (int ww = 0; ww < 8; ++ww) s += part[(ww * 9 + r) * 64 + ln];
            mod[(size_t)(l * 9 + r) * 6144 + cb * 64 + ln] = s + padab[l * 6144 + cb * 64 + ln]; }
        __syncthreads();
    }
}
__device__ __forceinline__ void phase_rope(const Params& p) {
    if (blockIdx.x != gridDim.x - 1) return;
    float* rope = (float*)(PF(ws) + WS_ROPE);
    for (int i = tid_(); i < 1024; i += 512) { const int pos = i >> 4, fi = i & 15; const float invf = powf(10000.0f, -(float)fi / 16.0f); const float ang = (float)pos * invf; rope[i] = cosf(ang); rope[1024 + i] = sinf(ang); }
}
__device__ __forceinline__ void convert_tile(const float* src, int K, int N, bf16_t* dst, int tile, LAS bf16_t* T) {
    const int tid = tid_(), tilesN = N >> 7, tk = tile / tilesN, tn = tile - tk * tilesN, k0 = tk * 128, n0 = tn * 128;
    const int r = tid >> 4, c8 = (tid & 15) * 8;
    f32x4 a[4], b[4];
#pragma unroll
    for (int i = 0; i < 4; ++i) { const float* s = src + (size_t)(k0 + r + 32 * i) * N + n0 + c8; a[i] = *(const f32x4*)s; b[i] = *(const f32x4*)(s + 4); }
#pragma unroll
    for (int i = 0; i < 4; ++i)
#pragma unroll
        for (int j = 0; j < 4; ++j) { T[(c8 + j) * 136 + r + 32 * i] = (bf16_t)f2bf(a[i][j]); T[(c8 + 4 + j) * 136 + r + 32 * i] = (bf16_t)f2bf(b[i][j]); }
    __syncthreads();
    const int n = tid >> 2, ks = (tid & 3) * 8;
#pragma unroll
    for (int i = 0; i < 4; ++i) { const u32x4 v = *(const LAS u32x4*)(T + n * 136 + ks + 32 * i); *(u32x4*)(dst + (size_t)(n0 + n) * K + k0 + ks + 32 * i) = v; }
    __syncthreads();
}
__device__ __forceinline__ void phase_convert(const Params& p, int l, LAS unsigned char* lds) {
    LAS bf16_t* T = (LAS bf16_t*)lds;
    bf16_t* WIN = (bf16_t*)(PF(ws) + WS_WIN); bf16_t* WB = (bf16_t*)(PF(ws) + WS_WB); bf16_t* WO = (bf16_t*)(PF(ws) + WS_WO); bf16_t* W1 = (bf16_t*)(PF(ws) + WS_W1); bf16_t* W2 = (bf16_t*)(PF(ws) + WS_W2);
    for (int it = blockIdx.x; it < 1184; it += gridDim.x) {
        if (it < 512) convert_tile(PF(w_in) + (size_t)l * DM * DIN, DM, DIN, WIN, it, T);
        else if (it < 608) { const int n = (it - 512) / 32, tl = (it - 512) % 32; convert_tile(PF(w_branch) + (size_t)(l * 3 + n) * 512 * DM, 512, DM, WB + (size_t)n * DM * 512, tl, T); }
        else if (it < 672) convert_tile(PF(w_out) + (size_t)l * DM * DM, DM, DM, WO, it - 608, T);
        else if (it < 928) convert_tile(PF(ffn_w1) + (size_t)l * DM * DFF, DM, DFF, W1, it - 672, T);
        else convert_tile(PF(ffn_w2) + (size_t)l * DFF * DM, DFF, DM, W2, it - 928, T);
    }
}
__device__ __forceinline__ void phase_norm(const Params& p, int l, const float* hlat, const float* hctx, const float* g, int modoff, int nrows, const float* slab = nullptr, const float* slabgate = nullptr, float* hwrite = nullptr) {
    const int tid = tid_(); const int w = tid >> 6, lane = tid & 63;
    bf16_t* U = (bf16_t*)(PF(ws) + WS_U); const float* mod = (const float*)(PF(ws) + WS_MOD);
    for (int row = blockIdx.x * 8 + w; row < nrows; row += gridDim.x * 8) {
        const float* src = row < NLAT ? hlat + (size_t)row * DM : hctx + (size_t)(row - NLAT) * DM;
        const int mr = row < NLAT ? (row >> 11) : 8;
        const float* md = mod + (size_t)(l * 9 + mr) * 6144 + modoff;
        f32x4 v[4]; float ss = 0.f;
#pragma unroll
        for (int i = 0; i < 4; ++i) { v[i] = *(const f32x4*)(src + i * 256 + lane * 4);
            if (slab != nullptr && row >= NLAT) { const size_t o = (size_t)(row - NLAT) * DM + i * 256 + lane * 4; const f32x4 gg = *(const f32x4*)(slabgate + i * 256 + lane * 4);
                const f32x4 s4 = (*(const f32x4*)(slab + o) + *(const f32x4*)(slab + o + (size_t)NCTX * DM)) + (*(const f32x4*)(slab + o + (size_t)2 * NCTX * DM) + *(const f32x4*)(slab + o + (size_t)3 * NCTX * DM));
                v[i] += gg * s4; if (hwrite != nullptr) *(f32x4*)(hwrite + o) = v[i]; }
            ss += v[i][0] * v[i][0] + v[i][1] * v[i][1] + v[i][2] * v[i][2] + v[i][3] * v[i][3]; }
#pragma unroll
        for (int o = 32; o >= 1; o >>= 1) ss += __shfl_xor(ss, o);
        const float rstd = rsqrtf(ss * (1.0f / 1024.0f) + 1e-6f);
#pragma unroll
        for (int i = 0; i < 4; ++i) { const int cidx = i * 256 + lane * 4; const f32x4 gg = *(const f32x4*)(g + cidx), sh = *(const f32x4*)(md + cidx), scv = *(const f32x4*)(md + 1024 + cidx);
            float o4[4];
#pragma unroll
            for (int j = 0; j < 4; ++j) o4[j] = (v[i][j] * rstd * gg[j]) * (1.0f + scv[j]) + sh[j];
            u32x2 wv; wv.x = pack2(o4[0], o4[1]); wv.y = pack2(o4[2], o4[3]);
            *(u32x2*)(U + (size_t)row * DM + cidx) = wv; }
    }
}
__device__ __forceinline__ void phase_hg_final(const Params& p, int l, int nrows, int wg, int nwg) {
    const int tid = tid_(); const int w = tid >> 6, lane = tid & 63; bf16_t* P = (bf16_t*)(PF(ws) + WS_P);
    const int hd = lane >> 4, e8 = (lane & 15) * 8; const float* png = PF(hg_norm_g);
    float ng[8];
#pragma unroll
    for (int i = 0; i < 8; ++i) ng[i] = png[l * 128 + e8 + i];
    for (int row = wg * 8 + w; row < nrows; row += nwg * 8) {
        bf16_t* rp = P + (size_t)row * PW;
        float a[8], b[8], og[8]; unpack8(*(const u32x4*)(rp + C_BF + hd * 128 + e8), a); unpack8(*(const u32x4*)(rp + C_BF + 512 + hd * 128 + e8), b); unpack8(*(const u32x4*)(rp + C_BO + hd * 128 + e8), og);
        float ss = 0.f;
#pragma unroll
        for (int i = 0; i < 8; ++i) { a[i] += b[i]; ss += a[i] * a[i]; }
        ss += __shfl_xor(ss, 1); ss += __shfl_xor(ss, 2); ss += __shfl_xor(ss, 4); ss += __shfl_xor(ss, 8);
        const float rstd = rsqrtf(ss * (1.0f / 128.0f) + 1e-6f);
        float y[8];
#pragma unroll
        for (int i = 0; i < 8; ++i) y[i] = a[i] * rstd * ng[i] * sigmoidf_(og[i]);
        *(u32x4*)(rp + C_BO + hd * 128 + e8) = pack8(y);
    }
}

__device__ __forceinline__ size_t agg_idx(int b, int gch, int dir, int which, int ch) { return ((((size_t)b * 36 + gch) * 2 + dir) * 2 + which) * 512 + ch; }
__device__ __forceinline__ float gelu_tanh(float x) { const float u = 0.7978845608028654f * (x + 0.044715f * x * x * x); const float th = 1.0f - 2.0f / (1.0f + __expf(2.0f * u)); return 0.5f * x * (1.0f + th); }
__device__ __forceinline__ void lru_tile(const Params& p, int l, LAS unsigned char* lds, int item, int mode, int& staged_nb) {
    LAS bf16_t* Wl = (LAS bf16_t*)lds;
    LAS bf16_t* Xb = Wl + 256 * 72;
    LAS float* Xf = (LAS float*)(lds + 46080);
    LAS float* Av = Xf + 4096;
    LAS float* Bv = Av + 8192;
    bf16_t* P = (bf16_t*)(PF(ws) + WS_P); float* AGG = (float*)(PF(ws) + WS_AGG);
    const int tid = tid_(), w = tid >> 6, lane = tid & 63, l16 = lane & 15, q4 = lane >> 4;
    const int nb = item & 7, rest = item >> 3, gch = rest % 36, b = rest / 36;
    const bool isctx = gch < 4; const int chunk = isctx ? gch : gch - 4, L = isctx ? CTXL : SEQ;
    const size_t seqrow0 = isctx ? (size_t)NLAT + b * CTXL : (size_t)b * SEQ; const int t0 = chunk * 64;
    if (staged_nb != nb) { const float* pwx = PF(lru_wx); const float* pwa = PF(lru_wa);
        for (int e = tid; e < 4 * 64 * 64; e += 512) { const int mat = e >> 12, i = (e >> 6) & 63, c = e & 63; const int dir = mat >> 1, kind = mat & 1;
            const float* W = kind ? pwx : pwa; const float v = W[((size_t)((l * 2 + dir) * 8 + nb) * 64 + i) * 64 + c];
            const int op = dir * 128 + (c >> 4) * 32 + kind * 16 + (c & 15);
            Wl[op * 72 + i] = (bf16_t)f2bf(v); }
        staged_nb = nb;
    }
    {
        const int t = tid >> 3, c8 = (tid & 7) * 8, ch = nb * 64 + c8, tt = t0 + t;
        float a8[8]; const float* pcb = PF(conv_b); const float* pcw = PF(conv_w);
        { const f32x4 b0 = *(const f32x4*)(pcb + l * 512 + ch), b1 = *(const f32x4*)(pcb + l * 512 + ch + 4);
#pragma unroll
          for (int i = 0; i < 4; ++i) { a8[i] = b0[i]; a8[4 + i] = b1[i]; } }
#pragma unroll
        for (int j = 0; j < 4; ++j) { const int ts = tt + j - 2;
            if (ts >= 0 && ts < L) { float xv[8]; unpack8(*(const u32x4*)(P + (seqrow0 + ts) * PW + C_AX + ch), xv);
                const f32x4 w0 = *(const f32x4*)(pcw + (l * 4 + j) * 512 + ch), w1 = *(const f32x4*)(pcw + (l * 4 + j) * 512 + ch + 4);
#pragma unroll
                for (int i = 0; i < 4; ++i) { a8[i] += xv[i] * w0[i]; a8[4 + i] += xv[4 + i] * w1[i]; } } }
#pragma unroll
        for (int i = 0; i < 8; ++i) Xf[t * 64 + c8 + i] = a8[i];
        *(LAS u32x4*)(Xb + t * 72 + c8) = pack8(a8);
    }
    __syncthreads();
    {
        const int dir = w >> 2, c = (w & 3) * 16 + l16, ch = nb * 64 + c;
        f32x4 acc[4][2];
#pragma unroll
        for (int mg = 0; mg < 4; ++mg) { acc[mg][0] = (f32x4){0.f, 0.f, 0.f, 0.f}; acc[mg][1] = (f32x4){0.f, 0.f, 0.f, 0.f}; }
#pragma unroll
        for (int ks = 0; ks < 2; ++ks) {
            const bf16x8 B0 = *(const LAS bf16x8*)(Wl + (w * 32 + l16) * 72 + ks * 32 + q4 * 8), B1 = *(const LAS bf16x8*)(Wl + (w * 32 + 16 + l16) * 72 + ks * 32 + q4 * 8);
#pragma unroll
            for (int mg = 0; mg < 4; ++mg) { const bf16x8 A = *(const LAS bf16x8*)(Xb + (mg * 16 + l16) * 72 + ks * 32 + q4 * 8);
                acc[mg][0] = mfma16(A, B0, acc[mg][0]); acc[mg][1] = mfma16(A, B1, acc[mg][1]); }
        }
        const float ba = PF(lru_ba)[(l * 2 + dir) * 512 + ch], bx = PF(lru_bx)[(l * 2 + dir) * 512 + ch], lam = PF(lru_lambda)[(l * 2 + dir) * 512 + ch];
        const float sp = log1pf(expf(-lam));
#pragma unroll
        for (int mg = 0; mg < 4; ++mg)
#pragma unroll
            for (int j = 0; j < 4; ++j) { const int t = mg * 16 + q4 * 4 + j;
                const float ea = 1.0f + __expf(-(acc[mg][0][j] + ba)), ex = 1.0f + __expf(-(acc[mg][1][j] + bx)); const float inv = __builtin_amdgcn_rcpf(ea * ex);
                const float r = inv * ex, ig = inv * ea;
                const float la = -8.0f * r * sp; const float a = __expf(la); const float x2 = 2.0f * la;
                float om = -x2 * (1.0f + x2 * (0.5f + x2 * (0.16666667f + x2 * (0.041666668f + x2 * 0.0083333338f))));
                if (x2 < -0.35f) om = 1.0f - a * a;
                const float bb = sqrtf(fmaxf(om, 0.f)) * ig * Xf[t * 64 + c];
                Av[(dir * 64 + t) * 64 + c] = a; Bv[(dir * 64 + t) * 64 + c] = bb; }
    }
    __syncthreads();
    {
        LAS float* SegA = Xf;
        LAS float* SegB = Xf + 512;
        const int d2 = tid >> 8, seg = (tid >> 6) & 3, c = tid & 63, ch = nb * 64 + c;
        float av[16], bv[16];
#pragma unroll
        for (int k = 0; k < 16; ++k) { const int s = seg * 16 + k; const int t = d2 ? 63 - s : s; const int ix = (d2 * 64 + t) * 64 + c; av[k] = Av[ix]; bv[k] = Bv[ix]; }
        float h = 0.f, ap = 1.f;
#pragma unroll
        for (int k = 0; k < 16; ++k) { h = av[k] * h + bv[k]; ap *= av[k]; }
        SegA[(d2 * 4 + seg) * 64 + c] = ap; SegB[(d2 * 4 + seg) * 64 + c] = h;
        float hin = 0.f;
        if (mode == 1) {
            const int mypos = d2 == 0 ? gch : (gch < 4 ? 3 - gch : 39 - gch);
            for (int p0 = 0; p0 < mypos; p0 += 6) { float Aa[6], Bb[6];
#pragma unroll
                for (int j = 0; j < 6; ++j) { const int pp = p0 + j; const int g = d2 == 0 ? pp : (pp < 4 ? 3 - pp : 39 - pp); const bool ok = pp < mypos;
                    Aa[j] = ok ? AGG[agg_idx(b, ok ? g : 0, d2, 0, ch)] : 1.0f; Bb[j] = ok ? AGG[agg_idx(b, ok ? g : 0, d2, 1, ch)] : 0.0f; }
#pragma unroll
                for (int j = 0; j < 6; ++j) hin = Aa[j] * hin + Bb[j]; }
        }
        __syncthreads();
        if (mode == 0) {
            if (seg == 3) { float A = 1.f, B = 0.f;
#pragma unroll
                for (int s2 = 0; s2 < 4; ++s2) { const float sa = SegA[(d2 * 4 + s2) * 64 + c], sb2 = SegB[(d2 * 4 + s2) * 64 + c]; B = sa * B + sb2; A *= sa; }
                AGG[agg_idx(b, gch, d2, 0, ch)] = A; AGG[agg_idx(b, gch, d2, 1, ch)] = B; }
        } else {
#pragma unroll
            for (int s2 = 0; s2 < 3; ++s2) if (s2 < seg) hin = SegA[(d2 * 4 + s2) * 64 + c] * hin + SegB[(d2 * 4 + s2) * 64 + c];
            float hh2 = hin;
#pragma unroll
            for (int k = 0; k < 16; ++k) { const int s = seg * 16 + k; const int t = d2 ? 63 - s : s; hh2 = av[k] * hh2 + bv[k]; Bv[(d2 * 64 + t) * 64 + c] = hh2; }
        }
    }
    __syncthreads();
    if (mode == 1) {
        const int t = tid >> 3, c8 = (tid & 7) * 8; bf16_t* gp = P + (seqrow0 + t0 + t) * PW + C_AG + nb * 64 + c8;
        float gt[8]; unpack8(*(const u32x4*)gp, gt); float y[8];
#pragma unroll
        for (int i = 0; i < 8; ++i) y[i] = (Bv[t * 64 + c8 + i] + Bv[(64 + t) * 64 + c8 + i]) * gelu_tanh(gt[i]);
        *(u32x4*)gp = pack8(y);
        __syncthreads();
    }
}

__device__ __forceinline__ void attn_item(const Params& p, int l, LAS unsigned char* lds, int item, int dry = 0) {
    LAS bf16_t* Kt = (LAS bf16_t*)lds;
    LAS bf16_t* Vt = Kt + 2 * 64 * 72;
    LAS float* rpbL = (LAS float*)(lds + 36864);
    LAS float* cosT = rpbL + 960;
    LAS float* sinT = cosT + 1024;
    LAS float* gq = sinT + 1024; LAS float* gk = gq + 64;
    bf16_t* P = (bf16_t*)(PF(ws) + WS_P); const float* rope = (const float*)(PF(ws) + WS_ROPE);
    const int tid = tid_(), w = __builtin_amdgcn_readfirstlane(tid >> 6), lane = tid & 63, l16 = lane & 15, q4 = lane >> 4, hh = w >> 2, qg4 = w & 3;
    const bool isctx = item >= 512;
    int b, hp, nloc, krU; int rq[2], kq0[2]; size_t qrow0[2];
    if (!isctx) { hp = item & 3; const int rp = (item >> 2) & 15; b = item >> 6;
        rq[0] = 2 * rp; rq[1] = 2 * rp + 1; kq0[0] = min(max(rq[0] - 4, 0), 24); kq0[1] = min(max(rq[1] - 4, 0), 24);
        qrow0[0] = (size_t)b * SEQ + rq[0] * 64; qrow0[1] = qrow0[0] + 64; krU = kq0[0]; nloc = kq0[1] + 8 - kq0[0]; }
    else { const int it = item - 512; hp = it & 3; const int qt = (it >> 2) & 1; b = it >> 3; rq[0] = rq[1] = 0; kq0[0] = kq0[1] = 0; krU = 0; nloc = 0;
        qrow0[0] = (size_t)NLAT + b * CTXL + qt * 128; qrow0[1] = qrow0[0] + 64; }
    const int h = hp * 2 + hh;
    const float* prpb = PF(na_rpb);
    for (int i = tid; i < 2 * 465; i += 512) { const int h2 = i / 465, j = i - h2 * 465; rpbL[h2 * 480 + j] = prpb[(size_t)((l * 8 + hp * 2 + h2) * 465) + j]; }
    for (int i = tid; i < 1024; i += 512) { cosT[i] = rope[i]; sinT[i] = rope[1024 + i]; }
    if (tid < 64) { gq[tid] = PF(na_qg)[l * 64 + tid]; gk[tid] = PF(na_kg)[l * 64 + tid]; }
    __syncthreads();
    const int qc = qg4 * 16 + l16;
    const int glo = qg4 < 2 ? 0 : qg4 - 1, ghi = qg4 == 0 ? 1 : (qg4 == 3 ? 3 : qg4 + 1);
    int bidx[4][4]; unsigned mbits = 0u;
    { const int cs0 = min(max(qc - 8, 0), 48);
#pragma unroll
      for (int g = 0; g < 4; ++g)
#pragma unroll
          for (int j = 0; j < 4; ++j) { const int kc = g * 16 + q4 * 4 + j; bidx[g][j] = hh * 480 + min(max(kc - qc, -15), 15) + 15; if (kc < cs0 || kc >= cs0 + 16) mbits |= 1u << (g * 4 + j); } }
    bf16x8 qpl[2][2], qrt[2][2];
#pragma unroll
    for (int qi = 0; qi < 2; ++qi) {
        const bf16_t* qp = P + (qrow0[qi] + qc) * PW + C_CQ + h * 64;
        float xq[16]; unpack8(*(const u32x4*)(qp + q4 * 8), xq); unpack8(*(const u32x4*)(qp + 32 + q4 * 8), xq + 8);
        float ss = 0.f;
#pragma unroll
        for (int i = 0; i < 16; ++i) ss += xq[i] * xq[i];
        ss += __shfl_xor(ss, 16); ss += __shfl_xor(ss, 32);
        const float rs = rsqrtf(ss * (1.0f / 64.0f) + 1e-6f) * 0.125f;
#pragma unroll
        for (int i = 0; i < 8; ++i) { xq[i] *= rs * gq[q4 * 8 + i]; xq[8 + i] *= rs * gq[32 + q4 * 8 + i]; }
        qpl[qi][0] = as_bf16x8(pack8(xq)); qpl[qi][1] = as_bf16x8(pack8(xq + 8));
        float xr[16];
#pragma unroll
        for (int ks = 0; ks < 2; ++ks) { const int pos = ks == 0 ? rq[qi] : qc;
#pragma unroll
            for (int jj = 0; jj < 8; ++jj) { const int fi = (q4 & 1) * 8 + jj; const float cs = cosT[pos * 16 + fi], sn = sinT[pos * 16 + fi]; const float xv = xq[ks * 8 + jj]; const float pr = __shfl_xor(xv, 32);
                xr[ks * 8 + jj] = (q4 < 2) ? (xv * cs - pr * sn) : (xv * cs + pr * sn); } }
        qrt[qi][0] = as_bf16x8(pack8(xr)); qrt[qi][1] = as_bf16x8(pack8(xr + 8));
    }
    f32x4 O[2][4];
#pragma unroll
    for (int qi = 0; qi < 2; ++qi)
#pragma unroll
        for (int i = 0; i < 4; ++i) O[qi][i] = (f32x4){0.f, 0.f, 0.f, 0.f};
    float mrun[2] = {-1e30f, -1e30f}, lsum[2] = {0.f, 0.f};
    const int pf_hh2 = tid >> 8, pf_h2 = hp * 2 + pf_hh2, pf_key = (tid & 255) >> 2, pf_seg = tid & 3, pf_vseg = (tid & 255) >> 6, pf_vkey = tid & 63;
    u32x4 pk0, pk1, pv0, pv1;
    { const size_t r0 = nloc ? (size_t)b * SEQ + krU * 64 : (size_t)NLAT + b * CTXL;
      const bf16_t* kp = P + (r0 + pf_key) * PW + C_CK + pf_h2 * 64 + pf_seg * 16; pk0 = *(const u32x4*)kp; pk1 = *(const u32x4*)(kp + 8);
      const bf16_t* vp = P + (r0 + pf_vkey) * PW + C_CV + pf_h2 * 64 + pf_vseg * 16; pv0 = *(const u32x4*)vp; pv1 = *(const u32x4*)(vp + 8); }
    const int ntot = nloc + 4; int Tn = 0;
#pragma unroll
    for (int ph = 0; ph < 2; ++ph) {
    const bool loc = (ph == 0); const int ntile = loc ? nloc : 4;
    for (int kt = 0; kt < ntile; ++kt) {
        const int kr = krU + kt; ++Tn;
        {
            const int hh2 = pf_hh2, key = pf_key, seg = pf_seg;
            float xk[16]; unpack8(pk0, xk); unpack8(pk1, xk + 8);
            float ss = 0.f;
#pragma unroll
            for (int i = 0; i < 16; ++i) ss += xk[i] * xk[i];
            ss += __shfl_xor(ss, 1); ss += __shfl_xor(ss, 2);
            const float rs = rsqrtf(ss * (1.0f / 64.0f) + 1e-6f);
#pragma unroll
            for (int i = 0; i < 16; ++i) xk[i] *= rs * gk[seg * 16 + i];
            if (loc) { const int pos = seg < 2 ? kr : key;
#pragma unroll
                for (int i = 0; i < 16; ++i) { const float pr = __shfl_xor(xk[i], 1); const float cs = cosT[pos * 16 + i], sn = sinT[pos * 16 + i]; xk[i] = (seg & 1) ? (xk[i] * cs + pr * sn) : (xk[i] * cs - pr * sn); } }
            LAS bf16_t* kd = Kt + (hh2 * 64 + key) * 72 + seg * 16;
            *(LAS u32x4*)kd = pack8(xk); *(LAS u32x4*)(kd + 8) = pack8(xk + 8);
        }
        {
            const int hh2 = pf_hh2, seg = pf_vseg, key = pf_vkey;
            const u32x4 a = pv0, c = pv1;
            LAS bf16_t* vd = Vt + (hh2 * 64 + seg * 16) * 72 + key;
            vd[0 * 72] = (bf16_t)(a.x & 0xffff); vd[1 * 72] = (bf16_t)(a.x >> 16); vd[2 * 72] = (bf16_t)(a.y & 0xffff); vd[3 * 72] = (bf16_t)(a.y >> 16);
            vd[4 * 72] = (bf16_t)(a.z & 0xffff); vd[5 * 72] = (bf16_t)(a.z >> 16); vd[6 * 72] = (bf16_t)(a.w & 0xffff); vd[7 * 72] = (bf16_t)(a.w >> 16);
            vd[8 * 72] = (bf16_t)(c.x & 0xffff); vd[9 * 72] = (bf16_t)(c.x >> 16); vd[10 * 72] = (bf16_t)(c.y & 0xffff); vd[11 * 72] = (bf16_t)(c.y >> 16);
            vd[12 * 72] = (bf16_t)(c.z & 0xffff); vd[13 * 72] = (bf16_t)(c.z >> 16); vd[14 * 72] = (bf16_t)(c.w & 0xffff); vd[15 * 72] = (bf16_t)(c.w >> 16);
        }
        if (Tn < ntot) { const size_t r0 = (Tn < nloc) ? (size_t)b * SEQ + (krU + Tn) * 64 : (size_t)NLAT + b * CTXL + (Tn - nloc) * 64;
            const bf16_t* kp = P + (r0 + pf_key) * PW + C_CK + pf_h2 * 64 + pf_seg * 16; pk0 = *(const u32x4*)kp; pk1 = *(const u32x4*)(kp + 8);
            const bf16_t* vp = P + (r0 + pf_vkey) * PW + C_CV + pf_h2 * 64 + pf_vseg * 16; pv0 = *(const u32x4*)vp; pv1 = *(const u32x4*)(vp + 8); }
        __syncthreads();
#pragma unroll
        for (int qi = 0; qi < 2; ++qi) {
            if (loc && (kr < kq0[qi] || kr >= kq0[qi] + 8)) continue;
            f32x4 st[4];
#pragma unroll
            for (int g = 0; g < 4; ++g) { const bool use = !loc || (g >= glo && g <= ghi);
                st[g] = (f32x4){0.f, 0.f, 0.f, 0.f};
                if (use) {
#pragma unroll
                    for (int ks = 0; ks < 2; ++ks) st[g] = mfma16(*(const LAS bf16x8*)(Kt + (hh * 64 + g * 16 + l16) * 72 + ks * 32 + q4 * 8), loc ? qrt[qi][ks] : qpl[qi][ks], st[g]);
                    if (loc) { const int dr31 = (kr - rq[qi] + 7) * 31;
#pragma unroll
                        for (int j = 0; j < 4; ++j) { const float sv = st[g][j] + rpbL[bidx[g][j] + dr31]; st[g][j] = ((mbits >> (g * 4 + j)) & 1u) ? -1e30f : sv; } }
                } else st[g] = (f32x4){-1e30f, -1e30f, -1e30f, -1e30f};
            }
            float tmax = -1e30f;
#pragma unroll
            for (int g = 0; g < 4; ++g)
#pragma unroll
                for (int j = 0; j < 4; ++j) tmax = fmaxf(tmax, st[g][j]);
            tmax = fmaxf(tmax, __shfl_xor(tmax, 16)); tmax = fmaxf(tmax, __shfl_xor(tmax, 32));
            const float mnew = fmaxf(mrun[qi], tmax); const float alpha = __expf(mrun[qi] - mnew); mrun[qi] = mnew;
            float psum = 0.f;
#pragma unroll
            for (int g = 0; g < 4; ++g) { const bool use = !loc || (g >= glo && g <= ghi);
                if (use) {
#pragma unroll
                    for (int j = 0; j < 4; ++j) { const float pv = __expf(st[g][j] - mnew); st[g][j] = pv; psum += pv; }
                } else st[g] = (f32x4){0.f, 0.f, 0.f, 0.f}; }
            lsum[qi] = lsum[qi] * alpha + psum;
#pragma unroll
            for (int i = 0; i < 4; ++i) O[qi][i] *= alpha;
            bf16x8 pb[2];
#pragma unroll
            for (int ks = 0; ks < 2; ++ks) { u32x4 wv; wv.x = pack2(st[2 * ks][0], st[2 * ks][1]); wv.y = pack2(st[2 * ks][2], st[2 * ks][3]); wv.z = pack2(st[2 * ks + 1][0], st[2 * ks + 1][1]); wv.w = pack2(st[2 * ks + 1][2], st[2 * ks + 1][3]); pb[ks] = as_bf16x8(wv); }
#pragma unroll
            for (int ks = 0; ks < 2; ++ks) if (!loc || (2 * ks + 1 >= glo && 2 * ks <= ghi))
#pragma unroll
                for (int dg = 0; dg < 4; ++dg) { const LAS bf16_t* vr = Vt + (hh * 64 + dg * 16 + l16) * 72 + ks * 32 + q4 * 4;
                    const u32x2 lo = *(const LAS u32x2*)vr, hi = *(const LAS u32x2*)(vr + 16); u32x4 av; av.x = lo.x; av.y = lo.y; av.z = hi.x; av.w = hi.y;
                    O[qi][dg] = mfma16(as_bf16x8(av), pb[ks], O[qi][dg]); }
        }
        __syncthreads();
    }
    }
#pragma unroll
    for (int qi = 0; qi < 2; ++qi) {
        float ls = lsum[qi]; ls += __shfl_xor(ls, 16); ls += __shfl_xor(ls, 32);
        const float inv = 1.0f / ls;
        bf16_t* op = dry ? ((bf16_t*)(PF(ws) + WS_DUMMY) + (size_t)(blockIdx.x & 63) * 16384 + (size_t)((qi * 8 + w) * 16 + l16) * 64) : (P + (qrow0[qi] + qc) * PW + C_CQ + h * 64);
#pragma unroll
        for (int dg = 0; dg < 4; ++dg) { u32x2 wv; wv.x = pack2(O[qi][dg][0] * inv, O[qi][dg][1] * inv); wv.y = pack2(O[qi][dg][2] * inv, O[qi][dg][3] * inv); *(u32x2*)(op + dg * 16 + q4 * 4) = wv; }
    }
    __syncthreads();
}

__device__ __forceinline__ void hgrn_stage(const bf16_t* P, LAS unsigned char* lds, int w, int lane, size_t row0, int dir, int h) {
#pragma unroll
    for (int i = 0; i < 2; ++i) { const int blk = i * 8 + w; const int t = blk * 4 + (lane >> 4); const bf16_t* rp = P + (row0 + (dir ? 63 - t : t)) * PW + (lane & 15) * 8;
        __builtin_amdgcn_global_load_lds((const unsigned*)(rp + C_BQ + h * 128), (LAS unsigned*)(lds + 118784 + blk * 1024), 16, 0, 0);
        __builtin_amdgcn_global_load_lds((const unsigned*)(rp + C_BF + dir * 512 + h * 128), (LAS unsigned*)(lds + 135168 + blk * 1024), 16, 0, 0); }
}
__device__ __forceinline__ void hgrn_chain(const Params& p, int l, LAS unsigned char* lds, int chain, int dry = 0) {
    LAS bf16_t* Q0 = (LAS bf16_t*)lds;
    LAS bf16_t* KP = (LAS bf16_t*)(lds + 17408);
    LAS bf16_t* SB = (LAS bf16_t*)(lds + 34816);
    LAS bf16_t* KDT = (LAS bf16_t*)(lds + 69632);
    LAS bf16_t* VT = (LAS bf16_t*)(lds + 88064);
    LAS bf16_t* ATT = (LAS bf16_t*)(lds + 106496);
    LAS float* TOT = (LAS float*)(lds + 115712);
    LAS float* DD = (LAS float*)(lds + 117760);
    const LAS bf16_t* SQ = (const LAS bf16_t*)(lds + 118784);
    const LAS bf16_t* SF = (const LAS bf16_t*)(lds + 135168);
    bf16_t* P = (bf16_t*)(PF(ws) + WS_P);
    const int tid = tid_(), w = __builtin_amdgcn_readfirstlane(tid >> 6), lane = tid & 63, l16 = lane & 15, q4 = lane >> 4;
    const int dir = chain & 1, h = (chain >> 1) & 3, b = chain >> 3;
    const int d = tid & 127, sb = tid >> 7;
    float lbv = 0.f;
    if (l > 0) { const float x0 = PF(hg_lb)[(dir * 2 + 0) * 512 + h * 128 + d], x1 = PF(hg_lb)[(dir * 2 + 1) * 512 + h * 128 + d]; lbv = 1.0f / (1.0f + expf(x0 - x1)); }
    for (int i = tid; i < 64 * 72 / 2; i += 512) ((LAS unsigned*)ATT)[i] = 0u;
    f32x4 S[8];
#pragma unroll
    for (int i = 0; i < 8; ++i) S[i] = (f32x4){0.f, 0.f, 0.f, 0.f};
    { const int gch0 = dir == 0 ? 0 : 3; hgrn_stage(P, lds, w, lane, (size_t)NLAT + b * CTXL + gch0 * 64, dir, h); }
    asm volatile("s_waitcnt vmcnt(0)" ::: "memory");
    __syncthreads();
    for (int ci = 0; ci < 36; ++ci) {
        const int gch = dir == 0 ? ci : (ci < 4 ? 3 - ci : 39 - ci);
        const bool isctx = gch < 4; const int chunk = isctx ? gch : gch - 4;
        const size_t row0 = isctx ? (size_t)NLAT + b * CTXL + chunk * 64 : (size_t)b * SEQ + chunk * 64;
        float bl[16], qv[16], kv[16]; float run = 0.f;
        {
            unsigned vraw[16];
#pragma unroll
            for (int ii = 0; ii < 16; ++ii) { const int t = sb * 16 + ii; vraw[ii] = P[(row0 + (dir ? 63 - t : t)) * PW + C_BI + h * 128 + d]; }
#pragma unroll
            for (int eg = 0; eg < 8; ++eg) { u32x2 wv; wv.x = pack2(S[eg][0], S[eg][1]); wv.y = pack2(S[eg][2], S[eg][3]); *(LAS u32x2*)(SB + (eg * 16 + l16) * 136 + w * 16 + q4 * 4) = wv; }
#pragma unroll
            for (int ii = 0; ii < 16; ++ii) { const int t = sb * 16 + ii;
                const float fr = bf2f(SF[t * 128 + d]), qr = bf2f(SQ[t * 128 + d]);
                const float sg = 1.0f / (1.0f + __expf(-fr)); const float f = lbv + (1.0f - lbv) * sg; run += __logf(f); bl[ii] = run; kv[ii] = 1.0f - f; qv[ii] = qr / (1.0f + __expf(-qr)); }
            TOT[sb * 128 + d] = run;
            u32x4 v0, v1; v0.x = vraw[0] | (vraw[1] << 16); v0.y = vraw[2] | (vraw[3] << 16); v0.z = vraw[4] | (vraw[5] << 16); v0.w = vraw[6] | (vraw[7] << 16);
            v1.x = vraw[8] | (vraw[9] << 16); v1.y = vraw[10] | (vraw[11] << 16); v1.z = vraw[12] | (vraw[13] << 16); v1.w = vraw[14] | (vraw[15] << 16);
            *(LAS u32x4*)(VT + d * 72 + sb * 16) = v0; *(LAS u32x4*)(VT + d * 72 + sb * 16 + 8) = v1;
        }
        __syncthreads();
        if (ci < 35) { const int cn = ci + 1; const int gn = dir == 0 ? cn : (cn < 4 ? 3 - cn : 39 - cn); const bool cx = gn < 4; const int ck = cx ? gn : gn - 4;
            hgrn_stage(P, lds, w, lane, cx ? (size_t)NLAT + b * CTXL + ck * 64 : (size_t)b * SEQ + ck * 64, dir, h); }
        {
            const float t0 = TOT[d], t1 = TOT[128 + d], t2 = TOT[256 + d], t3 = TOT[384 + d];
            const float Bs1 = t0, Bs2 = t0 + t1, Bs3 = Bs2 + t2, total = Bs3 + t3;
            const float Bsb = sb == 0 ? 0.f : (sb == 1 ? Bs1 : (sb == 2 ? Bs2 : Bs3));
            const float eB = __expf(Bsb), eT = __expf(total);
            float kd[16];
#pragma unroll
            for (int ii = 0; ii < 16; ++ii) { const float e0 = __expf(bl[ii]); Q0[(sb * 16 + ii) * 136 + d] = (bf16_t)pack2(qv[ii] * e0 * eB, 0.f);
                const float kp = kv[ii] * __expf(fminf(-(Bsb + bl[ii]), 80.f)); KP[(sb * 16 + ii) * 136 + d] = (bf16_t)pack2(kp, 0.f); kd[ii] = kp * eT; }
            *(LAS u32x4*)(KDT + d * 72 + sb * 16) = pack8(kd); *(LAS u32x4*)(KDT + d * 72 + sb * 16 + 8) = pack8(kd + 8);
            if (sb == 0) DD[d] = eT;
        }
        __syncthreads();
#pragma unroll
        for (int k2 = 0; k2 < 2; ++k2) { const int idx = w + 8 * k2;
            if (idx < 10) { const int i = idx < 1 ? 0 : (idx < 3 ? 1 : (idx < 6 ? 2 : 3)); const int j = idx - i * (i + 1) / 2;
                f32x4 sc = (f32x4){0.f, 0.f, 0.f, 0.f};
                const LAS bf16_t* qb = Q0 + (i * 16 + l16) * 136 + q4 * 8; const LAS bf16_t* kb = KP + (j * 16 + l16) * 136 + q4 * 8;
#pragma unroll
                for (int ks = 0; ks < 4; ++ks) sc = mfma16(*(const LAS bf16x8*)(qb + ks * 32), *(const LAS bf16x8*)(kb + ks * 32), sc);
#pragma unroll
                for (int jj = 0; jj < 4; ++jj) { const float v = (i == j && l16 > q4 * 4 + jj) ? 0.f : sc[jj]; ATT[(i * 16 + q4 * 4 + jj) * 72 + j * 16 + l16] = (bf16_t)pack2(v, 0.f); } } }
        __syncthreads();
        {
            bf16x8 SBf[4], VTf[2];
#pragma unroll
            for (int ks = 0; ks < 4; ++ks) SBf[ks] = *(const LAS bf16x8*)(SB + (w * 16 + l16) * 136 + ks * 32 + q4 * 8);
#pragma unroll
            for (int ks = 0; ks < 2; ++ks) VTf[ks] = *(const LAS bf16x8*)(VT + (w * 16 + l16) * 72 + ks * 32 + q4 * 8);
#pragma unroll
            for (int i = 0; i < 4; ++i) { f32x4 oa = (f32x4){0.f, 0.f, 0.f, 0.f};
#pragma unroll
                for (int ks = 0; ks < 4; ++ks) oa = mfma16(SBf[ks], *(const LAS bf16x8*)(Q0 + (i * 16 + l16) * 136 + ks * 32 + q4 * 8), oa);
#pragma unroll
                for (int ks = 0; ks < 2; ++ks) oa = mfma16(VTf[ks], *(const LAS bf16x8*)(ATT + (i * 16 + l16) * 72 + ks * 32 + q4 * 8), oa);
                const int t = i * 16 + l16; u32x2 wv; wv.x = pack2(oa[0], oa[1]); wv.y = pack2(oa[2], oa[3]);
                bf16_t* od = dry ? ((bf16_t*)(PF(ws) + WS_DUMMY) + (size_t)chain * 8192 + t * 128 + w * 16 + q4 * 4) : (P + (row0 + (dir ? 63 - t : t)) * PW + C_BF + dir * 512 + h * 128 + w * 16 + q4 * 4);
                *(u32x2*)od = wv; }
        }
        {
            const f32x4 dd = *(const LAS f32x4*)(DD + w * 16 + q4 * 4);
#pragma unroll
            for (int eg = 0; eg < 8; ++eg) S[eg] *= dd;
#pragma unroll
            for (int ks = 0; ks < 2; ++ks) { const bf16x8 A = *(const LAS bf16x8*)(KDT + (w * 16 + l16) * 72 + ks * 32 + q4 * 8);
#pragma unroll
                for (int eg = 0; eg < 8; ++eg) S[eg] = mfma16(A, *(const LAS bf16x8*)(VT + (eg * 16 + l16) * 72 + ks * 32 + q4 * 8), S[eg]); }
        }
        asm volatile("s_waitcnt vmcnt(0)" ::: "memory");
        __syncthreads();
    }
}

__global__ void __launch_bounds__(512, 2) fwd_megakernel(Params p) {
    extern __shared__ __attribute__((aligned(16))) unsigned char lds_raw[];
    LAS unsigned char* lds = (LAS unsigned char*)lds_raw;
    cg::grid_group grid = cg::this_grid();
    volatile LAS unsigned* xst = (volatile LAS unsigned*)(lds + LDS_BYTES - 16);
    if (threadIdx.x == 0) { xst[0] = 0u; xst[1] = 0u; xst[2] = 0u; xst[3] = 0u; }
    __syncthreads();
    const XcdBarrier xbar = xcd_barrier_post((unsigned*)(PF(ws) + WS_BAR), xst);
    const int G = gridDim.x, c = blockIdx.x;

    phase_mod(p, lds); __syncthreads();
    phase_rope(p);
    phase_convert(p, 0, lds);
    grid.sync();
#define WSP(T, off) ((T*)(PF(ws) + (off)))
    for (int l = 0; l < 2; ++l) {
        const bool lastl = (l == 1);
        const int Mrest = lastl ? NLAT : NTOK;
        if (l > 0) phase_convert(p, l, lds);
        phase_norm(p, l, l == 0 ? PF(x) : PF(out), l == 0 ? PF(ctx) : WSP(const float, WS_HC), PF(norm1_g) + l * DM, 0, NTOK,
                   (l > 0 && G == 256) ? (const float*)(PF(ws) + WS_P + (size_t)NTOK * DFF * 2) : nullptr, WSP(const float, WS_MOD) + (size_t)((l > 0 ? l - 1 : 0) * 9 + 8) * 6144 + 5120);
        xcd_barrier(xbar);

        { pg8::Gemm g{WSP(bf16_t, WS_U), WSP(bf16_t, WS_WIN), DM, DM, DM}; pg8::Sched S; S.init(NTOK, PW, G, c, DM, DM); pg8::EpiStore<0> E{WSP(bf16_t, WS_P), PW}; pg8::gemm_phase(lds, g, S, E); }
        xcd_barrier(xbar);
        if (c < 64) { hgrn_chain(p, l, lds, c); sub_barrier((unsigned*)(PF(ws) + WS_BAR) + 3520 + 64 * (2 * l), 64u); phase_hg_final(p, l, NTOK, c, 64); }
        else { const int cc = c - 64, GG = G - 64; const int nA = lastl ? 512 : 576;
            for (int it = cc; it < nA; it += GG) attn_item(p, l, lds, it);
            int staged = -1;
            for (int it = cc; it < 2304; it += GG) lru_tile(p, l, lds, it, 0, staged);
            sub_barrier((unsigned*)(PF(ws) + WS_BAR) + 3520 + 64 * (2 * l + 1), (unsigned)GG);
            for (int it = cc; it < 2304; it += GG) lru_tile(p, l, lds, it, 1, staged); }
        xcd_barrier(xbar);
        { pg8::Gemm g{WSP(bf16_t, WS_U), WSP(bf16_t, WS_WIN) + (size_t)PW * DM, DM, DM, DM}; pg8::Sched S; S.init(Mrest, 3072, G, c, DM, DM); pg8::EpiStore<1> E{WSP(bf16_t, WS_P), PW}; pg8::gemm_phase(lds, g, S, E); }
        xcd_barrier(xbar);
        { pg8::Gemm g{WSP(bf16_t, WS_P), WSP(bf16_t, WS_WB), PW, 512, 512}; pg8::MergeSched S; S.base.init(Mrest, DM, G, c, PW, 512);
          pg8::EpiMerge E{WSP(bf16_t, WS_P), WSP(bf16_t, WS_U)}; pg8::gemm_phase(lds, g, S, E); }
        xcd_barrier(xbar);
        { pg8::Gemm g{WSP(bf16_t, WS_U), WSP(bf16_t, WS_WO), DM, DM, DM};
          pg8::EpiResid E{l == 0 ? PF(x) : PF(out), l == 0 ? PF(ctx) : WSP(const float, WS_HC), PF(out), WSP(float, WS_HC), WSP(const float, WS_MOD) + (size_t)l * 9 * 6144 + 2048, WSP(float, WS_P)};
          if (!lastl && G == 256) { pg8::SplitSched S; S.base.init(NLAT, DM, G, c, DM, DM); S.sk = 256; pg8::gemm_phase(lds, g, S, E); }
          else { pg8::Sched S; S.init(Mrest, DM, G, c, DM, DM); pg8::gemm_phase(lds, g, S, E); } }
        xcd_barrier(xbar);
        if (!lastl && G == 256) phase_norm(p, l, PF(out), l == 0 ? PF(ctx) : WSP(const float, WS_HC), PF(norm2_g) + l * DM, 3072, Mrest, WSP(const float, WS_P), WSP(const float, WS_MOD) + (size_t)(l * 9 + 8) * 6144 + 2048, WSP(float, WS_HC));
        else phase_norm(p, l, PF(out), WSP(const float, WS_HC), PF(norm2_g) + l * DM, 3072, Mrest);
        xcd_barrier(xbar);
        { pg8::Gemm g{WSP(bf16_t, WS_U), WSP(bf16_t, WS_W1), DM, DM, DM}; pg8::Sched S; S.init(Mrest, DFF, G, c, DM, DM); pg8::EpiStore<2> E{WSP(bf16_t, WS_P), DFF}; pg8::gemm_phase(lds, g, S, E); }
        xcd_barrier(xbar);
        { pg8::Gemm g{WSP(bf16_t, WS_P), WSP(bf16_t, WS_W2), DFF, DFF, DFF};
          float* slab = (float*)(PF(ws) + WS_P + (size_t)NTOK * DFF * 2);
          pg8::EpiResid E{PF(out), WSP(const float, WS_HC), PF(out), WSP(float, WS_HC), WSP(const float, WS_MOD) + (size_t)l * 9 * 6144 + 5120, slab};
          if (!lastl && G == 256) { pg8::SplitSched S; S.base.init(NLAT, DM, G, c, DFF, DFF); S.sk = 1024; pg8::gemm_phase(lds, g, S, E); }
          else { pg8::Sched S; S.init(Mrest, DM, G, c, DFF, DFF); pg8::gemm_phase(lds, g, S, E); } }
        if (!lastl) xcd_barrier(xbar);
    }
}

extern "C" void kernel_launch(void* const* d_in, const int* in_sizes, int n_in, void* d_out, int out_size, void* d_ws, size_t ws_size, hipStream_t stream) {
    static int grid_blocks = 0;
    if (grid_blocks == 0) {
        int dev = 0, cus = 0, per_cu = 0;
        hipGetDevice(&dev);
        hipDeviceGetAttribute(&cus, hipDeviceAttributeMultiprocessorCount, dev);
        hipFuncSetAttribute((const void*)fwd_megakernel, hipFuncAttributeMaxDynamicSharedMemorySize, LDS_BYTES);
        hipOccupancyMaxActiveBlocksPerMultiprocessor(&per_cu, (const void*)fwd_megakernel, 512, LDS_BYTES);
        if (per_cu < 1 || n_in != 25 || ws_size < WS_END) { fprintf(stderr, "kernel_launch: cannot launch (per_cu %d, n_in %d, ws %zu need %zu)\n", per_cu, n_in, ws_size, (size_t)WS_END); grid_blocks = -1; }
        else grid_blocks = cus;
    }
    if (grid_blocks < 0) return;
    hipMemsetAsync((char*)d_ws + WS_BAR, 0, 16384, stream);
    Params p{};
    const float** pp = (const float**)&p;
    for (int i = 0; i < 25; ++i) pp[i] = (const float*)d_in[i];
    p.out = (float*)d_out; p.ws = (unsigned char*)d_ws;
    void* args[] = {&p};
    hipError_t e = hipLaunchCooperativeKernel((const void*)fwd_megakernel, dim3(grid_blocks), dim3(512), args, LDS_BYTES, stream);
    if (e != hipSuccess) fprintf(stderr, "cooperative launch failed: %s (grid %d)\n", hipGetErrorString(e), grid_blocks);
}
```

```cpp
#include <hip/hip_runtime.h>
#include <hip/hip_cooperative_groups.h>
#include <stdint.h>
#include <stdio.h>
namespace cg = cooperative_groups;

#define LAS __attribute__((address_space(3)))
typedef unsigned short bf16_t;
typedef short bf16x8 __attribute__((ext_vector_type(8)));
typedef float f32x4 __attribute__((ext_vector_type(4)));
typedef unsigned u32x4 __attribute__((ext_vector_type(4)));
typedef unsigned u32x2 __attribute__((ext_vector_type(2)));

constexpr int DM = 1024, NB = 8, SEQ = 2048, CTXL = 256, NLAT = NB * SEQ, NCTX = NB * CTXL, NTOK = NLAT + NCTX;
constexpr int PW = 5120, DIN = 8192, DFF = 4096;
constexpr int C_AX = 0, C_AG = 512, C_BQ = 1024, C_BF = 1536, C_BI = 2560, C_BO = 3072, C_CQ = 3584, C_CK = 4096, C_CV = 4608;
constexpr int LDS_BYTES = 163840;
constexpr size_t WS_WIN = 0;
constexpr size_t WS_WB = WS_WIN + (size_t)DIN * DM * 2;
constexpr size_t WS_WO = WS_WB + (size_t)3 * DM * 512 * 2;
constexpr size_t WS_W1 = WS_WO + (size_t)DM * DM * 2;
constexpr size_t WS_W2 = WS_W1 + (size_t)DFF * DM * 2;
constexpr size_t WS_U = WS_W2 + (size_t)DM * DFF * 2;
constexpr size_t WS_P = WS_U + (size_t)NTOK * DM * 2;
constexpr size_t WS_HC = WS_P + (size_t)NTOK * PW * 2;
constexpr size_t WS_MOD = WS_HC + (size_t)NCTX * DM * 4;
constexpr size_t WS_AGG = WS_MOD + (size_t)2 * 9 * 6144 * 4;
constexpr size_t WS_ROPE = WS_AGG + (size_t)NB * 36 * 2 * 2 * 512 * 4;
constexpr size_t WS_DUMMY = WS_ROPE + 2048 * 4;
constexpr size_t WS_BAR = WS_DUMMY + (2u << 20);
constexpr size_t WS_END = WS_BAR + 16384;

struct Params {
    const float *x, *c, *ctx, *c_ctx, *ada_w, *ada_b, *norm1_g, *norm2_g, *w_in, *conv_w, *conv_b, *lru_wa, *lru_ba, *lru_wx, *lru_bx, *lru_lambda,
        *hg_lb, *hg_norm_g, *na_qg, *na_kg, *na_rpb, *w_branch, *w_out, *ffn_w1, *ffn_w2;
    float* out; unsigned char* ws;
};


__device__ __forceinline__ unsigned long long ldkarg(int off) { unsigned long long v = 0;
#if defined(__HIP_DEVICE_COMPILE__)
    auto kp = __builtin_amdgcn_kernarg_segment_ptr();
    asm volatile("s_load_dwordx2 %0, %1, %2\n\ts_waitcnt lgkmcnt(0)" : "=s"(v) : "s"(kp), "s"(off));
#endif
    return v; }
template <class T> struct rm_ptr; template <class T> struct rm_ptr<T*> { typedef T type; };
template <class T> __device__ __forceinline__ T* as_global_ptr(unsigned long long v) { return (T*)(__attribute__((address_space(1))) T*)v; }
#define PF(f) (as_global_ptr<rm_ptr<decltype(Params::f)>::type>(ldkarg((int)__builtin_offsetof(Params, f))))

#define GAS __attribute__((address_space(1)))
template <class T> __device__ __forceinline__ GAS T* lnd(T* p) { asm volatile("" : "+v"(p)); return (GAS T*)p; }
__device__ __forceinline__ int tid_() { int t = threadIdx.x; asm volatile("" : "+v"(t)); return t; }
__device__ __forceinline__ float bf2f(unsigned v) { return __uint_as_float(v << 16); }
__device__ __forceinline__ float bflo(unsigned w) { return __uint_as_float(w << 16); }
__device__ __forceinline__ float bfhi(unsigned w) { return __uint_as_float(w & 0xffff0000u); }
__device__ __forceinline__ unsigned f2bf(float f) { unsigned u = __float_as_uint(f); u += 0x7fffu + ((u >> 16) & 1u); return u >> 16; }
typedef __bf16 bf16x2_t __attribute__((ext_vector_type(2)));
typedef float f32x2_t __attribute__((ext_vector_type(2)));
__device__ __forceinline__ unsigned pack2(float lo, float hi) { f32x2_t v = {lo, hi}; bf16x2_t b = __builtin_convertvector(v, bf16x2_t); union { bf16x2_t b; unsigned u; } t; t.b = b; return t.u; }
__device__ __forceinline__ float sigmoidf_(float x) { return 1.0f / (1.0f + __expf(-x)); }
__device__ __forceinline__ f32x4 mfma16(bf16x8 a, bf16x8 b, f32x4 c) { return __builtin_amdgcn_mfma_f32_16x16x32_bf16(a, b, c, 0, 0, 0); }
__device__ __forceinline__ bf16x8 as_bf16x8(u32x4 v) { union { u32x4 u; bf16x8 b; } t; t.u = v; return t.b; }
__device__ __forceinline__ void unpack8(u32x4 w, float* o) { o[0] = bflo(w.x); o[1] = bfhi(w.x); o[2] = bflo(w.y); o[3] = bfhi(w.y); o[4] = bflo(w.z); o[5] = bfhi(w.z); o[6] = bflo(w.w); o[7] = bfhi(w.w); }
__device__ __forceinline__ u32x4 pack8(const float* v) { u32x4 w; w.x = pack2(v[0], v[1]); w.y = pack2(v[2], v[3]); w.z = pack2(v[4], v[5]); w.w = pack2(v[6], v[7]); return w; }

namespace pg8 {
constexpr int BM = 256, BK = 64, HALF = 128, HTB = HALF * BK * 2, NXCD = 8, WGM = 4;
__device__ __forceinline__ int lds_byte(int r, int c) { const int st = (r >> 4) * 2 + (c >> 5), rr = r & 15, cc = c & 31, ob = rr * 64 + cc * 2; return st * 1024 + (ob ^ (((ob >> 9) & 1) << 5)); }
__device__ __forceinline__ void stage_rc(int b, int& R, int& C) { const int st = b / 1024, sb = b % 1024, swz = sb ^ (((sb >> 9) & 1) << 5); R = (st >> 1) * 16 + swz / 64; C = (st & 1) * 32 + (swz % 64) / 2; }
__device__ __forceinline__ int perm32(int rho) { const int n = rho >> 4, i = rho & 15; return 8 * (i >> 2) + 4 * n + (i & 3); }

struct Unit { int pm, pn, sub, nt; size_t aoff, boff; };
struct Gemm { const bf16_t* A; const bf16_t* Bt; int lda, ldb, K; };
struct Sched {
    int nM, nN, nwg, G, c, lda, ldb, nt;
    __device__ void init(int M, int N, int G_, int c_, int lda_, int ldb_) { nM = M / BM; nN = N / BM; nwg = nM * nN; G = G_; c = c_; lda = lda_; ldb = ldb_; nt = 0; }
    __device__ bool next(int i, Unit& u) const {
        const long L = (long)i * G + c; if (L >= nwg) return false;
        int wgid = (int)L; { const int q = nwg / NXCD, r = nwg % NXCD, xcd = wgid % NXCD, off = wgid / NXCD; wgid = (xcd < r ? xcd * (q + 1) : r * (q + 1) + (xcd - r) * q) + off; }
        const int nig = WGM * nN, gid = wgid / nig, fm = gid * WGM, gsz = (nM - fm) < WGM ? (nM - fm) : WGM;
        u.pm = fm + ((wgid % nig) % gsz); u.pn = (wgid % nig) / gsz; u.sub = 0; u.nt = nt;
        u.aoff = (size_t)u.pm * BM * lda * 2;
        u.boff = (size_t)u.pn * BM * ldb * 2;
        return true;
    }
};

template <int ACT> struct EpiStore {
    static constexpr bool PERM = true;
    bf16_t* O; int ldc;
    __device__ __forceinline__ void operator()(const f32x4 (&acc)[2][2][4][2], const Unit& u, int wr, int wc, int fr, int fq) const {
        const int row0 = u.pm * BM + wr * 64 + fr; int colt = u.pn * BM;
        if (ACT == 1) colt = (colt < 2048) ? (1024 + colt) : (2048 + colt);
        const int col0 = colt + wc * 32 + 8 * fq;
#pragma unroll
        for (int ai = 0; ai < 2; ++ai)
#pragma unroll
            for (int m = 0; m < 4; ++m) { GAS bf16_t* rowp = lnd(O + (size_t)(row0 + ai * HALF + m * 16) * ldc + col0);
#pragma unroll
                for (int bj = 0; bj < 2; ++bj) { f32x4 v0 = acc[ai][bj][m][0], v1 = acc[ai][bj][m][1];
                    if (ACT == 1) {
#pragma unroll
                        for (int j = 0; j < 4; ++j) { v0[j] = sigmoidf_(v0[j]); v1[j] = sigmoidf_(v1[j]); } }
                    if (ACT == 2) {
#pragma unroll
                        for (int j = 0; j < 4; ++j) { float a = fmaxf(v0[j], 0.f), b = fmaxf(v1[j], 0.f); v0[j] = a * a; v1[j] = b * b; } }
                    u32x4 w; w.x = pack2(v0[0], v0[1]); w.y = pack2(v0[2], v0[3]); w.z = pack2(v1[0], v1[1]); w.w = pack2(v1[2], v1[3]);
                    *(GAS u32x4*)(rowp + bj * HALF) = w; } }
    }
};
struct EpiMerge {
    static constexpr bool PERM = true;
    const bf16_t* P; bf16_t* U;
    __device__ __forceinline__ void operator()(const f32x4 (&acc)[2][2][4][2], const Unit& u, int wr, int wc, int fr, int fq) const {
        const int row0 = u.pm * BM + wr * 64 + fr; const int col0 = u.pn * BM + wc * 32 + 8 * fq;
        const int sub = u.sub; const int gcol = sub * 1024 + u.pn * BM; const int gd = ((gcol < 2048) ? (1024 + gcol) : (2048 + gcol)) + wc * 32 + 8 * fq;
        const bool addp = sub > 0;
#pragma unroll
        for (int ai = 0; ai < 2; ++ai)
#pragma unroll
            for (int m = 0; m < 4; ++m) { const size_t row = (size_t)(row0 + ai * HALF + m * 16); const GAS bf16_t* gp = lnd(P + row * PW + gd); GAS bf16_t* up = lnd(U + row * DM + col0);
#pragma unroll
                for (int bj = 0; bj < 2; ++bj) { const u32x4 gw = *(const GAS u32x4*)(gp + bj * HALF);
                    f32x4 a0 = acc[ai][bj][m][0], a1 = acc[ai][bj][m][1];
                    a0[0] *= bflo(gw.x); a0[1] *= bfhi(gw.x); a0[2] *= bflo(gw.y); a0[3] *= bfhi(gw.y); a1[0] *= bflo(gw.z); a1[1] *= bfhi(gw.z); a1[2] *= bflo(gw.w); a1[3] *= bfhi(gw.w);
                    if (addp) { const u32x4 pw = *(const GAS u32x4*)(up + bj * HALF);
                        a0[0] += bflo(pw.x); a0[1] += bfhi(pw.x); a0[2] += bflo(pw.y); a0[3] += bfhi(pw.y); a1[0] += bflo(pw.z); a1[1] += bfhi(pw.z); a1[2] += bflo(pw.w); a1[3] += bfhi(pw.w); }
                    u32x4 o; o.x = pack2(a0[0], a0[1]); o.y = pack2(a0[2], a0[3]); o.z = pack2(a1[0], a1[1]); o.w = pack2(a1[2], a1[3]);
                    *(GAS u32x4*)(up + bj * HALF) = o; } }
    }
};
struct EpiResid {
    static constexpr bool PERM = true;
    const float* inL; const float* inC; float* outL; float* outC; const float* mod;
    float* slab;
    __device__ __forceinline__ void operator()(const f32x4 (&acc)[2][2][4][2], const Unit& u, int wr, int wc, int fr, int fq) const {
        if (u.sub >= 1) {
            const int row0 = (u.pm - 64) * BM + wr * 64 + fr, col0 = u.pn * BM + wc * 32 + 8 * fq; float* sl = slab + (size_t)(u.sub - 1) * NCTX * DM;
#pragma unroll
            for (int ai = 0; ai < 2; ++ai)
#pragma unroll
                for (int m = 0; m < 4; ++m)
#pragma unroll
                    for (int bj = 0; bj < 2; ++bj) { GAS float* op = lnd(sl + (size_t)(row0 + ai * HALF + m * 16) * DM + col0 + bj * HALF); *(GAS f32x4*)op = acc[ai][bj][m][0]; *(GAS f32x4*)(op + 4) = acc[ai][bj][m][1]; }
            return;
        }
        const bool lat = u.pm < 64; const int rbase = lat ? u.pm * BM : (u.pm - 64) * BM;
        const float* in = lat ? inL : inC; float* out = lat ? outL : outC;
        const int row0 = rbase + wr * 64 + fr, col0 = u.pn * BM + wc * 32 + 8 * fq;
        const float* gt = mod + (size_t)(lat ? (u.pm >> 3) : 8) * 6144 + col0;
#pragma unroll
        for (int bj = 0; bj < 2; ++bj) { const f32x4 g0 = *(const f32x4*)(gt + bj * HALF), g1 = *(const f32x4*)(gt + bj * HALF + 4);
#pragma unroll
            for (int ai = 0; ai < 2; ++ai)
#pragma unroll
                for (int m = 0; m < 4; ++m) { const size_t ro = (size_t)(row0 + ai * HALF + m * 16) * DM + col0 + bj * HALF;
                    const GAS float* ip = lnd(in + ro); GAS float* op = lnd(out + ro); const f32x4 i0 = *(const GAS f32x4*)ip, i1 = *(const GAS f32x4*)(ip + 4);
                    *(GAS f32x4*)op = i0 + g0 * acc[ai][bj][m][0]; *(GAS f32x4*)(op + 4) = i1 + g1 * acc[ai][bj][m][1]; } }
    }
};

struct MergeSched {
    Sched base;
    __device__ bool next(int i, Unit& u) const {
        const int r = i / 3, n = i - 3 * r;
        if (!base.next(r, u)) return false;
        u.sub = n; u.aoff += (size_t)(n == 0 ? C_AG : C_BO + (n - 1) * 512) * 2; u.boff += (size_t)n * DM * 512 * 2;
        return true;
    }
};
struct SplitSched {
    Sched base;
    int sk;
    __device__ bool next(int i, Unit& u) const {
        if (base.next(i, u)) return true;
        const int nfull = (base.nwg - base.c + base.G - 1) / base.G;
        const int k = i - nfull; const int un = k * base.G + base.c; if (k < 0 || un >= 128) return false;
        const int ct = un >> 2, sl = un & 3; u.pm = 64 + (ct >> 2); u.pn = ct & 3; u.sub = 1 + sl; u.nt = sk / BK;
        u.aoff = (size_t)u.pm * BM * base.lda * 2 + (size_t)sl * sk * 2; u.boff = (size_t)u.pn * BM * base.ldb * 2 + (size_t)sl * sk * 2;
        return true;
    }
};
template <class Epi, class Sch>
__device__ __forceinline__ void gemm_phase(LAS unsigned char* lds, const Gemm g, const Sch& S, const Epi& E) {
    const int tid = tid_(), wid = __builtin_amdgcn_readfirstlane(tid >> 6), lane = tid & 63, wr = wid >> 2, wc = wid & 3, fr = lane & 15, fq = lane >> 4;
    const int K = g.K;
    unsigned voffA[2], voffB[2];
#pragma unroll
    for (int i = 0; i < 2; ++i) { int R, C; stage_rc(tid * 16 + i * 8192, R, C); const int Rb = Epi::PERM ? ((R & ~31) + perm32(R & 31)) : R;
        voffA[i] = (unsigned)(R * g.lda + C) * 2u; voffB[i] = (unsigned)(Rb * g.ldb + C) * 2u; }
    const size_t kstep = (size_t)(BK * 2);
    const size_t hstepA = (size_t)HALF * g.lda * 2, hstepB = (size_t)HALF * g.ldb * 2;
    const unsigned ldsw = (unsigned)wid * 1024u;
    const int aoff = lds_byte(wr * 64 + fr, fq * 8), boff = lds_byte(wc * 32 + fr, fq * 8);
#define PG8_SA(b, h) (((b) * 2 + (h)) * HTB)
#define PG8_SB(b, h) ((4 + (b) * 2 + (h)) * HTB)
#define PG8_STAGE(bufoff, gbase, voff) do { _Pragma("unroll") for (int _i = 0; _i < 2; ++_i) \
        __builtin_amdgcn_global_load_lds((const unsigned*)((const char*)(gbase) + (voff)[_i]), (LAS unsigned*)(lds + (bufoff) + ldsw + _i * 8192), 16, 0, 0); } while (0)
#define PG8_LDA(dst, b, h) do { _Pragma("unroll") for (int m = 0; m < 4; ++m) _Pragma("unroll") for (int k = 0; k < 2; ++k) dst[m][k] = *(const LAS bf16x8*)(lds + PG8_SA(b, h) + aoff + m * 2048 + k * 1024); } while (0)
#define PG8_LDB(dst, b, h) do { _Pragma("unroll") for (int n = 0; n < 2; ++n) _Pragma("unroll") for (int k = 0; k < 2; ++k) dst[n][k] = *(const LAS bf16x8*)(lds + PG8_SB(b, h) + boff + n * 2048 + k * 1024); } while (0)
#define PG8_MMA(ai, bj, At, Bt) do { __builtin_amdgcn_s_setprio(1); _Pragma("unroll") for (int m = 0; m < 4; ++m) _Pragma("unroll") for (int n = 0; n < 2; ++n) _Pragma("unroll") for (int k = 0; k < 2; ++k) \
        acc[ai][bj][m][n] = __builtin_amdgcn_mfma_f32_16x16x32_bf16(Bt[n][k], At[m][k], acc[ai][bj][m][n], 0, 0, 0); __builtin_amdgcn_s_setprio(0); } while (0)
#define PG8_WAIT_V(n) asm volatile("s_waitcnt vmcnt(" #n ")" ::: "memory")
#define PG8_WAIT_L(n) asm volatile("s_waitcnt lgkmcnt(" #n ")" ::: "memory")
#define PG8_BAR __builtin_amdgcn_s_barrier()
#define PG8_SCHED __builtin_amdgcn_sched_barrier(0)
    Unit cur, nxt; int ui = 0;
    if (!S.next(0, cur)) return;
    f32x4 acc[2][2][4][2];
#pragma unroll
    for (int a = 0; a < 2; ++a)
#pragma unroll
        for (int b = 0; b < 2; ++b)
#pragma unroll
            for (int m = 0; m < 4; ++m)
#pragma unroll
                for (int n = 0; n < 2; ++n) acc[a][b][m][n] = (f32x4){0.f, 0.f, 0.f, 0.f};
    bf16x8 At[4][2], B0[2][2], B1[2][2];
    const char* cA = (const char*)g.A + cur.aoff; const char* cB = (const char*)g.Bt + cur.boff;
    PG8_STAGE(PG8_SB(0, 0), cB, voffB); PG8_STAGE(PG8_SB(0, 1), cB + hstepB, voffB); PG8_STAGE(PG8_SA(0, 0), cA, voffA); PG8_STAGE(PG8_SA(0, 1), cA + hstepA, voffA);
    if (wr == 1) PG8_BAR;
    PG8_WAIT_V(2); PG8_BAR;
    PG8_STAGE(PG8_SB(1, 0), cB + kstep, voffB); PG8_STAGE(PG8_SA(1, 0), cA + kstep, voffA); PG8_STAGE(PG8_SB(1, 1), cB + hstepB + kstep, voffB);
    PG8_WAIT_V(6); PG8_BAR;
    for (;;) {
        const bool has_next = S.next(ui + 1, nxt);
        const char* nA = has_next ? (const char*)g.A + nxt.aoff : cA; const char* nB = has_next ? (const char*)g.Bt + nxt.boff : cB;
        const int nt = cur.nt ? cur.nt : K / BK;
        for (int t = 0; t < nt; t += 2) {
            const bool last = (t == nt - 2);
            const char* a1 = cA + (size_t)(t + 1) * kstep;
            const char* a2 = last ? nA : cA + (size_t)(t + 2) * kstep; const char* b2 = last ? nB : cB + (size_t)(t + 2) * kstep;
            const char* a3 = a2 + kstep; const char* b3 = b2 + kstep;
            PG8_LDB(B0, 0, 0); PG8_LDB(B1, 0, 1); PG8_SCHED; PG8_LDA(At, 0, 0); PG8_STAGE(PG8_SA(1, 1), a1 + hstepA, voffA);
            PG8_WAIT_V(8); PG8_WAIT_L(0); PG8_BAR; PG8_MMA(0, 0, At, B0); PG8_MMA(0, 1, At, B1); PG8_BAR; PG8_SCHED;
            PG8_LDA(At, 0, 1); PG8_STAGE(PG8_SB(0, 0), b2, voffB); PG8_STAGE(PG8_SB(0, 1), b2 + hstepB, voffB); PG8_STAGE(PG8_SA(0, 0), a2, voffA);
            PG8_WAIT_V(8); PG8_WAIT_L(0); PG8_BAR; PG8_MMA(1, 0, At, B0); PG8_MMA(1, 1, At, B1); PG8_BAR; PG8_SCHED;
            PG8_LDB(B0, 1, 0); PG8_LDB(B1, 1, 1); PG8_SCHED; PG8_LDA(At, 1, 0); PG8_STAGE(PG8_SA(0, 1), a2 + hstepA, voffA);
            PG8_WAIT_V(8); PG8_WAIT_L(0); PG8_BAR; PG8_MMA(0, 0, At, B0); PG8_MMA(0, 1, At, B1); PG8_BAR; PG8_SCHED;
            PG8_LDA(At, 1, 1); PG8_STAGE(PG8_SB(1, 0), b3, voffB); PG8_STAGE(PG8_SB(1, 1), b3 + hstepB, voffB); PG8_STAGE(PG8_SA(1, 0), a3, voffA);
            PG8_WAIT_V(8); PG8_WAIT_L(0); PG8_BAR; PG8_MMA(1, 0, At, B0); PG8_MMA(1, 1, At, B1); PG8_BAR; PG8_SCHED;
        }
        if (wr == 0) PG8_BAR;
        E(acc, cur, wr, wc, fr, fq);
        if (!has_next) break;
#pragma unroll
        for (int a = 0; a < 2; ++a)
#pragma unroll
            for (int b = 0; b < 2; ++b)
#pragma unroll
                for (int m = 0; m < 4; ++m)
#pragma unroll
                    for (int n = 0; n < 2; ++n) acc[a][b][m][n] = (f32x4){0.f, 0.f, 0.f, 0.f};
        cur = nxt; cA = nA; cB = nB; ++ui;
        if (wr == 1) PG8_BAR;
    }
    PG8_WAIT_V(0);
    PG8_BAR;
#undef PG8_SA
#undef PG8_SB
#undef PG8_STAGE
#undef PG8_LDA
#undef PG8_LDB
#undef PG8_MMA
#undef PG8_WAIT_V
#undef PG8_WAIT_L
#undef PG8_BAR
#undef PG8_SCHED
}
}


#define XB_TMO      128
#define XB_XCNT(j)  (256  + 64 * (j))
#define XB_XSUB(j)  (1280 + 64 * (j))
#define XB_XGEN(j)  (2304 + 64 * (j))
#define XB_TOP      3328
#define XB_TOPGEN   3392
#define XCD_BAR_WORDS 3456
#define XB_SPIN_CAP (1u << 20)
__device__ __forceinline__ unsigned xb_ld(unsigned* p)              { return __hip_atomic_load(p, __ATOMIC_RELAXED, __HIP_MEMORY_SCOPE_AGENT); }
__device__ __forceinline__ unsigned xb_add(unsigned* p, unsigned v) { return __hip_atomic_fetch_add(p, v, __ATOMIC_RELAXED, __HIP_MEMORY_SCOPE_AGENT); }
__device__ __forceinline__ unsigned xb_xcc_id() { return (unsigned)__builtin_amdgcn_s_getreg((3 << 11) | 20) & 0xFu; }
#define XB_SPIN(cond, bar) do { unsigned _sp = 0; while (cond) { __builtin_amdgcn_s_sleep(0); \
    if ((++_sp & 255u) == 0u) { if (xb_ld(&(bar)[XB_TMO])) break; if (_sp > XB_SPIN_CAP) { atomicAdd(&(bar)[XB_TMO], 1u); break; } } } } while (0)
struct XcdBarrier { unsigned* bar; unsigned x; volatile LAS unsigned* st; };
__device__ __forceinline__ XcdBarrier xcd_barrier_post(unsigned* bar, volatile LAS unsigned* st) {
    XcdBarrier b; b.bar = bar; b.x = xb_xcc_id(); b.st = st;
    if (threadIdx.x == 0) (void)xb_add(&bar[XB_XCNT(b.x)], 1u);
    return b;
}
__device__ __forceinline__ void xcd_barrier_complete(unsigned* bar, unsigned x, unsigned& nloc, unsigned& nx) {
    const unsigned G = gridDim.x * gridDim.y * gridDim.z;
    unsigned sum, cnt, mine, sp = 0u;
    for (;;) {
        sum = 0u; cnt = 0u; mine = 0u;
#pragma unroll
        for (unsigned j = 0; j < 16; ++j) { const unsigned c = xb_ld(&bar[XB_XCNT(j)]); sum += c; cnt += (c > 0u) ? 1u : 0u; mine = (j == x) ? c : mine; }
        if (sum == G) break;
        __builtin_amdgcn_s_sleep(1);
        if ((++sp & 255u) == 0u) { if (xb_ld(&bar[XB_TMO])) break; if (sp > XB_SPIN_CAP) { atomicAdd(&bar[XB_TMO], 1u); break; } }
    }
    nloc = mine > 0u ? mine : 1u; nx = cnt > 0u ? cnt : 1u;
}
__device__ __forceinline__ void xcd_barrier(const XcdBarrier& b) {
    asm volatile("s_waitcnt vmcnt(0)" ::: "memory");
    __syncthreads();
    if (threadIdx.x == 0) {
        unsigned* bar = b.bar;
        __builtin_amdgcn_s_waitcnt(0);
        unsigned nloc = b.st[0], nx = b.st[1];
        if (nloc == 0u) { xcd_barrier_complete(bar, b.x, nloc, nx); b.st[0] = nloc; b.st[1] = nx; }
        const unsigned old = xb_add(&bar[XB_XSUB(b.x)], 1u);
        const unsigned gen = old / nloc;
        if (old + 1u == (gen + 1u) * nloc) {
            __builtin_amdgcn_fence(__ATOMIC_RELEASE, "agent");
            asm volatile("s_waitcnt vmcnt(0)" ::: "memory");
            const unsigned og = xb_add(&bar[XB_TOP], 1u);
            const unsigned tg = og / nx;
            if (og + 1u == (tg + 1u) * nx) xb_add(&bar[XB_TOPGEN], 1u);
            else XB_SPIN(xb_ld(&bar[XB_TOPGEN]) == tg, bar);
            __builtin_amdgcn_fence(__ATOMIC_ACQUIRE, "agent");
            xb_add(&bar[XB_XGEN(b.x)], 1u);
            asm volatile("s_waitcnt vmcnt(0)" ::: "memory");
        } else {
            XB_SPIN(xb_ld(&bar[XB_XGEN(b.x)]) == gen, bar);
            __builtin_amdgcn_fence(__ATOMIC_ACQUIRE, "agent");
            asm volatile("s_waitcnt vmcnt(0)" ::: "memory");
        }
    }
    __syncthreads();
}

__device__ __forceinline__ void sub_barrier(unsigned* word, unsigned n) {
    asm volatile("s_waitcnt vmcnt(0)" ::: "memory");
    __syncthreads();
    if (threadIdx.x == 0) {
        __builtin_amdgcn_fence(__ATOMIC_RELEASE, "agent");
        asm volatile("s_waitcnt vmcnt(0)" ::: "memory");
        xb_add(word, 1u);
        unsigned sp = 0;
        while (xb_ld(word) < n) { __builtin_amdgcn_s_sleep(0); if (++sp > (1u << 22)) break; }
        __builtin_amdgcn_fence(__ATOMIC_ACQUIRE, "agent");
        asm volatile("s_waitcnt vmcnt(0)" ::: "memory");
    }
    __syncthreads();
}

__device__ __forceinline__ void phase_mod(const Params& p, LAS unsigned char* lds) {
    LAS float* sc = (LAS float*)lds;
    LAS float* part = sc + 9 * 1024;
    float* mod = (float*)(PF(ws) + WS_MOD);
    const int tid = tid_(), w = tid >> 6, lane = tid & 63;
    if ((int)blockIdx.x >= 192) return;
    const float* pc = PF(c); const float* pcc = PF(c_ctx); const float* padaw = PF(ada_w); const float* padab = PF(ada_b);
    for (int i = tid; i < 9 * 1024; i += 512) { const int r = i >> 10, k = i & 1023; const float v = (r < 8) ? pc[r * 1024 + k] : pcc[k]; sc[i] = v / (1.0f + expf(-v)); }
    __syncthreads();
    for (int item = blockIdx.x; item < 192; item += gridDim.x) {
        const int l = item / 96, cb = item % 96;
        const float* W = padaw + (size_t)l * 1024 * 6144 + cb * 64 + lane;
        float acc[9];
#pragma unroll
        for (int r = 0; r < 9; ++r) acc[r] = 0.f;
        for (int k = w * 128; k < w * 128 + 128; ++k) { const float wv = W[(size_t)k * 6144];
#pragma unroll
            for (int r = 0; r < 9; ++r) acc[r] += sc[r * 1024 + k] * wv; }
#pragma unroll
        for (int r = 0; r < 9; ++r) part[(w * 9 + r) * 64 + lane] = acc[r];
        __syncthreads();
        for (int i = tid; i < 576; i += 512) { const int r = i >> 6, ln = i & 63; float s = 0.f;
#pragma unroll
            for (int ww = 0; ww < 8; ++ww) s += part[(ww * 9 + r) * 64 + ln];
            mod[(size_t)(l * 9 + r) * 6144 + cb * 64 + ln] = s + padab[l * 6144 + cb * 64 + ln]; }
        __syncthreads();
    }
}
__device__ __forceinline__ void phase_rope(const Params& p) {
    if (blockIdx.x != gridDim.x - 1) return;
    float* rope = (float*)(PF(ws) + WS_ROPE);
    for (int i = tid_(); i < 1024; i += 512) { const int pos = i >> 4, fi = i & 15; const float invf = powf(10000.0f, -(float)fi / 16.0f); const float ang = (float)pos * invf; rope[i] = cosf(ang); rope[1024 + i] = sinf(ang); }
}
__device__ __forceinline__ void convert_tile(const float* src, int K, int N, bf16_t* dst, int tile, LAS bf16_t* T) {
    const int tid = tid_(), tilesN = N >> 7, tk = tile / tilesN, tn = tile - tk * tilesN, k0 = tk * 128, n0 = tn * 128;
    const int r = tid >> 4, c8 = (tid & 15) * 8;
    f32x4 a[4], b[4];
#pragma unroll
    for (int i = 0; i < 4; ++i) { const float* s = src + (size_t)(k0 + r + 32 * i) * N + n0 + c8; a[i] = *(const f32x4*)s; b[i] = *(const f32x4*)(s + 4); }
#pragma unroll
    for (int i = 0; i < 4; ++i)
#pragma unroll
        for (int j = 0; j < 4; ++j) { T[(c8 + j) * 136 + r + 32 * i] = (bf16_t)f2bf(a[i][j]); T[(c8 + 4 + j) * 136 + r + 32 * i] = (bf16_t)f2bf(b[i][j]); }
    __syncthreads();
    const int n = tid >> 2, ks = (tid & 3) * 8;
#pragma unroll
    for (int i = 0; i < 4; ++i) { const u32x4 v = *(const LAS u32x4*)(T + n * 136 + ks + 32 * i); *(u32x4*)(dst + (size_t)(n0 + n) * K + k0 + ks + 32 * i) = v; }
    __syncthreads();
}
__device__ __forceinline__ void phase_convert(const Params& p, int l, LAS unsigned char* lds) {
    LAS bf16_t* T = (LAS bf16_t*)lds;
    bf16_t* WIN = (bf16_t*)(PF(ws) + WS_WIN); bf16_t* WB = (bf16_t*)(PF(ws) + WS_WB); bf16_t* WO = (bf16_t*)(PF(ws) + WS_WO); bf16_t* W1 = (bf16_t*)(PF(ws) + WS_W1); bf16_t* W2 = (bf16_t*)(PF(ws) + WS_W2);
    for (int it = blockIdx.x; it < 1184; it += gridDim.x) {
        if (it < 512) convert_tile(PF(w_in) + (size_t)l * DM * DIN, DM, DIN, WIN, it, T);
        else if (it < 608) { const int n = (it - 512) / 32, tl = (it - 512) % 32; convert_tile(PF(w_branch) + (size_t)(l * 3 + n) * 512 * DM, 512, DM, WB + (size_t)n * DM * 512, tl, T); }
        else if (it < 672) convert_tile(PF(w_out) + (size_t)l * DM * DM, DM, DM, WO, it - 608, T);
        else if (it < 928) convert_tile(PF(ffn_w1) + (size_t)l * DM * DFF, DM, DFF, W1, it - 672, T);
        else convert_tile(PF(ffn_w2) + (size_t)l * DFF * DM, DFF, DM, W2, it - 928, T);
    }
}
__device__ __forceinline__ void phase_norm(const Params& p, int l, const float* hlat, const float* hctx, const float* g, int modoff, int nrows, const float* slab = nullptr, const float* slabgate = nullptr, float* hwrite = nullptr) {
    const int tid = tid_(); const int w = tid >> 6, lane = tid & 63;
    bf16_t* U = (bf16_t*)(PF(ws) + WS_U); const float* mod = (const float*)(PF(ws) + WS_MOD);
    for (int row = blockIdx.x * 8 + w; row < nrows; row += gridDim.x * 8) {
        const float* src = row < NLAT ? hlat + (size_t)row * DM : hctx + (size_t)(row - NLAT) * DM;
        const int mr = row < NLAT ? (row >> 11) : 8;
        const float* md = mod + (size_t)(l * 9 + mr) * 6144 + modoff;
        f32x4 v[4]; float ss = 0.f;
#pragma unroll
        for (int i = 0; i < 4; ++i) { v[i] = *(const f32x4*)(src + i * 256 + lane * 4);
            if (slab != nullptr && row >= NLAT) { const size_t o = (size_t)(row - NLAT) * DM + i * 256 + lane * 4; const f32x4 gg = *(const f32x4*)(slabgate + i * 256 + lane * 4);
                const f32x4 s4 = (*(const f32x4*)(slab + o) + *(const f32x4*)(slab + o + (size_t)NCTX * DM)) + (*(const f32x4*)(slab + o + (size_t)2 * NCTX * DM) + *(const f32x4*)(slab + o + (size_t)3 * NCTX * DM));
                v[i] += gg * s4; if (hwrite != nullptr) *(f32x4*)(hwrite + o) = v[i]; }
            ss += v[i][0] * v[i][0] + v[i][1] * v[i][1] + v[i][2] * v[i][2] + v[i][3] * v[i][3]; }
#pragma unroll
        for (int o = 32; o >= 1; o >>= 1) ss += __shfl_xor(ss, o);
        const float rstd = rsqrtf(ss * (1.0f / 1024.0f) + 1e-6f);
#pragma unroll
        for (int i = 0; i < 4; ++i) { const int cidx = i * 256 + lane * 4; const f32x4 gg = *(const f32x4*)(g + cidx), sh = *(const f32x4*)(md + cidx), scv = *(const f32x4*)(md + 1024 + cidx);
            float o4[4];
#pragma unroll
            for (int j = 0; j < 4; ++j) o4[j] = (v[i][j] * rstd * gg[j]) * (1.0f + scv[j]) + sh[j];
            u32x2 wv; wv.x = pack2(o4[0], o4[1]); wv.y = pack2(o4[2], o4[3]);
            *(u32x2*)(U + (size_t)row * DM + cidx) = wv; }
    }
}
__device__ __forceinline__ void phase_hg_final(const Params& p, int l, int nrows, int wg, int nwg) {
    const int tid = tid_(); const int w = tid >> 6, lane = tid & 63; bf16_t* P = (bf16_t*)(PF(ws) + WS_P);
    const int hd = lane >> 4, e8 = (lane & 15) * 8; const float* png = PF(hg_norm_g);
    float ng[8];
#pragma unroll
    for (int i = 0; i < 8; ++i) ng[i] = png[l * 128 + e8 + i];
    for (int row = wg * 8 + w; row < nrows; row += nwg * 8) {
        bf16_t* rp = P + (size_t)row * PW;
        float a[8], b[8], og[8]; unpack8(*(const u32x4*)(rp + C_BF + hd * 128 + e8), a); unpack8(*(const u32x4*)(rp + C_BF + 512 + hd * 128 + e8), b); unpack8(*(const u32x4*)(rp + C_BO + hd * 128 + e8), og);
        float ss = 0.f;
#pragma unroll
        for (int i = 0; i < 8; ++i) { a[i] += b[i]; ss += a[i] * a[i]; }
        ss += __shfl_xor(ss, 1); ss += __shfl_xor(ss, 2); ss += __shfl_xor(ss, 4); ss += __shfl_xor(ss, 8);
        const float rstd = rsqrtf(ss * (1.0f / 128.0f) + 1e-6f);
        float y[8];
#pragma unroll
        for (int i = 0; i < 8; ++i) y[i] = a[i] * rstd * ng[i] * sigmoidf_(og[i]);
        *(u32x4*)(rp + C_BO + hd * 128 + e8) = pack8(y);
    }
}

__device__ __forceinline__ size_t agg_idx(int b, int gch, int dir, int which, int ch) { return ((((size_t)b * 36 + gch) * 2 + dir) * 2 + which) * 512 + ch; }
__device__ __forceinline__ float gelu_tanh(float x) { const float u = 0.7978845608028654f * (x + 0.044715f * x * x * x); const float th = 1.0f - 2.0f / (1.0f + __expf(2.0f * u)); return 0.5f * x * (1.0f + th); }
__device__ __forceinline__ void lru_tile(const Params& p, int l, LAS unsigned char* lds, int item, int mode, int& staged_nb) {
    LAS bf16_t* Wl = (LAS bf16_t*)lds;
    LAS bf16_t* Xb = Wl + 256 * 72;
    LAS float* Xf = (LAS float*)(lds + 46080);
    LAS float* Av = Xf + 4096;
    LAS float* Bv = Av + 8192;
    bf16_t* P = (bf16_t*)(PF(ws) + WS_P); float* AGG = (float*)(PF(ws) + WS_AGG);
    const int tid = tid_(), w = tid >> 6, lane = tid & 63, l16 = lane & 15, q4 = lane >> 4;
    const int nb = item & 7, rest = item >> 3, gch = rest % 36, b = rest / 36;
    const bool isctx = gch < 4; const int chunk = isctx ? gch : gch - 4, L = isctx ? CTXL : SEQ;
    const size_t seqrow0 = isctx ? (size_t)NLAT + b * CTXL : (size_t)b * SEQ; const int t0 = chunk * 64;
    if (staged_nb != nb) { const float* pwx = PF(lru_wx); const float* pwa = PF(lru_wa);
        for (int e = tid; e < 4 * 64 * 64; e += 512) { const int mat = e >> 12, i = (e >> 6) & 63, c = e & 63; const int dir = mat >> 1, kind = mat & 1;
            const float* W = kind ? pwx : pwa; const float v = W[((size_t)((l * 2 + dir) * 8 + nb) * 64 + i) * 64 + c];
            const int op = dir * 128 + (c >> 4) * 32 + kind * 16 + (c & 15);
            Wl[op * 72 + i] = (bf16_t)f2bf(v); }
        staged_nb = nb;
    }
    {
        const int t = tid >> 3, c8 = (tid & 7) * 8, ch = nb * 64 + c8, tt = t0 + t;
        float a8[8]; const float* pcb = PF(conv_b); const float* pcw = PF(conv_w);
        { const f32x4 b0 = *(const f32x4*)(pcb + l * 512 + ch), b1 = *(const f32x4*)(pcb + l * 512 + ch + 4);
#pragma unroll
          for (int i = 0; i < 4; ++i) { a8[i] = b0[i]; a8[4 + i] = b1[i]; } }
#pragma unroll
        for (int j = 0; j < 4; ++j) { const int ts = tt + j - 2;
            if (ts >= 0 && ts < L) { float xv[8]; unpack8(*(const u32x4*)(P + (seqrow0 + ts) * PW + C_AX + ch), xv);
                const f32x4 w0 = *(const f32x4*)(pcw + (l * 4 + j) * 512 + ch), w1 = *(const f32x4*)(pcw + (l * 4 + j) * 512 + ch + 4);
#pragma unroll
                for (int i = 0; i < 4; ++i) { a8[i] += xv[i] * w0[i]; a8[4 + i] += xv[4 + i] * w1[i]; } } }
#pragma unroll
        for (int i = 0; i < 8; ++i) Xf[t * 64 + c8 + i] = a8[i];
        *(LAS u32x4*)(Xb + t * 72 + c8) = pack8(a8);
    }
    __syncthreads();
    {
        const int dir = w >> 2, c = (w & 3) * 16 + l16, ch = nb * 64 + c;
        f32x4 acc[4][2];
#pragma unroll
        for (int mg = 0; mg < 4; ++mg) { acc[mg][0] = (f32x4){0.f, 0.f, 0.f, 0.f}; acc[mg][1] = (f32x4){0.f, 0.f, 0.f, 0.f}; }
#pragma unroll
        for (int ks = 0; ks < 2; ++ks) {
            const bf16x8 B0 = *(const LAS bf16x8*)(Wl + (w * 32 + l16) * 72 + ks * 32 + q4 * 8), B1 = *(const LAS bf16x8*)(Wl + (w * 32 + 16 + l16) * 72 + ks * 32 + q4 * 8);
#pragma unroll
            for (int mg = 0; mg < 4; ++mg) { const bf16x8 A = *(const LAS bf16x8*)(Xb + (mg * 16 + l16) * 72 + ks * 32 + q4 * 8);
                acc[mg][0] = mfma16(A, B0, acc[mg][0]); acc[mg][1] = mfma16(A, B1, acc[mg][1]); }
        }
        const float ba = PF(lru_ba)[(l * 2 + dir) * 512 + ch], bx = PF(lru_bx)[(l * 2 + dir) * 512 + ch], lam = PF(lru_lambda)[(l * 2 + dir) * 512 + ch];
        const float sp = log1pf(expf(-lam));
#pragma unroll
        for (int mg = 0; mg < 4; ++mg)
#pragma unroll
            for (int j = 0; j < 4; ++j) { const int t = mg * 16 + q4 * 4 + j;
                const float ea = 1.0f + __expf(-(acc[mg][0][j] + ba)), ex = 1.0f + __expf(-(acc[mg][1][j] + bx)); const float inv = __builtin_amdgcn_rcpf(ea * ex);
                const float r = inv * ex, ig = inv * ea;
                const float la = -8.0f * r * sp; const float a = __expf(la); const float x2 = 2.0f * la;
                float om = -x2 * (1.0f + x2 * (0.5f + x2 * (0.16666667f + x2 * (0.041666668f + x2 * 0.0083333338f))));
                if (x2 < -0.35f) om = 1.0f - a * a;
                const float bb = sqrtf(fmaxf(om, 0.f)) * ig * Xf[t * 64 + c];
                Av[(dir * 64 + t) * 64 + c] = a; Bv[(dir * 64 + t) * 64 + c] = bb; }
    }
    __syncthreads();
    {
        LAS float* SegA = Xf;
        LAS float* SegB = Xf + 512;
        const int d2 = tid >> 8, seg = (tid >> 6) & 3, c = tid & 63, ch = nb * 64 + c;
        float av[16], bv[16];
#pragma unroll
        for (int k = 0; k < 16; ++k) { const int s = seg * 16 + k; const int t = d2 ? 63 - s : s; const int ix = (d2 * 64 + t) * 64 + c; av[k] = Av[ix]; bv[k] = Bv[ix]; }
        float h = 0.f, ap = 1.f;
#pragma unroll
        for (int k = 0; k < 16; ++k) { h = av[k] * h + bv[k]; ap *= av[k]; }
        SegA[(d2 * 4 + seg) * 64 + c] = ap; SegB[(d2 * 4 + seg) * 64 + c] = h;
        float hin = 0.f;
        if (mode == 1) {
            const int mypos = d2 == 0 ? gch : (gch < 4 ? 3 - gch : 39 - gch);
            for (int p0 = 0; p0 < mypos; p0 += 6) { float Aa[6], Bb[6];
#pragma unroll
                for (int j = 0; j < 6; ++j) { const int pp = p0 + j; const int g = d2 == 0 ? pp : (pp < 4 ? 3 - pp : 39 - pp); const bool ok = pp < mypos;
                    Aa[j] = ok ? AGG[agg_idx(b, ok ? g : 0, d2, 0, ch)] : 1.0f; Bb[j] = ok ? AGG[agg_idx(b, ok ? g : 0, d2, 1, ch)] : 0.0f; }
#pragma unroll
                for (int j = 0; j < 6; ++j) hin = Aa[j] * hin + Bb[j]; }
        }
        __syncthreads();
        if (mode == 0) {
            if (seg == 3) { float A = 1.f, B = 0.f;
#pragma unroll
                for (int s2 = 0; s2 < 4; ++s2) { const float sa = SegA[(d2 * 4 + s2) * 64 + c], sb2 = SegB[(d2 * 4 + s2) * 64 + c]; B = sa * B + sb2; A *= sa; }
                AGG[agg_idx(b, gch, d2, 0, ch)] = A; AGG[agg_idx(b, gch, d2, 1, ch)] = B; }
        } else {
#pragma unroll
            for (int s2 = 0; s2 < 3; ++s2) if (s2 < seg) hin = SegA[(d2 * 4 + s2) * 64 + c] * hin + SegB[(d2 * 4 + s2) * 64 + c];
            float hh2 = hin;
#pragma unroll
            for (int k = 0; k < 16; ++k) { const int s = seg * 16 + k; const int t = d2 ? 63 - s : s; hh2 = av[k] * hh2 + bv[k]; Bv[(d2 * 64 + t) * 64 + c] = hh2; }
        }
    }
    __syncthreads();
    if (mode == 1) {
        const int t = tid >> 3, c8 = (tid & 7) * 8; bf16_t* gp = P + (seqrow0 + t0 + t) * PW + C_AG + nb * 64 + c8;
        float gt[8]; unpack8(*(const u32x4*)gp, gt); float y[8];
#pragma unroll
        for (int i = 0; i < 8; ++i) y[i] = (Bv[t * 64 + c8 + i] + Bv[(64 + t) * 64 + c8 + i]) * gelu_tanh(gt[i]);
        *(u32x4*)gp = pack8(y);
        __syncthreads();
    }
}

__device__ __forceinline__ void attn_item(const Params& p, int l, LAS unsigned char* lds, int item, int dry = 0) {
    LAS bf16_t* Kt = (LAS bf16_t*)lds;
    LAS bf16_t* Vt = Kt + 2 * 64 * 72;
    LAS float* rpbL = (LAS float*)(lds + 36864);
    LAS float* cosT = rpbL + 960;
    LAS float* sinT = cosT + 1024;
    LAS float* gq = sinT + 1024; LAS float* gk = gq + 64;
    bf16_t* P = (bf16_t*)(PF(ws) + WS_P); const float* rope = (const float*)(PF(ws) + WS_ROPE);
    const int tid = tid_(), w = __builtin_amdgcn_readfirstlane(tid >> 6), lane = tid & 63, l16 = lane & 15, q4 = lane >> 4, hh = w >> 2, qg4 = w & 3;
    const bool isctx = item >= 512;
    int b, hp, nloc, krU; int rq[2], kq0[2]; size_t qrow0[2];
    if (!isctx) { hp = item & 3; const int rp = (item >> 2) & 15; b = item >> 6;
        rq[0] = 2 * rp; rq[1] = 2 * rp + 1; kq0[0] = min(max(rq[0] - 4, 0), 24); kq0[1] = min(max(rq[1] - 4, 0), 24);
        qrow0[0] = (size_t)b * SEQ + rq[0] * 64; qrow0[1] = qrow0[0] + 64; krU = kq0[0]; nloc = kq0[1] + 8 - kq0[0]; }
    else { const int it = item - 512; hp = it & 3; const int qt = (it >> 2) & 1; b = it >> 3; rq[0] = rq[1] = 0; kq0[0] = kq0[1] = 0; krU = 0; nloc = 0;
        qrow0[0] = (size_t)NLAT + b * CTXL + qt * 128; qrow0[1] = qrow0[0] + 64; }
    const int h = hp * 2 + hh;
    const float* prpb = PF(na_rpb);
    for (int i = tid; i < 2 * 465; i += 512) { const int h2 = i / 465, j = i - h2 * 465; rpbL[h2 * 480 + j] = prpb[(size_t)((l * 8 + hp * 2 + h2) * 465) + j]; }
    for (int i = tid; i < 1024; i += 512) { cosT[i] = rope[i]; sinT[i] = rope[1024 + i]; }
    if (tid < 64) { gq[tid] = PF(na_qg)[l * 64 + tid]; gk[tid] = PF(na_kg)[l * 64 + tid]; }
    __syncthreads();
    const int qc = qg4 * 16 + l16;
    const int glo = qg4 < 2 ? 0 : qg4 - 1, ghi = qg4 == 0 ? 1 : (qg4 == 3 ? 3 : qg4 + 1);
    int bidx[4][4]; unsigned mbits = 0u;
    { const int cs0 = min(max(qc - 8, 0), 48);
#pragma unroll
      for (int g = 0; g < 4; ++g)
#pragma unroll
          for (int j = 0; j < 4; ++j) { const int kc = g * 16 + q4 * 4 + j; bidx[g][j] = hh * 480 + min(max(kc - qc, -15), 15) + 15; if (kc < cs0 || kc >= cs0 + 16) mbits |= 1u << (g * 4 + j); } }
    bf16x8 qpl[2][2], qrt[2][2];
#pragma unroll
    for (int qi = 0; qi < 2; ++qi) {
        const bf16_t* qp = P + (qrow0[qi] + qc) * PW + C_CQ + h * 64;
        float xq[16]; unpack8(*(const u32x4*)(qp + q4 * 8), xq); unpack8(*(const u32x4*)(qp + 32 + q4 * 8), xq + 8);
        float ss = 0.f;
#pragma unroll
        for (int i = 0; i < 16; ++i) ss += xq[i] * xq[i];
        ss += __shfl_xor(ss, 16); ss += __shfl_xor(ss, 32);
        const float rs = rsqrtf(ss * (1.0f / 64.0f) + 1e-6f) * 0.125f;
#pragma unroll
        for (int i = 0; i < 8; ++i) { xq[i] *= rs * gq[q4 * 8 + i]; xq[8 + i] *= rs * gq[32 + q4 * 8 + i]; }
        qpl[qi][0] = as_bf16x8(pack8(xq)); qpl[qi][1] = as_bf16x8(pack8(xq + 8));
        float xr[16];
#pragma unroll
        for (int ks = 0; ks < 2; ++ks) { const int pos = ks == 0 ? rq[qi] : qc;
#pragma unroll
            for (int jj = 0; jj < 8; ++jj) { const int fi = (q4 & 1) * 8 + jj; const float cs = cosT[pos * 16 + fi], sn = sinT[pos * 16 + fi]; const float xv = xq[ks * 8 + jj]; const float pr = __shfl_xor(xv, 32);
                xr[ks * 8 + jj] = (q4 < 2) ? (xv * cs - pr * sn) : (xv * cs + pr * sn); } }
        qrt[qi][0] = as_bf16x8(pack8(xr)); qrt[qi][1] = as_bf16x8(pack8(xr + 8));
    }
    f32x4 O[2][4];
#pragma unroll
    for (int qi = 0; qi < 2; ++qi)
#pragma unroll
        for (int i = 0; i < 4; ++i) O[qi][i] = (f32x4){0.f, 0.f, 0.f, 0.f};
    float mrun[2] = {-1e30f, -1e30f}, lsum[2] = {0.f, 0.f};
    const int pf_hh2 = tid >> 8, pf_h2 = hp * 2 + pf_hh2, pf_key = (tid & 255) >> 2, pf_seg = tid & 3, pf_vseg = (tid & 255) >> 6, pf_vkey = tid & 63;
    u32x4 pk0, pk1, pv0, pv1;
    { const size_t r0 = nloc ? (size_t)b * SEQ + krU * 64 : (size_t)NLAT + b * CTXL;
      const bf16_t* kp = P + (r0 + pf_key) * PW + C_CK + pf_h2 * 64 + pf_seg * 16; pk0 = *(const u32x4*)kp; pk1 = *(const u32x4*)(kp + 8);
      const bf16_t* vp = P + (r0 + pf_vkey) * PW + C_CV + pf_h2 * 64 + pf_vseg * 16; pv0 = *(const u32x4*)vp; pv1 = *(const u32x4*)(vp + 8); }
    const int ntot = nloc + 4; int Tn = 0;
#pragma unroll
    for (int ph = 0; ph < 2; ++ph) {
    const bool loc = (ph == 0); const int ntile = loc ? nloc : 4;
    for (int kt = 0; kt < ntile; ++kt) {
        const int kr = krU + kt; ++Tn;
        {
            const int hh2 = pf_hh2, key = pf_key, seg = pf_seg;
            float xk[16]; unpack8(pk0, xk); unpack8(pk1, xk + 8);
            float ss = 0.f;
#pragma unroll
            for (int i = 0; i < 16; ++i) ss += xk[i] * xk[i];
            ss += __shfl_xor(ss, 1); ss += __shfl_xor(ss, 2);
            const float rs = rsqrtf(ss * (1.0f / 64.0f) + 1e-6f);
#pragma unroll
            for (int i = 0; i < 16; ++i) xk[i] *= rs * gk[seg * 16 + i];
            if (loc) { const int pos = seg < 2 ? kr : key;
#pragma unroll
                for (int i = 0; i < 16; ++i) { const float pr = __shfl_xor(xk[i], 1); const float cs = cosT[pos * 16 + i], sn = sinT[pos * 16 + i]; xk[i] = (seg & 1) ? (xk[i] * cs + pr * sn) : (xk[i] * cs - pr * sn); } }
            LAS bf16_t* kd = Kt + (hh2 * 64 + key) * 72 + seg * 16;
            *(LAS u32x4*)kd = pack8(xk); *(LAS u32x4*)(kd + 8) = pack8(xk + 8);
        }
        {
            const int hh2 = pf_hh2, seg = pf_vseg, key = pf_vkey;
            const u32x4 a = pv0, c = pv1;
            LAS bf16_t* vd = Vt + (hh2 * 64 + seg * 16) * 72 + key;
            vd[0 * 72] = (bf16_t)(a.x & 0xffff); vd[1 * 72] = (bf16_t)(a.x >> 16); vd[2 * 72] = (bf16_t)(a.y & 0xffff); vd[3 * 72] = (bf16_t)(a.y >> 16);
            vd[4 * 72] = (bf16_t)(a.z & 0xffff); vd[5 * 72] = (bf16_t)(a.z >> 16); vd[6 * 72] = (bf16_t)(a.w & 0xffff); vd[7 * 72] = (bf16_t)(a.w >> 16);
            vd[8 * 72] = (bf16_t)(c.x & 0xffff); vd[9 * 72] = (bf16_t)(c.x >> 16); vd[10 * 72] = (bf16_t)(c.y & 0xffff); vd[11 * 72] = (bf16_t)(c.y >> 16);
            vd[12 * 72] = (bf16_t)(c.z & 0xffff); vd[13 * 72] = (bf16_t)(c.z >> 16); vd[14 * 72] = (bf16_t)(c.w & 0xffff); vd[15 * 72] = (bf16_t)(c.w >> 16);
        }
        if (Tn < ntot) { const size_t r0 = (Tn < nloc) ? (size_t)b * SEQ + (krU + Tn) * 64 : (size_t)NLAT + b * CTXL + (Tn - nloc) * 64;
            const bf16_t* kp = P + (r0 + pf_key) * PW + C_CK + pf_h2 * 64 + pf_seg * 16; pk0 = *(const u32x4*)kp; pk1 = *(const u32x4*)(kp + 8);
            const bf16_t* vp = P + (r0 + pf_vkey) * PW + C_CV + pf_h2 * 64 + pf_vseg * 16; pv0 = *(const u32x4*)vp; pv1 = *(const u32x4*)(vp + 8); }
        __syncthreads();
#pragma unroll
        for (int qi = 0; qi < 2; ++qi) {
            if (loc && (kr < kq0[qi] || kr >= kq0[qi] + 8)) continue;
            f32x4 st[4];
#pragma unroll
            for (int g = 0; g < 4; ++g) { const bool use = !loc || (g >= glo && g <= ghi);
                st[g] = (f32x4){0.f, 0.f, 0.f, 0.f};
                if (use) {
#pragma unroll
                    for (int ks = 0; ks < 2; ++ks) st[g] = mfma16(*(const LAS bf16x8*)(Kt + (hh * 64 + g * 16 + l16) * 72 + ks * 32 + q4 * 8), loc ? qrt[qi][ks] : qpl[qi][ks], st[g]);
                    if (loc) { const int dr31 = (kr - rq[qi] + 7) * 31;
#pragma unroll
                        for (int j = 0; j < 4; ++j) { const float sv = st[g][j] + rpbL[bidx[g][j] + dr31]; st[g][j] = ((mbits >> (g * 4 + j)) & 1u) ? -1e30f : sv; } }
                } else st[g] = (f32x4){-1e30f, -1e30f, -1e30f, -1e30f};
            }
            float tmax = -1e30f;
#pragma unroll
            for (int g = 0; g < 4; ++g)
#pragma unroll
                for (int j = 0; j < 4; ++j) tmax = fmaxf(tmax, st[g][j]);
            tmax = fmaxf(tmax, __shfl_xor(tmax, 16)); tmax = fmaxf(tmax, __shfl_xor(tmax, 32));
            const float mnew = fmaxf(mrun[qi], tmax); const float alpha = __expf(mrun[qi] - mnew); mrun[qi] = mnew;
            float psum = 0.f;
#pragma unroll
            for (int g = 0; g < 4; ++g) { const bool use = !loc || (g >= glo && g <= ghi);
                if (use) {
#pragma unroll
                    for (int j = 0; j < 4; ++j) { const float pv = __expf(st[g][j] - mnew); st[g][j] = pv; psum += pv; }
                } else st[g] = (f32x4){0.f, 0.f, 0.f, 0.f}; }
            lsum[qi] = lsum[qi] * alpha + psum;
#pragma unroll
            for (int i = 0; i < 4; ++i) O[qi][i] *= alpha;
            bf16x8 pb[2];
#pragma unroll
            for (int ks = 0; ks < 2; ++ks) { u32x4 wv; wv.x = pack2(st[2 * ks][0], st[2 * ks][1]); wv.y = pack2(st[2 * ks][2], st[2 * ks][3]); wv.z = pack2(st[2 * ks + 1][0], st[2 * ks + 1][1]); wv.w = pack2(st[2 * ks + 1][2], st[2 * ks + 1][3]); pb[ks] = as_bf16x8(wv); }
#pragma unroll
            for (int ks = 0; ks < 2; ++ks) if (!loc || (2 * ks + 1 >= glo && 2 * ks <= ghi))
#pragma unroll
                for (int dg = 0; dg < 4; ++dg) { const LAS bf16_t* vr = Vt + (hh * 64 + dg * 16 + l16) * 72 + ks * 32 + q4 * 4;
                    const u32x2 lo = *(const LAS u32x2*)vr, hi = *(const LAS u32x2*)(vr + 16); u32x4 av; av.x = lo.x; av.y = lo.y; av.z = hi.x; av.w = hi.y;
                    O[qi][dg] = mfma16(as_bf16x8(av), pb[ks], O[qi][dg]); }
        }
        __syncthreads();
    }
    }
#pragma unroll
    for (int qi = 0; qi < 2; ++qi) {
        float ls = lsum[qi]; ls += __shfl_xor(ls, 16); ls += __shfl_xor(ls, 32);
        const float inv = 1.0f / ls;
        bf16_t* op = dry ? ((bf16_t*)(PF(ws) + WS_DUMMY) + (size_t)(blockIdx.x & 63) * 16384 + (size_t)((qi * 8 + w) * 16 + l16) * 64) : (P + (qrow0[qi] + qc) * PW + C_CQ + h * 64);
#pragma unroll
        for (int dg = 0; dg < 4; ++dg) { u32x2 wv; wv.x = pack2(O[qi][dg][0] * inv, O[qi][dg][1] * inv); wv.y = pack2(O[qi][dg][2] * inv, O[qi][dg][3] * inv); *(u32x2*)(op + dg * 16 + q4 * 4) = wv; }
    }
    __syncthreads();
}

__device__ __forceinline__ void hgrn_stage(const bf16_t* P, LAS unsigned char* lds, int w, int lane, size_t row0, int dir, int h) {
#pragma unroll
    for (int i = 0; i < 2; ++i) { const int blk = i * 8 + w; const int t = blk * 4 + (lane >> 4); const bf16_t* rp = P + (row0 + (dir ? 63 - t : t)) * PW + (lane & 15) * 8;
        __builtin_amdgcn_global_load_lds((const unsigned*)(rp + C_BQ + h * 128), (LAS unsigned*)(lds + 118784 + blk * 1024), 16, 0, 0);
        __builtin_amdgcn_global_load_lds((const unsigned*)(rp + C_BF + dir * 512 + h * 128), (LAS unsigned*)(lds + 135168 + blk * 1024), 16, 0, 0); }
}
__device__ __forceinline__ void hgrn_chain(const Params& p, int l, LAS unsigned char* lds, int chain, int dry = 0) {
    LAS bf16_t* Q0 = (LAS bf16_t*)lds;
    LAS bf16_t* KP = (LAS bf16_t*)(lds + 17408);
    LAS bf16_t* SB = (LAS bf16_t*)(lds + 34816);
    LAS bf16_t* KDT = (LAS bf16_t*)(lds + 69632);
    LAS bf16_t* VT = (LAS bf16_t*)(lds + 88064);
    LAS bf16_t* ATT = (LAS bf16_t*)(lds + 106496);
    LAS float* TOT = (LAS float*)(lds + 115712);
    LAS float* DD = (LAS float*)(lds + 117760);
    const LAS bf16_t* SQ = (const LAS bf16_t*)(lds + 118784);
    const LAS bf16_t* SF = (const LAS bf16_t*)(lds + 135168);
    bf16_t* P = (bf16_t*)(PF(ws) + WS_P);
    const int tid = tid_(), w = __builtin_amdgcn_readfirstlane(tid >> 6), lane = tid & 63, l16 = lane & 15, q4 = lane >> 4;
    const int dir = chain & 1, h = (chain >> 1) & 3, b = chain >> 3;
    const int d = tid & 127, sb = tid >> 7;
    float lbv = 0.f;
    if (l > 0) { const float x0 = PF(hg_lb)[(dir * 2 + 0) * 512 + h * 128 + d], x1 = PF(hg_lb)[(dir * 2 + 1) * 512 + h * 128 + d]; lbv = 1.0f / (1.0f + expf(x0 - x1)); }
    for (int i = tid; i < 64 * 72 / 2; i += 512) ((LAS unsigned*)ATT)[i] = 0u;
    f32x4 S[8];
#pragma unroll
    for (int i = 0; i < 8; ++i) S[i] = (f32x4){0.f, 0.f, 0.f, 0.f};
    { const int gch0 = dir == 0 ? 0 : 3; hgrn_stage(P, lds, w, lane, (size_t)NLAT + b * CTXL + gch0 * 64, dir, h); }
    asm volatile("s_waitcnt vmcnt(0)" ::: "memory");
    __syncthreads();
    for (int ci = 0; ci < 36; ++ci) {
        const int gch = dir == 0 ? ci : (ci < 4 ? 3 - ci : 39 - ci);
        const bool isctx = gch < 4; const int chunk = isctx ? gch : gch - 4;
        const size_t row0 = isctx ? (size_t)NLAT + b * CTXL + chunk * 64 : (size_t)b * SEQ + chunk * 64;
        float bl[16], qv[16], kv[16]; float run = 0.f;
        {
            unsigned vraw[16];
#pragma unroll
            for (int ii = 0; ii < 16; ++ii) { const int t = sb * 16 + ii; vraw[ii] = P[(row0 + (dir ? 63 - t : t)) * PW + C_BI + h * 128 + d]; }
#pragma unroll
            for (int eg = 0; eg < 8; ++eg) { u32x2 wv; wv.x = pack2(S[eg][0], S[eg][1]); wv.y = pack2(S[eg][2], S[eg][3]); *(LAS u32x2*)(SB + (eg * 16 + l16) * 136 + w * 16 + q4 * 4) = wv; }
#pragma unroll
            for (int ii = 0; ii < 16; ++ii) { const int t = sb * 16 + ii;
                const float fr = bf2f(SF[t * 128 + d]), qr = bf2f(SQ[t * 128 + d]);
                const float sg = 1.0f / (1.0f + __expf(-fr)); const float f = lbv + (1.0f - lbv) * sg; run += __logf(f); bl[ii] = run; kv[ii] = 1.0f - f; qv[ii] = qr / (1.0f + __expf(-qr)); }
            TOT[sb * 128 + d] = run;
            u32x4 v0, v1; v0.x = vraw[0] | (vraw[1] << 16); v0.y = vraw[2] | (vraw[3] << 16); v0.z = vraw[4] | (vraw[5] << 16); v0.w = vraw[6] | (vraw[7] << 16);
            v1.x = vraw[8] | (vraw[9] << 16); v1.y = vraw[10] | (vraw[11] << 16); v1.z = vraw[12] | (vraw[13] << 16); v1.w = vraw[14] | (vraw[15] << 16);
            *(LAS u32x4*)(VT + d * 72 + sb * 16) = v0; *(LAS u32x4*)(VT + d * 72 + sb * 16 + 8) = v1;
        }
        __syncthreads();
        if (ci < 35) { const int cn = ci + 1; const int gn = dir == 0 ? cn : (cn < 4 ? 3 - cn : 39 - cn); const bool cx = gn < 4; const int ck = cx ? gn : gn - 4;
            hgrn_stage(P, lds, w, lane, cx ? (size_t)NLAT + b * CTXL + ck * 64 : (size_t)b * SEQ + ck * 64, dir, h); }
        {
            const float t0 = TOT[d], t1 = TOT[128 + d], t2 = TOT[256 + d], t3 = TOT[384 + d];
            const float Bs1 = t0, Bs2 = t0 + t1, Bs3 = Bs2 + t2, total = Bs3 + t3;
            const float Bsb = sb == 0 ? 0.f : (sb == 1 ? Bs1 : (sb == 2 ? Bs2 : Bs3));
            const float eB = __expf(Bsb), eT = __expf(total);
            float kd[16];
#pragma unroll
            for (int ii = 0; ii < 16; ++ii) { const float e0 = __expf(bl[ii]); Q0[(sb * 16 + ii) * 136 + d] = (bf16_t)pack2(qv[ii] * e0 * eB, 0.f);
                const float kp = kv[ii] * __expf(fminf(-(Bsb + bl[ii]), 80.f)); KP[(sb * 16 + ii) * 136 + d] = (bf16_t)pack2(kp, 0.f); kd[ii] = kp * eT; }
            *(LAS u32x4*)(KDT + d * 72 + sb * 16) = pack8(kd); *(LAS u32x4*)(KDT + d * 72 + sb * 16 + 8) = pack8(kd + 8);
            if (sb == 0) DD[d] = eT;
        }
        __syncthreads();
#pragma unroll
        for (int k2 = 0; k2 < 2; ++k2) { const int idx = w + 8 * k2;
            if (idx < 10) { const int i = idx < 1 ? 0 : (idx < 3 ? 1 : (idx < 6 ? 2 : 3)); const int j = idx - i * (i + 1) / 2;
                f32x4 sc = (f32x4){0.f, 0.f, 0.f, 0.f};
                const LAS bf16_t* qb = Q0 + (i * 16 + l16) * 136 + q4 * 8; const LAS bf16_t* kb = KP + (j * 16 + l16) * 136 + q4 * 8;
#pragma unroll
                for (int ks = 0; ks < 4; ++ks) sc = mfma16(*(const LAS bf16x8*)(qb + ks * 32), *(const LAS bf16x8*)(kb + ks * 32), sc);
#pragma unroll
                for (int jj = 0; jj < 4; ++jj) { const float v = (i == j && l16 > q4 * 4 + jj) ? 0.f : sc[jj]; ATT[(i * 16 + q4 * 4 + jj) * 72 + j * 16 + l16] = (bf16_t)pack2(v, 0.f); } } }
        __syncthreads();
        {
            bf16x8 SBf[4], VTf[2];
#pragma unroll
            for (int ks = 0; ks < 4; ++ks) SBf[ks] = *(const LAS bf16x8*)(SB + (w * 16 + l16) * 136 + ks * 32 + q4 * 8);
#pragma unroll
            for (int ks = 0; ks < 2; ++ks) VTf[ks] = *(const LAS bf16x8*)(VT + (w * 16 + l16) * 72 + ks * 32 + q4 * 8);
#pragma unroll
            for (int i = 0; i < 4; ++i) { f32x4 oa = (f32x4){0.f, 0.f, 0.f, 0.f};
#pragma unroll
                for (int ks = 0; ks < 4; ++ks) oa = mfma16(SBf[ks], *(const LAS bf16x8*)(Q0 + (i * 16 + l16) * 136 + ks * 32 + q4 * 8), oa);
#pragma unroll
                for (int ks = 0; ks < 2; ++ks) oa = mfma16(VTf[ks], *(const LAS bf16x8*)(ATT + (i * 16 + l16) * 72 + ks * 32 + q4 * 8), oa);
                const int t = i * 16 + l16; u32x2 wv; wv.x = pack2(oa[0], oa[1]); wv.y = pack2(oa[2], oa[3]);
                bf16_t* od = dry ? ((bf16_t*)(PF(ws) + WS_DUMMY) + (size_t)chain * 8192 + t * 128 + w * 16 + q4 * 4) : (P + (row0 + (dir ? 63 - t : t)) * PW + C_BF + dir * 512 + h * 128 + w * 16 + q4 * 4);
                *(u32x2*)od = wv; }
        }
        {
            const f32x4 dd = *(const LAS f32x4*)(DD + w * 16 + q4 * 4);
#pragma unroll
            for (int eg = 0; eg < 8; ++eg) S[eg] *= dd;
#pragma unroll
            for (int ks = 0; ks < 2; ++ks) { const bf16x8 A = *(const LAS bf16x8*)(KDT + (w * 16 + l16) * 72 + ks * 32 + q4 * 8);
#pragma unroll
                for (int eg = 0; eg < 8; ++eg) S[eg] = mfma16(A, *(const LAS bf16x8*)(VT + (eg * 16 + l16) * 72 + ks * 32 + q4 * 8), S[eg]); }
        }
        asm volatile("s_waitcnt vmcnt(0)" ::: "memory");
        __syncthreads();
    }
}

__global__ void __launch_bounds__(512, 2) fwd_megakernel(Params p) {
    extern __shared__ __attribute__((aligned(16))) unsigned char lds_raw[];
    LAS unsigned char* lds = (LAS unsigned char*)lds_raw;
    cg::grid_group grid = cg::this_grid();
    volatile LAS unsigned* xst = (volatile LAS unsigned*)(lds + LDS_BYTES - 16);
    if (threadIdx.x == 0) { xst[0] = 0u; xst[1] = 0u; xst[2] = 0u; xst[3] = 0u; }
    __syncthreads();
    const XcdBarrier xbar = xcd_barrier_post((unsigned*)(PF(ws) + WS_BAR), xst);
    const int G = gridDim.x, c = blockIdx.x;

    phase_mod(p, lds); __syncthreads();
    phase_rope(p);
    phase_convert(p, 0, lds);
    grid.sync();
#define WSP(T, off) ((T*)(PF(ws) + (off)))
    for (int l = 0; l < 2; ++l) {
        const bool lastl = (l == 1);
        const int Mrest = lastl ? NLAT : NTOK;
        if (l > 0) phase_convert(p, l, lds);
        phase_norm(p, l, l == 0 ? PF(x) : PF(out), l == 0 ? PF(ctx) : WSP(const float, WS_HC), PF(norm1_g) + l * DM, 0, NTOK,
                   (l > 0 && G == 256) ? (const float*)(PF(ws) + WS_P + (size_t)NTOK * DFF * 2) : nullptr, WSP(const float, WS_MOD) + (size_t)((l > 0 ? l - 1 : 0) * 9 + 8) * 6144 + 5120);
        xcd_barrier(xbar);

        { pg8::Gemm g{WSP(bf16_t, WS_U), WSP(bf16_t, WS_WIN), DM, DM, DM}; pg8::Sched S; S.init(NTOK, PW, G, c, DM, DM); pg8::EpiStore<0> E{WSP(bf16_t, WS_P), PW}; pg8::gemm_phase(lds, g, S, E); }
        xcd_barrier(xbar);
        if (c < 64) { hgrn_chain(p, l, lds, c); sub_barrier((unsigned*)(PF(ws) + WS_BAR) + 3520 + 64 * (2 * l), 64u); phase_hg_final(p, l, NTOK, c, 64); }
        else { const int cc = c - 64, GG = G - 64; const int nA = lastl ? 512 : 576;
            for (int it = cc; it < nA; it += GG) attn_item(p, l, lds, it);
            int staged = -1;
            for (int it = cc; it < 2304; it += GG) lru_tile(p, l, lds, it, 0, staged);
            sub_barrier((unsigned*)(PF(ws) + WS_BAR) + 3520 + 64 * (2 * l + 1), (unsigned)GG);
            for (int it = cc; it < 2304; it += GG) lru_tile(p, l, lds, it, 1, staged); }
        xcd_barrier(xbar);
        { pg8::Gemm g{WSP(bf16_t, WS_U), WSP(bf16_t, WS_WIN) + (size_t)PW * DM, DM, DM, DM}; pg8::Sched S; S.init(Mrest, 3072, G, c, DM, DM); pg8::EpiStore<1> E{WSP(bf16_t, WS_P), PW}; pg8::gemm_phase(lds, g, S, E); }
        xcd_barrier(xbar);
        { pg8::Gemm g{WSP(bf16_t, WS_P), WSP(bf16_t, WS_WB), PW, 512, 512}; pg8::MergeSched S; S.base.init(Mrest, DM, G, c, PW, 512);
          pg8::EpiMerge E{WSP(bf16_t, WS_P), WSP(bf16_t, WS_U)}; pg8::gemm_phase(lds, g, S, E); }
        xcd_barrier(xbar);
        { pg8::Gemm g{WSP(bf16_t, WS_U), WSP(bf16_t, WS_WO), DM, DM, DM};
          pg8::EpiResid E{l == 0 ? PF(x) : PF(out), l == 0 ? PF(ctx) : WSP(const float, WS_HC), PF(out), WSP(float, WS_HC), WSP(const float, WS_MOD) + (size_t)l * 9 * 6144 + 2048, WSP(float, WS_P)};
          if (!lastl && G == 256) { pg8::SplitSched S; S.base.init(NLAT, DM, G, c, DM, DM); S.sk = 256; pg8::gemm_phase(lds, g, S, E); }
          else { pg8::Sched S; S.init(Mrest, DM, G, c, DM, DM); pg8::gemm_phase(lds, g, S, E); } }
        xcd_barrier(xbar);
        if (!lastl && G == 256) phase_norm(p, l, PF(out), l == 0 ? PF(ctx) : WSP(const float, WS_HC), PF(norm2_g) + l * DM, 3072, Mrest, WSP(const float, WS_P), WSP(const float, WS_MOD) + (size_t)(l * 9 + 8) * 6144 + 2048, WSP(float, WS_HC));
        else phase_norm(p, l, PF(out), WSP(const float, WS_HC), PF(norm2_g) + l * DM, 3072, Mrest);
        xcd_barrier(xbar);
        { pg8::Gemm g{WSP(bf16_t, WS_U), WSP(bf16_t, WS_W1), DM, DM, DM}; pg8::Sched S; S.init(Mrest, DFF, G, c, DM, DM); pg8::EpiStore<2> E{WSP(bf16_t, WS_P), DFF}; pg8::gemm_phase(lds, g, S, E); }
        xcd_barrier(xbar);
        { pg8::Gemm g{WSP(bf16_t, WS_P), WSP(bf16_t, WS_W2), DFF, DFF, DFF};
          float* slab = (float*)(PF(ws) + WS_P + (size_t)NTOK * DFF * 2);
          pg8::EpiResid E{PF(out), WSP(const float, WS_HC), PF(out), WSP(float, WS_HC), WSP(const float, WS_MOD) + (size_t)l * 9 * 6144 + 5120, slab};
          if (!lastl && G == 256) { pg8::SplitSched S; S.base.init(NLAT, DM, G, c, DFF, DFF); S.sk = 1024; pg8::gemm_phase(lds, g, S, E); }
          else { pg8::Sched S; S.init(Mrest, DM, G, c, DFF, DFF); pg8::gemm_phase(lds, g, S, E); } }
        if (!lastl) xcd_barrier(xbar);
    }
}

extern "C" void kernel_launch(void* const* d_in, const int* in_sizes, int n_in, void* d_out, int out_size, void* d_ws, size_t ws_size, hipStream_t stream) {
    static int grid_blocks = 0;
    if (grid_blocks == 0) {
        int dev = 0, cus = 0, per_cu = 0;
        hipGetDevice(&dev);
        hipDeviceGetAttribute(&cus, hipDeviceAttributeMultiprocessorCount, dev);
        hipFuncSetAttribute((const void*)fwd_megakernel, hipFuncAttributeMaxDynamicSharedMemorySize, LDS_BYTES);
        hipOccupancyMaxActiveBlocksPerMultiprocessor(&per_cu, (const void*)fwd_megakernel, 512, LDS_BYTES);
        if (per_cu < 1 || n_in != 25 || ws_size < WS_END) { fprintf(stderr, "kernel_launch: cannot launch (per_cu %d, n_in %d, ws %zu need %zu)\n", per_cu, n_in, ws_size, (size_t)WS_END); grid_blocks = -1; }
        else grid_blocks = cus;
    }
    if (grid_blocks < 0) return;
    hipMemsetAsync((char*)d_ws + WS_BAR, 0, 16384, stream);
    Params p{};
    const float** pp = (const float**)&p;
    for (int i = 0; i < 25; ++i) pp[i] = (const float*)d_in[i];
    p.out = (float*)d_out; p.ws = (unsigned char*)d_ws;
    void* args[] = {&p};
    hipError_t e = hipLaunchCooperativeKernel((const void*)fwd_megakernel, dim3(grid_blocks), dim3(512), args, LDS_BYTES, stream);
    if (e != hipSuccess) fprintf(stderr, "cooperative launch failed: %s (grid %d)\n", hipGetErrorString(e), grid_blocks);
}
```

```cpp
#include <hip/hip_runtime.h>
#include <hip/hip_cooperative_groups.h>
#include <stdint.h>
#include <stdio.h>
namespace cg = cooperative_groups;

#define LAS __attribute__((address_space(3)))
typedef unsigned short bf16_t;
typedef short bf16x8 __attribute__((ext_vector_type(8)));
typedef float f32x4 __attribute__((ext_vector_type(4)));
typedef unsigned u32x4 __attribute__((ext_vector_type(4)));
typedef unsigned u32x2 __attribute__((ext_vector_type(2)));

constexpr int DM = 1024, NB = 8, SEQ = 2048, CTXL = 256, NLAT = NB * SEQ, NCTX = NB * CTXL, NTOK = NLAT + NCTX;
constexpr int PW = 5120, DIN = 8192, DFF = 4096;
constexpr int C_AX = 0, C_AG = 512, C_BQ = 1024, C_BF = 1536, C_BI = 2560, C_BO = 3072, C_CQ = 3584, C_CK = 4096, C_CV = 4608;
constexpr int LDS_BYTES = 163840;
constexpr size_t WS_WIN = 0;
constexpr size_t WS_WB = WS_WIN + (size_t)DIN * DM * 2;
constexpr size_t WS_WO = WS_WB + (size_t)3 * DM * 512 * 2;
constexpr size_t WS_W1 = WS_WO + (size_t)DM * DM * 2;
constexpr size_t WS_W2 = WS_W1 + (size_t)DFF * DM * 2;
constexpr size_t WS_U = WS_W2 + (size_t)DM * DFF * 2;
constexpr size_t WS_P = WS_U + (size_t)NTOK * DM * 2;
constexpr size_t WS_HC = WS_P + (size_t)NTOK * PW * 2;
constexpr size_t WS_MOD = WS_HC + (size_t)NCTX * DM * 4;
constexpr size_t WS_AGG = WS_MOD + (size_t)2 * 9 * 6144 * 4;
constexpr size_t WS_ROPE = WS_AGG + (size_t)NB * 36 * 2 * 2 * 512 * 4;
constexpr size_t WS_DUMMY = WS_ROPE + 2048 * 4;
constexpr size_t WS_BAR = WS_DUMMY + (2u << 20);
constexpr size_t WS_END = WS_BAR + 16384;

struct Params {
    const float *x, *c, *ctx, *c_ctx, *ada_w, *ada_b, *norm1_g, *norm2_g, *w_in, *conv_w, *conv_b, *lru_wa, *lru_ba, *lru_wx, *lru_bx, *lru_lambda,
        *hg_lb, *hg_norm_g, *na_qg, *na_kg, *na_rpb, *w_branch, *w_out, *ffn_w1, *ffn_w2;
    float* out; unsigned char* ws;
};


__device__ __forceinline__ unsigned long long ldkarg(int off) { unsigned long long v = 0;
#if defined(__HIP_DEVICE_COMPILE__)
    auto kp = __builtin_amdgcn_kernarg_segment_ptr();
    asm volatile("s_load_dwordx2 %0, %1, %2\n\ts_waitcnt lgkmcnt(0)" : "=s"(v) : "s"(kp), "s"(off));
#endif
    return v; }
template <class T> struct rm_ptr; template <class T> struct rm_ptr<T*> { typedef T type; };
template <class T> __device__ __forceinline__ T* as_global_ptr(unsigned long long v) { return (T*)(__attribute__((address_space(1))) T*)v; }
#define PF(f) (as_global_ptr<rm_ptr<decltype(Params::f)>::type>(ldkarg((int)__builtin_offsetof(Params, f))))

#define GAS __attribute__((address_space(1)))
template <class T> __device__ __forceinline__ GAS T* lnd(T* p) { asm volatile("" : "+v"(p)); return (GAS T*)p; }
__device__ __forceinline__ int tid_() { int t = threadIdx.x; asm volatile("" : "+v"(t)); return t; }
__device__ __forceinline__ float bf2f(unsigned v) { return __uint_as_float(v << 16); }
__device__ __forceinline__ float bflo(unsigned w) { return __uint_as_float(w << 16); }
__device__ __forceinline__ float bfhi(unsigned w) { return __uint_as_float(w & 0xffff0000u); }
__device__ __forceinline__ unsigned f2bf(float f) { unsigned u = __float_as_uint(f); u += 0x7fffu + ((u >> 16) & 1u); return u >> 16; }
typedef __bf16 bf16x2_t __attribute__((ext_vector_type(2)));
typedef float f32x2_t __attribute__((ext_vector_type(2)));
__device__ __forceinline__ unsigned pack2(float lo, float hi) { f32x2_t v = {lo, hi}; bf16x2_t b = __builtin_convertvector(v, bf16x2_t); union { bf16x2_t b; unsigned u; } t; t.b = b; return t.u; }
__device__ __forceinline__ float sigmoidf_(float x) { return 1.0f / (1.0f + __expf(-x)); }
__device__ __forceinline__ f32x4 mfma16(bf16x8 a, bf16x8 b, f32x4 c) { return __builtin_amdgcn_mfma_f32_16x16x32_bf16(a, b, c, 0, 0, 0); }
__device__ __forceinline__ bf16x8 as_bf16x8(u32x4 v) { union { u32x4 u; bf16x8 b; } t; t.u = v; return t.b; }
__device__ __forceinline__ void unpack8(u32x4 w, float* o) { o[0] = bflo(w.x); o[1] = bfhi(w.x); o[2] = bflo(w.y); o[3] = bfhi(w.y); o[4] = bflo(w.z); o[5] = bfhi(w.z); o[6] = bflo(w.w); o[7] = bfhi(w.w); }
__device__ __forceinline__ u32x4 pack8(const float* v) { u32x4 w; w.x = pack2(v[0], v[1]); w.y = pack2(v[2], v[3]); w.z = pack2(v[4], v[5]); w.w = pack2(v[6], v[7]); return w; }

namespace pg8 {
constexpr int BM = 256, BK = 64, HALF = 128, HTB = HALF * BK * 2, NXCD = 8, WGM = 4;
__device__ __forceinline__ int lds_byte(int r, int c) { const int st = (r >> 4) * 2 + (c >> 5), rr = r & 15, cc = c & 31, ob = rr * 64 + cc * 2; return st * 1024 + (ob ^ (((ob >> 9) & 1) << 5)); }
__device__ __forceinline__ void stage_rc(int b, int& R, int& C) { const int st = b / 1024, sb = b % 1024, swz = sb ^ (((sb >> 9) & 1) << 5); R = (st >> 1) * 16 + swz / 64; C = (st & 1) * 32 + (swz % 64) / 2; }
__device__ __forceinline__ int perm32(int rho) { const int n = rho >> 4, i = rho & 15; return 8 * (i >> 2) + 4 * n + (i & 3); }

struct Unit { int pm, pn, sub, nt; size_t aoff, boff; };
struct Gemm { const bf16_t* A; const bf16_t* Bt; int lda, ldb, K; };
struct Sched {
    int nM, nN, nwg, G, c, lda, ldb, nt;
    __device__ void init(int M, int N, int G_, int c_, int lda_, int ldb_) { nM = M / BM; nN = N / BM; nwg = nM * nN; G = G_; c = c_; lda = lda_; ldb = ldb_; nt = 0; }
    __device__ bool next(int i, Unit& u) const {
        const long L = (long)i * G + c; if (L >= nwg) return false;
        int wgid = (int)L; { const int q = nwg / NXCD, r = nwg % NXCD, xcd = wgid % NXCD, off = wgid / NXCD; wgid = (xcd < r ? xcd * (q + 1) : r * (q + 1) + (xcd - r) * q) + off; }
        const int nig = WGM * nN, gid = wgid / nig, fm = gid * WGM, gsz = (nM - fm) < WGM ? (nM - fm) : WGM;
        u.pm = fm + ((wgid % nig) % gsz); u.pn = (wgid % nig) / gsz; u.sub = 0; u.nt = nt;
        u.aoff = (size_t)u.pm * BM * lda * 2;
        u.boff = (size_t)u.pn * BM * ldb * 2;
        return true;
    }
};

template <int ACT> struct EpiStore {
    static constexpr bool PERM = true;
    bf16_t* O; int ldc;
    __device__ __forceinline__ void operator()(const f32x4 (&acc)[2][2][4][2], const Unit& u, int wr, int wc, int fr, int fq) const {
        const int row0 = u.pm * BM + wr * 64 + fr; int colt = u.pn * BM;
        if (ACT == 1) colt = (colt < 2048) ? (1024 + colt) : (2048 + colt);
        const int col0 = colt + wc * 32 + 8 * fq;
#pragma unroll
        for (int ai = 0; ai < 2; ++ai)
#pragma unroll
            for (int m = 0; m < 4; ++m) { GAS bf16_t* rowp = lnd(O + (size_t)(row0 + ai * HALF + m * 16) * ldc + col0);
#pragma unroll
                for (int bj = 0; bj < 2; ++bj) { f32x4 v0 = acc[ai][bj][m][0], v1 = acc[ai][bj][m][1];
                    if (ACT == 1) {
#pragma unroll
                        for (int j = 0; j < 4; ++j) { v0[j] = sigmoidf_(v0[j]); v1[j] = sigmoidf_(v1[j]); } }
                    if (ACT == 2) {
#pragma unroll
                        for (int j = 0; j < 4; ++j) { float a = fmaxf(v0[j], 0.f), b = fmaxf(v1[j], 0.f); v0[j] = a * a; v1[j] = b * b; } }
                    u32x4 w; w.x = pack2(v0[0], v0[1]); w.y = pack2(v0[2], v0[3]); w.z = pack2(v1[0], v1[1]); w.w = pack2(v1[2], v1[3]);
                    *(GAS u32x4*)(rowp + bj * HALF) = w; } }
    }
};
struct EpiMerge {
    static constexpr bool PERM = true;
    const bf16_t* P; bf16_t* U;
    __device__ __forceinline__ void operator()(const f32x4 (&acc)[2][2][4][2], const Unit& u, int wr, int wc, int fr, int fq) const {
        const int row0 = u.pm * BM + wr * 64 + fr; const int col0 = u.pn * BM + wc * 32 + 8 * fq;
        const int sub = u.sub; const int gcol = sub * 1024 + u.pn * BM; const int gd = ((gcol < 2048) ? (1024 + gcol) : (2048 + gcol)) + wc * 32 + 8 * fq;
        const bool addp = sub > 0;
#pragma unroll
        for (int ai = 0; ai < 2; ++ai)
#pragma unroll
            for (int m = 0; m < 4; ++m) { const size_t row = (size_t)(row0 + ai * HALF + m * 16); const GAS bf16_t* gp = lnd(P + row * PW + gd); GAS bf16_t* up = lnd(U + row * DM + col0);
#pragma unroll
                for (int bj = 0; bj < 2; ++bj) { const u32x4 gw = *(const GAS u32x4*)(gp + bj * HALF);
                    f32x4 a0 = acc[ai][bj][m][0], a1 = acc[ai][bj][m][1];
                    a0[0] *= bflo(gw.x); a0[1] *= bfhi(gw.x); a0[2] *= bflo(gw.y); a0[3] *= bfhi(gw.y); a1[0] *= bflo(gw.z); a1[1] *= bfhi(gw.z); a1[2] *= bflo(gw.w); a1[3] *= bfhi(gw.w);
                    if (addp) { const u32x4 pw = *(const GAS u32x4*)(up + bj * HALF);
                        a0[0] += bflo(pw.x); a0[1] += bfhi(pw.x); a0[2] += bflo(pw.y); a0[3] += bfhi(pw.y); a1[0] += bflo(pw.z); a1[1] += bfhi(pw.z); a1[2] += bflo(pw.w); a1[3] += bfhi(pw.w); }
                    u32x4 o; o.x = pack2(a0[0], a0[1]); o.y = pack2(a0[2], a0[3]); o.z = pack2(a1[0], a1[1]); o.w = pack2(a1[2], a1[3]);
                    *(GAS u32x4*)(up + bj * HALF) = o; } }
    }
};
struct EpiResid {
    static constexpr bool PERM = true;
    const float* inL; const float* inC; float* outL; float* outC; const float* mod;
    float* slab;
    __device__ __forceinline__ void operator()(const f32x4 (&acc)[2][2][4][2], const Unit& u, int wr, int wc, int fr, int fq) const {
        if (u.sub >= 1) {
            const int row0 = (u.pm - 64) * BM + wr * 64 + fr, col0 = u.pn * BM + wc * 32 + 8 * fq; float* sl = slab + (size_t)(u.sub - 1) * NCTX * DM;
#pragma unroll
            for (int ai = 0; ai < 2; ++ai)
#pragma unroll
                for (int m = 0; m < 4; ++m)
#pragma unroll
                    for (int bj = 0; bj < 2; ++bj) { GAS float* op = lnd(sl + (size_t)(row0 + ai * HALF + m * 16) * DM + col0 + bj * HALF); *(GAS f32x4*)op = acc[ai][bj][m][0]; *(GAS f32x4*)(op + 4) = acc[ai][bj][m][1]; }
            return;
        }
        const bool lat = u.pm < 64; const int rbase = lat ? u.pm * BM : (u.pm - 64) * BM;
        const float* in = lat ? inL : inC; float* out = lat ? outL : outC;
        const int row0 = rbase + wr * 64 + fr, col0 = u.pn * BM + wc * 32 + 8 * fq;
        const float* gt = mod + (size_t)(lat ? (u.pm >> 3) : 8) * 6144 + col0;
#pragma unroll
        for (int bj = 0; bj < 2; ++bj) { const f32x4 g0 = *(const f32x4*)(gt + bj * HALF), g1 = *(const f32x4*)(gt + bj * HALF + 4);
#pragma unroll
            for (int ai = 0; ai < 2; ++ai)
#pragma unroll
                for (int m = 0; m < 4; ++m) { const size_t ro = (size_t)(row0 + ai * HALF + m * 16) * DM + col0 + bj * HALF;
                    const GAS float* ip = lnd(in + ro); GAS float* op = lnd(out + ro); const f32x4 i0 = *(const GAS f32x4*)ip, i1 = *(const GAS f32x4*)(ip + 4);
                    *(GAS f32x4*)op = i0 + g0 * acc[ai][bj][m][0]; *(GAS f32x4*)(op + 4) = i1 + g1 * acc[ai][bj][m][1]; } }
    }
};

struct MergeSched {
    Sched base;
    __device__ bool next(int i, Unit& u) const {
        const int r = i / 3, n = i - 3 * r;
        if (!base.next(r, u)) return false;
        u.sub = n; u.aoff += (size_t)(n == 0 ? C_AG : C_BO + (n - 1) * 512) * 2; u.boff += (size_t)n * DM * 512 * 2;
        return true;
    }
};
struct SplitSched {
    Sched base;
    int sk;
    __device__ bool next(int i, Unit& u) const {
        if (base.next(i, u)) return true;
        const int nfull = (base.nwg - base.c + base.G - 1) / base.G;
        const int k = i - nfull; const int un = k * base.G + base.c; if (k < 0 || un >= 128) return false;
        const int ct = un >> 2, sl = un & 3; u.pm = 64 + (ct >> 2); u.pn = ct & 3; u.sub = 1 + sl; u.nt = sk / BK;
        u.aoff = (size_t)u.pm * BM * base.lda * 2 + (size_t)sl * sk * 2; u.boff = (size_t)u.pn * BM * base.ldb * 2 + (size_t)sl * sk * 2;
        return true;
    }
};
template <class Epi, class Sch>
__device__ __forceinline__ void gemm_phase(LAS unsigned char* lds, const Gemm g, const Sch& S, const Epi& E) {
    const int tid = tid_(), wid = __builtin_amdgcn_readfirstlane(tid >> 6), lane = tid & 63, wr = wid >> 2, wc = wid & 3, fr = lane & 15, fq = lane >> 4;
    const int K = g.K;
    unsigned voffA[2], voffB[2];
#pragma unroll
    for (int i = 0; i < 2; ++i) { int R, C; stage_rc(tid * 16 + i * 8192, R, C); const int Rb = Epi::PERM ? ((R & ~31) + perm32(R & 31)) : R;
        voffA[i] = (unsigned)(R * g.lda + C) * 2u; voffB[i] = (unsigned)(Rb * g.ldb + C) * 2u; }
    const size_t kstep = (size_t)(BK * 2);
    const size_t hstepA = (size_t)HALF * g.lda * 2, hstepB = (size_t)HALF * g.ldb * 2;
    const unsigned ldsw = (unsigned)wid * 1024u;
    const int aoff = lds_byte(wr * 64 + fr, fq * 8), boff = lds_byte(wc * 32 + fr, fq * 8);
#define PG8_SA(b, h) (((b) * 2 + (h)) * HTB)
#define PG8_SB(b, h) ((4 + (b) * 2 + (h)) * HTB)
#define PG8_STAGE(bufoff, gbase, voff) do { _Pragma("unroll") for (int _i = 0; _i < 2; ++_i) \
        __builtin_amdgcn_global_load_lds((const unsigned*)((const char*)(gbase) + (voff)[_i]), (LAS unsigned*)(lds + (bufoff) + ldsw + _i * 8192), 16, 0, 0); } while (0)
#define PG8_LDA(dst, b, h) do { _Pragma("unroll") for (int m = 0; m < 4; ++m) _Pragma("unroll") for (int k = 0; k < 2; ++k) dst[m][k] = *(const LAS bf16x8*)(lds + PG8_SA(b, h) + aoff + m * 2048 + k * 1024); } while (0)
#define PG8_LDB(dst, b, h) do { _Pragma("unroll") for (int n = 0; n < 2; ++n) _Pragma("unroll") for (int k = 0; k < 2; ++k) dst[n][k] = *(const LAS bf16x8*)(lds + PG8_SB(b, h) + boff + n * 2048 + k * 1024); } while (0)
#define PG8_MMA(ai, bj, At, Bt) do { __builtin_amdgcn_s_setprio(1); _Pragma("unroll") for (int m = 0; m < 4; ++m) _Pragma("unroll") for (int n = 0; n < 2; ++n) _Pragma("unroll") for (int k = 0; k < 2; ++k) \
        acc[ai][bj][m][n] = __builtin_amdgcn_mfma_f32_16x16x32_bf16(Bt[n][k], At[m][k], acc[ai][bj][m][n], 0, 0, 0); __builtin_amdgcn_s_setprio(0); } while (0)
#define PG8_WAIT_V(n) asm volatile("s_waitcnt vmcnt(" #n ")" ::: "memory")
#define PG8_WAIT_L(n) asm volatile("s_waitcnt lgkmcnt(" #n ")" ::: "memory")
#define PG8_BAR __builtin_amdgcn_s_barrier()
#define PG8_SCHED __builtin_amdgcn_sched_barrier(0)
    Unit cur, nxt; int ui = 0;
    if (!S.next(0, cur)) return;
    f32x4 acc[2][2][4][2];
#pragma unroll
    for (int a = 0; a < 2; ++a)
#pragma unroll
        for (int b = 0; b < 2; ++b)
#pragma unroll
            for (int m = 0; m < 4; ++m)
#pragma unroll
                for (int n = 0; n < 2; ++n) acc[a][b][m][n] = (f32x4){0.f, 0.f, 0.f, 0.f};
    bf16x8 At[4][2], B0[2][2], B1[2][2];
    const char* cA = (const char*)g.A + cur.aoff; const char* cB = (const char*)g.Bt + cur.boff;
    PG8_STAGE(PG8_SB(0, 0), cB, voffB); PG8_STAGE(PG8_SB(0, 1), cB + hstepB, voffB); PG8_STAGE(PG8_SA(0, 0), cA, voffA); PG8_STAGE(PG8_SA(0, 1), cA + hstepA, voffA);
    if (wr == 1) PG8_BAR;
    PG8_WAIT_V(2); PG8_BAR;
    PG8_STAGE(PG8_SB(1, 0), cB + kstep, voffB); PG8_STAGE(PG8_SA(1, 0), cA + kstep, voffA); PG8_STAGE(PG8_SB(1, 1), cB + hstepB + kstep, voffB);
    PG8_WAIT_V(6); PG8_BAR;
    for (;;) {
        const bool has_next = S.next(ui + 1, nxt);
        const char* nA = has_next ? (const char*)g.A + nxt.aoff : cA; const char* nB = has_next ? (const char*)g.Bt + nxt.boff : cB;
        const int nt = cur.nt ? cur.nt : K / BK;
        for (int t = 0; t < nt; t += 2) {
            const bool last = (t == nt - 2);
            const char* a1 = cA + (size_t)(t + 1) * kstep;
            const char* a2 = last ? nA : cA + (size_t)(t + 2) * kstep; const char* b2 = last ? nB : cB + (size_t)(t + 2) * kstep;
            const char* a3 = a2 + kstep; const char* b3 = b2 + kstep;
            PG8_LDB(B0, 0, 0); PG8_LDB(B1, 0, 1); PG8_SCHED; PG8_LDA(At, 0, 0); PG8_STAGE(PG8_SA(1, 1), a1 + hstepA, voffA);
            PG8_WAIT_V(8); PG8_WAIT_L(0); PG8_BAR; PG8_MMA(0, 0, At, B0); PG8_MMA(0, 1, At, B1); PG8_BAR; PG8_SCHED;
            PG8_LDA(At, 0, 1); PG8_STAGE(PG8_SB(0, 0), b2, voffB); PG8_STAGE(PG8_SB(0, 1), b2 + hstepB, voffB); PG8_STAGE(PG8_SA(0, 0), a2, voffA);
            PG8_WAIT_V(8); PG8_WAIT_L(0); PG8_BAR; PG8_MMA(1, 0, At, B0); PG8_MMA(1, 1, At, B1); PG8_BAR; PG8_SCHED;
            PG8_LDB(B0, 1, 0); PG8_LDB(B1, 1, 1); PG8_SCHED; PG8_LDA(At, 1, 0); PG8_STAGE(PG8_SA(0, 1), a2 + hstepA, voffA);
            PG8_WAIT_V(8); PG8_WAIT_L(0); PG8_BAR; PG8_MMA(0, 0, At, B0); PG8_MMA(0, 1, At, B1); PG8_BAR; PG8_SCHED;
            PG8_LDA(At, 1, 1); PG8_STAGE(PG8_SB(1, 0), b3, voffB); PG8_STAGE(PG8_SB(1, 1), b3 + hstepB, voffB); PG8_STAGE(PG8_SA(1, 0), a3, voffA);
            PG8_WAIT_V(8); PG8_WAIT_L(0); PG8_BAR; PG8_MMA(1, 0, At, B0); PG8_MMA(1, 1, At, B1); PG8_BAR; PG8_SCHED;
        }
        if (wr == 0) PG8_BAR;
        E(acc, cur, wr, wc, fr, fq);
        if (!has_next) break;
#pragma unroll
        for (int a = 0; a < 2; ++a)
#pragma unroll
            for (int b = 0; b < 2; ++b)
#pragma unroll
                for (int m = 0; m < 4; ++m)
#pragma unroll
                    for (int n = 0; n < 2; ++n) acc[a][b][m][n] = (f32x4){0.f, 0.f, 0.f, 0.f};
        cur = nxt; cA = nA; cB = nB; ++ui;
        if (wr == 1) PG8_BAR;
    }
    PG8_WAIT_V(0);
    PG8_BAR;
#undef PG8_SA
#undef PG8_SB
#undef PG8_STAGE
#undef PG8_LDA
#undef PG8_LDB
#undef PG8_MMA
#undef PG8_WAIT_V
#undef PG8_WAIT_L
#undef PG8_BAR
#undef PG8_SCHED
}
}


#define XB_TMO      128
#define XB_XCNT(j)  (256  + 64 * (j))
#define XB_XSUB(j)  (1280 + 64 * (j))
#define XB_XGEN(j)  (2304 + 64 * (j))
#define XB_TOP      3328
#define XB_TOPGEN   3392
#define XCD_BAR_WORDS 3456
#define XB_SPIN_CAP (1u << 20)
__device__ __forceinline__ unsigned xb_ld(unsigned* p)              { return __hip_atomic_load(p, __ATOMIC_RELAXED, __HIP_MEMORY_SCOPE_AGENT); }
__device__ __forceinline__ unsigned xb_add(unsigned* p, unsigned v) { return __hip_atomic_fetch_add(p, v, __ATOMIC_RELAXED, __HIP_MEMORY_SCOPE_AGENT); }
__device__ __forceinline__ unsigned xb_xcc_id() { return (unsigned)__builtin_amdgcn_s_getreg((3 << 11) | 20) & 0xFu; }
#define XB_SPIN(cond, bar) do { unsigned _sp = 0; while (cond) { __builtin_amdgcn_s_sleep(0); \
    if ((++_sp & 255u) == 0u) { if (xb_ld(&(bar)[XB_TMO])) break; if (_sp > XB_SPIN_CAP) { atomicAdd(&(bar)[XB_TMO], 1u); break; } } } } while (0)
struct XcdBarrier { unsigned* bar; unsigned x; volatile LAS unsigned* st; };
__device__ __forceinline__ XcdBarrier xcd_barrier_post(unsigned* bar, volatile LAS unsigned* st) {
    XcdBarrier b; b.bar = bar; b.x = xb_xcc_id(); b.st = st;
    if (threadIdx.x == 0) (void)xb_add(&bar[XB_XCNT(b.x)], 1u);
    return b;
}
__device__ __forceinline__ void xcd_barrier_complete(unsigned* bar, unsigned x, unsigned& nloc, unsigned& nx) {
    const unsigned G = gridDim.x * gridDim.y * gridDim.z;
    unsigned sum, cnt, mine, sp = 0u;
    for (;;) {
        sum = 0u; cnt = 0u; mine = 0u;
#pragma unroll
        for (unsigned j = 0; j < 16; ++j) { const unsigned c = xb_ld(&bar[XB_XCNT(j)]); sum += c; cnt += (c > 0u) ? 1u : 0u; mine = (j == x) ? c : mine; }
        if (sum == G) break;
        __builtin_amdgcn_s_sleep(1);
        if ((++sp & 255u) == 0u) { if (xb_ld(&bar[XB_TMO])) break; if (sp > XB_SPIN_CAP) { atomicAdd(&bar[XB_TMO], 1u); break; } }
    }
    nloc = mine > 0u ? mine : 1u; nx = cnt > 0u ? cnt : 1u;
}
__device__ __forceinline__ void xcd_barrier(const XcdBarrier& b) {
    asm volatile("s_waitcnt vmcnt(0)" ::: "memory");
    __syncthreads();
    if (threadIdx.x == 0) {
        unsigned* bar = b.bar;
        __builtin_amdgcn_s_waitcnt(0);
        unsigned nloc = b.st[0], nx = b.st[1];
        if (nloc == 0u) { xcd_barrier_complete(bar, b.x, nloc, nx); b.st[0] = nloc; b.st[1] = nx; }
        const unsigned old = xb_add(&bar[XB_XSUB(b.x)], 1u);
        const unsigned gen = old / nloc;
        if (old + 1u == (gen + 1u) * nloc) {
            __builtin_amdgcn_fence(__ATOMIC_RELEASE, "agent");
            asm volatile("s_waitcnt vmcnt(0)" ::: "memory");
            const unsigned og = xb_add(&bar[XB_TOP], 1u);
            const unsigned tg = og / nx;
            if (og + 1u == (tg + 1u) * nx) xb_add(&bar[XB_TOPGEN], 1u);
            else XB_SPIN(xb_ld(&bar[XB_TOPGEN]) == tg, bar);
            __builtin_amdgcn_fence(__ATOMIC_ACQUIRE, "agent");
            xb_add(&bar[XB_XGEN(b.x)], 1u);
            asm volatile("s_waitcnt vmcnt(0)" ::: "memory");
        } else {
            XB_SPIN(xb_ld(&bar[XB_XGEN(b.x)]) == gen, bar);
            __builtin_amdgcn_fence(__ATOMIC_ACQUIRE, "agent");
            asm volatile("s_waitcnt vmcnt(0)" ::: "memory");
        }
    }
    __syncthreads();
}

__device__ __forceinline__ void sub_barrier(unsigned* word, unsigned n) {
    asm volatile("s_waitcnt vmcnt(0)" ::: "memory");
    __syncthreads();
    if (threadIdx.x == 0) {
        __builtin_amdgcn_fence(__ATOMIC_RELEASE, "agent");
        asm volatile("s_waitcnt vmcnt(0)" ::: "memory");
        xb_add(word, 1u);
        unsigned sp = 0;
        while (xb_ld(word) < n) { __builtin_amdgcn_s_sleep(0); if (++sp > (1u << 22)) break; }
        __builtin_amdgcn_fence(__ATOMIC_ACQUIRE, "agent");
        asm volatile("s_waitcnt vmcnt(0)" ::: "memory");
    }
    __syncthreads();
}

__device__ __forceinline__ void phase_mod(const Params& p, LAS unsigned char* lds) {
    LAS float* sc = (LAS float*)lds;
    LAS float* part = sc + 9 * 1024;
    float* mod = (float*)(PF(ws) + WS_MOD);
    const int tid = tid_(), w = tid >> 6, lane = tid & 63;
    if ((int)blockIdx.x >= 192) return;
    const float* pc = PF(c); const float* pcc = PF(c_ctx); const float* padaw = PF(ada_w); const float* padab = PF(ada_b);
    for (int i = tid; i < 9 * 1024; i += 512) { const int r = i >> 10, k = i & 1023; const float v = (r < 8) ? pc[r * 1024 + k] : pcc[k]; sc[i] = v / (1.0f + expf(-v)); }
    __syncthreads();
    for (int item = blockIdx.x; item < 192; item += gridDim.x) {
        const int l = item / 96, cb = item % 96;
        const float* W = padaw + (size_t)l * 1024 * 6144 + cb * 64 + lane;
        float acc[9];
#pragma unroll
        for (int r = 0; r < 9; ++r) acc[r] = 0.f;
        for (int k = w * 128; k < w * 128 + 128; ++k) { const float wv = W[(size_t)k * 6144];
#pragma unroll
            for (int r = 0; r < 9; ++r) acc[r] += sc[r * 1024 + k] * wv; }
#pragma unroll
        for (int r = 0; r < 9; ++r) part[(w * 9 + r) * 64 + lane] = acc[r];
        __syncthreads();
        for (int i = tid; i < 576; i += 512) { const int r = i >> 6, ln = i & 63; float s = 0.f;
#pragma unroll
            for (int ww = 0; ww < 8; ++ww) s += part[(ww * 9 + r) * 64 + ln];
            mod[(size_t)(l * 9 + r) * 6144 + cb * 64 + ln] = s + padab[l * 6144 + cb * 64 + ln]; }
        __syncthreads();
    }
}
__device__ __forceinline__ void phase_rope(const Params& p) {
    if (blockIdx.x != gridDim.x - 1) return;
    float* rope = (float*)(PF(ws) + WS_ROPE);
    for (int i = tid_(); i < 1024; i += 512) { const int pos = i >> 4, fi = i & 15; const float invf = powf(10000.0f, -(float)fi / 16.0f); const float ang = (float)pos * invf; rope[i] = cosf(ang); rope[1024 + i] = sinf(ang); }
}
__device__ __forceinline__ void convert_tile(const float* src, int K, int N, bf16_t* dst, int tile, LAS bf16_t* T) {
    const int tid = tid_(), tilesN = N >> 7, tk = tile / tilesN, tn = tile - tk * tilesN, k0 = tk * 128, n0 = tn * 128;
    const int r = tid >> 4, c8 = (tid & 15) * 8;
    f32x4 a[4], b[4];
#pragma unroll
    for (int i = 0; i < 4; ++i) { const float* s = src + (size_t)(k0 + r + 32 * i) * N + n0 + c8; a[i] = *(const f32x4*)s; b[i] = *(const f32x4*)(s + 4); }
#pragma unroll
    for (int i = 0; i < 4; ++i)
#pragma unroll
        for (int j = 0; j < 4; ++j) { T[(c8 + j) * 136 + r + 32 * i] = (bf16_t)f2bf(a[i][j]); T[(c8 + 4 + j) * 136 + r + 32 * i] = (bf16_t)f2bf(b[i][j]); }
    __syncthreads();
    const int n = tid >> 2, ks = (tid & 3) * 8;
#pragma unroll
    for (int i = 0; i < 4; ++i) { const u32x4 v = *(const LAS u32x4*)(T + n * 136 + ks + 32 * i); *(u32x4*)(dst + (size_t)(n0 + n) * K + k0 + ks + 32 * i) = v; }
    __syncthreads();
}
__device__ __forceinline__ void phase_convert(const Params& p, int l, LAS unsigned char* lds) {
    LAS bf16_t* T = (LAS bf16_t*)lds;
    bf16_t* WIN = (bf16_t*)(PF(ws) + WS_WIN); bf16_t* WB = (bf16_t*)(PF(ws) + WS_WB); bf16_t* WO = (bf16_t*)(PF(ws) + WS_WO); bf16_t* W1 = (bf16_t*)(PF(ws) + WS_W1); bf16_t* W2 = (bf16_t*)(PF(ws) + WS_W2);
    for (int it = blockIdx.x; it < 1184; it += gridDim.x) {
        if (it < 512) convert_tile(PF(w_in) + (size_t)l * DM * DIN, DM, DIN, WIN, it, T);
        else if (it < 608) { const int n = (it - 512) / 32, tl = (it - 512) % 32; convert_tile(PF(w_branch) + (size_t)(l * 3 + n) * 512 * DM, 512, DM, WB + (size_t)n * DM * 512, tl, T); }
        else if (it < 672) convert_tile(PF(w_out) + (size_t)l * DM * DM, DM, DM, WO, it - 608, T);
        else if (it < 928) convert_tile(PF(ffn_w1) + (size_t)l * DM * DFF, DM, DFF, W1, it - 672, T);
        else convert_tile(PF(ffn_w2) + (size_t)l * DFF * DM, DFF, DM, W2, it - 928, T);
    }
}
__device__ __forceinline__ void phase_norm(const Params& p, int l, const float* hlat, const float* hctx, const float* g, int modoff, int nrows, const float* slab = nullptr, const float* slabgate = nullptr, float* hwrite = nullptr) {
    const int tid = tid_(); const int w = tid >> 6, lane = tid & 63;
    bf16_t* U = (bf16_t*)(PF(ws) + WS_U); const float* mod = (const float*)(PF(ws) + WS_MOD);
    for (int row = blockIdx.x * 8 + w; row < nrows; row += gridDim.x * 8) {
        const float* src = row < NLAT ? hlat + (size_t)row * DM : hctx + (size_t)(row - NLAT) * DM;
        const int mr = row < NLAT ? (row >> 11) : 8;
        const float* md = mod + (size_t)(l * 9 + mr) * 6144 + modoff;
        f32x4 v[4]; float ss = 0.f;
#pragma unroll
        for (int i = 0; i < 4; ++i) { v[i] = *(const f32x4*)(src + i * 256 + lane * 4);
            if (slab != nullptr && row >= NLAT) { const size_t o = (size_t)(row - NLAT) * DM + i * 256 + lane * 4; const f32x4 gg = *(const f32x4*)(slabgate + i * 256 + lane * 4);
                const f32x4 s4 = (*(const f32x4*)(slab + o) + *(const f32x4*)(slab + o + (size_t)NCTX * DM)) + (*(const f32x4*)(slab + o + (size_t)2 * NCTX * DM) + *(const f32x4*)(slab + o + (size_t)3 * NCTX * DM));
                v[i] += gg * s4; if (hwrite != nullptr) *(f32x4*)(hwrite + o) = v[i]; }
            ss += v[i][0] * v[i][0] + v[i][1] * v[i][1] + v[i][2] * v[i][2] + v[i][3] * v[i][3]; }
#pragma unroll
        for (int o = 32; o >= 1; o >>= 1) ss += __shfl_xor(ss, o);
        const float rstd = rsqrtf(ss * (1.0f / 1024.0f) + 1e-6f);
#pragma unroll
        for (int i = 0; i < 4; ++i) { const int cidx = i * 256 + lane * 4; const f32x4 gg = *(const f32x4*)(g + cidx), sh = *(const f32x4*)(md + cidx), scv = *(const f32x4*)(md + 1024 + cidx);
            float o4[4];
#pragma unroll
            for (int j = 0; j < 4; ++j) o4[j] = (v[i][j] * rstd * gg[j]) * (1.0f + scv[j]) + sh[j];
            u32x2 wv; wv.x = pack2(o4[0], o4[1]); wv.y = pack2(o4[2], o4[3]);
            *(u32x2*)(U + (size_t)row * DM + cidx) = wv; }
    }
}
__device__ __forceinline__ void phase_hg_final(const Params& p, int l, int nrows, int wg, int nwg) {
    const int tid = tid_(); const int w = tid >> 6, lane = tid & 63; bf16_t* P = (bf16_t*)(PF(ws) + WS_P);
    const int hd = lane >> 4, e8 = (lane & 15) * 8; const float* png = PF(hg_norm_g);
    float ng[8];
#pragma unroll
    for (int i = 0; i < 8; ++i) ng[i] = png[l * 128 + e8 + i];
    for (int row = wg * 8 + w; row < nrows; row += nwg * 8) {
        bf16_t* rp = P + (size_t)row * PW;
        float a[8], b[8], og[8]; unpack8(*(const u32x4*)(rp + C_BF + hd * 128 + e8), a); unpack8(*(const u32x4*)(rp + C_BF + 512 + hd * 128 + e8), b); unpack8(*(const u32x4*)(rp + C_BO + hd * 128 + e8), og);
        float ss = 0.f;
#pragma unroll
        for (int i = 0; i < 8; ++i) { a[i] += b[i]; ss += a[i] * a[i]; }
        ss += __shfl_xor(ss, 1); ss += __shfl_xor(ss, 2); ss += __shfl_xor(ss, 4); ss += __shfl_xor(ss, 8);
        const float rstd = rsqrtf(ss * (1.0f / 128.0f) + 1e-6f);
        float y[8];
#pragma unroll
        for (int i = 0; i < 8; ++i) y[i] = a[i] * rstd * ng[i] * sigmoidf_(og[i]);
        *(u32x4*)(rp + C_BO + hd * 128 + e8) = pack8(y);
    }
}

__device__ __forceinline__ size_t agg_idx(int b, int gch, int dir, int which, int ch) { return ((((size_t)b * 36 + gch) * 2 + dir) * 2 + which) * 512 + ch; }
__device__ __forceinline__ float gelu_tanh(float x) { const float u = 0.7978845608028654f * (x + 0.044715f * x * x * x); const float th = 1.0f - 2.0f / (1.0f + __expf(2.0f * u)); return 0.5f * x * (1.0f + th); }
__device__ __forceinline__ void lru_tile(const Params& p, int l, LAS unsigned char* lds, int item, int mode, int& staged_nb) {
    LAS bf16_t* Wl = (LAS bf16_t*)lds;
    LAS bf16_t* Xb = Wl + 256 * 72;
    LAS float* Xf = (LAS float*)(lds + 46080);
    LAS float* Av = Xf + 4096;
    LAS float* Bv = Av + 8192;
    bf16_t* P = (bf16_t*)(PF(ws) + WS_P); float* AGG = (float*)(PF(ws) + WS_AGG);
    const int tid = tid_(), w = tid >> 6, lane = tid & 63, l16 = lane & 15, q4 = lane >> 4;
    const int nb = item & 7, rest = item >> 3, gch = rest % 36, b = rest / 36;
    const bool isctx = gch < 4; const int chunk = isctx ? gch : gch - 4, L = isctx ? CTXL : SEQ;
    const size_t seqrow0 = isctx ? (size_t)NLAT + b * CTXL : (size_t)b * SEQ; const int t0 = chunk * 64;
    if (staged_nb != nb) { const float* pwx = PF(lru_wx); const float* pwa = PF(lru_wa);
        for (int e = tid; e < 4 * 64 * 64; e += 512) { const int mat = e >> 12, i = (e >> 6) & 63, c = e & 63; const int dir = mat >> 1, kind = mat & 1;
            const float* W = kind ? pwx : pwa; const float v = W[((size_t)((l * 2 + dir) * 8 + nb) * 64 + i) * 64 + c];
            const int op = dir * 128 + (c >> 4) * 32 + kind * 16 + (c & 15);
            Wl[op * 72 + i] = (bf16_t)f2bf(v); }
        staged_nb = nb;
    }
    {
        const int t = tid >> 3, c8 = (tid & 7) * 8, ch = nb * 64 + c8, tt = t0 + t;
        float a8[8]; const float* pcb = PF(conv_b); const float* pcw = PF(conv_w);
        { const f32x4 b0 = *(const f32x4*)(pcb + l * 512 + ch), b1 = *(const f32x4*)(pcb + l * 512 + ch + 4);
#pragma unroll
          for (int i = 0; i < 4; ++i) { a8[i] = b0[i]; a8[4 + i] = b1[i]; } }
#pragma unroll
        for (int j = 0; j < 4; ++j) { const int ts = tt + j - 2;
            if (ts >= 0 && ts < L) { float xv[8]; unpack8(*(const u32x4*)(P + (seqrow0 + ts) * PW + C_AX + ch), xv);
                const f32x4 w0 = *(const f32x4*)(pcw + (l * 4 + j) * 512 + ch), w1 = *(const f32x4*)(pcw + (l * 4 + j) * 512 + ch + 4);
#pragma unroll
                for (int i = 0; i < 4; ++i) { a8[i] += xv[i] * w0[i]; a8[4 + i] += xv[4 + i] * w1[i]; } } }
#pragma unroll
        for (int i = 0; i < 8; ++i) Xf[t * 64 + c8 + i] = a8[i];
        *(LAS u32x4*)(Xb + t * 72 + c8) = pack8(a8);
    }
    __syncthreads();
    {
        const int dir = w >> 2, c = (w & 3) * 16 + l16, ch = nb * 64 + c;
        f32x4 acc[4][2];
#pragma unroll
        for (int mg = 0; mg < 4; ++mg) { acc[mg][0] = (f32x4){0.f, 0.f, 0.f, 0.f}; acc[mg][1] = (f32x4){0.f, 0.f, 0.f, 0.f}; }
#pragma unroll
        for (int ks = 0; ks < 2; ++ks) {
            const bf16x8 B0 = *(const LAS bf16x8*)(Wl + (w * 32 + l16) * 72 + ks * 32 + q4 * 8), B1 = *(const LAS bf16x8*)(Wl + (w * 32 + 16 + l16) * 72 + ks * 32 + q4 * 8);
#pragma unroll
            for (int mg = 0; mg < 4; ++mg) { const bf16x8 A = *(const LAS bf16x8*)(Xb + (mg * 16 + l16) * 72 + ks * 32 + q4 * 8);
                acc[mg][0] = mfma16(A, B0, acc[mg][0]); acc[mg][1] = mfma16(A, B1, acc[mg][1]); }
        }
        const float ba = PF(lru_ba)[(l * 2 + dir) * 512 + ch], bx = PF(lru_bx)[(l * 2 + dir) * 512 + ch], lam = PF(lru_lambda)[(l * 2 + dir) * 512 + ch];
        const float sp = log1pf(expf(-lam));
#pragma unroll
        for (int mg = 0; mg < 4; ++mg)
#pragma unroll
            for (int j = 0; j < 4; ++j) { const int t = mg * 16 + q4 * 4 + j;
                const float ea = 1.0f + __expf(-(acc[mg][0][j] + ba)), ex = 1.0f + __expf(-(acc[mg][1][j] + bx)); const float inv = __builtin_amdgcn_rcpf(ea * ex);
                const float r = inv * ex, ig = inv * ea;
                const float la = -8.0f * r * sp; const float a = __expf(la); const float x2 = 2.0f * la;
                float om = -x2 * (1.0f + x2 * (0.5f + x2 * (0.16666667f + x2 * (0.041666668f + x2 * 0.0083333338f))));
                if (x2 < -0.35f) om = 1.0f - a * a;
                const float bb = sqrtf(fmaxf(om, 0.f)) * ig * Xf[t * 64 + c];
                Av[(dir * 64 + t) * 64 + c] = a; Bv[(dir * 64 + t) * 64 + c] = bb; }
    }
    __syncthreads();
    {
        LAS float* SegA = Xf;
        LAS float* SegB = Xf + 512;
        const int d2 = tid >> 8, seg = (tid >> 6) & 3, c = tid & 63, ch = nb * 64 + c;
        float av[16], bv[16];
#pragma unroll
        for (int k = 0; k < 16; ++k) { const int s = seg * 16 + k; const int t = d2 ? 63 - s : s; const int ix = (d2 * 64 + t) * 64 + c; av[k] = Av[ix]; bv[k] = Bv[ix]; }
        float h = 0.f, ap = 1.f;
#pragma unroll
        for (int k = 0; k < 16; ++k) { h = av[k] * h + bv[k]; ap *= av[k]; }
        SegA[(d2 * 4 + seg) * 64 + c] = ap; SegB[(d2 * 4 + seg) * 64 + c] = h;
        float hin = 0.f;
        if (mode == 1) {
            const int mypos = d2 == 0 ? gch : (gch < 4 ? 3 - gch : 39 - gch);
            for (int p0 = 0; p0 < mypos; p0 += 6) { float Aa[6], Bb[6];
#pragma unroll
                for (int j = 0; j < 6; ++j) { const int pp = p0 + j; const int g = d2 == 0 ? pp : (pp < 4 ? 3 - pp : 39 - pp); const bool ok = pp < mypos;
                    Aa[j] = ok ? AGG[agg_idx(b, ok ? g : 0, d2, 0, ch)] : 1.0f; Bb[j] = ok ? AGG[agg_idx(b, ok ? g : 0, d2, 1, ch)] : 0.0f; }
#pragma unroll
                for (int j = 0; j < 6; ++j) hin = Aa[j] * hin + Bb[j]; }
        }
        __syncthreads();
        if (mode == 0) {
            if (seg == 3) { float A = 1.f, B = 0.f;
#pragma unroll
                for (int s2 = 0; s2 < 4; ++s2) { const float sa = SegA[(d2 * 4 + s2) * 64 + c], sb2 = SegB[(d2 * 4 + s2) * 64 + c]; B = sa * B + sb2; A *= sa; }
                AGG[agg_idx(b, gch, d2, 0, ch)] = A; AGG[agg_idx(b, gch, d2, 1, ch)] = B; }
        } else {
#pragma unroll
            for (int s2 = 0; s2 < 3; ++s2) if (s2 < seg) hin = SegA[(d2 * 4 + s2) * 64 + c] * hin + SegB[(d2 * 4 + s2) * 64 + c];
            float hh2 = hin;
#pragma unroll
            for (int k = 0; k < 16; ++k) { const int s = seg * 16 + k; const int t = d2 ? 63 - s : s; hh2 = av[k] * hh2 + bv[k]; Bv[(d2 * 64 + t) * 64 + c] = hh2; }
        }
    }
    __syncthreads();
    if (mode == 1) {
        const int t = tid >> 3, c8 = (tid & 7) * 8; bf16_t* gp = P + (seqrow0 + t0 + t) * PW + C_AG + nb * 64 + c8;
        float gt[8]; unpack8(*(const u32x4*)gp, gt); float y[8];
#pragma unroll
        for (int i = 0; i < 8; ++i) y[i] = (Bv[t * 64 + c8 + i] + Bv[(64 + t) * 64 + c8 + i]) * gelu_tanh(gt[i]);
        *(u32x4*)gp = pack8(y);
        __syncthreads();
    }
}

template <bool B> struct BoolC { static constexpr bool value = B; };
__device__ __forceinline__ void attn_item(const Params& p, int l, LAS unsigned char* lds, int item, int dry = 0) {
    LAS bf16_t* Kt = (LAS bf16_t*)lds;
    LAS float* rpbL = (LAS float*)(lds + 73728);
    LAS float* cosT = rpbL + 960;
    LAS float* sinT = cosT + 1024;
    LAS float* gq = sinT + 1024; LAS float* gk = gq + 64;
    bf16_t* P = (bf16_t*)(PF(ws) + WS_P); const float* rope = (const float*)(PF(ws) + WS_ROPE);
    const int tid = tid_(), w = __builtin_amdgcn_readfirstlane(tid >> 6), lane = tid & 63, l16 = lane & 15, q4 = lane >> 4, hh = w >> 2, qg4 = w & 3;
    const bool isctx = item >= 512;
    int b, hp, nloc, krU; int rq[2], kq0[2]; size_t qrow0[2];
    if (!isctx) { hp = item & 3; const int rp = (item >> 2) & 15; b = item >> 6;
        rq[0] = 2 * rp; rq[1] = 2 * rp + 1; kq0[0] = min(max(rq[0] - 4, 0), 24); kq0[1] = min(max(rq[1] - 4, 0), 24);
        qrow0[0] = (size_t)b * SEQ + rq[0] * 64; qrow0[1] = qrow0[0] + 64; krU = kq0[0]; nloc = kq0[1] + 8 - kq0[0]; }
    else { const int it = item - 512; hp = it & 3; const int qt = (it >> 2) & 1; b = it >> 3; rq[0] = rq[1] = 0; kq0[0] = kq0[1] = 0; krU = 0; nloc = 0;
        qrow0[0] = (size_t)NLAT + b * CTXL + qt * 128; qrow0[1] = qrow0[0] + 64; }
    const int h = hp * 2 + hh;
    const float* prpb = PF(na_rpb);
    for (int i = tid; i < 2 * 465; i += 512) { const int h2 = i / 465, j = i - h2 * 465; rpbL[h2 * 480 + j] = prpb[(size_t)((l * 8 + hp * 2 + h2) * 465) + j]; }
    for (int i = tid; i < 1024; i += 512) { cosT[i] = rope[i]; sinT[i] = rope[1024 + i]; }
    if (tid < 64) { gq[tid] = PF(na_qg)[l * 64 + tid]; gk[tid] = PF(na_kg)[l * 64 + tid]; }
    __syncthreads();
    const int qc = qg4 * 16 + l16;
    const int glo = qg4 < 2 ? 0 : qg4 - 1, ghi = qg4 == 0 ? 1 : (qg4 == 3 ? 3 : qg4 + 1);
    unsigned mbits = 0u; const int bbase = q4 * 4 - qc;
    { const int cs0 = min(max(qc - 8, 0), 48);
#pragma unroll
      for (int g = 0; g < 4; ++g)
#pragma unroll
          for (int j = 0; j < 4; ++j) { const int kc = g * 16 + q4 * 4 + j; if (kc < cs0 || kc >= cs0 + 16) mbits |= 1u << (g * 4 + j); } }
    bf16x8 qpl[2][2], qrt[2][2];
#pragma unroll
    for (int qi = 0; qi < 2; ++qi) {
        const bf16_t* qp = P + (qrow0[qi] + qc) * PW + C_CQ + h * 64;
        float xq[16]; unpack8(*(const u32x4*)(qp + q4 * 8), xq); unpack8(*(const u32x4*)(qp + 32 + q4 * 8), xq + 8);
        float ss = 0.f;
#pragma unroll
        for (int i = 0; i < 16; ++i) ss += xq[i] * xq[i];
        ss += __shfl_xor(ss, 16); ss += __shfl_xor(ss, 32);
        const float rs = rsqrtf(ss * (1.0f / 64.0f) + 1e-6f) * 0.125f;
#pragma unroll
        for (int i = 0; i < 8; ++i) { xq[i] *= rs * gq[q4 * 8 + i]; xq[8 + i] *= rs * gq[32 + q4 * 8 + i]; }
        qpl[qi][0] = as_bf16x8(pack8(xq)); qpl[qi][1] = as_bf16x8(pack8(xq + 8));
        float xr[16];
#pragma unroll
        for (int ks = 0; ks < 2; ++ks) { const int pos = ks == 0 ? rq[qi] : qc;
#pragma unroll
            for (int jj = 0; jj < 8; ++jj) { const int fi = (q4 & 1) * 8 + jj; const float cs = cosT[pos * 16 + fi], sn = sinT[pos * 16 + fi]; const float xv = xq[ks * 8 + jj]; const float pr = __shfl_xor(xv, 32);
                xr[ks * 8 + jj] = (q4 < 2) ? (xv * cs - pr * sn) : (xv * cs + pr * sn); } }
        qrt[qi][0] = as_bf16x8(pack8(xr)); qrt[qi][1] = as_bf16x8(pack8(xr + 8));
    }
    f32x4 O[2][4];
#pragma unroll
    for (int qi = 0; qi < 2; ++qi)
#pragma unroll
        for (int i = 0; i < 4; ++i) O[qi][i] = (f32x4){0.f, 0.f, 0.f, 0.f};
    float mrun[2] = {-1e30f, -1e30f}, lsum[2] = {0.f, 0.f};
    const int pf_hh2 = tid >> 8, pf_h2 = hp * 2 + pf_hh2, pf_key = (tid & 255) >> 2, pf_seg = tid & 3, pf_vseg = (tid & 255) >> 6, pf_vkey = tid & 63;
    u32x4 pk0, pk1, pv0, pv1;
    { const size_t r0 = nloc ? (size_t)b * SEQ + krU * 64 : (size_t)NLAT + b * CTXL;
      const bf16_t* kp = P + (r0 + pf_key) * PW + C_CK + pf_h2 * 64 + pf_seg * 16; pk0 = *(const u32x4*)kp; pk1 = *(const u32x4*)(kp + 8);
      const bf16_t* vp = P + (r0 + pf_vkey) * PW + C_CV + pf_h2 * 64 + pf_vseg * 16; pv0 = *(const u32x4*)vp; pv1 = *(const u32x4*)(vp + 8); }
    const int ntot = nloc + 4;
    auto stage = [&](int T, int buf) {
        const bool sloc = T < nloc; const int kr = krU + T;
        LAS bf16_t* KtB = Kt + buf * (4 * 64 * 72); LAS bf16_t* VtB = KtB + 2 * 64 * 72;
        {
            const int hh2 = pf_hh2, key = pf_key, seg = pf_seg;
            float xk[16]; unpack8(pk0, xk); unpack8(pk1, xk + 8);
            float ss = 0.f;
#pragma unroll
            for (int i = 0; i < 16; ++i) ss += xk[i] * xk[i];
            ss += __shfl_xor(ss, 1); ss += __shfl_xor(ss, 2);
            const float rs = rsqrtf(ss * (1.0f / 64.0f) + 1e-6f);
#pragma unroll
            for (int i = 0; i < 16; ++i) xk[i] *= rs * gk[seg * 16 + i];
            if (sloc) { const int pos = seg < 2 ? kr : key;
#pragma unroll
                for (int i = 0; i < 16; ++i) { const float pr = __shfl_xor(xk[i], 1); const float cs = cosT[pos * 16 + i], sn = sinT[pos * 16 + i]; xk[i] = (seg & 1) ? (xk[i] * cs + pr * sn) : (xk[i] * cs - pr * sn); } }
            LAS bf16_t* kd = KtB + (hh2 * 64 + key) * 72 + seg * 16;
            *(LAS u32x4*)kd = pack8(xk); *(LAS u32x4*)(kd + 8) = pack8(xk + 8);
        }
        {
            const int hh2 = pf_hh2, seg = pf_vseg, key = pf_vkey;
            const u32x4 a = pv0, c = pv1;
            LAS bf16_t* vd = VtB + (hh2 * 64 + seg * 16) * 72 + key;
            vd[0 * 72] = (bf16_t)(a.x & 0xffff); vd[1 * 72] = (bf16_t)(a.x >> 16); vd[2 * 72] = (bf16_t)(a.y & 0xffff); vd[3 * 72] = (bf16_t)(a.y >> 16);
            vd[4 * 72] = (bf16_t)(a.z & 0xffff); vd[5 * 72] = (bf16_t)(a.z >> 16); vd[6 * 72] = (bf16_t)(a.w & 0xffff); vd[7 * 72] = (bf16_t)(a.w >> 16);
            vd[8 * 72] = (bf16_t)(c.x & 0xffff); vd[9 * 72] = (bf16_t)(c.x >> 16); vd[10 * 72] = (bf16_t)(c.y & 0xffff); vd[11 * 72] = (bf16_t)(c.y >> 16);
            vd[12 * 72] = (bf16_t)(c.z & 0xffff); vd[13 * 72] = (bf16_t)(c.z >> 16); vd[14 * 72] = (bf16_t)(c.w & 0xffff); vd[15 * 72] = (bf16_t)(c.w >> 16);
        }
        { const int Tn = T + 1; if (Tn < ntot) { const size_t r0 = (Tn < nloc) ? (size_t)b * SEQ + (krU + Tn) * 64 : (size_t)NLAT + b * CTXL + (Tn - nloc) * 64;
            const bf16_t* kp = P + (r0 + pf_key) * PW + C_CK + pf_h2 * 64 + pf_seg * 16; pk0 = *(const u32x4*)kp; pk1 = *(const u32x4*)(kp + 8);
            const bf16_t* vp = P + (r0 + pf_vkey) * PW + C_CV + pf_h2 * 64 + pf_vseg * 16; pv0 = *(const u32x4*)vp; pv1 = *(const u32x4*)(vp + 8); } }
    };
    auto compute = [&](auto LOC, int T, int buf) {
        constexpr bool loc = decltype(LOC)::value; const int kr = krU + T;
        const LAS bf16_t* KtB = Kt + buf * (4 * 64 * 72); const LAS bf16_t* VtB = KtB + 2 * 64 * 72;
#pragma unroll
        for (int qi = 0; qi < 2; ++qi) {
            if (loc && (kr < kq0[qi] || kr >= kq0[qi] + 8)) continue;
            f32x4 st[4];
#pragma unroll
            for (int g = 0; g < 4; ++g) { const bool use = !loc || (g >= glo && g <= ghi);
                st[g] = (f32x4){0.f, 0.f, 0.f, 0.f};
                if (use) {
#pragma unroll
                    for (int ks = 0; ks < 2; ++ks) st[g] = mfma16(*(const LAS bf16x8*)(KtB + (hh * 64 + g * 16 + l16) * 72 + ks * 32 + q4 * 8), loc ? qrt[qi][ks] : qpl[qi][ks], st[g]);
                    if (loc) { const int dr31 = (kr - rq[qi] + 7) * 31;
#pragma unroll
                        for (int j = 0; j < 4; ++j) { const float sv = st[g][j] + rpbL[hh * 480 + min(max(bbase + g * 16 + j, -15), 15) + 15 + dr31]; st[g][j] = ((mbits >> (g * 4 + j)) & 1u) ? -1e30f : sv; } }
                } else st[g] = (f32x4){-1e30f, -1e30f, -1e30f, -1e30f};
            }
            float tmax = -1e30f;
#pragma unroll
            for (int g = 0; g < 4; ++g)
#pragma unroll
                for (int j = 0; j < 4; ++j) tmax = fmaxf(tmax, st[g][j]);
            tmax = fmaxf(tmax, __shfl_xor(tmax, 16)); tmax = fmaxf(tmax, __shfl_xor(tmax, 32));
            const float mnew = fmaxf(mrun[qi], tmax); const float alpha = __expf(mrun[qi] - mnew); mrun[qi] = mnew;
            float psum = 0.f;
#pragma unroll
            for (int g = 0; g < 4; ++g) { const bool use = !loc || (g >= glo && g <= ghi);
                if (use) {
#pragma unroll
                    for (int j = 0; j < 4; ++j) { const float pv = __expf(st[g][j] - mnew); st[g][j] = pv; psum += pv; }
                } else st[g] = (f32x4){0.f, 0.f, 0.f, 0.f}; }
            lsum[qi] = lsum[qi] * alpha + psum;
#pragma unroll
            for (int i = 0; i < 4; ++i) O[qi][i] *= alpha;
            bf16x8 pb[2];
#pragma unroll
            for (int ks = 0; ks < 2; ++ks) { u32x4 wv; wv.x = pack2(st[2 * ks][0], st[2 * ks][1]); wv.y = pack2(st[2 * ks][2], st[2 * ks][3]); wv.z = pack2(st[2 * ks + 1][0], st[2 * ks + 1][1]); wv.w = pack2(st[2 * ks + 1][2], st[2 * ks + 1][3]); pb[ks] = as_bf16x8(wv); }
#pragma unroll
            for (int ks = 0; ks < 2; ++ks) if (!loc || (2 * ks + 1 >= glo && 2 * ks <= ghi))
#pragma unroll
                for (int dg = 0; dg < 4; ++dg) { const LAS bf16_t* vr = VtB + (hh * 64 + dg * 16 + l16) * 72 + ks * 32 + q4 * 4;
                    const u32x2 lo = *(const LAS u32x2*)vr, hi = *(const LAS u32x2*)(vr + 16); u32x4 av; av.x = lo.x; av.y = lo.y; av.z = hi.x; av.w = hi.y;
                    O[qi][dg] = mfma16(as_bf16x8(av), pb[ks], O[qi][dg]); }
        }
    };
    stage(0, 0);
    __syncthreads();
    for (int T = 0; T < nloc; ++T) {
        stage(T + 1, (T + 1) & 1);
        compute(BoolC<true>{}, T, T & 1);
        __syncthreads();
    }
    for (int T = nloc; T < ntot; ++T) {
        if (T + 1 < ntot) stage(T + 1, (T + 1) & 1);
        compute(BoolC<false>{}, T, T & 1);
        __syncthreads();
    }
#pragma unroll
    for (int qi = 0; qi < 2; ++qi) {
        float ls = lsum[qi]; ls += __shfl_xor(ls, 16); ls += __shfl_xor(ls, 32);
        const float inv = 1.0f / ls;
        bf16_t* op = dry ? ((bf16_t*)(PF(ws) + WS_DUMMY) + (size_t)(blockIdx.x & 63) * 16384 + (size_t)((qi * 8 + w) * 16 + l16) * 64) : (P + (qrow0[qi] + qc) * PW + C_CQ + h * 64);
#pragma unroll
        for (int dg = 0; dg < 4; ++dg) { u32x2 wv; wv.x = pack2(O[qi][dg][0] * inv, O[qi][dg][1] * inv); wv.y = pack2(O[qi][dg][2] * inv, O[qi][dg][3] * inv); *(u32x2*)(op + dg * 16 + q4 * 4) = wv; }
    }
    __syncthreads();
}

__device__ __forceinline__ void hgrn_stage(const bf16_t* P, LAS unsigned char* lds, int w, int lane, size_t row0, int dir, int h) {
#pragma unroll
    for (int i = 0; i < 2; ++i) { const int blk = i * 8 + w; const int t = blk * 4 + (lane >> 4); const bf16_t* rp = P + (row0 + (dir ? 63 - t : t)) * PW + (lane & 15) * 8;
        __builtin_amdgcn_global_load_lds((const unsigned*)(rp + C_BQ + h * 128), (LAS unsigned*)(lds + 118784 + blk * 1024), 16, 0, 0);
        __builtin_amdgcn_global_load_lds((const unsigned*)(rp + C_BF + dir * 512 + h * 128), (LAS unsigned*)(lds + 135168 + blk * 1024), 16, 0, 0); }
}
__device__ __forceinline__ void hgrn_chain(const Params& p, int l, LAS unsigned char* lds, int chain, int dry = 0) {
    LAS bf16_t* Q0 = (LAS bf16_t*)lds;
    LAS bf16_t* KP = (LAS bf16_t*)(lds + 17408);
    LAS bf16_t* SB = (LAS bf16_t*)(lds + 34816);
    LAS bf16_t* KDT = (LAS bf16_t*)(lds + 69632);
    LAS bf16_t* VT = (LAS bf16_t*)(lds + 88064);
    LAS bf16_t* ATT = (LAS bf16_t*)(lds + 106496);
    LAS float* TOT = (LAS float*)(lds + 115712);
    LAS float* DD = (LAS float*)(lds + 117760);
    const LAS bf16_t* SQ = (const LAS bf16_t*)(lds + 118784);
    const LAS bf16_t* SF = (const LAS bf16_t*)(lds + 135168);
    bf16_t* P = (bf16_t*)(PF(ws) + WS_P);
    const int tid = tid_(), w = __builtin_amdgcn_readfirstlane(tid >> 6), lane = tid & 63, l16 = lane & 15, q4 = lane >> 4;
    const int dir = chain & 1, h = (chain >> 1) & 3, b = chain >> 3;
    const int d = tid & 127, sb = tid >> 7;
    float lbv = 0.f;
    if (l > 0) { const float x0 = PF(hg_lb)[(dir * 2 + 0) * 512 + h * 128 + d], x1 = PF(hg_lb)[(dir * 2 + 1) * 512 + h * 128 + d]; lbv = 1.0f / (1.0f + expf(x0 - x1)); }
    for (int i = tid; i < 64 * 72 / 2; i += 512) ((LAS unsigned*)ATT)[i] = 0u;
    f32x4 S[8];
#pragma unroll
    for (int i = 0; i < 8; ++i) S[i] = (f32x4){0.f, 0.f, 0.f, 0.f};
    { const int gch0 = dir == 0 ? 0 : 3; hgrn_stage(P, lds, w, lane, (size_t)NLAT + b * CTXL + gch0 * 64, dir, h); }
    asm volatile("s_waitcnt vmcnt(0)" ::: "memory");
    __syncthreads();
    for (int ci = 0; ci < 36; ++ci) {
        const int gch = dir == 0 ? ci : (ci < 4 ? 3 - ci : 39 - ci);
        const bool isctx = gch < 4; const int chunk = isctx ? gch : gch - 4;
        const size_t row0 = isctx ? (size_t)NLAT + b * CTXL + chunk * 64 : (size_t)b * SEQ + chunk * 64;
        float bl[16], qv[16], kv[16]; float run = 0.f;
        {
            unsigned vraw[16];
#pragma unroll
            for (int ii = 0; ii < 16; ++ii) { const int t = sb * 16 + ii; vraw[ii] = P[(row0 + (dir ? 63 - t : t)) * PW + C_BI + h * 128 + d]; }
#pragma unroll
            for (int eg = 0; eg < 8; ++eg) { u32x2 wv; wv.x = pack2(S[eg][0], S[eg][1]); wv.y = pack2(S[eg][2], S[eg][3]); *(LAS u32x2*)(SB + (eg * 16 + l16) * 136 + w * 16 + q4 * 4) = wv; }
#pragma unroll
            for (int ii = 0; ii < 16; ++ii) { const int t = sb * 16 + ii;
                const float fr = bf2f(SF[t * 128 + d]), qr = bf2f(SQ[t * 128 + d]);
                const float sg = 1.0f / (1.0f + __expf(-fr)); const float f = lbv + (1.0f - lbv) * sg; run += __logf(f); bl[ii] = run; kv[ii] = 1.0f - f; qv[ii] = qr / (1.0f + __expf(-qr)); }
            TOT[sb * 128 + d] = run;
            u32x4 v0, v1; v0.x = vraw[0] | (vraw[1] << 16); v0.y = vraw[2] | (vraw[3] << 16); v0.z = vraw[4] | (vraw[5] << 16); v0.w = vraw[6] | (vraw[7] << 16);
            v1.x = vraw[8] | (vraw[9] << 16); v1.y = vraw[10] | (vraw[11] << 16); v1.z = vraw[12] | (vraw[13] << 16); v1.w = vraw[14] | (vraw[15] << 16);
            *(LAS u32x4*)(VT + d * 72 + sb * 16) = v0; *(LAS u32x4*)(VT + d * 72 + sb * 16 + 8) = v1;
        }
        __syncthreads();
        if (ci < 35) { const int cn = ci + 1; const int gn = dir == 0 ? cn : (cn < 4 ? 3 - cn : 39 - cn); const bool cx = gn < 4; const int ck = cx ? gn : gn - 4;
            hgrn_stage(P, lds, w, lane, cx ? (size_t)NLAT + b * CTXL + ck * 64 : (size_t)b * SEQ + ck * 64, dir, h); }
        {
            const float t0 = TOT[d], t1 = TOT[128 + d], t2 = TOT[256 + d], t3 = TOT[384 + d];
            const float Bs1 = t0, Bs2 = t0 + t1, Bs3 = Bs2 + t2, total = Bs3 + t3;
            const float Bsb = sb == 0 ? 0.f : (sb == 1 ? Bs1 : (sb == 2 ? Bs2 : Bs3));
            const float eB = __expf(Bsb), eT = __expf(total);
            float kd[16];
#pragma unroll
            for (int ii = 0; ii < 16; ++ii) { const float e0 = __expf(bl[ii]); Q0[(sb * 16 + ii) * 136 + d] = (bf16_t)pack2(qv[ii] * e0 * eB, 0.f);
                const float kp = kv[ii] * __expf(fminf(-(Bsb + bl[ii]), 80.f)); KP[(sb * 16 + ii) * 136 + d] = (bf16_t)pack2(kp, 0.f); kd[ii] = kp * eT; }
            *(LAS u32x4*)(KDT + d * 72 + sb * 16) = pack8(kd); *(LAS u32x4*)(KDT + d * 72 + sb * 16 + 8) = pack8(kd + 8);
            if (sb == 0) DD[d] = eT;
        }
        __syncthreads();
#pragma unroll
        for (int k2 = 0; k2 < 2; ++k2) { const int idx = w + 8 * k2;
            if (idx < 10) { const int i = idx < 1 ? 0 : (idx < 3 ? 1 : (idx < 6 ? 2 : 3)); const int j = idx - i * (i + 1) / 2;
                f32x4 sc = (f32x4){0.f, 0.f, 0.f, 0.f};
                const LAS bf16_t* qb = Q0 + (i * 16 + l16) * 136 + q4 * 8; const LAS bf16_t* kb = KP + (j * 16 + l16) * 136 + q4 * 8;
#pragma unroll
                for (int ks = 0; ks < 4; ++ks) sc = mfma16(*(const LAS bf16x8*)(qb + ks * 32), *(const LAS bf16x8*)(kb + ks * 32), sc);
#pragma unroll
                for (int jj = 0; jj < 4; ++jj) { const float v = (i == j && l16 > q4 * 4 + jj) ? 0.f : sc[jj]; ATT[(i * 16 + q4 * 4 + jj) * 72 + j * 16 + l16] = (bf16_t)pack2(v, 0.f); } } }
        __syncthreads();
        {
            bf16x8 SBf[4], VTf[2];
#pragma unroll
            for (int ks = 0; ks < 4; ++ks) SBf[ks] = *(const LAS bf16x8*)(SB + (w * 16 + l16) * 136 + ks * 32 + q4 * 8);
#pragma unroll
            for (int ks = 0; ks < 2; ++ks) VTf[ks] = *(const LAS bf16x8*)(VT + (w * 16 + l16) * 72 + ks * 32 + q4 * 8);
#pragma unroll
            for (int i = 0; i < 4; ++i) { f32x4 oa = (f32x4){0.f, 0.f, 0.f, 0.f};
#pragma unroll
                for (int ks = 0; ks < 4; ++ks) oa = mfma16(SBf[ks], *(const LAS bf16x8*)(Q0 + (i * 16 + l16) * 136 + ks * 32 + q4 * 8), oa);
#pragma unroll
                for (int ks = 0; ks < 2; ++ks) oa = mfma16(VTf[ks], *(const LAS bf16x8*)(ATT + (i * 16 + l16) * 72 + ks * 32 + q4 * 8), oa);
                const int t = i * 16 + l16; u32x2 wv; wv.x = pack2(oa[0], oa[1]); wv.y = pack2(oa[2], oa[3]);
                bf16_t* od = dry ? ((bf16_t*)(PF(ws) + WS_DUMMY) + (size_t)chain * 8192 + t * 128 + w * 16 + q4 * 4) : (P + (row0 + (dir ? 63 - t : t)) * PW + C_BF + dir * 512 + h * 128 + w * 16 + q4 * 4);
                *(u32x2*)od = wv; }
        }
        {
            const f32x4 dd = *(const LAS f32x4*)(DD + w * 16 + q4 * 4);
#pragma unroll
            for (int eg = 0; eg < 8; ++eg) S[eg] *= dd;
#pragma unroll
            for (int ks = 0; ks < 2; ++ks) { const bf16x8 A = *(const LAS bf16x8*)(KDT + (w * 16 + l16) * 72 + ks * 32 + q4 * 8);
#pragma unroll
                for (int eg = 0; eg < 8; ++eg) S[eg] = mfma16(A, *(const LAS bf16x8*)(VT + (eg * 16 + l16) * 72 + ks * 32 + q4 * 8), S[eg]); }
        }
        asm volatile("s_waitcnt vmcnt(0)" ::: "memory");
        __syncthreads();
    }
}

__global__ void __launch_bounds__(512, 2) fwd_megakernel(Params p) {
    extern __shared__ __attribute__((aligned(16))) unsigned char lds_raw[];
    LAS unsigned char* lds = (LAS unsigned char*)lds_raw;
    cg::grid_group grid = cg::this_grid();
    volatile LAS unsigned* xst = (volatile LAS unsigned*)(lds + LDS_BYTES - 16);
    if (threadIdx.x == 0) { xst[0] = 0u; xst[1] = 0u; xst[2] = 0u; xst[3] = 0u; }
    __syncthreads();
    const XcdBarrier xbar = xcd_barrier_post((unsigned*)(PF(ws) + WS_BAR), xst);
    const int G = gridDim.x, c = blockIdx.x;

    phase_mod(p, lds); __syncthreads();
    phase_rope(p);
    phase_convert(p, 0, lds);
    grid.sync();
#define WSP(T, off) ((T*)(PF(ws) + (off)))
    for (int l = 0; l < 2; ++l) {
        const bool lastl = (l == 1);
        const int Mrest = lastl ? NLAT : NTOK;
        if (l > 0) phase_convert(p, l, lds);
        phase_norm(p, l, l == 0 ? PF(x) : PF(out), l == 0 ? PF(ctx) : WSP(const float, WS_HC), PF(norm1_g) + l * DM, 0, NTOK,
                   (l > 0 && G == 256) ? (const float*)(PF(ws) + WS_P + (size_t)NTOK * DFF * 2) : nullptr, WSP(const float, WS_MOD) + (size_t)((l > 0 ? l - 1 : 0) * 9 + 8) * 6144 + 5120);
        xcd_barrier(xbar);

        { pg8::Gemm g{WSP(bf16_t, WS_U), WSP(bf16_t, WS_WIN), DM, DM, DM}; pg8::Sched S; S.init(NTOK, PW, G, c, DM, DM); pg8::EpiStore<0> E{WSP(bf16_t, WS_P), PW}; pg8::gemm_phase(lds, g, S, E); }
        xcd_barrier(xbar);
        if (c < 64) { hgrn_chain(p, l, lds, c); sub_barrier((unsigned*)(PF(ws) + WS_BAR) + 3520 + 64 * (2 * l), 64u); phase_hg_final(p, l, NTOK, c, 64); }
        else { const int cc = c - 64, GG = G - 64; const int nA = lastl ? 512 : 576;
            for (int it = cc; it < nA; it += GG) attn_item(p, l, lds, it);
            int staged = -1;
            for (int it = cc; it < 2304; it += GG) lru_tile(p, l, lds, it, 0, staged);
            sub_barrier((unsigned*)(PF(ws) + WS_BAR) + 3520 + 64 * (2 * l + 1), (unsigned)GG);
            for (int it = cc; it < 2304; it += GG) lru_tile(p, l, lds, it, 1, staged); }
        xcd_barrier(xbar);
        { pg8::Gemm g{WSP(bf16_t, WS_U), WSP(bf16_t, WS_WIN) + (size_t)PW * DM, DM, DM, DM}; pg8::Sched S; S.init(Mrest, 3072, G, c, DM, DM); pg8::EpiStore<1> E{WSP(bf16_t, WS_P), PW}; pg8::gemm_phase(lds, g, S, E); }
        xcd_barrier(xbar);
        { pg8::Gemm g{WSP(bf16_t, WS_P), WSP(bf16_t, WS_WB), PW, 512, 512}; pg8::MergeSched S; S.base.init(Mrest, DM, G, c, PW, 512);
          pg8::EpiMerge E{WSP(bf16_t, WS_P), WSP(bf16_t, WS_U)}; pg8::gemm_phase(lds, g, S, E); }
        xcd_barrier(xbar);
        { pg8::Gemm g{WSP(bf16_t, WS_U), WSP(bf16_t, WS_WO), DM, DM, DM};
          pg8::EpiResid E{l == 0 ? PF(x) : PF(out), l == 0 ? PF(ctx) : WSP(const float, WS_HC), PF(out), WSP(float, WS_HC), WSP(const float, WS_MOD) + (size_t)l * 9 * 6144 + 2048, WSP(float, WS_P)};
          if (!lastl && G == 256) { pg8::SplitSched S; S.base.init(NLAT, DM, G, c, DM, DM); S.sk = 256; pg8::gemm_phase(lds, g, S, E); }
          else { pg8::Sched S; S.init(Mrest, DM, G, c, DM, DM); pg8::gemm_phase(lds, g, S, E); } }
        xcd_barrier(xbar);
        if (!lastl && G == 256) phase_norm(p, l, PF(out), l == 0 ? PF(ctx) : WSP(const float, WS_HC), PF(norm2_g) + l * DM, 3072, Mrest, WSP(const float, WS_P), WSP(const float, WS_MOD) + (size_t)(l * 9 + 8) * 6144 + 2048, WSP(float, WS_HC));
        else phase_norm(p, l, PF(out), WSP(const float, WS_HC), PF(norm2_g) + l * DM, 3072, Mrest);
        xcd_barrier(xbar);
        { pg8::Gemm g{WSP(bf16_t, WS_U), WSP(bf16_t, WS_W1), DM, DM, DM}; pg8::Sched S; S.init(Mrest, DFF, G, c, DM, DM); pg8::EpiStore<2> E{WSP(bf16_t, WS_P), DFF}; pg8::gemm_phase(lds, g, S, E); }
        xcd_barrier(xbar);
        { pg8::Gemm g{WSP(bf16_t, WS_P), WSP(bf16_t, WS_W2), DFF, DFF, DFF};
          float* slab = (float*)(PF(ws) + WS_P + (size_t)NTOK * DFF * 2);
          pg8::EpiResid E{PF(out), WSP(const float, WS_HC), PF(out), WSP(float, WS_HC), WSP(const float, WS_MOD) + (size_t)l * 9 * 6144 + 5120, slab};
          if (!lastl && G == 256) { pg8::SplitSched S; S.base.init(NLAT, DM, G, c, DFF, DFF); S.sk = 1024; pg8::gemm_phase(lds, g, S, E); }
          else { pg8::Sched S; S.init(Mrest, DM, G, c, DFF, DFF); pg8::gemm_phase(lds, g, S, E); } }
        if (!lastl) xcd_barrier(xbar);
    }
}

extern "C" void kernel_launch(void* const* d_in, const int* in_sizes, int n_in, void* d_out, int out_size, void* d_ws, size_t ws_size, hipStream_t stream) {
    static int grid_blocks = 0;
    if (grid_blocks == 0) {
        int dev = 0, cus = 0, per_cu = 0;
        hipGetDevice(&dev);
        hipDeviceGetAttribute(&cus, hipDeviceAttributeMultiprocessorCount, dev);
        hipFuncSetAttribute((const void*)fwd_megakernel, hipFuncAttributeMaxDynamicSharedMemorySize, LDS_BYTES);
        hipOccupancyMaxActiveBlocksPerMultiprocessor(&per_cu, (const void*)fwd_megakernel, 512, LDS_BYTES);
        if (per_cu < 1 || n_in != 25 || ws_size < WS_END) { fprintf(stderr, "kernel_launch: cannot launch (per_cu %d, n_in %d, ws %zu need %zu)\n", per_cu, n_in, ws_size, (size_t)WS_END); grid_blocks = -1; }
        else grid_blocks = cus;
    }
    if (grid_blocks < 0) return;
    hipMemsetAsync((char*)d_ws + WS_BAR, 0, 16384, stream);
    Params p{};
    const float** pp = (const float**)&p;
    for (int i = 0; i < 25; ++i) pp[i] = (const float*)d_in[i];
    p.out = (float*)d_out; p.ws = (unsigned char*)d_ws;
    void* args[] = {&p};
    hipError_t e = hipLaunchCooperativeKernel((const void*)fwd_megakernel, dim3(grid_blocks), dim3(512), args, LDS_BYTES, stream);
    if (e != hipSuccess) fprintf(stderr, "cooperative launch failed: %s (grid %d)\n", hipGetErrorString(e), grid_blocks);
}
```

```cpp
#include <hip/hip_runtime.h>
#include <hip/hip_cooperative_groups.h>
#include <stdint.h>
#include <stdio.h>
namespace cg = cooperative_groups;

#define LAS __attribute__((address_space(3)))
typedef unsigned short bf16_t;
typedef short bf16x8 __attribute__((ext_vector_type(8)));
typedef float f32x4 __attribute__((ext_vector_type(4)));
typedef unsigned u32x4 __attribute__((ext_vector_type(4)));
typedef unsigned u32x2 __attribute__((ext_vector_type(2)));

constexpr int DM = 1024, NB = 8, SEQ = 2048, CTXL = 256, NLAT = NB * SEQ, NCTX = NB * CTXL, NTOK = NLAT + NCTX;
constexpr int PW = 5120, DIN = 8192, DFF = 4096;
constexpr int C_AX = 0, C_AG = 512, C_BQ = 1024, C_BF = 1536, C_BI = 2560, C_BO = 3072, C_CQ = 3584, C_CK = 4096, C_CV = 4608;
constexpr int LDS_BYTES = 163840;
constexpr size_t WS_WIN = 0;
constexpr size_t WS_WB = WS_WIN + (size_t)DIN * DM * 2;
constexpr size_t WS_WO = WS_WB + (size_t)3 * DM * 512 * 2;
constexpr size_t WS_W1 = WS_WO + (size_t)DM * DM * 2;
constexpr size_t WS_W2 = WS_W1 + (size_t)DFF * DM * 2;
constexpr size_t WS_U = WS_W2 + (size_t)DM * DFF * 2;
constexpr size_t WS_P = WS_U + (size_t)NTOK * DM * 2;
constexpr size_t WS_HC = WS_P + (size_t)NTOK * PW * 2;
constexpr size_t WS_MOD = WS_HC + (size_t)NCTX * DM * 4;
constexpr size_t WS_AGG = WS_MOD + (size_t)2 * 9 * 6144 * 4;
constexpr size_t WS_ROPE = WS_AGG + (size_t)NB * 36 * 2 * 2 * 512 * 4;
constexpr size_t WS_DUMMY = WS_ROPE + 2048 * 4;
constexpr size_t WS_BAR = WS_DUMMY + (2u << 20);
constexpr size_t WS_END = WS_BAR + 16384;

struct Params {
    const float *x, *c, *ctx, *c_ctx, *ada_w, *ada_b, *norm1_g, *norm2_g, *w_in, *conv_w, *conv_b, *lru_wa, *lru_ba, *lru_wx, *lru_bx, *lru_lambda,
        *hg_lb, *hg_norm_g, *na_qg, *na_kg, *na_rpb, *w_branch, *w_out, *ffn_w1, *ffn_w2;
    float* out; unsigned char* ws;
};


__device__ __forceinline__ unsigned long long ldkarg(int off) { unsigned long long v = 0;
#if defined(__HIP_DEVICE_COMPILE__)
    auto kp = __builtin_amdgcn_kernarg_segment_ptr();
    asm volatile("s_load_dwordx2 %0, %1, %2\n\ts_waitcnt lgkmcnt(0)" : "=s"(v) : "s"(kp), "s"(off));
#endif
    return v; }
template <class T> struct rm_ptr; template <class T> struct rm_ptr<T*> { typedef T type; };
template <class T> __device__ __forceinline__ T* as_global_ptr(unsigned long long v) { return (T*)(__attribute__((address_space(1))) T*)v; }
#define PF(f) (as_global_ptr<rm_ptr<decltype(Params::f)>::type>(ldkarg((int)__builtin_offsetof(Params, f))))

#define GAS __attribute__((address_space(1)))
template <class T> __device__ __forceinline__ GAS T* lnd(T* p) { asm volatile("" : "+v"(p)); return (GAS T*)p; }
__device__ __forceinline__ int tid_() { int t = threadIdx.x; asm volatile("" : "+v"(t)); return t; }
__device__ __forceinline__ float bf2f(unsigned v) { return __uint_as_float(v << 16); }
__device__ __forceinline__ float bflo(unsigned w) { return __uint_as_float(w << 16); }
__device__ __forceinline__ float bfhi(unsigned w) { return __uint_as_float(w & 0xffff0000u); }
__device__ __forceinline__ unsigned f2bf(float f) { unsigned u = __float_as_uint(f); u += 0x7fffu + ((u >> 16) & 1u); return u >> 16; }
typedef __bf16 bf16x2_t __attribute__((ext_vector_type(2)));
typedef float f32x2_t __attribute__((ext_vector_type(2)));
__device__ __forceinline__ unsigned pack2(float lo, float hi) { f32x2_t v = {lo, hi}; bf16x2_t b = __builtin_convertvector(v, bf16x2_t); union { bf16x2_t b; unsigned u; } t; t.b = b; return t.u; }
__device__ __forceinline__ float sigmoidf_(float x) { return 1.0f / (1.0f + __expf(-x)); }
__device__ __forceinline__ f32x4 mfma16(bf16x8 a, bf16x8 b, f32x4 c) { return __builtin_amdgcn_mfma_f32_16x16x32_bf16(a, b, c, 0, 0, 0); }
__device__ __forceinline__ bf16x8 as_bf16x8(u32x4 v) { union { u32x4 u; bf16x8 b; } t; t.u = v; return t.b; }
__device__ __forceinline__ void unpack8(u32x4 w, float* o) { o[0] = bflo(w.x); o[1] = bfhi(w.x); o[2] = bflo(w.y); o[3] = bfhi(w.y); o[4] = bflo(w.z); o[5] = bfhi(w.z); o[6] = bflo(w.w); o[7] = bfhi(w.w); }
__device__ __forceinline__ u32x4 pack8(const float* v) { u32x4 w; w.x = pack2(v[0], v[1]); w.y = pack2(v[2], v[3]); w.z = pack2(v[4], v[5]); w.w = pack2(v[6], v[7]); return w; }

namespace pg8 {
constexpr int BM = 256, BK = 64, HALF = 128, HTB = HALF * BK * 2, NXCD = 8, WGM = 4;
__device__ __forceinline__ int lds_byte(int r, int c) { const int st = (r >> 4) * 2 + (c >> 5), rr = r & 15, cc = c & 31, ob = rr * 64 + cc * 2; return st * 1024 + (ob ^ (((ob >> 9) & 1) << 5)); }
__device__ __forceinline__ void stage_rc(int b, int& R, int& C) { const int st = b / 1024, sb = b % 1024, swz = sb ^ (((sb >> 9) & 1) << 5); R = (st >> 1) * 16 + swz / 64; C = (st & 1) * 32 + (swz % 64) / 2; }
__device__ __forceinline__ int perm32(int rho) { const int n = rho >> 4, i = rho & 15; return 8 * (i >> 2) + 4 * n + (i & 3); }

struct Unit { int pm, pn, sub, nt; size_t aoff, boff; };
struct Gemm { const bf16_t* A; const bf16_t* Bt; int lda, ldb, K; };
struct Sched {
    int nM, nN, nwg, G, c, lda, ldb, nt;
    __device__ void init(int M, int N, int G_, int c_, int lda_, int ldb_) { nM = M / BM; nN = N / BM; nwg = nM * nN; G = G_; c = c_; lda = lda_; ldb = ldb_; nt = 0; }
    __device__ bool next(int i, Unit& u) const {
        const long L = (long)i * G + c; if (L >= nwg) return false;
        int wgid = (int)L; { const int q = nwg / NXCD, r = nwg % NXCD, xcd = wgid % NXCD, off = wgid / NXCD; wgid = (xcd < r ? xcd * (q + 1) : r * (q + 1) + (xcd - r) * q) + off; }
        const int nig = WGM * nN, gid = wgid / nig, fm = gid * WGM, gsz = (nM - fm) < WGM ? (nM - fm) : WGM;
        u.pm = fm + ((wgid % nig) % gsz); u.pn = (wgid % nig) / gsz; u.sub = 0; u.nt = nt;
        u.aoff = (size_t)u.pm * BM * lda * 2;
        u.boff = (size_t)u.pn * BM * ldb * 2;
        return true;
    }
};

template <int ACT> struct EpiStore {
    static constexpr bool PERM = true;
    bf16_t* O; int ldc;
    __device__ __forceinline__ void operator()(const f32x4 (&acc)[2][2][4][2], const Unit& u, int wr, int wc, int fr, int fq) const {
        const int row0 = u.pm * BM + wr * 64 + fr; int colt = u.pn * BM;
        if (ACT == 1) colt = (colt < 2048) ? (1024 + colt) : (2048 + colt);
        const int col0 = colt + wc * 32 + 8 * fq;
#pragma unroll
        for (int ai = 0; ai < 2; ++ai)
#pragma unroll
            for (int m = 0; m < 4; ++m) { GAS bf16_t* rowp = lnd(O + (size_t)(row0 + ai * HALF + m * 16) * ldc + col0);
#pragma unroll
                for (int bj = 0; bj < 2; ++bj) { f32x4 v0 = acc[ai][bj][m][0], v1 = acc[ai][bj][m][1];
                    if (ACT == 1) {
#pragma unroll
                        for (int j = 0; j < 4; ++j) { v0[j] = sigmoidf_(v0[j]); v1[j] = sigmoidf_(v1[j]); } }
                    if (ACT == 2) {
#pragma unroll
                        for (int j = 0; j < 4; ++j) { float a = fmaxf(v0[j], 0.f), b = fmaxf(v1[j], 0.f); v0[j] = a * a; v1[j] = b * b; } }
                    u32x4 w; w.x = pack2(v0[0], v0[1]); w.y = pack2(v0[2], v0[3]); w.z = pack2(v1[0], v1[1]); w.w = pack2(v1[2], v1[3]);
                    *(GAS u32x4*)(rowp + bj * HALF) = w; } }
    }
};
struct EpiMerge {
    static constexpr bool PERM = true;
    const bf16_t* P; bf16_t* U;
    __device__ __forceinline__ void operator()(const f32x4 (&acc)[2][2][4][2], const Unit& u, int wr, int wc, int fr, int fq) const {
        const int row0 = u.pm * BM + wr * 64 + fr; const int col0 = u.pn * BM + wc * 32 + 8 * fq;
        const int sub = u.sub; const int gcol = sub * 1024 + u.pn * BM; const int gd = ((gcol < 2048) ? (1024 + gcol) : (2048 + gcol)) + wc * 32 + 8 * fq;
        const bool addp = sub > 0;
#pragma unroll
        for (int ai = 0; ai < 2; ++ai)
#pragma unroll
            for (int m = 0; m < 4; ++m) { const size_t row = (size_t)(row0 + ai * HALF + m * 16); const GAS bf16_t* gp = lnd(P + row * PW + gd); GAS bf16_t* up = lnd(U + row * DM + col0);
#pragma unroll
                for (int bj = 0; bj < 2; ++bj) { const u32x4 gw = *(const GAS u32x4*)(gp + bj * HALF);
                    f32x4 a0 = acc[ai][bj][m][0], a1 = acc[ai][bj][m][1];
                    a0[0] *= bflo(gw.x); a0[1] *= bfhi(gw.x); a0[2] *= bflo(gw.y); a0[3] *= bfhi(gw.y); a1[0] *= bflo(gw.z); a1[1] *= bfhi(gw.z); a1[2] *= bflo(gw.w); a1[3] *= bfhi(gw.w);
                    if (addp) { const u32x4 pw = *(const GAS u32x4*)(up + bj * HALF);
                        a0[0] += bflo(pw.x); a0[1] += bfhi(pw.x); a0[2] += bflo(pw.y); a0[3] += bfhi(pw.y); a1[0] += bflo(pw.z); a1[1] += bfhi(pw.z); a1[2] += bflo(pw.w); a1[3] += bfhi(pw.w); }
                    u32x4 o; o.x = pack2(a0[0], a0[1]); o.y = pack2(a0[2], a0[3]); o.z = pack2(a1[0], a1[1]); o.w = pack2(a1[2], a1[3]);
                    *(GAS u32x4*)(up + bj * HALF) = o; } }
    }
};
struct EpiResid {
    static constexpr bool PERM = true;
    const float* inL; const float* inC; float* outL; float* outC; const float* mod;
    float* slab;
    __device__ __forceinline__ void operator()(const f32x4 (&acc)[2][2][4][2], const Unit& u, int wr, int wc, int fr, int fq) const {
        if (u.sub >= 1) {
            const int row0 = (u.pm - 64) * BM + wr * 64 + fr, col0 = u.pn * BM + wc * 32 + 8 * fq; float* sl = slab + (size_t)(u.sub - 1) * NCTX * DM;
#pragma unroll
            for (int ai = 0; ai < 2; ++ai)
#pragma unroll
                for (int m = 0; m < 4; ++m)
#pragma unroll
                    for (int bj = 0; bj < 2; ++bj) { GAS float* op = lnd(sl + (size_t)(row0 + ai * HALF + m * 16) * DM + col0 + bj * HALF); *(GAS f32x4*)op = acc[ai][bj][m][0]; *(GAS f32x4*)(op + 4) = acc[ai][bj][m][1]; }
            return;
        }
        const bool lat = u.pm < 64; const int rbase = lat ? u.pm * BM : (u.pm - 64) * BM;
        const float* in = lat ? inL : inC; float* out = lat ? outL : outC;
        const int row0 = rbase + wr * 64 + fr, col0 = u.pn * BM + wc * 32 + 8 * fq;
        const float* gt = mod + (size_t)(lat ? (u.pm >> 3) : 8) * 6144 + col0;
#pragma unroll
        for (int bj = 0; bj < 2; ++bj) { const f32x4 g0 = *(const f32x4*)(gt + bj * HALF), g1 = *(const f32x4*)(gt + bj * HALF + 4);
#pragma unroll
            for (int ai = 0; ai < 2; ++ai)
#pragma unroll
                for (int m = 0; m < 4; ++m) { const size_t ro = (size_t)(row0 + ai * HALF + m * 16) * DM + col0 + bj * HALF;
                    const GAS float* ip = lnd(in + ro); GAS float* op = lnd(out + ro); const f32x4 i0 = *(const GAS f32x4*)ip, i1 = *(const GAS f32x4*)(ip + 4);
                    *(GAS f32x4*)op = i0 + g0 * acc[ai][bj][m][0]; *(GAS f32x4*)(op + 4) = i1 + g1 * acc[ai][bj][m][1]; } }
    }
};

struct MergeSched {
    Sched base;
    __device__ bool next(int i, Unit& u) const {
        const int r = i / 3, n = i - 3 * r;
        if (!base.next(r, u)) return false;
        u.sub = n; u.aoff += (size_t)(n == 0 ? C_AG : C_BO + (n - 1) * 512) * 2; u.boff += (size_t)n * DM * 512 * 2;
        return true;
    }
};
struct SplitSched {
    Sched base;
    int sk;
    __device__ bool next(int i, Unit& u) const {
        if (base.next(i, u)) return true;
        const int nfull = (base.nwg - base.c + base.G - 1) / base.G;
        const int k = i - nfull; const int un = k * base.G + base.c; if (k < 0 || un >= 128) return false;
        const int ct = un >> 2, sl = un & 3; u.pm = 64 + (ct >> 2); u.pn = ct & 3; u.sub = 1 + sl; u.nt = sk / BK;
        u.aoff = (size_t)u.pm * BM * base.lda * 2 + (size_t)sl * sk * 2; u.boff = (size_t)u.pn * BM * base.ldb * 2 + (size_t)sl * sk * 2;
        return true;
    }
};
template <class Epi, class Sch>
__device__ __forceinline__ void gemm_phase(LAS unsigned char* lds, const Gemm g, const Sch& S, const Epi& E) {
    const int tid = tid_(), wid = __builtin_amdgcn_readfirstlane(tid >> 6), lane = tid & 63, wr = wid >> 2, wc = wid & 3, fr = lane & 15, fq = lane >> 4;
    const int K = g.K;
    unsigned voffA[2], voffB[2];
#pragma unroll
    for (int i = 0; i < 2; ++i) { int R, C; stage_rc(tid * 16 + i * 8192, R, C); const int Rb = Epi::PERM ? ((R & ~31) + perm32(R & 31)) : R;
        voffA[i] = (unsigned)(R * g.lda + C) * 2u; voffB[i] = (unsigned)(Rb * g.ldb + C) * 2u; }
    const size_t kstep = (size_t)(BK * 2);
    const size_t hstepA = (size_t)HALF * g.lda * 2, hstepB = (size_t)HALF * g.ldb * 2;
    const unsigned ldsw = (unsigned)wid * 1024u;
    const int aoff = lds_byte(wr * 64 + fr, fq * 8), boff = lds_byte(wc * 32 + fr, fq * 8);
#define PG8_SA(b, h) (((b) * 2 + (h)) * HTB)
#define PG8_SB(b, h) ((4 + (b) * 2 + (h)) * HTB)
#define PG8_STAGE(bufoff, gbase, voff) do { _Pragma("unroll") for (int _i = 0; _i < 2; ++_i) \
        __builtin_amdgcn_global_load_lds((const unsigned*)((const char*)(gbase) + (voff)[_i]), (LAS unsigned*)(lds + (bufoff) + ldsw + _i * 8192), 16, 0, 0); } while (0)
#define PG8_LDA(dst, b, h) do { _Pragma("unroll") for (int m = 0; m < 4; ++m) _Pragma("unroll") for (int k = 0; k < 2; ++k) dst[m][k] = *(const LAS bf16x8*)(lds + PG8_SA(b, h) + aoff + m * 2048 + k * 1024); } while (0)
#define PG8_LDB(dst, b, h) do { _Pragma("unroll") for (int n = 0; n < 2; ++n) _Pragma("unroll") for (int k = 0; k < 2; ++k) dst[n][k] = *(const LAS bf16x8*)(lds + PG8_SB(b, h) + boff + n * 2048 + k * 1024); } while (0)
#define PG8_MMA(ai, bj, At, Bt) do { __builtin_amdgcn_s_setprio(1); _Pragma("unroll") for (int m = 0; m < 4; ++m) _Pragma("unroll") for (int n = 0; n < 2; ++n) _Pragma("unroll") for (int k = 0; k < 2; ++k) \
        acc[ai][bj][m][n] = __builtin_amdgcn_mfma_f32_16x16x32_bf16(Bt[n][k], At[m][k], acc[ai][bj][m][n], 0, 0, 0); __builtin_amdgcn_s_setprio(0); } while (0)
#define PG8_WAIT_V(n) asm volatile("s_waitcnt vmcnt(" #n ")" ::: "memory")
#define PG8_WAIT_L(n) asm volatile("s_waitcnt lgkmcnt(" #n ")" ::: "memory")
#define PG8_BAR __builtin_amdgcn_s_barrier()
#define PG8_SCHED __builtin_amdgcn_sched_barrier(0)
    Unit cur, nxt; int ui = 0;
    if (!S.next(0, cur)) return;
    f32x4 acc[2][2][4][2];
#pragma unroll
    for (int a = 0; a < 2; ++a)
#pragma unroll
        for (int b = 0; b < 2; ++b)
#pragma unroll
            for (int m = 0; m < 4; ++m)
#pragma unroll
                for (int n = 0; n < 2; ++n) acc[a][b][m][n] = (f32x4){0.f, 0.f, 0.f, 0.f};
    bf16x8 At[4][2], B0[2][2], B1[2][2];
    const char* cA = (const char*)g.A + cur.aoff; const char* cB = (const char*)g.Bt + cur.boff;
    PG8_STAGE(PG8_SB(0, 0), cB, voffB); PG8_STAGE(PG8_SB(0, 1), cB + hstepB, voffB); PG8_STAGE(PG8_SA(0, 0), cA, voffA); PG8_STAGE(PG8_SA(0, 1), cA + hstepA, voffA);
    if (wr == 1) PG8_BAR;
    PG8_WAIT_V(2); PG8_BAR;
    PG8_STAGE(PG8_SB(1, 0), cB + kstep, voffB); PG8_STAGE(PG8_SA(1, 0), cA + kstep, voffA); PG8_STAGE(PG8_SB(1, 1), cB + hstepB + kstep, voffB);
    PG8_WAIT_V(6); PG8_BAR;
    for (;;) {
        const bool has_next = S.next(ui + 1, nxt);
        const char* nA = has_next ? (const char*)g.A + nxt.aoff : cA; const char* nB = has_next ? (const char*)g.Bt + nxt.boff : cB;
        const int nt = cur.nt ? cur.nt : K / BK;
        for (int t = 0; t < nt; t += 2) {
            const bool last = (t == nt - 2);
            const char* a1 = cA + (size_t)(t + 1) * kstep;
            const char* a2 = last ? nA : cA + (size_t)(t + 2) * kstep; const char* b2 = last ? nB : cB + (size_t)(t + 2) * kstep;
            const char* a3 = a2 + kstep; const char* b3 = b2 + kstep;
            PG8_LDB(B0, 0, 0); PG8_LDB(B1, 0, 1); PG8_SCHED; PG8_LDA(At, 0, 0); PG8_STAGE(PG8_SA(1, 1), a1 + hstepA, voffA);
            PG8_WAIT_V(8); PG8_WAIT_L(0); PG8_BAR; PG8_MMA(0, 0, At, B0); PG8_MMA(0, 1, At, B1); PG8_BAR; PG8_SCHED;
            PG8_LDA(At, 0, 1); PG8_STAGE(PG8_SB(0, 0), b2, voffB); PG8_STAGE(PG8_SB(0, 1), b2 + hstepB, voffB); PG8_STAGE(PG8_SA(0, 0), a2, voffA);
            PG8_WAIT_V(8); PG8_WAIT_L(0); PG8_BAR; PG8_MMA(1, 0, At, B0); PG8_MMA(1, 1, At, B1); PG8_BAR; PG8_SCHED;
            PG8_LDB(B0, 1, 0); PG8_LDB(B1, 1, 1); PG8_SCHED; PG8_LDA(At, 1, 0); PG8_STAGE(PG8_SA(0, 1), a2 + hstepA, voffA);
            PG8_WAIT_V(8); PG8_WAIT_L(0); PG8_BAR; PG8_MMA(0, 0, At, B0); PG8_MMA(0, 1, At, B1); PG8_BAR; PG8_SCHED;
            PG8_LDA(At, 1, 1); PG8_STAGE(PG8_SB(1, 0), b3, voffB); PG8_STAGE(PG8_SB(1, 1), b3 + hstepB, voffB); PG8_STAGE(PG8_SA(1, 0), a3, voffA);
            PG8_WAIT_V(8); PG8_WAIT_L(0); PG8_BAR; PG8_MMA(1, 0, At, B0); PG8_MMA(1, 1, At, B1); PG8_BAR; PG8_SCHED;
        }
        if (wr == 0) PG8_BAR;
        E(acc, cur, wr, wc, fr, fq);
        if (!has_next) break;
#pragma unroll
        for (int a = 0; a < 2; ++a)
#pragma unroll
            for (int b = 0; b < 2; ++b)
#pragma unroll
                for (int m = 0; m < 4; ++m)
#pragma unroll
                    for (int n = 0; n < 2; ++n) acc[a][b][m][n] = (f32x4){0.f, 0.f, 0.f, 0.f};
        cur = nxt; cA = nA; cB = nB; ++ui;
        if (wr == 1) PG8_BAR;
    }
    PG8_WAIT_V(0);
    PG8_BAR;
#undef PG8_SA
#undef PG8_SB
#undef PG8_STAGE
#undef PG8_LDA
#undef PG8_LDB
#undef PG8_MMA
#undef PG8_WAIT_V
#undef PG8_WAIT_L
#undef PG8_BAR
#undef PG8_SCHED
}
}


#define XB_TMO      128
#define XB_XCNT(j)  (256  + 64 * (j))
#define XB_XSUB(j)  (1280 + 64 * (j))
#define XB_XGEN(j)  (2304 + 64 * (j))
#define XB_TOP      3328
#define XB_TOPGEN   3392
#define XCD_BAR_WORDS 3456
#define XB_SPIN_CAP (1u << 20)
__device__ __forceinline__ unsigned xb_ld(unsigned* p)              { return __hip_atomic_load(p, __ATOMIC_RELAXED, __HIP_MEMORY_SCOPE_AGENT); }
__device__ __forceinline__ unsigned xb_add(unsigned* p, unsigned v) { return __hip_atomic_fetch_add(p, v, __ATOMIC_RELAXED, __HIP_MEMORY_SCOPE_AGENT); }
__device__ __forceinline__ unsigned xb_xcc_id() { return (unsigned)__builtin_amdgcn_s_getreg((3 << 11) | 20) & 0xFu; }
#define XB_SPIN(cond, bar) do { unsigned _sp = 0; while (cond) { __builtin_amdgcn_s_sleep(0); \
    if ((++_sp & 255u) == 0u) { if (xb_ld(&(bar)[XB_TMO])) break; if (_sp > XB_SPIN_CAP) { atomicAdd(&(bar)[XB_TMO], 1u); break; } } } } while (0)
struct XcdBarrier { unsigned* bar; unsigned x; volatile LAS unsigned* st; };
__device__ __forceinline__ XcdBarrier xcd_barrier_post(unsigned* bar, volatile LAS unsigned* st) {
    XcdBarrier b; b.bar = bar; b.x = xb_xcc_id(); b.st = st;
    if (threadIdx.x == 0) (void)xb_add(&bar[XB_XCNT(b.x)], 1u);
    return b;
}
__device__ __forceinline__ void xcd_barrier_complete(unsigned* bar, unsigned x, unsigned& nloc, unsigned& nx) {
    const unsigned G = gridDim.x * gridDim.y * gridDim.z;
    unsigned sum, cnt, mine, sp = 0u;
    for (;;) {
        sum = 0u; cnt = 0u; mine = 0u;
#pragma unroll
        for (unsigned j = 0; j < 16; ++j) { const unsigned c = xb_ld(&bar[XB_XCNT(j)]); sum += c; cnt += (c > 0u) ? 1u : 0u; mine = (j == x) ? c : mine; }
        if (sum == G) break;
        __builtin_amdgcn_s_sleep(1);
        if ((++sp & 255u) == 0u) { if (xb_ld(&bar[XB_TMO])) break; if (sp > XB_SPIN_CAP) { atomicAdd(&bar[XB_TMO], 1u); break; } }
    }
    nloc = mine > 0u ? mine : 1u; nx = cnt > 0u ? cnt : 1u;
}
__device__ __forceinline__ void xcd_barrier(const XcdBarrier& b) {
    asm volatile("s_waitcnt vmcnt(0)" ::: "memory");
    __syncthreads();
    if (threadIdx.x == 0) {
        unsigned* bar = b.bar;
        __builtin_amdgcn_s_waitcnt(0);
        unsigned nloc = b.st[0], nx = b.st[1];
        if (nloc == 0u) { xcd_barrier_complete(bar, b.x, nloc, nx); b.st[0] = nloc; b.st[1] = nx; }
        const unsigned old = xb_add(&bar[XB_XSUB(b.x)], 1u);
        const unsigned gen = old / nloc;
        if (old + 1u == (gen + 1u) * nloc) {
            __builtin_amdgcn_fence(__ATOMIC_RELEASE, "agent");
            asm volatile("s_waitcnt vmcnt(0)" ::: "memory");
            const unsigned og = xb_add(&bar[XB_TOP], 1u);
            const unsigned tg = og / nx;
            if (og + 1u == (tg + 1u) * nx) xb_add(&bar[XB_TOPGEN], 1u);
            else XB_SPIN(xb_ld(&bar[XB_TOPGEN]) == tg, bar);
            __builtin_amdgcn_fence(__ATOMIC_ACQUIRE, "agent");
            xb_add(&bar[XB_XGEN(b.x)], 1u);
            asm volatile("s_waitcnt vmcnt(0)" ::: "memory");
        } else {
            XB_SPIN(xb_ld(&bar[XB_XGEN(b.x)]) == gen, bar);
            __builtin_amdgcn_fence(__ATOMIC_ACQUIRE, "agent");
            asm volatile("s_waitcnt vmcnt(0)" ::: "memory");
        }
    }
    __syncthreads();
}

__device__ __forceinline__ void sub_barrier(unsigned* word, unsigned n) {
    asm volatile("s_waitcnt vmcnt(0)" ::: "memory");
    __syncthreads();
    if (threadIdx.x == 0) {
        __builtin_amdgcn_fence(__ATOMIC_RELEASE, "agent");
        asm volatile("s_waitcnt vmcnt(0)" ::: "memory");
        xb_add(word, 1u);
        unsigned sp = 0;
        while (xb_ld(word) < n) { __builtin_amdgcn_s_sleep(0); if (++sp > (1u << 22)) break; }
        __builtin_amdgcn_fence(__ATOMIC_ACQUIRE, "agent");
        asm volatile("s_waitcnt vmcnt(0)" ::: "memory");
    }
    __syncthreads();
}

__device__ __forceinline__ void phase_mod(const Params& p, LAS unsigned char* lds) {
    LAS float* sc = (LAS float*)lds;
    LAS float* part = sc + 9 * 1024;
    float* mod = (float*)(PF(ws) + WS_MOD);
    const int tid = tid_(), w = tid >> 6, lane = tid & 63;
    if ((int)blockIdx.x >= 192) return;
    const float* pc = PF(c); const float* pcc = PF(c_ctx); const float* padaw = PF(ada_w); const float* padab = PF(ada_b);
    for (int i = tid; i < 9 * 1024; i += 512) { const int r = i >> 10, k = i & 1023; const float v = (r < 8) ? pc[r * 1024 + k] : pcc[k]; sc[i] = v / (1.0f + expf(-v)); }
    __syncthreads();
    for (int item = blockIdx.x; item < 192; item += gridDim.x) {
        const int l = item / 96, cb = item % 96;
        const float* W = padaw + (size_t)l * 1024 * 6144 + cb * 64 + lane;
        float acc[9];
#pragma unroll
        for (int r = 0; r < 9; ++r) acc[r] = 0.f;
        for (int k = w * 128; k < w * 128 + 128; ++k) { const float wv = W[(size_t)k * 6144];
#pragma unroll
            for (int r = 0; r < 9; ++r) acc[r] += sc[r * 1024 + k] * wv; }
#pragma unroll
        for (int r = 0; r < 9; ++r) part[(w * 9 + r) * 64 + lane] = acc[r];
        __syncthreads();
        for (int i = tid; i < 576; i += 512) { const int r = i >> 6, ln = i & 63; float s = 0.f;
#pragma unroll
            for (int ww = 0; ww < 8; ++ww) s += part[(ww * 9 + r) * 64 + ln];
            mod[(size_t)(l * 9 + r) * 6144 + cb * 64 + ln] = s + padab[l * 6144 + cb * 64 + ln]; }
        __syncthreads();
    }
}
__device__ __forceinline__ void phase_rope(const Params& p) {
    if (blockIdx.x != gridDim.x - 1) return;
    float* rope = (float*)(PF(ws) + WS_ROPE);
    for (int i = tid_(); i < 1024; i += 512) { const int pos = i >> 4, fi = i & 15; const float invf = powf(10000.0f, -(float)fi / 16.0f); const float ang = (float)pos * invf; rope[i] = cosf(ang); rope[1024 + i] = sinf(ang); }
}
__device__ __forceinline__ void convert_tile(const float* src, int K, int N, bf16_t* dst, int tile, LAS bf16_t* T) {
    const int tid = tid_(), tilesN = N >> 7, tk = tile / tilesN, tn = tile - tk * tilesN, k0 = tk * 128, n0 = tn * 128;
    const int r = tid >> 4, c8 = (tid & 15) * 8;
    f32x4 a[4], b[4];
#pragma unroll
    for (int i = 0; i < 4; ++i) { const float* s = src + (size_t)(k0 + r + 32 * i) * N + n0 + c8; a[i] = *(const f32x4*)s; b[i] = *(const f32x4*)(s + 4); }
#pragma unroll
    for (int i = 0; i < 4; ++i)
#pragma unroll
        for (int j = 0; j < 4; ++j) { T[(c8 + j) * 136 + r + 32 * i] = (bf16_t)f2bf(a[i][j]); T[(c8 + 4 + j) * 136 + r + 32 * i] = (bf16_t)f2bf(b[i][j]); }
    __syncthreads();
    const int n = tid >> 2, ks = (tid & 3) * 8;
#pragma unroll
    for (int i = 0; i < 4; ++i) { const u32x4 v = *(const LAS u32x4*)(T + n * 136 + ks + 32 * i); *(u32x4*)(dst + (size_t)(n0 + n) * K + k0 + ks + 32 * i) = v; }
    __syncthreads();
}
__device__ __forceinline__ void phase_convert(const Params& p, int l, LAS unsigned char* lds) {
    LAS bf16_t* T = (LAS bf16_t*)lds;
    bf16_t* WIN = (bf16_t*)(PF(ws) + WS_WIN); bf16_t* WB = (bf16_t*)(PF(ws) + WS_WB); bf16_t* WO = (bf16_t*)(PF(ws) + WS_WO); bf16_t* W1 = (bf16_t*)(PF(ws) + WS_W1); bf16_t* W2 = (bf16_t*)(PF(ws) + WS_W2);
    for (int it = blockIdx.x; it < 1184; it += gridDim.x) {
        if (it < 512) convert_tile(PF(w_in) + (size_t)l * DM * DIN, DM, DIN, WIN, it, T);
        else if (it < 608) { const int n = (it - 512) / 32, tl = (it - 512) % 32; convert_tile(PF(w_branch) + (size_t)(l * 3 + n) * 512 * DM, 512, DM, WB + (size_t)n * DM * 512, tl, T); }
        else if (it < 672) convert_tile(PF(w_out) + (size_t)l * DM * DM, DM, DM, WO, it - 608, T);
        else if (it < 928) convert_tile(PF(ffn_w1) + (size_t)l * DM * DFF, DM, DFF, W1, it - 672, T);
        else convert_tile(PF(ffn_w2) + (size_t)l * DFF * DM, DFF, DM, W2, it - 928, T);
    }
}
__device__ __forceinline__ void phase_norm(const Params& p, int l, const float* hlat, const float* hctx, const float* g, int modoff, int nrows, const float* slab = nullptr, const float* slabgate = nullptr, float* hwrite = nullptr) {
    const int tid = tid_(); const int w = tid >> 6, lane = tid & 63;
    bf16_t* U = (bf16_t*)(PF(ws) + WS_U); const float* mod = (const float*)(PF(ws) + WS_MOD);
    for (int row = blockIdx.x * 8 + w; row < nrows; row += gridDim.x * 8) {
        const float* src = row < NLAT ? hlat + (size_t)row * DM : hctx + (size_t)(row - NLAT) * DM;
        const int mr = row < NLAT ? (row >> 11) : 8;
        const float* md = mod + (size_t)(l * 9 + mr) * 6144 + modoff;
        f32x4 v[4]; float ss = 0.f;
#pragma unroll
        for (int i = 0; i < 4; ++i) { v[i] = *(const f32x4*)(src + i * 256 + lane * 4);
            if (slab != nullptr && row >= NLAT) { const size_t o = (size_t)(row - NLAT) * DM + i * 256 + lane * 4; const f32x4 gg = *(const f32x4*)(slabgate + i * 256 + lane * 4);
                const f32x4 s4 = (*(const f32x4*)(slab + o) + *(const f32x4*)(slab + o + (size_t)NCTX * DM)) + (*(const f32x4*)(slab + o + (size_t)2 * NCTX * DM) + *(const f32x4*)(slab + o + (size_t)3 * NCTX * DM));
                v[i] += gg * s4; if (hwrite != nullptr) *(f32x4*)(hwrite + o) = v[i]; }
            ss += v[i][0] * v[i][0] + v[i][1] * v[i][1] + v[i][2] * v[i][2] + v[i][3] * v[i][3]; }
#pragma unroll
        for (int o = 32; o >= 1; o >>= 1) ss += __shfl_xor(ss, o);
        const float rstd = rsqrtf(ss * (1.0f / 1024.0f) + 1e-6f);
#pragma unroll
        for (int i = 0; i < 4; ++i) { const int cidx = i * 256 + lane * 4; const f32x4 gg = *(const f32x4*)(g + cidx), sh = *(const f32x4*)(md + cidx), scv = *(const f32x4*)(md + 1024 + cidx);
            float o4[4];
#pragma unroll
            for (int j = 0; j < 4; ++j) o4[j] = (v[i][j] * rstd * gg[j]) * (1.0f + scv[j]) + sh[j];
            u32x2 wv; wv.x = pack2(o4[0], o4[1]); wv.y = pack2(o4[2], o4[3]);
            *(u32x2*)(U + (size_t)row * DM + cidx) = wv; }
    }
}
__device__ __forceinline__ void phase_hg_final(const Params& p, int l, int b, int wgi) {
    const int tid = tid_(); const int w = tid >> 6, lane = tid & 63; bf16_t* P = (bf16_t*)(PF(ws) + WS_P);
    const int hd = lane >> 4, e8 = (lane & 15) * 8; const float* png = PF(hg_norm_g);
    float ng[8];
#pragma unroll
    for (int i = 0; i < 8; ++i) ng[i] = png[l * 128 + e8 + i];
    for (int i0 = wgi * 8 + w; i0 < 2304; i0 += 3 * 64) {
        u32x4 ra[3], rb[3], ro[3]; bf16_t* rp[3];
#pragma unroll
        for (int k = 0; k < 3; ++k) { const int i = i0 + 64 * k; const int ic = i < 2304 ? i : i0; const size_t row = ic < 2048 ? (size_t)b * SEQ + ic : (size_t)NLAT + b * CTXL + (ic - 2048);
            rp[k] = P + row * PW; ra[k] = *(const u32x4*)(rp[k] + C_BF + hd * 128 + e8); rb[k] = *(const u32x4*)(rp[k] + C_BF + 512 + hd * 128 + e8); ro[k] = *(const u32x4*)(rp[k] + C_BO + hd * 128 + e8); }
#pragma unroll
        for (int k = 0; k < 3; ++k) {
            float a[8], bb[8], og[8]; unpack8(ra[k], a); unpack8(rb[k], bb); unpack8(ro[k], og);
            float ss = 0.f;
#pragma unroll
            for (int i = 0; i < 8; ++i) { a[i] += bb[i]; ss += a[i] * a[i]; }
            ss += __shfl_xor(ss, 1); ss += __shfl_xor(ss, 2); ss += __shfl_xor(ss, 4); ss += __shfl_xor(ss, 8);
            const float rstd = rsqrtf(ss * (1.0f / 128.0f) + 1e-6f);
            float y[8];
#pragma unroll
            for (int i = 0; i < 8; ++i) y[i] = a[i] * rstd * ng[i] * sigmoidf_(og[i]);
            if (i0 + 64 * k < 2304) *(u32x4*)(rp[k] + C_BO + hd * 128 + e8) = pack8(y);
        }
    }
}

__device__ __forceinline__ size_t agg_idx(int b, int gch, int dir, int which, int ch) { return ((((size_t)b * 36 + gch) * 2 + dir) * 2 + which) * 512 + ch; }
__device__ __forceinline__ float gelu_tanh(float x) { const float u = 0.7978845608028654f * (x + 0.044715f * x * x * x); const float th = 1.0f - 2.0f / (1.0f + __expf(2.0f * u)); return 0.5f * x * (1.0f + th); }
__device__ __forceinline__ void lru_tile(const Params& p, int l, LAS unsigned char* lds, int item, int mode, int& staged_nb) {
    LAS bf16_t* Wl = (LAS bf16_t*)lds;
    LAS bf16_t* Xb = Wl + 256 * 72;
    LAS float* Xf = (LAS float*)(lds + 46080);
    LAS float* Av = Xf + 4096;
    LAS float* Bv = Av + 8192;
    bf16_t* P = (bf16_t*)(PF(ws) + WS_P); float* AGG = (float*)(PF(ws) + WS_AGG);
    const int tid = tid_(), w = tid >> 6, lane = tid & 63, l16 = lane & 15, q4 = lane >> 4;
    const int nb = item & 7, rest = item >> 3, gch = rest % 36, b = rest / 36;
    const bool isctx = gch < 4; const int chunk = isctx ? gch : gch - 4, L = isctx ? CTXL : SEQ;
    const size_t seqrow0 = isctx ? (size_t)NLAT + b * CTXL : (size_t)b * SEQ; const int t0 = chunk * 64;
    if (staged_nb != nb) { const float* pwx = PF(lru_wx); const float* pwa = PF(lru_wa);
        for (int e = tid; e < 4 * 64 * 64; e += 512) { const int mat = e >> 12, i = (e >> 6) & 63, c = e & 63; const int dir = mat >> 1, kind = mat & 1;
            const float* W = kind ? pwx : pwa; const float v = W[((size_t)((l * 2 + dir) * 8 + nb) * 64 + i) * 64 + c];
            const int op = dir * 128 + (c >> 4) * 32 + kind * 16 + (c & 15);
            Wl[op * 72 + i] = (bf16_t)f2bf(v); }
        staged_nb = nb;
    }
    {
        const int t = tid >> 3, c8 = (tid & 7) * 8, ch = nb * 64 + c8, tt = t0 + t;
        float a8[8]; const float* pcb = PF(conv_b); const float* pcw = PF(conv_w);
        { const f32x4 b0 = *(const f32x4*)(pcb + l * 512 + ch), b1 = *(const f32x4*)(pcb + l * 512 + ch + 4);
#pragma unroll
          for (int i = 0; i < 4; ++i) { a8[i] = b0[i]; a8[4 + i] = b1[i]; } }
#pragma unroll
        for (int j = 0; j < 4; ++j) { const int ts = tt + j - 2;
            if (ts >= 0 && ts < L) { float xv[8]; unpack8(*(const u32x4*)(P + (seqrow0 + ts) * PW + C_AX + ch), xv);
                const f32x4 w0 = *(const f32x4*)(pcw + (l * 4 + j) * 512 + ch), w1 = *(const f32x4*)(pcw + (l * 4 + j) * 512 + ch + 4);
#pragma unroll
                for (int i = 0; i < 4; ++i) { a8[i] += xv[i] * w0[i]; a8[4 + i] += xv[4 + i] * w1[i]; } } }
#pragma unroll
        for (int i = 0; i < 8; ++i) Xf[t * 64 + c8 + i] = a8[i];
        *(LAS u32x4*)(Xb + t * 72 + c8) = pack8(a8);
    }
    __syncthreads();
    {
        const int dir = w >> 2, c = (w & 3) * 16 + l16, ch = nb * 64 + c;
        f32x4 acc[4][2];
#pragma unroll
        for (int mg = 0; mg < 4; ++mg) { acc[mg][0] = (f32x4){0.f, 0.f, 0.f, 0.f}; acc[mg][1] = (f32x4){0.f, 0.f, 0.f, 0.f}; }
#pragma unroll
        for (int ks = 0; ks < 2; ++ks) {
            const bf16x8 B0 = *(const LAS bf16x8*)(Wl + (w * 32 + l16) * 72 + ks * 32 + q4 * 8), B1 = *(const LAS bf16x8*)(Wl + (w * 32 + 16 + l16) * 72 + ks * 32 + q4 * 8);
#pragma unroll
            for (int mg = 0; mg < 4; ++mg) { const bf16x8 A = *(const LAS bf16x8*)(Xb + (mg * 16 + l16) * 72 + ks * 32 + q4 * 8);
                acc[mg][0] = mfma16(A, B0, acc[mg][0]); acc[mg][1] = mfma16(A, B1, acc[mg][1]); }
        }
        const float ba = PF(lru_ba)[(l * 2 + dir) * 512 + ch], bx = PF(lru_bx)[(l * 2 + dir) * 512 + ch], lam = PF(lru_lambda)[(l * 2 + dir) * 512 + ch];
        const float sp = log1pf(expf(-lam));
#pragma unroll
        for (int mg = 0; mg < 4; ++mg)
#pragma unroll
            for (int j = 0; j < 4; ++j) { const int t = mg * 16 + q4 * 4 + j;
                const float ea = 1.0f + __expf(-(acc[mg][0][j] + ba)), ex = 1.0f + __expf(-(acc[mg][1][j] + bx)); const float inv = __builtin_amdgcn_rcpf(ea * ex);
                const float r = inv * ex, ig = inv * ea;
                const float la = -8.0f * r * sp; const float a = __expf(la); const float x2 = 2.0f * la;
                float om = -x2 * (1.0f + x2 * (0.5f + x2 * (0.16666667f + x2 * (0.041666668f + x2 * 0.0083333338f))));
                if (x2 < -0.35f) om = 1.0f - a * a;
                const float bb = sqrtf(fmaxf(om, 0.f)) * ig * Xf[t * 64 + c];
                Av[(dir * 64 + t) * 64 + c] = a; Bv[(dir * 64 + t) * 64 + c] = bb; }
    }
    __syncthreads();
    {
        LAS float* SegA = Xf;
        LAS float* SegB = Xf + 512;
        const int d2 = tid >> 8, seg = (tid >> 6) & 3, c = tid & 63, ch = nb * 64 + c;
        float av[16], bv[16];
#pragma unroll
        for (int k = 0; k < 16; ++k) { const int s = seg * 16 + k; const int t = d2 ? 63 - s : s; const int ix = (d2 * 64 + t) * 64 + c; av[k] = Av[ix]; bv[k] = Bv[ix]; }
        float h = 0.f, ap = 1.f;
#pragma unroll
        for (int k = 0; k < 16; ++k) { h = av[k] * h + bv[k]; ap *= av[k]; }
        SegA[(d2 * 4 + seg) * 64 + c] = ap; SegB[(d2 * 4 + seg) * 64 + c] = h;
        float hin = 0.f;
        if (mode == 1) {
            const int mypos = d2 == 0 ? gch : (gch < 4 ? 3 - gch : 39 - gch);
            for (int p0 = 0; p0 < mypos; p0 += 6) { float Aa[6], Bb[6];
#pragma unroll
                for (int j = 0; j < 6; ++j) { const int pp = p0 + j; const int g = d2 == 0 ? pp : (pp < 4 ? 3 - pp : 39 - pp); const bool ok = pp < mypos;
                    Aa[j] = ok ? AGG[agg_idx(b, ok ? g : 0, d2, 0, ch)] : 1.0f; Bb[j] = ok ? AGG[agg_idx(b, ok ? g : 0, d2, 1, ch)] : 0.0f; }
#pragma unroll
                for (int j = 0; j < 6; ++j) hin = Aa[j] * hin + Bb[j]; }
        }
        __syncthreads();
        if (mode == 0) {
            if (seg == 3) { float A = 1.f, B = 0.f;
#pragma unroll
                for (int s2 = 0; s2 < 4; ++s2) { const float sa = SegA[(d2 * 4 + s2) * 64 + c], sb2 = SegB[(d2 * 4 + s2) * 64 + c]; B = sa * B + sb2; A *= sa; }
                AGG[agg_idx(b, gch, d2, 0, ch)] = A; AGG[agg_idx(b, gch, d2, 1, ch)] = B; }
        } else {
#pragma unroll
            for (int s2 = 0; s2 < 3; ++s2) if (s2 < seg) hin = SegA[(d2 * 4 + s2) * 64 + c] * hin + SegB[(d2 * 4 + s2) * 64 + c];
            float hh2 = hin;
#pragma unroll
            for (int k = 0; k < 16; ++k) { const int s = seg * 16 + k; const int t = d2 ? 63 - s : s; hh2 = av[k] * hh2 + bv[k]; Bv[(d2 * 64 + t) * 64 + c] = hh2; }
        }
    }
    __syncthreads();
    if (mode == 1) {
        const int t = tid >> 3, c8 = (tid & 7) * 8; bf16_t* gp = P + (seqrow0 + t0 + t) * PW + C_AG + nb * 64 + c8;
        float gt[8]; unpack8(*(const u32x4*)gp, gt); float y[8];
#pragma unroll
        for (int i = 0; i < 8; ++i) y[i] = (Bv[t * 64 + c8 + i] + Bv[(64 + t) * 64 + c8 + i]) * gelu_tanh(gt[i]);
        *(u32x4*)gp = pack8(y);
        __syncthreads();
    }
}

template <bool B> struct BoolC { static constexpr bool value = B; };
__device__ __forceinline__ void attn_item(const Params& p, int l, LAS unsigned char* lds, int item, int dry = 0) {
    LAS bf16_t* Kt = (LAS bf16_t*)lds;
    LAS float* rpbL = (LAS float*)(lds + 73728);
    LAS float* cosT = rpbL + 960;
    LAS float* sinT = cosT + 1024;
    LAS float* gq = sinT + 1024; LAS float* gk = gq + 64;
    bf16_t* P = (bf16_t*)(PF(ws) + WS_P); const float* rope = (const float*)(PF(ws) + WS_ROPE);
    const int tid = tid_(), w = __builtin_amdgcn_readfirstlane(tid >> 6), lane = tid & 63, l16 = lane & 15, q4 = lane >> 4, hh = w >> 2, qg4 = w & 3;
    const bool isctx = item >= 512;
    int b, hp, nloc, krU; int rq[2], kq0[2]; size_t qrow0[2];
    if (!isctx) { hp = item & 3; const int rp = (item >> 2) & 15; b = item >> 6;
        rq[0] = 2 * rp; rq[1] = 2 * rp + 1; kq0[0] = min(max(rq[0] - 4, 0), 24); kq0[1] = min(max(rq[1] - 4, 0), 24);
        qrow0[0] = (size_t)b * SEQ + rq[0] * 64; qrow0[1] = qrow0[0] + 64; krU = kq0[0]; nloc = kq0[1] + 8 - kq0[0]; }
    else { const int it = item - 512; hp = it & 3; const int qt = (it >> 2) & 1; b = it >> 3; rq[0] = rq[1] = 0; kq0[0] = kq0[1] = 0; krU = 0; nloc = 0;
        qrow0[0] = (size_t)NLAT + b * CTXL + qt * 128; qrow0[1] = qrow0[0] + 64; }
    const int h = hp * 2 + hh;
    const float* prpb = PF(na_rpb);
    for (int i = tid; i < 2 * 465; i += 512) { const int h2 = i / 465, j = i - h2 * 465; rpbL[h2 * 480 + j] = prpb[(size_t)((l * 8 + hp * 2 + h2) * 465) + j]; }
    for (int i = tid; i < 1024; i += 512) { cosT[i] = rope[i]; sinT[i] = rope[1024 + i]; }
    if (tid < 64) { gq[tid] = PF(na_qg)[l * 64 + tid]; gk[tid] = PF(na_kg)[l * 64 + tid]; }
    __syncthreads();
    const int qc = qg4 * 16 + l16;
    const int glo = qg4 < 2 ? 0 : qg4 - 1, ghi = qg4 == 0 ? 1 : (qg4 == 3 ? 3 : qg4 + 1);
    unsigned mbits = 0u; const int bbase = q4 * 4 - qc;
    { const int cs0 = min(max(qc - 8, 0), 48);
#pragma unroll
      for (int g = 0; g < 4; ++g)
#pragma unroll
          for (int j = 0; j < 4; ++j) { const int kc = g * 16 + q4 * 4 + j; if (kc < cs0 || kc >= cs0 + 16) mbits |= 1u << (g * 4 + j); } }
    bf16x8 qpl[2][2], qrt[2][2];
#pragma unroll
    for (int qi = 0; qi < 2; ++qi) {
        const bf16_t* qp = P + (qrow0[qi] + qc) * PW + C_CQ + h * 64;
        float xq[16]; unpack8(*(const u32x4*)(qp + q4 * 8), xq); unpack8(*(const u32x4*)(qp + 32 + q4 * 8), xq + 8);
        float ss = 0.f;
#pragma unroll
        for (int i = 0; i < 16; ++i) ss += xq[i] * xq[i];
        ss += __shfl_xor(ss, 16); ss += __shfl_xor(ss, 32);
        const float rs = rsqrtf(ss * (1.0f / 64.0f) + 1e-6f) * 0.125f;
#pragma unroll
        for (int i = 0; i < 8; ++i) { xq[i] *= rs * gq[q4 * 8 + i]; xq[8 + i] *= rs * gq[32 + q4 * 8 + i]; }
        qpl[qi][0] = as_bf16x8(pack8(xq)); qpl[qi][1] = as_bf16x8(pack8(xq + 8));
        float xr[16];
#pragma unroll
        for (int ks = 0; ks < 2; ++ks) { const int pos = ks == 0 ? rq[qi] : qc;
#pragma unroll
            for (int jj = 0; jj < 8; ++jj) { const int fi = (q4 & 1) * 8 + jj; const float cs = cosT[pos * 16 + fi], sn = sinT[pos * 16 + fi]; const float xv = xq[ks * 8 + jj]; const float pr = __shfl_xor(xv, 32);
                xr[ks * 8 + jj] = (q4 < 2) ? (xv * cs - pr * sn) : (xv * cs + pr * sn); } }
        qrt[qi][0] = as_bf16x8(pack8(xr)); qrt[qi][1] = as_bf16x8(pack8(xr + 8));
    }
    f32x4 O[2][4];
#pragma unroll
    for (int qi = 0; qi < 2; ++qi)
#pragma unroll
        for (int i = 0; i < 4; ++i) O[qi][i] = (f32x4){0.f, 0.f, 0.f, 0.f};
    float mrun[2] = {-1e30f, -1e30f}, lsum[2] = {0.f, 0.f};
    const int pf_hh2 = tid >> 8, pf_h2 = hp * 2 + pf_hh2, pf_key = (tid & 255) >> 2, pf_seg = tid & 3, pf_vseg = (tid & 255) >> 6, pf_vkey = tid & 63;
    u32x4 pk0, pk1, pv0, pv1;
    { const size_t r0 = nloc ? (size_t)b * SEQ + krU * 64 : (size_t)NLAT + b * CTXL;
      const bf16_t* kp = P + (r0 + pf_key) * PW + C_CK + pf_h2 * 64 + pf_seg * 16; pk0 = *(const u32x4*)kp; pk1 = *(const u32x4*)(kp + 8);
      const bf16_t* vp = P + (r0 + pf_vkey) * PW + C_CV + pf_h2 * 64 + pf_vseg * 16; pv0 = *(const u32x4*)vp; pv1 = *(const u32x4*)(vp + 8); }
    const int ntot = nloc + 4;
    auto stage = [&](int T, int buf) {
        const bool sloc = T < nloc; const int kr = krU + T;
        LAS bf16_t* KtB = Kt + buf * (4 * 64 * 72); LAS bf16_t* VtB = KtB + 2 * 64 * 72;
        {
            const int hh2 = pf_hh2, key = pf_key, seg = pf_seg;
            float xk[16]; unpack8(pk0, xk); unpack8(pk1, xk + 8);
            float ss = 0.f;
#pragma unroll
            for (int i = 0; i < 16; ++i) ss += xk[i] * xk[i];
            ss += __shfl_xor(ss, 1); ss += __shfl_xor(ss, 2);
            const float rs = rsqrtf(ss * (1.0f / 64.0f) + 1e-6f);
#pragma unroll
            for (int i = 0; i < 16; ++i) xk[i] *= rs * gk[seg * 16 + i];
            if (sloc) { const int pos = seg < 2 ? kr : key;
#pragma unroll
                for (int i = 0; i < 16; ++i) { const float pr = __shfl_xor(xk[i], 1); const float cs = cosT[pos * 16 + i], sn = sinT[pos * 16 + i]; xk[i] = (seg & 1) ? (xk[i] * cs + pr * sn) : (xk[i] * cs - pr * sn); } }
            LAS bf16_t* kd = KtB + (hh2 * 64 + key) * 72 + seg * 16;
            *(LAS u32x4*)kd = pack8(xk); *(LAS u32x4*)(kd + 8) = pack8(xk + 8);
        }
        {
            const int hh2 = pf_hh2, seg = pf_vseg, key = pf_vkey;
            const u32x4 a = pv0, c = pv1;
            LAS bf16_t* vd = VtB + (hh2 * 64 + seg * 16) * 72 + key;
            vd[0 * 72] = (bf16_t)(a.x & 0xffff); vd[1 * 72] = (bf16_t)(a.x >> 16); vd[2 * 72] = (bf16_t)(a.y & 0xffff); vd[3 * 72] = (bf16_t)(a.y >> 16);
            vd[4 * 72] = (bf16_t)(a.z & 0xffff); vd[5 * 72] = (bf16_t)(a.z >> 16); vd[6 * 72] = (bf16_t)(a.w & 0xffff); vd[7 * 72] = (bf16_t)(a.w >> 16);
            vd[8 * 72] = (bf16_t)(c.x & 0xffff); vd[9 * 72] = (bf16_t)(c.x >> 16); vd[10 * 72] = (bf16_t)(c.y & 0xffff); vd[11 * 72] = (bf16_t)(c.y >> 16);
            vd[12 * 72] = (bf16_t)(c.z & 0xffff); vd[13 * 72] = (bf16_t)(c.z >> 16); vd[14 * 72] = (bf16_t)(c.w & 0xffff); vd[15 * 72] = (bf16_t)(c.w >> 16);
        }
        { const int Tn = T + 1; if (Tn < ntot) { const size_t r0 = (Tn < nloc) ? (size_t)b * SEQ + (krU + Tn) * 64 : (size_t)NLAT + b * CTXL + (Tn - nloc) * 64;
            const bf16_t* kp = P + (r0 + pf_key) * PW + C_CK + pf_h2 * 64 + pf_seg * 16; pk0 = *(const u32x4*)kp; pk1 = *(const u32x4*)(kp + 8);
            const bf16_t* vp = P + (r0 + pf_vkey) * PW + C_CV + pf_h2 * 64 + pf_vseg * 16; pv0 = *(const u32x4*)vp; pv1 = *(const u32x4*)(vp + 8); } }
    };
    auto compute = [&](auto LOC, int T, int buf) {
        constexpr bool loc = decltype(LOC)::value; const int kr = krU + T;
        const LAS bf16_t* KtB = Kt + buf * (4 * 64 * 72); const LAS bf16_t* VtB = KtB + 2 * 64 * 72;
#pragma unroll
        for (int qi = 0; qi < 2; ++qi) {
            if (loc && (kr < kq0[qi] || kr >= kq0[qi] + 8)) continue;
            f32x4 st[4];
#pragma unroll
            for (int g = 0; g < 4; ++g) { const bool use = !loc || (g >= glo && g <= ghi);
                st[g] = (f32x4){0.f, 0.f, 0.f, 0.f};
                if (use) {
#pragma unroll
                    for (int ks = 0; ks < 2; ++ks) st[g] = mfma16(*(const LAS bf16x8*)(KtB + (hh * 64 + g * 16 + l16) * 72 + ks * 32 + q4 * 8), loc ? qrt[qi][ks] : qpl[qi][ks], st[g]);
                    if (loc) { const int dr31 = (kr - rq[qi] + 7) * 31;
#pragma unroll
                        for (int j = 0; j < 4; ++j) { const float sv = st[g][j] + rpbL[hh * 480 + min(max(bbase + g * 16 + j, -15), 15) + 15 + dr31]; st[g][j] = ((mbits >> (g * 4 + j)) & 1u) ? -1e30f : sv; } }
                } else st[g] = (f32x4){-1e30f, -1e30f, -1e30f, -1e30f};
            }
            float tmax = -1e30f;
#pragma unroll
            for (int g = 0; g < 4; ++g)
#pragma unroll
                for (int j = 0; j < 4; ++j) tmax = fmaxf(tmax, st[g][j]);
            tmax = fmaxf(tmax, __shfl_xor(tmax, 16)); tmax = fmaxf(tmax, __shfl_xor(tmax, 32));
            const float mnew = fmaxf(mrun[qi], tmax); const float alpha = __expf(mrun[qi] - mnew); mrun[qi] = mnew;
            float psum = 0.f;
#pragma unroll
            for (int g = 0; g < 4; ++g) { const bool use = !loc || (g >= glo && g <= ghi);
                if (use) {
#pragma unroll
                    for (int j = 0; j < 4; ++j) { const float pv = __expf(st[g][j] - mnew); st[g][j] = pv; psum += pv; }
                } else st[g] = (f32x4){0.f, 0.f, 0.f, 0.f}; }
            lsum[qi] = lsum[qi] * alpha + psum;
#pragma unroll
            for (int i = 0; i < 4; ++i) O[qi][i] *= alpha;
            bf16x8 pb[2];
#pragma unroll
            for (int ks = 0; ks < 2; ++ks) { u32x4 wv; wv.x = pack2(st[2 * ks][0], st[2 * ks][1]); wv.y = pack2(st[2 * ks][2], st[2 * ks][3]); wv.z = pack2(st[2 * ks + 1][0], st[2 * ks + 1][1]); wv.w = pack2(st[2 * ks + 1][2], st[2 * ks + 1][3]); pb[ks] = as_bf16x8(wv); }
#pragma unroll
            for (int ks = 0; ks < 2; ++ks) if (!loc || (2 * ks + 1 >= glo && 2 * ks <= ghi))
#pragma unroll
                for (int dg = 0; dg < 4; ++dg) { const LAS bf16_t* vr = VtB + (hh * 64 + dg * 16 + l16) * 72 + ks * 32 + q4 * 4;
                    const u32x2 lo = *(const LAS u32x2*)vr, hi = *(const LAS u32x2*)(vr + 16); u32x4 av; av.x = lo.x; av.y = lo.y; av.z = hi.x; av.w = hi.y;
                    O[qi][dg] = mfma16(as_bf16x8(av), pb[ks], O[qi][dg]); }
        }
    };
    stage(0, 0);
    __syncthreads();
    for (int T = 0; T < nloc; ++T) {
        stage(T + 1, (T + 1) & 1);
        compute(BoolC<true>{}, T, T & 1);
        __syncthreads();
    }
    for (int T = nloc; T < ntot; ++T) {
        if (T + 1 < ntot) stage(T + 1, (T + 1) & 1);
        compute(BoolC<false>{}, T, T & 1);
        __syncthreads();
    }
#pragma unroll
    for (int qi = 0; qi < 2; ++qi) {
        float ls = lsum[qi]; ls += __shfl_xor(ls, 16); ls += __shfl_xor(ls, 32);
        const float inv = 1.0f / ls;
        bf16_t* op = dry ? ((bf16_t*)(PF(ws) + WS_DUMMY) + (size_t)(blockIdx.x & 63) * 16384 + (size_t)((qi * 8 + w) * 16 + l16) * 64) : (P + (qrow0[qi] + qc) * PW + C_CQ + h * 64);
#pragma unroll
        for (int dg = 0; dg < 4; ++dg) { u32x2 wv; wv.x = pack2(O[qi][dg][0] * inv, O[qi][dg][1] * inv); wv.y = pack2(O[qi][dg][2] * inv, O[qi][dg][3] * inv); *(u32x2*)(op + dg * 16 + q4 * 4) = wv; }
    }
    __syncthreads();
}

__device__ __forceinline__ void hgrn_stage(const bf16_t* P, LAS unsigned char* lds, int w, int lane, size_t row0, int dir, int h) {
#pragma unroll
    for (int i = 0; i < 2; ++i) { const int blk = i * 8 + w; const int t = blk * 4 + (lane >> 4); const bf16_t* rp = P + (row0 + (dir ? 63 - t : t)) * PW + (lane & 15) * 8;
        __builtin_amdgcn_global_load_lds((const unsigned*)(rp + C_BQ + h * 128), (LAS unsigned*)(lds + 118784 + blk * 1024), 16, 0, 0);
        __builtin_amdgcn_global_load_lds((const unsigned*)(rp + C_BF + dir * 512 + h * 128), (LAS unsigned*)(lds + 135168 + blk * 1024), 16, 0, 0); }
}
__device__ __forceinline__ void hgrn_chain(const Params& p, int l, LAS unsigned char* lds, int chain, int dry = 0) {
    LAS bf16_t* Q0 = (LAS bf16_t*)lds;
    LAS bf16_t* KP = (LAS bf16_t*)(lds + 17408);
    LAS bf16_t* SB = (LAS bf16_t*)(lds + 34816);
    LAS bf16_t* KDT = (LAS bf16_t*)(lds + 69632);
    LAS bf16_t* VT = (LAS bf16_t*)(lds + 88064);
    LAS bf16_t* ATT = (LAS bf16_t*)(lds + 106496);
    LAS float* TOT = (LAS float*)(lds + 115712);
    LAS float* DD = (LAS float*)(lds + 117760);
    const LAS bf16_t* SQ = (const LAS bf16_t*)(lds + 118784);
    const LAS bf16_t* SF = (const LAS bf16_t*)(lds + 135168);
    bf16_t* P = (bf16_t*)(PF(ws) + WS_P);
    const int tid = tid_(), w = __builtin_amdgcn_readfirstlane(tid >> 6), lane = tid & 63, l16 = lane & 15, q4 = lane >> 4;
    const int dir = chain & 1, h = (chain >> 1) & 3, b = chain >> 3;
    const int d = tid & 127, sb = tid >> 7;
    float lbv = 0.f;
    if (l > 0) { const float x0 = PF(hg_lb)[(dir * 2 + 0) * 512 + h * 128 + d], x1 = PF(hg_lb)[(dir * 2 + 1) * 512 + h * 128 + d]; lbv = 1.0f / (1.0f + expf(x0 - x1)); }
    for (int i = tid; i < 64 * 72 / 2; i += 512) ((LAS unsigned*)ATT)[i] = 0u;
    f32x4 S[8];
#pragma unroll
    for (int i = 0; i < 8; ++i) S[i] = (f32x4){0.f, 0.f, 0.f, 0.f};
    { const int gch0 = dir == 0 ? 0 : 3; hgrn_stage(P, lds, w, lane, (size_t)NLAT + b * CTXL + gch0 * 64, dir, h); }
    asm volatile("s_waitcnt vmcnt(0)" ::: "memory");
    __syncthreads();
    for (int ci = 0; ci < 36; ++ci) {
        const int gch = dir == 0 ? ci : (ci < 4 ? 3 - ci : 39 - ci);
        const bool isctx = gch < 4; const int chunk = isctx ? gch : gch - 4;
        const size_t row0 = isctx ? (size_t)NLAT + b * CTXL + chunk * 64 : (size_t)b * SEQ + chunk * 64;
        float bl[16], qv[16], kv[16]; float run = 0.f;
        {
            unsigned vraw[16];
#pragma unroll
            for (int ii = 0; ii < 16; ++ii) { const int t = sb * 16 + ii; vraw[ii] = P[(row0 + (dir ? 63 - t : t)) * PW + C_BI + h * 128 + d]; }
#pragma unroll
            for (int eg = 0; eg < 8; ++eg) { u32x2 wv; wv.x = pack2(S[eg][0], S[eg][1]); wv.y = pack2(S[eg][2], S[eg][3]); *(LAS u32x2*)(SB + (eg * 16 + l16) * 136 + w * 16 + q4 * 4) = wv; }
#pragma unroll
            for (int ii = 0; ii < 16; ++ii) { const int t = sb * 16 + ii;
                const float fr = bf2f(SF[t * 128 + d]), qr = bf2f(SQ[t * 128 + d]);
                const float sg = 1.0f / (1.0f + __expf(-fr)); const float f = lbv + (1.0f - lbv) * sg; run += __logf(f); bl[ii] = run; kv[ii] = 1.0f - f; qv[ii] = qr / (1.0f + __expf(-qr)); }
            TOT[sb * 128 + d] = run;
            u32x4 v0, v1; v0.x = vraw[0] | (vraw[1] << 16); v0.y = vraw[2] | (vraw[3] << 16); v0.z = vraw[4] | (vraw[5] << 16); v0.w = vraw[6] | (vraw[7] << 16);
            v1.x = vraw[8] | (vraw[9] << 16); v1.y = vraw[10] | (vraw[11] << 16); v1.z = vraw[12] | (vraw[13] << 16); v1.w = vraw[14] | (vraw[15] << 16);
            *(LAS u32x4*)(VT + d * 72 + sb * 16) = v0; *(LAS u32x4*)(VT + d * 72 + sb * 16 + 8) = v1;
        }
        __syncthreads();
        if (ci < 35) { const int cn = ci + 1; const int gn = dir == 0 ? cn : (cn < 4 ? 3 - cn : 39 - cn); const bool cx = gn < 4; const int ck = cx ? gn : gn - 4;
            hgrn_stage(P, lds, w, lane, cx ? (size_t)NLAT + b * CTXL + ck * 64 : (size_t)b * SEQ + ck * 64, dir, h); }
        {
            const float t0 = TOT[d], t1 = TOT[128 + d], t2 = TOT[256 + d], t3 = TOT[384 + d];
            const float Bs1 = t0, Bs2 = t0 + t1, Bs3 = Bs2 + t2, total = Bs3 + t3;
            const float Bsb = sb == 0 ? 0.f : (sb == 1 ? Bs1 : (sb == 2 ? Bs2 : Bs3));
            const float eB = __expf(Bsb), eT = __expf(total);
            float kd[16];
#pragma unroll
            for (int ii = 0; ii < 16; ++ii) { const float e0 = __expf(bl[ii]); Q0[(sb * 16 + ii) * 136 + d] = (bf16_t)pack2(qv[ii] * e0 * eB, 0.f);
                const float kp = kv[ii] * __expf(fminf(-(Bsb + bl[ii]), 80.f)); KP[(sb * 16 + ii) * 136 + d] = (bf16_t)pack2(kp, 0.f); kd[ii] = kp * eT; }
            *(LAS u32x4*)(KDT + d * 72 + sb * 16) = pack8(kd); *(LAS u32x4*)(KDT + d * 72 + sb * 16 + 8) = pack8(kd + 8);
            if (sb == 0) DD[d] = eT;
        }
        __syncthreads();
        const bool need_o = !(l == 1 && isctx);
        if (need_o)
#pragma unroll
        for (int k2 = 0; k2 < 2; ++k2) { const int idx = w + 8 * k2;
            if (idx < 10) { const int i = idx < 1 ? 0 : (idx < 3 ? 1 : (idx < 6 ? 2 : 3)); const int j = idx - i * (i + 1) / 2;
                f32x4 sc = (f32x4){0.f, 0.f, 0.f, 0.f};
                const LAS bf16_t* qb = Q0 + (i * 16 + l16) * 136 + q4 * 8; const LAS bf16_t* kb = KP + (j * 16 + l16) * 136 + q4 * 8;
#pragma unroll
                for (int ks = 0; ks < 4; ++ks) sc = mfma16(*(const LAS bf16x8*)(qb + ks * 32), *(const LAS bf16x8*)(kb + ks * 32), sc);
#pragma unroll
                for (int jj = 0; jj < 4; ++jj) { const float v = (i == j && l16 > q4 * 4 + jj) ? 0.f : sc[jj]; ATT[(i * 16 + q4 * 4 + jj) * 72 + j * 16 + l16] = (bf16_t)pack2(v, 0.f); } } }
        __syncthreads();
        if (need_o) {
            bf16x8 SBf[4], VTf[2];
#pragma unroll
            for (int ks = 0; ks < 4; ++ks) SBf[ks] = *(const LAS bf16x8*)(SB + (w * 16 + l16) * 136 + ks * 32 + q4 * 8);
#pragma unroll
            for (int ks = 0; ks < 2; ++ks) VTf[ks] = *(const LAS bf16x8*)(VT + (w * 16 + l16) * 72 + ks * 32 + q4 * 8);
#pragma unroll
            for (int i = 0; i < 4; ++i) { f32x4 oa = (f32x4){0.f, 0.f, 0.f, 0.f};
#pragma unroll
                for (int ks = 0; ks < 4; ++ks) oa = mfma16(SBf[ks], *(const LAS bf16x8*)(Q0 + (i * 16 + l16) * 136 + ks * 32 + q4 * 8), oa);
#pragma unroll
                for (int ks = 0; ks < 2; ++ks) oa = mfma16(VTf[ks], *(const LAS bf16x8*)(ATT + (i * 16 + l16) * 72 + ks * 32 + q4 * 8), oa);
                const int t = i * 16 + l16; u32x2 wv; wv.x = pack2(oa[0], oa[1]); wv.y = pack2(oa[2], oa[3]);
                bf16_t* od = dry ? ((bf16_t*)(PF(ws) + WS_DUMMY) + (size_t)chain * 8192 + t * 128 + w * 16 + q4 * 4) : (P + (row0 + (dir ? 63 - t : t)) * PW + C_BF + dir * 512 + h * 128 + w * 16 + q4 * 4);
                *(u32x2*)od = wv; }
        }
        {
            const f32x4 dd = *(const LAS f32x4*)(DD + w * 16 + q4 * 4);
#pragma unroll
            for (int eg = 0; eg < 8; ++eg) S[eg] *= dd;
#pragma unroll
            for (int ks = 0; ks < 2; ++ks) { const bf16x8 A = *(const LAS bf16x8*)(KDT + (w * 16 + l16) * 72 + ks * 32 + q4 * 8);
#pragma unroll
                for (int eg = 0; eg < 8; ++eg) S[eg] = mfma16(A, *(const LAS bf16x8*)(VT + (eg * 16 + l16) * 72 + ks * 32 + q4 * 8), S[eg]); }
        }
        asm volatile("s_waitcnt vmcnt(0)" ::: "memory");
        __syncthreads();
    }
}

__global__ void __launch_bounds__(512, 2) fwd_megakernel(Params p) {
    extern __shared__ __attribute__((aligned(16))) unsigned char lds_raw[];
    LAS unsigned char* lds = (LAS unsigned char*)lds_raw;
    cg::grid_group grid = cg::this_grid();
    volatile LAS unsigned* xst = (volatile LAS unsigned*)(lds + LDS_BYTES - 16);
    if (threadIdx.x == 0) { xst[0] = 0u; xst[1] = 0u; xst[2] = 0u; xst[3] = 0u; }
    __syncthreads();
    const XcdBarrier xbar = xcd_barrier_post((unsigned*)(PF(ws) + WS_BAR), xst);
    const int G = gridDim.x, c = blockIdx.x;

    phase_mod(p, lds); __syncthreads();
    phase_rope(p);
    phase_convert(p, 0, lds);
    if (PF(ws) == nullptr) grid.sync();
    xcd_barrier(xbar);
#define WSP(T, off) ((T*)(PF(ws) + (off)))
    for (int l = 0; l < 2; ++l) {
        const bool lastl = (l == 1);
        const int Mrest = lastl ? NLAT : NTOK;
        if (l > 0) phase_convert(p, l, lds);
        phase_norm(p, l, l == 0 ? PF(x) : PF(out), l == 0 ? PF(ctx) : WSP(const float, WS_HC), PF(norm1_g) + l * DM, 0, NTOK,
                   (l > 0 && G == 256) ? (const float*)(PF(ws) + WS_P + (size_t)NTOK * DFF * 2) : nullptr, WSP(const float, WS_MOD) + (size_t)((l > 0 ? l - 1 : 0) * 9 + 8) * 6144 + 5120);
        xcd_barrier(xbar);

        { pg8::Gemm g{WSP(bf16_t, WS_U), WSP(bf16_t, WS_WIN), DM, DM, DM}; pg8::Sched S; S.init(NTOK, PW, G, c, DM, DM); pg8::EpiStore<0> E{WSP(bf16_t, WS_P), PW}; pg8::gemm_phase(lds, g, S, E); }
        xcd_barrier(xbar);
        if (c < 64) { hgrn_chain(p, l, lds, c);
            sub_barrier((unsigned*)(PF(ws) + WS_BAR) + 3776 + 16 * ((c >> 3) + 8 * l), 8u); phase_hg_final(p, l, c >> 3, c & 7); }
        else { const int cc = c - 64, GG = G - 64; const int nA = lastl ? 512 : 576;
            for (int it = cc; it < nA; it += GG) attn_item(p, l, lds, it);
            int staged = -1;
            for (int it = cc; it < 2304; it += GG) lru_tile(p, l, lds, it, 0, staged);
            sub_barrier((unsigned*)(PF(ws) + WS_BAR) + 3520 + 64 * (2 * l + 1), (unsigned)GG);
            for (int it = cc; it < 2304; it += GG) lru_tile(p, l, lds, it, 1, staged); }
        xcd_barrier(xbar);
        { pg8::Gemm g{WSP(bf16_t, WS_U), WSP(bf16_t, WS_WIN) + (size_t)PW * DM, DM, DM, DM}; pg8::Sched S; S.init(Mrest, 3072, G, c, DM, DM); pg8::EpiStore<1> E{WSP(bf16_t, WS_P), PW}; pg8::gemm_phase(lds, g, S, E); }
        xcd_barrier(xbar);
        { pg8::Gemm g{WSP(bf16_t, WS_P), WSP(bf16_t, WS_WB), PW, 512, 512}; pg8::MergeSched S; S.base.init(Mrest, DM, G, c, PW, 512);
          pg8::EpiMerge E{WSP(bf16_t, WS_P), WSP(bf16_t, WS_U)}; pg8::gemm_phase(lds, g, S, E); }
        xcd_barrier(xbar);
        { pg8::Gemm g{WSP(bf16_t, WS_U), WSP(bf16_t, WS_WO), DM, DM, DM};
          pg8::EpiResid E{l == 0 ? PF(x) : PF(out), l == 0 ? PF(ctx) : WSP(const float, WS_HC), PF(out), WSP(float, WS_HC), WSP(const float, WS_MOD) + (size_t)l * 9 * 6144 + 2048, WSP(float, WS_P)};
          if (!lastl && G == 256) { pg8::SplitSched S; S.base.init(NLAT, DM, G, c, DM, DM); S.sk = 256; pg8::gemm_phase(lds, g, S, E); }
          else { pg8::Sched S; S.init(Mrest, DM, G, c, DM, DM); pg8::gemm_phase(lds, g, S, E); } }
        xcd_barrier(xbar);
        if (!lastl && G == 256) phase_norm(p, l, PF(out), l == 0 ? PF(ctx) : WSP(const float, WS_HC), PF(norm2_g) + l * DM, 3072, Mrest, WSP(const float, WS_P), WSP(const float, WS_MOD) + (size_t)(l * 9 + 8) * 6144 + 2048, WSP(float, WS_HC));
        else phase_norm(p, l, PF(out), WSP(const float, WS_HC), PF(norm2_g) + l * DM, 3072, Mrest);
        xcd_barrier(xbar);
        { pg8::Gemm g{WSP(bf16_t, WS_U), WSP(bf16_t, WS_W1), DM, DM, DM}; pg8::Sched S; S.init(Mrest, DFF, G, c, DM, DM); pg8::EpiStore<2> E{WSP(bf16_t, WS_P), DFF}; pg8::gemm_phase(lds, g, S, E); }
        xcd_barrier(xbar);
        { pg8::Gemm g{WSP(bf16_t, WS_P), WSP(bf16_t, WS_W2), DFF, DFF, DFF};
          float* slab = (float*)(PF(ws) + WS_P + (size_t)NTOK * DFF * 2);
          pg8::EpiResid E{PF(out), WSP(const float, WS_HC), PF(out), WSP(float, WS_HC), WSP(const float, WS_MOD) + (size_t)l * 9 * 6144 + 5120, slab};
          if (!lastl && G == 256) { pg8::SplitSched S; S.base.init(NLAT, DM, G, c, DFF, DFF); S.sk = 1024; pg8::gemm_phase(lds, g, S, E); }
          else { pg8::Sched S; S.init(Mrest, DM, G, c, DFF, DFF); pg8::gemm_phase(lds, g, S, E); } }
        if (!lastl) xcd_barrier(xbar);
    }
}

extern "C" void kernel_launch(void* const* d_in, const int* in_sizes, int n_in, void* d_out, int out_size, void* d_ws, size_t ws_size, hipStream_t stream) {
    static int grid_blocks = 0;
    if (grid_blocks == 0) {
        int dev = 0, cus = 0, per_cu = 0;
        hipGetDevice(&dev);
        hipDeviceGetAttribute(&cus, hipDeviceAttributeMultiprocessorCount, dev);
        hipFuncSetAttribute((const void*)fwd_megakernel, hipFuncAttributeMaxDynamicSharedMemorySize, LDS_BYTES);
        hipOccupancyMaxActiveBlocksPerMultiprocessor(&per_cu, (const void*)fwd_megakernel, 512, LDS_BYTES);
        if (per_cu < 1 || n_in != 25 || ws_size < WS_END) { fprintf(stderr, "kernel_launch: cannot launch (per_cu %d, n_in %d, ws %zu need %zu)\n", per_cu, n_in, ws_size, (size_t)WS_END); grid_blocks = -1; }
        else grid_blocks = cus;
    }
    if (grid_blocks < 0) return;
    hipMemsetAsync((char*)d_ws + WS_BAR, 0, 16384, stream);
    Params p{};
    const float** pp = (const float**)&p;
    for (int i = 0; i < 25; ++i) pp[i] = (const float*)d_in[i];
    p.out = (float*)d_out; p.ws = (unsigned char*)d_ws;
    void* args[] = {&p};
    hipError_t e = hipLaunchCooperativeKernel((const void*)fwd_megakernel, dim3(grid_blocks), dim3(512), args, LDS_BYTES, stream);
    if (e != hipSuccess) fprintf(stderr, "cooperative launch failed: %s (grid %d)\n", hipGetErrorString(e), grid_blocks);
}
```

```cpp
#include <hip/hip_runtime.h>
#include <hip/hip_cooperative_groups.h>
#include <stdint.h>
#include <stdio.h>
namespace cg = cooperative_groups;

#define LAS __attribute__((address_space(3)))
typedef unsigned short bf16_t;
typedef short bf16x8 __attribute__((ext_vector_type(8)));
typedef float f32x4 __attribute__((ext_vector_type(4)));
typedef unsigned u32x4 __attribute__((ext_vector_type(4)));
typedef unsigned u32x2 __attribute__((ext_vector_type(2)));

constexpr int DM = 1024, NB = 8, SEQ = 2048, CTXL = 256, NLAT = NB * SEQ, NCTX = NB * CTXL, NTOK = NLAT + NCTX;
constexpr int PW = 5120, DIN = 8192, DFF = 4096;
constexpr int C_AX = 0, C_AG = 512, C_BQ = 1024, C_BF = 1536, C_BI = 2560, C_BO = 3072, C_CQ = 3584, C_CK = 4096, C_CV = 4608;
constexpr int LDS_BYTES = 163840;
constexpr size_t WS_WIN = 0;
constexpr size_t WS_WB = WS_WIN + (size_t)DIN * DM * 2;
constexpr size_t WS_WO = WS_WB + (size_t)3 * DM * 512 * 2;
constexpr size_t WS_W1 = WS_WO + (size_t)DM * DM * 2;
constexpr size_t WS_W2 = WS_W1 + (size_t)DFF * DM * 2;
constexpr size_t WS_U = WS_W2 + (size_t)DM * DFF * 2;
constexpr size_t WS_P = WS_U + (size_t)NTOK * DM * 2;
constexpr size_t WS_HC = WS_P + (size_t)NTOK * PW * 2;
constexpr size_t WS_MOD = WS_HC + (size_t)NCTX * DM * 4;
constexpr size_t WS_AGG = WS_MOD + (size_t)2 * 9 * 6144 * 4;
constexpr size_t WS_ROPE = WS_AGG + (size_t)NB * 36 * 2 * 2 * 512 * 4;
constexpr size_t WS_DUMMY = WS_ROPE + 2048 * 4;
constexpr size_t WS_BAR = WS_DUMMY + (2u << 20);
constexpr size_t WS_END = WS_BAR + 16384;

struct Params {
    const float *x, *c, *ctx, *c_ctx, *ada_w, *ada_b, *norm1_g, *norm2_g, *w_in, *conv_w, *conv_b, *lru_wa, *lru_ba, *lru_wx, *lru_bx, *lru_lambda,
        *hg_lb, *hg_norm_g, *na_qg, *na_kg, *na_rpb, *w_branch, *w_out, *ffn_w1, *ffn_w2;
    float* out; unsigned char* ws;
};


__device__ __forceinline__ unsigned long long ldkarg(int off) { unsigned long long v = 0;
#if defined(__HIP_DEVICE_COMPILE__)
    auto kp = __builtin_amdgcn_kernarg_segment_ptr();
    asm volatile("s_load_dwordx2 %0, %1, %2\n\ts_waitcnt lgkmcnt(0)" : "=s"(v) : "s"(kp), "s"(off));
#endif
    return v; }
template <class T> struct rm_ptr; template <class T> struct rm_ptr<T*> { typedef T type; };
template <class T> __device__ __forceinline__ T* as_global_ptr(unsigned long long v) { return (T*)(__attribute__((address_space(1))) T*)v; }
#define PF(f) (as_global_ptr<rm_ptr<decltype(Params::f)>::type>(ldkarg((int)__builtin_offsetof(Params, f))))

#define GAS __attribute__((address_space(1)))
template <class T> __device__ __forceinline__ GAS T* lnd(T* p) { asm volatile("" : "+v"(p)); return (GAS T*)p; }
__device__ __forceinline__ int tid_() { int t = threadIdx.x; asm volatile("" : "+v"(t)); return t; }
__device__ __forceinline__ float bf2f(unsigned v) { return __uint_as_float(v << 16); }
__device__ __forceinline__ float bflo(unsigned w) { return __uint_as_float(w << 16); }
__device__ __forceinline__ float bfhi(unsigned w) { return __uint_as_float(w & 0xffff0000u); }
__device__ __forceinline__ unsigned f2bf(float f) { unsigned u = __float_as_uint(f); u += 0x7fffu + ((u >> 16) & 1u); return u >> 16; }
typedef __bf16 bf16x2_t __attribute__((ext_vector_type(2)));
typedef float f32x2_t __attribute__((ext_vector_type(2)));
__device__ __forceinline__ unsigned pack2(float lo, float hi) { f32x2_t v = {lo, hi}; bf16x2_t b = __builtin_convertvector(v, bf16x2_t); union { bf16x2_t b; unsigned u; } t; t.b = b; return t.u; }
__device__ __forceinline__ float sigmoidf_(float x) { return __builtin_amdgcn_rcpf(1.0f + __expf(-x)); }
__device__ __forceinline__ f32x4 mfma16(bf16x8 a, bf16x8 b, f32x4 c) { return __builtin_amdgcn_mfma_f32_16x16x32_bf16(a, b, c, 0, 0, 0); }
__device__ __forceinline__ bf16x8 as_bf16x8(u32x4 v) { union { u32x4 u; bf16x8 b; } t; t.u = v; return t.b; }
__device__ __forceinline__ void unpack8(u32x4 w, float* o) { o[0] = bflo(w.x); o[1] = bfhi(w.x); o[2] = bflo(w.y); o[3] = bfhi(w.y); o[4] = bflo(w.z); o[5] = bfhi(w.z); o[6] = bflo(w.w); o[7] = bfhi(w.w); }
__device__ __forceinline__ u32x4 pack8(const float* v) { u32x4 w; w.x = pack2(v[0], v[1]); w.y = pack2(v[2], v[3]); w.z = pack2(v[4], v[5]); w.w = pack2(v[6], v[7]); return w; }

namespace pg8 {
constexpr int BM = 256, BK = 64, HALF = 128, HTB = HALF * BK * 2, NXCD = 8, WGM = 4;
__device__ __forceinline__ int lds_byte(int r, int c) { const int st = (r >> 4) * 2 + (c >> 5), rr = r & 15, cc = c & 31, ob = rr * 64 + cc * 2; return st * 1024 + (ob ^ (((ob >> 9) & 1) << 5)); }
__device__ __forceinline__ void stage_rc(int b, int& R, int& C) { const int st = b / 1024, sb = b % 1024, swz = sb ^ (((sb >> 9) & 1) << 5); R = (st >> 1) * 16 + swz / 64; C = (st & 1) * 32 + (swz % 64) / 2; }
__device__ __forceinline__ int perm32(int rho) { const int n = rho >> 4, i = rho & 15; return 8 * (i >> 2) + 4 * n + (i & 3); }

struct Unit { int pm, pn, sub, nt; size_t aoff, boff; };
struct Gemm { const bf16_t* A; const bf16_t* Bt; int lda, ldb, K; };
struct Sched {
    int nM, nN, nwg, G, c, lda, ldb, nt;
    __device__ void init(int M, int N, int G_, int c_, int lda_, int ldb_) { nM = M / BM; nN = N / BM; nwg = nM * nN; G = G_; c = c_; lda = lda_; ldb = ldb_; nt = 0; }
    __device__ bool next(int i, Unit& u) const {
        const long L = (long)i * G + c; if (L >= nwg) return false;
        int wgid = (int)L; { const int q = nwg / NXCD, r = nwg % NXCD, xcd = wgid % NXCD, off = wgid / NXCD; wgid = (xcd < r ? xcd * (q + 1) : r * (q + 1) + (xcd - r) * q) + off; }
        const int nig = WGM * nN, gid = wgid / nig, fm = gid * WGM, gsz = (nM - fm) < WGM ? (nM - fm) : WGM;
        u.pm = fm + ((wgid % nig) % gsz); u.pn = (wgid % nig) / gsz; u.sub = 0; u.nt = nt;
        u.aoff = (size_t)u.pm * BM * lda * 2;
        u.boff = (size_t)u.pn * BM * ldb * 2;
        return true;
    }
};

template <int ACT> struct EpiStore {
    static constexpr bool PERM = true;
    bf16_t* O; int ldc;
    __device__ __forceinline__ void operator()(const f32x4 (&acc)[2][2][4][2], const Unit& u, int wr, int wc, int fr, int fq) const {
        const int row0 = u.pm * BM + wr * 64 + fr; int colt = u.pn * BM;
        if (ACT == 1) colt = (colt < 2048) ? (1024 + colt) : (2048 + colt);
        const int col0 = colt + wc * 32 + 8 * fq;
#pragma unroll
        for (int ai = 0; ai < 2; ++ai)
#pragma unroll
            for (int m = 0; m < 4; ++m) { GAS bf16_t* rowp = lnd(O + (size_t)(row0 + ai * HALF + m * 16) * ldc + col0);
#pragma unroll
                for (int bj = 0; bj < 2; ++bj) { f32x4 v0 = acc[ai][bj][m][0], v1 = acc[ai][bj][m][1];
                    if (ACT == 1) {
#pragma unroll
                        for (int j = 0; j < 4; ++j) { v0[j] = sigmoidf_(v0[j]); v1[j] = sigmoidf_(v1[j]); } }
                    if (ACT == 2) {
#pragma unroll
                        for (int j = 0; j < 4; ++j) { float a = fmaxf(v0[j], 0.f), b = fmaxf(v1[j], 0.f); v0[j] = a * a; v1[j] = b * b; } }
                    u32x4 w; w.x = pack2(v0[0], v0[1]); w.y = pack2(v0[2], v0[3]); w.z = pack2(v1[0], v1[1]); w.w = pack2(v1[2], v1[3]);
                    *(GAS u32x4*)(rowp + bj * HALF) = w; } }
    }
};
struct EpiMerge {
    static constexpr bool PERM = true;
    const bf16_t* P; bf16_t* U;
    __device__ __forceinline__ void operator()(const f32x4 (&acc)[2][2][4][2], const Unit& u, int wr, int wc, int fr, int fq) const {
        const int row0 = u.pm * BM + wr * 64 + fr; const int col0 = u.pn * BM + wc * 32 + 8 * fq;
        const int sub = u.sub; const int gcol = sub * 1024 + u.pn * BM; const int gd = ((gcol < 2048) ? (1024 + gcol) : (2048 + gcol)) + wc * 32 + 8 * fq;
        const bool addp = sub > 0;
#pragma unroll
        for (int ai = 0; ai < 2; ++ai)
#pragma unroll
            for (int m = 0; m < 4; ++m) { const size_t row = (size_t)(row0 + ai * HALF + m * 16); const GAS bf16_t* gp = lnd(P + row * PW + gd); GAS bf16_t* up = lnd(U + row * DM + col0);
#pragma unroll
                for (int bj = 0; bj < 2; ++bj) { const u32x4 gw = *(const GAS u32x4*)(gp + bj * HALF);
                    f32x4 a0 = acc[ai][bj][m][0], a1 = acc[ai][bj][m][1];
                    a0[0] *= bflo(gw.x); a0[1] *= bfhi(gw.x); a0[2] *= bflo(gw.y); a0[3] *= bfhi(gw.y); a1[0] *= bflo(gw.z); a1[1] *= bfhi(gw.z); a1[2] *= bflo(gw.w); a1[3] *= bfhi(gw.w);
                    if (addp) { const u32x4 pw = *(const GAS u32x4*)(up + bj * HALF);
                        a0[0] += bflo(pw.x); a0[1] += bfhi(pw.x); a0[2] += bflo(pw.y); a0[3] += bfhi(pw.y); a1[0] += bflo(pw.z); a1[1] += bfhi(pw.z); a1[2] += bflo(pw.w); a1[3] += bfhi(pw.w); }
                    u32x4 o; o.x = pack2(a0[0], a0[1]); o.y = pack2(a0[2], a0[3]); o.z = pack2(a1[0], a1[1]); o.w = pack2(a1[2], a1[3]);
                    *(GAS u32x4*)(up + bj * HALF) = o; } }
    }
};
struct EpiResid {
    static constexpr bool PERM = true;
    const float* inL; const float* inC; float* outL; float* outC; const float* mod;
    float* slab;
    __device__ __forceinline__ void operator()(const f32x4 (&acc)[2][2][4][2], const Unit& u, int wr, int wc, int fr, int fq) const {
        if (u.sub >= 1) {
            const int row0 = (u.pm - 64) * BM + wr * 64 + fr, col0 = u.pn * BM + wc * 32 + 8 * fq; float* sl = slab + (size_t)(u.sub - 1) * NCTX * DM;
#pragma unroll
            for (int ai = 0; ai < 2; ++ai)
#pragma unroll
                for (int m = 0; m < 4; ++m)
#pragma unroll
                    for (int bj = 0; bj < 2; ++bj) { GAS float* op = lnd(sl + (size_t)(row0 + ai * HALF + m * 16) * DM + col0 + bj * HALF); *(GAS f32x4*)op = acc[ai][bj][m][0]; *(GAS f32x4*)(op + 4) = acc[ai][bj][m][1]; }
            return;
        }
        const bool lat = u.pm < 64; const int rbase = lat ? u.pm * BM : (u.pm - 64) * BM;
        const float* in = lat ? inL : inC; float* out = lat ? outL : outC;
        const int row0 = rbase + wr * 64 + fr, col0 = u.pn * BM + wc * 32 + 8 * fq;
        const float* gt = mod + (size_t)(lat ? (u.pm >> 3) : 8) * 6144 + col0;
#pragma unroll
        for (int bj = 0; bj < 2; ++bj) { const f32x4 g0 = *(const f32x4*)(gt + bj * HALF), g1 = *(const f32x4*)(gt + bj * HALF + 4);
#pragma unroll
            for (int ai = 0; ai < 2; ++ai)
#pragma unroll
                for (int m = 0; m < 4; ++m) { const size_t ro = (size_t)(row0 + ai * HALF + m * 16) * DM + col0 + bj * HALF;
                    const GAS float* ip = lnd(in + ro); GAS float* op = lnd(out + ro); const f32x4 i0 = *(const GAS f32x4*)ip, i1 = *(const GAS f32x4*)(ip + 4);
                    *(GAS f32x4*)op = i0 + g0 * acc[ai][bj][m][0]; *(GAS f32x4*)(op + 4) = i1 + g1 * acc[ai][bj][m][1]; } }
    }
};

struct MergeSched {
    Sched base;
    __device__ bool next(int i, Unit& u) const {
        const int r = i / 3, n = i - 3 * r;
        if (!base.next(r, u)) return false;
        u.sub = n; u.aoff += (size_t)(n == 0 ? C_AG : C_BO + (n - 1) * 512) * 2; u.boff += (size_t)n * DM * 512 * 2;
        return true;
    }
};
struct SplitSched {
    Sched base;
    int sk;
    __device__ bool next(int i, Unit& u) const {
        if (base.next(i, u)) return true;
        const int nfull = (base.nwg - base.c + base.G - 1) / base.G;
        const int k = i - nfull; const int un = k * base.G + base.c; if (k < 0 || un >= 128) return false;
        const int ct = un >> 2, sl = un & 3; u.pm = 64 + (ct >> 2); u.pn = ct & 3; u.sub = 1 + sl; u.nt = sk / BK;
        u.aoff = (size_t)u.pm * BM * base.lda * 2 + (size_t)sl * sk * 2; u.boff = (size_t)u.pn * BM * base.ldb * 2 + (size_t)sl * sk * 2;
        return true;
    }
};
template <class Epi, class Sch>
__device__ __forceinline__ void gemm_phase(LAS unsigned char* lds, const Gemm g, const Sch& S, const Epi& E) {
    const int tid = tid_(), wid = __builtin_amdgcn_readfirstlane(tid >> 6), lane = tid & 63, wr = wid >> 2, wc = wid & 3, fr = lane & 15, fq = lane >> 4;
    const int K = g.K;
    unsigned voffA[2], voffB[2];
#pragma unroll
    for (int i = 0; i < 2; ++i) { int R, C; stage_rc(tid * 16 + i * 8192, R, C); const int Rb = Epi::PERM ? ((R & ~31) + perm32(R & 31)) : R;
        voffA[i] = (unsigned)(R * g.lda + C) * 2u; voffB[i] = (unsigned)(Rb * g.ldb + C) * 2u; }
    const size_t kstep = (size_t)(BK * 2);
    const size_t hstepA = (size_t)HALF * g.lda * 2, hstepB = (size_t)HALF * g.ldb * 2;
    const unsigned ldsw = (unsigned)wid * 1024u;
    const int aoff = lds_byte(wr * 64 + fr, fq * 8), boff = lds_byte(wc * 32 + fr, fq * 8);
#define PG8_SA(b, h) (((b) * 2 + (h)) * HTB)
#define PG8_SB(b, h) ((4 + (b) * 2 + (h)) * HTB)
#define PG8_STAGE(bufoff, gbase, voff) do { _Pragma("unroll") for (int _i = 0; _i < 2; ++_i) \
        __builtin_amdgcn_global_load_lds((const unsigned*)((const char*)(gbase) + (voff)[_i]), (LAS unsigned*)(lds + (bufoff) + ldsw + _i * 8192), 16, 0, 0); } while (0)
#define PG8_LDA(dst, b, h) do { _Pragma("unroll") for (int m = 0; m < 4; ++m) _Pragma("unroll") for (int k = 0; k < 2; ++k) dst[m][k] = *(const LAS bf16x8*)(lds + PG8_SA(b, h) + aoff + m * 2048 + k * 1024); } while (0)
#define PG8_LDB(dst, b, h) do { _Pragma("unroll") for (int n = 0; n < 2; ++n) _Pragma("unroll") for (int k = 0; k < 2; ++k) dst[n][k] = *(const LAS bf16x8*)(lds + PG8_SB(b, h) + boff + n * 2048 + k * 1024); } while (0)
#define PG8_MMA(ai, bj, At, Bt) do { __builtin_amdgcn_s_setprio(1); _Pragma("unroll") for (int m = 0; m < 4; ++m) _Pragma("unroll") for (int n = 0; n < 2; ++n) _Pragma("unroll") for (int k = 0; k < 2; ++k) \
        acc[ai][bj][m][n] = __builtin_amdgcn_mfma_f32_16x16x32_bf16(Bt[n][k], At[m][k], acc[ai][bj][m][n], 0, 0, 0); __builtin_amdgcn_s_setprio(0); } while (0)
#define PG8_WAIT_V(n) asm volatile("s_waitcnt vmcnt(" #n ")" ::: "memory")
#define PG8_WAIT_L(n) asm volatile("s_waitcnt lgkmcnt(" #n ")" ::: "memory")
#define PG8_BAR __builtin_amdgcn_s_barrier()
#define PG8_SCHED __builtin_amdgcn_sched_barrier(0)
    Unit cur, nxt; int ui = 0;
    if (!S.next(0, cur)) return;
    f32x4 acc[2][2][4][2];
#pragma unroll
    for (int a = 0; a < 2; ++a)
#pragma unroll
        for (int b = 0; b < 2; ++b)
#pragma unroll
            for (int m = 0; m < 4; ++m)
#pragma unroll
                for (int n = 0; n < 2; ++n) acc[a][b][m][n] = (f32x4){0.f, 0.f, 0.f, 0.f};
    bf16x8 At[4][2], B0[2][2], B1[2][2];
    const char* cA = (const char*)g.A + cur.aoff; const char* cB = (const char*)g.Bt + cur.boff;
    PG8_STAGE(PG8_SB(0, 0), cB, voffB); PG8_STAGE(PG8_SB(0, 1), cB + hstepB, voffB); PG8_STAGE(PG8_SA(0, 0), cA, voffA); PG8_STAGE(PG8_SA(0, 1), cA + hstepA, voffA);
    if (wr == 1) PG8_BAR;
    PG8_WAIT_V(2); PG8_BAR;
    PG8_STAGE(PG8_SB(1, 0), cB + kstep, voffB); PG8_STAGE(PG8_SA(1, 0), cA + kstep, voffA); PG8_STAGE(PG8_SB(1, 1), cB + hstepB + kstep, voffB);
    PG8_WAIT_V(6); PG8_BAR;
    for (;;) {
        const bool has_next = S.next(ui + 1, nxt);
        const char* nA = has_next ? (const char*)g.A + nxt.aoff : cA; const char* nB = has_next ? (const char*)g.Bt + nxt.boff : cB;
        const int nt = cur.nt ? cur.nt : K / BK;
        for (int t = 0; t < nt; t += 2) {
            const bool last = (t == nt - 2);
            const char* a1 = cA + (size_t)(t + 1) * kstep;
            const char* a2 = last ? nA : cA + (size_t)(t + 2) * kstep; const char* b2 = last ? nB : cB + (size_t)(t + 2) * kstep;
            const char* a3 = a2 + kstep; const char* b3 = b2 + kstep;
            PG8_LDB(B0, 0, 0); PG8_LDB(B1, 0, 1); PG8_SCHED; PG8_LDA(At, 0, 0); PG8_STAGE(PG8_SA(1, 1), a1 + hstepA, voffA);
            PG8_WAIT_V(8); PG8_WAIT_L(0); PG8_BAR; PG8_MMA(0, 0, At, B0); PG8_MMA(0, 1, At, B1); PG8_BAR; PG8_SCHED;
            PG8_LDA(At, 0, 1); PG8_STAGE(PG8_SB(0, 0), b2, voffB); PG8_STAGE(PG8_SB(0, 1), b2 + hstepB, voffB); PG8_STAGE(PG8_SA(0, 0), a2, voffA);
            PG8_WAIT_V(8); PG8_WAIT_L(0); PG8_BAR; PG8_MMA(1, 0, At, B0); PG8_MMA(1, 1, At, B1); PG8_BAR; PG8_SCHED;
            PG8_LDB(B0, 1, 0); PG8_LDB(B1, 1, 1); PG8_SCHED; PG8_LDA(At, 1, 0); PG8_STAGE(PG8_SA(0, 1), a2 + hstepA, voffA);
            PG8_WAIT_V(8); PG8_WAIT_L(0); PG8_BAR; PG8_MMA(0, 0, At, B0); PG8_MMA(0, 1, At, B1); PG8_BAR; PG8_SCHED;
            PG8_LDA(At, 1, 1); PG8_STAGE(PG8_SB(1, 0), b3, voffB); PG8_STAGE(PG8_SB(1, 1), b3 + hstepB, voffB); PG8_STAGE(PG8_SA(1, 0), a3, voffA);
            PG8_WAIT_V(8); PG8_WAIT_L(0); PG8_BAR; PG8_MMA(1, 0, At, B0); PG8_MMA(1, 1, At, B1); PG8_BAR; PG8_SCHED;
        }
        if (wr == 0) PG8_BAR;
        E(acc, cur, wr, wc, fr, fq);
        if (!has_next) break;
#pragma unroll
        for (int a = 0; a < 2; ++a)
#pragma unroll
            for (int b = 0; b < 2; ++b)
#pragma unroll
                for (int m = 0; m < 4; ++m)
#pragma unroll
                    for (int n = 0; n < 2; ++n) acc[a][b][m][n] = (f32x4){0.f, 0.f, 0.f, 0.f};
        cur = nxt; cA = nA; cB = nB; ++ui;
        if (wr == 1) PG8_BAR;
    }
    PG8_WAIT_V(0);
    PG8_BAR;
#undef PG8_SA
#undef PG8_SB
#undef PG8_STAGE
#undef PG8_LDA
#undef PG8_LDB
#undef PG8_MMA
#undef PG8_WAIT_V
#undef PG8_WAIT_L
#undef PG8_BAR
#undef PG8_SCHED
}
}


#define XB_TMO      128
#define XB_XCNT(j)  (256  + 64 * (j))
#define XB_XSUB(j)  (1280 + 64 * (j))
#define XB_XGEN(j)  (2304 + 64 * (j))
#define XB_TOP      3328
#define XB_TOPGEN   3392
#define XCD_BAR_WORDS 3456
#define XB_SPIN_CAP (1u << 20)
__device__ __forceinline__ unsigned xb_ld(unsigned* p)              { return __hip_atomic_load(p, __ATOMIC_RELAXED, __HIP_MEMORY_SCOPE_AGENT); }
__device__ __forceinline__ unsigned xb_add(unsigned* p, unsigned v) { return __hip_atomic_fetch_add(p, v, __ATOMIC_RELAXED, __HIP_MEMORY_SCOPE_AGENT); }
__device__ __forceinline__ unsigned xb_xcc_id() { return (unsigned)__builtin_amdgcn_s_getreg((3 << 11) | 20) & 0xFu; }
#define XB_SPIN(cond, bar) do { unsigned _sp = 0; while (cond) { __builtin_amdgcn_s_sleep(0); \
    if ((++_sp & 255u) == 0u) { if (xb_ld(&(bar)[XB_TMO])) break; if (_sp > XB_SPIN_CAP) { atomicAdd(&(bar)[XB_TMO], 1u); break; } } } } while (0)
struct XcdBarrier { unsigned* bar; unsigned x; volatile LAS unsigned* st; };
__device__ __forceinline__ XcdBarrier xcd_barrier_post(unsigned* bar, volatile LAS unsigned* st) {
    XcdBarrier b; b.bar = bar; b.x = xb_xcc_id(); b.st = st;
    if (threadIdx.x == 0) (void)xb_add(&bar[XB_XCNT(b.x)], 1u);
    return b;
}
__device__ __forceinline__ void xcd_barrier_complete(unsigned* bar, unsigned x, unsigned& nloc, unsigned& nx) {
    const unsigned G = gridDim.x * gridDim.y * gridDim.z;
    unsigned sum, cnt, mine, sp = 0u;
    for (;;) {
        sum = 0u; cnt = 0u; mine = 0u;
#pragma unroll
        for (unsigned j = 0; j < 16; ++j) { const unsigned c = xb_ld(&bar[XB_XCNT(j)]); sum += c; cnt += (c > 0u) ? 1u : 0u; mine = (j == x) ? c : mine; }
        if (sum == G) break;
        __builtin_amdgcn_s_sleep(1);
        if ((++sp & 255u) == 0u) { if (xb_ld(&bar[XB_TMO])) break; if (sp > XB_SPIN_CAP) { atomicAdd(&bar[XB_TMO], 1u); break; } }
    }
    nloc = mine > 0u ? mine : 1u; nx = cnt > 0u ? cnt : 1u;
}
__device__ __forceinline__ void xcd_barrier(const XcdBarrier& b) {
    asm volatile("s_waitcnt vmcnt(0)" ::: "memory");
    __syncthreads();
    if (threadIdx.x == 0) {
        unsigned* bar = b.bar;
        __builtin_amdgcn_s_waitcnt(0);
        unsigned nloc = b.st[0], nx = b.st[1];
        if (nloc == 0u) { xcd_barrier_complete(bar, b.x, nloc, nx); b.st[0] = nloc; b.st[1] = nx; }
        const unsigned old = xb_add(&bar[XB_XSUB(b.x)], 1u);
        const unsigned gen = old / nloc;
        if (old + 1u == (gen + 1u) * nloc) {
            __builtin_amdgcn_fence(__ATOMIC_RELEASE, "agent");
            asm volatile("s_waitcnt vmcnt(0)" ::: "memory");
            const unsigned og = xb_add(&bar[XB_TOP], 1u);
            const unsigned tg = og / nx;
            if (og + 1u == (tg + 1u) * nx) xb_add(&bar[XB_TOPGEN], 1u);
            else XB_SPIN(xb_ld(&bar[XB_TOPGEN]) == tg, bar);
            __builtin_amdgcn_fence(__ATOMIC_ACQUIRE, "agent");
            xb_add(&bar[XB_XGEN(b.x)], 1u);
            asm volatile("s_waitcnt vmcnt(0)" ::: "memory");
        } else {
            XB_SPIN(xb_ld(&bar[XB_XGEN(b.x)]) == gen, bar);
            __builtin_amdgcn_fence(__ATOMIC_ACQUIRE, "agent");
            asm volatile("s_waitcnt vmcnt(0)" ::: "memory");
        }
    }
    __syncthreads();
}

__device__ __forceinline__ void sub_barrier(unsigned* word, unsigned n) {
    asm volatile("s_waitcnt vmcnt(0)" ::: "memory");
    __syncthreads();
    if (threadIdx.x == 0) {
        __builtin_amdgcn_fence(__ATOMIC_RELEASE, "agent");
        asm volatile("s_waitcnt vmcnt(0)" ::: "memory");
        xb_add(word, 1u);
        unsigned sp = 0;
        while (xb_ld(word) < n) { __builtin_amdgcn_s_sleep(0); if (++sp > (1u << 22)) break; }
        __builtin_amdgcn_fence(__ATOMIC_ACQUIRE, "agent");
        asm volatile("s_waitcnt vmcnt(0)" ::: "memory");
    }
    __syncthreads();
}

__device__ __forceinline__ void phase_mod(const Params& p, LAS unsigned char* lds) {
    LAS float* sc = (LAS float*)lds;
    LAS float* part = sc + 9 * 1024;
    float* mod = (float*)(PF(ws) + WS_MOD);
    const int tid = tid_(), w = tid >> 6, lane = tid & 63;
    if ((int)blockIdx.x >= 192) return;
    const float* pc = PF(c); const float* pcc = PF(c_ctx); const float* padaw = PF(ada_w); const float* padab = PF(ada_b);
    for (int i = tid; i < 9 * 1024; i += 512) { const int r = i >> 10, k = i & 1023; const float v = (r < 8) ? pc[r * 1024 + k] : pcc[k]; sc[i] = v / (1.0f + expf(-v)); }
    __syncthreads();
    for (int item = blockIdx.x; item < 192; item += gridDim.x) {
        const int l = item / 96, cb = item % 96;
        const float* W = padaw + (size_t)l * 1024 * 6144 + cb * 64 + lane;
        float acc[9];
#pragma unroll
        for (int r = 0; r < 9; ++r) acc[r] = 0.f;
        for (int k = w * 128; k < w * 128 + 128; ++k) { const float wv = W[(size_t)k * 6144];
#pragma unroll
            for (int r = 0; r < 9; ++r) acc[r] += sc[r * 1024 + k] * wv; }
#pragma unroll
        for (int r = 0; r < 9; ++r) part[(w * 9 + r) * 64 + lane] = acc[r];
        __syncthreads();
        for (int i = tid; i < 576; i += 512) { const int r = i >> 6, ln = i & 63; float s = 0.f;
#pragma unroll
            for (int ww = 0; ww < 8; ++ww) s += part[(ww * 9 + r) * 64 + ln];
            mod[(size_t)(l * 9 + r) * 6144 + cb * 64 + ln] = s + padab[l * 6144 + cb * 64 + ln]; }
        __syncthreads();
    }
}
__device__ __forceinline__ void phase_rope(const Params& p) {
    if (blockIdx.x != gridDim.x - 1) return;
    float* rope = (float*)(PF(ws) + WS_ROPE);
    for (int i = tid_(); i < 1024; i += 512) { const int pos = i >> 4, fi = i & 15; const float invf = powf(10000.0f, -(float)fi / 16.0f); const float ang = (float)pos * invf; rope[i] = cosf(ang); rope[1024 + i] = sinf(ang); }
}
__device__ __forceinline__ void convert_tile(const float* src, int K, int N, bf16_t* dst, int tile, LAS bf16_t* T) {
    const int tid = tid_(), tilesN = N >> 7, tk = tile / tilesN, tn = tile - tk * tilesN, k0 = tk * 128, n0 = tn * 128;
    const int r = tid >> 4, c8 = (tid & 15) * 8;
    f32x4 a[4], b[4];
#pragma unroll
    for (int i = 0; i < 4; ++i) { const float* s = src + (size_t)(k0 + r + 32 * i) * N + n0 + c8; a[i] = *(const f32x4*)s; b[i] = *(const f32x4*)(s + 4); }
#pragma unroll
    for (int i = 0; i < 4; ++i)
#pragma unroll
        for (int j = 0; j < 4; ++j) { T[(c8 + j) * 136 + r + 32 * i] = (bf16_t)f2bf(a[i][j]); T[(c8 + 4 + j) * 136 + r + 32 * i] = (bf16_t)f2bf(b[i][j]); }
    __syncthreads();
    const int n = tid >> 2, ks = (tid & 3) * 8;
#pragma unroll
    for (int i = 0; i < 4; ++i) { const u32x4 v = *(const LAS u32x4*)(T + n * 136 + ks + 32 * i); *(u32x4*)(dst + (size_t)(n0 + n) * K + k0 + ks + 32 * i) = v; }
    __syncthreads();
}
__device__ __forceinline__ void phase_convert(const Params& p, int l, LAS unsigned char* lds) {
    LAS bf16_t* T = (LAS bf16_t*)lds;
    bf16_t* WIN = (bf16_t*)(PF(ws) + WS_WIN); bf16_t* WB = (bf16_t*)(PF(ws) + WS_WB); bf16_t* WO = (bf16_t*)(PF(ws) + WS_WO); bf16_t* W1 = (bf16_t*)(PF(ws) + WS_W1); bf16_t* W2 = (bf16_t*)(PF(ws) + WS_W2);
    for (int it = blockIdx.x; it < 1184; it += gridDim.x) {
        if (it < 512) convert_tile(PF(w_in) + (size_t)l * DM * DIN, DM, DIN, WIN, it, T);
        else if (it < 608) { const int n = (it - 512) / 32, tl = (it - 512) % 32; convert_tile(PF(w_branch) + (size_t)(l * 3 + n) * 512 * DM, 512, DM, WB + (size_t)n * DM * 512, tl, T); }
        else if (it < 672) convert_tile(PF(w_out) + (size_t)l * DM * DM, DM, DM, WO, it - 608, T);
        else if (it < 928) convert_tile(PF(ffn_w1) + (size_t)l * DM * DFF, DM, DFF, W1, it - 672, T);
        else convert_tile(PF(ffn_w2) + (size_t)l * DFF * DM, DFF, DM, W2, it - 928, T);
    }
}
__device__ __forceinline__ void phase_norm(const Params& p, int l, const float* hlat, const float* hctx, const float* g, int modoff, int nrows, const float* slab = nullptr, const float* slabgate = nullptr, float* hwrite = nullptr) {
    const int tid = tid_(); const int w = tid >> 6, lane = tid & 63;
    bf16_t* U = (bf16_t*)(PF(ws) + WS_U); const float* mod = (const float*)(PF(ws) + WS_MOD);
    for (int row = blockIdx.x * 8 + w; row < nrows; row += gridDim.x * 8) {
        const float* src = row < NLAT ? hlat + (size_t)row * DM : hctx + (size_t)(row - NLAT) * DM;
        const int mr = row < NLAT ? (row >> 11) : 8;
        const float* md = mod + (size_t)(l * 9 + mr) * 6144 + modoff;
        f32x4 v[4]; float ss = 0.f;
#pragma unroll
        for (int i = 0; i < 4; ++i) { v[i] = *(const f32x4*)(src + i * 256 + lane * 4);
            if (slab != nullptr && row >= NLAT) { const size_t o = (size_t)(row - NLAT) * DM + i * 256 + lane * 4; const f32x4 gg = *(const f32x4*)(slabgate + i * 256 + lane * 4);
                const f32x4 s4 = (*(const f32x4*)(slab + o) + *(const f32x4*)(slab + o + (size_t)NCTX * DM)) + (*(const f32x4*)(slab + o + (size_t)2 * NCTX * DM) + *(const f32x4*)(slab + o + (size_t)3 * NCTX * DM));
                v[i] += gg * s4; if (hwrite != nullptr) *(f32x4*)(hwrite + o) = v[i]; }
            ss += v[i][0] * v[i][0] + v[i][1] * v[i][1] + v[i][2] * v[i][2] + v[i][3] * v[i][3]; }
#pragma unroll
        for (int o = 32; o >= 1; o >>= 1) ss += __shfl_xor(ss, o);
        const float rstd = rsqrtf(ss * (1.0f / 1024.0f) + 1e-6f);
#pragma unroll
        for (int i = 0; i < 4; ++i) { const int cidx = i * 256 + lane * 4; const f32x4 gg = *(const f32x4*)(g + cidx), sh = *(const f32x4*)(md + cidx), scv = *(const f32x4*)(md + 1024 + cidx);
            float o4[4];
#pragma unroll
            for (int j = 0; j < 4; ++j) o4[j] = (v[i][j] * rstd * gg[j]) * (1.0f + scv[j]) + sh[j];
            u32x2 wv; wv.x = pack2(o4[0], o4[1]); wv.y = pack2(o4[2], o4[3]);
            *(u32x2*)(U + (size_t)row * DM + cidx) = wv; }
    }
}
__device__ __forceinline__ void phase_hg_final(const Params& p, int l, int b, int wgi) {
    const int tid = tid_(); const int w = tid >> 6, lane = tid & 63; bf16_t* P = (bf16_t*)(PF(ws) + WS_P);
    const int hd = lane >> 4, e8 = (lane & 15) * 8; const float* png = PF(hg_norm_g);
    float ng[8];
#pragma unroll
    for (int i = 0; i < 8; ++i) ng[i] = png[l * 128 + e8 + i];
    for (int i0 = wgi * 8 + w; i0 < 2304; i0 += 3 * 64) {
        u32x4 ra[3], rb[3], ro[3]; bf16_t* rp[3];
#pragma unroll
        for (int k = 0; k < 3; ++k) { const int i = i0 + 64 * k; const int ic = i < 2304 ? i : i0; const size_t row = ic < 2048 ? (size_t)b * SEQ + ic : (size_t)NLAT + b * CTXL + (ic - 2048);
            rp[k] = P + row * PW; ra[k] = *(const u32x4*)(rp[k] + C_BF + hd * 128 + e8); rb[k] = *(const u32x4*)(rp[k] + C_BF + 512 + hd * 128 + e8); ro[k] = *(const u32x4*)(rp[k] + C_BO + hd * 128 + e8); }
#pragma unroll
        for (int k = 0; k < 3; ++k) {
            float a[8], bb[8], og[8]; unpack8(ra[k], a); unpack8(rb[k], bb); unpack8(ro[k], og);
            float ss = 0.f;
#pragma unroll
            for (int i = 0; i < 8; ++i) { a[i] += bb[i]; ss += a[i] * a[i]; }
            ss += __shfl_xor(ss, 1); ss += __shfl_xor(ss, 2); ss += __shfl_xor(ss, 4); ss += __shfl_xor(ss, 8);
            const float rstd = rsqrtf(ss * (1.0f / 128.0f) + 1e-6f);
            float y[8];
#pragma unroll
            for (int i = 0; i < 8; ++i) y[i] = a[i] * rstd * ng[i] * sigmoidf_(og[i]);
            if (i0 + 64 * k < 2304) *(u32x4*)(rp[k] + C_BO + hd * 128 + e8) = pack8(y);
        }
    }
}

__device__ __forceinline__ size_t agg_idx(int b, int gch, int dir, int which, int ch) { return ((((size_t)b * 36 + gch) * 2 + dir) * 2 + which) * 512 + ch; }
__device__ __forceinline__ float gelu_tanh(float x) { const float u = 0.7978845608028654f * (x + 0.044715f * x * x * x); const float th = 1.0f - 2.0f * __builtin_amdgcn_rcpf(1.0f + __expf(2.0f * u)); return 0.5f * x * (1.0f + th); }
struct LruPtrs { bf16_t* P; float* AGG; const float *cb, *cw, *ba, *bx, *lam; };
__device__ __forceinline__ LruPtrs lru_ptrs() { LruPtrs q; q.P = (bf16_t*)(PF(ws) + WS_P); q.AGG = (float*)(PF(ws) + WS_AGG); q.cb = PF(conv_b); q.cw = PF(conv_w); q.ba = PF(lru_ba); q.bx = PF(lru_bx); q.lam = PF(lru_lambda); return q; }
__device__ __forceinline__ void lru_tile(const Params& p, int l, LAS unsigned char* lds, int item, int mode, int& staged_nb, const LruPtrs& lp) {
    LAS bf16_t* Wl = (LAS bf16_t*)lds;
    LAS bf16_t* Xb = Wl + 256 * 72;
    LAS float* Xf = (LAS float*)(lds + 46080);
    LAS float* Av = Xf + 4096;
    LAS float* Bv = Av + 8192;
    bf16_t* P = lp.P; float* AGG = lp.AGG;
    const int tid = tid_(), w = tid >> 6, lane = tid & 63, l16 = lane & 15, q4 = lane >> 4;
    const int nb = item & 7, rest = item >> 3, gch = rest % 36, b = rest / 36;
    const bool isctx = gch < 4; const int chunk = isctx ? gch : gch - 4, L = isctx ? CTXL : SEQ;
    const size_t seqrow0 = isctx ? (size_t)NLAT + b * CTXL : (size_t)b * SEQ; const int t0 = chunk * 64;
    if (staged_nb != nb) { const float* pwx = PF(lru_wx); const float* pwa = PF(lru_wa);
        for (int e = tid; e < 4 * 64 * 64; e += 512) { const int mat = e >> 12, i = (e >> 6) & 63, c = e & 63; const int dir = mat >> 1, kind = mat & 1;
            const float* W = kind ? pwx : pwa; const float v = W[((size_t)((l * 2 + dir) * 8 + nb) * 64 + i) * 64 + c];
            const int op = dir * 128 + (c >> 4) * 32 + kind * 16 + (c & 15);
            Wl[op * 72 + i] = (bf16_t)f2bf(v); }
        staged_nb = nb;
    }
    {
        const int t = tid >> 3, c8 = (tid & 7) * 8, ch = nb * 64 + c8, tt = t0 + t;
        float a8[8]; const float* pcb = lp.cb; const float* pcw = lp.cw;
        { const f32x4 b0 = *(const f32x4*)(pcb + l * 512 + ch), b1 = *(const f32x4*)(pcb + l * 512 + ch + 4);
#pragma unroll
          for (int i = 0; i < 4; ++i) { a8[i] = b0[i]; a8[4 + i] = b1[i]; } }
#pragma unroll
        for (int j = 0; j < 4; ++j) { const int ts = tt + j - 2;
            if (ts >= 0 && ts < L) { float xv[8]; unpack8(*(const u32x4*)(P + (seqrow0 + ts) * PW + C_AX + ch), xv);
                const f32x4 w0 = *(const f32x4*)(pcw + (l * 4 + j) * 512 + ch), w1 = *(const f32x4*)(pcw + (l * 4 + j) * 512 + ch + 4);
#pragma unroll
                for (int i = 0; i < 4; ++i) { a8[i] += xv[i] * w0[i]; a8[4 + i] += xv[4 + i] * w1[i]; } } }
#pragma unroll
        for (int i = 0; i < 8; ++i) Xf[t * 64 + c8 + i] = a8[i];
        *(LAS u32x4*)(Xb + t * 72 + c8) = pack8(a8);
    }
    __syncthreads();
    {
        const int dir = w >> 2, c = (w & 3) * 16 + l16, ch = nb * 64 + c;
        f32x4 acc[4][2];
#pragma unroll
        for (int mg = 0; mg < 4; ++mg) { acc[mg][0] = (f32x4){0.f, 0.f, 0.f, 0.f}; acc[mg][1] = (f32x4){0.f, 0.f, 0.f, 0.f}; }
#pragma unroll
        for (int ks = 0; ks < 2; ++ks) {
            const bf16x8 B0 = *(const LAS bf16x8*)(Wl + (w * 32 + l16) * 72 + ks * 32 + q4 * 8), B1 = *(const LAS bf16x8*)(Wl + (w * 32 + 16 + l16) * 72 + ks * 32 + q4 * 8);
#pragma unroll
            for (int mg = 0; mg < 4; ++mg) { const bf16x8 A = *(const LAS bf16x8*)(Xb + (mg * 16 + l16) * 72 + ks * 32 + q4 * 8);
                acc[mg][0] = mfma16(A, B0, acc[mg][0]); acc[mg][1] = mfma16(A, B1, acc[mg][1]); }
        }
        const float ba = lp.ba[(l * 2 + dir) * 512 + ch], bx = lp.bx[(l * 2 + dir) * 512 + ch], lam = lp.lam[(l * 2 + dir) * 512 + ch];
        const float sp = log1pf(expf(-lam));
#pragma unroll
        for (int mg = 0; mg < 4; ++mg)
#pragma unroll
            for (int j = 0; j < 4; ++j) { const int t = mg * 16 + q4 * 4 + j;
                const float ea = 1.0f + __expf(-(acc[mg][0][j] + ba)), ex = 1.0f + __expf(-(acc[mg][1][j] + bx)); const float inv = __builtin_amdgcn_rcpf(ea * ex);
                const float r = inv * ex, ig = inv * ea;
                const float la = -8.0f * r * sp; const float a = __expf(la); const float x2 = 2.0f * la;
                float om = -x2 * (1.0f + x2 * (0.5f + x2 * (0.16666667f + x2 * (0.041666668f + x2 * 0.0083333338f))));
                if (x2 < -0.35f) om = 1.0f - a * a;
                const float bb = sqrtf(fmaxf(om, 0.f)) * ig * Xf[t * 64 + c];
                Av[(dir * 64 + t) * 64 + c] = a; Bv[(dir * 64 + t) * 64 + c] = bb; }
    }
    __syncthreads();
    {
        LAS float* SegA = Xf;
        LAS float* SegB = Xf + 512;
        const int d2 = tid >> 8, seg = (tid >> 6) & 3, c = tid & 63, ch = nb * 64 + c;
        float av[16], bv[16];
#pragma unroll
        for (int k = 0; k < 16; ++k) { const int s = seg * 16 + k; const int t = d2 ? 63 - s : s; const int ix = (d2 * 64 + t) * 64 + c; av[k] = Av[ix]; bv[k] = Bv[ix]; }
        float h = 0.f, ap = 1.f;
#pragma unroll
        for (int k = 0; k < 16; ++k) { h = av[k] * h + bv[k]; ap *= av[k]; }
        SegA[(d2 * 4 + seg) * 64 + c] = ap; SegB[(d2 * 4 + seg) * 64 + c] = h;
        float hin = 0.f;
        if (mode == 1) {
            const int mypos = d2 == 0 ? gch : (gch < 4 ? 3 - gch : 39 - gch);
            for (int p0 = 0; p0 < mypos; p0 += 6) { float Aa[6], Bb[6];
#pragma unroll
                for (int j = 0; j < 6; ++j) { const int pp = p0 + j; const int g = d2 == 0 ? pp : (pp < 4 ? 3 - pp : 39 - pp); const bool ok = pp < mypos;
                    Aa[j] = ok ? AGG[agg_idx(b, ok ? g : 0, d2, 0, ch)] : 1.0f; Bb[j] = ok ? AGG[agg_idx(b, ok ? g : 0, d2, 1, ch)] : 0.0f; }
#pragma unroll
                for (int j = 0; j < 6; ++j) hin = Aa[j] * hin + Bb[j]; }
        }
        __syncthreads();
        if (mode == 0) {
            if (seg == 3) { float A = 1.f, B = 0.f;
#pragma unroll
                for (int s2 = 0; s2 < 4; ++s2) { const float sa = SegA[(d2 * 4 + s2) * 64 + c], sb2 = SegB[(d2 * 4 + s2) * 64 + c]; B = sa * B + sb2; A *= sa; }
                AGG[agg_idx(b, gch, d2, 0, ch)] = A; AGG[agg_idx(b, gch, d2, 1, ch)] = B; }
        } else {
#pragma unroll
            for (int s2 = 0; s2 < 3; ++s2) if (s2 < seg) hin = SegA[(d2 * 4 + s2) * 64 + c] * hin + SegB[(d2 * 4 + s2) * 64 + c];
            float hh2 = hin;
#pragma unroll
            for (int k = 0; k < 16; ++k) { const int s = seg * 16 + k; const int t = d2 ? 63 - s : s; hh2 = av[k] * hh2 + bv[k]; Bv[(d2 * 64 + t) * 64 + c] = hh2; }
        }
    }
    __syncthreads();
    if (mode == 1) {
        const int t = tid >> 3, c8 = (tid & 7) * 8; bf16_t* gp = P + (seqrow0 + t0 + t) * PW + C_AG + nb * 64 + c8;
        float gt[8]; unpack8(*(const u32x4*)gp, gt); float y[8];
#pragma unroll
        for (int i = 0; i < 8; ++i) y[i] = (Bv[t * 64 + c8 + i] + Bv[(64 + t) * 64 + c8 + i]) * gelu_tanh(gt[i]);
        *(u32x4*)gp = pack8(y);
        __syncthreads();
    }
}

template <bool B> struct BoolC { static constexpr bool value = B; };
__device__ __forceinline__ void attn_item(const Params& p, int l, LAS unsigned char* lds, int item, int dry = 0) {
    LAS bf16_t* Kt = (LAS bf16_t*)lds;
    LAS float* rpbL = (LAS float*)(lds + 73728);
    LAS float* cosT = rpbL + 960;
    LAS float* sinT = cosT + 1024;
    LAS float* gq = sinT + 1024; LAS float* gk = gq + 64;
    bf16_t* P = (bf16_t*)(PF(ws) + WS_P); const float* rope = (const float*)(PF(ws) + WS_ROPE);
    const int tid = tid_(), w = __builtin_amdgcn_readfirstlane(tid >> 6), lane = tid & 63, l16 = lane & 15, q4 = lane >> 4, hh = w >> 2, qg4 = w & 3;
    const bool isctx = item >= 512;
    int b, hp, nloc, krU; int rq[2], kq0[2]; size_t qrow0[2];
    if (!isctx) { hp = item & 3; const int rp = (item >> 2) & 15; b = item >> 6;
        rq[0] = 2 * rp; rq[1] = 2 * rp + 1; kq0[0] = min(max(rq[0] - 4, 0), 24); kq0[1] = min(max(rq[1] - 4, 0), 24);
        qrow0[0] = (size_t)b * SEQ + rq[0] * 64; qrow0[1] = qrow0[0] + 64; krU = kq0[0]; nloc = kq0[1] + 8 - kq0[0]; }
    else { const int it = item - 512; hp = it & 3; const int qt = (it >> 2) & 1; b = it >> 3; rq[0] = rq[1] = 0; kq0[0] = kq0[1] = 0; krU = 0; nloc = 0;
        qrow0[0] = (size_t)NLAT + b * CTXL + qt * 128; qrow0[1] = qrow0[0] + 64; }
    const int h = hp * 2 + hh;
    const float* prpb = PF(na_rpb);
    for (int i = tid; i < 2 * 465; i += 512) { const int h2 = i / 465, j = i - h2 * 465; rpbL[h2 * 480 + j] = prpb[(size_t)((l * 8 + hp * 2 + h2) * 465) + j]; }
    for (int i = tid; i < 1024; i += 512) { cosT[i] = rope[i]; sinT[i] = rope[1024 + i]; }
    if (tid < 64) { gq[tid] = PF(na_qg)[l * 64 + tid]; gk[tid] = PF(na_kg)[l * 64 + tid]; }
    __syncthreads();
    const int qc = qg4 * 16 + l16;
    const int glo = qg4 < 2 ? 0 : qg4 - 1, ghi = qg4 == 0 ? 1 : (qg4 == 3 ? 3 : qg4 + 1);
    unsigned mbits = 0u; const int bbase = q4 * 4 - qc;
    { const int cs0 = min(max(qc - 8, 0), 48);
#pragma unroll
      for (int g = 0; g < 4; ++g)
#pragma unroll
          for (int j = 0; j < 4; ++j) { const int kc = g * 16 + q4 * 4 + j; if (kc < cs0 || kc >= cs0 + 16) mbits |= 1u << (g * 4 + j); } }
    bf16x8 qpl[2][2], qrt[2][2];
#pragma unroll
    for (int qi = 0; qi < 2; ++qi) {
        const bf16_t* qp = P + (qrow0[qi] + qc) * PW + C_CQ + h * 64;
        float xq[16]; unpack8(*(const u32x4*)(qp + q4 * 8), xq); unpack8(*(const u32x4*)(qp + 32 + q4 * 8), xq + 8);
        float ss = 0.f;
#pragma unroll
        for (int i = 0; i < 16; ++i) ss += xq[i] * xq[i];
        ss += __shfl_xor(ss, 16); ss += __shfl_xor(ss, 32);
        const float rs = rsqrtf(ss * (1.0f / 64.0f) + 1e-6f) * 0.125f;
#pragma unroll
        for (int i = 0; i < 8; ++i) { xq[i] *= rs * gq[q4 * 8 + i]; xq[8 + i] *= rs * gq[32 + q4 * 8 + i]; }
        qpl[qi][0] = as_bf16x8(pack8(xq)); qpl[qi][1] = as_bf16x8(pack8(xq + 8));
        float xr[16];
#pragma unroll
        for (int ks = 0; ks < 2; ++ks) { const int pos = ks == 0 ? rq[qi] : qc;
#pragma unroll
            for (int jj = 0; jj < 8; ++jj) { const int fi = (q4 & 1) * 8 + jj; const float cs = cosT[pos * 16 + fi], sn = sinT[pos * 16 + fi]; const float xv = xq[ks * 8 + jj]; const float pr = __shfl_xor(xv, 32);
                xr[ks * 8 + jj] = (q4 < 2) ? (xv * cs - pr * sn) : (xv * cs + pr * sn); } }
        qrt[qi][0] = as_bf16x8(pack8(xr)); qrt[qi][1] = as_bf16x8(pack8(xr + 8));
    }
    f32x4 O[2][4];
#pragma unroll
    for (int qi = 0; qi < 2; ++qi)
#pragma unroll
        for (int i = 0; i < 4; ++i) O[qi][i] = (f32x4){0.f, 0.f, 0.f, 0.f};
    float mrun[2] = {-1e30f, -1e30f}, lsum[2] = {0.f, 0.f};
    const int pf_hh2 = tid >> 8, pf_h2 = hp * 2 + pf_hh2, pf_key = (tid & 255) >> 2, pf_seg = tid & 3, pf_vseg = (tid & 255) >> 6, pf_vkey = tid & 63;
    u32x4 pk0, pk1, pv0, pv1;
    { const size_t r0 = nloc ? (size_t)b * SEQ + krU * 64 : (size_t)NLAT + b * CTXL;
      const bf16_t* kp = P + (r0 + pf_key) * PW + C_CK + pf_h2 * 64 + pf_seg * 16; pk0 = *(const u32x4*)kp; pk1 = *(const u32x4*)(kp + 8);
      const bf16_t* vp = P + (r0 + pf_vkey) * PW + C_CV + pf_h2 * 64 + pf_vseg * 16; pv0 = *(const u32x4*)vp; pv1 = *(const u32x4*)(vp + 8); }
    const int ntot = nloc + 4;
    auto stage = [&](int T, int buf) {
        const bool sloc = T < nloc; const int kr = krU + T;
        LAS bf16_t* KtB = Kt + buf * (4 * 64 * 72); LAS bf16_t* VtB = KtB + 2 * 64 * 72;
        {
            const int hh2 = pf_hh2, key = pf_key, seg = pf_seg;
            float xk[16]; unpack8(pk0, xk); unpack8(pk1, xk + 8);
            float ss = 0.f;
#pragma unroll
            for (int i = 0; i < 16; ++i) ss += xk[i] * xk[i];
            ss += __shfl_xor(ss, 1); ss += __shfl_xor(ss, 2);
            const float rs = rsqrtf(ss * (1.0f / 64.0f) + 1e-6f);
#pragma unroll
            for (int i = 0; i < 16; ++i) xk[i] *= rs * gk[seg * 16 + i];
            if (sloc) { const int pos = seg < 2 ? kr : key;
#pragma unroll
                for (int i = 0; i < 16; ++i) { const float pr = __shfl_xor(xk[i], 1); const float cs = cosT[pos * 16 + i], sn = sinT[pos * 16 + i]; xk[i] = (seg & 1) ? (xk[i] * cs + pr * sn) : (xk[i] * cs - pr * sn); } }
            LAS bf16_t* kd = KtB + (hh2 * 64 + key) * 72 + seg * 16;
            *(LAS u32x4*)kd = pack8(xk); *(LAS u32x4*)(kd + 8) = pack8(xk + 8);
        }
        {
            const int hh2 = pf_hh2, seg = pf_vseg, key = pf_vkey;
            const u32x4 a = pv0, c = pv1;
            LAS bf16_t* vd = VtB + (hh2 * 64 + seg * 16) * 72 + key;
            vd[0 * 72] = (bf16_t)(a.x & 0xffff); vd[1 * 72] = (bf16_t)(a.x >> 16); vd[2 * 72] = (bf16_t)(a.y & 0xffff); vd[3 * 72] = (bf16_t)(a.y >> 16);
            vd[4 * 72] = (bf16_t)(a.z & 0xffff); vd[5 * 72] = (bf16_t)(a.z >> 16); vd[6 * 72] = (bf16_t)(a.w & 0xffff); vd[7 * 72] = (bf16_t)(a.w >> 16);
            vd[8 * 72] = (bf16_t)(c.x & 0xffff); vd[9 * 72] = (bf16_t)(c.x >> 16); vd[10 * 72] = (bf16_t)(c.y & 0xffff); vd[11 * 72] = (bf16_t)(c.y >> 16);
            vd[12 * 72] = (bf16_t)(c.z & 0xffff); vd[13 * 72] = (bf16_t)(c.z >> 16); vd[14 * 72] = (bf16_t)(c.w & 0xffff); vd[15 * 72] = (bf16_t)(c.w >> 16);
        }
        { const int Tn = T + 1; if (Tn < ntot) { const size_t r0 = (Tn < nloc) ? (size_t)b * SEQ + (krU + Tn) * 64 : (size_t)NLAT + b * CTXL + (Tn - nloc) * 64;
            const bf16_t* kp = P + (r0 + pf_key) * PW + C_CK + pf_h2 * 64 + pf_seg * 16; pk0 = *(const u32x4*)kp; pk1 = *(const u32x4*)(kp + 8);
            const bf16_t* vp = P + (r0 + pf_vkey) * PW + C_CV + pf_h2 * 64 + pf_vseg * 16; pv0 = *(const u32x4*)vp; pv1 = *(const u32x4*)(vp + 8); } }
    };
    auto compute = [&](auto LOC, int T, int buf) {
        constexpr bool loc = decltype(LOC)::value; const int kr = krU + T;
        const LAS bf16_t* KtB = Kt + buf * (4 * 64 * 72); const LAS bf16_t* VtB = KtB + 2 * 64 * 72;
#pragma unroll
        for (int qi = 0; qi < 2; ++qi) {
            if (loc && (kr < kq0[qi] || kr >= kq0[qi] + 8)) continue;
            f32x4 st[4];
#pragma unroll
            for (int g = 0; g < 4; ++g) { const bool use = !loc || (g >= glo && g <= ghi);
                st[g] = (f32x4){0.f, 0.f, 0.f, 0.f};
                if (use) {
#pragma unroll
                    for (int ks = 0; ks < 2; ++ks) st[g] = mfma16(*(const LAS bf16x8*)(KtB + (hh * 64 + g * 16 + l16) * 72 + ks * 32 + q4 * 8), loc ? qrt[qi][ks] : qpl[qi][ks], st[g]);
                    if (loc) { const int dr31 = (kr - rq[qi] + 7) * 31;
#pragma unroll
                        for (int j = 0; j < 4; ++j) { const float sv = st[g][j] + rpbL[hh * 480 + min(max(bbase + g * 16 + j, -15), 15) + 15 + dr31]; st[g][j] = ((mbits >> (g * 4 + j)) & 1u) ? -1e30f : sv; } }
                } else st[g] = (f32x4){-1e30f, -1e30f, -1e30f, -1e30f};
            }
            float tmax = -1e30f;
#pragma unroll
            for (int g = 0; g < 4; ++g)
#pragma unroll
                for (int j = 0; j < 4; ++j) tmax = fmaxf(tmax, st[g][j]);
            tmax = fmaxf(tmax, __shfl_xor(tmax, 16)); tmax = fmaxf(tmax, __shfl_xor(tmax, 32));
            const float mnew = fmaxf(mrun[qi], tmax); const float alpha = __expf(mrun[qi] - mnew); mrun[qi] = mnew;
            float psum = 0.f;
#pragma unroll
            for (int g = 0; g < 4; ++g) { const bool use = !loc || (g >= glo && g <= ghi);
                if (use) {
#pragma unroll
                    for (int j = 0; j < 4; ++j) { const float pv = __expf(st[g][j] - mnew); st[g][j] = pv; psum += pv; }
                } else st[g] = (f32x4){0.f, 0.f, 0.f, 0.f}; }
            lsum[qi] = lsum[qi] * alpha + psum;
#pragma unroll
            for (int i = 0; i < 4; ++i) O[qi][i] *= alpha;
            bf16x8 pb[2];
#pragma unroll
            for (int ks = 0; ks < 2; ++ks) { u32x4 wv; wv.x = pack2(st[2 * ks][0], st[2 * ks][1]); wv.y = pack2(st[2 * ks][2], st[2 * ks][3]); wv.z = pack2(st[2 * ks + 1][0], st[2 * ks + 1][1]); wv.w = pack2(st[2 * ks + 1][2], st[2 * ks + 1][3]); pb[ks] = as_bf16x8(wv); }
#pragma unroll
            for (int ks = 0; ks < 2; ++ks) if (!loc || (2 * ks + 1 >= glo && 2 * ks <= ghi))
#pragma unroll
                for (int dg = 0; dg < 4; ++dg) { const LAS bf16_t* vr = VtB + (hh * 64 + dg * 16 + l16) * 72 + ks * 32 + q4 * 4;
                    const u32x2 lo = *(const LAS u32x2*)vr, hi = *(const LAS u32x2*)(vr + 16); u32x4 av; av.x = lo.x; av.y = lo.y; av.z = hi.x; av.w = hi.y;
                    O[qi][dg] = mfma16(as_bf16x8(av), pb[ks], O[qi][dg]); }
        }
    };
    stage(0, 0);
    __syncthreads();
    for (int T = 0; T < nloc; ++T) {
        stage(T + 1, (T + 1) & 1);
        compute(BoolC<true>{}, T, T & 1);
        __syncthreads();
    }
    for (int T = nloc; T < ntot; ++T) {
        if (T + 1 < ntot) stage(T + 1, (T + 1) & 1);
        compute(BoolC<false>{}, T, T & 1);
        __syncthreads();
    }
#pragma unroll
    for (int qi = 0; qi < 2; ++qi) {
        float ls = lsum[qi]; ls += __shfl_xor(ls, 16); ls += __shfl_xor(ls, 32);
        const float inv = 1.0f / ls;
        bf16_t* op = dry ? ((bf16_t*)(PF(ws) + WS_DUMMY) + (size_t)(blockIdx.x & 63) * 16384 + (size_t)((qi * 8 + w) * 16 + l16) * 64) : (P + (qrow0[qi] + qc) * PW + C_CQ + h * 64);
#pragma unroll
        for (int dg = 0; dg < 4; ++dg) { u32x2 wv; wv.x = pack2(O[qi][dg][0] * inv, O[qi][dg][1] * inv); wv.y = pack2(O[qi][dg][2] * inv, O[qi][dg][3] * inv); *(u32x2*)(op + dg * 16 + q4 * 4) = wv; }
    }
    __syncthreads();
}

__device__ __forceinline__ void hgrn_stage(const bf16_t* P, LAS unsigned char* lds, int w, int lane, size_t row0, int dir, int h) {
#pragma unroll
    for (int i = 0; i < 2; ++i) { const int blk = i * 8 + w; const int t = blk * 4 + (lane >> 4); const bf16_t* rp = P + (row0 + (dir ? 63 - t : t)) * PW + (lane & 15) * 8;
        __builtin_amdgcn_global_load_lds((const unsigned*)(rp + C_BQ + h * 128), (LAS unsigned*)(lds + 118784 + blk * 1024), 16, 0, 0);
        __builtin_amdgcn_global_load_lds((const unsigned*)(rp + C_BF + dir * 512 + h * 128), (LAS unsigned*)(lds + 135168 + blk * 1024), 16, 0, 0); }
}
__device__ __forceinline__ void hgrn_chain(const Params& p, int l, LAS unsigned char* lds, int chain, int dry = 0) {
    LAS bf16_t* Q0 = (LAS bf16_t*)lds;
    LAS bf16_t* KP = (LAS bf16_t*)(lds + 17408);
    LAS bf16_t* SB = (LAS bf16_t*)(lds + 34816);
    LAS bf16_t* KDT = (LAS bf16_t*)(lds + 69632);
    LAS bf16_t* VT = (LAS bf16_t*)(lds + 88064);
    LAS bf16_t* ATT = (LAS bf16_t*)(lds + 106496);
    LAS float* TOT = (LAS float*)(lds + 115712);
    LAS float* DD = (LAS float*)(lds + 117760);
    const LAS bf16_t* SQ = (const LAS bf16_t*)(lds + 118784);
    const LAS bf16_t* SF = (const LAS bf16_t*)(lds + 135168);
    bf16_t* P = (bf16_t*)(PF(ws) + WS_P);
    const int tid = tid_(), w = __builtin_amdgcn_readfirstlane(tid >> 6), lane = tid & 63, l16 = lane & 15, q4 = lane >> 4;
    const int dir = chain & 1, h = (chain >> 1) & 3, b = chain >> 3;
    const int d = tid & 127, sb = tid >> 7;
    float lbv = 0.f;
    if (l > 0) { const float x0 = PF(hg_lb)[(dir * 2 + 0) * 512 + h * 128 + d], x1 = PF(hg_lb)[(dir * 2 + 1) * 512 + h * 128 + d]; lbv = 1.0f / (1.0f + expf(x0 - x1)); }
    for (int i = tid; i < 64 * 72 / 2; i += 512) ((LAS unsigned*)ATT)[i] = 0u;
    f32x4 S[8];
#pragma unroll
    for (int i = 0; i < 8; ++i) S[i] = (f32x4){0.f, 0.f, 0.f, 0.f};
    { const int gch0 = dir == 0 ? 0 : 3; hgrn_stage(P, lds, w, lane, (size_t)NLAT + b * CTXL + gch0 * 64, dir, h); }
    asm volatile("s_waitcnt vmcnt(0)" ::: "memory");
    __syncthreads();
    for (int ci = 0; ci < 36; ++ci) {
        const int gch = dir == 0 ? ci : (ci < 4 ? 3 - ci : 39 - ci);
        const bool isctx = gch < 4; const int chunk = isctx ? gch : gch - 4;
        const size_t row0 = isctx ? (size_t)NLAT + b * CTXL + chunk * 64 : (size_t)b * SEQ + chunk * 64;
        float bl[16], qv[16], kv[16]; float run = 0.f;
        {
            unsigned vraw[16];
#pragma unroll
            for (int ii = 0; ii < 16; ++ii) { const int t = sb * 16 + ii; vraw[ii] = P[(row0 + (dir ? 63 - t : t)) * PW + C_BI + h * 128 + d]; }
#pragma unroll
            for (int eg = 0; eg < 8; ++eg) { u32x2 wv; wv.x = pack2(S[eg][0], S[eg][1]); wv.y = pack2(S[eg][2], S[eg][3]); *(LAS u32x2*)(SB + (eg * 16 + l16) * 136 + w * 16 + q4 * 4) = wv; }
#pragma unroll
            for (int ii = 0; ii < 16; ++ii) { const int t = sb * 16 + ii;
                const float fr = bf2f(SF[t * 128 + d]), qr = bf2f(SQ[t * 128 + d]);
                const float sg = __builtin_amdgcn_rcpf(1.0f + __expf(-fr)); const float f = lbv + (1.0f - lbv) * sg; run += __logf(f); bl[ii] = run; kv[ii] = 1.0f - f; qv[ii] = qr * __builtin_amdgcn_rcpf(1.0f + __expf(-qr)); }
            TOT[sb * 128 + d] = run;
            u32x4 v0, v1; v0.x = vraw[0] | (vraw[1] << 16); v0.y = vraw[2] | (vraw[3] << 16); v0.z = vraw[4] | (vraw[5] << 16); v0.w = vraw[6] | (vraw[7] << 16);
            v1.x = vraw[8] | (vraw[9] << 16); v1.y = vraw[10] | (vraw[11] << 16); v1.z = vraw[12] | (vraw[13] << 16); v1.w = vraw[14] | (vraw[15] << 16);
            *(LAS u32x4*)(VT + d * 72 + sb * 16) = v0; *(LAS u32x4*)(VT + d * 72 + sb * 16 + 8) = v1;
        }
        __syncthreads();
        if (ci < 35) { const int cn = ci + 1; const int gn = dir == 0 ? cn : (cn < 4 ? 3 - cn : 39 - cn); const bool cx = gn < 4; const int ck = cx ? gn : gn - 4;
            hgrn_stage(P, lds, w, lane, cx ? (size_t)NLAT + b * CTXL + ck * 64 : (size_t)b * SEQ + ck * 64, dir, h); }
        {
            const float t0 = TOT[d], t1 = TOT[128 + d], t2 = TOT[256 + d], t3 = TOT[384 + d];
            const float Bs1 = t0, Bs2 = t0 + t1, Bs3 = Bs2 + t2, total = Bs3 + t3;
            const float Bsb = sb == 0 ? 0.f : (sb == 1 ? Bs1 : (sb == 2 ? Bs2 : Bs3));
            const float eB = __expf(Bsb), eT = __expf(total);
            float kd[16];
#pragma unroll
            for (int ii = 0; ii < 16; ++ii) { const float e0 = __expf(bl[ii]); Q0[(sb * 16 + ii) * 136 + d] = (bf16_t)pack2(qv[ii] * e0 * eB, 0.f);
                const float kp = kv[ii] * __expf(fminf(-(Bsb + bl[ii]), 80.f)); KP[(sb * 16 + ii) * 136 + d] = (bf16_t)pack2(kp, 0.f); kd[ii] = kp * eT; }
            *(LAS u32x4*)(KDT + d * 72 + sb * 16) = pack8(kd); *(LAS u32x4*)(KDT + d * 72 + sb * 16 + 8) = pack8(kd + 8);
            if (sb == 0) DD[d] = eT;
        }
        __syncthreads();
        const bool need_o = !(l == 1 && isctx);
        if (need_o)
#pragma unroll
        for (int k2 = 0; k2 < 2; ++k2) { const int idx = w + 8 * k2;
            if (idx < 10) { const int i = idx < 1 ? 0 : (idx < 3 ? 1 : (idx < 6 ? 2 : 3)); const int j = idx - i * (i + 1) / 2;
                f32x4 sc = (f32x4){0.f, 0.f, 0.f, 0.f};
                const LAS bf16_t* qb = Q0 + (i * 16 + l16) * 136 + q4 * 8; const LAS bf16_t* kb = KP + (j * 16 + l16) * 136 + q4 * 8;
#pragma unroll
                for (int ks = 0; ks < 4; ++ks) sc = mfma16(*(const LAS bf16x8*)(qb + ks * 32), *(const LAS bf16x8*)(kb + ks * 32), sc);
#pragma unroll
                for (int jj = 0; jj < 4; ++jj) { const float v = (i == j && l16 > q4 * 4 + jj) ? 0.f : sc[jj]; ATT[(i * 16 + q4 * 4 + jj) * 72 + j * 16 + l16] = (bf16_t)pack2(v, 0.f); } } }
        __syncthreads();
        if (need_o) {
            bf16x8 SBf[4], VTf[2];
#pragma unroll
            for (int ks = 0; ks < 4; ++ks) SBf[ks] = *(const LAS bf16x8*)(SB + (w * 16 + l16) * 136 + ks * 32 + q4 * 8);
#pragma unroll
            for (int ks = 0; ks < 2; ++ks) VTf[ks] = *(const LAS bf16x8*)(VT + (w * 16 + l16) * 72 + ks * 32 + q4 * 8);
#pragma unroll
            for (int i = 0; i < 4; ++i) { f32x4 oa = (f32x4){0.f, 0.f, 0.f, 0.f};
#pragma unroll
                for (int ks = 0; ks < 4; ++ks) oa = mfma16(SBf[ks], *(const LAS bf16x8*)(Q0 + (i * 16 + l16) * 136 + ks * 32 + q4 * 8), oa);
#pragma unroll
                for (int ks = 0; ks < 2; ++ks) oa = mfma16(VTf[ks], *(const LAS bf16x8*)(ATT + (i * 16 + l16) * 72 + ks * 32 + q4 * 8), oa);
                const int t = i * 16 + l16; u32x2 wv; wv.x = pack2(oa[0], oa[1]); wv.y = pack2(oa[2], oa[3]);
                bf16_t* od = dry ? ((bf16_t*)(PF(ws) + WS_DUMMY) + (size_t)chain * 8192 + t * 128 + w * 16 + q4 * 4) : (P + (row0 + (dir ? 63 - t : t)) * PW + C_BF + dir * 512 + h * 128 + w * 16 + q4 * 4);
                *(u32x2*)od = wv; }
        }
        {
            const f32x4 dd = *(const LAS f32x4*)(DD + w * 16 + q4 * 4);
#pragma unroll
            for (int eg = 0; eg < 8; ++eg) S[eg] *= dd;
#pragma unroll
            for (int ks = 0; ks < 2; ++ks) { const bf16x8 A = *(const LAS bf16x8*)(KDT + (w * 16 + l16) * 72 + ks * 32 + q4 * 8);
#pragma unroll
                for (int eg = 0; eg < 8; ++eg) S[eg] = mfma16(A, *(const LAS bf16x8*)(VT + (eg * 16 + l16) * 72 + ks * 32 + q4 * 8), S[eg]); }
        }
        asm volatile("s_waitcnt vmcnt(0)" ::: "memory");
        __syncthreads();
    }
}

__global__ void __launch_bounds__(512, 2) fwd_megakernel(Params p) {
    extern __shared__ __attribute__((aligned(16))) unsigned char lds_raw[];
    LAS unsigned char* lds = (LAS unsigned char*)lds_raw;
    cg::grid_group grid = cg::this_grid();
    volatile LAS unsigned* xst = (volatile LAS unsigned*)(lds + LDS_BYTES - 16);
    if (threadIdx.x == 0) { xst[0] = 0u; xst[1] = 0u; xst[2] = 0u; xst[3] = 0u; }
    __syncthreads();
    const XcdBarrier xbar = xcd_barrier_post((unsigned*)(PF(ws) + WS_BAR), xst);
    const int G = gridDim.x, c = blockIdx.x;

    phase_mod(p, lds); __syncthreads();
    phase_rope(p);
    phase_convert(p, 0, lds);
    if (PF(ws) == nullptr) grid.sync();
    xcd_barrier(xbar);
#define WSP(T, off) ((T*)(PF(ws) + (off)))
    for (int l = 0; l < 2; ++l) {
        const bool lastl = (l == 1);
        const int Mrest = lastl ? NLAT : NTOK;
        if (l > 0) phase_convert(p, l, lds);
        phase_norm(p, l, l == 0 ? PF(x) : PF(out), l == 0 ? PF(ctx) : WSP(const float, WS_HC), PF(norm1_g) + l * DM, 0, NTOK,
                   (l > 0 && G == 256) ? (const float*)(PF(ws) + WS_P + (size_t)NTOK * DFF * 2) : nullptr, WSP(const float, WS_MOD) + (size_t)((l > 0 ? l - 1 : 0) * 9 + 8) * 6144 + 5120);
        xcd_barrier(xbar);

        { pg8::Gemm g{WSP(bf16_t, WS_U), WSP(bf16_t, WS_WIN), DM, DM, DM}; pg8::Sched S; S.init(NTOK, PW, G, c, DM, DM); pg8::EpiStore<0> E{WSP(bf16_t, WS_P), PW}; pg8::gemm_phase(lds, g, S, E); }
        xcd_barrier(xbar);
        if (c < 64) { hgrn_chain(p, l, lds, c);
            sub_barrier((unsigned*)(PF(ws) + WS_BAR) + 3776 + 16 * ((c >> 3) + 8 * l), 8u); phase_hg_final(p, l, c >> 3, c & 7); }
        else { const int cc = c - 64, GG = G - 64; const int nA = lastl ? 512 : 576;
            for (int it = cc; it < nA; it += GG) attn_item(p, l, lds, it);
            int staged = -1; const LruPtrs lp = lru_ptrs();
            for (int it = cc; it < 2304; it += GG) lru_tile(p, l, lds, it, 0, staged, lp);
            sub_barrier((unsigned*)(PF(ws) + WS_BAR) + 3520 + 64 * (2 * l + 1), (unsigned)GG);
            for (int it = cc; it < 2304; it += GG) lru_tile(p, l, lds, it, 1, staged, lp); }
        xcd_barrier(xbar);
        { pg8::Gemm g{WSP(bf16_t, WS_U), WSP(bf16_t, WS_WIN) + (size_t)PW * DM, DM, DM, DM}; pg8::Sched S; S.init(Mrest, 3072, G, c, DM, DM); pg8::EpiStore<1> E{WSP(bf16_t, WS_P), PW}; pg8::gemm_phase(lds, g, S, E); }
        xcd_barrier(xbar);
        { pg8::Gemm g{WSP(bf16_t, WS_P), WSP(bf16_t, WS_WB), PW, 512, 512}; pg8::MergeSched S; S.base.init(Mrest, DM, G, c, PW, 512);
          pg8::EpiMerge E{WSP(bf16_t, WS_P), WSP(bf16_t, WS_U)}; pg8::gemm_phase(lds, g, S, E); }
        xcd_barrier(xbar);
        { pg8::Gemm g{WSP(bf16_t, WS_U), WSP(bf16_t, WS_WO), DM, DM, DM};
          pg8::EpiResid E{l == 0 ? PF(x) : PF(out), l == 0 ? PF(ctx) : WSP(const float, WS_HC), PF(out), WSP(float, WS_HC), WSP(const float, WS_MOD) + (size_t)l * 9 * 6144 + 2048, WSP(float, WS_P)};
          if (!lastl && G == 256) { pg8::SplitSched S; S.base.init(NLAT, DM, G, c, DM, DM); S.sk = 256; pg8::gemm_phase(lds, g, S, E); }
          else { pg8::Sched S; S.init(Mrest, DM, G, c, DM, DM); pg8::gemm_phase(lds, g, S, E); } }
        xcd_barrier(xbar);
        if (!lastl && G == 256) phase_norm(p, l, PF(out), l == 0 ? PF(ctx) : WSP(const float, WS_HC), PF(norm2_g) + l * DM, 3072, Mrest, WSP(const float, WS_P), WSP(const float, WS_MOD) + (size_t)(l * 9 + 8) * 6144 + 2048, WSP(float, WS_HC));
        else phase_norm(p, l, PF(out), WSP(const float, WS_HC), PF(norm2_g) + l * DM, 3072, Mrest);
        xcd_barrier(xbar);
        { pg8::Gemm g{WSP(bf16_t, WS_U), WSP(bf16_t, WS_W1), DM, DM, DM}; pg8::Sched S; S.init(Mrest, DFF, G, c, DM, DM); pg8::EpiStore<2> E{WSP(bf16_t, WS_P), DFF}; pg8::gemm_phase(lds, g, S, E); }
        xcd_barrier(xbar);
        { pg8::Gemm g{WSP(bf16_t, WS_P), WSP(bf16_t, WS_W2), DFF, DFF, DFF};
          float* slab = (float*)(PF(ws) + WS_P + (size_t)NTOK * DFF * 2);
          pg8::EpiResid E{PF(out), WSP(const float, WS_HC), PF(out), WSP(float, WS_HC), WSP(const float, WS_MOD) + (size_t)l * 9 * 6144 + 5120, slab};
          if (!lastl && G == 256) { pg8::SplitSched S; S.base.init(NLAT, DM, G, c, DFF, DFF); S.sk = 1024; pg8::gemm_phase(lds, g, S, E); }
          else { pg8::Sched S; S.init(Mrest, DM, G, c, DFF, DFF); pg8::gemm_phase(lds, g, S, E); } }
        if (!lastl) xcd_barrier(xbar);
    }
}

extern "C" void kernel_launch(void* const* d_in, const int* in_sizes, int n_in, void* d_out, int out_size, void* d_ws, size_t ws_size, hipStream_t stream) {
    static int grid_blocks = 0;
    if (grid_blocks == 0) {
        int dev = 0, cus = 0, per_cu = 0;
        hipGetDevice(&dev);
        hipDeviceGetAttribute(&cus, hipDeviceAttributeMultiprocessorCount, dev);
        hipFuncSetAttribute((const void*)fwd_megakernel, hipFuncAttributeMaxDynamicSharedMemorySize, LDS_BYTES);
        hipOccupancyMaxActiveBlocksPerMultiprocessor(&per_cu, (const void*)fwd_megakernel, 512, LDS_BYTES);
        if (per_cu < 1 || n_in != 25 || ws_size < WS_END) { fprintf(stderr, "kernel_launch: cannot launch (per_cu %d, n_in %d, ws %zu need %zu)\n", per_cu, n_in, ws_size, (size_t)WS_END); grid_blocks = -1; }
        else grid_blocks = cus;
    }
    if (grid_blocks < 0) return;
    hipMemsetAsync((char*)d_ws + WS_BAR, 0, 16384, stream);
    Params p{};
    const float** pp = (const float**)&p;
    for (int i = 0; i < 25; ++i) pp[i] = (const float*)d_in[i];
    p.out = (float*)d_out; p.ws = (unsigned char*)d_ws;
    void* args[] = {&p};
    hipError_t e = hipLaunchCooperativeKernel((const void*)fwd_megakernel, dim3(grid_blocks), dim3(512), args, LDS_BYTES, stream);
    if (e != hipSuccess) fprintf(stderr, "cooperative launch failed: %s (grid %d)\n", hipGetErrorString(e), grid_blocks);
}
```

```cpp
#include <hip/hip_runtime.h>
#include <hip/hip_cooperative_groups.h>
#include <stdint.h>
#include <stdio.h>
namespace cg = cooperative_groups;

#define LAS __attribute__((address_space(3)))
typedef unsigned short bf16_t;
typedef short bf16x8 __attribute__((ext_vector_type(8)));
typedef float f32x4 __attribute__((ext_vector_type(4)));
typedef unsigned u32x4 __attribute__((ext_vector_type(4)));
typedef unsigned u32x2 __attribute__((ext_vector_type(2)));

constexpr int DM = 1024, NB = 8, SEQ = 2048, CTXL = 256, NLAT = NB * SEQ, NCTX = NB * CTXL, NTOK = NLAT + NCTX;
constexpr int PW = 5120, DIN = 8192, DFF = 4096;
constexpr int C_AX = 0, C_AG = 512, C_BQ = 1024, C_BF = 1536, C_BI = 2560, C_BO = 3072, C_CQ = 3584, C_CK = 4096, C_CV = 4608;
constexpr int LDS_BYTES = 163840;
constexpr size_t WS_WIN = 0;
constexpr size_t WS_WB = WS_WIN + (size_t)DIN * DM * 2;
constexpr size_t WS_WO = WS_WB + (size_t)3 * DM * 512 * 2;
constexpr size_t WS_W1 = WS_WO + (size_t)DM * DM * 2;
constexpr size_t WS_W2 = WS_W1 + (size_t)DFF * DM * 2;
constexpr size_t WS_U = WS_W2 + (size_t)DM * DFF * 2;
constexpr size_t WS_P = WS_U + (size_t)NTOK * DM * 2;
constexpr size_t WS_HC = WS_P + (size_t)NTOK * PW * 2;
constexpr size_t WS_MOD = WS_HC + (size_t)NCTX * DM * 4;
constexpr size_t WS_AGG = WS_MOD + (size_t)2 * 9 * 6144 * 4;
constexpr size_t WS_ROPE = WS_AGG + (size_t)NB * 36 * 2 * 2 * 512 * 4;
constexpr size_t WS_DUMMY = WS_ROPE + 2048 * 4;
constexpr size_t WS_BAR = WS_DUMMY + (2u << 20);
constexpr size_t WS_END = WS_BAR + 16384;

struct Params {
    const float *x, *c, *ctx, *c_ctx, *ada_w, *ada_b, *norm1_g, *norm2_g, *w_in, *conv_w, *conv_b, *lru_wa, *lru_ba, *lru_wx, *lru_bx, *lru_lambda,
        *hg_lb, *hg_norm_g, *na_qg, *na_kg, *na_rpb, *w_branch, *w_out, *ffn_w1, *ffn_w2;
    float* out; unsigned char* ws;
};


__device__ __forceinline__ unsigned long long ldkarg(int off) { unsigned long long v = 0;
#if defined(__HIP_DEVICE_COMPILE__)
    auto kp = __builtin_amdgcn_kernarg_segment_ptr();
    asm volatile("s_load_dwordx2 %0, %1, %2\n\ts_waitcnt lgkmcnt(0)" : "=s"(v) : "s"(kp), "s"(off));
#endif
    return v; }
template <class T> struct rm_ptr; template <class T> struct rm_ptr<T*> { typedef T type; };
template <class T> __device__ __forceinline__ T* as_global_ptr(unsigned long long v) { return (T*)(__attribute__((address_space(1))) T*)v; }
#define PF(f) (as_global_ptr<rm_ptr<decltype(Params::f)>::type>(ldkarg((int)__builtin_offsetof(Params, f))))

#define GAS __attribute__((address_space(1)))
template <class T> __device__ __forceinline__ GAS T* lnd(T* p) { asm volatile("" : "+v"(p)); return (GAS T*)p; }
__device__ __forceinline__ int tid_() { int t = threadIdx.x; asm volatile("" : "+v"(t)); return t; }
__device__ __forceinline__ float bf2f(unsigned v) { return __uint_as_float(v << 16); }
__device__ __forceinline__ float bflo(unsigned w) { return __uint_as_float(w << 16); }
__device__ __forceinline__ float bfhi(unsigned w) { return __uint_as_float(w & 0xffff0000u); }
__device__ __forceinline__ unsigned f2bf(float f) { unsigned u = __float_as_uint(f); u += 0x7fffu + ((u >> 16) & 1u); return u >> 16; }
typedef __bf16 bf16x2_t __attribute__((ext_vector_type(2)));
typedef float f32x2_t __attribute__((ext_vector_type(2)));
__device__ __forceinline__ unsigned pack2(float lo, float hi) { f32x2_t v = {lo, hi}; bf16x2_t b = __builtin_convertvector(v, bf16x2_t); union { bf16x2_t b; unsigned u; } t; t.b = b; return t.u; }
__device__ __forceinline__ float fexp_(float x) { return __builtin_amdgcn_exp2f(x * 1.4426950408889634f); }
__device__ __forceinline__ float flog_(float x) { return __builtin_amdgcn_logf(x) * 0.6931471805599453f; }
__device__ __forceinline__ float sigmoidf_(float x) { return __builtin_amdgcn_rcpf(1.0f + fexp_(-x)); }
__device__ __forceinline__ f32x4 mfma16(bf16x8 a, bf16x8 b, f32x4 c) { return __builtin_amdgcn_mfma_f32_16x16x32_bf16(a, b, c, 0, 0, 0); }
__device__ __forceinline__ bf16x8 as_bf16x8(u32x4 v) { union { u32x4 u; bf16x8 b; } t; t.u = v; return t.b; }
__device__ __forceinline__ void unpack8(u32x4 w, float* o) { o[0] = bflo(w.x); o[1] = bfhi(w.x); o[2] = bflo(w.y); o[3] = bfhi(w.y); o[4] = bflo(w.z); o[5] = bfhi(w.z); o[6] = bflo(w.w); o[7] = bfhi(w.w); }
__device__ __forceinline__ u32x4 pack8(const float* v) { u32x4 w; w.x = pack2(v[0], v[1]); w.y = pack2(v[2], v[3]); w.z = pack2(v[4], v[5]); w.w = pack2(v[6], v[7]); return w; }

namespace pg8 {
constexpr int BM = 256, BK = 64, HALF = 128, HTB = HALF * BK * 2, NXCD = 8, WGM = 4;
__device__ __forceinline__ int lds_byte(int r, int c) { const int st = (r >> 4) * 2 + (c >> 5), rr = r & 15, cc = c & 31, ob = rr * 64 + cc * 2; return st * 1024 + (ob ^ (((ob >> 9) & 1) << 5)); }
__device__ __forceinline__ void stage_rc(int b, int& R, int& C) { const int st = b / 1024, sb = b % 1024, swz = sb ^ (((sb >> 9) & 1) << 5); R = (st >> 1) * 16 + swz / 64; C = (st & 1) * 32 + (swz % 64) / 2; }
__device__ __forceinline__ int perm32(int rho) { const int n = rho >> 4, i = rho & 15; return 8 * (i >> 2) + 4 * n + (i & 3); }

struct Unit { int pm, pn, sub, nt; size_t aoff, boff; };
struct Gemm { const bf16_t* A; const bf16_t* Bt; int lda, ldb, K; };
struct Sched {
    int nM, nN, nwg, G, c, lda, ldb, nt;
    __device__ void init(int M, int N, int G_, int c_, int lda_, int ldb_) { nM = M / BM; nN = N / BM; nwg = nM * nN; G = G_; c = c_; lda = lda_; ldb = ldb_; nt = 0; }
    __device__ bool next(int i, Unit& u) const {
        const long L = (long)i * G + c; if (L >= nwg) return false;
        int wgid = (int)L; { const int q = nwg / NXCD, r = nwg % NXCD, xcd = wgid % NXCD, off = wgid / NXCD; wgid = (xcd < r ? xcd * (q + 1) : r * (q + 1) + (xcd - r) * q) + off; }
        const int nig = WGM * nN, gid = wgid / nig, fm = gid * WGM, gsz = (nM - fm) < WGM ? (nM - fm) : WGM;
        u.pm = fm + ((wgid % nig) % gsz); u.pn = (wgid % nig) / gsz; u.sub = 0; u.nt = nt;
        u.aoff = (size_t)u.pm * BM * lda * 2;
        u.boff = (size_t)u.pn * BM * ldb * 2;
        return true;
    }
};

template <int ACT> struct EpiStore {
    static constexpr bool PERM = true;
    bf16_t* O; int ldc;
    __device__ __forceinline__ void operator()(const f32x4 (&acc)[2][2][4][2], const Unit& u, int wr, int wc, int fr, int fq) const {
        const int row0 = u.pm * BM + wr * 64 + fr; int colt = u.pn * BM;
        if (ACT == 1) colt = (colt < 2048) ? (1024 + colt) : (2048 + colt);
        const int col0 = colt + wc * 32 + 8 * fq;
#pragma unroll
        for (int ai = 0; ai < 2; ++ai)
#pragma unroll
            for (int m = 0; m < 4; ++m) { GAS bf16_t* rowp = lnd(O + (size_t)(row0 + ai * HALF + m * 16) * ldc + col0);
#pragma unroll
                for (int bj = 0; bj < 2; ++bj) { f32x4 v0 = acc[ai][bj][m][0], v1 = acc[ai][bj][m][1];
                    if (ACT == 1) {
#pragma unroll
                        for (int j = 0; j < 4; ++j) { v0[j] = sigmoidf_(v0[j]); v1[j] = sigmoidf_(v1[j]); } }
                    if (ACT == 2) {
#pragma unroll
                        for (int j = 0; j < 4; ++j) { float a = fmaxf(v0[j], 0.f), b = fmaxf(v1[j], 0.f); v0[j] = a * a; v1[j] = b * b; } }
                    u32x4 w; w.x = pack2(v0[0], v0[1]); w.y = pack2(v0[2], v0[3]); w.z = pack2(v1[0], v1[1]); w.w = pack2(v1[2], v1[3]);
                    *(GAS u32x4*)(rowp + bj * HALF) = w; } }
    }
};
struct EpiMerge {
    static constexpr bool PERM = true;
    const bf16_t* P; bf16_t* U;
    __device__ __forceinline__ void operator()(const f32x4 (&acc)[2][2][4][2], const Unit& u, int wr, int wc, int fr, int fq) const {
        const int row0 = u.pm * BM + wr * 64 + fr; const int col0 = u.pn * BM + wc * 32 + 8 * fq;
        const int sub = u.sub; const int gcol = sub * 1024 + u.pn * BM; const int gd = ((gcol < 2048) ? (1024 + gcol) : (2048 + gcol)) + wc * 32 + 8 * fq;
        const bool addp = sub > 0;
#pragma unroll
        for (int ai = 0; ai < 2; ++ai)
#pragma unroll
            for (int m = 0; m < 4; ++m) { const size_t row = (size_t)(row0 + ai * HALF + m * 16); const GAS bf16_t* gp = lnd(P + row * PW + gd); GAS bf16_t* up = lnd(U + row * DM + col0);
#pragma unroll
                for (int bj = 0; bj < 2; ++bj) { const u32x4 gw = *(const GAS u32x4*)(gp + bj * HALF);
                    f32x4 a0 = acc[ai][bj][m][0], a1 = acc[ai][bj][m][1];
                    a0[0] *= bflo(gw.x); a0[1] *= bfhi(gw.x); a0[2] *= bflo(gw.y); a0[3] *= bfhi(gw.y); a1[0] *= bflo(gw.z); a1[1] *= bfhi(gw.z); a1[2] *= bflo(gw.w); a1[3] *= bfhi(gw.w);
                    if (addp) { const u32x4 pw = *(const GAS u32x4*)(up + bj * HALF);
                        a0[0] += bflo(pw.x); a0[1] += bfhi(pw.x); a0[2] += bflo(pw.y); a0[3] += bfhi(pw.y); a1[0] += bflo(pw.z); a1[1] += bfhi(pw.z); a1[2] += bflo(pw.w); a1[3] += bfhi(pw.w); }
                    u32x4 o; o.x = pack2(a0[0], a0[1]); o.y = pack2(a0[2], a0[3]); o.z = pack2(a1[0], a1[1]); o.w = pack2(a1[2], a1[3]);
                    *(GAS u32x4*)(up + bj * HALF) = o; } }
    }
};
struct EpiResid {
    static constexpr bool PERM = true;
    const float* inL; const float* inC; float* outL; float* outC; const float* mod;
    float* slab;
    __device__ __forceinline__ void operator()(const f32x4 (&acc)[2][2][4][2], const Unit& u, int wr, int wc, int fr, int fq) const {
        if (u.sub >= 1) {
            const int row0 = (u.pm - 64) * BM + wr * 64 + fr, col0 = u.pn * BM + wc * 32 + 8 * fq; float* sl = slab + (size_t)(u.sub - 1) * NCTX * DM;
#pragma unroll
            for (int ai = 0; ai < 2; ++ai)
#pragma unroll
                for (int m = 0; m < 4; ++m)
#pragma unroll
                    for (int bj = 0; bj < 2; ++bj) { GAS float* op = lnd(sl + (size_t)(row0 + ai * HALF + m * 16) * DM + col0 + bj * HALF); *(GAS f32x4*)op = acc[ai][bj][m][0]; *(GAS f32x4*)(op + 4) = acc[ai][bj][m][1]; }
            return;
        }
        const bool lat = u.pm < 64; const int rbase = lat ? u.pm * BM : (u.pm - 64) * BM;
        const float* in = lat ? inL : inC; float* out = lat ? outL : outC;
        const int row0 = rbase + wr * 64 + fr, col0 = u.pn * BM + wc * 32 + 8 * fq;
        const float* gt = mod + (size_t)(lat ? (u.pm >> 3) : 8) * 6144 + col0;
#pragma unroll
        for (int bj = 0; bj < 2; ++bj) { const f32x4 g0 = *(const f32x4*)(gt + bj * HALF), g1 = *(const f32x4*)(gt + bj * HALF + 4);
#pragma unroll
            for (int ai = 0; ai < 2; ++ai)
#pragma unroll
                for (int m = 0; m < 4; ++m) { const size_t ro = (size_t)(row0 + ai * HALF + m * 16) * DM + col0 + bj * HALF;
                    const GAS float* ip = lnd(in + ro); GAS float* op = lnd(out + ro); const f32x4 i0 = *(const GAS f32x4*)ip, i1 = *(const GAS f32x4*)(ip + 4);
                    *(GAS f32x4*)op = i0 + g0 * acc[ai][bj][m][0]; *(GAS f32x4*)(op + 4) = i1 + g1 * acc[ai][bj][m][1]; } }
    }
};

struct MergeSched {
    Sched base;
    __device__ bool next(int i, Unit& u) const {
        const int r = i / 3, n = i - 3 * r;
        if (!base.next(r, u)) return false;
        u.sub = n; u.aoff += (size_t)(n == 0 ? C_AG : C_BO + (n - 1) * 512) * 2; u.boff += (size_t)n * DM * 512 * 2;
        return true;
    }
};
struct SplitSched {
    Sched base;
    int sk;
    __device__ bool next(int i, Unit& u) const {
        if (base.next(i, u)) return true;
        const int nfull = (base.nwg - base.c + base.G - 1) / base.G;
        const int k = i - nfull; const int un = k * base.G + base.c; if (k < 0 || un >= 128) return false;
        const int ct = un >> 2, sl = un & 3; u.pm = 64 + (ct >> 2); u.pn = ct & 3; u.sub = 1 + sl; u.nt = sk / BK;
        u.aoff = (size_t)u.pm * BM * base.lda * 2 + (size_t)sl * sk * 2; u.boff = (size_t)u.pn * BM * base.ldb * 2 + (size_t)sl * sk * 2;
        return true;
    }
};
template <class Epi, class Sch>
__device__ __forceinline__ void gemm_phase(LAS unsigned char* lds, const Gemm g, const Sch& S, const Epi& E) {
    const int tid = tid_(), wid = __builtin_amdgcn_readfirstlane(tid >> 6), lane = tid & 63, wr = wid >> 2, wc = wid & 3, fr = lane & 15, fq = lane >> 4;
    const int K = g.K;
    unsigned voffA[2], voffB[2];
#pragma unroll
    for (int i = 0; i < 2; ++i) { int R, C; stage_rc(tid * 16 + i * 8192, R, C); const int Rb = Epi::PERM ? ((R & ~31) + perm32(R & 31)) : R;
        voffA[i] = (unsigned)(R * g.lda + C) * 2u; voffB[i] = (unsigned)(Rb * g.ldb + C) * 2u; }
    const size_t kstep = (size_t)(BK * 2);
    const size_t hstepA = (size_t)HALF * g.lda * 2, hstepB = (size_t)HALF * g.ldb * 2;
    const unsigned ldsw = (unsigned)wid * 1024u;
    const int aoff = lds_byte(wr * 64 + fr, fq * 8), boff = lds_byte(wc * 32 + fr, fq * 8);
#define PG8_SA(b, h) (((b) * 2 + (h)) * HTB)
#define PG8_SB(b, h) ((4 + (b) * 2 + (h)) * HTB)
#define PG8_STAGE(bufoff, gbase, voff) do { _Pragma("unroll") for (int _i = 0; _i < 2; ++_i) \
        __builtin_amdgcn_global_load_lds((const unsigned*)((const char*)(gbase) + (voff)[_i]), (LAS unsigned*)(lds + (bufoff) + ldsw + _i * 8192), 16, 0, 0); } while (0)
#define PG8_LDA(dst, b, h) do { _Pragma("unroll") for (int m = 0; m < 4; ++m) _Pragma("unroll") for (int k = 0; k < 2; ++k) dst[m][k] = *(const LAS bf16x8*)(lds + PG8_SA(b, h) + aoff + m * 2048 + k * 1024); } while (0)
#define PG8_LDB(dst, b, h) do { _Pragma("unroll") for (int n = 0; n < 2; ++n) _Pragma("unroll") for (int k = 0; k < 2; ++k) dst[n][k] = *(const LAS bf16x8*)(lds + PG8_SB(b, h) + boff + n * 2048 + k * 1024); } while (0)
#define PG8_MMA(ai, bj, At, Bt) do { __builtin_amdgcn_s_setprio(1); _Pragma("unroll") for (int m = 0; m < 4; ++m) _Pragma("unroll") for (int n = 0; n < 2; ++n) _Pragma("unroll") for (int k = 0; k < 2; ++k) \
        acc[ai][bj][m][n] = __builtin_amdgcn_mfma_f32_16x16x32_bf16(Bt[n][k], At[m][k], acc[ai][bj][m][n], 0, 0, 0); __builtin_amdgcn_s_setprio(0); } while (0)
#define PG8_WAIT_V(n) asm volatile("s_waitcnt vmcnt(" #n ")" ::: "memory")
#define PG8_WAIT_L(n) asm volatile("s_waitcnt lgkmcnt(" #n ")" ::: "memory")
#define PG8_BAR __builtin_amdgcn_s_barrier()
#define PG8_SCHED __builtin_amdgcn_sched_barrier(0)
    Unit cur, nxt; int ui = 0;
    if (!S.next(0, cur)) return;
    f32x4 acc[2][2][4][2];
#pragma unroll
    for (int a = 0; a < 2; ++a)
#pragma unroll
        for (int b = 0; b < 2; ++b)
#pragma unroll
            for (int m = 0; m < 4; ++m)
#pragma unroll
                for (int n = 0; n < 2; ++n) acc[a][b][m][n] = (f32x4){0.f, 0.f, 0.f, 0.f};
    bf16x8 At[4][2], B0[2][2], B1[2][2];
    const char* cA = (const char*)g.A + cur.aoff; const char* cB = (const char*)g.Bt + cur.boff;
    PG8_STAGE(PG8_SB(0, 0), cB, voffB); PG8_STAGE(PG8_SB(0, 1), cB + hstepB, voffB); PG8_STAGE(PG8_SA(0, 0), cA, voffA); PG8_STAGE(PG8_SA(0, 1), cA + hstepA, voffA);
    if (wr == 1) PG8_BAR;
    PG8_WAIT_V(2); PG8_BAR;
    PG8_STAGE(PG8_SB(1, 0), cB + kstep, voffB); PG8_STAGE(PG8_SA(1, 0), cA + kstep, voffA); PG8_STAGE(PG8_SB(1, 1), cB + hstepB + kstep, voffB);
    PG8_WAIT_V(6); PG8_BAR;
    for (;;) {
        const bool has_next = S.next(ui + 1, nxt);
        const char* nA = has_next ? (const char*)g.A + nxt.aoff : cA; const char* nB = has_next ? (const char*)g.Bt + nxt.boff : cB;
        const int nt = cur.nt ? cur.nt : K / BK;
        for (int t = 0; t < nt; t += 2) {
            const bool last = (t == nt - 2);
            const char* a1 = cA + (size_t)(t + 1) * kstep;
            const char* a2 = last ? nA : cA + (size_t)(t + 2) * kstep; const char* b2 = last ? nB : cB + (size_t)(t + 2) * kstep;
            const char* a3 = a2 + kstep; const char* b3 = b2 + kstep;
            PG8_LDB(B0, 0, 0); PG8_LDB(B1, 0, 1); PG8_SCHED; PG8_LDA(At, 0, 0); PG8_STAGE(PG8_SA(1, 1), a1 + hstepA, voffA);
            PG8_WAIT_V(8); PG8_WAIT_L(0); PG8_BAR; PG8_MMA(0, 0, At, B0); PG8_MMA(0, 1, At, B1); PG8_BAR; PG8_SCHED;
            PG8_LDA(At, 0, 1); PG8_STAGE(PG8_SB(0, 0), b2, voffB); PG8_STAGE(PG8_SB(0, 1), b2 + hstepB, voffB); PG8_STAGE(PG8_SA(0, 0), a2, voffA);
            PG8_WAIT_V(8); PG8_WAIT_L(0); PG8_BAR; PG8_MMA(1, 0, At, B0); PG8_MMA(1, 1, At, B1); PG8_BAR; PG8_SCHED;
            PG8_LDB(B0, 1, 0); PG8_LDB(B1, 1, 1); PG8_SCHED; PG8_LDA(At, 1, 0); PG8_STAGE(PG8_SA(0, 1), a2 + hstepA, voffA);
            PG8_WAIT_V(8); PG8_WAIT_L(0); PG8_BAR; PG8_MMA(0, 0, At, B0); PG8_MMA(0, 1, At, B1); PG8_BAR; PG8_SCHED;
            PG8_LDA(At, 1, 1); PG8_STAGE(PG8_SB(1, 0), b3, voffB); PG8_STAGE(PG8_SB(1, 1), b3 + hstepB, voffB); PG8_STAGE(PG8_SA(1, 0), a3, voffA);
            PG8_WAIT_V(8); PG8_WAIT_L(0); PG8_BAR; PG8_MMA(1, 0, At, B0); PG8_MMA(1, 1, At, B1); PG8_BAR; PG8_SCHED;
        }
        if (wr == 0) PG8_BAR;
        E(acc, cur, wr, wc, fr, fq);
        if (!has_next) break;
#pragma unroll
        for (int a = 0; a < 2; ++a)
#pragma unroll
            for (int b = 0; b < 2; ++b)
#pragma unroll
                for (int m = 0; m < 4; ++m)
#pragma unroll
                    for (int n = 0; n < 2; ++n) acc[a][b][m][n] = (f32x4){0.f, 0.f, 0.f, 0.f};
        cur = nxt; cA = nA; cB = nB; ++ui;
        if (wr == 1) PG8_BAR;
    }
    PG8_WAIT_V(0);
    PG8_BAR;
#undef PG8_SA
#undef PG8_SB
#undef PG8_STAGE
#undef PG8_LDA
#undef PG8_LDB
#undef PG8_MMA
#undef PG8_WAIT_V
#undef PG8_WAIT_L
#undef PG8_BAR
#undef PG8_SCHED
}
}


#define XB_TMO      128
#define XB_XCNT(j)  (256  + 64 * (j))
#define XB_XSUB(j)  (1280 + 64 * (j))
#define XB_XGEN(j)  (2304 + 64 * (j))
#define XB_TOP      3328
#define XB_TOPGEN   3392
#define XCD_BAR_WORDS 3456
#define XB_SPIN_CAP (1u << 20)
__device__ __forceinline__ unsigned xb_ld(unsigned* p)              { return __hip_atomic_load(p, __ATOMIC_RELAXED, __HIP_MEMORY_SCOPE_AGENT); }
__device__ __forceinline__ unsigned xb_add(unsigned* p, unsigned v) { return __hip_atomic_fetch_add(p, v, __ATOMIC_RELAXED, __HIP_MEMORY_SCOPE_AGENT); }
__device__ __forceinline__ unsigned xb_xcc_id() { return (unsigned)__builtin_amdgcn_s_getreg((3 << 11) | 20) & 0xFu; }
#define XB_SPIN(cond, bar) do { unsigned _sp = 0; while (cond) { __builtin_amdgcn_s_sleep(0); \
    if ((++_sp & 255u) == 0u) { if (xb_ld(&(bar)[XB_TMO])) break; if (_sp > XB_SPIN_CAP) { atomicAdd(&(bar)[XB_TMO], 1u); break; } } } } while (0)
struct XcdBarrier { unsigned* bar; unsigned x; volatile LAS unsigned* st; };
__device__ __forceinline__ XcdBarrier xcd_barrier_post(unsigned* bar, volatile LAS unsigned* st) {
    XcdBarrier b; b.bar = bar; b.x = xb_xcc_id(); b.st = st;
    if (threadIdx.x == 0) (void)xb_add(&bar[XB_XCNT(b.x)], 1u);
    return b;
}
__device__ __forceinline__ void xcd_barrier_complete(unsigned* bar, unsigned x, unsigned& nloc, unsigned& nx) {
    const unsigned G = gridDim.x * gridDim.y * gridDim.z;
    unsigned sum, cnt, mine, sp = 0u;
    for (;;) {
        sum = 0u; cnt = 0u; mine = 0u;
#pragma unroll
        for (unsigned j = 0; j < 16; ++j) { const unsigned c = xb_ld(&bar[XB_XCNT(j)]); sum += c; cnt += (c > 0u) ? 1u : 0u; mine = (j == x) ? c : mine; }
        if (sum == G) break;
        __builtin_amdgcn_s_sleep(1);
        if ((++sp & 255u) == 0u) { if (xb_ld(&bar[XB_TMO])) break; if (sp > XB_SPIN_CAP) { atomicAdd(&bar[XB_TMO], 1u); break; } }
    }
    nloc = mine > 0u ? mine : 1u; nx = cnt > 0u ? cnt : 1u;
}
__device__ __forceinline__ void xcd_barrier(const XcdBarrier& b) {
    asm volatile("s_waitcnt vmcnt(0)" ::: "memory");
    __syncthreads();
    if (threadIdx.x == 0) {
        unsigned* bar = b.bar;
        __builtin_amdgcn_s_waitcnt(0);
        unsigned nloc = b.st[0], nx = b.st[1];
        if (nloc == 0u) { xcd_barrier_complete(bar, b.x, nloc, nx); b.st[0] = nloc; b.st[1] = nx; }
        const unsigned old = xb_add(&bar[XB_XSUB(b.x)], 1u);
        const unsigned gen = old / nloc;
        if (old + 1u == (gen + 1u) * nloc) {
            __builtin_amdgcn_fence(__ATOMIC_RELEASE, "agent");
            asm volatile("s_waitcnt vmcnt(0)" ::: "memory");
            const unsigned og = xb_add(&bar[XB_TOP], 1u);
            const unsigned tg = og / nx;
            if (og + 1u == (tg + 1u) * nx) xb_add(&bar[XB_TOPGEN], 1u);
            else XB_SPIN(xb_ld(&bar[XB_TOPGEN]) == tg, bar);
            __builtin_amdgcn_fence(__ATOMIC_ACQUIRE, "agent");
            xb_add(&bar[XB_XGEN(b.x)], 1u);
            asm volatile("s_waitcnt vmcnt(0)" ::: "memory");
        } else {
            XB_SPIN(xb_ld(&bar[XB_XGEN(b.x)]) == gen, bar);
            __builtin_amdgcn_fence(__ATOMIC_ACQUIRE, "agent");
            asm volatile("s_waitcnt vmcnt(0)" ::: "memory");
        }
    }
    __syncthreads();
}

__device__ __forceinline__ void sub_barrier(unsigned* word, unsigned n) {
    asm volatile("s_waitcnt vmcnt(0)" ::: "memory");
    __syncthreads();
    if (threadIdx.x == 0) {
        __builtin_amdgcn_fence(__ATOMIC_RELEASE, "agent");
        asm volatile("s_waitcnt vmcnt(0)" ::: "memory");
        xb_add(word, 1u);
        unsigned sp = 0;
        while (xb_ld(word) < n) { __builtin_amdgcn_s_sleep(0); if (++sp > (1u << 22)) break; }
        __builtin_amdgcn_fence(__ATOMIC_ACQUIRE, "agent");
        asm volatile("s_waitcnt vmcnt(0)" ::: "memory");
    }
    __syncthreads();
}

__device__ __forceinline__ void phase_mod(const Params& p, LAS unsigned char* lds) {
    LAS float* sc = (LAS float*)lds;
    LAS float* part = sc + 9 * 1024;
    float* mod = (float*)(PF(ws) + WS_MOD);
    const int tid = tid_(), w = tid >> 6, lane = tid & 63;
    if ((int)blockIdx.x >= 192) return;
    const float* pc = PF(c); const float* pcc = PF(c_ctx); const float* padaw = PF(ada_w); const float* padab = PF(ada_b);
    for (int i = tid; i < 9 * 1024; i += 512) { const int r = i >> 10, k = i & 1023; const float v = (r < 8) ? pc[r * 1024 + k] : pcc[k]; sc[i] = v / (1.0f + expf(-v)); }
    __syncthreads();
    for (int item = blockIdx.x; item < 192; item += gridDim.x) {
        const int l = item / 96, cb = item % 96;
        const float* W = padaw + (size_t)l * 1024 * 6144 + cb * 64 + lane;
        float acc[9];
#pragma unroll
        for (int r = 0; r < 9; ++r) acc[r] = 0.f;
        for (int k = w * 128; k < w * 128 + 128; ++k) { const float wv = W[(size_t)k * 6144];
#pragma unroll
            for (int r = 0; r < 9; ++r) acc[r] += sc[r * 1024 + k] * wv; }
#pragma unroll
        for (int r = 0; r < 9; ++r) part[(w * 9 + r) * 64 + lane] = acc[r];
        __syncthreads();
        for (int i = tid; i < 576; i += 512) { const int r = i >> 6, ln = i & 63; float s = 0.f;
#pragma unroll
            for (int ww = 0; ww < 8; ++ww) s += part[(ww * 9 + r) * 64 + ln];
            mod[(size_t)(l * 9 + r) * 6144 + cb * 64 + ln] = s + padab[l * 6144 + cb * 64 + ln]; }
        __syncthreads();
    }
}
__device__ __forceinline__ void phase_rope(const Params& p) {
    if (blockIdx.x != gridDim.x - 1) return;
    float* rope = (float*)(PF(ws) + WS_ROPE);
    for (int i = tid_(); i < 1024; i += 512) { const int pos = i >> 4, fi = i & 15; const float invf = powf(10000.0f, -(float)fi / 16.0f); const float ang = (float)pos * invf; rope[i] = cosf(ang); rope[1024 + i] = sinf(ang); }
}
__device__ __forceinline__ void convert_tile(const float* src, int K, int N, bf16_t* dst, int tile, LAS bf16_t* T) {
    const int tid = tid_(), tilesN = N >> 7, tk = tile / tilesN, tn = tile - tk * tilesN, k0 = tk * 128, n0 = tn * 128;
    const int r = tid >> 4, c8 = (tid & 15) * 8;
    f32x4 a[4], b[4];
#pragma unroll
    for (int i = 0; i < 4; ++i) { const float* s = src + (size_t)(k0 + r + 32 * i) * N + n0 + c8; a[i] = *(const f32x4*)s; b[i] = *(const f32x4*)(s + 4); }
#pragma unroll
    for (int i = 0; i < 4; ++i)
#pragma unroll
        for (int j = 0; j < 4; ++j) { T[(c8 + j) * 136 + r + 32 * i] = (bf16_t)f2bf(a[i][j]); T[(c8 + 4 + j) * 136 + r + 32 * i] = (bf16_t)f2bf(b[i][j]); }
    __syncthreads();
    const int n = tid >> 2, ks = (tid & 3) * 8;
#pragma unroll
    for (int i = 0; i < 4; ++i) { const u32x4 v = *(const LAS u32x4*)(T + n * 136 + ks + 32 * i); *(u32x4*)(dst + (size_t)(n0 + n) * K + k0 + ks + 32 * i) = v; }
    __syncthreads();
}
__device__ __forceinline__ void phase_convert(const Params& p, int l, LAS unsigned char* lds) {
    LAS bf16_t* T = (LAS bf16_t*)lds;
    bf16_t* WIN = (bf16_t*)(PF(ws) + WS_WIN); bf16_t* WB = (bf16_t*)(PF(ws) + WS_WB); bf16_t* WO = (bf16_t*)(PF(ws) + WS_WO); bf16_t* W1 = (bf16_t*)(PF(ws) + WS_W1); bf16_t* W2 = (bf16_t*)(PF(ws) + WS_W2);
    for (int it = blockIdx.x; it < 1184; it += gridDim.x) {
        if (it < 512) convert_tile(PF(w_in) + (size_t)l * DM * DIN, DM, DIN, WIN, it, T);
        else if (it < 608) { const int n = (it - 512) / 32, tl = (it - 512) % 32; convert_tile(PF(w_branch) + (size_t)(l * 3 + n) * 512 * DM, 512, DM, WB + (size_t)n * DM * 512, tl, T); }
        else if (it < 672) convert_tile(PF(w_out) + (size_t)l * DM * DM, DM, DM, WO, it - 608, T);
        else if (it < 928) convert_tile(PF(ffn_w1) + (size_t)l * DM * DFF, DM, DFF, W1, it - 672, T);
        else convert_tile(PF(ffn_w2) + (size_t)l * DFF * DM, DFF, DM, W2, it - 928, T);
    }
}
__device__ __forceinline__ void phase_norm(const Params& p, int l, const float* hlat, const float* hctx, const float* g, int modoff, int nrows, const float* slab = nullptr, const float* slabgate = nullptr, float* hwrite = nullptr) {
    const int tid = tid_(); const int w = tid >> 6, lane = tid & 63;
    bf16_t* U = (bf16_t*)(PF(ws) + WS_U); const float* mod = (const float*)(PF(ws) + WS_MOD);
    for (int row = blockIdx.x * 8 + w; row < nrows; row += gridDim.x * 8) {
        const float* src = row < NLAT ? hlat + (size_t)row * DM : hctx + (size_t)(row - NLAT) * DM;
        const int mr = row < NLAT ? (row >> 11) : 8;
        const float* md = mod + (size_t)(l * 9 + mr) * 6144 + modoff;
        f32x4 v[4]; float ss = 0.f;
#pragma unroll
        for (int i = 0; i < 4; ++i) { v[i] = *(const f32x4*)(src + i * 256 + lane * 4);
            if (slab != nullptr && row >= NLAT) { const size_t o = (size_t)(row - NLAT) * DM + i * 256 + lane * 4; const f32x4 gg = *(const f32x4*)(slabgate + i * 256 + lane * 4);
                const f32x4 s4 = (*(const f32x4*)(slab + o) + *(const f32x4*)(slab + o + (size_t)NCTX * DM)) + (*(const f32x4*)(slab + o + (size_t)2 * NCTX * DM) + *(const f32x4*)(slab + o + (size_t)3 * NCTX * DM));
                v[i] += gg * s4; if (hwrite != nullptr) *(f32x4*)(hwrite + o) = v[i]; }
            ss += v[i][0] * v[i][0] + v[i][1] * v[i][1] + v[i][2] * v[i][2] + v[i][3] * v[i][3]; }
#pragma unroll
        for (int o = 32; o >= 1; o >>= 1) ss += __shfl_xor(ss, o);
        const float rstd = rsqrtf(ss * (1.0f / 1024.0f) + 1e-6f);
#pragma unroll
        for (int i = 0; i < 4; ++i) { const int cidx = i * 256 + lane * 4; const f32x4 gg = *(const f32x4*)(g + cidx), sh = *(const f32x4*)(md + cidx), scv = *(const f32x4*)(md + 1024 + cidx);
            float o4[4];
#pragma unroll
            for (int j = 0; j < 4; ++j) o4[j] = (v[i][j] * rstd * gg[j]) * (1.0f + scv[j]) + sh[j];
            u32x2 wv; wv.x = pack2(o4[0], o4[1]); wv.y = pack2(o4[2], o4[3]);
            *(u32x2*)(U + (size_t)row * DM + cidx) = wv; }
    }
}
__device__ __forceinline__ void phase_hg_final(const Params& p, int l, int b, int wgi) {
    const int tid = tid_(); const int w = tid >> 6, lane = tid & 63; bf16_t* P = (bf16_t*)(PF(ws) + WS_P);
    const int hd = lane >> 4, e8 = (lane & 15) * 8; const float* png = PF(hg_norm_g);
    float ng[8];
#pragma unroll
    for (int i = 0; i < 8; ++i) ng[i] = png[l * 128 + e8 + i];
    for (int i0 = wgi * 8 + w; i0 < 2304; i0 += 3 * 64) {
        u32x4 ra[3], rb[3], ro[3]; bf16_t* rp[3];
#pragma unroll
        for (int k = 0; k < 3; ++k) { const int i = i0 + 64 * k; const int ic = i < 2304 ? i : i0; const size_t row = ic < 2048 ? (size_t)b * SEQ + ic : (size_t)NLAT + b * CTXL + (ic - 2048);
            rp[k] = P + row * PW; ra[k] = *(const u32x4*)(rp[k] + C_BF + hd * 128 + e8); rb[k] = *(const u32x4*)(rp[k] + C_BF + 512 + hd * 128 + e8); ro[k] = *(const u32x4*)(rp[k] + C_BO + hd * 128 + e8); }
#pragma unroll
        for (int k = 0; k < 3; ++k) {
            float a[8], bb[8], og[8]; unpack8(ra[k], a); unpack8(rb[k], bb); unpack8(ro[k], og);
            float ss = 0.f;
#pragma unroll
            for (int i = 0; i < 8; ++i) { a[i] += bb[i]; ss += a[i] * a[i]; }
            ss += __shfl_xor(ss, 1); ss += __shfl_xor(ss, 2); ss += __shfl_xor(ss, 4); ss += __shfl_xor(ss, 8);
            const float rstd = rsqrtf(ss * (1.0f / 128.0f) + 1e-6f);
            float y[8];
#pragma unroll
            for (int i = 0; i < 8; ++i) y[i] = a[i] * rstd * ng[i] * sigmoidf_(og[i]);
            if (i0 + 64 * k < 2304) *(u32x4*)(rp[k] + C_BO + hd * 128 + e8) = pack8(y);
        }
    }
}

__device__ __forceinline__ size_t agg_idx(int b, int gch, int dir, int which, int ch) { return ((((size_t)b * 36 + gch) * 2 + dir) * 2 + which) * 512 + ch; }
__device__ __forceinline__ float gelu_tanh(float x) { const float u = 0.7978845608028654f * (x + 0.044715f * x * x * x); const float th = 1.0f - 2.0f * __builtin_amdgcn_rcpf(1.0f + fexp_(2.0f * u)); return 0.5f * x * (1.0f + th); }
struct LruPtrs { bf16_t* P; float* AGG; const float *cb, *cw, *ba, *bx, *lam; };
__device__ __forceinline__ LruPtrs lru_ptrs() { LruPtrs q; q.P = (bf16_t*)(PF(ws) + WS_P); q.AGG = (float*)(PF(ws) + WS_AGG); q.cb = PF(conv_b); q.cw = PF(conv_w); q.ba = PF(lru_ba); q.bx = PF(lru_bx); q.lam = PF(lru_lambda); return q; }
__device__ __forceinline__ void lru_tile(const Params& p, int l, LAS unsigned char* lds, int item, int mode, int& staged_nb, const LruPtrs& lp) {
    LAS bf16_t* Wl = (LAS bf16_t*)lds;
    LAS bf16_t* Xb = Wl + 256 * 72;
    LAS float* Xf = (LAS float*)(lds + 46080);
    LAS float* Av = Xf + 4096;
    LAS float* Bv = Av + 8192;
    bf16_t* P = lp.P; float* AGG = lp.AGG;
    const int tid = tid_(), w = tid >> 6, lane = tid & 63, l16 = lane & 15, q4 = lane >> 4;
    const int nb = item & 7, rest = item >> 3, gch = rest % 36, b = rest / 36;
    const bool isctx = gch < 4; const int chunk = isctx ? gch : gch - 4, L = isctx ? CTXL : SEQ;
    const size_t seqrow0 = isctx ? (size_t)NLAT + b * CTXL : (size_t)b * SEQ; const int t0 = chunk * 64;
    if (staged_nb != nb) { const float* pwx = PF(lru_wx); const float* pwa = PF(lru_wa);
        for (int e = tid; e < 4 * 64 * 64; e += 512) { const int mat = e >> 12, i = (e >> 6) & 63, c = e & 63; const int dir = mat >> 1, kind = mat & 1;
            const float* W = kind ? pwx : pwa; const float v = W[((size_t)((l * 2 + dir) * 8 + nb) * 64 + i) * 64 + c];
            const int op = dir * 128 + (c >> 4) * 32 + kind * 16 + (c & 15);
            Wl[op * 72 + i] = (bf16_t)f2bf(v); }
        staged_nb = nb;
    }
    {
        const int t = tid >> 3, c8 = (tid & 7) * 8, ch = nb * 64 + c8, tt = t0 + t;
        float a8[8]; const float* pcb = lp.cb; const float* pcw = lp.cw;
        { const f32x4 b0 = *(const f32x4*)(pcb + l * 512 + ch), b1 = *(const f32x4*)(pcb + l * 512 + ch + 4);
#pragma unroll
          for (int i = 0; i < 4; ++i) { a8[i] = b0[i]; a8[4 + i] = b1[i]; } }
#pragma unroll
        for (int j = 0; j < 4; ++j) { const int ts = tt + j - 2;
            if (ts >= 0 && ts < L) { float xv[8]; unpack8(*(const u32x4*)(P + (seqrow0 + ts) * PW + C_AX + ch), xv);
                const f32x4 w0 = *(const f32x4*)(pcw + (l * 4 + j) * 512 + ch), w1 = *(const f32x4*)(pcw + (l * 4 + j) * 512 + ch + 4);
#pragma unroll
                for (int i = 0; i < 4; ++i) { a8[i] += xv[i] * w0[i]; a8[4 + i] += xv[4 + i] * w1[i]; } } }
#pragma unroll
        for (int i = 0; i < 8; ++i) Xf[t * 64 + c8 + i] = a8[i];
        *(LAS u32x4*)(Xb + t * 72 + c8) = pack8(a8);
    }
    __syncthreads();
    {
        const int dir = w >> 2, c = (w & 3) * 16 + l16, ch = nb * 64 + c;
        f32x4 acc[4][2];
#pragma unroll
        for (int mg = 0; mg < 4; ++mg) { acc[mg][0] = (f32x4){0.f, 0.f, 0.f, 0.f}; acc[mg][1] = (f32x4){0.f, 0.f, 0.f, 0.f}; }
#pragma unroll
        for (int ks = 0; ks < 2; ++ks) {
            const bf16x8 B0 = *(const LAS bf16x8*)(Wl + (w * 32 + l16) * 72 + ks * 32 + q4 * 8), B1 = *(const LAS bf16x8*)(Wl + (w * 32 + 16 + l16) * 72 + ks * 32 + q4 * 8);
#pragma unroll
            for (int mg = 0; mg < 4; ++mg) { const bf16x8 A = *(const LAS bf16x8*)(Xb + (mg * 16 + l16) * 72 + ks * 32 + q4 * 8);
                acc[mg][0] = mfma16(A, B0, acc[mg][0]); acc[mg][1] = mfma16(A, B1, acc[mg][1]); }
        }
        const float ba = lp.ba[(l * 2 + dir) * 512 + ch], bx = lp.bx[(l * 2 + dir) * 512 + ch], lam = lp.lam[(l * 2 + dir) * 512 + ch];
        const float sp = log1pf(expf(-lam));
#pragma unroll
        for (int mg = 0; mg < 4; ++mg)
#pragma unroll
            for (int j = 0; j < 4; ++j) { const int t = mg * 16 + q4 * 4 + j;
                const float ea = 1.0f + fexp_(-(acc[mg][0][j] + ba)), ex = 1.0f + fexp_(-(acc[mg][1][j] + bx)); const float inv = __builtin_amdgcn_rcpf(ea * ex);
                const float r = inv * ex, ig = inv * ea;
                const float la = -8.0f * r * sp; const float a = fexp_(la); const float x2 = 2.0f * la;
                float om = -x2 * (1.0f + x2 * (0.5f + x2 * (0.16666667f + x2 * (0.041666668f + x2 * 0.0083333338f))));
                if (x2 < -0.35f) om = 1.0f - a * a;
                const float bb = sqrtf(fmaxf(om, 0.f)) * ig * Xf[t * 64 + c];
                Av[(dir * 64 + t) * 64 + c] = a; Bv[(dir * 64 + t) * 64 + c] = bb; }
    }
    __syncthreads();
    {
        LAS float* SegA = Xf;
        LAS float* SegB = Xf + 512;
        const int d2 = tid >> 8, seg = (tid >> 6) & 3, c = tid & 63, ch = nb * 64 + c;
        float av[16], bv[16];
#pragma unroll
        for (int k = 0; k < 16; ++k) { const int s = seg * 16 + k; const int t = d2 ? 63 - s : s; const int ix = (d2 * 64 + t) * 64 + c; av[k] = Av[ix]; bv[k] = Bv[ix]; }
        float h = 0.f, ap = 1.f;
#pragma unroll
        for (int k = 0; k < 16; ++k) { h = av[k] * h + bv[k]; ap *= av[k]; }
        SegA[(d2 * 4 + seg) * 64 + c] = ap; SegB[(d2 * 4 + seg) * 64 + c] = h;
        float hin = 0.f;
        if (mode == 1) {
            const int mypos = d2 == 0 ? gch : (gch < 4 ? 3 - gch : 39 - gch);
            for (int p0 = 0; p0 < mypos; p0 += 6) { float Aa[6], Bb[6];
#pragma unroll
                for (int j = 0; j < 6; ++j) { const int pp = p0 + j; const int g = d2 == 0 ? pp : (pp < 4 ? 3 - pp : 39 - pp); const bool ok = pp < mypos;
                    Aa[j] = ok ? AGG[agg_idx(b, ok ? g : 0, d2, 0, ch)] : 1.0f; Bb[j] = ok ? AGG[agg_idx(b, ok ? g : 0, d2, 1, ch)] : 0.0f; }
#pragma unroll
                for (int j = 0; j < 6; ++j) hin = Aa[j] * hin + Bb[j]; }
        }
        __syncthreads();
        if (mode == 0) {
            if (seg == 3) { float A = 1.f, B = 0.f;
#pragma unroll
                for (int s2 = 0; s2 < 4; ++s2) { const float sa = SegA[(d2 * 4 + s2) * 64 + c], sb2 = SegB[(d2 * 4 + s2) * 64 + c]; B = sa * B + sb2; A *= sa; }
                AGG[agg_idx(b, gch, d2, 0, ch)] = A; AGG[agg_idx(b, gch, d2, 1, ch)] = B; }
        } else {
#pragma unroll
            for (int s2 = 0; s2 < 3; ++s2) if (s2 < seg) hin = SegA[(d2 * 4 + s2) * 64 + c] * hin + SegB[(d2 * 4 + s2) * 64 + c];
            float hh2 = hin;
#pragma unroll
            for (int k = 0; k < 16; ++k) { const int s = seg * 16 + k; const int t = d2 ? 63 - s : s; hh2 = av[k] * hh2 + bv[k]; Bv[(d2 * 64 + t) * 64 + c] = hh2; }
        }
    }
    __syncthreads();
    if (mode == 1) {
        const int t = tid >> 3, c8 = (tid & 7) * 8; bf16_t* gp = P + (seqrow0 + t0 + t) * PW + C_AG + nb * 64 + c8;
        float gt[8]; unpack8(*(const u32x4*)gp, gt); float y[8];
#pragma unroll
        for (int i = 0; i < 8; ++i) y[i] = (Bv[t * 64 + c8 + i] + Bv[(64 + t) * 64 + c8 + i]) * gelu_tanh(gt[i]);
        *(u32x4*)gp = pack8(y);
        __syncthreads();
    }
}

template <bool B> struct BoolC { static constexpr bool value = B; };
__device__ __forceinline__ void attn_item(const Params& p, int l, LAS unsigned char* lds, int item, int dry = 0) {
    LAS bf16_t* Kt = (LAS bf16_t*)lds;
    LAS float* rpbL = (LAS float*)(lds + 73728);
    LAS float* cosT = rpbL + 960;
    LAS float* sinT = cosT + 1024;
    LAS float* gq = sinT + 1024; LAS float* gk = gq + 64;
    bf16_t* P = (bf16_t*)(PF(ws) + WS_P); const float* rope = (const float*)(PF(ws) + WS_ROPE);
    const int tid = tid_(), w = __builtin_amdgcn_readfirstlane(tid >> 6), lane = tid & 63, l16 = lane & 15, q4 = lane >> 4, hh = w >> 2, qg4 = w & 3;
    const bool isctx = item >= 512;
    int b, hp, nloc, krU; int rq[2], kq0[2]; size_t qrow0[2];
    if (!isctx) { hp = item & 3; const int rp = (item >> 2) & 15; b = item >> 6;
        rq[0] = 2 * rp; rq[1] = 2 * rp + 1; kq0[0] = min(max(rq[0] - 4, 0), 24); kq0[1] = min(max(rq[1] - 4, 0), 24);
        qrow0[0] = (size_t)b * SEQ + rq[0] * 64; qrow0[1] = qrow0[0] + 64; krU = kq0[0]; nloc = kq0[1] + 8 - kq0[0]; }
    else { const int it = item - 512; hp = it & 3; const int qt = (it >> 2) & 1; b = it >> 3; rq[0] = rq[1] = 0; kq0[0] = kq0[1] = 0; krU = 0; nloc = 0;
        qrow0[0] = (size_t)NLAT + b * CTXL + qt * 128; qrow0[1] = qrow0[0] + 64; }
    const int h = hp * 2 + hh;
    const float* prpb = PF(na_rpb);
    for (int i = tid; i < 2 * 465; i += 512) { const int h2 = i / 465, j = i - h2 * 465; rpbL[h2 * 480 + j] = prpb[(size_t)((l * 8 + hp * 2 + h2) * 465) + j]; }
    for (int i = tid; i < 1024; i += 512) { cosT[i] = rope[i]; sinT[i] = rope[1024 + i]; }
    if (tid < 64) { gq[tid] = PF(na_qg)[l * 64 + tid]; gk[tid] = PF(na_kg)[l * 64 + tid]; }
    __syncthreads();
    const int qc = qg4 * 16 + l16;
    const int glo = qg4 < 2 ? 0 : qg4 - 1, ghi = qg4 == 0 ? 1 : (qg4 == 3 ? 3 : qg4 + 1);
    unsigned mbits = 0u; const int bbase = q4 * 4 - qc;
    { const int cs0 = min(max(qc - 8, 0), 48);
#pragma unroll
      for (int g = 0; g < 4; ++g)
#pragma unroll
          for (int j = 0; j < 4; ++j) { const int kc = g * 16 + q4 * 4 + j; if (kc < cs0 || kc >= cs0 + 16) mbits |= 1u << (g * 4 + j); } }
    bf16x8 qpl[2][2], qrt[2][2];
#pragma unroll
    for (int qi = 0; qi < 2; ++qi) {
        const bf16_t* qp = P + (qrow0[qi] + qc) * PW + C_CQ + h * 64;
        float xq[16]; unpack8(*(const u32x4*)(qp + q4 * 8), xq); unpack8(*(const u32x4*)(qp + 32 + q4 * 8), xq + 8);
        float ss = 0.f;
#pragma unroll
        for (int i = 0; i < 16; ++i) ss += xq[i] * xq[i];
        ss += __shfl_xor(ss, 16); ss += __shfl_xor(ss, 32);
        const float rs = rsqrtf(ss * (1.0f / 64.0f) + 1e-6f) * 0.125f;
#pragma unroll
        for (int i = 0; i < 8; ++i) { xq[i] *= rs * gq[q4 * 8 + i]; xq[8 + i] *= rs * gq[32 + q4 * 8 + i]; }
        qpl[qi][0] = as_bf16x8(pack8(xq)); qpl[qi][1] = as_bf16x8(pack8(xq + 8));
        float xr[16];
#pragma unroll
        for (int ks = 0; ks < 2; ++ks) { const int pos = ks == 0 ? rq[qi] : qc;
#pragma unroll
            for (int jj = 0; jj < 8; ++jj) { const int fi = (q4 & 1) * 8 + jj; const float cs = cosT[pos * 16 + fi], sn = sinT[pos * 16 + fi]; const float xv = xq[ks * 8 + jj]; const float pr = __shfl_xor(xv, 32);
                xr[ks * 8 + jj] = (q4 < 2) ? (xv * cs - pr * sn) : (xv * cs + pr * sn); } }
        qrt[qi][0] = as_bf16x8(pack8(xr)); qrt[qi][1] = as_bf16x8(pack8(xr + 8));
    }
    f32x4 O[2][4];
#pragma unroll
    for (int qi = 0; qi < 2; ++qi)
#pragma unroll
        for (int i = 0; i < 4; ++i) O[qi][i] = (f32x4){0.f, 0.f, 0.f, 0.f};
    float mrun[2] = {-1e30f, -1e30f}, lsum[2] = {0.f, 0.f};
    const int pf_hh2 = tid >> 8, pf_h2 = hp * 2 + pf_hh2, pf_key = (tid & 255) >> 2, pf_seg = tid & 3, pf_vseg = (tid & 255) >> 6, pf_vkey = tid & 63;
    u32x4 pk0, pk1, pv0, pv1;
    { const size_t r0 = nloc ? (size_t)b * SEQ + krU * 64 : (size_t)NLAT + b * CTXL;
      const bf16_t* kp = P + (r0 + pf_key) * PW + C_CK + pf_h2 * 64 + pf_seg * 16; pk0 = *(const u32x4*)kp; pk1 = *(const u32x4*)(kp + 8);
      const bf16_t* vp = P + (r0 + pf_vkey) * PW + C_CV + pf_h2 * 64 + pf_vseg * 16; pv0 = *(const u32x4*)vp; pv1 = *(const u32x4*)(vp + 8); }
    const int ntot = nloc + 4;
    auto stage = [&](int T, int buf) {
        const bool sloc = T < nloc; const int kr = krU + T;
        LAS bf16_t* KtB = Kt + buf * (4 * 64 * 72); LAS bf16_t* VtB = KtB + 2 * 64 * 72;
        {
            const int hh2 = pf_hh2, key = pf_key, seg = pf_seg;
            float xk[16]; unpack8(pk0, xk); unpack8(pk1, xk + 8);
            float ss = 0.f;
#pragma unroll
            for (int i = 0; i < 16; ++i) ss += xk[i] * xk[i];
            ss += __shfl_xor(ss, 1); ss += __shfl_xor(ss, 2);
            const float rs = rsqrtf(ss * (1.0f / 64.0f) + 1e-6f);
#pragma unroll
            for (int i = 0; i < 16; ++i) xk[i] *= rs * gk[seg * 16 + i];
            if (sloc) { const int pos = seg < 2 ? kr : key;
#pragma unroll
                for (int i = 0; i < 16; ++i) { const float pr = __shfl_xor(xk[i], 1); const float cs = cosT[pos * 16 + i], sn = sinT[pos * 16 + i]; xk[i] = (seg & 1) ? (xk[i] * cs + pr * sn) : (xk[i] * cs - pr * sn); } }
            LAS bf16_t* kd = KtB + (hh2 * 64 + key) * 72 + seg * 16;
            *(LAS u32x4*)kd = pack8(xk); *(LAS u32x4*)(kd + 8) = pack8(xk + 8);
        }
        {
            const int hh2 = pf_hh2, seg = pf_vseg, key = pf_vkey;
            const u32x4 a = pv0, c = pv1;
            LAS bf16_t* vd = VtB + (hh2 * 64 + seg * 16) * 72 + key;
            vd[0 * 72] = (bf16_t)(a.x & 0xffff); vd[1 * 72] = (bf16_t)(a.x >> 16); vd[2 * 72] = (bf16_t)(a.y & 0xffff); vd[3 * 72] = (bf16_t)(a.y >> 16);
            vd[4 * 72] = (bf16_t)(a.z & 0xffff); vd[5 * 72] = (bf16_t)(a.z >> 16); vd[6 * 72] = (bf16_t)(a.w & 0xffff); vd[7 * 72] = (bf16_t)(a.w >> 16);
            vd[8 * 72] = (bf16_t)(c.x & 0xffff); vd[9 * 72] = (bf16_t)(c.x >> 16); vd[10 * 72] = (bf16_t)(c.y & 0xffff); vd[11 * 72] = (bf16_t)(c.y >> 16);
            vd[12 * 72] = (bf16_t)(c.z & 0xffff); vd[13 * 72] = (bf16_t)(c.z >> 16); vd[14 * 72] = (bf16_t)(c.w & 0xffff); vd[15 * 72] = (bf16_t)(c.w >> 16);
        }
        { const int Tn = T + 1; if (Tn < ntot) { const size_t r0 = (Tn < nloc) ? (size_t)b * SEQ + (krU + Tn) * 64 : (size_t)NLAT + b * CTXL + (Tn - nloc) * 64;
            const bf16_t* kp = P + (r0 + pf_key) * PW + C_CK + pf_h2 * 64 + pf_seg * 16; pk0 = *(const u32x4*)kp; pk1 = *(const u32x4*)(kp + 8);
            const bf16_t* vp = P + (r0 + pf_vkey) * PW + C_CV + pf_h2 * 64 + pf_vseg * 16; pv0 = *(const u32x4*)vp; pv1 = *(const u32x4*)(vp + 8); } }
    };
    auto compute = [&](auto LOC, int T, int buf) {
        constexpr bool loc = decltype(LOC)::value; const int kr = krU + T;
        const LAS bf16_t* KtB = Kt + buf * (4 * 64 * 72); const LAS bf16_t* VtB = KtB + 2 * 64 * 72;
#pragma unroll
        for (int qi = 0; qi < 2; ++qi) {
            if (loc && (kr < kq0[qi] || kr >= kq0[qi] + 8)) continue;
            f32x4 st[4];
#pragma unroll
            for (int g = 0; g < 4; ++g) { const bool use = !loc || (g >= glo && g <= ghi);
                st[g] = (f32x4){0.f, 0.f, 0.f, 0.f};
                if (use) {
#pragma unroll
                    for (int ks = 0; ks < 2; ++ks) st[g] = mfma16(*(const LAS bf16x8*)(KtB + (hh * 64 + g * 16 + l16) * 72 + ks * 32 + q4 * 8), loc ? qrt[qi][ks] : qpl[qi][ks], st[g]);
                    if (loc) { const int dr31 = (kr - rq[qi] + 7) * 31;
#pragma unroll
                        for (int j = 0; j < 4; ++j) { const float sv = st[g][j] + rpbL[hh * 480 + min(max(bbase + g * 16 + j, -15), 15) + 15 + dr31]; st[g][j] = ((mbits >> (g * 4 + j)) & 1u) ? -1e30f : sv; } }
                } else st[g] = (f32x4){-1e30f, -1e30f, -1e30f, -1e30f};
            }
            float tmax = -1e30f;
#pragma unroll
            for (int g = 0; g < 4; ++g)
#pragma unroll
                for (int j = 0; j < 4; ++j) tmax = fmaxf(tmax, st[g][j]);
            tmax = fmaxf(tmax, __shfl_xor(tmax, 16)); tmax = fmaxf(tmax, __shfl_xor(tmax, 32));
            const float mnew = fmaxf(mrun[qi], tmax); const float alpha = fexp_(mrun[qi] - mnew); mrun[qi] = mnew;
            float psum = 0.f;
#pragma unroll
            for (int g = 0; g < 4; ++g) { const bool use = !loc || (g >= glo && g <= ghi);
                if (use) {
#pragma unroll
                    for (int j = 0; j < 4; ++j) { const float pv = fexp_(st[g][j] - mnew); st[g][j] = pv; psum += pv; }
                } else st[g] = (f32x4){0.f, 0.f, 0.f, 0.f}; }
            lsum[qi] = lsum[qi] * alpha + psum;
#pragma unroll
            for (int i = 0; i < 4; ++i) O[qi][i] *= alpha;
            bf16x8 pb[2];
#pragma unroll
            for (int ks = 0; ks < 2; ++ks) { u32x4 wv; wv.x = pack2(st[2 * ks][0], st[2 * ks][1]); wv.y = pack2(st[2 * ks][2], st[2 * ks][3]); wv.z = pack2(st[2 * ks + 1][0], st[2 * ks + 1][1]); wv.w = pack2(st[2 * ks + 1][2], st[2 * ks + 1][3]); pb[ks] = as_bf16x8(wv); }
#pragma unroll
            for (int ks = 0; ks < 2; ++ks) if (!loc || (2 * ks + 1 >= glo && 2 * ks <= ghi))
#pragma unroll
                for (int dg = 0; dg < 4; ++dg) { const LAS bf16_t* vr = VtB + (hh * 64 + dg * 16 + l16) * 72 + ks * 32 + q4 * 4;
                    const u32x2 lo = *(const LAS u32x2*)vr, hi = *(const LAS u32x2*)(vr + 16); u32x4 av; av.x = lo.x; av.y = lo.y; av.z = hi.x; av.w = hi.y;
                    O[qi][dg] = mfma16(as_bf16x8(av), pb[ks], O[qi][dg]); }
        }
    };
    stage(0, 0);
    __syncthreads();
    for (int T = 0; T < nloc; ++T) {
        stage(T + 1, (T + 1) & 1);
        compute(BoolC<true>{}, T, T & 1);
        __syncthreads();
    }
    for (int T = nloc; T < ntot; ++T) {
        if (T + 1 < ntot) stage(T + 1, (T + 1) & 1);
        compute(BoolC<false>{}, T, T & 1);
        __syncthreads();
    }
#pragma unroll
    for (int qi = 0; qi < 2; ++qi) {
        float ls = lsum[qi]; ls += __shfl_xor(ls, 16); ls += __shfl_xor(ls, 32);
        const float inv = 1.0f / ls;
        bf16_t* op = dry ? ((bf16_t*)(PF(ws) + WS_DUMMY) + (size_t)(blockIdx.x & 63) * 16384 + (size_t)((qi * 8 + w) * 16 + l16) * 64) : (P + (qrow0[qi] + qc) * PW + C_CQ + h * 64);
#pragma unroll
        for (int dg = 0; dg < 4; ++dg) { u32x2 wv; wv.x = pack2(O[qi][dg][0] * inv, O[qi][dg][1] * inv); wv.y = pack2(O[qi][dg][2] * inv, O[qi][dg][3] * inv); *(u32x2*)(op + dg * 16 + q4 * 4) = wv; }
    }
    __syncthreads();
}

__device__ __forceinline__ void hgrn_stage(const bf16_t* P, LAS unsigned char* lds, int w, int lane, size_t row0, int dir, int h) {
#pragma unroll
    for (int i = 0; i < 2; ++i) { const int blk = i * 8 + w; const int t = blk * 4 + (lane >> 4); const bf16_t* rp = P + (row0 + (dir ? 63 - t : t)) * PW + (lane & 15) * 8;
        __builtin_amdgcn_global_load_lds((const unsigned*)(rp + C_BQ + h * 128), (LAS unsigned*)(lds + 118784 + blk * 1024), 16, 0, 0);
        __builtin_amdgcn_global_load_lds((const unsigned*)(rp + C_BF + dir * 512 + h * 128), (LAS unsigned*)(lds + 135168 + blk * 1024), 16, 0, 0); }
}
__device__ __forceinline__ void hgrn_chain(const Params& p, int l, LAS unsigned char* lds, int chain, int dry = 0) {
    LAS bf16_t* Q0 = (LAS bf16_t*)lds;
    LAS bf16_t* KP = (LAS bf16_t*)(lds + 17408);
    LAS bf16_t* SB = (LAS bf16_t*)(lds + 34816);
    LAS bf16_t* KDT = (LAS bf16_t*)(lds + 69632);
    LAS bf16_t* VT = (LAS bf16_t*)(lds + 88064);
    LAS bf16_t* ATT = (LAS bf16_t*)(lds + 106496);
    LAS float* TOT = (LAS float*)(lds + 115712);
    LAS float* DD = (LAS float*)(lds + 117760);
    const LAS bf16_t* SQ = (const LAS bf16_t*)(lds + 118784);
    const LAS bf16_t* SF = (const LAS bf16_t*)(lds + 135168);
    bf16_t* P = (bf16_t*)(PF(ws) + WS_P);
    const int tid = tid_(), w = __builtin_amdgcn_readfirstlane(tid >> 6), lane = tid & 63, l16 = lane & 15, q4 = lane >> 4;
    const int dir = chain & 1, h = (chain >> 1) & 3, b = chain >> 3;
    const int d = tid & 127, sb = tid >> 7;
    float lbv = 0.f;
    if (l > 0) { const float x0 = PF(hg_lb)[(dir * 2 + 0) * 512 + h * 128 + d], x1 = PF(hg_lb)[(dir * 2 + 1) * 512 + h * 128 + d]; lbv = 1.0f / (1.0f + expf(x0 - x1)); }
    for (int i = tid; i < 64 * 72 / 2; i += 512) ((LAS unsigned*)ATT)[i] = 0u;
    f32x4 S[8];
#pragma unroll
    for (int i = 0; i < 8; ++i) S[i] = (f32x4){0.f, 0.f, 0.f, 0.f};
    { const int gch0 = dir == 0 ? 0 : 3; hgrn_stage(P, lds, w, lane, (size_t)NLAT + b * CTXL + gch0 * 64, dir, h); }
    asm volatile("s_waitcnt vmcnt(0)" ::: "memory");
    __syncthreads();
    for (int ci = 0; ci < 36; ++ci) {
        const int gch = dir == 0 ? ci : (ci < 4 ? 3 - ci : 39 - ci);
        const bool isctx = gch < 4; const int chunk = isctx ? gch : gch - 4;
        const size_t row0 = isctx ? (size_t)NLAT + b * CTXL + chunk * 64 : (size_t)b * SEQ + chunk * 64;
        float bl[16], qv[16], kv[16]; float run = 0.f;
        {
            unsigned vraw[16];
            { const bf16_t* vp = P + (row0 + (dir ? 63 - sb * 16 : sb * 16)) * PW + C_BI + h * 128 + d; const long vstep = dir ? -(long)PW : (long)PW;
#pragma unroll
              for (int ii = 0; ii < 16; ++ii) { vraw[ii] = *vp; vp += vstep; } }
#pragma unroll
            for (int eg = 0; eg < 8; ++eg) { u32x2 wv; wv.x = pack2(S[eg][0], S[eg][1]); wv.y = pack2(S[eg][2], S[eg][3]); *(LAS u32x2*)(SB + (eg * 16 + l16) * 136 + w * 16 + q4 * 4) = wv; }
#pragma unroll
            for (int ii = 0; ii < 16; ++ii) { const int t = sb * 16 + ii;
                const float fr = bf2f(SF[t * 128 + d]), qr = bf2f(SQ[t * 128 + d]);
                const float sg = __builtin_amdgcn_rcpf(1.0f + fexp_(-fr)); const float f = lbv + (1.0f - lbv) * sg; run += flog_(f); bl[ii] = run; kv[ii] = 1.0f - f; qv[ii] = qr * __builtin_amdgcn_rcpf(1.0f + fexp_(-qr)); }
            TOT[sb * 128 + d] = run;
            u32x4 v0, v1; v0.x = vraw[0] | (vraw[1] << 16); v0.y = vraw[2] | (vraw[3] << 16); v0.z = vraw[4] | (vraw[5] << 16); v0.w = vraw[6] | (vraw[7] << 16);
            v1.x = vraw[8] | (vraw[9] << 16); v1.y = vraw[10] | (vraw[11] << 16); v1.z = vraw[12] | (vraw[13] << 16); v1.w = vraw[14] | (vraw[15] << 16);
            *(LAS u32x4*)(VT + d * 72 + sb * 16) = v0; *(LAS u32x4*)(VT + d * 72 + sb * 16 + 8) = v1;
        }
        __syncthreads();
        if (ci < 35) { const int cn = ci + 1; const int gn = dir == 0 ? cn : (cn < 4 ? 3 - cn : 39 - cn); const bool cx = gn < 4; const int ck = cx ? gn : gn - 4;
            hgrn_stage(P, lds, w, lane, cx ? (size_t)NLAT + b * CTXL + ck * 64 : (size_t)b * SEQ + ck * 64, dir, h); }
        {
            const float t0 = TOT[d], t1 = TOT[128 + d], t2 = TOT[256 + d], t3 = TOT[384 + d];
            const float Bs1 = t0, Bs2 = t0 + t1, Bs3 = Bs2 + t2, total = Bs3 + t3;
            const float Bsb = sb == 0 ? 0.f : (sb == 1 ? Bs1 : (sb == 2 ? Bs2 : Bs3));
            const float eB = fexp_(Bsb), eT = fexp_(total);
            float kd[16];
#pragma unroll
            for (int ii = 0; ii < 16; ++ii) { const float e0 = fexp_(bl[ii]); Q0[(sb * 16 + ii) * 136 + d] = (bf16_t)pack2(qv[ii] * e0 * eB, 0.f);
                const float kp = kv[ii] * fexp_(fminf(-(Bsb + bl[ii]), 80.f)); KP[(sb * 16 + ii) * 136 + d] = (bf16_t)pack2(kp, 0.f); kd[ii] = kp * eT; }
            *(LAS u32x4*)(KDT + d * 72 + sb * 16) = pack8(kd); *(LAS u32x4*)(KDT + d * 72 + sb * 16 + 8) = pack8(kd + 8);
            if (sb == 0) DD[d] = eT;
        }
        __syncthreads();
        const bool need_o = !(l == 1 && isctx);
        if (need_o)
#pragma unroll
        for (int k2 = 0; k2 < 2; ++k2) { const int idx = w + 8 * k2;
            if (idx < 10) { const int i = idx < 1 ? 0 : (idx < 3 ? 1 : (idx < 6 ? 2 : 3)); const int j = idx - i * (i + 1) / 2;
                f32x4 sc = (f32x4){0.f, 0.f, 0.f, 0.f};
                const LAS bf16_t* qb = Q0 + (i * 16 + l16) * 136 + q4 * 8; const LAS bf16_t* kb = KP + (j * 16 + l16) * 136 + q4 * 8;
#pragma unroll
                for (int ks = 0; ks < 4; ++ks) sc = mfma16(*(const LAS bf16x8*)(qb + ks * 32), *(const LAS bf16x8*)(kb + ks * 32), sc);
#pragma unroll
                for (int jj = 0; jj < 4; ++jj) { const float v = (i == j && l16 > q4 * 4 + jj) ? 0.f : sc[jj]; ATT[(i * 16 + q4 * 4 + jj) * 72 + j * 16 + l16] = (bf16_t)pack2(v, 0.f); } } }
        __syncthreads();
        if (need_o) {
            bf16x8 SBf[4], VTf[2];
#pragma unroll
            for (int ks = 0; ks < 4; ++ks) SBf[ks] = *(const LAS bf16x8*)(SB + (w * 16 + l16) * 136 + ks * 32 + q4 * 8);
#pragma unroll
            for (int ks = 0; ks < 2; ++ks) VTf[ks] = *(const LAS bf16x8*)(VT + (w * 16 + l16) * 72 + ks * 32 + q4 * 8);
#pragma unroll
            for (int i = 0; i < 4; ++i) { f32x4 oa = (f32x4){0.f, 0.f, 0.f, 0.f};
#pragma unroll
                for (int ks = 0; ks < 4; ++ks) oa = mfma16(SBf[ks], *(const LAS bf16x8*)(Q0 + (i * 16 + l16) * 136 + ks * 32 + q4 * 8), oa);
#pragma unroll
                for (int ks = 0; ks < 2; ++ks) oa = mfma16(VTf[ks], *(const LAS bf16x8*)(ATT + (i * 16 + l16) * 72 + ks * 32 + q4 * 8), oa);
                const int t = i * 16 + l16; u32x2 wv; wv.x = pack2(oa[0], oa[1]); wv.y = pack2(oa[2], oa[3]);
                bf16_t* od = dry ? ((bf16_t*)(PF(ws) + WS_DUMMY) + (size_t)chain * 8192 + t * 128 + w * 16 + q4 * 4) : (P + (row0 + (dir ? 63 - t : t)) * PW + C_BF + dir * 512 + h * 128 + w * 16 + q4 * 4);
                *(u32x2*)od = wv; }
        }
        {
            const f32x4 dd = *(const LAS f32x4*)(DD + w * 16 + q4 * 4);
#pragma unroll
            for (int eg = 0; eg < 8; ++eg) S[eg] *= dd;
#pragma unroll
            for (int ks = 0; ks < 2; ++ks) { const bf16x8 A = *(const LAS bf16x8*)(KDT + (w * 16 + l16) * 72 + ks * 32 + q4 * 8);
#pragma unroll
                for (int eg = 0; eg < 8; ++eg) S[eg] = mfma16(A, *(const LAS bf16x8*)(VT + (eg * 16 + l16) * 72 + ks * 32 + q4 * 8), S[eg]); }
        }
        asm volatile("s_waitcnt vmcnt(0)" ::: "memory");
        __syncthreads();
    }
}

__global__ void __launch_bounds__(512, 2) fwd_megakernel(Params p) {
    extern __shared__ __attribute__((aligned(16))) unsigned char lds_raw[];
    LAS unsigned char* lds = (LAS unsigned char*)lds_raw;
    cg::grid_group grid = cg::this_grid();
    volatile LAS unsigned* xst = (volatile LAS unsigned*)(lds + LDS_BYTES - 16);
    if (threadIdx.x == 0) { xst[0] = 0u; xst[1] = 0u; xst[2] = 0u; xst[3] = 0u; }
    __syncthreads();
    const XcdBarrier xbar = xcd_barrier_post((unsigned*)(PF(ws) + WS_BAR), xst);
    const int G = gridDim.x, c = blockIdx.x;

    phase_mod(p, lds); __syncthreads();
    phase_rope(p);
    phase_convert(p, 0, lds);
    if (PF(ws) == nullptr) grid.sync();
    xcd_barrier(xbar);
#define WSP(T, off) ((T*)(PF(ws) + (off)))
    for (int l = 0; l < 2; ++l) {
        const bool lastl = (l == 1);
        const int Mrest = lastl ? NLAT : NTOK;
        if (l > 0) phase_convert(p, l, lds);
        phase_norm(p, l, l == 0 ? PF(x) : PF(out), l == 0 ? PF(ctx) : WSP(const float, WS_HC), PF(norm1_g) + l * DM, 0, NTOK,
                   (l > 0 && G == 256) ? (const float*)(PF(ws) + WS_P + (size_t)NTOK * DFF * 2) : nullptr, WSP(const float, WS_MOD) + (size_t)((l > 0 ? l - 1 : 0) * 9 + 8) * 6144 + 5120);
        xcd_barrier(xbar);

        { pg8::Gemm g{WSP(bf16_t, WS_U), WSP(bf16_t, WS_WIN), DM, DM, DM}; pg8::Sched S; S.init(NTOK, PW, G, c, DM, DM); pg8::EpiStore<0> E{WSP(bf16_t, WS_P), PW}; pg8::gemm_phase(lds, g, S, E); }
        xcd_barrier(xbar);
        {
            int staged = -1; const LruPtrs lp = lru_ptrs();
            if (c < 64) { hgrn_chain(p, l, lds, c);
                sub_barrier((unsigned*)(PF(ws) + WS_BAR) + 3776 + 16 * ((c >> 3) + 8 * l), 8u); phase_hg_final(p, l, c >> 3, c & 7); }
            else { const int cc = c - 64, GG = G - 64; const int nA = lastl ? 512 : 576;
                for (int it = cc; it < nA; it += GG) attn_item(p, l, lds, it);
                for (int it = cc; it < 2304; it += GG) lru_tile(p, l, lds, it, 0, staged, lp); }
            sub_barrier((unsigned*)(PF(ws) + WS_BAR) + 3520 + 64 * (2 * l + 1), (unsigned)G);
            if ((c & 7) != (staged & 7) || staged < 0) staged = -1;
            for (int it = c; it < 2304; it += G) lru_tile(p, l, lds, it, 1, staged, lp);
        }
        xcd_barrier(xbar);
        { pg8::Gemm g{WSP(bf16_t, WS_U), WSP(bf16_t, WS_WIN) + (size_t)PW * DM, DM, DM, DM}; pg8::Sched S; S.init(Mrest, 3072, G, c, DM, DM); pg8::EpiStore<1> E{WSP(bf16_t, WS_P), PW}; pg8::gemm_phase(lds, g, S, E); }
        xcd_barrier(xbar);
        { pg8::Gemm g{WSP(bf16_t, WS_P), WSP(bf16_t, WS_WB), PW, 512, 512}; pg8::MergeSched S; S.base.init(Mrest, DM, G, c, PW, 512);
          pg8::EpiMerge E{WSP(bf16_t, WS_P), WSP(bf16_t, WS_U)}; pg8::gemm_phase(lds, g, S, E); }
        xcd_barrier(xbar);
        { pg8::Gemm g{WSP(bf16_t, WS_U), WSP(bf16_t, WS_WO), DM, DM, DM};
          pg8::EpiResid E{l == 0 ? PF(x) : PF(out), l == 0 ? PF(ctx) : WSP(const float, WS_HC), PF(out), WSP(float, WS_HC), WSP(const float, WS_MOD) + (size_t)l * 9 * 6144 + 2048, WSP(float, WS_P)};
          if (!lastl && G == 256) { pg8::SplitSched S; S.base.init(NLAT, DM, G, c, DM, DM); S.sk = 256; pg8::gemm_phase(lds, g, S, E); }
          else { pg8::Sched S; S.init(Mrest, DM, G, c, DM, DM); pg8::gemm_phase(lds, g, S, E); } }
        xcd_barrier(xbar);
        if (!lastl && G == 256) phase_norm(p, l, PF(out), l == 0 ? PF(ctx) : WSP(const float, WS_HC), PF(norm2_g) + l * DM, 3072, Mrest, WSP(const float, WS_P), WSP(const float, WS_MOD) + (size_t)(l * 9 + 8) * 6144 + 2048, WSP(float, WS_HC));
        else phase_norm(p, l, PF(out), WSP(const float, WS_HC), PF(norm2_g) + l * DM, 3072, Mrest);
        xcd_barrier(xbar);
        { pg8::Gemm g{WSP(bf16_t, WS_U), WSP(bf16_t, WS_W1), DM, DM, DM}; pg8::Sched S; S.init(Mrest, DFF, G, c, DM, DM); pg8::EpiStore<2> E{WSP(bf16_t, WS_P), DFF}; pg8::gemm_phase(lds, g, S, E); }
        xcd_barrier(xbar);
        { pg8::Gemm g{WSP(bf16_t, WS_P), WSP(bf16_t, WS_W2), DFF, DFF, DFF};
          float* slab = (float*)(PF(ws) + WS_P + (size_t)NTOK * DFF * 2);
          pg8::EpiResid E{PF(out), WSP(const float, WS_HC), PF(out), WSP(float, WS_HC), WSP(const float, WS_MOD) + (size_t)l * 9 * 6144 + 5120, slab};
          if (!lastl && G == 256) { pg8::SplitSched S; S.base.init(NLAT, DM, G, c, DFF, DFF); S.sk = 1024; pg8::gemm_phase(lds, g, S, E); }
          else { pg8::Sched S; S.init(Mrest, DM, G, c, DFF, DFF); pg8::gemm_phase(lds, g, S, E); } }
        if (!lastl) xcd_barrier(xbar);
    }
}

extern "C" void kernel_launch(void* const* d_in, const int* in_sizes, int n_in, void* d_out, int out_size, void* d_ws, size_t ws_size, hipStream_t stream) {
    static int grid_blocks = 0;
    if (grid_blocks == 0) {
        int dev = 0, cus = 0, per_cu = 0;
        hipGetDevice(&dev);
        hipDeviceGetAttribute(&cus, hipDeviceAttributeMultiprocessorCount, dev);
        hipFuncSetAttribute((const void*)fwd_megakernel, hipFuncAttributeMaxDynamicSharedMemorySize, LDS_BYTES);
        hipOccupancyMaxActiveBlocksPerMultiprocessor(&per_cu, (const void*)fwd_megakernel, 512, LDS_BYTES);
        if (per_cu < 1 || n_in != 25 || ws_size < WS_END) { fprintf(stderr, "kernel_launch: cannot launch (per_cu %d, n_in %d, ws %zu need %zu)\n", per_cu, n_in, ws_size, (size_t)WS_END); grid_blocks = -1; }
        else grid_blocks = cus;
    }
    if (grid_blocks < 0) return;
    hipMemsetAsync((char*)d_ws + WS_BAR, 0, 16384, stream);
    Params p{};
    const float** pp = (const float**)&p;
    for (int i = 0; i < 25; ++i) pp[i] = (const float*)d_in[i];
    p.out = (float*)d_out; p.ws = (unsigned char*)d_ws;
    void* args[] = {&p};
    hipError_t e = hipLaunchCooperativeKernel((const void*)fwd_megakernel, dim3(grid_blocks), dim3(512), args, LDS_BYTES, stream);
    if (e != hipSuccess) fprintf(stderr, "cooperative launch failed: %s (grid %d)\n", hipGetErrorString(e), grid_blocks);
}
```

```cpp
#include <hip/hip_runtime.h>
#include <hip/hip_cooperative_groups.h>
#include <stdint.h>
#include <stdio.h>
namespace cg = cooperative_groups;

#define LAS __attribute__((address_space(3)))
typedef unsigned short bf16_t;
typedef short bf16x8 __attribute__((ext_vector_type(8)));
typedef float f32x4 __attribute__((ext_vector_type(4)));
typedef unsigned u32x4 __attribute__((ext_vector_type(4)));
typedef unsigned u32x2 __attribute__((ext_vector_type(2)));

constexpr int DM = 1024, NB = 8, SEQ = 2048, CTXL = 256, NLAT = NB * SEQ, NCTX = NB * CTXL, NTOK = NLAT + NCTX;
constexpr int PW = 5120, DIN = 8192, DFF = 4096;
constexpr int C_AX = 0, C_AG = 512, C_BQ = 1024, C_BF = 1536, C_BI = 2560, C_BO = 3072, C_CQ = 3584, C_CK = 4096, C_CV = 4608;
constexpr int LDS_BYTES = 163840;
constexpr size_t WS_WIN = 0;
constexpr size_t WS_WB = WS_WIN + (size_t)DIN * DM * 2;
constexpr size_t WS_WO = WS_WB + (size_t)3 * DM * 512 * 2;
constexpr size_t WS_W1 = WS_WO + (size_t)DM * DM * 2;
constexpr size_t WS_W2 = WS_W1 + (size_t)DFF * DM * 2;
constexpr size_t WS_U = WS_W2 + (size_t)DM * DFF * 2;
constexpr size_t WS_P = WS_U + (size_t)NTOK * DM * 2;
constexpr size_t WS_HC = WS_P + (size_t)NTOK * PW * 2;
constexpr size_t WS_MOD = WS_HC + (size_t)NCTX * DM * 4;
constexpr size_t WS_AGG = WS_MOD + (size_t)2 * 9 * 6144 * 4;
constexpr size_t WS_ROPE = WS_AGG + (size_t)NB * 36 * 2 * 2 * 512 * 4;
constexpr size_t WS_DUMMY = WS_ROPE + 2048 * 4;
constexpr size_t WS_BAR = WS_DUMMY + (2u << 20);
constexpr size_t WS_END = WS_BAR + 16384;

struct Params {
    const float *x, *c, *ctx, *c_ctx, *ada_w, *ada_b, *norm1_g, *norm2_g, *w_in, *conv_w, *conv_b, *lru_wa, *lru_ba, *lru_wx, *lru_bx, *lru_lambda,
        *hg_lb, *hg_norm_g, *na_qg, *na_kg, *na_rpb, *w_branch, *w_out, *ffn_w1, *ffn_w2;
    float* out; unsigned char* ws;
};


__device__ __forceinline__ unsigned long long ldkarg(int off) { unsigned long long v = 0;
#if defined(__HIP_DEVICE_COMPILE__)
    auto kp = __builtin_amdgcn_kernarg_segment_ptr();
    asm volatile("s_load_dwordx2 %0, %1, %2\n\ts_waitcnt lgkmcnt(0)" : "=s"(v) : "s"(kp), "s"(off));
#endif
    return v; }
template <class T> struct rm_ptr; template <class T> struct rm_ptr<T*> { typedef T type; };
template <class T> __device__ __forceinline__ T* as_global_ptr(unsigned long long v) { return (T*)(__attribute__((address_space(1))) T*)v; }
#define PF(f) (as_global_ptr<rm_ptr<decltype(Params::f)>::type>(ldkarg((int)__builtin_offsetof(Params, f))))

#define GAS __attribute__((address_space(1)))
template <class T> __device__ __forceinline__ GAS T* lnd(T* p) { asm volatile("" : "+v"(p)); return (GAS T*)p; }
__device__ __forceinline__ int tid_() { int t = threadIdx.x; asm volatile("" : "+v"(t)); return t; }
__device__ __forceinline__ float bf2f(unsigned v) { return __uint_as_float(v << 16); }
__device__ __forceinline__ float bflo(unsigned w) { return __uint_as_float(w << 16); }
__device__ __forceinline__ float bfhi(unsigned w) { return __uint_as_float(w & 0xffff0000u); }
__device__ __forceinline__ unsigned f2bf(float f) { unsigned u = __float_as_uint(f); u += 0x7fffu + ((u >> 16) & 1u); return u >> 16; }
typedef __bf16 bf16x2_t __attribute__((ext_vector_type(2)));
typedef float f32x2_t __attribute__((ext_vector_type(2)));
__device__ __forceinline__ unsigned pack2(float lo, float hi) { f32x2_t v = {lo, hi}; bf16x2_t b = __builtin_convertvector(v, bf16x2_t); union { bf16x2_t b; unsigned u; } t; t.b = b; return t.u; }
__device__ __forceinline__ float fexp_(float x) { return __builtin_amdgcn_exp2f(x * 1.4426950408889634f); }
__device__ __forceinline__ float flog_(float x) { return __builtin_amdgcn_logf(x) * 0.6931471805599453f; }
__device__ __forceinline__ float dpp_xor1(float v) { return __int_as_float(__builtin_amdgcn_mov_dpp(__float_as_int(v), 0xB1, 0xF, 0xF, true)); }
__device__ __forceinline__ float dpp_xor2(float v) { return __int_as_float(__builtin_amdgcn_mov_dpp(__float_as_int(v), 0x4E, 0xF, 0xF, true)); }
__device__ __forceinline__ float sigmoidf_(float x) { return __builtin_amdgcn_rcpf(1.0f + fexp_(-x)); }
__device__ __forceinline__ f32x4 mfma16(bf16x8 a, bf16x8 b, f32x4 c) { return __builtin_amdgcn_mfma_f32_16x16x32_bf16(a, b, c, 0, 0, 0); }
__device__ __forceinline__ bf16x8 as_bf16x8(u32x4 v) { union { u32x4 u; bf16x8 b; } t; t.u = v; return t.b; }
__device__ __forceinline__ void unpack8(u32x4 w, float* o) { o[0] = bflo(w.x); o[1] = bfhi(w.x); o[2] = bflo(w.y); o[3] = bfhi(w.y); o[4] = bflo(w.z); o[5] = bfhi(w.z); o[6] = bflo(w.w); o[7] = bfhi(w.w); }
__device__ __forceinline__ u32x4 pack8(const float* v) { u32x4 w; w.x = pack2(v[0], v[1]); w.y = pack2(v[2], v[3]); w.z = pack2(v[4], v[5]); w.w = pack2(v[6], v[7]); return w; }

namespace pg8 {
constexpr int BM = 256, BK = 64, HALF = 128, HTB = HALF * BK * 2, NXCD = 8, WGM = 4;
__device__ __forceinline__ int lds_byte(int r, int c) { const int st = (r >> 4) * 2 + (c >> 5), rr = r & 15, cc = c & 31, ob = rr * 64 + cc * 2; return st * 1024 + (ob ^ (((ob >> 9) & 1) << 5)); }
__device__ __forceinline__ void stage_rc(int b, int& R, int& C) { const int st = b / 1024, sb = b % 1024, swz = sb ^ (((sb >> 9) & 1) << 5); R = (st >> 1) * 16 + swz / 64; C = (st & 1) * 32 + (swz % 64) / 2; }
__device__ __forceinline__ int perm32(int rho) { const int n = rho >> 4, i = rho & 15; return 8 * (i >> 2) + 4 * n + (i & 3); }

struct Unit { int pm, pn, sub, nt; size_t aoff, boff; };
struct Gemm { const bf16_t* A; const bf16_t* Bt; int lda, ldb, K; };
struct Sched {
    int nM, nN, nwg, G, c, lda, ldb, nt;
    __device__ void init(int M, int N, int G_, int c_, int lda_, int ldb_) { nM = M / BM; nN = N / BM; nwg = nM * nN; G = G_; c = c_; lda = lda_; ldb = ldb_; nt = 0; }
    __device__ bool next(int i, Unit& u) const {
        const long L = (long)i * G + c; if (L >= nwg) return false;
        int wgid = (int)L; { const int q = nwg / NXCD, r = nwg % NXCD, xcd = wgid % NXCD, off = wgid / NXCD; wgid = (xcd < r ? xcd * (q + 1) : r * (q + 1) + (xcd - r) * q) + off; }
        const int nig = WGM * nN, gid = wgid / nig, fm = gid * WGM, gsz = (nM - fm) < WGM ? (nM - fm) : WGM;
        u.pm = fm + ((wgid % nig) % gsz); u.pn = (wgid % nig) / gsz; u.sub = 0; u.nt = nt;
        u.aoff = (size_t)u.pm * BM * lda * 2;
        u.boff = (size_t)u.pn * BM * ldb * 2;
        return true;
    }
};

template <int ACT> struct EpiStore {
    static constexpr bool PERM = true;
    bf16_t* O; int ldc;
    __device__ __forceinline__ void operator()(const f32x4 (&acc)[2][2][4][2], const Unit& u, int wr, int wc, int fr, int fq) const {
        const int row0 = u.pm * BM + wr * 64 + fr; int colt = u.pn * BM;
        if (ACT == 1) colt = (colt < 2048) ? (1024 + colt) : (2048 + colt);
        const int col0 = colt + wc * 32 + 8 * fq;
#pragma unroll
        for (int ai = 0; ai < 2; ++ai)
#pragma unroll
            for (int m = 0; m < 4; ++m) { GAS bf16_t* rowp = lnd(O + (size_t)(row0 + ai * HALF + m * 16) * ldc + col0);
#pragma unroll
                for (int bj = 0; bj < 2; ++bj) { f32x4 v0 = acc[ai][bj][m][0], v1 = acc[ai][bj][m][1];
                    if (ACT == 1) {
#pragma unroll
                        for (int j = 0; j < 4; ++j) { v0[j] = sigmoidf_(v0[j]); v1[j] = sigmoidf_(v1[j]); } }
                    if (ACT == 2) {
#pragma unroll
                        for (int j = 0; j < 4; ++j) { float a = fmaxf(v0[j], 0.f), b = fmaxf(v1[j], 0.f); v0[j] = a * a; v1[j] = b * b; } }
                    u32x4 w; w.x = pack2(v0[0], v0[1]); w.y = pack2(v0[2], v0[3]); w.z = pack2(v1[0], v1[1]); w.w = pack2(v1[2], v1[3]);
                    *(GAS u32x4*)(rowp + bj * HALF) = w; } }
    }
};
struct EpiMerge {
    static constexpr bool PERM = true;
    const bf16_t* P; bf16_t* U;
    __device__ __forceinline__ void operator()(const f32x4 (&acc)[2][2][4][2], const Unit& u, int wr, int wc, int fr, int fq) const {
        const int row0 = u.pm * BM + wr * 64 + fr; const int col0 = u.pn * BM + wc * 32 + 8 * fq;
        const int sub = u.sub; const int gcol = sub * 1024 + u.pn * BM; const int gd = ((gcol < 2048) ? (1024 + gcol) : (2048 + gcol)) + wc * 32 + 8 * fq;
        const bool addp = sub > 0;
#pragma unroll
        for (int ai = 0; ai < 2; ++ai)
#pragma unroll
            for (int m = 0; m < 4; ++m) { const size_t row = (size_t)(row0 + ai * HALF + m * 16); const GAS bf16_t* gp = lnd(P + row * PW + gd); GAS bf16_t* up = lnd(U + row * DM + col0);
#pragma unroll
                for (int bj = 0; bj < 2; ++bj) { const u32x4 gw = *(const GAS u32x4*)(gp + bj * HALF);
                    f32x4 a0 = acc[ai][bj][m][0], a1 = acc[ai][bj][m][1];
                    a0[0] *= bflo(gw.x); a0[1] *= bfhi(gw.x); a0[2] *= bflo(gw.y); a0[3] *= bfhi(gw.y); a1[0] *= bflo(gw.z); a1[1] *= bfhi(gw.z); a1[2] *= bflo(gw.w); a1[3] *= bfhi(gw.w);
                    if (addp) { const u32x4 pw = *(const GAS u32x4*)(up + bj * HALF);
                        a0[0] += bflo(pw.x); a0[1] += bfhi(pw.x); a0[2] += bflo(pw.y); a0[3] += bfhi(pw.y); a1[0] += bflo(pw.z); a1[1] += bfhi(pw.z); a1[2] += bflo(pw.w); a1[3] += bfhi(pw.w); }
                    u32x4 o; o.x = pack2(a0[0], a0[1]); o.y = pack2(a0[2], a0[3]); o.z = pack2(a1[0], a1[1]); o.w = pack2(a1[2], a1[3]);
                    *(GAS u32x4*)(up + bj * HALF) = o; } }
    }
};
struct EpiResid {
    static constexpr bool PERM = true;
    const float* inL; const float* inC; float* outL; float* outC; const float* mod;
    float* slab;
    __device__ __forceinline__ void operator()(const f32x4 (&acc)[2][2][4][2], const Unit& u, int wr, int wc, int fr, int fq) const {
        if (u.sub >= 1) {
            const int row0 = (u.pm - 64) * BM + wr * 64 + fr, col0 = u.pn * BM + wc * 32 + 8 * fq; float* sl = slab + (size_t)(u.sub - 1) * NCTX * DM;
#pragma unroll
            for (int ai = 0; ai < 2; ++ai)
#pragma unroll
                for (int m = 0; m < 4; ++m)
#pragma unroll
                    for (int bj = 0; bj < 2; ++bj) { GAS float* op = lnd(sl + (size_t)(row0 + ai * HALF + m * 16) * DM + col0 + bj * HALF); *(GAS f32x4*)op = acc[ai][bj][m][0]; *(GAS f32x4*)(op + 4) = acc[ai][bj][m][1]; }
            return;
        }
        const bool lat = u.pm < 64; const int rbase = lat ? u.pm * BM : (u.pm - 64) * BM;
        const float* in = lat ? inL : inC; float* out = lat ? outL : outC;
        const int row0 = rbase + wr * 64 + fr, col0 = u.pn * BM + wc * 32 + 8 * fq;
        const float* gt = mod + (size_t)(lat ? (u.pm >> 3) : 8) * 6144 + col0;
#pragma unroll
        for (int bj = 0; bj < 2; ++bj) { const f32x4 g0 = *(const f32x4*)(gt + bj * HALF), g1 = *(const f32x4*)(gt + bj * HALF + 4);
#pragma unroll
            for (int ai = 0; ai < 2; ++ai)
#pragma unroll
                for (int m = 0; m < 4; ++m) { const size_t ro = (size_t)(row0 + ai * HALF + m * 16) * DM + col0 + bj * HALF;
                    const GAS float* ip = lnd(in + ro); GAS float* op = lnd(out + ro); const f32x4 i0 = *(const GAS f32x4*)ip, i1 = *(const GAS f32x4*)(ip + 4);
                    *(GAS f32x4*)op = i0 + g0 * acc[ai][bj][m][0]; *(GAS f32x4*)(op + 4) = i1 + g1 * acc[ai][bj][m][1]; } }
    }
};

struct MergeSched {
    Sched base;
    __device__ bool next(int i, Unit& u) const {
        const int r = i / 3, n = i - 3 * r;
        if (!base.next(r, u)) return false;
        u.sub = n; u.aoff += (size_t)(n == 0 ? C_AG : C_BO + (n - 1) * 512) * 2; u.boff += (size_t)n * DM * 512 * 2;
        return true;
    }
};
struct SplitSched {
    Sched base;
    int sk;
    __device__ bool next(int i, Unit& u) const {
        if (base.next(i, u)) return true;
        const int nfull = (base.nwg - base.c + base.G - 1) / base.G;
        const int k = i - nfull; const int un = k * base.G + base.c; if (k < 0 || un >= 128) return false;
        const int ct = un >> 2, sl = un & 3; u.pm = 64 + (ct >> 2); u.pn = ct & 3; u.sub = 1 + sl; u.nt = sk / BK;
        u.aoff = (size_t)u.pm * BM * base.lda * 2 + (size_t)sl * sk * 2; u.boff = (size_t)u.pn * BM * base.ldb * 2 + (size_t)sl * sk * 2;
        return true;
    }
};
template <class Epi, class Sch>
__device__ __forceinline__ void gemm_phase(LAS unsigned char* lds, const Gemm g, const Sch& S, const Epi& E) {
    const int tid = tid_(), wid = __builtin_amdgcn_readfirstlane(tid >> 6), lane = tid & 63, wr = wid >> 2, wc = wid & 3, fr = lane & 15, fq = lane >> 4;
    const int K = g.K;
    unsigned voffA[2], voffB[2];
#pragma unroll
    for (int i = 0; i < 2; ++i) { int R, C; stage_rc(tid * 16 + i * 8192, R, C); const int Rb = Epi::PERM ? ((R & ~31) + perm32(R & 31)) : R;
        voffA[i] = (unsigned)(R * g.lda + C) * 2u; voffB[i] = (unsigned)(Rb * g.ldb + C) * 2u; }
    const size_t kstep = (size_t)(BK * 2);
    const size_t hstepA = (size_t)HALF * g.lda * 2, hstepB = (size_t)HALF * g.ldb * 2;
    const unsigned ldsw = (unsigned)wid * 1024u;
    const int aoff = lds_byte(wr * 64 + fr, fq * 8), boff = lds_byte(wc * 32 + fr, fq * 8);
#define PG8_SA(b, h) (((b) * 2 + (h)) * HTB)
#define PG8_SB(b, h) ((4 + (b) * 2 + (h)) * HTB)
#define PG8_STAGE(bufoff, gbase, voff) do { _Pragma("unroll") for (int _i = 0; _i < 2; ++_i) \
        __builtin_amdgcn_global_load_lds((const unsigned*)((const char*)(gbase) + (voff)[_i]), (LAS unsigned*)(lds + (bufoff) + ldsw + _i * 8192), 16, 0, 0); } while (0)
#define PG8_LDA(dst, b, h) do { _Pragma("unroll") for (int m = 0; m < 4; ++m) _Pragma("unroll") for (int k = 0; k < 2; ++k) dst[m][k] = *(const LAS bf16x8*)(lds + PG8_SA(b, h) + aoff + m * 2048 + k * 1024); } while (0)
#define PG8_LDB(dst, b, h) do { _Pragma("unroll") for (int n = 0; n < 2; ++n) _Pragma("unroll") for (int k = 0; k < 2; ++k) dst[n][k] = *(const LAS bf16x8*)(lds + PG8_SB(b, h) + boff + n * 2048 + k * 1024); } while (0)
#define PG8_MMA(ai, bj, At, Bt) do { __builtin_amdgcn_s_setprio(1); _Pragma("unroll") for (int m = 0; m < 4; ++m) _Pragma("unroll") for (int n = 0; n < 2; ++n) _Pragma("unroll") for (int k = 0; k < 2; ++k) \
        acc[ai][bj][m][n] = __builtin_amdgcn_mfma_f32_16x16x32_bf16(Bt[n][k], At[m][k], acc[ai][bj][m][n], 0, 0, 0); __builtin_amdgcn_s_setprio(0); } while (0)
#define PG8_WAIT_V(n) asm volatile("s_waitcnt vmcnt(" #n ")" ::: "memory")
#define PG8_WAIT_L(n) asm volatile("s_waitcnt lgkmcnt(" #n ")" ::: "memory")
#define PG8_BAR __builtin_amdgcn_s_barrier()
#define PG8_SCHED __builtin_amdgcn_sched_barrier(0)
    Unit cur, nxt; int ui = 0;
    if (!S.next(0, cur)) return;
    f32x4 acc[2][2][4][2];
#pragma unroll
    for (int a = 0; a < 2; ++a)
#pragma unroll
        for (int b = 0; b < 2; ++b)
#pragma unroll
            for (int m = 0; m < 4; ++m)
#pragma unroll
                for (int n = 0; n < 2; ++n) acc[a][b][m][n] = (f32x4){0.f, 0.f, 0.f, 0.f};
    bf16x8 At[4][2], B0[2][2], B1[2][2];
    const char* cA = (const char*)g.A + cur.aoff; const char* cB = (const char*)g.Bt + cur.boff;
    PG8_STAGE(PG8_SB(0, 0), cB, voffB); PG8_STAGE(PG8_SB(0, 1), cB + hstepB, voffB); PG8_STAGE(PG8_SA(0, 0), cA, voffA); PG8_STAGE(PG8_SA(0, 1), cA + hstepA, voffA);
    if (wr == 1) PG8_BAR;
    PG8_WAIT_V(2); PG8_BAR;
    PG8_STAGE(PG8_SB(1, 0), cB + kstep, voffB); PG8_STAGE(PG8_SA(1, 0), cA + kstep, voffA); PG8_STAGE(PG8_SB(1, 1), cB + hstepB + kstep, voffB);
    PG8_WAIT_V(6); PG8_BAR;
    for (;;) {
        const bool has_next = S.next(ui + 1, nxt);
        const char* nA = has_next ? (const char*)g.A + nxt.aoff : cA; const char* nB = has_next ? (const char*)g.Bt + nxt.boff : cB;
        const int nt = cur.nt ? cur.nt : K / BK;
        for (int t = 0; t < nt; t += 2) {
            const bool last = (t == nt - 2);
            const char* a1 = cA + (size_t)(t + 1) * kstep;
            const char* a2 = last ? nA : cA + (size_t)(t + 2) * kstep; const char* b2 = last ? nB : cB + (size_t)(t + 2) * kstep;
            const char* a3 = a2 + kstep; const char* b3 = b2 + kstep;
            PG8_LDB(B0, 0, 0); PG8_LDB(B1, 0, 1); PG8_SCHED; PG8_LDA(At, 0, 0); PG8_STAGE(PG8_SA(1, 1), a1 + hstepA, voffA);
            PG8_WAIT_V(8); PG8_WAIT_L(0); PG8_BAR; PG8_MMA(0, 0, At, B0); PG8_MMA(0, 1, At, B1); PG8_BAR; PG8_SCHED;
            PG8_LDA(At, 0, 1); PG8_STAGE(PG8_SB(0, 0), b2, voffB); PG8_STAGE(PG8_SB(0, 1), b2 + hstepB, voffB); PG8_STAGE(PG8_SA(0, 0), a2, voffA);
            PG8_WAIT_V(8); PG8_WAIT_L(0); PG8_BAR; PG8_MMA(1, 0, At, B0); PG8_MMA(1, 1, At, B1); PG8_BAR; PG8_SCHED;
            PG8_LDB(B0, 1, 0); PG8_LDB(B1, 1, 1); PG8_SCHED; PG8_LDA(At, 1, 0); PG8_STAGE(PG8_SA(0, 1), a2 + hstepA, voffA);
            PG8_WAIT_V(8); PG8_WAIT_L(0); PG8_BAR; PG8_MMA(0, 0, At, B0); PG8_MMA(0, 1, At, B1); PG8_BAR; PG8_SCHED;
            PG8_LDA(At, 1, 1); PG8_STAGE(PG8_SB(1, 0), b3, voffB); PG8_STAGE(PG8_SB(1, 1), b3 + hstepB, voffB); PG8_STAGE(PG8_SA(1, 0), a3, voffA);
            PG8_WAIT_V(8); PG8_WAIT_L(0); PG8_BAR; PG8_MMA(1, 0, At, B0); PG8_MMA(1, 1, At, B1); PG8_BAR; PG8_SCHED;
        }
        if (wr == 0) PG8_BAR;
        E(acc, cur, wr, wc, fr, fq);
        if (!has_next) break;
#pragma unroll
        for (int a = 0; a < 2; ++a)
#pragma unroll
            for (int b = 0; b < 2; ++b)
#pragma unroll
                for (int m = 0; m < 4; ++m)
#pragma unroll
                    for (int n = 0; n < 2; ++n) acc[a][b][m][n] = (f32x4){0.f, 0.f, 0.f, 0.f};
        cur = nxt; cA = nA; cB = nB; ++ui;
        if (wr == 1) PG8_BAR;
    }
    PG8_WAIT_V(0);
    PG8_BAR;
#undef PG8_SA
#undef PG8_SB
#undef PG8_STAGE
#undef PG8_LDA
#undef PG8_LDB
#undef PG8_MMA
#undef PG8_WAIT_V
#undef PG8_WAIT_L
#undef PG8_BAR
#undef PG8_SCHED
}
}


#define XB_TMO      128
#define XB_XCNT(j)  (256  + 64 * (j))
#define XB_XSUB(j)  (1280 + 64 * (j))
#define XB_XGEN(j)  (2304 + 64 * (j))
#define XB_TOP      3328
#define XB_TOPGEN   3392
#define XCD_BAR_WORDS 3456
#define XB_SPIN_CAP (1u << 20)
__device__ __forceinline__ unsigned xb_ld(unsigned* p)              { return __hip_atomic_load(p, __ATOMIC_RELAXED, __HIP_MEMORY_SCOPE_AGENT); }
__device__ __forceinline__ unsigned xb_add(unsigned* p, unsigned v) { return __hip_atomic_fetch_add(p, v, __ATOMIC_RELAXED, __HIP_MEMORY_SCOPE_AGENT); }
__device__ __forceinline__ unsigned xb_xcc_id() { return (unsigned)__builtin_amdgcn_s_getreg((3 << 11) | 20) & 0xFu; }
#define XB_SPIN(cond, bar) do { unsigned _sp = 0; while (cond) { __builtin_amdgcn_s_sleep(0); \
    if ((++_sp & 255u) == 0u) { if (xb_ld(&(bar)[XB_TMO])) break; if (_sp > XB_SPIN_CAP) { atomicAdd(&(bar)[XB_TMO], 1u); break; } } } } while (0)
struct XcdBarrier { unsigned* bar; unsigned x; volatile LAS unsigned* st; };
__device__ __forceinline__ XcdBarrier xcd_barrier_post(unsigned* bar, volatile LAS unsigned* st) {
    XcdBarrier b; b.bar = bar; b.x = xb_xcc_id(); b.st = st;
    if (threadIdx.x == 0) (void)xb_add(&bar[XB_XCNT(b.x)], 1u);
    return b;
}
__device__ __forceinline__ void xcd_barrier_complete(unsigned* bar, unsigned x, unsigned& nloc, unsigned& nx) {
    const unsigned G = gridDim.x * gridDim.y * gridDim.z;
    unsigned sum, cnt, mine, sp = 0u;
    for (;;) {
        sum = 0u; cnt = 0u; mine = 0u;
#pragma unroll
        for (unsigned j = 0; j < 16; ++j) { const unsigned c = xb_ld(&bar[XB_XCNT(j)]); sum += c; cnt += (c > 0u) ? 1u : 0u; mine = (j == x) ? c : mine; }
        if (sum == G) break;
        __builtin_amdgcn_s_sleep(1);
        if ((++sp & 255u) == 0u) { if (xb_ld(&bar[XB_TMO])) break; if (sp > XB_SPIN_CAP) { atomicAdd(&bar[XB_TMO], 1u); break; } }
    }
    nloc = mine > 0u ? mine : 1u; nx = cnt > 0u ? cnt : 1u;
}
__device__ __forceinline__ void xcd_barrier(const XcdBarrier& b) {
    asm volatile("s_waitcnt vmcnt(0)" ::: "memory");
    __syncthreads();
    if (threadIdx.x == 0) {
        unsigned* bar = b.bar;
        __builtin_amdgcn_s_waitcnt(0);
        unsigned nloc = b.st[0], nx = b.st[1];
        if (nloc == 0u) { xcd_barrier_complete(bar, b.x, nloc, nx); b.st[0] = nloc; b.st[1] = nx; }
        const unsigned old = xb_add(&bar[XB_XSUB(b.x)], 1u);
        const unsigned gen = old / nloc;
        if (old + 1u == (gen + 1u) * nloc) {
            __builtin_amdgcn_fence(__ATOMIC_RELEASE, "agent");
            asm volatile("s_waitcnt vmcnt(0)" ::: "memory");
            const unsigned og = xb_add(&bar[XB_TOP], 1u);
            const unsigned tg = og / nx;
            if (og + 1u == (tg + 1u) * nx) xb_add(&bar[XB_TOPGEN], 1u);
            else XB_SPIN(xb_ld(&bar[XB_TOPGEN]) == tg, bar);
            __builtin_amdgcn_fence(__ATOMIC_ACQUIRE, "agent");
            xb_add(&bar[XB_XGEN(b.x)], 1u);
            asm volatile("s_waitcnt vmcnt(0)" ::: "memory");
        } else {
            XB_SPIN(xb_ld(&bar[XB_XGEN(b.x)]) == gen, bar);
            __builtin_amdgcn_fence(__ATOMIC_ACQUIRE, "agent");
            asm volatile("s_waitcnt vmcnt(0)" ::: "memory");
        }
    }
    __syncthreads();
}

__device__ __forceinline__ void sub_barrier(unsigned* word, unsigned n) {
    asm volatile("s_waitcnt vmcnt(0)" ::: "memory");
    __syncthreads();
    if (threadIdx.x == 0) {
        __builtin_amdgcn_fence(__ATOMIC_RELEASE, "agent");
        asm volatile("s_waitcnt vmcnt(0)" ::: "memory");
        xb_add(word, 1u);
        unsigned sp = 0;
        while (xb_ld(word) < n) { __builtin_amdgcn_s_sleep(0); if (++sp > (1u << 22)) break; }
        __builtin_amdgcn_fence(__ATOMIC_ACQUIRE, "agent");
        asm volatile("s_waitcnt vmcnt(0)" ::: "memory");
    }
    __syncthreads();
}

__device__ __forceinline__ void phase_mod(const Params& p, LAS unsigned char* lds) {
    LAS float* sc = (LAS float*)lds;
    LAS float* part = sc + 9 * 1024;
    float* mod = (float*)(PF(ws) + WS_MOD);
    const int tid = tid_(), w = tid >> 6, lane = tid & 63;
    if ((int)blockIdx.x >= 192) return;
    const float* pc = PF(c); const float* pcc = PF(c_ctx); const float* padaw = PF(ada_w); const float* padab = PF(ada_b);
    for (int i = tid; i < 9 * 1024; i += 512) { const int r = i >> 10, k = i & 1023; const float v = (r < 8) ? pc[r * 1024 + k] : pcc[k]; sc[i] = v / (1.0f + expf(-v)); }
    __syncthreads();
    for (int item = blockIdx.x; item < 192; item += gridDim.x) {
        const int l = item / 96, cb = item % 96;
        const float* W = padaw + (size_t)l * 1024 * 6144 + cb * 64 + lane;
        float acc[9];
#pragma unroll
        for (int r = 0; r < 9; ++r) acc[r] = 0.f;
        for (int k = w * 128; k < w * 128 + 128; ++k) { const float wv = W[(size_t)k * 6144];
#pragma unroll
            for (int r = 0; r < 9; ++r) acc[r] += sc[r * 1024 + k] * wv; }
#pragma unroll
        for (int r = 0; r < 9; ++r) part[(w * 9 + r) * 64 + lane] = acc[r];
        __syncthreads();
        for (int i = tid; i < 576; i += 512) { const int r = i >> 6, ln = i & 63; float s = 0.f;
#pragma unroll
            for (int ww = 0; ww < 8; ++ww) s += part[(ww * 9 + r) * 64 + ln];
            mod[(size_t)(l * 9 + r) * 6144 + cb * 64 + ln] = s + padab[l * 6144 + cb * 64 + ln]; }
        __syncthreads();
    }
}
__device__ __forceinline__ void phase_rope(const Params& p) {
    if (blockIdx.x != gridDim.x - 1) return;
    float* rope = (float*)(PF(ws) + WS_ROPE);
    for (int i = tid_(); i < 1024; i += 512) { const int pos = i >> 4, fi = i & 15; const float invf = powf(10000.0f, -(float)fi / 16.0f); const float ang = (float)pos * invf; rope[i] = cosf(ang); rope[1024 + i] = sinf(ang); }
}
__device__ __forceinline__ void convert_tile(const float* src, int K, int N, bf16_t* dst, int tile, LAS bf16_t* T) {
    const int tid = tid_(), tilesN = N >> 7, tk = tile / tilesN, tn = tile - tk * tilesN, k0 = tk * 128, n0 = tn * 128;
    const int r = tid >> 4, c8 = (tid & 15) * 8;
    f32x4 a[4], b[4];
#pragma unroll
    for (int i = 0; i < 4; ++i) { const float* s = src + (size_t)(k0 + r + 32 * i) * N + n0 + c8; a[i] = *(const f32x4*)s; b[i] = *(const f32x4*)(s + 4); }
#pragma unroll
    for (int i = 0; i < 4; ++i)
#pragma unroll
        for (int j = 0; j < 4; ++j) { T[(c8 + j) * 136 + r + 32 * i] = (bf16_t)f2bf(a[i][j]); T[(c8 + 4 + j) * 136 + r + 32 * i] = (bf16_t)f2bf(b[i][j]); }
    __syncthreads();
    const int n = tid >> 2, ks = (tid & 3) * 8;
#pragma unroll
    for (int i = 0; i < 4; ++i) { const u32x4 v = *(const LAS u32x4*)(T + n * 136 + ks + 32 * i); *(u32x4*)(dst + (size_t)(n0 + n) * K + k0 + ks + 32 * i) = v; }
    __syncthreads();
}
__device__ __forceinline__ void phase_convert(const Params& p, int l, LAS unsigned char* lds) {
    LAS bf16_t* T = (LAS bf16_t*)lds;
    bf16_t* WIN = (bf16_t*)(PF(ws) + WS_WIN); bf16_t* WB = (bf16_t*)(PF(ws) + WS_WB); bf16_t* WO = (bf16_t*)(PF(ws) + WS_WO); bf16_t* W1 = (bf16_t*)(PF(ws) + WS_W1); bf16_t* W2 = (bf16_t*)(PF(ws) + WS_W2);
    for (int it = blockIdx.x; it < 1184; it += gridDim.x) {
        if (it < 512) convert_tile(PF(w_in) + (size_t)l * DM * DIN, DM, DIN, WIN, it, T);
        else if (it < 608) { const int n = (it - 512) / 32, tl = (it - 512) % 32; convert_tile(PF(w_branch) + (size_t)(l * 3 + n) * 512 * DM, 512, DM, WB + (size_t)n * DM * 512, tl, T); }
        else if (it < 672) convert_tile(PF(w_out) + (size_t)l * DM * DM, DM, DM, WO, it - 608, T);
        else if (it < 928) convert_tile(PF(ffn_w1) + (size_t)l * DM * DFF, DM, DFF, W1, it - 672, T);
        else convert_tile(PF(ffn_w2) + (size_t)l * DFF * DM, DFF, DM, W2, it - 928, T);
    }
}
__device__ __forceinline__ void phase_norm(const Params& p, int l, const float* hlat, const float* hctx, const float* g, int modoff, int nrows, const float* slab = nullptr, const float* slabgate = nullptr, float* hwrite = nullptr) {
    const int tid = tid_(); const int w = tid >> 6, lane = tid & 63;
    bf16_t* U = (bf16_t*)(PF(ws) + WS_U); const float* mod = (const float*)(PF(ws) + WS_MOD);
    for (int row = blockIdx.x * 8 + w; row < nrows; row += gridDim.x * 8) {
        const float* src = row < NLAT ? hlat + (size_t)row * DM : hctx + (size_t)(row - NLAT) * DM;
        const int mr = row < NLAT ? (row >> 11) : 8;
        const float* md = mod + (size_t)(l * 9 + mr) * 6144 + modoff;
        f32x4 v[4]; float ss = 0.f;
#pragma unroll
        for (int i = 0; i < 4; ++i) { v[i] = *(const f32x4*)(src + i * 256 + lane * 4);
            if (slab != nullptr && row >= NLAT) { const size_t o = (size_t)(row - NLAT) * DM + i * 256 + lane * 4; const f32x4 gg = *(const f32x4*)(slabgate + i * 256 + lane * 4);
                const f32x4 s4 = (*(const f32x4*)(slab + o) + *(const f32x4*)(slab + o + (size_t)NCTX * DM)) + (*(const f32x4*)(slab + o + (size_t)2 * NCTX * DM) + *(const f32x4*)(slab + o + (size_t)3 * NCTX * DM));
                v[i] += gg * s4; if (hwrite != nullptr) *(f32x4*)(hwrite + o) = v[i]; }
            ss += v[i][0] * v[i][0] + v[i][1] * v[i][1] + v[i][2] * v[i][2] + v[i][3] * v[i][3]; }
#pragma unroll
        for (int o = 32; o >= 1; o >>= 1) ss += __shfl_xor(ss, o);
        const float rstd = rsqrtf(ss * (1.0f / 1024.0f) + 1e-6f);
#pragma unroll
        for (int i = 0; i < 4; ++i) { const int cidx = i * 256 + lane * 4; const f32x4 gg = *(const f32x4*)(g + cidx), sh = *(const f32x4*)(md + cidx), scv = *(const f32x4*)(md + 1024 + cidx);
            float o4[4];
#pragma unroll
            for (int j = 0; j < 4; ++j) o4[j] = (v[i][j] * rstd * gg[j]) * (1.0f + scv[j]) + sh[j];
            u32x2 wv; wv.x = pack2(o4[0], o4[1]); wv.y = pack2(o4[2], o4[3]);
            *(u32x2*)(U + (size_t)row * DM + cidx) = wv; }
    }
}
__device__ __forceinline__ void phase_hg_final(const Params& p, int l, int b, int wgi) {
    const int tid = tid_(); const int w = tid >> 6, lane = tid & 63; bf16_t* P = (bf16_t*)(PF(ws) + WS_P);
    const int hd = lane >> 4, e8 = (lane & 15) * 8; const float* png = PF(hg_norm_g);
    float ng[8];
#pragma unroll
    for (int i = 0; i < 8; ++i) ng[i] = png[l * 128 + e8 + i];
    for (int i0 = wgi * 8 + w; i0 < 2304; i0 += 3 * 64) {
        u32x4 ra[3], rb[3], ro[3]; bf16_t* rp[3];
#pragma unroll
        for (int k = 0; k < 3; ++k) { const int i = i0 + 64 * k; const int ic = i < 2304 ? i : i0; const size_t row = ic < 2048 ? (size_t)b * SEQ + ic : (size_t)NLAT + b * CTXL + (ic - 2048);
            rp[k] = P + row * PW; ra[k] = *(const u32x4*)(rp[k] + C_BF + hd * 128 + e8); rb[k] = *(const u32x4*)(rp[k] + C_BF + 512 + hd * 128 + e8); ro[k] = *(const u32x4*)(rp[k] + C_BO + hd * 128 + e8); }
#pragma unroll
        for (int k = 0; k < 3; ++k) {
            float a[8], bb[8], og[8]; unpack8(ra[k], a); unpack8(rb[k], bb); unpack8(ro[k], og);
            float ss = 0.f;
#pragma unroll
            for (int i = 0; i < 8; ++i) { a[i] += bb[i]; ss += a[i] * a[i]; }
            ss += __shfl_xor(ss, 1); ss += __shfl_xor(ss, 2); ss += __shfl_xor(ss, 4); ss += __shfl_xor(ss, 8);
            const float rstd = rsqrtf(ss * (1.0f / 128.0f) + 1e-6f);
            float y[8];
#pragma unroll
            for (int i = 0; i < 8; ++i) y[i] = a[i] * rstd * ng[i] * sigmoidf_(og[i]);
            if (i0 + 64 * k < 2304) *(u32x4*)(rp[k] + C_BO + hd * 128 + e8) = pack8(y);
        }
    }
}

__device__ __forceinline__ size_t agg_idx(int b, int gch, int dir, int which, int ch) { return ((((size_t)b * 36 + gch) * 2 + dir) * 2 + which) * 512 + ch; }
__device__ __forceinline__ float gelu_tanh(float x) { const float u = 0.7978845608028654f * (x + 0.044715f * x * x * x); const float th = 1.0f - 2.0f * __builtin_amdgcn_rcpf(1.0f + fexp_(2.0f * u)); return 0.5f * x * (1.0f + th); }
struct LruPtrs { bf16_t* P; float* AGG; const float *cb, *cw, *ba, *bx, *lam; };
__device__ __forceinline__ LruPtrs lru_ptrs() { LruPtrs q; q.P = (bf16_t*)(PF(ws) + WS_P); q.AGG = (float*)(PF(ws) + WS_AGG); q.cb = PF(conv_b); q.cw = PF(conv_w); q.ba = PF(lru_ba); q.bx = PF(lru_bx); q.lam = PF(lru_lambda); return q; }
__device__ __forceinline__ void lru_tile(const Params& p, int l, LAS unsigned char* lds, int item, int mode, int& staged_nb, const LruPtrs& lp, float (&kc)[3]) {
    LAS bf16_t* Wl = (LAS bf16_t*)lds;
    LAS bf16_t* Xb = Wl + 256 * 72;
    LAS float* Xf = (LAS float*)(lds + 46080);
    LAS float* Av = Xf + 4096;
    LAS float* Bv = Av + 8192;
    bf16_t* P = lp.P; float* AGG = lp.AGG;
    const int tid = tid_(), w = tid >> 6, lane = tid & 63, l16 = lane & 15, q4 = lane >> 4;
    const int nb = item & 7, rest = item >> 3, gch = rest % 36, b = rest / 36;
    const bool isctx = gch < 4; const int chunk = isctx ? gch : gch - 4, L = isctx ? CTXL : SEQ;
    const size_t seqrow0 = isctx ? (size_t)NLAT + b * CTXL : (size_t)b * SEQ; const int t0 = chunk * 64;
    if (staged_nb != nb) { const float* pwx = PF(lru_wx); const float* pwa = PF(lru_wa);
        for (int e = tid; e < 4 * 64 * 64; e += 512) { const int mat = e >> 12, i = (e >> 6) & 63, c = e & 63; const int dir = mat >> 1, kind = mat & 1;
            const float* W = kind ? pwx : pwa; const float v = W[((size_t)((l * 2 + dir) * 8 + nb) * 64 + i) * 64 + c];
            const int op = dir * 128 + (c >> 4) * 32 + kind * 16 + (c & 15);
            Wl[op * 72 + i] = (bf16_t)f2bf(v); }
        { const int dir = w >> 2, ch = nb * 64 + (w & 3) * 16 + l16; kc[0] = lp.ba[(l * 2 + dir) * 512 + ch]; kc[1] = lp.bx[(l * 2 + dir) * 512 + ch]; kc[2] = log1pf(expf(-lp.lam[(l * 2 + dir) * 512 + ch])); }
        staged_nb = nb;
    }
    {
        const int t = tid >> 3, c8 = (tid & 7) * 8, ch = nb * 64 + c8, tt = t0 + t;
        float a8[8]; const float* pcb = lp.cb; const float* pcw = lp.cw;
        { const f32x4 b0 = *(const f32x4*)(pcb + l * 512 + ch), b1 = *(const f32x4*)(pcb + l * 512 + ch + 4);
#pragma unroll
          for (int i = 0; i < 4; ++i) { a8[i] = b0[i]; a8[4 + i] = b1[i]; } }
#pragma unroll
        for (int j = 0; j < 4; ++j) { const int ts = tt + j - 2;
            if (ts >= 0 && ts < L) { float xv[8]; unpack8(*(const u32x4*)(P + (seqrow0 + ts) * PW + C_AX + ch), xv);
                const f32x4 w0 = *(const f32x4*)(pcw + (l * 4 + j) * 512 + ch), w1 = *(const f32x4*)(pcw + (l * 4 + j) * 512 + ch + 4);
#pragma unroll
                for (int i = 0; i < 4; ++i) { a8[i] += xv[i] * w0[i]; a8[4 + i] += xv[4 + i] * w1[i]; } } }
#pragma unroll
        for (int i = 0; i < 8; ++i) Xf[t * 64 + c8 + i] = a8[i];
        *(LAS u32x4*)(Xb + t * 72 + c8) = pack8(a8);
    }
    __syncthreads();
    {
        const int dir = w >> 2, c = (w & 3) * 16 + l16, ch = nb * 64 + c;
        f32x4 acc[4][2];
#pragma unroll
        for (int mg = 0; mg < 4; ++mg) { acc[mg][0] = (f32x4){0.f, 0.f, 0.f, 0.f}; acc[mg][1] = (f32x4){0.f, 0.f, 0.f, 0.f}; }
#pragma unroll
        for (int ks = 0; ks < 2; ++ks) {
            const bf16x8 B0 = *(const LAS bf16x8*)(Wl + (w * 32 + l16) * 72 + ks * 32 + q4 * 8), B1 = *(const LAS bf16x8*)(Wl + (w * 32 + 16 + l16) * 72 + ks * 32 + q4 * 8);
#pragma unroll
            for (int mg = 0; mg < 4; ++mg) { const bf16x8 A = *(const LAS bf16x8*)(Xb + (mg * 16 + l16) * 72 + ks * 32 + q4 * 8);
                acc[mg][0] = mfma16(A, B0, acc[mg][0]); acc[mg][1] = mfma16(A, B1, acc[mg][1]); }
        }
        const float ba = kc[0], bx = kc[1], sp = kc[2];
#pragma unroll
        for (int mg = 0; mg < 4; ++mg)
#pragma unroll
            for (int j = 0; j < 4; ++j) { const int t = mg * 16 + q4 * 4 + j;
                const float ea = 1.0f + fexp_(-(acc[mg][0][j] + ba)), ex = 1.0f + fexp_(-(acc[mg][1][j] + bx)); const float inv = __builtin_amdgcn_rcpf(ea * ex);
                const float r = inv * ex, ig = inv * ea;
                const float la = -8.0f * r * sp; const float a = fexp_(la); const float x2 = 2.0f * la;
                float om = -x2 * (1.0f + x2 * (0.5f + x2 * (0.16666667f + x2 * (0.041666668f + x2 * 0.0083333338f))));
                if (x2 < -0.35f) om = 1.0f - a * a;
                const float bb = sqrtf(fmaxf(om, 0.f)) * ig * Xf[t * 64 + c];
                Av[(dir * 64 + t) * 64 + c] = a; Bv[(dir * 64 + t) * 64 + c] = bb; }
    }
    __syncthreads();
    {
        LAS float* SegA = Xf;
        LAS float* SegB = Xf + 512;
        const int d2 = tid >> 8, seg = (tid >> 6) & 3, c = tid & 63, ch = nb * 64 + c;
        float av[16], bv[16];
#pragma unroll
        for (int k = 0; k < 16; ++k) { const int s = seg * 16 + k; const int t = d2 ? 63 - s : s; const int ix = (d2 * 64 + t) * 64 + c; av[k] = Av[ix]; bv[k] = Bv[ix]; }
        float h = 0.f, ap = 1.f;
#pragma unroll
        for (int k = 0; k < 16; ++k) { h = av[k] * h + bv[k]; ap *= av[k]; }
        SegA[(d2 * 4 + seg) * 64 + c] = ap; SegB[(d2 * 4 + seg) * 64 + c] = h;
        float hin = 0.f;
        if (mode == 1) {
            const int mypos = d2 == 0 ? gch : (gch < 4 ? 3 - gch : 39 - gch);
            for (int p0 = 0; p0 < mypos; p0 += 6) { float Aa[6], Bb[6];
#pragma unroll
                for (int j = 0; j < 6; ++j) { const int pp = p0 + j; const int g = d2 == 0 ? pp : (pp < 4 ? 3 - pp : 39 - pp); const bool ok = pp < mypos;
                    Aa[j] = ok ? AGG[agg_idx(b, ok ? g : 0, d2, 0, ch)] : 1.0f; Bb[j] = ok ? AGG[agg_idx(b, ok ? g : 0, d2, 1, ch)] : 0.0f; }
#pragma unroll
                for (int j = 0; j < 6; ++j) hin = Aa[j] * hin + Bb[j]; }
        }
        __syncthreads();
        if (mode == 0) {
            if (seg == 3) { float A = 1.f, B = 0.f;
#pragma unroll
                for (int s2 = 0; s2 < 4; ++s2) { const float sa = SegA[(d2 * 4 + s2) * 64 + c], sb2 = SegB[(d2 * 4 + s2) * 64 + c]; B = sa * B + sb2; A *= sa; }
                AGG[agg_idx(b, gch, d2, 0, ch)] = A; AGG[agg_idx(b, gch, d2, 1, ch)] = B; }
        } else {
#pragma unroll
            for (int s2 = 0; s2 < 3; ++s2) if (s2 < seg) hin = SegA[(d2 * 4 + s2) * 64 + c] * hin + SegB[(d2 * 4 + s2) * 64 + c];
            float hh2 = hin;
#pragma unroll
            for (int k = 0; k < 16; ++k) { const int s = seg * 16 + k; const int t = d2 ? 63 - s : s; hh2 = av[k] * hh2 + bv[k]; Bv[(d2 * 64 + t) * 64 + c] = hh2; }
        }
    }
    __syncthreads();
    if (mode == 1) {
        const int t = tid >> 3, c8 = (tid & 7) * 8; bf16_t* gp = P + (seqrow0 + t0 + t) * PW + C_AG + nb * 64 + c8;
        float gt[8]; unpack8(*(const u32x4*)gp, gt); float y[8];
#pragma unroll
        for (int i = 0; i < 8; ++i) y[i] = (Bv[t * 64 + c8 + i] + Bv[(64 + t) * 64 + c8 + i]) * gelu_tanh(gt[i]);
        *(u32x4*)gp = pack8(y);
        __syncthreads();
    }
}

template <bool B> struct BoolC { static constexpr bool value = B; };
__device__ __forceinline__ void attn_item(const Params& p, int l, LAS unsigned char* lds, int item, int dry = 0) {
    LAS bf16_t* Kt = (LAS bf16_t*)lds;
    LAS float* rpbL = (LAS float*)(lds + 73728);
    LAS float* cosT = rpbL + 960;
    LAS float* sinT = cosT + 1024;
    LAS float* gq = sinT + 1024; LAS float* gk = gq + 64;
    bf16_t* P = (bf16_t*)(PF(ws) + WS_P); const float* rope = (const float*)(PF(ws) + WS_ROPE);
    const int tid = tid_(), w = __builtin_amdgcn_readfirstlane(tid >> 6), lane = tid & 63, l16 = lane & 15, q4 = lane >> 4, hh = w >> 2, qg4 = w & 3;
    const bool isctx = item >= 512;
    int b, hp, nloc, krU; int rq[2], kq0[2]; size_t qrow0[2];
    if (!isctx) { hp = item & 3; const int rp = (item >> 2) & 15; b = item >> 6;
        rq[0] = 2 * rp; rq[1] = 2 * rp + 1; kq0[0] = min(max(rq[0] - 4, 0), 24); kq0[1] = min(max(rq[1] - 4, 0), 24);
        qrow0[0] = (size_t)b * SEQ + rq[0] * 64; qrow0[1] = qrow0[0] + 64; krU = kq0[0]; nloc = kq0[1] + 8 - kq0[0]; }
    else { const int it = item - 512; hp = it & 3; const int qt = (it >> 2) & 1; b = it >> 3; rq[0] = rq[1] = 0; kq0[0] = kq0[1] = 0; krU = 0; nloc = 0;
        qrow0[0] = (size_t)NLAT + b * CTXL + qt * 128; qrow0[1] = qrow0[0] + 64; }
    const int h = hp * 2 + hh;
    const float* prpb = PF(na_rpb);
    for (int i = tid; i < 2 * 465; i += 512) { const int h2 = i / 465, j = i - h2 * 465; rpbL[h2 * 480 + j] = prpb[(size_t)((l * 8 + hp * 2 + h2) * 465) + j]; }
    for (int i = tid; i < 1024; i += 512) { cosT[i] = rope[i]; sinT[i] = rope[1024 + i]; }
    if (tid < 64) { gq[tid] = PF(na_qg)[l * 64 + tid]; gk[tid] = PF(na_kg)[l * 64 + tid]; }
    __syncthreads();
    const int qc = qg4 * 16 + l16;
    const int glo = qg4 < 2 ? 0 : qg4 - 1, ghi = qg4 == 0 ? 1 : (qg4 == 3 ? 3 : qg4 + 1);
    unsigned mbits = 0u; const int bbase = q4 * 4 - qc;
    { const int cs0 = min(max(qc - 8, 0), 48);
#pragma unroll
      for (int g = 0; g < 4; ++g)
#pragma unroll
          for (int j = 0; j < 4; ++j) { const int kc = g * 16 + q4 * 4 + j; if (kc < cs0 || kc >= cs0 + 16) mbits |= 1u << (g * 4 + j); } }
    bf16x8 qpl[2][2], qrt[2][2];
#pragma unroll
    for (int qi = 0; qi < 2; ++qi) {
        const bf16_t* qp = P + (qrow0[qi] + qc) * PW + C_CQ + h * 64;
        float xq[16]; unpack8(*(const u32x4*)(qp + q4 * 8), xq); unpack8(*(const u32x4*)(qp + 32 + q4 * 8), xq + 8);
        float ss = 0.f;
#pragma unroll
        for (int i = 0; i < 16; ++i) ss += xq[i] * xq[i];
        ss += __shfl_xor(ss, 16); ss += __shfl_xor(ss, 32);
        const float rs = rsqrtf(ss * (1.0f / 64.0f) + 1e-6f) * 0.125f;
#pragma unroll
        for (int i = 0; i < 8; ++i) { xq[i] *= rs * gq[q4 * 8 + i]; xq[8 + i] *= rs * gq[32 + q4 * 8 + i]; }
        qpl[qi][0] = as_bf16x8(pack8(xq)); qpl[qi][1] = as_bf16x8(pack8(xq + 8));
        float xr[16];
#pragma unroll
        for (int ks = 0; ks < 2; ++ks) { const int pos = ks == 0 ? rq[qi] : qc;
#pragma unroll
            for (int jj = 0; jj < 8; ++jj) { const int fi = (q4 & 1) * 8 + jj; const float cs = cosT[pos * 16 + fi], sn = sinT[pos * 16 + fi]; const float xv = xq[ks * 8 + jj]; const float pr = __shfl_xor(xv, 32);
                xr[ks * 8 + jj] = (q4 < 2) ? (xv * cs - pr * sn) : (xv * cs + pr * sn); } }
        qrt[qi][0] = as_bf16x8(pack8(xr)); qrt[qi][1] = as_bf16x8(pack8(xr + 8));
    }
    f32x4 O[2][4];
#pragma unroll
    for (int qi = 0; qi < 2; ++qi)
#pragma unroll
        for (int i = 0; i < 4; ++i) O[qi][i] = (f32x4){0.f, 0.f, 0.f, 0.f};
    float mrun[2] = {-1e30f, -1e30f}, lsum[2] = {0.f, 0.f};
    const int pf_hh2 = tid >> 8, pf_h2 = hp * 2 + pf_hh2, pf_key = (tid & 255) >> 2, pf_seg = tid & 3, pf_vseg = (tid & 255) >> 6, pf_vkey = tid & 63;
    u32x4 pk0, pk1, pv0, pv1;
    { const size_t r0 = nloc ? (size_t)b * SEQ + krU * 64 : (size_t)NLAT + b * CTXL;
      const bf16_t* kp = P + (r0 + pf_key) * PW + C_CK + pf_h2 * 64 + pf_seg * 16; pk0 = *(const u32x4*)kp; pk1 = *(const u32x4*)(kp + 8);
      const bf16_t* vp = P + (r0 + pf_vkey) * PW + C_CV + pf_h2 * 64 + pf_vseg * 16; pv0 = *(const u32x4*)vp; pv1 = *(const u32x4*)(vp + 8); }
    const int ntot = nloc + 4;
    float gkr[16];
#pragma unroll
    for (int i = 0; i < 16; ++i) gkr[i] = gk[pf_seg * 16 + i];
    auto stage = [&](int T, int buf) {
        const bool sloc = T < nloc; const int kr = krU + T;
        LAS bf16_t* KtB = Kt + buf * (4 * 64 * 72); LAS bf16_t* VtB = KtB + 2 * 64 * 72;
        {
            const int hh2 = pf_hh2, key = pf_key, seg = pf_seg;
            float xk[16]; unpack8(pk0, xk); unpack8(pk1, xk + 8);
            float ss = 0.f;
#pragma unroll
            for (int i = 0; i < 16; ++i) ss += xk[i] * xk[i];
            ss += dpp_xor1(ss); ss += dpp_xor2(ss);
            const float rs = rsqrtf(ss * (1.0f / 64.0f) + 1e-6f);
#pragma unroll
            for (int i = 0; i < 16; ++i) xk[i] *= rs * gkr[i];
            if (sloc) { const int pos = seg < 2 ? kr : key;
#pragma unroll
                for (int i = 0; i < 16; ++i) { const float pr = dpp_xor1(xk[i]); const float cs = cosT[pos * 16 + i], sn = sinT[pos * 16 + i]; xk[i] = (seg & 1) ? (xk[i] * cs + pr * sn) : (xk[i] * cs - pr * sn); } }
            LAS bf16_t* kd = KtB + (hh2 * 64 + key) * 72 + seg * 16;
            *(LAS u32x4*)kd = pack8(xk); *(LAS u32x4*)(kd + 8) = pack8(xk + 8);
        }
        {
            const int hh2 = pf_hh2, seg = pf_vseg, key = pf_vkey;
            const u32x4 a = pv0, c = pv1;
            LAS bf16_t* vd = VtB + (hh2 * 64 + seg * 16) * 72 + key;
            vd[0 * 72] = (bf16_t)(a.x & 0xffff); vd[1 * 72] = (bf16_t)(a.x >> 16); vd[2 * 72] = (bf16_t)(a.y & 0xffff); vd[3 * 72] = (bf16_t)(a.y >> 16);
            vd[4 * 72] = (bf16_t)(a.z & 0xffff); vd[5 * 72] = (bf16_t)(a.z >> 16); vd[6 * 72] = (bf16_t)(a.w & 0xffff); vd[7 * 72] = (bf16_t)(a.w >> 16);
            vd[8 * 72] = (bf16_t)(c.x & 0xffff); vd[9 * 72] = (bf16_t)(c.x >> 16); vd[10 * 72] = (bf16_t)(c.y & 0xffff); vd[11 * 72] = (bf16_t)(c.y >> 16);
            vd[12 * 72] = (bf16_t)(c.z & 0xffff); vd[13 * 72] = (bf16_t)(c.z >> 16); vd[14 * 72] = (bf16_t)(c.w & 0xffff); vd[15 * 72] = (bf16_t)(c.w >> 16);
        }
        { const int Tn = T + 1; if (Tn < ntot) { const size_t r0 = (Tn < nloc) ? (size_t)b * SEQ + (krU + Tn) * 64 : (size_t)NLAT + b * CTXL + (Tn - nloc) * 64;
            const bf16_t* kp = P + (r0 + pf_key) * PW + C_CK + pf_h2 * 64 + pf_seg * 16; pk0 = *(const u32x4*)kp; pk1 = *(const u32x4*)(kp + 8);
            const bf16_t* vp = P + (r0 + pf_vkey) * PW + C_CV + pf_h2 * 64 + pf_vseg * 16; pv0 = *(const u32x4*)vp; pv1 = *(const u32x4*)(vp + 8); } }
    };
    auto compute = [&](auto LOC, int T, int buf) {
        constexpr bool loc = decltype(LOC)::value; const int kr = krU + T;
        const LAS bf16_t* KtB = Kt + buf * (4 * 64 * 72); const LAS bf16_t* VtB = KtB + 2 * 64 * 72;
#pragma unroll
        for (int qi = 0; qi < 2; ++qi) {
            if (loc && (kr < kq0[qi] || kr >= kq0[qi] + 8)) continue;
            f32x4 st[4];
#pragma unroll
            for (int g = 0; g < 4; ++g) { const bool use = !loc || (g >= glo && g <= ghi);
                st[g] = (f32x4){0.f, 0.f, 0.f, 0.f};
                if (use) {
#pragma unroll
                    for (int ks = 0; ks < 2; ++ks) st[g] = mfma16(*(const LAS bf16x8*)(KtB + (hh * 64 + g * 16 + l16) * 72 + ks * 32 + q4 * 8), loc ? qrt[qi][ks] : qpl[qi][ks], st[g]);
                    if (loc) { const int dr31 = (kr - rq[qi] + 7) * 31;
#pragma unroll
                        for (int j = 0; j < 4; ++j) { const float sv = st[g][j] + rpbL[hh * 480 + min(max(bbase + g * 16 + j, -15), 15) + 15 + dr31]; st[g][j] = ((mbits >> (g * 4 + j)) & 1u) ? -1e30f : sv; } }
                } else st[g] = (f32x4){-1e30f, -1e30f, -1e30f, -1e30f};
            }
            float tmax = -1e30f;
#pragma unroll
            for (int g = 0; g < 4; ++g)
#pragma unroll
                for (int j = 0; j < 4; ++j) tmax = fmaxf(tmax, st[g][j]);
            tmax = fmaxf(tmax, __shfl_xor(tmax, 16)); tmax = fmaxf(tmax, __shfl_xor(tmax, 32));
            const float mnew = fmaxf(mrun[qi], tmax); const float alpha = fexp_(mrun[qi] - mnew); mrun[qi] = mnew;
            float psum = 0.f;
#pragma unroll
            for (int g = 0; g < 4; ++g) { const bool use = !loc || (g >= glo && g <= ghi);
                if (use) {
#pragma unroll
                    for (int j = 0; j < 4; ++j) { const float pv = fexp_(st[g][j] - mnew); st[g][j] = pv; psum += pv; }
                } else st[g] = (f32x4){0.f, 0.f, 0.f, 0.f}; }
            lsum[qi] = lsum[qi] * alpha + psum;
#pragma unroll
            for (int i = 0; i < 4; ++i) O[qi][i] *= alpha;
            bf16x8 pb[2];
#pragma unroll
            for (int ks = 0; ks < 2; ++ks) { u32x4 wv; wv.x = pack2(st[2 * ks][0], st[2 * ks][1]); wv.y = pack2(st[2 * ks][2], st[2 * ks][3]); wv.z = pack2(st[2 * ks + 1][0], st[2 * ks + 1][1]); wv.w = pack2(st[2 * ks + 1][2], st[2 * ks + 1][3]); pb[ks] = as_bf16x8(wv); }
#pragma unroll
            for (int ks = 0; ks < 2; ++ks) if (!loc || (2 * ks + 1 >= glo && 2 * ks <= ghi))
#pragma unroll
                for (int dg = 0; dg < 4; ++dg) { const LAS bf16_t* vr = VtB + (hh * 64 + dg * 16 + l16) * 72 + ks * 32 + q4 * 4;
                    const u32x2 lo = *(const LAS u32x2*)vr, hi = *(const LAS u32x2*)(vr + 16); u32x4 av; av.x = lo.x; av.y = lo.y; av.z = hi.x; av.w = hi.y;
                    O[qi][dg] = mfma16(as_bf16x8(av), pb[ks], O[qi][dg]); }
        }
    };
    stage(0, 0);
    __syncthreads();
    for (int T = 0; T < nloc; ++T) {
        stage(T + 1, (T + 1) & 1);
        compute(BoolC<true>{}, T, T & 1);
        __syncthreads();
    }
    for (int T = nloc; T < ntot; ++T) {
        if (T + 1 < ntot) stage(T + 1, (T + 1) & 1);
        compute(BoolC<false>{}, T, T & 1);
        __syncthreads();
    }
#pragma unroll
    for (int qi = 0; qi < 2; ++qi) {
        float ls = lsum[qi]; ls += __shfl_xor(ls, 16); ls += __shfl_xor(ls, 32);
        const float inv = 1.0f / ls;
        bf16_t* op = dry ? ((bf16_t*)(PF(ws) + WS_DUMMY) + (size_t)(blockIdx.x & 63) * 16384 + (size_t)((qi * 8 + w) * 16 + l16) * 64) : (P + (qrow0[qi] + qc) * PW + C_CQ + h * 64);
#pragma unroll
        for (int dg = 0; dg < 4; ++dg) { u32x2 wv; wv.x = pack2(O[qi][dg][0] * inv, O[qi][dg][1] * inv); wv.y = pack2(O[qi][dg][2] * inv, O[qi][dg][3] * inv); *(u32x2*)(op + dg * 16 + q4 * 4) = wv; }
    }
    __syncthreads();
}

__device__ __forceinline__ void hgrn_stage(const bf16_t* P, LAS unsigned char* lds, int w, int lane, size_t row0, int dir, int h) {
#pragma unroll
    for (int i = 0; i < 2; ++i) { const int blk = i * 8 + w; const int t = blk * 4 + (lane >> 4); const bf16_t* rp = P + (row0 + (dir ? 63 - t : t)) * PW + (lane & 15) * 8;
        __builtin_amdgcn_global_load_lds((const unsigned*)(rp + C_BQ + h * 128), (LAS unsigned*)(lds + 118784 + blk * 1024), 16, 0, 0);
        __builtin_amdgcn_global_load_lds((const unsigned*)(rp + C_BF + dir * 512 + h * 128), (LAS unsigned*)(lds + 135168 + blk * 1024), 16, 0, 0); }
}
__device__ __forceinline__ void hgrn_chain(const Params& p, int l, LAS unsigned char* lds, int chain, int dry = 0) {
    LAS bf16_t* Q0 = (LAS bf16_t*)lds;
    LAS bf16_t* KP = (LAS bf16_t*)(lds + 17408);
    LAS bf16_t* SB = (LAS bf16_t*)(lds + 34816);
    LAS bf16_t* KDT = (LAS bf16_t*)(lds + 69632);
    LAS bf16_t* VT = (LAS bf16_t*)(lds + 88064);
    LAS bf16_t* ATT = (LAS bf16_t*)(lds + 106496);
    LAS float* TOT = (LAS float*)(lds + 115712);
    LAS float* DD = (LAS float*)(lds + 117760);
    const LAS bf16_t* SQ = (const LAS bf16_t*)(lds + 118784);
    const LAS bf16_t* SF = (const LAS bf16_t*)(lds + 135168);
    bf16_t* P = (bf16_t*)(PF(ws) + WS_P);
    const int tid = tid_(), w = __builtin_amdgcn_readfirstlane(tid >> 6), lane = tid & 63, l16 = lane & 15, q4 = lane >> 4;
    const int dir = chain & 1, h = (chain >> 1) & 3, b = chain >> 3;
    const int d = tid & 127, sb = tid >> 7;
    float lbv = 0.f;
    if (l > 0) { const float x0 = PF(hg_lb)[(dir * 2 + 0) * 512 + h * 128 + d], x1 = PF(hg_lb)[(dir * 2 + 1) * 512 + h * 128 + d]; lbv = 1.0f / (1.0f + expf(x0 - x1)); }
    for (int i = tid; i < 64 * 72 / 2; i += 512) ((LAS unsigned*)ATT)[i] = 0u;
    f32x4 S[8];
#pragma unroll
    for (int i = 0; i < 8; ++i) S[i] = (f32x4){0.f, 0.f, 0.f, 0.f};
    { const int gch0 = dir == 0 ? 0 : 3; hgrn_stage(P, lds, w, lane, (size_t)NLAT + b * CTXL + gch0 * 64, dir, h); }
    asm volatile("s_waitcnt vmcnt(0)" ::: "memory");
    __syncthreads();
    for (int ci = 0; ci < 36; ++ci) {
        const int gch = dir == 0 ? ci : (ci < 4 ? 3 - ci : 39 - ci);
        const bool isctx = gch < 4; const int chunk = isctx ? gch : gch - 4;
        const size_t row0 = isctx ? (size_t)NLAT + b * CTXL + chunk * 64 : (size_t)b * SEQ + chunk * 64;
        float bl[16], qv[16], kv[16]; float run = 0.f;
        {
            unsigned vraw[16];
            { const bf16_t* vp = P + (row0 + (dir ? 63 - sb * 16 : sb * 16)) * PW + C_BI + h * 128 + d; const long vstep = dir ? -(long)PW : (long)PW;
#pragma unroll
              for (int ii = 0; ii < 16; ++ii) { vraw[ii] = *vp; vp += vstep; } }
#pragma unroll
            for (int eg = 0; eg < 8; ++eg) { u32x2 wv; wv.x = pack2(S[eg][0], S[eg][1]); wv.y = pack2(S[eg][2], S[eg][3]); *(LAS u32x2*)(SB + (eg * 16 + l16) * 136 + w * 16 + q4 * 4) = wv; }
#pragma unroll
            for (int ii = 0; ii < 16; ++ii) { const int t = sb * 16 + ii;
                const float fr = bf2f(SF[t * 128 + d]), qr = bf2f(SQ[t * 128 + d]);
                const float sg = __builtin_amdgcn_rcpf(1.0f + fexp_(-fr)); const float f = lbv + (1.0f - lbv) * sg; run += flog_(f); bl[ii] = run; kv[ii] = 1.0f - f; qv[ii] = qr * __builtin_amdgcn_rcpf(1.0f + fexp_(-qr)); }
            TOT[sb * 128 + d] = run;
            u32x4 v0, v1; v0.x = vraw[0] | (vraw[1] << 16); v0.y = vraw[2] | (vraw[3] << 16); v0.z = vraw[4] | (vraw[5] << 16); v0.w = vraw[6] | (vraw[7] << 16);
            v1.x = vraw[8] | (vraw[9] << 16); v1.y = vraw[10] | (vraw[11] << 16); v1.z = vraw[12] | (vraw[13] << 16); v1.w = vraw[14] | (vraw[15] << 16);
            *(LAS u32x4*)(VT + d * 72 + sb * 16) = v0; *(LAS u32x4*)(VT + d * 72 + sb * 16 + 8) = v1;
        }
        __syncthreads();
        if (ci < 35) { const int cn = ci + 1; const int gn = dir == 0 ? cn : (cn < 4 ? 3 - cn : 39 - cn); const bool cx = gn < 4; const int ck = cx ? gn : gn - 4;
            hgrn_stage(P, lds, w, lane, cx ? (size_t)NLAT + b * CTXL + ck * 64 : (size_t)b * SEQ + ck * 64, dir, h); }
        {
            const float t0 = TOT[d], t1 = TOT[128 + d], t2 = TOT[256 + d], t3 = TOT[384 + d];
            const float Bs1 = t0, Bs2 = t0 + t1, Bs3 = Bs2 + t2, total = Bs3 + t3;
            const float Bsb = sb == 0 ? 0.f : (sb == 1 ? Bs1 : (sb == 2 ? Bs2 : Bs3));
            const float eB = fexp_(Bsb), eT = fexp_(total);
            float kd[16];
#pragma unroll
            for (int ii = 0; ii < 16; ++ii) { const float e0 = fexp_(bl[ii]); Q0[(sb * 16 + ii) * 136 + d] = (bf16_t)pack2(qv[ii] * e0 * eB, 0.f);
                const float kp = kv[ii] * fexp_(fminf(-(Bsb + bl[ii]), 80.f)); KP[(sb * 16 + ii) * 136 + d] = (bf16_t)pack2(kp, 0.f); kd[ii] = kp * eT; }
            *(LAS u32x4*)(KDT + d * 72 + sb * 16) = pack8(kd); *(LAS u32x4*)(KDT + d * 72 + sb * 16 + 8) = pack8(kd + 8);
            if (sb == 0) DD[d] = eT;
        }
        __syncthreads();
        const bool need_o = !(l == 1 && isctx);
        if (need_o)
#pragma unroll
        for (int k2 = 0; k2 < 2; ++k2) { const int idx = w + 8 * k2;
            if (idx < 10) { const int i = idx < 1 ? 0 : (idx < 3 ? 1 : (idx < 6 ? 2 : 3)); const int j = idx - i * (i + 1) / 2;
                f32x4 sc = (f32x4){0.f, 0.f, 0.f, 0.f};
                const LAS bf16_t* qb = Q0 + (i * 16 + l16) * 136 + q4 * 8; const LAS bf16_t* kb = KP + (j * 16 + l16) * 136 + q4 * 8;
#pragma unroll
                for (int ks = 0; ks < 4; ++ks) sc = mfma16(*(const LAS bf16x8*)(qb + ks * 32), *(const LAS bf16x8*)(kb + ks * 32), sc);
#pragma unroll
                for (int jj = 0; jj < 4; ++jj) { const float v = (i == j && l16 > q4 * 4 + jj) ? 0.f : sc[jj]; ATT[(i * 16 + q4 * 4 + jj) * 72 + j * 16 + l16] = (bf16_t)pack2(v, 0.f); } } }
        __syncthreads();
        if (need_o) {
            bf16x8 SBf[4], VTf[2];
#pragma unroll
            for (int ks = 0; ks < 4; ++ks) SBf[ks] = *(const LAS bf16x8*)(SB + (w * 16 + l16) * 136 + ks * 32 + q4 * 8);
#pragma unroll
            for (int ks = 0; ks < 2; ++ks) VTf[ks] = *(const LAS bf16x8*)(VT + (w * 16 + l16) * 72 + ks * 32 + q4 * 8);
#pragma unroll
            for (int i = 0; i < 4; ++i) { f32x4 oa = (f32x4){0.f, 0.f, 0.f, 0.f};
#pragma unroll
                for (int ks = 0; ks < 4; ++ks) oa = mfma16(SBf[ks], *(const LAS bf16x8*)(Q0 + (i * 16 + l16) * 136 + ks * 32 + q4 * 8), oa);
#pragma unroll
                for (int ks = 0; ks < 2; ++ks) oa = mfma16(VTf[ks], *(const LAS bf16x8*)(ATT + (i * 16 + l16) * 72 + ks * 32 + q4 * 8), oa);
                const int t = i * 16 + l16; u32x2 wv; wv.x = pack2(oa[0], oa[1]); wv.y = pack2(oa[2], oa[3]);
                bf16_t* od = dry ? ((bf16_t*)(PF(ws) + WS_DUMMY) + (size_t)chain * 8192 + t * 128 + w * 16 + q4 * 4) : (P + (row0 + (dir ? 63 - t : t)) * PW + C_BF + dir * 512 + h * 128 + w * 16 + q4 * 4);
                *(u32x2*)od = wv; }
        }
        {
            const f32x4 dd = *(const LAS f32x4*)(DD + w * 16 + q4 * 4);
#pragma unroll
            for (int eg = 0; eg < 8; ++eg) S[eg] *= dd;
#pragma unroll
            for (int ks = 0; ks < 2; ++ks) { const bf16x8 A = *(const LAS bf16x8*)(KDT + (w * 16 + l16) * 72 + ks * 32 + q4 * 8);
#pragma unroll
                for (int eg = 0; eg < 8; ++eg) S[eg] = mfma16(A, *(const LAS bf16x8*)(VT + (eg * 16 + l16) * 72 + ks * 32 + q4 * 8), S[eg]); }
        }
        asm volatile("s_waitcnt vmcnt(0)" ::: "memory");
        __syncthreads();
    }
}

__global__ void __launch_bounds__(512, 2) fwd_megakernel(Params p) {
    extern __shared__ __attribute__((aligned(16))) unsigned char lds_raw[];
    LAS unsigned char* lds = (LAS unsigned char*)lds_raw;
    cg::grid_group grid = cg::this_grid();
    volatile LAS unsigned* xst = (volatile LAS unsigned*)(lds + LDS_BYTES - 16);
    if (threadIdx.x == 0) { xst[0] = 0u; xst[1] = 0u; xst[2] = 0u; xst[3] = 0u; }
    __syncthreads();
    const XcdBarrier xbar = xcd_barrier_post((unsigned*)(PF(ws) + WS_BAR), xst);
    const int G = gridDim.x, c = blockIdx.x;

    phase_mod(p, lds); __syncthreads();
    phase_rope(p);
    phase_convert(p, 0, lds);
    if (PF(ws) == nullptr) grid.sync();
    xcd_barrier(xbar);
#define WSP(T, off) ((T*)(PF(ws) + (off)))
    for (int l = 0; l < 2; ++l) {
        const bool lastl = (l == 1);
        const int Mrest = lastl ? NLAT : NTOK;
        if (l > 0) phase_convert(p, l, lds);
        phase_norm(p, l, l == 0 ? PF(x) : PF(out), l == 0 ? PF(ctx) : WSP(const float, WS_HC), PF(norm1_g) + l * DM, 0, NTOK,
                   (l > 0 && G == 256) ? (const float*)(PF(ws) + WS_P + (size_t)NTOK * DFF * 2) : nullptr, WSP(const float, WS_MOD) + (size_t)((l > 0 ? l - 1 : 0) * 9 + 8) * 6144 + 5120);
        xcd_barrier(xbar);

        { pg8::Gemm g{WSP(bf16_t, WS_U), WSP(bf16_t, WS_WIN), DM, DM, DM}; pg8::Sched S; S.init(NTOK, PW, G, c, DM, DM); pg8::EpiStore<0> E{WSP(bf16_t, WS_P), PW}; pg8::gemm_phase(lds, g, S, E); }
        xcd_barrier(xbar);
        {
            int staged = -1; float kc[3] = {0.f, 0.f, 0.f}; const LruPtrs lp = lru_ptrs();
            if (c < 64) { hgrn_chain(p, l, lds, c);
                sub_barrier((unsigned*)(PF(ws) + WS_BAR) + 3776 + 16 * ((c >> 3) + 8 * l), 8u); phase_hg_final(p, l, c >> 3, c & 7); }
            else { const int cc = c - 64, GG = G - 64; const int nA = lastl ? 512 : 576;
                for (int it = cc; it < nA; it += GG) attn_item(p, l, lds, it);
                for (int it = cc; it < 2304; it += GG) lru_tile(p, l, lds, it, 0, staged, lp, kc); }
            sub_barrier((unsigned*)(PF(ws) + WS_BAR) + 3520 + 64 * (2 * l + 1), (unsigned)G);
            if ((c & 7) != (staged & 7) || staged < 0) staged = -1;
            for (int it = c; it < 2304; it += G) lru_tile(p, l, lds, it, 1, staged, lp, kc);
        }
        xcd_barrier(xbar);
        { pg8::Gemm g{WSP(bf16_t, WS_U), WSP(bf16_t, WS_WIN) + (size_t)PW * DM, DM, DM, DM}; pg8::Sched S; S.init(Mrest, 3072, G, c, DM, DM); pg8::EpiStore<1> E{WSP(bf16_t, WS_P), PW}; pg8::gemm_phase(lds, g, S, E); }
        xcd_barrier(xbar);
        { pg8::Gemm g{WSP(bf16_t, WS_P), WSP(bf16_t, WS_WB), PW, 512, 512}; pg8::MergeSched S; S.base.init(Mrest, DM, G, c, PW, 512);
          pg8::EpiMerge E{WSP(bf16_t, WS_P), WSP(bf16_t, WS_U)}; pg8::gemm_phase(lds, g, S, E); }
        xcd_barrier(xbar);
        { pg8::Gemm g{WSP(bf16_t, WS_U), WSP(bf16_t, WS_WO), DM, DM, DM};
          pg8::EpiResid E{l == 0 ? PF(x) : PF(out), l == 0 ? PF(ctx) : WSP(const float, WS_HC), PF(out), WSP(float, WS_HC), WSP(const float, WS_MOD) + (size_t)l * 9 * 6144 + 2048, WSP(float, WS_P)};
          if (!lastl && G == 256) { pg8::SplitSched S; S.base.init(NLAT, DM, G, c, DM, DM); S.sk = 256; pg8::gemm_phase(lds, g, S, E); }
          else { pg8::Sched S; S.init(Mrest, DM, G, c, DM, DM); pg8::gemm_phase(lds, g, S, E); } }
        xcd_barrier(xbar);
        if (!lastl && G == 256) phase_norm(p, l, PF(out), l == 0 ? PF(ctx) : WSP(const float, WS_HC), PF(norm2_g) + l * DM, 3072, Mrest, WSP(const float, WS_P), WSP(const float, WS_MOD) + (size_t)(l * 9 + 8) * 6144 + 2048, WSP(float, WS_HC));
        else phase_norm(p, l, PF(out), WSP(const float, WS_HC), PF(norm2_g) + l * DM, 3072, Mrest);
        xcd_barrier(xbar);
        { pg8::Gemm g{WSP(bf16_t, WS_U), WSP(bf16_t, WS_W1), DM, DM, DM}; pg8::Sched S; S.init(Mrest, DFF, G, c, DM, DM); pg8::EpiStore<2> E{WSP(bf16_t, WS_P), DFF}; pg8::gemm_phase(lds, g, S, E); }
        xcd_barrier(xbar);
        { pg8::Gemm g{WSP(bf16_t, WS_P), WSP(bf16_t, WS_W2), DFF, DFF, DFF};
          float* slab = (float*)(PF(ws) + WS_P + (size_t)NTOK * DFF * 2);
          pg8::EpiResid E{PF(out), WSP(const float, WS_HC), PF(out), WSP(float, WS_HC), WSP(const float, WS_MOD) + (size_t)l * 9 * 6144 + 5120, slab};
          if (!lastl && G == 256) { pg8::SplitSched S; S.base.init(NLAT, DM, G, c, DFF, DFF); S.sk = 1024; pg8::gemm_phase(lds, g, S, E); }
          else { pg8::Sched S; S.init(Mrest, DM, G, c, DFF, DFF); pg8::gemm_phase(lds, g, S, E); } }
        if (!lastl) xcd_barrier(xbar);
    }
}

extern "C" void kernel_launch(void* const* d_in, const int* in_sizes, int n_in, void* d_out, int out_size, void* d_ws, size_t ws_size, hipStream_t stream) {
    static int grid_blocks = 0;
    if (grid_blocks == 0) {
        int dev = 0, cus = 0, per_cu = 0;
        hipGetDevice(&dev);
        hipDeviceGetAttribute(&cus, hipDeviceAttributeMultiprocessorCount, dev);
        hipFuncSetAttribute((const void*)fwd_megakernel, hipFuncAttributeMaxDynamicSharedMemorySize, LDS_BYTES);
        hipOccupancyMaxActiveBlocksPerMultiprocessor(&per_cu, (const void*)fwd_megakernel, 512, LDS_BYTES);
        if (per_cu < 1 || n_in != 25 || ws_size < WS_END) { fprintf(stderr, "kernel_launch: cannot launch (per_cu %d, n_in %d, ws %zu need %zu)\n", per_cu, n_in, ws_size, (size_t)WS_END); grid_blocks = -1; }
        else grid_blocks = cus;
    }
    if (grid_blocks < 0) return;
    hipMemsetAsync((char*)d_ws + WS_BAR, 0, 16384, stream);
    Params p{};
    const float** pp = (const float**)&p;
    for (int i = 0; i < 25; ++i) pp[i] = (const float*)d_in[i];
    p.out = (float*)d_out; p.ws = (unsigned char*)d_ws;
    void* args[] = {&p};
    hipError_t e = hipLaunchCooperativeKernel((const void*)fwd_megakernel, dim3(grid_blocks), dim3(512), args, LDS_BYTES, stream);
    if (e != hipSuccess) fprintf(stderr, "cooperative launch failed: %s (grid %d)\n", hipGetErrorString(e), grid_blocks);
}
```

```cpp
#include <hip/hip_runtime.h>
#include <hip/hip_cooperative_groups.h>
#include <stdint.h>
#include <stdio.h>
namespace cg = cooperative_groups;

#define LAS __attribute__((address_space(3)))
typedef unsigned short bf16_t;
typedef short bf16x8 __attribute__((ext_vector_type(8)));
typedef float f32x4 __attribute__((ext_vector_type(4)));
typedef unsigned u32x4 __attribute__((ext_vector_type(4)));
typedef unsigned u32x2 __attribute__((ext_vector_type(2)));

constexpr int DM = 1024, NB = 8, SEQ = 2048, CTXL = 256, NLAT = NB * SEQ, NCTX = NB * CTXL, NTOK = NLAT + NCTX;
constexpr int PW = 5120, DIN = 8192, DFF = 4096;
constexpr int C_AX = 0, C_AG = 512, C_BQ = 1024, C_BF = 1536, C_BI = 2560, C_BO = 3072, C_CQ = 3584, C_CK = 4096, C_CV = 4608;
constexpr int LDS_BYTES = 163840;
constexpr size_t WS_WIN = 0;
constexpr size_t WS_WB = WS_WIN + (size_t)DIN * DM * 2;
constexpr size_t WS_WO = WS_WB + (size_t)3 * DM * 512 * 2;
constexpr size_t WS_W1 = WS_WO + (size_t)DM * DM * 2;
constexpr size_t WS_W2 = WS_W1 + (size_t)DFF * DM * 2;
constexpr size_t WS_U = WS_W2 + (size_t)DM * DFF * 2;
constexpr size_t WS_P = WS_U + (size_t)NTOK * DM * 2;
constexpr size_t WS_HC = WS_P + (size_t)NTOK * PW * 2;
constexpr size_t WS_MOD = WS_HC + (size_t)NCTX * DM * 4;
constexpr size_t WS_AGG = WS_MOD + (size_t)2 * 9 * 6144 * 4;
constexpr size_t WS_ROPE = WS_AGG + (size_t)NB * 36 * 2 * 2 * 512 * 4;
constexpr size_t WS_DUMMY = WS_ROPE + 2048 * 4;
constexpr size_t WS_BAR = WS_DUMMY + (2u << 20);
constexpr size_t WS_END = WS_BAR + 16384;

struct Params {
    const float *x, *c, *ctx, *c_ctx, *ada_w, *ada_b, *norm1_g, *norm2_g, *w_in, *conv_w, *conv_b, *lru_wa, *lru_ba, *lru_wx, *lru_bx, *lru_lambda,
        *hg_lb, *hg_norm_g, *na_qg, *na_kg, *na_rpb, *w_branch, *w_out, *ffn_w1, *ffn_w2;
    float* out; unsigned char* ws;
};


__device__ __forceinline__ unsigned long long ldkarg(int off) { unsigned long long v = 0;
#if defined(__HIP_DEVICE_COMPILE__)
    auto kp = __builtin_amdgcn_kernarg_segment_ptr();
    asm volatile("s_load_dwordx2 %0, %1, %2\n\ts_waitcnt lgkmcnt(0)" : "=s"(v) : "s"(kp), "s"(off));
#endif
    return v; }
template <class T> struct rm_ptr; template <class T> struct rm_ptr<T*> { typedef T type; };
template <class T> __device__ __forceinline__ T* as_global_ptr(unsigned long long v) { return (T*)(__attribute__((address_space(1))) T*)v; }
#define PF(f) (as_global_ptr<rm_ptr<decltype(Params::f)>::type>(ldkarg((int)__builtin_offsetof(Params, f))))

#define GAS __attribute__((address_space(1)))
template <class T> __device__ __forceinline__ GAS T* lnd(T* p) { asm volatile("" : "+v"(p)); return (GAS T*)p; }
__device__ __forceinline__ int tid_() { int t = threadIdx.x; asm volatile("" : "+v"(t)); return t; }
__device__ __forceinline__ float bf2f(unsigned v) { return __uint_as_float(v << 16); }
__device__ __forceinline__ float bflo(unsigned w) { return __uint_as_float(w << 16); }
__device__ __forceinline__ float bfhi(unsigned w) { return __uint_as_float(w & 0xffff0000u); }
__device__ __forceinline__ unsigned f2bf(float f) { unsigned u = __float_as_uint(f); u += 0x7fffu + ((u >> 16) & 1u); return u >> 16; }
typedef __bf16 bf16x2_t __attribute__((ext_vector_type(2)));
typedef float f32x2_t __attribute__((ext_vector_type(2)));
__device__ __forceinline__ unsigned pack2(float lo, float hi) { f32x2_t v = {lo, hi}; bf16x2_t b = __builtin_convertvector(v, bf16x2_t); union { bf16x2_t b; unsigned u; } t; t.b = b; return t.u; }
__device__ __forceinline__ float fexp_(float x) { return __builtin_amdgcn_exp2f(x * 1.4426950408889634f); }
__device__ __forceinline__ float flog_(float x) { return __builtin_amdgcn_logf(x) * 0.6931471805599453f; }
__device__ __forceinline__ float dpp_xor1(float v) { return __int_as_float(__builtin_amdgcn_mov_dpp(__float_as_int(v), 0xB1, 0xF, 0xF, true)); }
__device__ __forceinline__ float dpp_xor2(float v) { return __int_as_float(__builtin_amdgcn_mov_dpp(__float_as_int(v), 0x4E, 0xF, 0xF, true)); }
__device__ __forceinline__ float sigmoidf_(float x) { return __builtin_amdgcn_rcpf(1.0f + fexp_(-x)); }
__device__ __forceinline__ f32x4 mfma16(bf16x8 a, bf16x8 b, f32x4 c) { return __builtin_amdgcn_mfma_f32_16x16x32_bf16(a, b, c, 0, 0, 0); }
__device__ __forceinline__ bf16x8 as_bf16x8(u32x4 v) { union { u32x4 u; bf16x8 b; } t; t.u = v; return t.b; }
__device__ __forceinline__ void unpack8(u32x4 w, float* o) { o[0] = bflo(w.x); o[1] = bfhi(w.x); o[2] = bflo(w.y); o[3] = bfhi(w.y); o[4] = bflo(w.z); o[5] = bfhi(w.z); o[6] = bflo(w.w); o[7] = bfhi(w.w); }
__device__ __forceinline__ u32x4 pack8(const float* v) { u32x4 w; w.x = pack2(v[0], v[1]); w.y = pack2(v[2], v[3]); w.z = pack2(v[4], v[5]); w.w = pack2(v[6], v[7]); return w; }

namespace pg8 {
constexpr int BM = 256, BK = 64, HALF = 128, HTB = HALF * BK * 2, NXCD = 8, WGM = 4;
__device__ __forceinline__ int lds_byte(int r, int c) { const int st = (r >> 4) * 2 + (c >> 5), rr = r & 15, cc = c & 31, ob = rr * 64 + cc * 2; return st * 1024 + (ob ^ (((ob >> 9) & 1) << 5)); }
__device__ __forceinline__ void stage_rc(int b, int& R, int& C) { const int st = b / 1024, sb = b % 1024, swz = sb ^ (((sb >> 9) & 1) << 5); R = (st >> 1) * 16 + swz / 64; C = (st & 1) * 32 + (swz % 64) / 2; }
__device__ __forceinline__ int perm32(int rho) { const int n = rho >> 4, i = rho & 15; return 8 * (i >> 2) + 4 * n + (i & 3); }

struct Unit { int pm, pn, sub, nt; size_t aoff, boff; };
struct Gemm { const bf16_t* A; const bf16_t* Bt; int lda, ldb, K; };
struct Sched {
    int nM, nN, nwg, G, c, lda, ldb, nt;
    __device__ void init(int M, int N, int G_, int c_, int lda_, int ldb_) { nM = M / BM; nN = N / BM; nwg = nM * nN; G = G_; c = c_; lda = lda_; ldb = ldb_; nt = 0; }
    __device__ bool next(int i, Unit& u) const {
        const long L = (long)i * G + c; if (L >= nwg) return false;
        int wgid = (int)L; { const int q = nwg / NXCD, r = nwg % NXCD, xcd = wgid % NXCD, off = wgid / NXCD; wgid = (xcd < r ? xcd * (q + 1) : r * (q + 1) + (xcd - r) * q) + off; }
        const int nig = WGM * nN, gid = wgid / nig, fm = gid * WGM, gsz = (nM - fm) < WGM ? (nM - fm) : WGM;
        u.pm = fm + ((wgid % nig) % gsz); u.pn = (wgid % nig) / gsz; u.sub = 0; u.nt = nt;
        u.aoff = (size_t)u.pm * BM * lda * 2;
        u.boff = (size_t)u.pn * BM * ldb * 2;
        return true;
    }
};

template <int ACT> struct EpiStore {
    static constexpr bool PERM = true;
    bf16_t* O; int ldc;
    __device__ __forceinline__ void operator()(const f32x4 (&acc)[2][2][4][2], const Unit& u, int wr, int wc, int fr, int fq) const {
        const int row0 = u.pm * BM + wr * 64 + fr; int colt = u.pn * BM;
        if (ACT == 1) colt = (colt < 2048) ? (1024 + colt) : (2048 + colt);
        const int col0 = colt + wc * 32 + 8 * fq;
#pragma unroll
        for (int ai = 0; ai < 2; ++ai)
#pragma unroll
            for (int m = 0; m < 4; ++m) { GAS bf16_t* rowp = lnd(O + (size_t)(row0 + ai * HALF + m * 16) * ldc + col0);
#pragma unroll
                for (int bj = 0; bj < 2; ++bj) { f32x4 v0 = acc[ai][bj][m][0], v1 = acc[ai][bj][m][1];
                    if (ACT == 1) {
#pragma unroll
                        for (int j = 0; j < 4; ++j) { v0[j] = sigmoidf_(v0[j]); v1[j] = sigmoidf_(v1[j]); } }
                    if (ACT == 2) {
#pragma unroll
                        for (int j = 0; j < 4; ++j) { float a = fmaxf(v0[j], 0.f), b = fmaxf(v1[j], 0.f); v0[j] = a * a; v1[j] = b * b; } }
                    u32x4 w; w.x = pack2(v0[0], v0[1]); w.y = pack2(v0[2], v0[3]); w.z = pack2(v1[0], v1[1]); w.w = pack2(v1[2], v1[3]);
                    *(GAS u32x4*)(rowp + bj * HALF) = w; } }
    }
};
struct EpiMerge {
    static constexpr bool PERM = true;
    const bf16_t* P; bf16_t* U;
    __device__ __forceinline__ void operator()(const f32x4 (&acc)[2][2][4][2], const Unit& u, int wr, int wc, int fr, int fq) const {
        const int row0 = u.pm * BM + wr * 64 + fr; const int col0 = u.pn * BM + wc * 32 + 8 * fq;
        const int sub = u.sub; const int gcol = sub * 1024 + u.pn * BM; const int gd = ((gcol < 2048) ? (1024 + gcol) : (2048 + gcol)) + wc * 32 + 8 * fq;
        const bool addp = sub > 0;
#pragma unroll
        for (int ai = 0; ai < 2; ++ai)
#pragma unroll
            for (int m = 0; m < 4; ++m) { const size_t row = (size_t)(row0 + ai * HALF + m * 16); const GAS bf16_t* gp = lnd(P + row * PW + gd); GAS bf16_t* up = lnd(U + row * DM + col0);
#pragma unroll
                for (int bj = 0; bj < 2; ++bj) { const u32x4 gw = *(const GAS u32x4*)(gp + bj * HALF);
                    f32x4 a0 = acc[ai][bj][m][0], a1 = acc[ai][bj][m][1];
                    a0[0] *= bflo(gw.x); a0[1] *= bfhi(gw.x); a0[2] *= bflo(gw.y); a0[3] *= bfhi(gw.y); a1[0] *= bflo(gw.z); a1[1] *= bfhi(gw.z); a1[2] *= bflo(gw.w); a1[3] *= bfhi(gw.w);
                    if (addp) { const u32x4 pw = *(const GAS u32x4*)(up + bj * HALF);
                        a0[0] += bflo(pw.x); a0[1] += bfhi(pw.x); a0[2] += bflo(pw.y); a0[3] += bfhi(pw.y); a1[0] += bflo(pw.z); a1[1] += bfhi(pw.z); a1[2] += bflo(pw.w); a1[3] += bfhi(pw.w); }
                    u32x4 o; o.x = pack2(a0[0], a0[1]); o.y = pack2(a0[2], a0[3]); o.z = pack2(a1[0], a1[1]); o.w = pack2(a1[2], a1[3]);
                    *(GAS u32x4*)(up + bj * HALF) = o; } }
    }
};
struct EpiResid {
    static constexpr bool PERM = true;
    const float* inL; const float* inC; float* outL; float* outC; const float* mod;
    float* slab;
    __device__ __forceinline__ void operator()(const f32x4 (&acc)[2][2][4][2], const Unit& u, int wr, int wc, int fr, int fq) const {
        if (u.sub >= 1) {
            const int row0 = (u.pm - 64) * BM + wr * 64 + fr, col0 = u.pn * BM + wc * 32 + 8 * fq; float* sl = slab + (size_t)(u.sub - 1) * NCTX * DM;
#pragma unroll
            for (int ai = 0; ai < 2; ++ai)
#pragma unroll
                for (int m = 0; m < 4; ++m)
#pragma unroll
                    for (int bj = 0; bj < 2; ++bj) { GAS float* op = lnd(sl + (size_t)(row0 + ai * HALF + m * 16) * DM + col0 + bj * HALF); *(GAS f32x4*)op = acc[ai][bj][m][0]; *(GAS f32x4*)(op + 4) = acc[ai][bj][m][1]; }
            return;
        }
        const bool lat = u.pm < 64; const int rbase = lat ? u.pm * BM : (u.pm - 64) * BM;
        const float* in = lat ? inL : inC; float* out = lat ? outL : outC;
        const int row0 = rbase + wr * 64 + fr, col0 = u.pn * BM + wc * 32 + 8 * fq;
        const float* gt = mod + (size_t)(lat ? (u.pm >> 3) : 8) * 6144 + col0;
#pragma unroll
        for (int bj = 0; bj < 2; ++bj) { const f32x4 g0 = *(const f32x4*)(gt + bj * HALF), g1 = *(const f32x4*)(gt + bj * HALF + 4);
#pragma unroll
            for (int ai = 0; ai < 2; ++ai)
#pragma unroll
                for (int m = 0; m < 4; ++m) { const size_t ro = (size_t)(row0 + ai * HALF + m * 16) * DM + col0 + bj * HALF;
                    const GAS float* ip = lnd(in + ro); GAS float* op = lnd(out + ro); const f32x4 i0 = *(const GAS f32x4*)ip, i1 = *(const GAS f32x4*)(ip + 4);
                    *(GAS f32x4*)op = i0 + g0 * acc[ai][bj][m][0]; *(GAS f32x4*)(op + 4) = i1 + g1 * acc[ai][bj][m][1]; } }
    }
};

struct MergeSched {
    Sched base;
    __device__ bool next(int i, Unit& u) const {
        const int r = i / 3, n = i - 3 * r;
        if (!base.next(r, u)) return false;
        u.sub = n; u.aoff += (size_t)(n == 0 ? C_AG : C_BO + (n - 1) * 512) * 2; u.boff += (size_t)n * DM * 512 * 2;
        return true;
    }
};
struct SplitSched {
    Sched base;
    int sk;
    __device__ bool next(int i, Unit& u) const {
        if (base.next(i, u)) return true;
        const int nfull = (base.nwg - base.c + base.G - 1) / base.G;
        const int k = i - nfull; const int un = k * base.G + base.c; if (k < 0 || un >= 128) return false;
        const int ct = un >> 2, sl = un & 3; u.pm = 64 + (ct >> 2); u.pn = ct & 3; u.sub = 1 + sl; u.nt = sk / BK;
        u.aoff = (size_t)u.pm * BM * base.lda * 2 + (size_t)sl * sk * 2; u.boff = (size_t)u.pn * BM * base.ldb * 2 + (size_t)sl * sk * 2;
        return true;
    }
};
template <class Epi, class Sch>
__device__ __forceinline__ void gemm_phase(LAS unsigned char* lds, const Gemm g, const Sch& S, const Epi& E) {
    const int tid = tid_(), wid = __builtin_amdgcn_readfirstlane(tid >> 6), lane = tid & 63, wr = wid >> 2, wc = wid & 3, fr = lane & 15, fq = lane >> 4;
    const int K = g.K;
    unsigned voffA[2], voffB[2];
#pragma unroll
    for (int i = 0; i < 2; ++i) { int R, C; stage_rc(tid * 16 + i * 8192, R, C); const int Rb = Epi::PERM ? ((R & ~31) + perm32(R & 31)) : R;
        voffA[i] = (unsigned)(R * g.lda + C) * 2u; voffB[i] = (unsigned)(Rb * g.ldb + C) * 2u; }
    const size_t kstep = (size_t)(BK * 2);
    const size_t hstepA = (size_t)HALF * g.lda * 2, hstepB = (size_t)HALF * g.ldb * 2;
    const unsigned ldsw = (unsigned)wid * 1024u;
    const int aoff = lds_byte(wr * 64 + fr, fq * 8), boff = lds_byte(wc * 32 + fr, fq * 8);
#define PG8_SA(b, h) (((b) * 2 + (h)) * HTB)
#define PG8_SB(b, h) ((4 + (b) * 2 + (h)) * HTB)
#define PG8_STAGE(bufoff, gbase, voff) do { _Pragma("unroll") for (int _i = 0; _i < 2; ++_i) \
        __builtin_amdgcn_global_load_lds((const unsigned*)((const char*)(gbase) + (voff)[_i]), (LAS unsigned*)(lds + (bufoff) + ldsw + _i * 8192), 16, 0, 0); } while (0)
#define PG8_LDA(dst, b, h) do { _Pragma("unroll") for (int m = 0; m < 4; ++m) _Pragma("unroll") for (int k = 0; k < 2; ++k) dst[m][k] = *(const LAS bf16x8*)(lds + PG8_SA(b, h) + aoff + m * 2048 + k * 1024); } while (0)
#define PG8_LDB(dst, b, h) do { _Pragma("unroll") for (int n = 0; n < 2; ++n) _Pragma("unroll") for (int k = 0; k < 2; ++k) dst[n][k] = *(const LAS bf16x8*)(lds + PG8_SB(b, h) + boff + n * 2048 + k * 1024); } while (0)
#define PG8_MMA(ai, bj, At, Bt) do { __builtin_amdgcn_s_setprio(1); _Pragma("unroll") for (int m = 0; m < 4; ++m) _Pragma("unroll") for (int n = 0; n < 2; ++n) _Pragma("unroll") for (int k = 0; k < 2; ++k) \
        acc[ai][bj][m][n] = __builtin_amdgcn_mfma_f32_16x16x32_bf16(Bt[n][k], At[m][k], acc[ai][bj][m][n], 0, 0, 0); __builtin_amdgcn_s_setprio(0); } while (0)
#define PG8_WAIT_V(n) asm volatile("s_waitcnt vmcnt(" #n ")" ::: "memory")
#define PG8_WAIT_L(n) asm volatile("s_waitcnt lgkmcnt(" #n ")" ::: "memory")
#define PG8_BAR __builtin_amdgcn_s_barrier()
#define PG8_SCHED __builtin_amdgcn_sched_barrier(0)
    Unit cur, nxt; int ui = 0;
    if (!S.next(0, cur)) return;
    f32x4 acc[2][2][4][2];
#pragma unroll
    for (int a = 0; a < 2; ++a)
#pragma unroll
        for (int b = 0; b < 2; ++b)
#pragma unroll
            for (int m = 0; m < 4; ++m)
#pragma unroll
                for (int n = 0; n < 2; ++n) acc[a][b][m][n] = (f32x4){0.f, 0.f, 0.f, 0.f};
    bf16x8 At[4][2], B0[2][2], B1[2][2];
    const char* cA = (const char*)g.A + cur.aoff; const char* cB = (const char*)g.Bt + cur.boff;
    PG8_STAGE(PG8_SB(0, 0), cB, voffB); PG8_STAGE(PG8_SB(0, 1), cB + hstepB, voffB); PG8_STAGE(PG8_SA(0, 0), cA, voffA); PG8_STAGE(PG8_SA(0, 1), cA + hstepA, voffA);
    if (wr == 1) PG8_BAR;
    PG8_WAIT_V(2); PG8_BAR;
    PG8_STAGE(PG8_SB(1, 0), cB + kstep, voffB); PG8_STAGE(PG8_SA(1, 0), cA + kstep, voffA); PG8_STAGE(PG8_SB(1, 1), cB + hstepB + kstep, voffB);
    PG8_WAIT_V(6); PG8_BAR;
    for (;;) {
        const bool has_next = S.next(ui + 1, nxt);
        const char* nA = has_next ? (const char*)g.A + nxt.aoff : cA; const char* nB = has_next ? (const char*)g.Bt + nxt.boff : cB;
        const int nt = cur.nt ? cur.nt : K / BK;
        for (int t = 0; t < nt; t += 2) {
            const bool last = (t == nt - 2);
            const char* a1 = cA + (size_t)(t + 1) * kstep;
            const char* a2 = last ? nA : cA + (size_t)(t + 2) * kstep; const char* b2 = last ? nB : cB + (size_t)(t + 2) * kstep;
            const char* a3 = a2 + kstep; const char* b3 = b2 + kstep;
            PG8_LDB(B0, 0, 0); PG8_LDB(B1, 0, 1); PG8_SCHED; PG8_LDA(At, 0, 0); PG8_STAGE(PG8_SA(1, 1), a1 + hstepA, voffA);
            PG8_WAIT_V(8); PG8_WAIT_L(0); PG8_BAR; PG8_MMA(0, 0, At, B0); PG8_MMA(0, 1, At, B1); PG8_BAR; PG8_SCHED;
            PG8_LDA(At, 0, 1); PG8_STAGE(PG8_SB(0, 0), b2, voffB); PG8_STAGE(PG8_SB(0, 1), b2 + hstepB, voffB); PG8_STAGE(PG8_SA(0, 0), a2, voffA);
            PG8_WAIT_V(8); PG8_WAIT_L(0); PG8_BAR; PG8_MMA(1, 0, At, B0); PG8_MMA(1, 1, At, B1); PG8_BAR; PG8_SCHED;
            PG8_LDB(B0, 1, 0); PG8_LDB(B1, 1, 1); PG8_SCHED; PG8_LDA(At, 1, 0); PG8_STAGE(PG8_SA(0, 1), a2 + hstepA, voffA);
            PG8_WAIT_V(8); PG8_WAIT_L(0); PG8_BAR; PG8_MMA(0, 0, At, B0); PG8_MMA(0, 1, At, B1); PG8_BAR; PG8_SCHED;
            PG8_LDA(At, 1, 1); PG8_STAGE(PG8_SB(1, 0), b3, voffB); PG8_STAGE(PG8_SB(1, 1), b3 + hstepB, voffB); PG8_STAGE(PG8_SA(1, 0), a3, voffA);
            PG8_WAIT_V(8); PG8_WAIT_L(0); PG8_BAR; PG8_MMA(1, 0, At, B0); PG8_MMA(1, 1, At, B1); PG8_BAR; PG8_SCHED;
        }
        if (wr == 0) PG8_BAR;
        E(acc, cur, wr, wc, fr, fq);
        if (!has_next) break;
#pragma unroll
        for (int a = 0; a < 2; ++a)
#pragma unroll
            for (int b = 0; b < 2; ++b)
#pragma unroll
                for (int m = 0; m < 4; ++m)
#pragma unroll
                    for (int n = 0; n < 2; ++n) acc[a][b][m][n] = (f32x4){0.f, 0.f, 0.f, 0.f};
        cur = nxt; cA = nA; cB = nB; ++ui;
        if (wr == 1) PG8_BAR;
    }
    PG8_WAIT_V(0);
    PG8_BAR;
#undef PG8_SA
#undef PG8_SB
#undef PG8_STAGE
#undef PG8_LDA
#undef PG8_LDB
#undef PG8_MMA
#undef PG8_WAIT_V
#undef PG8_WAIT_L
#undef PG8_BAR
#undef PG8_SCHED
}
}


#define XB_TMO      128
#define XB_XCNT(j)  (256  + 64 * (j))
#define XB_XSUB(j)  (1280 + 64 * (j))
#define XB_XGEN(j)  (2304 + 64 * (j))
#define XB_TOP      3328
#define XB_TOPGEN   3392
#define XCD_BAR_WORDS 3456
#define XB_SPIN_CAP (1u << 20)
__device__ __forceinline__ unsigned xb_ld(unsigned* p)              { return __hip_atomic_load(p, __ATOMIC_RELAXED, __HIP_MEMORY_SCOPE_AGENT); }
__device__ __forceinline__ unsigned xb_add(unsigned* p, unsigned v) { return __hip_atomic_fetch_add(p, v, __ATOMIC_RELAXED, __HIP_MEMORY_SCOPE_AGENT); }
__device__ __forceinline__ unsigned xb_xcc_id() { return (unsigned)__builtin_amdgcn_s_getreg((3 << 11) | 20) & 0xFu; }
#define XB_SPIN(cond, bar) do { unsigned _sp = 0; while (cond) { __builtin_amdgcn_s_sleep(0); \
    if ((++_sp & 255u) == 0u) { if (xb_ld(&(bar)[XB_TMO])) break; if (_sp > XB_SPIN_CAP) { atomicAdd(&(bar)[XB_TMO], 1u); break; } } } } while (0)
struct XcdBarrier { unsigned* bar; unsigned x; volatile LAS unsigned* st; };
__device__ __forceinline__ XcdBarrier xcd_barrier_post(unsigned* bar, volatile LAS unsigned* st) {
    XcdBarrier b; b.bar = bar; b.x = xb_xcc_id(); b.st = st;
    if (threadIdx.x == 0) (void)xb_add(&bar[XB_XCNT(b.x)], 1u);
    return b;
}
__device__ __forceinline__ void xcd_barrier_complete(unsigned* bar, unsigned x, unsigned& nloc, unsigned& nx) {
    const unsigned G = gridDim.x * gridDim.y * gridDim.z;
    unsigned sum, cnt, mine, sp = 0u;
    for (;;) {
        sum = 0u; cnt = 0u; mine = 0u;
#pragma unroll
        for (unsigned j = 0; j < 16; ++j) { const unsigned c = xb_ld(&bar[XB_XCNT(j)]); sum += c; cnt += (c > 0u) ? 1u : 0u; mine = (j == x) ? c : mine; }
        if (sum == G) break;
        __builtin_amdgcn_s_sleep(1);
        if ((++sp & 255u) == 0u) { if (xb_ld(&bar[XB_TMO])) break; if (sp > XB_SPIN_CAP) { atomicAdd(&bar[XB_TMO], 1u); break; } }
    }
    nloc = mine > 0u ? mine : 1u; nx = cnt > 0u ? cnt : 1u;
}
__device__ __forceinline__ void xcd_barrier(const XcdBarrier& b) {
    asm volatile("s_waitcnt vmcnt(0)" ::: "memory");
    __syncthreads();
    if (threadIdx.x == 0) {
        unsigned* bar = b.bar;
        __builtin_amdgcn_s_waitcnt(0);
        unsigned nloc = b.st[0], nx = b.st[1];
        if (nloc == 0u) { xcd_barrier_complete(bar, b.x, nloc, nx); b.st[0] = nloc; b.st[1] = nx; }
        const unsigned old = xb_add(&bar[XB_XSUB(b.x)], 1u);
        const unsigned gen = old / nloc;
        if (old + 1u == (gen + 1u) * nloc) {
            __builtin_amdgcn_fence(__ATOMIC_RELEASE, "agent");
            asm volatile("s_waitcnt vmcnt(0)" ::: "memory");
            const unsigned og = xb_add(&bar[XB_TOP], 1u);
            const unsigned tg = og / nx;
            if (og + 1u == (tg + 1u) * nx) xb_add(&bar[XB_TOPGEN], 1u);
            else XB_SPIN(xb_ld(&bar[XB_TOPGEN]) == tg, bar);
            __builtin_amdgcn_fence(__ATOMIC_ACQUIRE, "agent");
            xb_add(&bar[XB_XGEN(b.x)], 1u);
            asm volatile("s_waitcnt vmcnt(0)" ::: "memory");
        } else {
            XB_SPIN(xb_ld(&bar[XB_XGEN(b.x)]) == gen, bar);
            __builtin_amdgcn_fence(__ATOMIC_ACQUIRE, "agent");
            asm volatile("s_waitcnt vmcnt(0)" ::: "memory");
        }
    }
    __syncthreads();
}

__device__ __forceinline__ void sub_barrier(unsigned* word, unsigned n) {
    asm volatile("s_waitcnt vmcnt(0)" ::: "memory");
    __syncthreads();
    if (threadIdx.x == 0) {
        __builtin_amdgcn_fence(__ATOMIC_RELEASE, "agent");
        asm volatile("s_waitcnt vmcnt(0)" ::: "memory");
        xb_add(word, 1u);
        unsigned sp = 0;
        while (xb_ld(word) < n) { __builtin_amdgcn_s_sleep(0); if (++sp > (1u << 22)) break; }
        __builtin_amdgcn_fence(__ATOMIC_ACQUIRE, "agent");
        asm volatile("s_waitcnt vmcnt(0)" ::: "memory");
    }
    __syncthreads();
}

__device__ __forceinline__ void phase_mod(const Params& p, LAS unsigned char* lds) {
    LAS float* sc = (LAS float*)lds;
    LAS float* part = sc + 9 * 1024;
    float* mod = (float*)(PF(ws) + WS_MOD);
    const int tid = tid_(), w = tid >> 6, lane = tid & 63;
    if ((int)blockIdx.x >= 192) return;
    const float* pc = PF(c); const float* pcc = PF(c_ctx); const float* padaw = PF(ada_w); const float* padab = PF(ada_b);
    for (int i = tid; i < 9 * 1024; i += 512) { const int r = i >> 10, k = i & 1023; const float v = (r < 8) ? pc[r * 1024 + k] : pcc[k]; sc[i] = v / (1.0f + expf(-v)); }
    __syncthreads();
    for (int item = blockIdx.x; item < 192; item += gridDim.x) {
        const int l = item / 96, cb = item % 96;
        const float* W = padaw + (size_t)l * 1024 * 6144 + cb * 64 + lane;
        float acc[9];
#pragma unroll
        for (int r = 0; r < 9; ++r) acc[r] = 0.f;
        for (int k = w * 128; k < w * 128 + 128; ++k) { const float wv = W[(size_t)k * 6144];
#pragma unroll
            for (int r = 0; r < 9; ++r) acc[r] += sc[r * 1024 + k] * wv; }
#pragma unroll
        for (int r = 0; r < 9; ++r) part[(w * 9 + r) * 64 + lane] = acc[r];
        __syncthreads();
        for (int i = tid; i < 576; i += 512) { const int r = i >> 6, ln = i & 63; float s = 0.f;
#pragma unroll
            for (int ww = 0; ww < 8; ++ww) s += part[(ww * 9 + r) * 64 + ln];
            mod[(size_t)(l * 9 + r) * 6144 + cb * 64 + ln] = s + padab[l * 6144 + cb * 64 + ln]; }
        __syncthreads();
    }
}
__device__ __forceinline__ void phase_rope(const Params& p) {
    if (blockIdx.x != gridDim.x - 1) return;
    float* rope = (float*)(PF(ws) + WS_ROPE);
    for (int i = tid_(); i < 1024; i += 512) { const int pos = i >> 4, fi = i & 15; const float invf = powf(10000.0f, -(float)fi / 16.0f); const float ang = (float)pos * invf; rope[i] = cosf(ang); rope[1024 + i] = sinf(ang); }
}
__device__ __forceinline__ void convert_tile(const float* src, int K, int N, bf16_t* dst, int tile, LAS bf16_t* T) {
    const int tid = tid_(), tilesN = N >> 7, tk = tile / tilesN, tn = tile - tk * tilesN, k0 = tk * 128, n0 = tn * 128;
    const int r = tid >> 4, c8 = (tid & 15) * 8;
    f32x4 a[4], b[4];
#pragma unroll
    for (int i = 0; i < 4; ++i) { const float* s = src + (size_t)(k0 + r + 32 * i) * N + n0 + c8; a[i] = *(const f32x4*)s; b[i] = *(const f32x4*)(s + 4); }
#pragma unroll
    for (int i = 0; i < 4; ++i)
#pragma unroll
        for (int j = 0; j < 4; ++j) { T[(c8 + j) * 136 + r + 32 * i] = (bf16_t)f2bf(a[i][j]); T[(c8 + 4 + j) * 136 + r + 32 * i] = (bf16_t)f2bf(b[i][j]); }
    __syncthreads();
    const int n = tid >> 2, ks = (tid & 3) * 8;
#pragma unroll
    for (int i = 0; i < 4; ++i) { const u32x4 v = *(const LAS u32x4*)(T + n * 136 + ks + 32 * i); *(u32x4*)(dst + (size_t)(n0 + n) * K + k0 + ks + 32 * i) = v; }
    __syncthreads();
}
__device__ __forceinline__ void phase_convert(const Params& p, int l, LAS unsigned char* lds) {
    LAS bf16_t* T = (LAS bf16_t*)lds;
    bf16_t* WIN = (bf16_t*)(PF(ws) + WS_WIN); bf16_t* WB = (bf16_t*)(PF(ws) + WS_WB); bf16_t* WO = (bf16_t*)(PF(ws) + WS_WO); bf16_t* W1 = (bf16_t*)(PF(ws) + WS_W1); bf16_t* W2 = (bf16_t*)(PF(ws) + WS_W2);
    for (int it = blockIdx.x; it < 1184; it += gridDim.x) {
        if (it < 512) convert_tile(PF(w_in) + (size_t)l * DM * DIN, DM, DIN, WIN, it, T);
        else if (it < 608) { const int n = (it - 512) / 32, tl = (it - 512) % 32; convert_tile(PF(w_branch) + (size_t)(l * 3 + n) * 512 * DM, 512, DM, WB + (size_t)n * DM * 512, tl, T); }
        else if (it < 672) convert_tile(PF(w_out) + (size_t)l * DM * DM, DM, DM, WO, it - 608, T);
        else if (it < 928) convert_tile(PF(ffn_w1) + (size_t)l * DM * DFF, DM, DFF, W1, it - 672, T);
        else convert_tile(PF(ffn_w2) + (size_t)l * DFF * DM, DFF, DM, W2, it - 928, T);
    }
}
__device__ __forceinline__ void phase_norm(const Params& p, int l, const float* hlat, const float* hctx, const float* g, int modoff, int nrows, const float* slab = nullptr, const float* slabgate = nullptr, float* hwrite = nullptr) {
    const int tid = tid_(); const int w = tid >> 6, lane = tid & 63;
    bf16_t* U = (bf16_t*)(PF(ws) + WS_U); const float* mod = (const float*)(PF(ws) + WS_MOD);
    for (int row = blockIdx.x * 8 + w; row < nrows; row += gridDim.x * 8) {
        const float* src = row < NLAT ? hlat + (size_t)row * DM : hctx + (size_t)(row - NLAT) * DM;
        const int mr = row < NLAT ? (row >> 11) : 8;
        const float* md = mod + (size_t)(l * 9 + mr) * 6144 + modoff;
        f32x4 v[4]; float ss = 0.f;
#pragma unroll
        for (int i = 0; i < 4; ++i) { v[i] = *(const f32x4*)(src + i * 256 + lane * 4);
            if (slab != nullptr && row >= NLAT) { const size_t o = (size_t)(row - NLAT) * DM + i * 256 + lane * 4; const f32x4 gg = *(const f32x4*)(slabgate + i * 256 + lane * 4);
                const f32x4 s4 = (*(const f32x4*)(slab + o) + *(const f32x4*)(slab + o + (size_t)NCTX * DM)) + (*(const f32x4*)(slab + o + (size_t)2 * NCTX * DM) + *(const f32x4*)(slab + o + (size_t)3 * NCTX * DM));
                v[i] += gg * s4; if (hwrite != nullptr) *(f32x4*)(hwrite + o) = v[i]; }
            ss += v[i][0] * v[i][0] + v[i][1] * v[i][1] + v[i][2] * v[i][2] + v[i][3] * v[i][3]; }
#pragma unroll
        for (int o = 32; o >= 1; o >>= 1) ss += __shfl_xor(ss, o);
        const float rstd = rsqrtf(ss * (1.0f / 1024.0f) + 1e-6f);
#pragma unroll
        for (int i = 0; i < 4; ++i) { const int cidx = i * 256 + lane * 4; const f32x4 gg = *(const f32x4*)(g + cidx), sh = *(const f32x4*)(md + cidx), scv = *(const f32x4*)(md + 1024 + cidx);
            float o4[4];
#pragma unroll
            for (int j = 0; j < 4; ++j) o4[j] = (v[i][j] * rstd * gg[j]) * (1.0f + scv[j]) + sh[j];
            u32x2 wv; wv.x = pack2(o4[0], o4[1]); wv.y = pack2(o4[2], o4[3]);
            *(u32x2*)(U + (size_t)row * DM + cidx) = wv; }
    }
}
__device__ __forceinline__ void phase_hg_final(const Params& p, int l, int b, int wgi, int nw) {
    const int tid = tid_(); const int w = tid >> 6, lane = tid & 63; bf16_t* P = (bf16_t*)(PF(ws) + WS_P);
    const int hd = lane >> 4, e8 = (lane & 15) * 8; const float* png = PF(hg_norm_g);
    float ng[8];
#pragma unroll
    for (int i = 0; i < 8; ++i) ng[i] = png[l * 128 + e8 + i];
    for (int i0 = wgi * 8 + w; i0 < 2304; i0 += 3 * nw) {
        u32x4 ra[3], rb[3], ro[3]; bf16_t* rp[3];
#pragma unroll
        for (int k = 0; k < 3; ++k) { const int i = i0 + nw * k; const int ic = i < 2304 ? i : i0; const size_t row = ic < 2048 ? (size_t)b * SEQ + ic : (size_t)NLAT + b * CTXL + (ic - 2048);
            rp[k] = P + row * PW; ra[k] = *(const u32x4*)(rp[k] + C_BF + hd * 128 + e8); rb[k] = *(const u32x4*)(rp[k] + C_BF + 512 + hd * 128 + e8); ro[k] = *(const u32x4*)(rp[k] + C_BO + hd * 128 + e8); }
#pragma unroll
        for (int k = 0; k < 3; ++k) {
            float a[8], bb[8], og[8]; unpack8(ra[k], a); unpack8(rb[k], bb); unpack8(ro[k], og);
            float ss = 0.f;
#pragma unroll
            for (int i = 0; i < 8; ++i) { a[i] += bb[i]; ss += a[i] * a[i]; }
            ss += __shfl_xor(ss, 1); ss += __shfl_xor(ss, 2); ss += __shfl_xor(ss, 4); ss += __shfl_xor(ss, 8);
            const float rstd = rsqrtf(ss * (1.0f / 128.0f) + 1e-6f);
            float y[8];
#pragma unroll
            for (int i = 0; i < 8; ++i) y[i] = a[i] * rstd * ng[i] * sigmoidf_(og[i]);
            if (i0 + nw * k < 2304) *(u32x4*)(rp[k] + C_BO + hd * 128 + e8) = pack8(y);
        }
    }
}

__device__ __forceinline__ size_t agg_idx(int b, int gch, int dir, int which, int ch) { return ((((size_t)b * 36 + gch) * 2 + dir) * 2 + which) * 512 + ch; }
__device__ __forceinline__ float gelu_tanh(float x) { const float u = 0.7978845608028654f * (x + 0.044715f * x * x * x); const float th = 1.0f - 2.0f * __builtin_amdgcn_rcpf(1.0f + fexp_(2.0f * u)); return 0.5f * x * (1.0f + th); }
struct LruPtrs { bf16_t* P; float* AGG; const float *cb, *cw, *ba, *bx, *lam; };
__device__ __forceinline__ LruPtrs lru_ptrs() { LruPtrs q; q.P = (bf16_t*)(PF(ws) + WS_P); q.AGG = (float*)(PF(ws) + WS_AGG); q.cb = PF(conv_b); q.cw = PF(conv_w); q.ba = PF(lru_ba); q.bx = PF(lru_bx); q.lam = PF(lru_lambda); return q; }
__device__ __forceinline__ void lru_tile(const Params& p, int l, LAS unsigned char* lds, int item, int mode, int& staged_nb, const LruPtrs& lp, float (&kc)[3]) {
    LAS bf16_t* Wl = (LAS bf16_t*)lds;
    LAS bf16_t* Xb = Wl + 256 * 72;
    LAS float* Xf = (LAS float*)(lds + 46080);
    LAS float* Av = Xf + 4096;
    LAS float* Bv = Av + 8192;
    bf16_t* P = lp.P; float* AGG = lp.AGG;
    const int tid = tid_(), w = tid >> 6, lane = tid & 63, l16 = lane & 15, q4 = lane >> 4;
    const int nb = item & 7, rest = item >> 3, gch = rest % 36, b = rest / 36;
    const bool isctx = gch < 4; const int chunk = isctx ? gch : gch - 4, L = isctx ? CTXL : SEQ;
    const size_t seqrow0 = isctx ? (size_t)NLAT + b * CTXL : (size_t)b * SEQ; const int t0 = chunk * 64;
    if (staged_nb != nb) { const float* pwx = PF(lru_wx); const float* pwa = PF(lru_wa);
        for (int e = tid; e < 4 * 64 * 64; e += 512) { const int mat = e >> 12, i = (e >> 6) & 63, c = e & 63; const int dir = mat >> 1, kind = mat & 1;
            const float* W = kind ? pwx : pwa; const float v = W[((size_t)((l * 2 + dir) * 8 + nb) * 64 + i) * 64 + c];
            const int op = dir * 128 + (c >> 4) * 32 + kind * 16 + (c & 15);
            Wl[op * 72 + i] = (bf16_t)f2bf(v); }
        { const int dir = w >> 2, ch = nb * 64 + (w & 3) * 16 + l16; kc[0] = lp.ba[(l * 2 + dir) * 512 + ch]; kc[1] = lp.bx[(l * 2 + dir) * 512 + ch]; kc[2] = log1pf(expf(-lp.lam[(l * 2 + dir) * 512 + ch])); }
        staged_nb = nb;
    }
    {
        const int t = tid >> 3, c8 = (tid & 7) * 8, ch = nb * 64 + c8, tt = t0 + t;
        float a8[8]; const float* pcb = lp.cb; const float* pcw = lp.cw;
        { const f32x4 b0 = *(const f32x4*)(pcb + l * 512 + ch), b1 = *(const f32x4*)(pcb + l * 512 + ch + 4);
#pragma unroll
          for (int i = 0; i < 4; ++i) { a8[i] = b0[i]; a8[4 + i] = b1[i]; } }
#pragma unroll
        for (int j = 0; j < 4; ++j) { const int ts = tt + j - 2;
            if (ts >= 0 && ts < L) { float xv[8]; unpack8(*(const u32x4*)(P + (seqrow0 + ts) * PW + C_AX + ch), xv);
                const f32x4 w0 = *(const f32x4*)(pcw + (l * 4 + j) * 512 + ch), w1 = *(const f32x4*)(pcw + (l * 4 + j) * 512 + ch + 4);
#pragma unroll
                for (int i = 0; i < 4; ++i) { a8[i] += xv[i] * w0[i]; a8[4 + i] += xv[4 + i] * w1[i]; } } }
#pragma unroll
        for (int i = 0; i < 8; ++i) Xf[t * 64 + c8 + i] = a8[i];
        *(LAS u32x4*)(Xb + t * 72 + c8) = pack8(a8);
    }
    __syncthreads();
    {
        const int dir = w >> 2, c = (w & 3) * 16 + l16, ch = nb * 64 + c;
        f32x4 acc[4][2];
#pragma unroll
        for (int mg = 0; mg < 4; ++mg) { acc[mg][0] = (f32x4){0.f, 0.f, 0.f, 0.f}; acc[mg][1] = (f32x4){0.f, 0.f, 0.f, 0.f}; }
#pragma unroll
        for (int ks = 0; ks < 2; ++ks) {
            const bf16x8 B0 = *(const LAS bf16x8*)(Wl + (w * 32 + l16) * 72 + ks * 32 + q4 * 8), B1 = *(const LAS bf16x8*)(Wl + (w * 32 + 16 + l16) * 72 + ks * 32 + q4 * 8);
#pragma unroll
            for (int mg = 0; mg < 4; ++mg) { const bf16x8 A = *(const LAS bf16x8*)(Xb + (mg * 16 + l16) * 72 + ks * 32 + q4 * 8);
                acc[mg][0] = mfma16(A, B0, acc[mg][0]); acc[mg][1] = mfma16(A, B1, acc[mg][1]); }
        }
        const float ba = kc[0], bx = kc[1], sp = kc[2];
#pragma unroll
        for (int mg = 0; mg < 4; ++mg)
#pragma unroll
            for (int j = 0; j < 4; ++j) { const int t = mg * 16 + q4 * 4 + j;
                const float ea = 1.0f + fexp_(-(acc[mg][0][j] + ba)), ex = 1.0f + fexp_(-(acc[mg][1][j] + bx)); const float inv = __builtin_amdgcn_rcpf(ea * ex);
                const float r = inv * ex, ig = inv * ea;
                const float la = -8.0f * r * sp; const float a = fexp_(la); const float x2 = 2.0f * la;
                float om = -x2 * (1.0f + x2 * (0.5f + x2 * (0.16666667f + x2 * (0.041666668f + x2 * 0.0083333338f))));
                if (x2 < -0.35f) om = 1.0f - a * a;
                const float bb = sqrtf(fmaxf(om, 0.f)) * ig * Xf[t * 64 + c];
                Av[(dir * 64 + t) * 64 + c] = a; Bv[(dir * 64 + t) * 64 + c] = bb; }
    }
    __syncthreads();
    {
        LAS float* SegA = Xf;
        LAS float* SegB = Xf + 512;
        const int d2 = tid >> 8, seg = (tid >> 6) & 3, c = tid & 63, ch = nb * 64 + c;
        float av[16], bv[16];
#pragma unroll
        for (int k = 0; k < 16; ++k) { const int s = seg * 16 + k; const int t = d2 ? 63 - s : s; const int ix = (d2 * 64 + t) * 64 + c; av[k] = Av[ix]; bv[k] = Bv[ix]; }
        float h = 0.f, ap = 1.f;
#pragma unroll
        for (int k = 0; k < 16; ++k) { h = av[k] * h + bv[k]; ap *= av[k]; }
        SegA[(d2 * 4 + seg) * 64 + c] = ap; SegB[(d2 * 4 + seg) * 64 + c] = h;
        float hin = 0.f;
        if (mode == 1) {
            const int mypos = d2 == 0 ? gch : (gch < 4 ? 3 - gch : 39 - gch);
            for (int p0 = 0; p0 < mypos; p0 += 6) { float Aa[6], Bb[6];
#pragma unroll
                for (int j = 0; j < 6; ++j) { const int pp = p0 + j; const int g = d2 == 0 ? pp : (pp < 4 ? 3 - pp : 39 - pp); const bool ok = pp < mypos;
                    Aa[j] = ok ? AGG[agg_idx(b, ok ? g : 0, d2, 0, ch)] : 1.0f; Bb[j] = ok ? AGG[agg_idx(b, ok ? g : 0, d2, 1, ch)] : 0.0f; }
#pragma unroll
                for (int j = 0; j < 6; ++j) hin = Aa[j] * hin + Bb[j]; }
        }
        __syncthreads();
        if (mode == 0) {
            if (seg == 3) { float A = 1.f, B = 0.f;
#pragma unroll
                for (int s2 = 0; s2 < 4; ++s2) { const float sa = SegA[(d2 * 4 + s2) * 64 + c], sb2 = SegB[(d2 * 4 + s2) * 64 + c]; B = sa * B + sb2; A *= sa; }
                AGG[agg_idx(b, gch, d2, 0, ch)] = A; AGG[agg_idx(b, gch, d2, 1, ch)] = B; }
        } else {
#pragma unroll
            for (int s2 = 0; s2 < 3; ++s2) if (s2 < seg) hin = SegA[(d2 * 4 + s2) * 64 + c] * hin + SegB[(d2 * 4 + s2) * 64 + c];
            float hh2 = hin;
#pragma unroll
            for (int k = 0; k < 16; ++k) { const int s = seg * 16 + k; const int t = d2 ? 63 - s : s; hh2 = av[k] * hh2 + bv[k]; Bv[(d2 * 64 + t) * 64 + c] = hh2; }
        }
    }
    __syncthreads();
    if (mode == 1) {
        const int t = tid >> 3, c8 = (tid & 7) * 8; bf16_t* gp = P + (seqrow0 + t0 + t) * PW + C_AG + nb * 64 + c8;
        float gt[8]; unpack8(*(const u32x4*)gp, gt); float y[8];
#pragma unroll
        for (int i = 0; i < 8; ++i) y[i] = (Bv[t * 64 + c8 + i] + Bv[(64 + t) * 64 + c8 + i]) * gelu_tanh(gt[i]);
        *(u32x4*)gp = pack8(y);
        __syncthreads();
    }
}

template <bool B> struct BoolC { static constexpr bool value = B; };
__device__ __forceinline__ void attn_item(const Params& p, int l, LAS unsigned char* lds, int item, int dry = 0) {
    LAS bf16_t* Kt = (LAS bf16_t*)lds;
    LAS float* rpbL = (LAS float*)(lds + 73728);
    LAS float* cosT = rpbL + 960;
    LAS float* sinT = cosT + 1024;
    LAS float* gq = sinT + 1024; LAS float* gk = gq + 64;
    bf16_t* P = (bf16_t*)(PF(ws) + WS_P); const float* rope = (const float*)(PF(ws) + WS_ROPE);
    const int tid = tid_(), w = __builtin_amdgcn_readfirstlane(tid >> 6), lane = tid & 63, l16 = lane & 15, q4 = lane >> 4, hh = w >> 2, qg4 = w & 3;
    const bool isctx = item >= 512;
    int b, hp, nloc, krU; int rq[2], kq0[2]; size_t qrow0[2];
    if (!isctx) { hp = item & 3; const int rp = (item >> 2) & 15; b = item >> 6;
        rq[0] = 2 * rp; rq[1] = 2 * rp + 1; kq0[0] = min(max(rq[0] - 4, 0), 24); kq0[1] = min(max(rq[1] - 4, 0), 24);
        qrow0[0] = (size_t)b * SEQ + rq[0] * 64; qrow0[1] = qrow0[0] + 64; krU = kq0[0]; nloc = kq0[1] + 8 - kq0[0]; }
    else { const int it = item - 512; hp = it & 3; const int qt = (it >> 2) & 1; b = it >> 3; rq[0] = rq[1] = 0; kq0[0] = kq0[1] = 0; krU = 0; nloc = 0;
        qrow0[0] = (size_t)NLAT + b * CTXL + qt * 128; qrow0[1] = qrow0[0] + 64; }
    const int h = hp * 2 + hh;
    const float* prpb = PF(na_rpb);
    for (int i = tid; i < 2 * 465; i += 512) { const int h2 = i / 465, j = i - h2 * 465; rpbL[h2 * 480 + j] = prpb[(size_t)((l * 8 + hp * 2 + h2) * 465) + j]; }
    for (int i = tid; i < 1024; i += 512) { cosT[i] = rope[i]; sinT[i] = rope[1024 + i]; }
    if (tid < 64) { gq[tid] = PF(na_qg)[l * 64 + tid]; gk[tid] = PF(na_kg)[l * 64 + tid]; }
    __syncthreads();
    const int qc = qg4 * 16 + l16;
    const int glo = qg4 < 2 ? 0 : qg4 - 1, ghi = qg4 == 0 ? 1 : (qg4 == 3 ? 3 : qg4 + 1);
    unsigned mbits = 0u; const int bbase = q4 * 4 - qc;
    { const int cs0 = min(max(qc - 8, 0), 48);
#pragma unroll
      for (int g = 0; g < 4; ++g)
#pragma unroll
          for (int j = 0; j < 4; ++j) { const int kc = g * 16 + q4 * 4 + j; if (kc < cs0 || kc >= cs0 + 16) mbits |= 1u << (g * 4 + j); } }
    bf16x8 qpl[2][2], qrt[2][2];
#pragma unroll
    for (int qi = 0; qi < 2; ++qi) {
        const bf16_t* qp = P + (qrow0[qi] + qc) * PW + C_CQ + h * 64;
        float xq[16]; unpack8(*(const u32x4*)(qp + q4 * 8), xq); unpack8(*(const u32x4*)(qp + 32 + q4 * 8), xq + 8);
        float ss = 0.f;
#pragma unroll
        for (int i = 0; i < 16; ++i) ss += xq[i] * xq[i];
        ss += __shfl_xor(ss, 16); ss += __shfl_xor(ss, 32);
        const float rs = rsqrtf(ss * (1.0f / 64.0f) + 1e-6f) * 0.125f;
#pragma unroll
        for (int i = 0; i < 8; ++i) { xq[i] *= rs * gq[q4 * 8 + i]; xq[8 + i] *= rs * gq[32 + q4 * 8 + i]; }
        qpl[qi][0] = as_bf16x8(pack8(xq)); qpl[qi][1] = as_bf16x8(pack8(xq + 8));
        float xr[16];
#pragma unroll
        for (int ks = 0; ks < 2; ++ks) { const int pos = ks == 0 ? rq[qi] : qc;
#pragma unroll
            for (int jj = 0; jj < 8; ++jj) { const int fi = (q4 & 1) * 8 + jj; const float cs = cosT[pos * 16 + fi], sn = sinT[pos * 16 + fi]; const float xv = xq[ks * 8 + jj]; const float pr = __shfl_xor(xv, 32);
                xr[ks * 8 + jj] = (q4 < 2) ? (xv * cs - pr * sn) : (xv * cs + pr * sn); } }
        qrt[qi][0] = as_bf16x8(pack8(xr)); qrt[qi][1] = as_bf16x8(pack8(xr + 8));
    }
    f32x4 O[2][4];
#pragma unroll
    for (int qi = 0; qi < 2; ++qi)
#pragma unroll
        for (int i = 0; i < 4; ++i) O[qi][i] = (f32x4){0.f, 0.f, 0.f, 0.f};
    float mrun[2] = {-1e30f, -1e30f}, lsum[2] = {0.f, 0.f};
    const int pf_hh2 = tid >> 8, pf_h2 = hp * 2 + pf_hh2, pf_key = (tid & 255) >> 2, pf_seg = tid & 3, pf_vseg = (tid & 255) >> 6, pf_vkey = tid & 63;
    u32x4 pk0, pk1, pv0, pv1;
    { const size_t r0 = nloc ? (size_t)b * SEQ + krU * 64 : (size_t)NLAT + b * CTXL;
      const bf16_t* kp = P + (r0 + pf_key) * PW + C_CK + pf_h2 * 64 + pf_seg * 16; pk0 = *(const u32x4*)kp; pk1 = *(const u32x4*)(kp + 8);
      const bf16_t* vp = P + (r0 + pf_vkey) * PW + C_CV + pf_h2 * 64 + pf_vseg * 16; pv0 = *(const u32x4*)vp; pv1 = *(const u32x4*)(vp + 8); }
    const int ntot = nloc + 4;
    float gkr[16];
#pragma unroll
    for (int i = 0; i < 16; ++i) gkr[i] = gk[pf_seg * 16 + i];
    auto stage = [&](int T, int buf) {
        const bool sloc = T < nloc; const int kr = krU + T;
        LAS bf16_t* KtB = Kt + buf * (4 * 64 * 72); LAS bf16_t* VtB = KtB + 2 * 64 * 72;
        {
            const int hh2 = pf_hh2, key = pf_key, seg = pf_seg;
            float xk[16]; unpack8(pk0, xk); unpack8(pk1, xk + 8);
            float ss = 0.f;
#pragma unroll
            for (int i = 0; i < 16; ++i) ss += xk[i] * xk[i];
            ss += dpp_xor1(ss); ss += dpp_xor2(ss);
            const float rs = rsqrtf(ss * (1.0f / 64.0f) + 1e-6f);
#pragma unroll
            for (int i = 0; i < 16; ++i) xk[i] *= rs * gkr[i];
            if (sloc) { const int pos = seg < 2 ? kr : key;
#pragma unroll
                for (int i = 0; i < 16; ++i) { const float pr = dpp_xor1(xk[i]); const float cs = cosT[pos * 16 + i], sn = sinT[pos * 16 + i]; xk[i] = (seg & 1) ? (xk[i] * cs + pr * sn) : (xk[i] * cs - pr * sn); } }
            LAS bf16_t* kd = KtB + (hh2 * 64 + key) * 72 + seg * 16;
            *(LAS u32x4*)kd = pack8(xk); *(LAS u32x4*)(kd + 8) = pack8(xk + 8);
        }
        {
            const int hh2 = pf_hh2, seg = pf_vseg, key = pf_vkey;
            const u32x4 a = pv0, c = pv1;
            LAS bf16_t* vd = VtB + (hh2 * 64 + seg * 16) * 72 + key;
            vd[0 * 72] = (bf16_t)(a.x & 0xffff); vd[1 * 72] = (bf16_t)(a.x >> 16); vd[2 * 72] = (bf16_t)(a.y & 0xffff); vd[3 * 72] = (bf16_t)(a.y >> 16);
            vd[4 * 72] = (bf16_t)(a.z & 0xffff); vd[5 * 72] = (bf16_t)(a.z >> 16); vd[6 * 72] = (bf16_t)(a.w & 0xffff); vd[7 * 72] = (bf16_t)(a.w >> 16);
            vd[8 * 72] = (bf16_t)(c.x & 0xffff); vd[9 * 72] = (bf16_t)(c.x >> 16); vd[10 * 72] = (bf16_t)(c.y & 0xffff); vd[11 * 72] = (bf16_t)(c.y >> 16);
            vd[12 * 72] = (bf16_t)(c.z & 0xffff); vd[13 * 72] = (bf16_t)(c.z >> 16); vd[14 * 72] = (bf16_t)(c.w & 0xffff); vd[15 * 72] = (bf16_t)(c.w >> 16);
        }
        { const int Tn = T + 1; if (Tn < ntot) { const size_t r0 = (Tn < nloc) ? (size_t)b * SEQ + (krU + Tn) * 64 : (size_t)NLAT + b * CTXL + (Tn - nloc) * 64;
            const bf16_t* kp = P + (r0 + pf_key) * PW + C_CK + pf_h2 * 64 + pf_seg * 16; pk0 = *(const u32x4*)kp; pk1 = *(const u32x4*)(kp + 8);
            const bf16_t* vp = P + (r0 + pf_vkey) * PW + C_CV + pf_h2 * 64 + pf_vseg * 16; pv0 = *(const u32x4*)vp; pv1 = *(const u32x4*)(vp + 8); } }
    };
    auto compute = [&](auto LOC, int T, int buf) {
        constexpr bool loc = decltype(LOC)::value; const int kr = krU + T;
        const LAS bf16_t* KtB = Kt + buf * (4 * 64 * 72); const LAS bf16_t* VtB = KtB + 2 * 64 * 72;
#pragma unroll
        for (int qi = 0; qi < 2; ++qi) {
            if (loc && (kr < kq0[qi] || kr >= kq0[qi] + 8)) continue;
            f32x4 st[4];
#pragma unroll
            for (int g = 0; g < 4; ++g) { const bool use = !loc || (g >= glo && g <= ghi);
                st[g] = (f32x4){0.f, 0.f, 0.f, 0.f};
                if (use) {
#pragma unroll
                    for (int ks = 0; ks < 2; ++ks) st[g] = mfma16(*(const LAS bf16x8*)(KtB + (hh * 64 + g * 16 + l16) * 72 + ks * 32 + q4 * 8), loc ? qrt[qi][ks] : qpl[qi][ks], st[g]);
                    if (loc) { const int dr31 = (kr - rq[qi] + 7) * 31;
#pragma unroll
                        for (int j = 0; j < 4; ++j) { const float sv = st[g][j] + rpbL[hh * 480 + min(max(bbase + g * 16 + j, -15), 15) + 15 + dr31]; st[g][j] = ((mbits >> (g * 4 + j)) & 1u) ? -1e30f : sv; } }
                } else st[g] = (f32x4){-1e30f, -1e30f, -1e30f, -1e30f};
            }
            float tmax = -1e30f;
#pragma unroll
            for (int g = 0; g < 4; ++g)
#pragma unroll
                for (int j = 0; j < 4; ++j) tmax = fmaxf(tmax, st[g][j]);
            tmax = fmaxf(tmax, __shfl_xor(tmax, 16)); tmax = fmaxf(tmax, __shfl_xor(tmax, 32));
            const float mnew = fmaxf(mrun[qi], tmax); const float alpha = fexp_(mrun[qi] - mnew); mrun[qi] = mnew;
            float psum = 0.f;
#pragma unroll
            for (int g = 0; g < 4; ++g) { const bool use = !loc || (g >= glo && g <= ghi);
                if (use) {
#pragma unroll
                    for (int j = 0; j < 4; ++j) { const float pv = fexp_(st[g][j] - mnew); st[g][j] = pv; psum += pv; }
                } else st[g] = (f32x4){0.f, 0.f, 0.f, 0.f}; }
            lsum[qi] = lsum[qi] * alpha + psum;
#pragma unroll
            for (int i = 0; i < 4; ++i) O[qi][i] *= alpha;
            bf16x8 pb[2];
#pragma unroll
            for (int ks = 0; ks < 2; ++ks) { u32x4 wv; wv.x = pack2(st[2 * ks][0], st[2 * ks][1]); wv.y = pack2(st[2 * ks][2], st[2 * ks][3]); wv.z = pack2(st[2 * ks + 1][0], st[2 * ks + 1][1]); wv.w = pack2(st[2 * ks + 1][2], st[2 * ks + 1][3]); pb[ks] = as_bf16x8(wv); }
#pragma unroll
            for (int ks = 0; ks < 2; ++ks) if (!loc || (2 * ks + 1 >= glo && 2 * ks <= ghi))
#pragma unroll
                for (int dg = 0; dg < 4; ++dg) { const LAS bf16_t* vr = VtB + (hh * 64 + dg * 16 + l16) * 72 + ks * 32 + q4 * 4;
                    const u32x2 lo = *(const LAS u32x2*)vr, hi = *(const LAS u32x2*)(vr + 16); u32x4 av; av.x = lo.x; av.y = lo.y; av.z = hi.x; av.w = hi.y;
                    O[qi][dg] = mfma16(as_bf16x8(av), pb[ks], O[qi][dg]); }
        }
    };
    stage(0, 0);
    __syncthreads();
    for (int T = 0; T < nloc; ++T) {
        stage(T + 1, (T + 1) & 1);
        compute(BoolC<true>{}, T, T & 1);
        __syncthreads();
    }
    for (int T = nloc; T < ntot; ++T) {
        if (T + 1 < ntot) stage(T + 1, (T + 1) & 1);
        compute(BoolC<false>{}, T, T & 1);
        __syncthreads();
    }
#pragma unroll
    for (int qi = 0; qi < 2; ++qi) {
        float ls = lsum[qi]; ls += __shfl_xor(ls, 16); ls += __shfl_xor(ls, 32);
        const float inv = 1.0f / ls;
        bf16_t* op = dry ? ((bf16_t*)(PF(ws) + WS_DUMMY) + (size_t)(blockIdx.x & 63) * 16384 + (size_t)((qi * 8 + w) * 16 + l16) * 64) : (P + (qrow0[qi] + qc) * PW + C_CQ + h * 64);
#pragma unroll
        for (int dg = 0; dg < 4; ++dg) { u32x2 wv; wv.x = pack2(O[qi][dg][0] * inv, O[qi][dg][1] * inv); wv.y = pack2(O[qi][dg][2] * inv, O[qi][dg][3] * inv); *(u32x2*)(op + dg * 16 + q4 * 4) = wv; }
    }
    __syncthreads();
}

__device__ __forceinline__ void hgrn_stage(const bf16_t* P, LAS unsigned char* lds, int w, int lane, size_t row0, int dir, int h) {
#pragma unroll
    for (int i = 0; i < 2; ++i) { const int blk = i * 8 + w; const int t = blk * 4 + (lane >> 4); const bf16_t* rp = P + (row0 + (dir ? 63 - t : t)) * PW + (lane & 15) * 8;
        __builtin_amdgcn_global_load_lds((const unsigned*)(rp + C_BQ + h * 128), (LAS unsigned*)(lds + 118784 + blk * 1024), 16, 0, 0);
        __builtin_amdgcn_global_load_lds((const unsigned*)(rp + C_BF + dir * 512 + h * 128), (LAS unsigned*)(lds + 135168 + blk * 1024), 16, 0, 0); }
}
__device__ __forceinline__ void hgrn_chain(const Params& p, int l, LAS unsigned char* lds, int chain, int dry = 0) {
    LAS bf16_t* Q0 = (LAS bf16_t*)lds;
    LAS bf16_t* KP = (LAS bf16_t*)(lds + 17408);
    LAS bf16_t* SB = (LAS bf16_t*)(lds + 34816);
    LAS bf16_t* KDT = (LAS bf16_t*)(lds + 69632);
    LAS bf16_t* VT = (LAS bf16_t*)(lds + 88064);
    LAS bf16_t* ATT = (LAS bf16_t*)(lds + 106496);
    LAS float* TOT = (LAS float*)(lds + 115712);
    LAS float* DD = (LAS float*)(lds + 117760);
    const LAS bf16_t* SQ = (const LAS bf16_t*)(lds + 118784);
    const LAS bf16_t* SF = (const LAS bf16_t*)(lds + 135168);
    bf16_t* P = (bf16_t*)(PF(ws) + WS_P);
    const int tid = tid_(), w = __builtin_amdgcn_readfirstlane(tid >> 6), lane = tid & 63, l16 = lane & 15, q4 = lane >> 4;
    const int dir = chain & 1, h = (chain >> 1) & 3, b = chain >> 3;
    const int d = tid & 127, sb = tid >> 7;
    float lbv = 0.f;
    if (l > 0) { const float x0 = PF(hg_lb)[(dir * 2 + 0) * 512 + h * 128 + d], x1 = PF(hg_lb)[(dir * 2 + 1) * 512 + h * 128 + d]; lbv = 1.0f / (1.0f + expf(x0 - x1)); }
    for (int i = tid; i < 64 * 72 / 2; i += 512) ((LAS unsigned*)ATT)[i] = 0u;
    f32x4 S[8];
#pragma unroll
    for (int i = 0; i < 8; ++i) S[i] = (f32x4){0.f, 0.f, 0.f, 0.f};
    { const int gch0 = dir == 0 ? 0 : 3; hgrn_stage(P, lds, w, lane, (size_t)NLAT + b * CTXL + gch0 * 64, dir, h); }
    asm volatile("s_waitcnt vmcnt(0)" ::: "memory");
    __syncthreads();
    for (int ci = 0; ci < 36; ++ci) {
        const int gch = dir == 0 ? ci : (ci < 4 ? 3 - ci : 39 - ci);
        const bool isctx = gch < 4; const int chunk = isctx ? gch : gch - 4;
        const size_t row0 = isctx ? (size_t)NLAT + b * CTXL + chunk * 64 : (size_t)b * SEQ + chunk * 64;
        float bl[16], qv[16], kv[16]; float run = 0.f;
        {
            unsigned vraw[16];
            { const bf16_t* vp = P + (row0 + (dir ? 63 - sb * 16 : sb * 16)) * PW + C_BI + h * 128 + d; const long vstep = dir ? -(long)PW : (long)PW;
#pragma unroll
              for (int ii = 0; ii < 16; ++ii) { vraw[ii] = *vp; vp += vstep; } }
#pragma unroll
            for (int eg = 0; eg < 8; ++eg) { u32x2 wv; wv.x = pack2(S[eg][0], S[eg][1]); wv.y = pack2(S[eg][2], S[eg][3]); *(LAS u32x2*)(SB + (eg * 16 + l16) * 136 + w * 16 + q4 * 4) = wv; }
#pragma unroll
            for (int ii = 0; ii < 16; ++ii) { const int t = sb * 16 + ii;
                const float fr = bf2f(SF[t * 128 + d]), qr = bf2f(SQ[t * 128 + d]);
                const float sg = __builtin_amdgcn_rcpf(1.0f + fexp_(-fr)); const float f = lbv + (1.0f - lbv) * sg; run += flog_(f); bl[ii] = run; kv[ii] = 1.0f - f; qv[ii] = qr * __builtin_amdgcn_rcpf(1.0f + fexp_(-qr)); }
            TOT[sb * 128 + d] = run;
            u32x4 v0, v1; v0.x = vraw[0] | (vraw[1] << 16); v0.y = vraw[2] | (vraw[3] << 16); v0.z = vraw[4] | (vraw[5] << 16); v0.w = vraw[6] | (vraw[7] << 16);
            v1.x = vraw[8] | (vraw[9] << 16); v1.y = vraw[10] | (vraw[11] << 16); v1.z = vraw[12] | (vraw[13] << 16); v1.w = vraw[14] | (vraw[15] << 16);
            *(LAS u32x4*)(VT + d * 72 + sb * 16) = v0; *(LAS u32x4*)(VT + d * 72 + sb * 16 + 8) = v1;
        }
        __syncthreads();
        if (ci < 35) { const int cn = ci + 1; const int gn = dir == 0 ? cn : (cn < 4 ? 3 - cn : 39 - cn); const bool cx = gn < 4; const int ck = cx ? gn : gn - 4;
            hgrn_stage(P, lds, w, lane, cx ? (size_t)NLAT + b * CTXL + ck * 64 : (size_t)b * SEQ + ck * 64, dir, h); }
        {
            const float t0 = TOT[d], t1 = TOT[128 + d], t2 = TOT[256 + d], t3 = TOT[384 + d];
            const float Bs1 = t0, Bs2 = t0 + t1, Bs3 = Bs2 + t2, total = Bs3 + t3;
            const float Bsb = sb == 0 ? 0.f : (sb == 1 ? Bs1 : (sb == 2 ? Bs2 : Bs3));
            const float eB = fexp_(Bsb), eT = fexp_(total);
            float kd[16];
#pragma unroll
            for (int ii = 0; ii < 16; ++ii) { const float e0 = fexp_(bl[ii]); Q0[(sb * 16 + ii) * 136 + d] = (bf16_t)pack2(qv[ii] * e0 * eB, 0.f);
                const float kp = kv[ii] * fexp_(fminf(-(Bsb + bl[ii]), 80.f)); KP[(sb * 16 + ii) * 136 + d] = (bf16_t)pack2(kp, 0.f); kd[ii] = kp * eT; }
            *(LAS u32x4*)(KDT + d * 72 + sb * 16) = pack8(kd); *(LAS u32x4*)(KDT + d * 72 + sb * 16 + 8) = pack8(kd + 8);
            if (sb == 0) DD[d] = eT;
        }
        __syncthreads();
        const bool need_o = !(l == 1 && isctx);
        if (need_o)
#pragma unroll
        for (int k2 = 0; k2 < 2; ++k2) { const int idx = w + 8 * k2;
            if (idx < 10) { const int i = idx < 1 ? 0 : (idx < 3 ? 1 : (idx < 6 ? 2 : 3)); const int j = idx - i * (i + 1) / 2;
                f32x4 sc = (f32x4){0.f, 0.f, 0.f, 0.f};
                const LAS bf16_t* qb = Q0 + (i * 16 + l16) * 136 + q4 * 8; const LAS bf16_t* kb = KP + (j * 16 + l16) * 136 + q4 * 8;
#pragma unroll
                for (int ks = 0; ks < 4; ++ks) sc = mfma16(*(const LAS bf16x8*)(qb + ks * 32), *(const LAS bf16x8*)(kb + ks * 32), sc);
#pragma unroll
                for (int jj = 0; jj < 4; ++jj) { const float v = (i == j && l16 > q4 * 4 + jj) ? 0.f : sc[jj]; ATT[(i * 16 + q4 * 4 + jj) * 72 + j * 16 + l16] = (bf16_t)pack2(v, 0.f); } } }
        __syncthreads();
        if (need_o) {
            bf16x8 SBf[4], VTf[2];
#pragma unroll
            for (int ks = 0; ks < 4; ++ks) SBf[ks] = *(const LAS bf16x8*)(SB + (w * 16 + l16) * 136 + ks * 32 + q4 * 8);
#pragma unroll
            for (int ks = 0; ks < 2; ++ks) VTf[ks] = *(const LAS bf16x8*)(VT + (w * 16 + l16) * 72 + ks * 32 + q4 * 8);
#pragma unroll
            for (int i = 0; i < 4; ++i) { f32x4 oa = (f32x4){0.f, 0.f, 0.f, 0.f};
#pragma unroll
                for (int ks = 0; ks < 4; ++ks) oa = mfma16(SBf[ks], *(const LAS bf16x8*)(Q0 + (i * 16 + l16) * 136 + ks * 32 + q4 * 8), oa);
#pragma unroll
                for (int ks = 0; ks < 2; ++ks) oa = mfma16(VTf[ks], *(const LAS bf16x8*)(ATT + (i * 16 + l16) * 72 + ks * 32 + q4 * 8), oa);
                const int t = i * 16 + l16; u32x2 wv; wv.x = pack2(oa[0], oa[1]); wv.y = pack2(oa[2], oa[3]);
                bf16_t* od = dry ? ((bf16_t*)(PF(ws) + WS_DUMMY) + (size_t)chain * 8192 + t * 128 + w * 16 + q4 * 4) : (P + (row0 + (dir ? 63 - t : t)) * PW + C_BF + dir * 512 + h * 128 + w * 16 + q4 * 4);
                *(u32x2*)od = wv; }
        }
        {
            const f32x4 dd = *(const LAS f32x4*)(DD + w * 16 + q4 * 4);
#pragma unroll
            for (int eg = 0; eg < 8; ++eg) S[eg] *= dd;
#pragma unroll
            for (int ks = 0; ks < 2; ++ks) { const bf16x8 A = *(const LAS bf16x8*)(KDT + (w * 16 + l16) * 72 + ks * 32 + q4 * 8);
#pragma unroll
                for (int eg = 0; eg < 8; ++eg) S[eg] = mfma16(A, *(const LAS bf16x8*)(VT + (eg * 16 + l16) * 72 + ks * 32 + q4 * 8), S[eg]); }
        }
        asm volatile("s_waitcnt vmcnt(0)" ::: "memory");
        __syncthreads();
    }
}

__global__ void __launch_bounds__(512, 2) fwd_megakernel(Params p) {
    extern __shared__ __attribute__((aligned(16))) unsigned char lds_raw[];
    LAS unsigned char* lds = (LAS unsigned char*)lds_raw;
    cg::grid_group grid = cg::this_grid();
    volatile LAS unsigned* xst = (volatile LAS unsigned*)(lds + LDS_BYTES - 16);
    if (threadIdx.x == 0) { xst[0] = 0u; xst[1] = 0u; xst[2] = 0u; xst[3] = 0u; }
    __syncthreads();
    const XcdBarrier xbar = xcd_barrier_post((unsigned*)(PF(ws) + WS_BAR), xst);
    const int G = gridDim.x, c = blockIdx.x;

    phase_mod(p, lds); __syncthreads();
    phase_rope(p);
    phase_convert(p, 0, lds);
    if (PF(ws) == nullptr) grid.sync();
    xcd_barrier(xbar);
#define WSP(T, off) ((T*)(PF(ws) + (off)))
    for (int l = 0; l < 2; ++l) {
        const bool lastl = (l == 1);
        const int Mrest = lastl ? NLAT : NTOK;
        if (l > 0) phase_convert(p, l, lds);
        phase_norm(p, l, l == 0 ? PF(x) : PF(out), l == 0 ? PF(ctx) : WSP(const float, WS_HC), PF(norm1_g) + l * DM, 0, NTOK,
                   (l > 0 && G == 256) ? (const float*)(PF(ws) + WS_P + (size_t)NTOK * DFF * 2) : nullptr, WSP(const float, WS_MOD) + (size_t)((l > 0 ? l - 1 : 0) * 9 + 8) * 6144 + 5120);
        xcd_barrier(xbar);

        { pg8::Gemm g{WSP(bf16_t, WS_U), WSP(bf16_t, WS_WIN), DM, DM, DM}; pg8::Sched S; S.init(NTOK, PW, G, c, DM, DM); pg8::EpiStore<0> E{WSP(bf16_t, WS_P), PW}; pg8::gemm_phase(lds, g, S, E); }
        xcd_barrier(xbar);
        {
            int staged = -1; float kc[3] = {0.f, 0.f, 0.f}; const LruPtrs lp = lru_ptrs();
            if (c < 64) hgrn_chain(p, l, lds, c);
            else { const int cc = c - 64, GG = G - 64; const int nA = lastl ? 512 : 576;
                for (int it = cc; it < nA; it += GG) attn_item(p, l, lds, it);
                for (int it = cc; it < 2304; it += GG) lru_tile(p, l, lds, it, 0, staged, lp, kc); }
            sub_barrier((unsigned*)(PF(ws) + WS_BAR) + 3520 + 64 * (2 * l + 1), (unsigned)G);
            if ((c & 7) != (staged & 7) || staged < 0) staged = -1;
            for (int it = c; it < 2304; it += G) lru_tile(p, l, lds, it, 1, staged, lp, kc);
            if (G == 256) phase_hg_final(p, l, c >> 5, c & 31, 256); else if (c < 64) phase_hg_final(p, l, c >> 3, c & 7, 64);
        }
        xcd_barrier(xbar);
        { pg8::Gemm g{WSP(bf16_t, WS_U), WSP(bf16_t, WS_WIN) + (size_t)PW * DM, DM, DM, DM}; pg8::Sched S; S.init(Mrest, 3072, G, c, DM, DM); pg8::EpiStore<1> E{WSP(bf16_t, WS_P), PW}; pg8::gemm_phase(lds, g, S, E); }
        xcd_barrier(xbar);
        { pg8::Gemm g{WSP(bf16_t, WS_P), WSP(bf16_t, WS_WB), PW, 512, 512}; pg8::MergeSched S; S.base.init(Mrest, DM, G, c, PW, 512);
          pg8::EpiMerge E{WSP(bf16_t, WS_P), WSP(bf16_t, WS_U)}; pg8::gemm_phase(lds, g, S, E); }
        xcd_barrier(xbar);
        { pg8::Gemm g{WSP(bf16_t, WS_U), WSP(bf16_t, WS_WO), DM, DM, DM};
          pg8::EpiResid E{l == 0 ? PF(x) : PF(out), l == 0 ? PF(ctx) : WSP(const float, WS_HC), PF(out), WSP(float, WS_HC), WSP(const float, WS_MOD) + (size_t)l * 9 * 6144 + 2048, WSP(float, WS_P)};
          if (!lastl && G == 256) { pg8::SplitSched S; S.base.init(NLAT, DM, G, c, DM, DM); S.sk = 256; pg8::gemm_phase(lds, g, S, E); }
          else { pg8::Sched S; S.init(Mrest, DM, G, c, DM, DM); pg8::gemm_phase(lds, g, S, E); } }
        xcd_barrier(xbar);
        if (!lastl && G == 256) phase_norm(p, l, PF(out), l == 0 ? PF(ctx) : WSP(const float, WS_HC), PF(norm2_g) + l * DM, 3072, Mrest, WSP(const float, WS_P), WSP(const float, WS_MOD) + (size_t)(l * 9 + 8) * 6144 + 2048, WSP(float, WS_HC));
        else phase_norm(p, l, PF(out), WSP(const float, WS_HC), PF(norm2_g) + l * DM, 3072, Mrest);
        xcd_barrier(xbar);
        { pg8::Gemm g{WSP(bf16_t, WS_U), WSP(bf16_t, WS_W1), DM, DM, DM}; pg8::Sched S; S.init(Mrest, DFF, G, c, DM, DM); pg8::EpiStore<2> E{WSP(bf16_t, WS_P), DFF}; pg8::gemm_phase(lds, g, S, E); }
        xcd_barrier(xbar);
        { pg8::Gemm g{WSP(bf16_t, WS_P), WSP(bf16_t, WS_W2), DFF, DFF, DFF};
          float* slab = (float*)(PF(ws) + WS_P + (size_t)NTOK * DFF * 2);
          pg8::EpiResid E{PF(out), WSP(const float, WS_HC), PF(out), WSP(float, WS_HC), WSP(const float, WS_MOD) + (size_t)l * 9 * 6144 + 5120, slab};
          if (!lastl && G == 256) { pg8::SplitSched S; S.base.init(NLAT, DM, G, c, DFF, DFF); S.sk = 1024; pg8::gemm_phase(lds, g, S, E); }
          else { pg8::Sched S; S.init(Mrest, DM, G, c, DFF, DFF); pg8::gemm_phase(lds, g, S, E); } }
        if (!lastl) xcd_barrier(xbar);
    }
}

extern "C" void kernel_launch(void* const* d_in, const int* in_sizes, int n_in, void* d_out, int out_size, void* d_ws, size_t ws_size, hipStream_t stream) {
    static int grid_blocks = 0;
    if (grid_blocks == 0) {
        int dev = 0, cus = 0, per_cu = 0;
        hipGetDevice(&dev);
        hipDeviceGetAttribute(&cus, hipDeviceAttributeMultiprocessorCount, dev);
        hipFuncSetAttribute((const void*)fwd_megakernel, hipFuncAttributeMaxDynamicSharedMemorySize, LDS_BYTES);
        hipOccupancyMaxActiveBlocksPerMultiprocessor(&per_cu, (const void*)fwd_megakernel, 512, LDS_BYTES);
        if (per_cu < 1 || n_in != 25 || ws_size < WS_END) { fprintf(stderr, "kernel_launch: cannot launch (per_cu %d, n_in %d, ws %zu need %zu)\n", per_cu, n_in, ws_size, (size_t)WS_END); grid_blocks = -1; }
        else grid_blocks = cus;
    }
    if (grid_blocks < 0) return;
    hipMemsetAsync((char*)d_ws + WS_BAR, 0, 16384, stream);
    Params p{};
    const float** pp = (const float**)&p;
    for (int i = 0; i < 25; ++i) pp[i] = (const float*)d_in[i];
    p.out = (float*)d_out; p.ws = (unsigned char*)d_ws;
    void* args[] = {&p};
    hipError_t e = hipLaunchCooperativeKernel((const void*)fwd_megakernel, dim3(grid_blocks), dim3(512), args, LDS_BYTES, stream);
    if (e != hipSuccess) fprintf(stderr, "cooperative launch failed: %s (grid %d)\n", hipGetErrorString(e), grid_blocks);
}
```

```cpp
#include <hip/hip_runtime.h>
#include <hip/hip_cooperative_groups.h>
#include <stdint.h>
#include <stdio.h>
namespace cg = cooperative_groups;

#define LAS __attribute__((address_space(3)))
typedef unsigned short bf16_t;
typedef short bf16x8 __attribute__((ext_vector_type(8)));
typedef float f32x4 __attribute__((ext_vector_type(4)));
typedef unsigned u32x4 __attribute__((ext_vector_type(4)));
typedef unsigned u32x2 __attribute__((ext_vector_type(2)));

constexpr int DM = 1024, NB = 8, SEQ = 2048, CTXL = 256, NLAT = NB * SEQ, NCTX = NB * CTXL, NTOK = NLAT + NCTX;
constexpr int PW = 5120, DIN = 8192, DFF = 4096;
constexpr int C_AX = 0, C_AG = 512, C_BQ = 1024, C_BF = 1536, C_BI = 2560, C_BO = 3072, C_CQ = 3584, C_CK = 4096, C_CV = 4608;
constexpr int LDS_BYTES = 163840;
constexpr size_t WS_WIN = 0;
constexpr size_t WS_WB = WS_WIN + (size_t)DIN * DM * 2;
constexpr size_t WS_WO = WS_WB + (size_t)3 * DM * 512 * 2;
constexpr size_t WS_W1 = WS_WO + (size_t)DM * DM * 2;
constexpr size_t WS_W2 = WS_W1 + (size_t)DFF * DM * 2;
constexpr size_t WS_U = WS_W2 + (size_t)DM * DFF * 2;
constexpr size_t WS_P = WS_U + (size_t)NTOK * DM * 2;
constexpr size_t WS_HC = WS_P + (size_t)NTOK * PW * 2;
constexpr size_t WS_MOD = WS_HC + (size_t)NCTX * DM * 4;
constexpr size_t WS_AGG = WS_MOD + (size_t)2 * 9 * 6144 * 4;
constexpr size_t WS_ROPE = WS_AGG + (size_t)NB * 36 * 2 * 2 * 512 * 4;
constexpr size_t WS_DUMMY = WS_ROPE + 2048 * 4;
constexpr size_t WS_BAR = WS_DUMMY + (2u << 20);
constexpr size_t WS_END = WS_BAR + 16384;

struct Params {
    const float *x, *c, *ctx, *c_ctx, *ada_w, *ada_b, *norm1_g, *norm2_g, *w_in, *conv_w, *conv_b, *lru_wa, *lru_ba, *lru_wx, *lru_bx, *lru_lambda,
        *hg_lb, *hg_norm_g, *na_qg, *na_kg, *na_rpb, *w_branch, *w_out, *ffn_w1, *ffn_w2;
    float* out; unsigned char* ws;
};


__device__ __forceinline__ unsigned long long ldkarg(int off) { unsigned long long v = 0;
#if defined(__HIP_DEVICE_COMPILE__)
    auto kp = __builtin_amdgcn_kernarg_segment_ptr();
    asm volatile("s_load_dwordx2 %0, %1, %2\n\ts_waitcnt lgkmcnt(0)" : "=s"(v) : "s"(kp), "s"(off));
#endif
    return v; }
template <class T> struct rm_ptr; template <class T> struct rm_ptr<T*> { typedef T type; };
template <class T> __device__ __forceinline__ T* as_global_ptr(unsigned long long v) { return (T*)(__attribute__((address_space(1))) T*)v; }
#define PF(f) (as_global_ptr<rm_ptr<decltype(Params::f)>::type>(ldkarg((int)__builtin_offsetof(Params, f))))

#define GAS __attribute__((address_space(1)))
template <class T> __device__ __forceinline__ GAS T* lnd(T* p) { asm volatile("" : "+v"(p)); return (GAS T*)p; }
__device__ __forceinline__ int tid_() { int t = threadIdx.x; asm volatile("" : "+v"(t)); return t; }
__device__ __forceinline__ float bf2f(unsigned v) { return __uint_as_float(v << 16); }
__device__ __forceinline__ float bflo(unsigned w) { return __uint_as_float(w << 16); }
__device__ __forceinline__ float bfhi(unsigned w) { return __uint_as_float(w & 0xffff0000u); }
__device__ __forceinline__ unsigned f2bf(float f) { unsigned u = __float_as_uint(f); u += 0x7fffu + ((u >> 16) & 1u); return u >> 16; }
typedef __bf16 bf16x2_t __attribute__((ext_vector_type(2)));
typedef float f32x2_t __attribute__((ext_vector_type(2)));
__device__ __forceinline__ unsigned pack2(float lo, float hi) { f32x2_t v = {lo, hi}; bf16x2_t b = __builtin_convertvector(v, bf16x2_t); union { bf16x2_t b; unsigned u; } t; t.b = b; return t.u; }
__device__ __forceinline__ float fexp_(float x) { return __builtin_amdgcn_exp2f(x * 1.4426950408889634f); }
__device__ __forceinline__ float flog_(float x) { return __builtin_amdgcn_logf(x) * 0.6931471805599453f; }
__device__ __forceinline__ float dpp_xor1(float v) { return __int_as_float(__builtin_amdgcn_mov_dpp(__float_as_int(v), 0xB1, 0xF, 0xF, true)); }
__device__ __forceinline__ float dpp_xor2(float v) { return __int_as_float(__builtin_amdgcn_mov_dpp(__float_as_int(v), 0x4E, 0xF, 0xF, true)); }
__device__ __forceinline__ float sigmoidf_(float x) { return __builtin_amdgcn_rcpf(1.0f + fexp_(-x)); }
__device__ __forceinline__ f32x4 mfma16(bf16x8 a, bf16x8 b, f32x4 c) { return __builtin_amdgcn_mfma_f32_16x16x32_bf16(a, b, c, 0, 0, 0); }
__device__ __forceinline__ bf16x8 as_bf16x8(u32x4 v) { union { u32x4 u; bf16x8 b; } t; t.u = v; return t.b; }
__device__ __forceinline__ void unpack8(u32x4 w, float* o) { o[0] = bflo(w.x); o[1] = bfhi(w.x); o[2] = bflo(w.y); o[3] = bfhi(w.y); o[4] = bflo(w.z); o[5] = bfhi(w.z); o[6] = bflo(w.w); o[7] = bfhi(w.w); }
__device__ __forceinline__ u32x4 pack8(const float* v) { u32x4 w; w.x = pack2(v[0], v[1]); w.y = pack2(v[2], v[3]); w.z = pack2(v[4], v[5]); w.w = pack2(v[6], v[7]); return w; }

namespace pg8 {
constexpr int BM = 256, BK = 64, HALF = 128, HTB = HALF * BK * 2, NXCD = 8, WGM = 4;
__device__ __forceinline__ int lds_byte(int r, int c) { const int st = (r >> 4) * 2 + (c >> 5), rr = r & 15, cc = c & 31, ob = rr * 64 + cc * 2; return st * 1024 + (ob ^ (((ob >> 9) & 1) << 5)); }
__device__ __forceinline__ void stage_rc(int b, int& R, int& C) { const int st = b / 1024, sb = b % 1024, swz = sb ^ (((sb >> 9) & 1) << 5); R = (st >> 1) * 16 + swz / 64; C = (st & 1) * 32 + (swz % 64) / 2; }
__device__ __forceinline__ int perm32(int rho) { const int n = rho >> 4, i = rho & 15; return 8 * (i >> 2) + 4 * n + (i & 3); }

struct Unit { int pm, pn, sub, nt; size_t aoff, boff; };
struct Gemm { const bf16_t* A; const bf16_t* Bt; int lda, ldb, K; };
struct Sched {
    int nM, nN, nwg, G, c, lda, ldb, nt;
    __device__ void init(int M, int N, int G_, int c_, int lda_, int ldb_) { nM = M / BM; nN = N / BM; nwg = nM * nN; G = G_; c = c_; lda = lda_; ldb = ldb_; nt = 0; }
    __device__ bool next(int i, Unit& u) const {
        const long L = (long)i * G + c; if (L >= nwg) return false;
        int wgid = (int)L; { const int q = nwg / NXCD, r = nwg % NXCD, xcd = wgid % NXCD, off = wgid / NXCD; wgid = (xcd < r ? xcd * (q + 1) : r * (q + 1) + (xcd - r) * q) + off; }
        const int nig = WGM * nN, gid = wgid / nig, fm = gid * WGM, gsz = (nM - fm) < WGM ? (nM - fm) : WGM;
        u.pm = fm + ((wgid % nig) % gsz); u.pn = (wgid % nig) / gsz; u.sub = 0; u.nt = nt;
        u.aoff = (size_t)u.pm * BM * lda * 2;
        u.boff = (size_t)u.pn * BM * ldb * 2;
        return true;
    }
};

template <int ACT> struct EpiStore {
    static constexpr bool PERM = true;
    bf16_t* O; int ldc;
    __device__ __forceinline__ void operator()(const f32x4 (&acc)[2][2][4][2], const Unit& u, int wr, int wc, int fr, int fq) const {
        const int row0 = u.pm * BM + wr * 64 + fr; int colt = u.pn * BM;
        if (ACT == 1) colt = (colt < 2048) ? (1024 + colt) : (2048 + colt);
        const int col0 = colt + wc * 32 + 8 * fq;
#pragma unroll
        for (int ai = 0; ai < 2; ++ai)
#pragma unroll
            for (int m = 0; m < 4; ++m) { GAS bf16_t* rowp = lnd(O + (size_t)(row0 + ai * HALF + m * 16) * ldc + col0);
#pragma unroll
                for (int bj = 0; bj < 2; ++bj) { f32x4 v0 = acc[ai][bj][m][0], v1 = acc[ai][bj][m][1];
                    if (ACT == 1) {
#pragma unroll
                        for (int j = 0; j < 4; ++j) { v0[j] = sigmoidf_(v0[j]); v1[j] = sigmoidf_(v1[j]); } }
                    if (ACT == 2) {
#pragma unroll
                        for (int j = 0; j < 4; ++j) { float a = fmaxf(v0[j], 0.f), b = fmaxf(v1[j], 0.f); v0[j] = a * a; v1[j] = b * b; } }
                    u32x4 w; w.x = pack2(v0[0], v0[1]); w.y = pack2(v0[2], v0[3]); w.z = pack2(v1[0], v1[1]); w.w = pack2(v1[2], v1[3]);
                    *(GAS u32x4*)(rowp + bj * HALF) = w; } }
    }
};
struct EpiMerge {
    static constexpr bool PERM = true;
    const bf16_t* P; bf16_t* U;
    __device__ __forceinline__ void operator()(const f32x4 (&acc)[2][2][4][2], const Unit& u, int wr, int wc, int fr, int fq) const {
        const int row0 = u.pm * BM + wr * 64 + fr; const int col0 = u.pn * BM + wc * 32 + 8 * fq;
        const int sub = u.sub; const int gcol = sub * 1024 + u.pn * BM; const int gd = ((gcol < 2048) ? (1024 + gcol) : (2048 + gcol)) + wc * 32 + 8 * fq;
        const bool addp = sub > 0;
#pragma unroll
        for (int ai = 0; ai < 2; ++ai)
#pragma unroll
            for (int m = 0; m < 4; ++m) { const size_t row = (size_t)(row0 + ai * HALF + m * 16); const GAS bf16_t* gp = lnd(P + row * PW + gd); GAS bf16_t* up = lnd(U + row * DM + col0);
#pragma unroll
                for (int bj = 0; bj < 2; ++bj) { const u32x4 gw = *(const GAS u32x4*)(gp + bj * HALF);
                    f32x4 a0 = acc[ai][bj][m][0], a1 = acc[ai][bj][m][1];
                    a0[0] *= bflo(gw.x); a0[1] *= bfhi(gw.x); a0[2] *= bflo(gw.y); a0[3] *= bfhi(gw.y); a1[0] *= bflo(gw.z); a1[1] *= bfhi(gw.z); a1[2] *= bflo(gw.w); a1[3] *= bfhi(gw.w);
                    if (addp) { const u32x4 pw = *(const GAS u32x4*)(up + bj * HALF);
                        a0[0] += bflo(pw.x); a0[1] += bfhi(pw.x); a0[2] += bflo(pw.y); a0[3] += bfhi(pw.y); a1[0] += bflo(pw.z); a1[1] += bfhi(pw.z); a1[2] += bflo(pw.w); a1[3] += bfhi(pw.w); }
                    u32x4 o; o.x = pack2(a0[0], a0[1]); o.y = pack2(a0[2], a0[3]); o.z = pack2(a1[0], a1[1]); o.w = pack2(a1[2], a1[3]);
                    *(GAS u32x4*)(up + bj * HALF) = o; } }
    }
};
struct EpiResid {
    static constexpr bool PERM = true;
    const float* inL; const float* inC; float* outL; float* outC; const float* mod;
    float* slab;
    __device__ __forceinline__ void operator()(const f32x4 (&acc)[2][2][4][2], const Unit& u, int wr, int wc, int fr, int fq) const {
        if (u.sub >= 1) {
            const int row0 = (u.pm - 64) * BM + wr * 64 + fr, col0 = u.pn * BM + wc * 32 + 8 * fq; float* sl = slab + (size_t)(u.sub - 1) * NCTX * DM;
#pragma unroll
            for (int ai = 0; ai < 2; ++ai)
#pragma unroll
                for (int m = 0; m < 4; ++m)
#pragma unroll
                    for (int bj = 0; bj < 2; ++bj) { GAS float* op = lnd(sl + (size_t)(row0 + ai * HALF + m * 16) * DM + col0 + bj * HALF); *(GAS f32x4*)op = acc[ai][bj][m][0]; *(GAS f32x4*)(op + 4) = acc[ai][bj][m][1]; }
            return;
        }
        const bool lat = u.pm < 64; const int rbase = lat ? u.pm * BM : (u.pm - 64) * BM;
        const float* in = lat ? inL : inC; float* out = lat ? outL : outC;
        const int row0 = rbase + wr * 64 + fr, col0 = u.pn * BM + wc * 32 + 8 * fq;
        const float* gt = mod + (size_t)(lat ? (u.pm >> 3) : 8) * 6144 + col0;
#pragma unroll
        for (int bj = 0; bj < 2; ++bj) { const f32x4 g0 = *(const f32x4*)(gt + bj * HALF), g1 = *(const f32x4*)(gt + bj * HALF + 4);
#pragma unroll
            for (int ai = 0; ai < 2; ++ai)
#pragma unroll
                for (int m = 0; m < 4; ++m) { const size_t ro = (size_t)(row0 + ai * HALF + m * 16) * DM + col0 + bj * HALF;
                    const GAS float* ip = lnd(in + ro); GAS float* op = lnd(out + ro); const f32x4 i0 = *(const GAS f32x4*)ip, i1 = *(const GAS f32x4*)(ip + 4);
                    *(GAS f32x4*)op = i0 + g0 * acc[ai][bj][m][0]; *(GAS f32x4*)(op + 4) = i1 + g1 * acc[ai][bj][m][1]; } }
    }
};

struct MergeSched {
    Sched base;
    __device__ bool next(int i, Unit& u) const {
        const int r = i / 3, n = i - 3 * r;
        if (!base.next(r, u)) return false;
        u.sub = n; u.aoff += (size_t)(n == 0 ? C_AG : C_BO + (n - 1) * 512) * 2; u.boff += (size_t)n * DM * 512 * 2;
        return true;
    }
};
struct SplitSched {
    Sched base;
    int sk;
    __device__ bool next(int i, Unit& u) const {
        if (base.next(i, u)) return true;
        const int nfull = (base.nwg - base.c + base.G - 1) / base.G;
        const int k = i - nfull; const int un = k * base.G + base.c; if (k < 0 || un >= 128) return false;
        const int ct = un >> 2, sl = un & 3; u.pm = 64 + (ct >> 2); u.pn = ct & 3; u.sub = 1 + sl; u.nt = sk / BK;
        u.aoff = (size_t)u.pm * BM * base.lda * 2 + (size_t)sl * sk * 2; u.boff = (size_t)u.pn * BM * base.ldb * 2 + (size_t)sl * sk * 2;
        return true;
    }
};
template <class Epi, class Sch>
__device__ __forceinline__ void gemm_phase(LAS unsigned char* lds, const Gemm g, const Sch& S, const Epi& E) {
    const int tid = tid_(), wid = __builtin_amdgcn_readfirstlane(tid >> 6), lane = tid & 63, wr = wid >> 2, wc = wid & 3, fr = lane & 15, fq = lane >> 4;
    const int K = g.K;
    unsigned voffA[2], voffB[2];
#pragma unroll
    for (int i = 0; i < 2; ++i) { int R, C; stage_rc(tid * 16 + i * 8192, R, C); const int Rb = Epi::PERM ? ((R & ~31) + perm32(R & 31)) : R;
        voffA[i] = (unsigned)(R * g.lda + C) * 2u; voffB[i] = (unsigned)(Rb * g.ldb + C) * 2u; }
    const size_t kstep = (size_t)(BK * 2);
    const size_t hstepA = (size_t)HALF * g.lda * 2, hstepB = (size_t)HALF * g.ldb * 2;
    const unsigned ldsw = (unsigned)wid * 1024u;
    const int aoff = lds_byte(wr * 64 + fr, fq * 8), boff = lds_byte(wc * 32 + fr, fq * 8);
#define PG8_SA(b, h) (((b) * 2 + (h)) * HTB)
#define PG8_SB(b, h) ((4 + (b) * 2 + (h)) * HTB)
#define PG8_STAGE(bufoff, gbase, voff) do { _Pragma("unroll") for (int _i = 0; _i < 2; ++_i) \
        __builtin_amdgcn_global_load_lds((const unsigned*)((const char*)(gbase) + (voff)[_i]), (LAS unsigned*)(lds + (bufoff) + ldsw + _i * 8192), 16, 0, 0); } while (0)
#define PG8_LDA(dst, b, h) do { _Pragma("unroll") for (int m = 0; m < 4; ++m) _Pragma("unroll") for (int k = 0; k < 2; ++k) dst[m][k] = *(const LAS bf16x8*)(lds + PG8_SA(b, h) + aoff + m * 2048 + k * 1024); } while (0)
#define PG8_LDB(dst, b, h) do { _Pragma("unroll") for (int n = 0; n < 2; ++n) _Pragma("unroll") for (int k = 0; k < 2; ++k) dst[n][k] = *(const LAS bf16x8*)(lds + PG8_SB(b, h) + boff + n * 2048 + k * 1024); } while (0)
#define PG8_MMA(ai, bj, At, Bt) do { __builtin_amdgcn_s_setprio(1); _Pragma("unroll") for (int m = 0; m < 4; ++m) _Pragma("unroll") for (int n = 0; n < 2; ++n) _Pragma("unroll") for (int k = 0; k < 2; ++k) \
        acc[ai][bj][m][n] = __builtin_amdgcn_mfma_f32_16x16x32_bf16(Bt[n][k], At[m][k], acc[ai][bj][m][n], 0, 0, 0); __builtin_amdgcn_s_setprio(0); } while (0)
#define PG8_WAIT_V(n) asm volatile("s_waitcnt vmcnt(" #n ")" ::: "memory")
#define PG8_WAIT_L(n) asm volatile("s_waitcnt lgkmcnt(" #n ")" ::: "memory")
#define PG8_BAR __builtin_amdgcn_s_barrier()
#define PG8_SCHED __builtin_amdgcn_sched_barrier(0)
    Unit cur, nxt; int ui = 0;
    if (!S.next(0, cur)) return;
    f32x4 acc[2][2][4][2];
#pragma unroll
    for (int a = 0; a < 2; ++a)
#pragma unroll
        for (int b = 0; b < 2; ++b)
#pragma unroll
            for (int m = 0; m < 4; ++m)
#pragma unroll
                for (int n = 0; n < 2; ++n) acc[a][b][m][n] = (f32x4){0.f, 0.f, 0.f, 0.f};
    bf16x8 At[4][2], B0[2][2], B1[2][2];
    const char* cA = (const char*)g.A + cur.aoff; const char* cB = (const char*)g.Bt + cur.boff;
    PG8_STAGE(PG8_SB(0, 0), cB, voffB); PG8_STAGE(PG8_SB(0, 1), cB + hstepB, voffB); PG8_STAGE(PG8_SA(0, 0), cA, voffA); PG8_STAGE(PG8_SA(0, 1), cA + hstepA, voffA);
    if (wr == 1) PG8_BAR;
    PG8_WAIT_V(2); PG8_BAR;
    PG8_STAGE(PG8_SB(1, 0), cB + kstep, voffB); PG8_STAGE(PG8_SA(1, 0), cA + kstep, voffA); PG8_STAGE(PG8_SB(1, 1), cB + hstepB + kstep, voffB);
    PG8_WAIT_V(6); PG8_BAR;
    for (;;) {
        const bool has_next = S.next(ui + 1, nxt);
        const char* nA = has_next ? (const char*)g.A + nxt.aoff : cA; const char* nB = has_next ? (const char*)g.Bt + nxt.boff : cB;
        const int nt = cur.nt ? cur.nt : K / BK;
        for (int t = 0; t < nt; t += 2) {
            const bool last = (t == nt - 2);
            const char* a1 = cA + (size_t)(t + 1) * kstep;
            const char* a2 = last ? nA : cA + (size_t)(t + 2) * kstep; const char* b2 = last ? nB : cB + (size_t)(t + 2) * kstep;
            const char* a3 = a2 + kstep; const char* b3 = b2 + kstep;
            PG8_LDB(B0, 0, 0); PG8_LDB(B1, 0, 1); PG8_SCHED; PG8_LDA(At, 0, 0); PG8_STAGE(PG8_SA(1, 1), a1 + hstepA, voffA);
            PG8_WAIT_V(8); PG8_WAIT_L(0); PG8_BAR; PG8_MMA(0, 0, At, B0); PG8_MMA(0, 1, At, B1); PG8_BAR; PG8_SCHED;
            PG8_LDA(At, 0, 1); PG8_STAGE(PG8_SB(0, 0), b2, voffB); PG8_STAGE(PG8_SB(0, 1), b2 + hstepB, voffB); PG8_STAGE(PG8_SA(0, 0), a2, voffA);
            PG8_WAIT_V(8); PG8_WAIT_L(0); PG8_BAR; PG8_MMA(1, 0, At, B0); PG8_MMA(1, 1, At, B1); PG8_BAR; PG8_SCHED;
            PG8_LDB(B0, 1, 0); PG8_LDB(B1, 1, 1); PG8_SCHED; PG8_LDA(At, 1, 0); PG8_STAGE(PG8_SA(0, 1), a2 + hstepA, voffA);
            PG8_WAIT_V(8); PG8_WAIT_L(0); PG8_BAR; PG8_MMA(0, 0, At, B0); PG8_MMA(0, 1, At, B1); PG8_BAR; PG8_SCHED;
            PG8_LDA(At, 1, 1); PG8_STAGE(PG8_SB(1, 0), b3, voffB); PG8_STAGE(PG8_SB(1, 1), b3 + hstepB, voffB); PG8_STAGE(PG8_SA(1, 0), a3, voffA);
            PG8_WAIT_V(8); PG8_WAIT_L(0); PG8_BAR; PG8_MMA(1, 0, At, B0); PG8_MMA(1, 1, At, B1); PG8_BAR; PG8_SCHED;
        }
        if (wr == 0) PG8_BAR;
        E(acc, cur, wr, wc, fr, fq);
        if (!has_next) break;
#pragma unroll
        for (int a = 0; a < 2; ++a)
#pragma unroll
            for (int b = 0; b < 2; ++b)
#pragma unroll
                for (int m = 0; m < 4; ++m)
#pragma unroll
                    for (int n = 0; n < 2; ++n) acc[a][b][m][n] = (f32x4){0.f, 0.f, 0.f, 0.f};
        cur = nxt; cA = nA; cB = nB; ++ui;
        if (wr == 1) PG8_BAR;
    }
    PG8_WAIT_V(0);
    PG8_BAR;
#undef PG8_SA
#undef PG8_SB
#undef PG8_STAGE
#undef PG8_LDA
#undef PG8_LDB
#undef PG8_MMA
#undef PG8_WAIT_V
#undef PG8_WAIT_L
#undef PG8_BAR
#undef PG8_SCHED
}
}


#define XB_TMO      128
#define XB_XCNT(j)  (256  + 64 * (j))
#define XB_XSUB(j)  (1280 + 64 * (j))
#define XB_XGEN(j)  (2304 + 64 * (j))
#define XB_TOP      3328
#define XB_TOPGEN   3392
#define XCD_BAR_WORDS 3456
#define XB_SPIN_CAP (1u << 20)
__device__ __forceinline__ unsigned xb_ld(unsigned* p)              { return __hip_atomic_load(p, __ATOMIC_RELAXED, __HIP_MEMORY_SCOPE_AGENT); }
__device__ __forceinline__ unsigned xb_add(unsigned* p, unsigned v) { return __hip_atomic_fetch_add(p, v, __ATOMIC_RELAXED, __HIP_MEMORY_SCOPE_AGENT); }
__device__ __forceinline__ unsigned xb_xcc_id() { return (unsigned)__builtin_amdgcn_s_getreg((3 << 11) | 20) & 0xFu; }
#define XB_SPIN(cond, bar) do { unsigned _sp = 0; while (cond) { __builtin_amdgcn_s_sleep(0); \
    if ((++_sp & 255u) == 0u) { if (xb_ld(&(bar)[XB_TMO])) break; if (_sp > XB_SPIN_CAP) { atomicAdd(&(bar)[XB_TMO], 1u); break; } } } } while (0)
struct XcdBarrier { unsigned* bar; unsigned x; volatile LAS unsigned* st; };
__device__ __forceinline__ XcdBarrier xcd_barrier_post(unsigned* bar, volatile LAS unsigned* st) {
    XcdBarrier b; b.bar = bar; b.x = xb_xcc_id(); b.st = st;
    if (threadIdx.x == 0) (void)xb_add(&bar[XB_XCNT(b.x)], 1u);
    return b;
}
__device__ __forceinline__ void xcd_barrier_complete(unsigned* bar, unsigned x, unsigned& nloc, unsigned& nx) {
    const unsigned G = gridDim.x * gridDim.y * gridDim.z;
    unsigned sum, cnt, mine, sp = 0u;
    for (;;) {
        sum = 0u; cnt = 0u; mine = 0u;
#pragma unroll
        for (unsigned j = 0; j < 16; ++j) { const unsigned c = xb_ld(&bar[XB_XCNT(j)]); sum += c; cnt += (c > 0u) ? 1u : 0u; mine = (j == x) ? c : mine; }
        if (sum == G) break;
        __builtin_amdgcn_s_sleep(1);
        if ((++sp & 255u) == 0u) { if (xb_ld(&bar[XB_TMO])) break; if (sp > XB_SPIN_CAP) { atomicAdd(&bar[XB_TMO], 1u); break; } }
    }
    nloc = mine > 0u ? mine : 1u; nx = cnt > 0u ? cnt : 1u;
}
__device__ __forceinline__ void xcd_barrier(const XcdBarrier& b) {
    asm volatile("s_waitcnt vmcnt(0)" ::: "memory");
    __syncthreads();
    if (threadIdx.x == 0) {
        unsigned* bar = b.bar;
        __builtin_amdgcn_s_waitcnt(0);
        unsigned nloc = b.st[0], nx = b.st[1];
        if (nloc == 0u) { xcd_barrier_complete(bar, b.x, nloc, nx); b.st[0] = nloc; b.st[1] = nx; }
        const unsigned old = xb_add(&bar[XB_XSUB(b.x)], 1u);
        const unsigned gen = old / nloc;
        if (old + 1u == (gen + 1u) * nloc) {
            __builtin_amdgcn_fence(__ATOMIC_RELEASE, "agent");
            asm volatile("s_waitcnt vmcnt(0)" ::: "memory");
            const unsigned og = xb_add(&bar[XB_TOP], 1u);
            const unsigned tg = og / nx;
            if (og + 1u == (tg + 1u) * nx) xb_add(&bar[XB_TOPGEN], 1u);
            else XB_SPIN(xb_ld(&bar[XB_TOPGEN]) == tg, bar);
            __builtin_amdgcn_fence(__ATOMIC_ACQUIRE, "agent");
            xb_add(&bar[XB_XGEN(b.x)], 1u);
            asm volatile("s_waitcnt vmcnt(0)" ::: "memory");
        } else {
            XB_SPIN(xb_ld(&bar[XB_XGEN(b.x)]) == gen, bar);
            __builtin_amdgcn_fence(__ATOMIC_ACQUIRE, "agent");
            asm volatile("s_waitcnt vmcnt(0)" ::: "memory");
        }
    }
    __syncthreads();
}

__device__ __forceinline__ void sub_barrier(unsigned* word, unsigned n) {
    asm volatile("s_waitcnt vmcnt(0)" ::: "memory");
    __syncthreads();
    if (threadIdx.x == 0) {
        __builtin_amdgcn_fence(__ATOMIC_RELEASE, "agent");
        asm volatile("s_waitcnt vmcnt(0)" ::: "memory");
        xb_add(word, 1u);
        unsigned sp = 0;
        while (xb_ld(word) < n) { __builtin_amdgcn_s_sleep(0); if (++sp > (1u << 22)) break; }
        __builtin_amdgcn_fence(__ATOMIC_ACQUIRE, "agent");
        asm volatile("s_waitcnt vmcnt(0)" ::: "memory");
    }
    __syncthreads();
}

__device__ __forceinline__ void phase_mod(const Params& p, LAS unsigned char* lds) {
    LAS float* sc = (LAS float*)lds;
    LAS float* part = sc + 9 * 1024;
    float* mod = (float*)(PF(ws) + WS_MOD);
    const int tid = tid_(), w = tid >> 6, lane = tid & 63;
    if ((int)blockIdx.x >= 192) return;
    const float* pc = PF(c); const float* pcc = PF(c_ctx); const float* padaw = PF(ada_w); const float* padab = PF(ada_b);
    for (int i = tid; i < 9 * 1024; i += 512) { const int r = i >> 10, k = i & 1023; const float v = (r < 8) ? pc[r * 1024 + k] : pcc[k]; sc[i] = v / (1.0f + expf(-v)); }
    __syncthreads();
    for (int item = blockIdx.x; item < 192; item += gridDim.x) {
        const int l = item / 96, cb = item % 96;
        const float* W = padaw + (size_t)l * 1024 * 6144 + cb * 64 + lane;
        float acc[9];
#pragma unroll
        for (int r = 0; r < 9; ++r) acc[r] = 0.f;
        for (int k = w * 128; k < w * 128 + 128; ++k) { const float wv = W[(size_t)k * 6144];
#pragma unroll
            for (int r = 0; r < 9; ++r) acc[r] += sc[r * 1024 + k] * wv; }
#pragma unroll
        for (int r = 0; r < 9; ++r) part[(w * 9 + r) * 64 + lane] = acc[r];
        __syncthreads();
        for (int i = tid; i < 576; i += 512) { const int r = i >> 6, ln = i & 63; float s = 0.f;
#pragma unroll
            for (int ww = 0; ww < 8; ++ww) s += part[(ww * 9 + r) * 64 + ln];
            mod[(size_t)(l * 9 + r) * 6144 + cb * 64 + ln] = s + padab[l * 6144 + cb * 64 + ln]; }
        __syncthreads();
    }
}
__device__ __forceinline__ void phase_rope(const Params& p) {
    if (blockIdx.x != gridDim.x - 1) return;
    float* rope = (float*)(PF(ws) + WS_ROPE);
    for (int i = tid_(); i < 1024; i += 512) { const int pos = i >> 4, fi = i & 15; const float invf = powf(10000.0f, -(float)fi / 16.0f); const float ang = (float)pos * invf; rope[i] = cosf(ang); rope[1024 + i] = sinf(ang); }
}
__device__ __forceinline__ void convert_tile(const float* src, int K, int N, bf16_t* dst, int tile, LAS bf16_t* T) {
    const int tid = tid_(), tilesN = N >> 7, tk = tile / tilesN, tn = tile - tk * tilesN, k0 = tk * 128, n0 = tn * 128;
    const int r = tid >> 4, c8 = (tid & 15) * 8;
    f32x4 a[4], b[4];
#pragma unroll
    for (int i = 0; i < 4; ++i) { const float* s = src + (size_t)(k0 + r + 32 * i) * N + n0 + c8; a[i] = *(const f32x4*)s; b[i] = *(const f32x4*)(s + 4); }
#pragma unroll
    for (int i = 0; i < 4; ++i)
#pragma unroll
        for (int j = 0; j < 4; ++j) { T[(c8 + j) * 136 + r + 32 * i] = (bf16_t)f2bf(a[i][j]); T[(c8 + 4 + j) * 136 + r + 32 * i] = (bf16_t)f2bf(b[i][j]); }
    __syncthreads();
    const int n = tid >> 2, ks = (tid & 3) * 8;
#pragma unroll
    for (int i = 0; i < 4; ++i) { const u32x4 v = *(const LAS u32x4*)(T + n * 136 + ks + 32 * i); *(u32x4*)(dst + (size_t)(n0 + n) * K + k0 + ks + 32 * i) = v; }
    __syncthreads();
}
__device__ __forceinline__ void phase_convert(const Params& p, int l, LAS unsigned char* lds) {
    LAS bf16_t* T = (LAS bf16_t*)lds;
    bf16_t* WIN = (bf16_t*)(PF(ws) + WS_WIN); bf16_t* WB = (bf16_t*)(PF(ws) + WS_WB); bf16_t* WO = (bf16_t*)(PF(ws) + WS_WO); bf16_t* W1 = (bf16_t*)(PF(ws) + WS_W1); bf16_t* W2 = (bf16_t*)(PF(ws) + WS_W2);
    for (int it = blockIdx.x; it < 1184; it += gridDim.x) {
        if (it < 512) convert_tile(PF(w_in) + (size_t)l * DM * DIN, DM, DIN, WIN, it, T);
        else if (it < 608) { const int n = (it - 512) / 32, tl = (it - 512) % 32; convert_tile(PF(w_branch) + (size_t)(l * 3 + n) * 512 * DM, 512, DM, WB + (size_t)n * DM * 512, tl, T); }
        else if (it < 672) convert_tile(PF(w_out) + (size_t)l * DM * DM, DM, DM, WO, it - 608, T);
        else if (it < 928) convert_tile(PF(ffn_w1) + (size_t)l * DM * DFF, DM, DFF, W1, it - 672, T);
        else convert_tile(PF(ffn_w2) + (size_t)l * DFF * DM, DFF, DM, W2, it - 928, T);
    }
}
__device__ __forceinline__ void phase_norm(const Params& p, int l, const float* hlat, const float* hctx, const float* g, int modoff, int nrows, const float* slab = nullptr, const float* slabgate = nullptr, float* hwrite = nullptr) {
    const int tid = tid_(); const int w = tid >> 6, lane = tid & 63;
    bf16_t* U = (bf16_t*)(PF(ws) + WS_U); const float* mod = (const float*)(PF(ws) + WS_MOD);
    for (int row = blockIdx.x * 8 + w; row < nrows; row += gridDim.x * 8) {
        const float* src = row < NLAT ? hlat + (size_t)row * DM : hctx + (size_t)(row - NLAT) * DM;
        const int mr = row < NLAT ? (row >> 11) : 8;
        const float* md = mod + (size_t)(l * 9 + mr) * 6144 + modoff;
        f32x4 v[4]; float ss = 0.f;
#pragma unroll
        for (int i = 0; i < 4; ++i) { v[i] = *(const f32x4*)(src + i * 256 + lane * 4);
            if (slab != nullptr && row >= NLAT) { const size_t o = (size_t)(row - NLAT) * DM + i * 256 + lane * 4; const f32x4 gg = *(const f32x4*)(slabgate + i * 256 + lane * 4);
                const f32x4 s4 = (*(const f32x4*)(slab + o) + *(const f32x4*)(slab + o + (size_t)NCTX * DM)) + (*(const f32x4*)(slab + o + (size_t)2 * NCTX * DM) + *(const f32x4*)(slab + o + (size_t)3 * NCTX * DM));
                v[i] += gg * s4; if (hwrite != nullptr) *(f32x4*)(hwrite + o) = v[i]; }
            ss += v[i][0] * v[i][0] + v[i][1] * v[i][1] + v[i][2] * v[i][2] + v[i][3] * v[i][3]; }
#pragma unroll
        for (int o = 32; o >= 1; o >>= 1) ss += __shfl_xor(ss, o);
        const float rstd = rsqrtf(ss * (1.0f / 1024.0f) + 1e-6f);
#pragma unroll
        for (int i = 0; i < 4; ++i) { const int cidx = i * 256 + lane * 4; const f32x4 gg = *(const f32x4*)(g + cidx), sh = *(const f32x4*)(md + cidx), scv = *(const f32x4*)(md + 1024 + cidx);
            float o4[4];
#pragma unroll
            for (int j = 0; j < 4; ++j) o4[j] = (v[i][j] * rstd * gg[j]) * (1.0f + scv[j]) + sh[j];
            u32x2 wv; wv.x = pack2(o4[0], o4[1]); wv.y = pack2(o4[2], o4[3]);
            *(u32x2*)(U + (size_t)row * DM + cidx) = wv; }
    }
}
__device__ __forceinline__ void phase_hg_final(const Params& p, int l, int b, int wgi, int nw) {
    const int tid = tid_(); const int w = tid >> 6, lane = tid & 63; bf16_t* P = (bf16_t*)(PF(ws) + WS_P);
    const int hd = lane >> 4, e8 = (lane & 15) * 8; const float* png = PF(hg_norm_g);
    float ng[8];
#pragma unroll
    for (int i = 0; i < 8; ++i) ng[i] = png[l * 128 + e8 + i];
    const int nrow_b = (l == 1) ? 2048 : 2304;
    for (int i0 = wgi * 8 + w; i0 < nrow_b; i0 += 3 * nw) {
        u32x4 ra[3], rb[3], ro[3]; bf16_t* rp[3];
#pragma unroll
        for (int k = 0; k < 3; ++k) { const int i = i0 + nw * k; const int ic = i < nrow_b ? i : i0; const size_t row = ic < 2048 ? (size_t)b * SEQ + ic : (size_t)NLAT + b * CTXL + (ic - 2048);
            rp[k] = P + row * PW; ra[k] = *(const u32x4*)(rp[k] + C_BF + hd * 128 + e8); rb[k] = *(const u32x4*)(rp[k] + C_BF + 512 + hd * 128 + e8); ro[k] = *(const u32x4*)(rp[k] + C_BO + hd * 128 + e8); }
#pragma unroll
        for (int k = 0; k < 3; ++k) {
            float a[8], bb[8], og[8]; unpack8(ra[k], a); unpack8(rb[k], bb); unpack8(ro[k], og);
            float ss = 0.f;
#pragma unroll
            for (int i = 0; i < 8; ++i) { a[i] += bb[i]; ss += a[i] * a[i]; }
            ss += __shfl_xor(ss, 1); ss += __shfl_xor(ss, 2); ss += __shfl_xor(ss, 4); ss += __shfl_xor(ss, 8);
            const float rstd = rsqrtf(ss * (1.0f / 128.0f) + 1e-6f);
            float y[8];
#pragma unroll
            for (int i = 0; i < 8; ++i) y[i] = a[i] * rstd * ng[i] * sigmoidf_(og[i]);
            if (i0 + nw * k < nrow_b) *(u32x4*)(rp[k] + C_BO + hd * 128 + e8) = pack8(y);
        }
    }
}

__device__ __forceinline__ size_t agg_idx(int b, int gch, int dir, int which, int ch) { return ((((size_t)b * 36 + gch) * 2 + dir) * 2 + which) * 512 + ch; }
__device__ __forceinline__ float gelu_tanh(float x) { const float u = 0.7978845608028654f * (x + 0.044715f * x * x * x); const float th = 1.0f - 2.0f * __builtin_amdgcn_rcpf(1.0f + fexp_(2.0f * u)); return 0.5f * x * (1.0f + th); }
struct LruPtrs { bf16_t* P; float* AGG; const float *cb, *cw, *ba, *bx, *lam; };
__device__ __forceinline__ LruPtrs lru_ptrs() { LruPtrs q; q.P = (bf16_t*)(PF(ws) + WS_P); q.AGG = (float*)(PF(ws) + WS_AGG); q.cb = PF(conv_b); q.cw = PF(conv_w); q.ba = PF(lru_ba); q.bx = PF(lru_bx); q.lam = PF(lru_lambda); return q; }
__device__ __forceinline__ void lru_tile(const Params& p, int l, LAS unsigned char* lds, int item, int mode, int& staged_nb, const LruPtrs& lp, float (&kc)[3]) {
    LAS bf16_t* Wl = (LAS bf16_t*)lds;
    LAS bf16_t* Xb = Wl + 256 * 72;
    LAS float* Xf = (LAS float*)(lds + 46080);
    LAS float* Av = Xf + 4096;
    LAS float* Bv = Av + 8192;
    bf16_t* P = lp.P; float* AGG = lp.AGG;
    const int tid = tid_(), w = tid >> 6, lane = tid & 63, l16 = lane & 15, q4 = lane >> 4;
    const int nb = item & 7, rest = item >> 3, gch = rest % 36, b = rest / 36;
    const bool isctx = gch < 4; const int chunk = isctx ? gch : gch - 4, L = isctx ? CTXL : SEQ;
    const size_t seqrow0 = isctx ? (size_t)NLAT + b * CTXL : (size_t)b * SEQ; const int t0 = chunk * 64;
    if (staged_nb != nb) { const float* pwx = PF(lru_wx); const float* pwa = PF(lru_wa);
        for (int e = tid; e < 4 * 64 * 64; e += 512) { const int mat = e >> 12, i = (e >> 6) & 63, c = e & 63; const int dir = mat >> 1, kind = mat & 1;
            const float* W = kind ? pwx : pwa; const float v = W[((size_t)((l * 2 + dir) * 8 + nb) * 64 + i) * 64 + c];
            const int op = dir * 128 + (c >> 4) * 32 + kind * 16 + (c & 15);
            Wl[op * 72 + i] = (bf16_t)f2bf(v); }
        { const int dir = w >> 2, ch = nb * 64 + (w & 3) * 16 + l16; kc[0] = lp.ba[(l * 2 + dir) * 512 + ch]; kc[1] = lp.bx[(l * 2 + dir) * 512 + ch]; kc[2] = log1pf(expf(-lp.lam[(l * 2 + dir) * 512 + ch])); }
        staged_nb = nb;
    }
    {
        const int t = tid >> 3, c8 = (tid & 7) * 8, ch = nb * 64 + c8, tt = t0 + t;
        float a8[8]; const float* pcb = lp.cb; const float* pcw = lp.cw;
        { const f32x4 b0 = *(const f32x4*)(pcb + l * 512 + ch), b1 = *(const f32x4*)(pcb + l * 512 + ch + 4);
#pragma unroll
          for (int i = 0; i < 4; ++i) { a8[i] = b0[i]; a8[4 + i] = b1[i]; } }
#pragma unroll
        for (int j = 0; j < 4; ++j) { const int ts = tt + j - 2;
            if (ts >= 0 && ts < L) { float xv[8]; unpack8(*(const u32x4*)(P + (seqrow0 + ts) * PW + C_AX + ch), xv);
                const f32x4 w0 = *(const f32x4*)(pcw + (l * 4 + j) * 512 + ch), w1 = *(const f32x4*)(pcw + (l * 4 + j) * 512 + ch + 4);
#pragma unroll
                for (int i = 0; i < 4; ++i) { a8[i] += xv[i] * w0[i]; a8[4 + i] += xv[4 + i] * w1[i]; } } }
#pragma unroll
        for (int i = 0; i < 8; ++i) Xf[t * 64 + c8 + i] = a8[i];
        *(LAS u32x4*)(Xb + t * 72 + c8) = pack8(a8);
    }
    __syncthreads();
    {
        const int dir = w >> 2, c = (w & 3) * 16 + l16, ch = nb * 64 + c;
        f32x4 acc[4][2];
#pragma unroll
        for (int mg = 0; mg < 4; ++mg) { acc[mg][0] = (f32x4){0.f, 0.f, 0.f, 0.f}; acc[mg][1] = (f32x4){0.f, 0.f, 0.f, 0.f}; }
#pragma unroll
        for (int ks = 0; ks < 2; ++ks) {
            const bf16x8 B0 = *(const LAS bf16x8*)(Wl + (w * 32 + l16) * 72 + ks * 32 + q4 * 8), B1 = *(const LAS bf16x8*)(Wl + (w * 32 + 16 + l16) * 72 + ks * 32 + q4 * 8);
#pragma unroll
            for (int mg = 0; mg < 4; ++mg) { const bf16x8 A = *(const LAS bf16x8*)(Xb + (mg * 16 + l16) * 72 + ks * 32 + q4 * 8);
                acc[mg][0] = mfma16(A, B0, acc[mg][0]); acc[mg][1] = mfma16(A, B1, acc[mg][1]); }
        }
        const float ba = kc[0], bx = kc[1], sp = kc[2];
#pragma unroll
        for (int mg = 0; mg < 4; ++mg)
#pragma unroll
            for (int j = 0; j < 4; ++j) { const int t = mg * 16 + q4 * 4 + j;
                const float ea = 1.0f + fexp_(-(acc[mg][0][j] + ba)), ex = 1.0f + fexp_(-(acc[mg][1][j] + bx)); const float inv = __builtin_amdgcn_rcpf(ea * ex);
                const float r = inv * ex, ig = inv * ea;
                const float la = -8.0f * r * sp; const float a = fexp_(la); const float x2 = 2.0f * la;
                float om = -x2 * (1.0f + x2 * (0.5f + x2 * (0.16666667f + x2 * (0.041666668f + x2 * 0.0083333338f))));
                if (x2 < -0.35f) om = 1.0f - a * a;
                const float bb = sqrtf(fmaxf(om, 0.f)) * ig * Xf[t * 64 + c];
                Av[(dir * 64 + t) * 64 + c] = a; Bv[(dir * 64 + t) * 64 + c] = bb; }
    }
    __syncthreads();
    {
        LAS float* SegA = Xf;
        LAS float* SegB = Xf + 512;
        const int d2 = tid >> 8, seg = (tid >> 6) & 3, c = tid & 63, ch = nb * 64 + c;
        float av[16], bv[16];
#pragma unroll
        for (int k = 0; k < 16; ++k) { const int s = seg * 16 + k; const int t = d2 ? 63 - s : s; const int ix = (d2 * 64 + t) * 64 + c; av[k] = Av[ix]; bv[k] = Bv[ix]; }
        float h = 0.f, ap = 1.f;
#pragma unroll
        for (int k = 0; k < 16; ++k) { h = av[k] * h + bv[k]; ap *= av[k]; }
        SegA[(d2 * 4 + seg) * 64 + c] = ap; SegB[(d2 * 4 + seg) * 64 + c] = h;
        float hin = 0.f;
        if (mode == 1) {
            const int mypos = d2 == 0 ? gch : (gch < 4 ? 3 - gch : 39 - gch);
            for (int p0 = 0; p0 < mypos; p0 += 6) { float Aa[6], Bb[6];
#pragma unroll
                for (int j = 0; j < 6; ++j) { const int pp = p0 + j; const int g = d2 == 0 ? pp : (pp < 4 ? 3 - pp : 39 - pp); const bool ok = pp < mypos;
                    Aa[j] = ok ? AGG[agg_idx(b, ok ? g : 0, d2, 0, ch)] : 1.0f; Bb[j] = ok ? AGG[agg_idx(b, ok ? g : 0, d2, 1, ch)] : 0.0f; }
#pragma unroll
                for (int j = 0; j < 6; ++j) hin = Aa[j] * hin + Bb[j]; }
        }
        __syncthreads();
        if (mode == 0) {
            if (seg == 3) { float A = 1.f, B = 0.f;
#pragma unroll
                for (int s2 = 0; s2 < 4; ++s2) { const float sa = SegA[(d2 * 4 + s2) * 64 + c], sb2 = SegB[(d2 * 4 + s2) * 64 + c]; B = sa * B + sb2; A *= sa; }
                AGG[agg_idx(b, gch, d2, 0, ch)] = A; AGG[agg_idx(b, gch, d2, 1, ch)] = B; }
        } else {
#pragma unroll
            for (int s2 = 0; s2 < 3; ++s2) if (s2 < seg) hin = SegA[(d2 * 4 + s2) * 64 + c] * hin + SegB[(d2 * 4 + s2) * 64 + c];
            float hh2 = hin;
#pragma unroll
            for (int k = 0; k < 16; ++k) { const int s = seg * 16 + k; const int t = d2 ? 63 - s : s; hh2 = av[k] * hh2 + bv[k]; Bv[(d2 * 64 + t) * 64 + c] = hh2; }
        }
    }
    __syncthreads();
    if (mode == 1) {
        const int t = tid >> 3, c8 = (tid & 7) * 8; bf16_t* gp = P + (seqrow0 + t0 + t) * PW + C_AG + nb * 64 + c8;
        float gt[8]; unpack8(*(const u32x4*)gp, gt); float y[8];
#pragma unroll
        for (int i = 0; i < 8; ++i) y[i] = (Bv[t * 64 + c8 + i] + Bv[(64 + t) * 64 + c8 + i]) * gelu_tanh(gt[i]);
        *(u32x4*)gp = pack8(y);
        __syncthreads();
    }
}

template <bool B> struct BoolC { static constexpr bool value = B; };
__device__ __forceinline__ void attn_item(const Params& p, int l, LAS unsigned char* lds, int item, int dry = 0) {
    LAS bf16_t* Kt = (LAS bf16_t*)lds;
    LAS float* rpbL = (LAS float*)(lds + 73728);
    LAS float* cosT = rpbL + 960;
    LAS float* sinT = cosT + 1024;
    LAS float* gq = sinT + 1024; LAS float* gk = gq + 64;
    bf16_t* P = (bf16_t*)(PF(ws) + WS_P); const float* rope = (const float*)(PF(ws) + WS_ROPE);
    const int tid = tid_(), w = __builtin_amdgcn_readfirstlane(tid >> 6), lane = tid & 63, l16 = lane & 15, q4 = lane >> 4, hh = w >> 2, qg4 = w & 3;
    const bool isctx = item >= 512;
    int b, hp, nloc, krU; int rq[2], kq0[2]; size_t qrow0[2];
    if (!isctx) { hp = item & 3; const int rp = (item >> 2) & 15; b = item >> 6;
        rq[0] = 2 * rp; rq[1] = 2 * rp + 1; kq0[0] = min(max(rq[0] - 4, 0), 24); kq0[1] = min(max(rq[1] - 4, 0), 24);
        qrow0[0] = (size_t)b * SEQ + rq[0] * 64; qrow0[1] = qrow0[0] + 64; krU = kq0[0]; nloc = kq0[1] + 8 - kq0[0]; }
    else { const int it = item - 512; hp = it & 3; const int qt = (it >> 2) & 1; b = it >> 3; rq[0] = rq[1] = 0; kq0[0] = kq0[1] = 0; krU = 0; nloc = 0;
        qrow0[0] = (size_t)NLAT + b * CTXL + qt * 128; qrow0[1] = qrow0[0] + 64; }
    const int h = hp * 2 + hh;
    const float* prpb = PF(na_rpb);
    for (int i = tid; i < 2 * 465; i += 512) { const int h2 = i / 465, j = i - h2 * 465; rpbL[h2 * 480 + j] = prpb[(size_t)((l * 8 + hp * 2 + h2) * 465) + j]; }
    for (int i = tid; i < 1024; i += 512) { cosT[i] = rope[i]; sinT[i] = rope[1024 + i]; }
    if (tid < 64) { gq[tid] = PF(na_qg)[l * 64 + tid]; gk[tid] = PF(na_kg)[l * 64 + tid]; }
    __syncthreads();
    const int qc = qg4 * 16 + l16;
    const int glo = qg4 < 2 ? 0 : qg4 - 1, ghi = qg4 == 0 ? 1 : (qg4 == 3 ? 3 : qg4 + 1);
    unsigned mbits = 0u; const int bbase = q4 * 4 - qc;
    { const int cs0 = min(max(qc - 8, 0), 48);
#pragma unroll
      for (int g = 0; g < 4; ++g)
#pragma unroll
          for (int j = 0; j < 4; ++j) { const int kc = g * 16 + q4 * 4 + j; if (kc < cs0 || kc >= cs0 + 16) mbits |= 1u << (g * 4 + j); } }
    bf16x8 qpl[2][2], qrt[2][2];
#pragma unroll
    for (int qi = 0; qi < 2; ++qi) {
        const bf16_t* qp = P + (qrow0[qi] + qc) * PW + C_CQ + h * 64;
        float xq[16]; unpack8(*(const u32x4*)(qp + q4 * 8), xq); unpack8(*(const u32x4*)(qp + 32 + q4 * 8), xq + 8);
        float ss = 0.f;
#pragma unroll
        for (int i = 0; i < 16; ++i) ss += xq[i] * xq[i];
        ss += __shfl_xor(ss, 16); ss += __shfl_xor(ss, 32);
        const float rs = rsqrtf(ss * (1.0f / 64.0f) + 1e-6f) * 0.125f;
#pragma unroll
        for (int i = 0; i < 8; ++i) { xq[i] *= rs * gq[q4 * 8 + i]; xq[8 + i] *= rs * gq[32 + q4 * 8 + i]; }
        qpl[qi][0] = as_bf16x8(pack8(xq)); qpl[qi][1] = as_bf16x8(pack8(xq + 8));
        float xr[16];
#pragma unroll
        for (int ks = 0; ks < 2; ++ks) { const int pos = ks == 0 ? rq[qi] : qc;
#pragma unroll
            for (int jj = 0; jj < 8; ++jj) { const int fi = (q4 & 1) * 8 + jj; const float cs = cosT[pos * 16 + fi], sn = sinT[pos * 16 + fi]; const float xv = xq[ks * 8 + jj]; const float pr = __shfl_xor(xv, 32);
                xr[ks * 8 + jj] = (q4 < 2) ? (xv * cs - pr * sn) : (xv * cs + pr * sn); } }
        qrt[qi][0] = as_bf16x8(pack8(xr)); qrt[qi][1] = as_bf16x8(pack8(xr + 8));
    }
    f32x4 O[2][4];
#pragma unroll
    for (int qi = 0; qi < 2; ++qi)
#pragma unroll
        for (int i = 0; i < 4; ++i) O[qi][i] = (f32x4){0.f, 0.f, 0.f, 0.f};
    float mrun[2] = {-1e30f, -1e30f}, lsum[2] = {0.f, 0.f};
    const int pf_hh2 = tid >> 8, pf_h2 = hp * 2 + pf_hh2, pf_key = (tid & 255) >> 2, pf_seg = tid & 3, pf_vseg = (tid & 255) >> 6, pf_vkey = tid & 63;
    u32x4 pk0, pk1, pv0, pv1;
    { const size_t r0 = nloc ? (size_t)b * SEQ + krU * 64 : (size_t)NLAT + b * CTXL;
      const bf16_t* kp = P + (r0 + pf_key) * PW + C_CK + pf_h2 * 64 + pf_seg * 16; pk0 = *(const u32x4*)kp; pk1 = *(const u32x4*)(kp + 8);
      const bf16_t* vp = P + (r0 + pf_vkey) * PW + C_CV + pf_h2 * 64 + pf_vseg * 16; pv0 = *(const u32x4*)vp; pv1 = *(const u32x4*)(vp + 8); }
    const int ntot = nloc + 4;
    float gkr[16];
#pragma unroll
    for (int i = 0; i < 16; ++i) gkr[i] = gk[pf_seg * 16 + i];
    auto stage = [&](int T, int buf) {
        const bool sloc = T < nloc; const int kr = krU + T;
        LAS bf16_t* KtB = Kt + buf * (4 * 64 * 72); LAS bf16_t* VtB = KtB + 2 * 64 * 72;
        {
            const int hh2 = pf_hh2, key = pf_key, seg = pf_seg;
            float xk[16]; unpack8(pk0, xk); unpack8(pk1, xk + 8);
            float ss = 0.f;
#pragma unroll
            for (int i = 0; i < 16; ++i) ss += xk[i] * xk[i];
            ss += dpp_xor1(ss); ss += dpp_xor2(ss);
            const float rs = rsqrtf(ss * (1.0f / 64.0f) + 1e-6f);
#pragma unroll
            for (int i = 0; i < 16; ++i) xk[i] *= rs * gkr[i];
            if (sloc) { const int pos = seg < 2 ? kr : key;
#pragma unroll
                for (int i = 0; i < 16; ++i) { const float pr = dpp_xor1(xk[i]); const float cs = cosT[pos * 16 + i], sn = sinT[pos * 16 + i]; xk[i] = (seg & 1) ? (xk[i] * cs + pr * sn) : (xk[i] * cs - pr * sn); } }
            LAS bf16_t* kd = KtB + (hh2 * 64 + key) * 72 + seg * 16;
            *(LAS u32x4*)kd = pack8(xk); *(LAS u32x4*)(kd + 8) = pack8(xk + 8);
        }
        {
            const int hh2 = pf_hh2, seg = pf_vseg, key = pf_vkey;
            const u32x4 a = pv0, c = pv1;
            LAS bf16_t* vd = VtB + (hh2 * 64 + seg * 16) * 72 + key;
            vd[0 * 72] = (bf16_t)(a.x & 0xffff); vd[1 * 72] = (bf16_t)(a.x >> 16); vd[2 * 72] = (bf16_t)(a.y & 0xffff); vd[3 * 72] = (bf16_t)(a.y >> 16);
            vd[4 * 72] = (bf16_t)(a.z & 0xffff); vd[5 * 72] = (bf16_t)(a.z >> 16); vd[6 * 72] = (bf16_t)(a.w & 0xffff); vd[7 * 72] = (bf16_t)(a.w >> 16);
            vd[8 * 72] = (bf16_t)(c.x & 0xffff); vd[9 * 72] = (bf16_t)(c.x >> 16); vd[10 * 72] = (bf16_t)(c.y & 0xffff); vd[11 * 72] = (bf16_t)(c.y >> 16);
            vd[12 * 72] = (bf16_t)(c.z & 0xffff); vd[13 * 72] = (bf16_t)(c.z >> 16); vd[14 * 72] = (bf16_t)(c.w & 0xffff); vd[15 * 72] = (bf16_t)(c.w >> 16);
        }
        { const int Tn = T + 1; if (Tn < ntot) { const size_t r0 = (Tn < nloc) ? (size_t)b * SEQ + (krU + Tn) * 64 : (size_t)NLAT + b * CTXL + (Tn - nloc) * 64;
            const bf16_t* kp = P + (r0 + pf_key) * PW + C_CK + pf_h2 * 64 + pf_seg * 16; pk0 = *(const u32x4*)kp; pk1 = *(const u32x4*)(kp + 8);
            const bf16_t* vp = P + (r0 + pf_vkey) * PW + C_CV + pf_h2 * 64 + pf_vseg * 16; pv0 = *(const u32x4*)vp; pv1 = *(const u32x4*)(vp + 8); } }
    };
    auto compute = [&](auto LOC, int T, int buf) {
        constexpr bool loc = decltype(LOC)::value; const int kr = krU + T;
        const LAS bf16_t* KtB = Kt + buf * (4 * 64 * 72); const LAS bf16_t* VtB = KtB + 2 * 64 * 72;
#pragma unroll
        for (int qi = 0; qi < 2; ++qi) {
            if (loc && (kr < kq0[qi] || kr >= kq0[qi] + 8)) continue;
            f32x4 st[4];
#pragma unroll
            for (int g = 0; g < 4; ++g) { const bool use = !loc || (g >= glo && g <= ghi);
                st[g] = (f32x4){0.f, 0.f, 0.f, 0.f};
                if (use) {
#pragma unroll
                    for (int ks = 0; ks < 2; ++ks) st[g] = mfma16(*(const LAS bf16x8*)(KtB + (hh * 64 + g * 16 + l16) * 72 + ks * 32 + q4 * 8), loc ? qrt[qi][ks] : qpl[qi][ks], st[g]);
                    if (loc) { const int dr31 = (kr - rq[qi] + 7) * 31;
#pragma unroll
                        for (int j = 0; j < 4; ++j) { const float sv = st[g][j] + rpbL[hh * 480 + min(max(bbase + g * 16 + j, -15), 15) + 15 + dr31]; st[g][j] = ((mbits >> (g * 4 + j)) & 1u) ? -1e30f : sv; } }
                } else st[g] = (f32x4){-1e30f, -1e30f, -1e30f, -1e30f};
            }
            float tmax = -1e30f;
#pragma unroll
            for (int g = 0; g < 4; ++g)
#pragma unroll
                for (int j = 0; j < 4; ++j) tmax = fmaxf(tmax, st[g][j]);
            tmax = fmaxf(tmax, __shfl_xor(tmax, 16)); tmax = fmaxf(tmax, __shfl_xor(tmax, 32));
            const float mnew = fmaxf(mrun[qi], tmax); const float alpha = fexp_(mrun[qi] - mnew); mrun[qi] = mnew;
            float psum = 0.f;
#pragma unroll
            for (int g = 0; g < 4; ++g) { const bool use = !loc || (g >= glo && g <= ghi);
                if (use) {
#pragma unroll
                    for (int j = 0; j < 4; ++j) { const float pv = fexp_(st[g][j] - mnew); st[g][j] = pv; psum += pv; }
                } else st[g] = (f32x4){0.f, 0.f, 0.f, 0.f}; }
            lsum[qi] = lsum[qi] * alpha + psum;
#pragma unroll
            for (int i = 0; i < 4; ++i) O[qi][i] *= alpha;
            bf16x8 pb[2];
#pragma unroll
            for (int ks = 0; ks < 2; ++ks) { u32x4 wv; wv.x = pack2(st[2 * ks][0], st[2 * ks][1]); wv.y = pack2(st[2 * ks][2], st[2 * ks][3]); wv.z = pack2(st[2 * ks + 1][0], st[2 * ks + 1][1]); wv.w = pack2(st[2 * ks + 1][2], st[2 * ks + 1][3]); pb[ks] = as_bf16x8(wv); }
#pragma unroll
            for (int ks = 0; ks < 2; ++ks) if (!loc || (2 * ks + 1 >= glo && 2 * ks <= ghi))
#pragma unroll
                for (int dg = 0; dg < 4; ++dg) { const LAS bf16_t* vr = VtB + (hh * 64 + dg * 16 + l16) * 72 + ks * 32 + q4 * 4;
                    const u32x2 lo = *(const LAS u32x2*)vr, hi = *(const LAS u32x2*)(vr + 16); u32x4 av; av.x = lo.x; av.y = lo.y; av.z = hi.x; av.w = hi.y;
                    O[qi][dg] = mfma16(as_bf16x8(av), pb[ks], O[qi][dg]); }
        }
    };
    stage(0, 0);
    __syncthreads();
    for (int T = 0; T < nloc; ++T) {
        stage(T + 1, (T + 1) & 1);
        compute(BoolC<true>{}, T, T & 1);
        __syncthreads();
    }
    for (int T = nloc; T < ntot; ++T) {
        if (T + 1 < ntot) stage(T + 1, (T + 1) & 1);
        compute(BoolC<false>{}, T, T & 1);
        __syncthreads();
    }
#pragma unroll
    for (int qi = 0; qi < 2; ++qi) {
        float ls = lsum[qi]; ls += __shfl_xor(ls, 16); ls += __shfl_xor(ls, 32);
        const float inv = 1.0f / ls;
        bf16_t* op = dry ? ((bf16_t*)(PF(ws) + WS_DUMMY) + (size_t)(blockIdx.x & 63) * 16384 + (size_t)((qi * 8 + w) * 16 + l16) * 64) : (P + (qrow0[qi] + qc) * PW + C_CQ + h * 64);
#pragma unroll
        for (int dg = 0; dg < 4; ++dg) { u32x2 wv; wv.x = pack2(O[qi][dg][0] * inv, O[qi][dg][1] * inv); wv.y = pack2(O[qi][dg][2] * inv, O[qi][dg][3] * inv); *(u32x2*)(op + dg * 16 + q4 * 4) = wv; }
    }
    __syncthreads();
}

__device__ __forceinline__ void hgrn_stage(const bf16_t* P, LAS unsigned char* lds, int w, int lane, size_t row0, int dir, int h) {
#pragma unroll
    for (int i = 0; i < 2; ++i) { const int blk = i * 8 + w; const int t = blk * 4 + (lane >> 4); const bf16_t* rp = P + (row0 + (dir ? 63 - t : t)) * PW + (lane & 15) * 8;
        __builtin_amdgcn_global_load_lds((const unsigned*)(rp + C_BQ + h * 128), (LAS unsigned*)(lds + 118784 + blk * 1024), 16, 0, 0);
        __builtin_amdgcn_global_load_lds((const unsigned*)(rp + C_BF + dir * 512 + h * 128), (LAS unsigned*)(lds + 135168 + blk * 1024), 16, 0, 0); }
}
__device__ __forceinline__ void hgrn_chain(const Params& p, int l, LAS unsigned char* lds, int chain, int dry = 0) {
    LAS bf16_t* Q0 = (LAS bf16_t*)lds;
    LAS bf16_t* KP = (LAS bf16_t*)(lds + 17408);
    LAS bf16_t* SB = (LAS bf16_t*)(lds + 34816);
    LAS bf16_t* KDT = (LAS bf16_t*)(lds + 69632);
    LAS bf16_t* VT = (LAS bf16_t*)(lds + 88064);
    LAS bf16_t* ATT = (LAS bf16_t*)(lds + 106496);
    LAS float* TOT = (LAS float*)(lds + 115712);
    LAS float* DD = (LAS float*)(lds + 117760);
    const LAS bf16_t* SQ = (const LAS bf16_t*)(lds + 118784);
    const LAS bf16_t* SF = (const LAS bf16_t*)(lds + 135168);
    bf16_t* P = (bf16_t*)(PF(ws) + WS_P);
    const int tid = tid_(), w = __builtin_amdgcn_readfirstlane(tid >> 6), lane = tid & 63, l16 = lane & 15, q4 = lane >> 4;
    const int dir = chain & 1, h = (chain >> 1) & 3, b = chain >> 3;
    const int d = tid & 127, sb = tid >> 7;
    float lbv = 0.f;
    if (l > 0) { const float x0 = PF(hg_lb)[(dir * 2 + 0) * 512 + h * 128 + d], x1 = PF(hg_lb)[(dir * 2 + 1) * 512 + h * 128 + d]; lbv = 1.0f / (1.0f + expf(x0 - x1)); }
    for (int i = tid; i < 64 * 72 / 2; i += 512) ((LAS unsigned*)ATT)[i] = 0u;
    f32x4 S[8];
#pragma unroll
    for (int i = 0; i < 8; ++i) S[i] = (f32x4){0.f, 0.f, 0.f, 0.f};
    { const int gch0 = dir == 0 ? 0 : 3; hgrn_stage(P, lds, w, lane, (size_t)NLAT + b * CTXL + gch0 * 64, dir, h); }
    asm volatile("s_waitcnt vmcnt(0)" ::: "memory");
    __syncthreads();
    for (int ci = 0; ci < 36; ++ci) {
        const int gch = dir == 0 ? ci : (ci < 4 ? 3 - ci : 39 - ci);
        const bool isctx = gch < 4; const int chunk = isctx ? gch : gch - 4;
        const size_t row0 = isctx ? (size_t)NLAT + b * CTXL + chunk * 64 : (size_t)b * SEQ + chunk * 64;
        float bl[16], qv[16], kv[16]; float run = 0.f;
        {
            unsigned vraw[16];
            { const bf16_t* vp = P + (row0 + (dir ? 63 - sb * 16 : sb * 16)) * PW + C_BI + h * 128 + d; const long vstep = dir ? -(long)PW : (long)PW;
#pragma unroll
              for (int ii = 0; ii < 16; ++ii) { vraw[ii] = *vp; vp += vstep; } }
#pragma unroll
            for (int eg = 0; eg < 8; ++eg) { u32x2 wv; wv.x = pack2(S[eg][0], S[eg][1]); wv.y = pack2(S[eg][2], S[eg][3]); *(LAS u32x2*)(SB + (eg * 16 + l16) * 136 + w * 16 + q4 * 4) = wv; }
#pragma unroll
            for (int ii = 0; ii < 16; ++ii) { const int t = sb * 16 + ii;
                const float fr = bf2f(SF[t * 128 + d]), qr = bf2f(SQ[t * 128 + d]);
                const float sg = __builtin_amdgcn_rcpf(1.0f + fexp_(-fr)); const float f = lbv + (1.0f - lbv) * sg; run += flog_(f); bl[ii] = run; kv[ii] = 1.0f - f; qv[ii] = qr * __builtin_amdgcn_rcpf(1.0f + fexp_(-qr)); }
            TOT[sb * 128 + d] = run;
            u32x4 v0, v1; v0.x = vraw[0] | (vraw[1] << 16); v0.y = vraw[2] | (vraw[3] << 16); v0.z = vraw[4] | (vraw[5] << 16); v0.w = vraw[6] | (vraw[7] << 16);
            v1.x = vraw[8] | (vraw[9] << 16); v1.y = vraw[10] | (vraw[11] << 16); v1.z = vraw[12] | (vraw[13] << 16); v1.w = vraw[14] | (vraw[15] << 16);
            *(LAS u32x4*)(VT + d * 72 + sb * 16) = v0; *(LAS u32x4*)(VT + d * 72 + sb * 16 + 8) = v1;
        }
        __syncthreads();
        if (ci < 35) { const int cn = ci + 1; const int gn = dir == 0 ? cn : (cn < 4 ? 3 - cn : 39 - cn); const bool cx = gn < 4; const int ck = cx ? gn : gn - 4;
            hgrn_stage(P, lds, w, lane, cx ? (size_t)NLAT + b * CTXL + ck * 64 : (size_t)b * SEQ + ck * 64, dir, h); }
        {
            const float t0 = TOT[d], t1 = TOT[128 + d], t2 = TOT[256 + d], t3 = TOT[384 + d];
            const float Bs1 = t0, Bs2 = t0 + t1, Bs3 = Bs2 + t2, total = Bs3 + t3;
            const float Bsb = sb == 0 ? 0.f : (sb == 1 ? Bs1 : (sb == 2 ? Bs2 : Bs3));
            const float eB = fexp_(Bsb), eT = fexp_(total);
            float kd[16];
#pragma unroll
            for (int ii = 0; ii < 16; ++ii) { const float e0 = fexp_(bl[ii]); Q0[(sb * 16 + ii) * 136 + d] = (bf16_t)pack2(qv[ii] * e0 * eB, 0.f);
                const float kp = kv[ii] * fexp_(fminf(-(Bsb + bl[ii]), 80.f)); KP[(sb * 16 + ii) * 136 + d] = (bf16_t)pack2(kp, 0.f); kd[ii] = kp * eT; }
            *(LAS u32x4*)(KDT + d * 72 + sb * 16) = pack8(kd); *(LAS u32x4*)(KDT + d * 72 + sb * 16 + 8) = pack8(kd + 8);
            if (sb == 0) DD[d] = eT;
        }
        __syncthreads();
        const bool need_o = !(l == 1 && isctx);
        if (need_o)
#pragma unroll
        for (int k2 = 0; k2 < 2; ++k2) { const int idx = w + 8 * k2;
            if (idx < 10) { const int i = idx < 1 ? 0 : (idx < 3 ? 1 : (idx < 6 ? 2 : 3)); const int j = idx - i * (i + 1) / 2;
                f32x4 sc = (f32x4){0.f, 0.f, 0.f, 0.f};
                const LAS bf16_t* qb = Q0 + (i * 16 + l16) * 136 + q4 * 8; const LAS bf16_t* kb = KP + (j * 16 + l16) * 136 + q4 * 8;
#pragma unroll
                for (int ks = 0; ks < 4; ++ks) sc = mfma16(*(const LAS bf16x8*)(qb + ks * 32), *(const LAS bf16x8*)(kb + ks * 32), sc);
#pragma unroll
                for (int jj = 0; jj < 4; ++jj) { const float v = (i == j && l16 > q4 * 4 + jj) ? 0.f : sc[jj]; ATT[(i * 16 + q4 * 4 + jj) * 72 + j * 16 + l16] = (bf16_t)pack2(v, 0.f); } } }
        __syncthreads();
        if (need_o) {
            bf16x8 SBf[4], VTf[2];
#pragma unroll
            for (int ks = 0; ks < 4; ++ks) SBf[ks] = *(const LAS bf16x8*)(SB + (w * 16 + l16) * 136 + ks * 32 + q4 * 8);
#pragma unroll
            for (int ks = 0; ks < 2; ++ks) VTf[ks] = *(const LAS bf16x8*)(VT + (w * 16 + l16) * 72 + ks * 32 + q4 * 8);
#pragma unroll
            for (int i = 0; i < 4; ++i) { f32x4 oa = (f32x4){0.f, 0.f, 0.f, 0.f};
#pragma unroll
                for (int ks = 0; ks < 4; ++ks) oa = mfma16(SBf[ks], *(const LAS bf16x8*)(Q0 + (i * 16 + l16) * 136 + ks * 32 + q4 * 8), oa);
#pragma unroll
                for (int ks = 0; ks < 2; ++ks) oa = mfma16(VTf[ks], *(const LAS bf16x8*)(ATT + (i * 16 + l16) * 72 + ks * 32 + q4 * 8), oa);
                const int t = i * 16 + l16; u32x2 wv; wv.x = pack2(oa[0], oa[1]); wv.y = pack2(oa[2], oa[3]);
                bf16_t* od = dry ? ((bf16_t*)(PF(ws) + WS_DUMMY) + (size_t)chain * 8192 + t * 128 + w * 16 + q4 * 4) : (P + (row0 + (dir ? 63 - t : t)) * PW + C_BF + dir * 512 + h * 128 + w * 16 + q4 * 4);
                *(u32x2*)od = wv; }
        }
        {
            const f32x4 dd = *(const LAS f32x4*)(DD + w * 16 + q4 * 4);
#pragma unroll
            for (int eg = 0; eg < 8; ++eg) S[eg] *= dd;
#pragma unroll
            for (int ks = 0; ks < 2; ++ks) { const bf16x8 A = *(const LAS bf16x8*)(KDT + (w * 16 + l16) * 72 + ks * 32 + q4 * 8);
#pragma unroll
                for (int eg = 0; eg < 8; ++eg) S[eg] = mfma16(A, *(const LAS bf16x8*)(VT + (eg * 16 + l16) * 72 + ks * 32 + q4 * 8), S[eg]); }
        }
        asm volatile("s_waitcnt vmcnt(0)" ::: "memory");
        __syncthreads();
    }
}

__global__ void __launch_bounds__(512, 2) fwd_megakernel(Params p) {
    extern __shared__ __attribute__((aligned(16))) unsigned char lds_raw[];
    LAS unsigned char* lds = (LAS unsigned char*)lds_raw;
    cg::grid_group grid = cg::this_grid();
    volatile LAS unsigned* xst = (volatile LAS unsigned*)(lds + LDS_BYTES - 16);
    if (threadIdx.x == 0) { xst[0] = 0u; xst[1] = 0u; xst[2] = 0u; xst[3] = 0u; }
    __syncthreads();
    const XcdBarrier xbar = xcd_barrier_post((unsigned*)(PF(ws) + WS_BAR), xst);
    const int G = gridDim.x, c = blockIdx.x;

    phase_mod(p, lds); __syncthreads();
    phase_rope(p);
    phase_convert(p, 0, lds);
    if (PF(ws) == nullptr) grid.sync();
    xcd_barrier(xbar);
#define WSP(T, off) ((T*)(PF(ws) + (off)))
    for (int l = 0; l < 2; ++l) {
        const bool lastl = (l == 1);
        const int Mrest = lastl ? NLAT : NTOK;
        if (l > 0) phase_convert(p, l, lds);
        phase_norm(p, l, l == 0 ? PF(x) : PF(out), l == 0 ? PF(ctx) : WSP(const float, WS_HC), PF(norm1_g) + l * DM, 0, NTOK,
                   (l > 0 && G == 256) ? (const float*)(PF(ws) + WS_P + (size_t)NTOK * DFF * 2) : nullptr, WSP(const float, WS_MOD) + (size_t)((l > 0 ? l - 1 : 0) * 9 + 8) * 6144 + 5120);
        xcd_barrier(xbar);

        { pg8::Gemm g{WSP(bf16_t, WS_U), WSP(bf16_t, WS_WIN), DM, DM, DM}; pg8::Sched S; S.init(NTOK, PW, G, c, DM, DM); pg8::EpiStore<0> E{WSP(bf16_t, WS_P), PW}; pg8::gemm_phase(lds, g, S, E); }
        xcd_barrier(xbar);
        {
            int staged = -1; float kc[3] = {0.f, 0.f, 0.f}; const LruPtrs lp = lru_ptrs();
            if (c < 64) hgrn_chain(p, l, lds, c);
            else { const int cc = c - 64, GG = G - 64; const int nA = lastl ? 512 : 576;
                for (int it = cc; it < nA; it += GG) attn_item(p, l, lds, it);
                for (int it = cc; it < 2304; it += GG) lru_tile(p, l, lds, it, 0, staged, lp, kc); }
            sub_barrier((unsigned*)(PF(ws) + WS_BAR) + 3520 + 64 * (2 * l + 1), (unsigned)G);
            if ((c & 7) != (staged & 7) || staged < 0) staged = -1;
            for (int it = c; it < 2304; it += G) { if (lastl && ((it >> 3) % 36) < 4) continue;
                lru_tile(p, l, lds, it, 1, staged, lp, kc); }
            if (G == 256) phase_hg_final(p, l, c >> 5, c & 31, 256); else if (c < 64) phase_hg_final(p, l, c >> 3, c & 7, 64);
        }
        xcd_barrier(xbar);
        { pg8::Gemm g{WSP(bf16_t, WS_U), WSP(bf16_t, WS_WIN) + (size_t)PW * DM, DM, DM, DM}; pg8::Sched S; S.init(Mrest, 3072, G, c, DM, DM); pg8::EpiStore<1> E{WSP(bf16_t, WS_P), PW}; pg8::gemm_phase(lds, g, S, E); }
        xcd_barrier(xbar);
        { pg8::Gemm g{WSP(bf16_t, WS_P), WSP(bf16_t, WS_WB), PW, 512, 512}; pg8::MergeSched S; S.base.init(Mrest, DM, G, c, PW, 512);
          pg8::EpiMerge E{WSP(bf16_t, WS_P), WSP(bf16_t, WS_U)}; pg8::gemm_phase(lds, g, S, E); }
        xcd_barrier(xbar);
        { pg8::Gemm g{WSP(bf16_t, WS_U), WSP(bf16_t, WS_WO), DM, DM, DM};
          pg8::EpiResid E{l == 0 ? PF(x) : PF(out), l == 0 ? PF(ctx) : WSP(const float, WS_HC), PF(out), WSP(float, WS_HC), WSP(const float, WS_MOD) + (size_t)l * 9 * 6144 + 2048, WSP(float, WS_P)};
          if (!lastl && G == 256) { pg8::SplitSched S; S.base.init(NLAT, DM, G, c, DM, DM); S.sk = 256; pg8::gemm_phase(lds, g, S, E); }
          else { pg8::Sched S; S.init(Mrest, DM, G, c, DM, DM); pg8::gemm_phase(lds, g, S, E); } }
        xcd_barrier(xbar);
        if (!lastl && G == 256) phase_norm(p, l, PF(out), l == 0 ? PF(ctx) : WSP(const float, WS_HC), PF(norm2_g) + l * DM, 3072, Mrest, WSP(const float, WS_P), WSP(const float, WS_MOD) + (size_t)(l * 9 + 8) * 6144 + 2048, WSP(float, WS_HC));
        else phase_norm(p, l, PF(out), WSP(const float, WS_HC), PF(norm2_g) + l * DM, 3072, Mrest);
        xcd_barrier(xbar);
        { pg8::Gemm g{WSP(bf16_t, WS_U), WSP(bf16_t, WS_W1), DM, DM, DM}; pg8::Sched S; S.init(Mrest, DFF, G, c, DM, DM); pg8::EpiStore<2> E{WSP(bf16_t, WS_P), DFF}; pg8::gemm_phase(lds, g, S, E); }
        xcd_barrier(xbar);
        { pg8::Gemm g{WSP(bf16_t, WS_P), WSP(bf16_t, WS_W2), DFF, DFF, DFF};
          float* slab = (float*)(PF(ws) + WS_P + (size_t)NTOK * DFF * 2);
          pg8::EpiResid E{PF(out), WSP(const float, WS_HC), PF(out), WSP(float, WS_HC), WSP(const float, WS_MOD) + (size_t)l * 9 * 6144 + 5120, slab};
          if (!lastl && G == 256) { pg8::SplitSched S; S.base.init(NLAT, DM, G, c, DFF, DFF); S.sk = 1024; pg8::gemm_phase(lds, g, S, E); }
          else { pg8::Sched S; S.init(Mrest, DM, G, c, DFF, DFF); pg8::gemm_phase(lds, g, S, E); } }
        if (!lastl) xcd_barrier(xbar);
    }
}

extern "C" void kernel_launch(void* const* d_in, const int* in_sizes, int n_in, void* d_out, int out_size, void* d_ws, size_t ws_size, hipStream_t stream) {
    static int grid_blocks = 0;
    if (grid_blocks == 0) {
        int dev = 0, cus = 0, per_cu = 0;
        hipGetDevice(&dev);
        hipDeviceGetAttribute(&cus, hipDeviceAttributeMultiprocessorCount, dev);
        hipFuncSetAttribute((const void*)fwd_megakernel, hipFuncAttributeMaxDynamicSharedMemorySize, LDS_BYTES);
        hipOccupancyMaxActiveBlocksPerMultiprocessor(&per_cu, (const void*)fwd_megakernel, 512, LDS_BYTES);
        if (per_cu < 1 || n_in != 25 || ws_size < WS_END) { fprintf(stderr, "kernel_launch: cannot launch (per_cu %d, n_in %d, ws %zu need %zu)\n", per_cu, n_in, ws_size, (size_t)WS_END); grid_blocks = -1; }
        else grid_blocks = cus;
    }
    if (grid_blocks < 0) return;
    hipMemsetAsync((char*)d_ws + WS_BAR, 0, 16384, stream);
    Params p{};
    const float** pp = (const float**)&p;
    for (int i = 0; i < 25; ++i) pp[i] = (const float*)d_in[i];
    p.out = (float*)d_out; p.ws = (unsigned char*)d_ws;
    void* args[] = {&p};
    hipError_t e = hipLaunchCooperativeKernel((const void*)fwd_megakernel, dim3(grid_blocks), dim3(512), args, LDS_BYTES, stream);
    if (e != hipSuccess) fprintf(stderr, "cooperative launch failed: %s (grid %d)\n", hipGetErrorString(e), grid_blocks);
}
```

```cpp
#include <hip/hip_runtime.h>
#include <hip/hip_cooperative_groups.h>
#include <stdint.h>
#include <stdio.h>
namespace cg = cooperative_groups;

#define LAS __attribute__((address_space(3)))
typedef unsigned short bf16_t;
typedef short bf16x8 __attribute__((ext_vector_type(8)));
typedef float f32x4 __attribute__((ext_vector_type(4)));
typedef unsigned u32x4 __attribute__((ext_vector_type(4)));
typedef unsigned u32x2 __attribute__((ext_vector_type(2)));

constexpr int DM = 1024, NB = 8, SEQ = 2048, CTXL = 256, NLAT = NB * SEQ, NCTX = NB * CTXL, NTOK = NLAT + NCTX;
constexpr int PW = 5120, DIN = 8192, DFF = 4096;
constexpr int C_AX = 0, C_AG = 512, C_BQ = 1024, C_BF = 1536, C_BI = 2560, C_BO = 3072, C_CQ = 3584, C_CK = 4096, C_CV = 4608;
constexpr int LDS_BYTES = 163840;
constexpr size_t WS_WIN = 0;
constexpr size_t WS_WB = WS_WIN + (size_t)DIN * DM * 2;
constexpr size_t WS_WO = WS_WB + (size_t)3 * DM * 512 * 2;
constexpr size_t WS_W1 = WS_WO + (size_t)DM * DM * 2;
constexpr size_t WS_W2 = WS_W1 + (size_t)DFF * DM * 2;
constexpr size_t WS_U = WS_W2 + (size_t)DM * DFF * 2;
constexpr size_t WS_P = WS_U + (size_t)NTOK * DM * 2;
constexpr size_t WS_HC = WS_P + (size_t)NTOK * PW * 2;
constexpr size_t WS_MOD = WS_HC + (size_t)NCTX * DM * 4;
constexpr size_t WS_AGG = WS_MOD + (size_t)2 * 9 * 6144 * 4;
constexpr size_t WS_ROPE = WS_AGG + (size_t)NB * 36 * 2 * 2 * 512 * 4;
constexpr size_t WS_DUMMY = WS_ROPE + 2048 * 4;
constexpr size_t WS_BAR = WS_DUMMY + (2u << 20);
constexpr size_t WS_END = WS_BAR + 16384;

struct Params {
    const float *x, *c, *ctx, *c_ctx, *ada_w, *ada_b, *norm1_g, *norm2_g, *w_in, *conv_w, *conv_b, *lru_wa, *lru_ba, *lru_wx, *lru_bx, *lru_lambda,
        *hg_lb, *hg_norm_g, *na_qg, *na_kg, *na_rpb, *w_branch, *w_out, *ffn_w1, *ffn_w2;
    float* out; unsigned char* ws;
};


__device__ __forceinline__ unsigned long long ldkarg(int off) { unsigned long long v = 0;
#if defined(__HIP_DEVICE_COMPILE__)
    auto kp = __builtin_amdgcn_kernarg_segment_ptr();
    asm volatile("s_load_dwordx2 %0, %1, %2\n\ts_waitcnt lgkmcnt(0)" : "=s"(v) : "s"(kp), "s"(off));
#endif
    return v; }
template <class T> struct rm_ptr; template <class T> struct rm_ptr<T*> { typedef T type; };
template <class T> __device__ __forceinline__ T* as_global_ptr(unsigned long long v) { return (T*)(__attribute__((address_space(1))) T*)v; }
#define PF(f) (as_global_ptr<rm_ptr<decltype(Params::f)>::type>(ldkarg((int)__builtin_offsetof(Params, f))))

#define GAS __attribute__((address_space(1)))
template <class T> __device__ __forceinline__ GAS T* lnd(T* p) { asm volatile("" : "+v"(p)); return (GAS T*)p; }
__device__ __forceinline__ int tid_() { int t = threadIdx.x; asm volatile("" : "+v"(t)); return t; }
__device__ __forceinline__ float bf2f(unsigned v) { return __uint_as_float(v << 16); }
__device__ __forceinline__ float bflo(unsigned w) { return __uint_as_float(w << 16); }
__device__ __forceinline__ float bfhi(unsigned w) { return __uint_as_float(w & 0xffff0000u); }
__device__ __forceinline__ unsigned f2bf(float f) { unsigned u = __float_as_uint(f); u += 0x7fffu + ((u >> 16) & 1u); return u >> 16; }
typedef __bf16 bf16x2_t __attribute__((ext_vector_type(2)));
typedef float f32x2_t __attribute__((ext_vector_type(2)));
__device__ __forceinline__ unsigned pack2(float lo, float hi) { f32x2_t v = {lo, hi}; bf16x2_t b = __builtin_convertvector(v, bf16x2_t); union { bf16x2_t b; unsigned u; } t; t.b = b; return t.u; }
__device__ __forceinline__ float fexp_(float x) { return __builtin_amdgcn_exp2f(x * 1.4426950408889634f); }
__device__ __forceinline__ float flog_(float x) { return __builtin_amdgcn_logf(x) * 0.6931471805599453f; }
__device__ __forceinline__ float dpp_xor1(float v) { return __int_as_float(__builtin_amdgcn_mov_dpp(__float_as_int(v), 0xB1, 0xF, 0xF, true)); }
__device__ __forceinline__ float dpp_xor2(float v) { return __int_as_float(__builtin_amdgcn_mov_dpp(__float_as_int(v), 0x4E, 0xF, 0xF, true)); }
__device__ __forceinline__ float sigmoidf_(float x) { return __builtin_amdgcn_rcpf(1.0f + fexp_(-x)); }
__device__ __forceinline__ f32x4 mfma16(bf16x8 a, bf16x8 b, f32x4 c) { return __builtin_amdgcn_mfma_f32_16x16x32_bf16(a, b, c, 0, 0, 0); }
__device__ __forceinline__ bf16x8 as_bf16x8(u32x4 v) { union { u32x4 u; bf16x8 b; } t; t.u = v; return t.b; }
__device__ __forceinline__ void unpack8(u32x4 w, float* o) { o[0] = bflo(w.x); o[1] = bfhi(w.x); o[2] = bflo(w.y); o[3] = bfhi(w.y); o[4] = bflo(w.z); o[5] = bfhi(w.z); o[6] = bflo(w.w); o[7] = bfhi(w.w); }
__device__ __forceinline__ u32x4 pack8(const float* v) { u32x4 w; w.x = pack2(v[0], v[1]); w.y = pack2(v[2], v[3]); w.z = pack2(v[4], v[5]); w.w = pack2(v[6], v[7]); return w; }

namespace pg8 {
constexpr int BM = 256, BK = 64, HALF = 128, HTB = HALF * BK * 2, NXCD = 8, WGM = 4;
__device__ __forceinline__ int lds_byte(int r, int c) { const int st = (r >> 4) * 2 + (c >> 5), rr = r & 15, cc = c & 31, ob = rr * 64 + cc * 2; return st * 1024 + (ob ^ (((ob >> 9) & 1) << 5)); }
__device__ __forceinline__ void stage_rc(int b, int& R, int& C) { const int st = b / 1024, sb = b % 1024, swz = sb ^ (((sb >> 9) & 1) << 5); R = (st >> 1) * 16 + swz / 64; C = (st & 1) * 32 + (swz % 64) / 2; }
__device__ __forceinline__ int perm32(int rho) { const int n = rho >> 4, i = rho & 15; return 8 * (i >> 2) + 4 * n + (i & 3); }

struct Unit { int pm, pn, sub, nt; size_t aoff, boff; };
struct Gemm { const bf16_t* A; const bf16_t* Bt; int lda, ldb, K; };
struct Sched {
    int nM, nN, nwg, G, c, lda, ldb, nt;
    __device__ void init(int M, int N, int G_, int c_, int lda_, int ldb_) { nM = M / BM; nN = N / BM; nwg = nM * nN; G = G_; c = c_; lda = lda_; ldb = ldb_; nt = 0; }
    __device__ bool next(int i, Unit& u) const {
        const long L = (long)i * G + c; if (L >= nwg) return false;
        int wgid = (int)L; { const int q = nwg / NXCD, r = nwg % NXCD, xcd = wgid % NXCD, off = wgid / NXCD; wgid = (xcd < r ? xcd * (q + 1) : r * (q + 1) + (xcd - r) * q) + off; }
        const int nig = WGM * nN, gid = wgid / nig, fm = gid * WGM, gsz = (nM - fm) < WGM ? (nM - fm) : WGM;
        u.pm = fm + ((wgid % nig) % gsz); u.pn = (wgid % nig) / gsz; u.sub = 0; u.nt = nt;
        u.aoff = (size_t)u.pm * BM * lda * 2;
        u.boff = (size_t)u.pn * BM * ldb * 2;
        return true;
    }
};

template <int ACT> struct EpiStore {
    static constexpr bool PERM = true;
    bf16_t* O; int ldc;
    __device__ __forceinline__ void operator()(const f32x4 (&acc)[2][2][4][2], const Unit& u, int wr, int wc, int fr, int fq) const {
        const int row0 = u.pm * BM + wr * 64 + fr; int colt = u.pn * BM;
        if (ACT == 1) colt = (colt < 2048) ? (1024 + colt) : (2048 + colt);
        const int col0 = colt + wc * 32 + 8 * fq;
#pragma unroll
        for (int ai = 0; ai < 2; ++ai)
#pragma unroll
            for (int m = 0; m < 4; ++m) { GAS bf16_t* rowp = lnd(O + (size_t)(row0 + ai * HALF + m * 16) * ldc + col0);
#pragma unroll
                for (int bj = 0; bj < 2; ++bj) { f32x4 v0 = acc[ai][bj][m][0], v1 = acc[ai][bj][m][1];
                    if (ACT == 1) {
#pragma unroll
                        for (int j = 0; j < 4; ++j) { v0[j] = sigmoidf_(v0[j]); v1[j] = sigmoidf_(v1[j]); } }
                    if (ACT == 2) {
#pragma unroll
                        for (int j = 0; j < 4; ++j) { float a = fmaxf(v0[j], 0.f), b = fmaxf(v1[j], 0.f); v0[j] = a * a; v1[j] = b * b; } }
                    u32x4 w; w.x = pack2(v0[0], v0[1]); w.y = pack2(v0[2], v0[3]); w.z = pack2(v1[0], v1[1]); w.w = pack2(v1[2], v1[3]);
                    *(GAS u32x4*)(rowp + bj * HALF) = w; } }
    }
};
struct EpiMerge {
    static constexpr bool PERM = true;
    const bf16_t* P; bf16_t* U;
    __device__ __forceinline__ void operator()(const f32x4 (&acc)[2][2][4][2], const Unit& u, int wr, int wc, int fr, int fq) const {
        const int row0 = u.pm * BM + wr * 64 + fr; const int col0 = u.pn * BM + wc * 32 + 8 * fq;
        const int sub = u.sub; const int gcol = sub * 1024 + u.pn * BM; const int gd = ((gcol < 2048) ? (1024 + gcol) : (2048 + gcol)) + wc * 32 + 8 * fq;
        const bool addp = sub > 0;
#pragma unroll
        for (int ai = 0; ai < 2; ++ai)
#pragma unroll
            for (int m = 0; m < 4; ++m) { const size_t row = (size_t)(row0 + ai * HALF + m * 16); const GAS bf16_t* gp = lnd(P + row * PW + gd); GAS bf16_t* up = lnd(U + row * DM + col0);
#pragma unroll
                for (int bj = 0; bj < 2; ++bj) { const u32x4 gw = *(const GAS u32x4*)(gp + bj * HALF);
                    f32x4 a0 = acc[ai][bj][m][0], a1 = acc[ai][bj][m][1];
                    a0[0] *= bflo(gw.x); a0[1] *= bfhi(gw.x); a0[2] *= bflo(gw.y); a0[3] *= bfhi(gw.y); a1[0] *= bflo(gw.z); a1[1] *= bfhi(gw.z); a1[2] *= bflo(gw.w); a1[3] *= bfhi(gw.w);
                    if (addp) { const u32x4 pw = *(const GAS u32x4*)(up + bj * HALF);
                        a0[0] += bflo(pw.x); a0[1] += bfhi(pw.x); a0[2] += bflo(pw.y); a0[3] += bfhi(pw.y); a1[0] += bflo(pw.z); a1[1] += bfhi(pw.z); a1[2] += bflo(pw.w); a1[3] += bfhi(pw.w); }
                    u32x4 o; o.x = pack2(a0[0], a0[1]); o.y = pack2(a0[2], a0[3]); o.z = pack2(a1[0], a1[1]); o.w = pack2(a1[2], a1[3]);
                    *(GAS u32x4*)(up + bj * HALF) = o; } }
    }
};
struct EpiResid {
    static constexpr bool PERM = true;
    const float* inL; const float* inC; float* outL; float* outC; const float* mod;
    float* slab;
    __device__ __forceinline__ void operator()(const f32x4 (&acc)[2][2][4][2], const Unit& u, int wr, int wc, int fr, int fq) const {
        if (u.sub >= 1) {
            const int row0 = (u.pm - 64) * BM + wr * 64 + fr, col0 = u.pn * BM + wc * 32 + 8 * fq; float* sl = slab + (size_t)(u.sub - 1) * NCTX * DM;
#pragma unroll
            for (int ai = 0; ai < 2; ++ai)
#pragma unroll
                for (int m = 0; m < 4; ++m)
#pragma unroll
                    for (int bj = 0; bj < 2; ++bj) { GAS float* op = lnd(sl + (size_t)(row0 + ai * HALF + m * 16) * DM + col0 + bj * HALF); *(GAS f32x4*)op = acc[ai][bj][m][0]; *(GAS f32x4*)(op + 4) = acc[ai][bj][m][1]; }
            return;
        }
        const bool lat = u.pm < 64; const int rbase = lat ? u.pm * BM : (u.pm - 64) * BM;
        const float* in = lat ? inL : inC; float* out = lat ? outL : outC;
        const int row0 = rbase + wr * 64 + fr, col0 = u.pn * BM + wc * 32 + 8 * fq;
        const float* gt = mod + (size_t)(lat ? (u.pm >> 3) : 8) * 6144 + col0;
#pragma unroll
        for (int bj = 0; bj < 2; ++bj) { const f32x4 g0 = *(const f32x4*)(gt + bj * HALF), g1 = *(const f32x4*)(gt + bj * HALF + 4);
#pragma unroll
            for (int ai = 0; ai < 2; ++ai)
#pragma unroll
                for (int m = 0; m < 4; ++m) { const size_t ro = (size_t)(row0 + ai * HALF + m * 16) * DM + col0 + bj * HALF;
                    const GAS float* ip = lnd(in + ro); GAS float* op = lnd(out + ro); const f32x4 i0 = *(const GAS f32x4*)ip, i1 = *(const GAS f32x4*)(ip + 4);
                    *(GAS f32x4*)op = i0 + g0 * acc[ai][bj][m][0]; *(GAS f32x4*)(op + 4) = i1 + g1 * acc[ai][bj][m][1]; } }
    }
};

struct MergeSched {
    Sched base;
    __device__ bool next(int i, Unit& u) const {
        const int r = i / 3, n = i - 3 * r;
        if (!base.next(r, u)) return false;
        u.sub = n; u.aoff += (size_t)(n == 0 ? C_AG : C_BO + (n - 1) * 512) * 2; u.boff += (size_t)n * DM * 512 * 2;
        return true;
    }
};
struct SplitSched {
    Sched base;
    int sk;
    __device__ bool next(int i, Unit& u) const {
        if (base.next(i, u)) return true;
        const int nfull = (base.nwg - base.c + base.G - 1) / base.G;
        const int k = i - nfull; const int un = k * base.G + base.c; if (k < 0 || un >= 128) return false;
        const int ct = un >> 2, sl = un & 3; u.pm = 64 + (ct >> 2); u.pn = ct & 3; u.sub = 1 + sl; u.nt = sk / BK;
        u.aoff = (size_t)u.pm * BM * base.lda * 2 + (size_t)sl * sk * 2; u.boff = (size_t)u.pn * BM * base.ldb * 2 + (size_t)sl * sk * 2;
        return true;
    }
};
template <class Epi, class Sch>
__device__ __forceinline__ void gemm_phase(LAS unsigned char* lds, const Gemm g, const Sch& S, const Epi& E) {
    const int tid = tid_(), wid = __builtin_amdgcn_readfirstlane(tid >> 6), lane = tid & 63, wr = wid >> 2, wc = wid & 3, fr = lane & 15, fq = lane >> 4;
    const int K = g.K;
    unsigned voffA[2], voffB[2];
#pragma unroll
    for (int i = 0; i < 2; ++i) { int R, C; stage_rc(tid * 16 + i * 8192, R, C); const int Rb = Epi::PERM ? ((R & ~31) + perm32(R & 31)) : R;
        voffA[i] = (unsigned)(R * g.lda + C) * 2u; voffB[i] = (unsigned)(Rb * g.ldb + C) * 2u; }
    const size_t kstep = (size_t)(BK * 2);
    const size_t hstepA = (size_t)HALF * g.lda * 2, hstepB = (size_t)HALF * g.ldb * 2;
    const unsigned ldsw = (unsigned)wid * 1024u;
    const int aoff = lds_byte(wr * 64 + fr, fq * 8), boff = lds_byte(wc * 32 + fr, fq * 8);
#define PG8_SA(b, h) (((b) * 2 + (h)) * HTB)
#define PG8_SB(b, h) ((4 + (b) * 2 + (h)) * HTB)
#define PG8_STAGE(bufoff, gbase, voff) do { _Pragma("unroll") for (int _i = 0; _i < 2; ++_i) \
        __builtin_amdgcn_global_load_lds((const unsigned*)((const char*)(gbase) + (voff)[_i]), (LAS unsigned*)(lds + (bufoff) + ldsw + _i * 8192), 16, 0, 0); } while (0)
#define PG8_LDA(dst, b, h) do { _Pragma("unroll") for (int m = 0; m < 4; ++m) _Pragma("unroll") for (int k = 0; k < 2; ++k) dst[m][k] = *(const LAS bf16x8*)(lds + PG8_SA(b, h) + aoff + m * 2048 + k * 1024); } while (0)
#define PG8_LDB(dst, b, h) do { _Pragma("unroll") for (int n = 0; n < 2; ++n) _Pragma("unroll") for (int k = 0; k < 2; ++k) dst[n][k] = *(const LAS bf16x8*)(lds + PG8_SB(b, h) + boff + n * 2048 + k * 1024); } while (0)
#define PG8_MMA(ai, bj, At, Bt) do { __builtin_amdgcn_s_setprio(1); _Pragma("unroll") for (int m = 0; m < 4; ++m) _Pragma("unroll") for (int n = 0; n < 2; ++n) _Pragma("unroll") for (int k = 0; k < 2; ++k) \
        acc[ai][bj][m][n] = __builtin_amdgcn_mfma_f32_16x16x32_bf16(Bt[n][k], At[m][k], acc[ai][bj][m][n], 0, 0, 0); __builtin_amdgcn_s_setprio(0); } while (0)
#define PG8_WAIT_V(n) asm volatile("s_waitcnt vmcnt(" #n ")" ::: "memory")
#define PG8_WAIT_L(n) asm volatile("s_waitcnt lgkmcnt(" #n ")" ::: "memory")
#define PG8_BAR __builtin_amdgcn_s_barrier()
#define PG8_SCHED __builtin_amdgcn_sched_barrier(0)
    Unit cur, nxt; int ui = 0;
    if (!S.next(0, cur)) return;
    f32x4 acc[2][2][4][2];
#pragma unroll
    for (int a = 0; a < 2; ++a)
#pragma unroll
        for (int b = 0; b < 2; ++b)
#pragma unroll
            for (int m = 0; m < 4; ++m)
#pragma unroll
                for (int n = 0; n < 2; ++n) acc[a][b][m][n] = (f32x4){0.f, 0.f, 0.f, 0.f};
    bf16x8 At[4][2], B0[2][2], B1[2][2];
    const char* cA = (const char*)g.A + cur.aoff; const char* cB = (const char*)g.Bt + cur.boff;
    PG8_STAGE(PG8_SB(0, 0), cB, voffB); PG8_STAGE(PG8_SB(0, 1), cB + hstepB, voffB); PG8_STAGE(PG8_SA(0, 0), cA, voffA); PG8_STAGE(PG8_SA(0, 1), cA + hstepA, voffA);
    if (wr == 1) PG8_BAR;
    PG8_WAIT_V(2); PG8_BAR;
    PG8_STAGE(PG8_SB(1, 0), cB + kstep, voffB); PG8_STAGE(PG8_SA(1, 0), cA + kstep, voffA); PG8_STAGE(PG8_SB(1, 1), cB + hstepB + kstep, voffB);
    PG8_WAIT_V(6); PG8_BAR;
    for (;;) {
        const bool has_next = S.next(ui + 1, nxt);
        const char* nA = has_next ? (const char*)g.A + nxt.aoff : cA; const char* nB = has_next ? (const char*)g.Bt + nxt.boff : cB;
        const int nt = cur.nt ? cur.nt : K / BK;
        for (int t = 0; t < nt; t += 2) {
            const bool last = (t == nt - 2);
            const char* a1 = cA + (size_t)(t + 1) * kstep;
            const char* a2 = last ? nA : cA + (size_t)(t + 2) * kstep; const char* b2 = last ? nB : cB + (size_t)(t + 2) * kstep;
            const char* a3 = a2 + kstep; const char* b3 = b2 + kstep;
            PG8_LDB(B0, 0, 0); PG8_LDB(B1, 0, 1); PG8_SCHED; PG8_LDA(At, 0, 0); PG8_STAGE(PG8_SA(1, 1), a1 + hstepA, voffA);
            PG8_WAIT_V(8); PG8_WAIT_L(0); PG8_BAR; PG8_MMA(0, 0, At, B0); PG8_MMA(0, 1, At, B1); PG8_BAR; PG8_SCHED;
            PG8_LDA(At, 0, 1); PG8_STAGE(PG8_SB(0, 0), b2, voffB); PG8_STAGE(PG8_SB(0, 1), b2 + hstepB, voffB); PG8_STAGE(PG8_SA(0, 0), a2, voffA);
            PG8_WAIT_V(8); PG8_WAIT_L(0); PG8_BAR; PG8_MMA(1, 0, At, B0); PG8_MMA(1, 1, At, B1); PG8_BAR; PG8_SCHED;
            PG8_LDB(B0, 1, 0); PG8_LDB(B1, 1, 1); PG8_SCHED; PG8_LDA(At, 1, 0); PG8_STAGE(PG8_SA(0, 1), a2 + hstepA, voffA);
            PG8_WAIT_V(8); PG8_WAIT_L(0); PG8_BAR; PG8_MMA(0, 0, At, B0); PG8_MMA(0, 1, At, B1); PG8_BAR; PG8_SCHED;
            PG8_LDA(At, 1, 1); PG8_STAGE(PG8_SB(1, 0), b3, voffB); PG8_STAGE(PG8_SB(1, 1), b3 + hstepB, voffB); PG8_STAGE(PG8_SA(1, 0), a3, voffA);
            PG8_WAIT_V(8); PG8_WAIT_L(0); PG8_BAR; PG8_MMA(1, 0, At, B0); PG8_MMA(1, 1, At, B1); PG8_BAR; PG8_SCHED;
        }
        if (wr == 0) PG8_BAR;
        E(acc, cur, wr, wc, fr, fq);
        if (!has_next) break;
#pragma unroll
        for (int a = 0; a < 2; ++a)
#pragma unroll
            for (int b = 0; b < 2; ++b)
#pragma unroll
                for (int m = 0; m < 4; ++m)
#pragma unroll
                    for (int n = 0; n < 2; ++n) acc[a][b][m][n] = (f32x4){0.f, 0.f, 0.f, 0.f};
        cur = nxt; cA = nA; cB = nB; ++ui;
        if (wr == 1) PG8_BAR;
    }
    PG8_WAIT_V(0);
    PG8_BAR;
#undef PG8_SA
#undef PG8_SB
#undef PG8_STAGE
#undef PG8_LDA
#undef PG8_LDB
#undef PG8_MMA
#undef PG8_WAIT_V
#undef PG8_WAIT_L
#undef PG8_BAR
#undef PG8_SCHED
}
}


#define XB_TMO      128
#define XB_XCNT(j)  (256  + 64 * (j))
#define XB_XSUB(j)  (1280 + 64 * (j))
#define XB_XGEN(j)  (2304 + 64 * (j))
#define XB_TOP      3328
#define XB_TOPGEN   3392
#define XCD_BAR_WORDS 3456
#define XB_SPIN_CAP (1u << 20)
__device__ __forceinline__ unsigned xb_ld(unsigned* p)              { return __hip_atomic_load(p, __ATOMIC_RELAXED, __HIP_MEMORY_SCOPE_AGENT); }
__device__ __forceinline__ unsigned xb_add(unsigned* p, unsigned v) { return __hip_atomic_fetch_add(p, v, __ATOMIC_RELAXED, __HIP_MEMORY_SCOPE_AGENT); }
__device__ __forceinline__ unsigned xb_xcc_id() { return (unsigned)__builtin_amdgcn_s_getreg((3 << 11) | 20) & 0xFu; }
#define XB_SPIN(cond, bar) do { unsigned _sp = 0; while (cond) { __builtin_amdgcn_s_sleep(0); \
    if ((++_sp & 255u) == 0u) { if (xb_ld(&(bar)[XB_TMO])) break; if (_sp > XB_SPIN_CAP) { atomicAdd(&(bar)[XB_TMO], 1u); break; } } } } while (0)
struct XcdBarrier { unsigned* bar; unsigned x; volatile LAS unsigned* st; };
__device__ __forceinline__ XcdBarrier xcd_barrier_post(unsigned* bar, volatile LAS unsigned* st) {
    XcdBarrier b; b.bar = bar; b.x = xb_xcc_id(); b.st = st;
    if (threadIdx.x == 0) (void)xb_add(&bar[XB_XCNT(b.x)], 1u);
    return b;
}
__device__ __forceinline__ void xcd_barrier_complete(unsigned* bar, unsigned x, unsigned& nloc, unsigned& nx) {
    const unsigned G = gridDim.x * gridDim.y * gridDim.z;
    unsigned sum, cnt, mine, sp = 0u;
    for (;;) {
        sum = 0u; cnt = 0u; mine = 0u;
#pragma unroll
        for (unsigned j = 0; j < 16; ++j) { const unsigned c = xb_ld(&bar[XB_XCNT(j)]); sum += c; cnt += (c > 0u) ? 1u : 0u; mine = (j == x) ? c : mine; }
        if (sum == G) break;
        __builtin_amdgcn_s_sleep(1);
        if ((++sp & 255u) == 0u) { if (xb_ld(&bar[XB_TMO])) break; if (sp > XB_SPIN_CAP) { atomicAdd(&bar[XB_TMO], 1u); break; } }
    }
    nloc = mine > 0u ? mine : 1u; nx = cnt > 0u ? cnt : 1u;
}
__device__ __forceinline__ void xcd_barrier(const XcdBarrier& b) {
    asm volatile("s_waitcnt vmcnt(0)" ::: "memory");
    __syncthreads();
    if (threadIdx.x == 0) {
        unsigned* bar = b.bar;
        __builtin_amdgcn_s_waitcnt(0);
        unsigned nloc = b.st[0], nx = b.st[1];
        if (nloc == 0u) { xcd_barrier_complete(bar, b.x, nloc, nx); b.st[0] = nloc; b.st[1] = nx; }
        const unsigned old = xb_add(&bar[XB_XSUB(b.x)], 1u);
        const unsigned gen = old / nloc;
        if (old + 1u == (gen + 1u) * nloc) {
            __builtin_amdgcn_fence(__ATOMIC_RELEASE, "agent");
            asm volatile("s_waitcnt vmcnt(0)" ::: "memory");
            const unsigned og = xb_add(&bar[XB_TOP], 1u);
            const unsigned tg = og / nx;
            if (og + 1u == (tg + 1u) * nx) xb_add(&bar[XB_TOPGEN], 1u);
            else XB_SPIN(xb_ld(&bar[XB_TOPGEN]) == tg, bar);
            __builtin_amdgcn_fence(__ATOMIC_ACQUIRE, "agent");
            xb_add(&bar[XB_XGEN(b.x)], 1u);
            asm volatile("s_waitcnt vmcnt(0)" ::: "memory");
        } else {
            XB_SPIN(xb_ld(&bar[XB_XGEN(b.x)]) == gen, bar);
            __builtin_amdgcn_fence(__ATOMIC_ACQUIRE, "agent");
            asm volatile("s_waitcnt vmcnt(0)" ::: "memory");
        }
    }
    __syncthreads();
}

__device__ __forceinline__ void sub_barrier(unsigned* word, unsigned n) {
    asm volatile("s_waitcnt vmcnt(0)" ::: "memory");
    __syncthreads();
    if (threadIdx.x == 0) {
        __builtin_amdgcn_fence(__ATOMIC_RELEASE, "agent");
        asm volatile("s_waitcnt vmcnt(0)" ::: "memory");
        xb_add(word, 1u);
        unsigned sp = 0;
        while (xb_ld(word) < n) { __builtin_amdgcn_s_sleep(0); if (++sp > (1u << 22)) break; }
        __builtin_amdgcn_fence(__ATOMIC_ACQUIRE, "agent");
        asm volatile("s_waitcnt vmcnt(0)" ::: "memory");
    }
    __syncthreads();
}

__device__ __forceinline__ void phase_mod(const Params& p, LAS unsigned char* lds) {
    LAS float* sc = (LAS float*)lds;
    LAS float* part = sc + 9 * 1024;
    float* mod = (float*)(PF(ws) + WS_MOD);
    const int tid = tid_(), w = tid >> 6, lane = tid & 63;
    if ((int)blockIdx.x >= 192) return;
    const float* pc = PF(c); const float* pcc = PF(c_ctx); const float* padaw = PF(ada_w); const float* padab = PF(ada_b);
    for (int i = tid; i < 9 * 1024; i += 512) { const int r = i >> 10, k = i & 1023; const float v = (r < 8) ? pc[r * 1024 + k] : pcc[k]; sc[i] = v / (1.0f + expf(-v)); }
    __syncthreads();
    for (int item = blockIdx.x; item < 192; item += gridDim.x) {
        const int l = item / 96, cb = item % 96;
        const float* W = padaw + (size_t)l * 1024 * 6144 + cb * 64 + lane;
        float acc[9];
#pragma unroll
        for (int r = 0; r < 9; ++r) acc[r] = 0.f;
        for (int k = w * 128; k < w * 128 + 128; ++k) { const float wv = W[(size_t)k * 6144];
#pragma unroll
            for (int r = 0; r < 9; ++r) acc[r] += sc[r * 1024 + k] * wv; }
#pragma unroll
        for (int r = 0; r < 9; ++r) part[(w * 9 + r) * 64 + lane] = acc[r];
        __syncthreads();
        for (int i = tid; i < 576; i += 512) { const int r = i >> 6, ln = i & 63; float s = 0.f;
#pragma unroll
            for (int ww = 0; ww < 8; ++ww) s += part[(ww * 9 + r) * 64 + ln];
            mod[(size_t)(l * 9 + r) * 6144 + cb * 64 + ln] = s + padab[l * 6144 + cb * 64 + ln]; }
        __syncthreads();
    }
}
__device__ __forceinline__ void phase_rope(const Params& p) {
    if (blockIdx.x != gridDim.x - 1) return;
    float* rope = (float*)(PF(ws) + WS_ROPE);
    for (int i = tid_(); i < 1024; i += 512) { const int pos = i >> 4, fi = i & 15; const float invf = powf(10000.0f, -(float)fi / 16.0f); const float ang = (float)pos * invf; rope[i] = cosf(ang); rope[1024 + i] = sinf(ang); }
}
__device__ __forceinline__ void convert_tile(const float* src, int K, int N, bf16_t* dst, int tile, LAS bf16_t* T) {
    const int tid = tid_(), tilesN = N >> 7, tk = tile / tilesN, tn = tile - tk * tilesN, k0 = tk * 128, n0 = tn * 128;
    const int r = tid >> 4, c8 = (tid & 15) * 8;
    f32x4 a[4], b[4];
#pragma unroll
    for (int i = 0; i < 4; ++i) { const float* s = src + (size_t)(k0 + r + 32 * i) * N + n0 + c8; a[i] = *(const f32x4*)s; b[i] = *(const f32x4*)(s + 4); }
#pragma unroll
    for (int i = 0; i < 4; ++i)
#pragma unroll
        for (int j = 0; j < 4; ++j) { T[(c8 + j) * 136 + r + 32 * i] = (bf16_t)f2bf(a[i][j]); T[(c8 + 4 + j) * 136 + r + 32 * i] = (bf16_t)f2bf(b[i][j]); }
    __syncthreads();
    const int n = tid >> 2, ks = (tid & 3) * 8;
#pragma unroll
    for (int i = 0; i < 4; ++i) { const u32x4 v = *(const LAS u32x4*)(T + n * 136 + ks + 32 * i); *(u32x4*)(dst + (size_t)(n0 + n) * K + k0 + ks + 32 * i) = v; }
    __syncthreads();
}
__device__ __forceinline__ void phase_convert(const Params& p, int l, LAS unsigned char* lds) {
    LAS bf16_t* T = (LAS bf16_t*)lds;
    bf16_t* WIN = (bf16_t*)(PF(ws) + WS_WIN); bf16_t* WB = (bf16_t*)(PF(ws) + WS_WB); bf16_t* WO = (bf16_t*)(PF(ws) + WS_WO); bf16_t* W1 = (bf16_t*)(PF(ws) + WS_W1); bf16_t* W2 = (bf16_t*)(PF(ws) + WS_W2);
    for (int it = blockIdx.x; it < 1184; it += gridDim.x) {
        if (it < 512) convert_tile(PF(w_in) + (size_t)l * DM * DIN, DM, DIN, WIN, it, T);
        else if (it < 608) { const int n = (it - 512) / 32, tl = (it - 512) % 32; convert_tile(PF(w_branch) + (size_t)(l * 3 + n) * 512 * DM, 512, DM, WB + (size_t)n * DM * 512, tl, T); }
        else if (it < 672) convert_tile(PF(w_out) + (size_t)l * DM * DM, DM, DM, WO, it - 608, T);
        else if (it < 928) convert_tile(PF(ffn_w1) + (size_t)l * DM * DFF, DM, DFF, W1, it - 672, T);
        else convert_tile(PF(ffn_w2) + (size_t)l * DFF * DM, DFF, DM, W2, it - 928, T);
    }
}
__device__ __forceinline__ void phase_norm(const Params& p, int l, const float* hlat, const float* hctx, const float* g, int modoff, int nrows, const float* slab = nullptr, const float* slabgate = nullptr, float* hwrite = nullptr) {
    const int tid = tid_(); const int w = tid >> 6, lane = tid & 63;
    bf16_t* U = (bf16_t*)(PF(ws) + WS_U); const float* mod = (const float*)(PF(ws) + WS_MOD);
    for (int row = blockIdx.x * 8 + w; row < nrows; row += gridDim.x * 8) {
        const float* src = row < NLAT ? hlat + (size_t)row * DM : hctx + (size_t)(row - NLAT) * DM;
        const int mr = row < NLAT ? (row >> 11) : 8;
        const float* md = mod + (size_t)(l * 9 + mr) * 6144 + modoff;
        f32x4 v[4]; float ss = 0.f;
#pragma unroll
        for (int i = 0; i < 4; ++i) { v[i] = *(const f32x4*)(src + i * 256 + lane * 4);
            if (slab != nullptr && row >= NLAT) { const size_t o = (size_t)(row - NLAT) * DM + i * 256 + lane * 4; const f32x4 gg = *(const f32x4*)(slabgate + i * 256 + lane * 4);
                const f32x4 s4 = (*(const f32x4*)(slab + o) + *(const f32x4*)(slab + o + (size_t)NCTX * DM)) + (*(const f32x4*)(slab + o + (size_t)2 * NCTX * DM) + *(const f32x4*)(slab + o + (size_t)3 * NCTX * DM));
                v[i] += gg * s4; if (hwrite != nullptr) *(f32x4*)(hwrite + o) = v[i]; }
            ss += v[i][0] * v[i][0] + v[i][1] * v[i][1] + v[i][2] * v[i][2] + v[i][3] * v[i][3]; }
#pragma unroll
        for (int o = 32; o >= 1; o >>= 1) ss += __shfl_xor(ss, o);
        const float rstd = rsqrtf(ss * (1.0f / 1024.0f) + 1e-6f);
#pragma unroll
        for (int i = 0; i < 4; ++i) { const int cidx = i * 256 + lane * 4; const f32x4 gg = *(const f32x4*)(g + cidx), sh = *(const f32x4*)(md + cidx), scv = *(const f32x4*)(md + 1024 + cidx);
            float o4[4];
#pragma unroll
            for (int j = 0; j < 4; ++j) o4[j] = (v[i][j] * rstd * gg[j]) * (1.0f + scv[j]) + sh[j];
            u32x2 wv; wv.x = pack2(o4[0], o4[1]); wv.y = pack2(o4[2], o4[3]);
            *(u32x2*)(U + (size_t)row * DM + cidx) = wv; }
    }
}
__device__ __forceinline__ void phase_hg_final(const Params& p, int l, int b, int wgi, int nw) {
    const int tid = tid_(); const int w = tid >> 6, lane = tid & 63; bf16_t* P = (bf16_t*)(PF(ws) + WS_P);
    const int hd = lane >> 4, e8 = (lane & 15) * 8; const float* png = PF(hg_norm_g);
    float ng[8];
#pragma unroll
    for (int i = 0; i < 8; ++i) ng[i] = png[l * 128 + e8 + i];
    const int nrow_b = (l == 1) ? 2048 : 2304;
    for (int i0 = wgi * 8 + w; i0 < nrow_b; i0 += 3 * nw) {
        u32x4 ra[3], rb[3], ro[3]; bf16_t* rp[3];
#pragma unroll
        for (int k = 0; k < 3; ++k) { const int i = i0 + nw * k; const int ic = i < nrow_b ? i : i0; const size_t row = ic < 2048 ? (size_t)b * SEQ + ic : (size_t)NLAT + b * CTXL + (ic - 2048);
            rp[k] = P + row * PW; ra[k] = *(const u32x4*)(rp[k] + C_BF + hd * 128 + e8); rb[k] = *(const u32x4*)(rp[k] + C_BF + 512 + hd * 128 + e8); ro[k] = *(const u32x4*)(rp[k] + C_BO + hd * 128 + e8); }
#pragma unroll
        for (int k = 0; k < 3; ++k) {
            float a[8], bb[8], og[8]; unpack8(ra[k], a); unpack8(rb[k], bb); unpack8(ro[k], og);
            float ss = 0.f;
#pragma unroll
            for (int i = 0; i < 8; ++i) { a[i] += bb[i]; ss += a[i] * a[i]; }
            ss += __shfl_xor(ss, 1); ss += __shfl_xor(ss, 2); ss += __shfl_xor(ss, 4); ss += __shfl_xor(ss, 8);
            const float rstd = rsqrtf(ss * (1.0f / 128.0f) + 1e-6f);
            float y[8];
#pragma unroll
            for (int i = 0; i < 8; ++i) y[i] = a[i] * rstd * ng[i] * sigmoidf_(og[i]);
            if (i0 + nw * k < nrow_b) *(u32x4*)(rp[k] + C_BO + hd * 128 + e8) = pack8(y);
        }
    }
}

__device__ __forceinline__ size_t agg_idx(int b, int gch, int dir, int which, int ch) { return ((((size_t)b * 36 + gch) * 2 + dir) * 2 + which) * 512 + ch; }
__device__ __forceinline__ float gelu_tanh(float x) { const float u = 0.7978845608028654f * (x + 0.044715f * x * x * x); const float th = 1.0f - 2.0f * __builtin_amdgcn_rcpf(1.0f + fexp_(2.0f * u)); return 0.5f * x * (1.0f + th); }
struct LruPtrs { bf16_t* P; float* AGG; const float *cb, *cw, *ba, *bx, *lam; };
__device__ __forceinline__ LruPtrs lru_ptrs() { LruPtrs q; q.P = (bf16_t*)(PF(ws) + WS_P); q.AGG = (float*)(PF(ws) + WS_AGG); q.cb = PF(conv_b); q.cw = PF(conv_w); q.ba = PF(lru_ba); q.bx = PF(lru_bx); q.lam = PF(lru_lambda); return q; }
__device__ __forceinline__ void lru_tile(const Params& p, int l, LAS unsigned char* lds, int item, int mode, int& staged_nb, const LruPtrs& lp, float (&kc)[3]) {
    LAS bf16_t* Wl = (LAS bf16_t*)lds;
    LAS bf16_t* Xb = Wl + 256 * 72;
    LAS float* Xf = (LAS float*)(lds + 46080);
    LAS float* Av = Xf + 4096;
    LAS float* Bv = Av + 8192;
    bf16_t* P = lp.P; float* AGG = lp.AGG;
    const int tid = tid_(), w = tid >> 6, lane = tid & 63, l16 = lane & 15, q4 = lane >> 4;
    const int nb = item & 7, rest = item >> 3, gch = rest % 36, b = rest / 36;
    const bool isctx = gch < 4; const int chunk = isctx ? gch : gch - 4, L = isctx ? CTXL : SEQ;
    const size_t seqrow0 = isctx ? (size_t)NLAT + b * CTXL : (size_t)b * SEQ; const int t0 = chunk * 64;
    if (staged_nb != nb) { const float* pwx = PF(lru_wx); const float* pwa = PF(lru_wa);
        for (int e = tid; e < 4 * 64 * 64; e += 512) { const int mat = e >> 12, i = (e >> 6) & 63, c = e & 63; const int dir = mat >> 1, kind = mat & 1;
            const float* W = kind ? pwx : pwa; const float v = W[((size_t)((l * 2 + dir) * 8 + nb) * 64 + i) * 64 + c];
            const int op = dir * 128 + (c >> 4) * 32 + kind * 16 + (c & 15);
            Wl[op * 72 + i] = (bf16_t)f2bf(v); }
        { const int dir = w >> 2, ch = nb * 64 + (w & 3) * 16 + l16; kc[0] = lp.ba[(l * 2 + dir) * 512 + ch]; kc[1] = lp.bx[(l * 2 + dir) * 512 + ch]; kc[2] = log1pf(expf(-lp.lam[(l * 2 + dir) * 512 + ch])); }
        staged_nb = nb;
    }
    {
        const int t = tid >> 3, c8 = (tid & 7) * 8, ch = nb * 64 + c8, tt = t0 + t;
        float a8[8]; const float* pcb = lp.cb; const float* pcw = lp.cw;
        { const f32x4 b0 = *(const f32x4*)(pcb + l * 512 + ch), b1 = *(const f32x4*)(pcb + l * 512 + ch + 4);
#pragma unroll
          for (int i = 0; i < 4; ++i) { a8[i] = b0[i]; a8[4 + i] = b1[i]; } }
#pragma unroll
        for (int j = 0; j < 4; ++j) { const int ts = tt + j - 2;
            if (ts >= 0 && ts < L) { float xv[8]; unpack8(*(const u32x4*)(P + (seqrow0 + ts) * PW + C_AX + ch), xv);
                const f32x4 w0 = *(const f32x4*)(pcw + (l * 4 + j) * 512 + ch), w1 = *(const f32x4*)(pcw + (l * 4 + j) * 512 + ch + 4);
#pragma unroll
                for (int i = 0; i < 4; ++i) { a8[i] += xv[i] * w0[i]; a8[4 + i] += xv[4 + i] * w1[i]; } } }
#pragma unroll
        for (int i = 0; i < 8; ++i) Xf[t * 64 + c8 + i] = a8[i];
        *(LAS u32x4*)(Xb + t * 72 + c8) = pack8(a8);
    }
    __syncthreads();
    {
        const int dir = w >> 2, c = (w & 3) * 16 + l16, ch = nb * 64 + c;
        f32x4 acc[4][2];
#pragma unroll
        for (int mg = 0; mg < 4; ++mg) { acc[mg][0] = (f32x4){0.f, 0.f, 0.f, 0.f}; acc[mg][1] = (f32x4){0.f, 0.f, 0.f, 0.f}; }
#pragma unroll
        for (int ks = 0; ks < 2; ++ks) {
            const bf16x8 B0 = *(const LAS bf16x8*)(Wl + (w * 32 + l16) * 72 + ks * 32 + q4 * 8), B1 = *(const LAS bf16x8*)(Wl + (w * 32 + 16 + l16) * 72 + ks * 32 + q4 * 8);
#pragma unroll
            for (int mg = 0; mg < 4; ++mg) { const bf16x8 A = *(const LAS bf16x8*)(Xb + (mg * 16 + l16) * 72 + ks * 32 + q4 * 8);
                acc[mg][0] = mfma16(A, B0, acc[mg][0]); acc[mg][1] = mfma16(A, B1, acc[mg][1]); }
        }
        const float ba = kc[0], bx = kc[1], sp = kc[2];
#pragma unroll
        for (int mg = 0; mg < 4; ++mg)
#pragma unroll
            for (int j = 0; j < 4; ++j) { const int t = mg * 16 + q4 * 4 + j;
                const float ea = 1.0f + fexp_(-(acc[mg][0][j] + ba)), ex = 1.0f + fexp_(-(acc[mg][1][j] + bx)); const float inv = __builtin_amdgcn_rcpf(ea * ex);
                const float r = inv * ex, ig = inv * ea;
                const float la = -8.0f * r * sp; const float a = fexp_(la); const float x2 = 2.0f * la;
                float om = -x2 * (1.0f + x2 * (0.5f + x2 * (0.16666667f + x2 * (0.041666668f + x2 * 0.0083333338f))));
                if (x2 < -0.35f) om = 1.0f - a * a;
                const float bb = __builtin_amdgcn_sqrtf(fmaxf(om, 0.f)) * ig * Xf[t * 64 + c];
                Av[(dir * 64 + t) * 64 + c] = a; Bv[(dir * 64 + t) * 64 + c] = bb; }
    }
    __syncthreads();
    {
        LAS float* SegA = Xf;
        LAS float* SegB = Xf + 512;
        const int d2 = tid >> 8, seg = (tid >> 6) & 3, c = tid & 63, ch = nb * 64 + c;
        float av[16], bv[16];
#pragma unroll
        for (int k = 0; k < 16; ++k) { const int s = seg * 16 + k; const int t = d2 ? 63 - s : s; const int ix = (d2 * 64 + t) * 64 + c; av[k] = Av[ix]; bv[k] = Bv[ix]; }
        float h = 0.f, ap = 1.f;
#pragma unroll
        for (int k = 0; k < 16; ++k) { h = av[k] * h + bv[k]; ap *= av[k]; }
        SegA[(d2 * 4 + seg) * 64 + c] = ap; SegB[(d2 * 4 + seg) * 64 + c] = h;
        float hin = 0.f;
        if (mode == 1) {
            const int mypos = d2 == 0 ? gch : (gch < 4 ? 3 - gch : 39 - gch);
            for (int p0 = 0; p0 < mypos; p0 += 6) { float Aa[6], Bb[6];
#pragma unroll
                for (int j = 0; j < 6; ++j) { const int pp = p0 + j; const int g = d2 == 0 ? pp : (pp < 4 ? 3 - pp : 39 - pp); const bool ok = pp < mypos;
                    Aa[j] = ok ? AGG[agg_idx(b, ok ? g : 0, d2, 0, ch)] : 1.0f; Bb[j] = ok ? AGG[agg_idx(b, ok ? g : 0, d2, 1, ch)] : 0.0f; }
#pragma unroll
                for (int j = 0; j < 6; ++j) hin = Aa[j] * hin + Bb[j]; }
        }
        __syncthreads();
        if (mode == 0) {
            if (seg == 3) { float A = 1.f, B = 0.f;
#pragma unroll
                for (int s2 = 0; s2 < 4; ++s2) { const float sa = SegA[(d2 * 4 + s2) * 64 + c], sb2 = SegB[(d2 * 4 + s2) * 64 + c]; B = sa * B + sb2; A *= sa; }
                AGG[agg_idx(b, gch, d2, 0, ch)] = A; AGG[agg_idx(b, gch, d2, 1, ch)] = B; }
        } else {
#pragma unroll
            for (int s2 = 0; s2 < 3; ++s2) if (s2 < seg) hin = SegA[(d2 * 4 + s2) * 64 + c] * hin + SegB[(d2 * 4 + s2) * 64 + c];
            float hh2 = hin;
#pragma unroll
            for (int k = 0; k < 16; ++k) { const int s = seg * 16 + k; const int t = d2 ? 63 - s : s; hh2 = av[k] * hh2 + bv[k]; Bv[(d2 * 64 + t) * 64 + c] = hh2; }
        }
    }
    __syncthreads();
    if (mode == 1) {
        const int t = tid >> 3, c8 = (tid & 7) * 8; bf16_t* gp = P + (seqrow0 + t0 + t) * PW + C_AG + nb * 64 + c8;
        float gt[8]; unpack8(*(const u32x4*)gp, gt); float y[8];
#pragma unroll
        for (int i = 0; i < 8; ++i) y[i] = (Bv[t * 64 + c8 + i] + Bv[(64 + t) * 64 + c8 + i]) * gelu_tanh(gt[i]);
        *(u32x4*)gp = pack8(y);
        __syncthreads();
    }
}

template <bool B> struct BoolC { static constexpr bool value = B; };
__device__ __forceinline__ void attn_item(const Params& p, int l, LAS unsigned char* lds, int item, int dry = 0) {
    LAS bf16_t* Kt = (LAS bf16_t*)lds;
    LAS float* rpbL = (LAS float*)(lds + 73728);
    LAS float* cosT = rpbL + 960;
    LAS float* sinT = cosT + 1024;
    LAS float* gq = sinT + 1024; LAS float* gk = gq + 64;
    bf16_t* P = (bf16_t*)(PF(ws) + WS_P); const float* rope = (const float*)(PF(ws) + WS_ROPE);
    const int tid = tid_(), w = __builtin_amdgcn_readfirstlane(tid >> 6), lane = tid & 63, l16 = lane & 15, q4 = lane >> 4, hh = w >> 2, qg4 = w & 3;
    const bool isctx = item >= 512;
    int b, hp, nloc, krU; int rq[2], kq0[2]; size_t qrow0[2];
    if (!isctx) { hp = item & 3; const int rp = (item >> 2) & 15; b = item >> 6;
        rq[0] = 2 * rp; rq[1] = 2 * rp + 1; kq0[0] = min(max(rq[0] - 4, 0), 24); kq0[1] = min(max(rq[1] - 4, 0), 24);
        qrow0[0] = (size_t)b * SEQ + rq[0] * 64; qrow0[1] = qrow0[0] + 64; krU = kq0[0]; nloc = kq0[1] + 8 - kq0[0]; }
    else { const int it = item - 512; hp = it & 3; const int qt = (it >> 2) & 1; b = it >> 3; rq[0] = rq[1] = 0; kq0[0] = kq0[1] = 0; krU = 0; nloc = 0;
        qrow0[0] = (size_t)NLAT + b * CTXL + qt * 128; qrow0[1] = qrow0[0] + 64; }
    const int h = hp * 2 + hh;
    const float* prpb = PF(na_rpb);
    for (int i = tid; i < 2 * 465; i += 512) { const int h2 = i / 465, j = i - h2 * 465; rpbL[h2 * 480 + j] = prpb[(size_t)((l * 8 + hp * 2 + h2) * 465) + j]; }
    for (int i = tid; i < 1024; i += 512) { cosT[i] = rope[i]; sinT[i] = rope[1024 + i]; }
    if (tid < 64) { gq[tid] = PF(na_qg)[l * 64 + tid]; gk[tid] = PF(na_kg)[l * 64 + tid]; }
    __syncthreads();
    const int qc = qg4 * 16 + l16;
    const int glo = qg4 < 2 ? 0 : qg4 - 1, ghi = qg4 == 0 ? 1 : (qg4 == 3 ? 3 : qg4 + 1);
    unsigned mbits = 0u; const int bbase = q4 * 4 - qc;
    { const int cs0 = min(max(qc - 8, 0), 48);
#pragma unroll
      for (int g = 0; g < 4; ++g)
#pragma unroll
          for (int j = 0; j < 4; ++j) { const int kc = g * 16 + q4 * 4 + j; if (kc < cs0 || kc >= cs0 + 16) mbits |= 1u << (g * 4 + j); } }
    bf16x8 qpl[2][2], qrt[2][2];
#pragma unroll
    for (int qi = 0; qi < 2; ++qi) {
        const bf16_t* qp = P + (qrow0[qi] + qc) * PW + C_CQ + h * 64;
        float xq[16]; unpack8(*(const u32x4*)(qp + q4 * 8), xq); unpack8(*(const u32x4*)(qp + 32 + q4 * 8), xq + 8);
        float ss = 0.f;
#pragma unroll
        for (int i = 0; i < 16; ++i) ss += xq[i] * xq[i];
        ss += __shfl_xor(ss, 16); ss += __shfl_xor(ss, 32);
        const float rs = rsqrtf(ss * (1.0f / 64.0f) + 1e-6f) * 0.125f;
#pragma unroll
        for (int i = 0; i < 8; ++i) { xq[i] *= rs * gq[q4 * 8 + i]; xq[8 + i] *= rs * gq[32 + q4 * 8 + i]; }
        qpl[qi][0] = as_bf16x8(pack8(xq)); qpl[qi][1] = as_bf16x8(pack8(xq + 8));
        float xr[16];
#pragma unroll
        for (int ks = 0; ks < 2; ++ks) { const int pos = ks == 0 ? rq[qi] : qc;
#pragma unroll
            for (int jj = 0; jj < 8; ++jj) { const int fi = (q4 & 1) * 8 + jj; const float cs = cosT[pos * 16 + fi], sn = sinT[pos * 16 + fi]; const float xv = xq[ks * 8 + jj]; const float pr = __shfl_xor(xv, 32);
                xr[ks * 8 + jj] = (q4 < 2) ? (xv * cs - pr * sn) : (xv * cs + pr * sn); } }
        qrt[qi][0] = as_bf16x8(pack8(xr)); qrt[qi][1] = as_bf16x8(pack8(xr + 8));
    }
    f32x4 O[2][4];
#pragma unroll
    for (int qi = 0; qi < 2; ++qi)
#pragma unroll
        for (int i = 0; i < 4; ++i) O[qi][i] = (f32x4){0.f, 0.f, 0.f, 0.f};
    float mrun[2] = {-1e30f, -1e30f}, lsum[2] = {0.f, 0.f};
    const int pf_hh2 = tid >> 8, pf_h2 = hp * 2 + pf_hh2, pf_key = (tid & 255) >> 2, pf_seg = tid & 3, pf_vseg = (tid & 255) >> 6, pf_vkey = tid & 63;
    u32x4 pk0, pk1, pv0, pv1;
    { const size_t r0 = nloc ? (size_t)b * SEQ + krU * 64 : (size_t)NLAT + b * CTXL;
      const bf16_t* kp = P + (r0 + pf_key) * PW + C_CK + pf_h2 * 64 + pf_seg * 16; pk0 = *(const u32x4*)kp; pk1 = *(const u32x4*)(kp + 8);
      const bf16_t* vp = P + (r0 + pf_vkey) * PW + C_CV + pf_h2 * 64 + pf_vseg * 16; pv0 = *(const u32x4*)vp; pv1 = *(const u32x4*)(vp + 8); }
    const int ntot = nloc + 4;
    float gkr[16];
#pragma unroll
    for (int i = 0; i < 16; ++i) gkr[i] = gk[pf_seg * 16 + i];
    auto stage = [&](int T, int buf) {
        const bool sloc = T < nloc; const int kr = krU + T;
        LAS bf16_t* KtB = Kt + buf * (4 * 64 * 72); LAS bf16_t* VtB = KtB + 2 * 64 * 72;
        {
            const int hh2 = pf_hh2, key = pf_key, seg = pf_seg;
            float xk[16]; unpack8(pk0, xk); unpack8(pk1, xk + 8);
            float ss = 0.f;
#pragma unroll
            for (int i = 0; i < 16; ++i) ss += xk[i] * xk[i];
            ss += dpp_xor1(ss); ss += dpp_xor2(ss);
            const float rs = rsqrtf(ss * (1.0f / 64.0f) + 1e-6f);
#pragma unroll
            for (int i = 0; i < 16; ++i) xk[i] *= rs * gkr[i];
            if (sloc) { const int pos = seg < 2 ? kr : key;
#pragma unroll
                for (int i = 0; i < 16; ++i) { const float pr = dpp_xor1(xk[i]); const float cs = cosT[pos * 16 + i], sn = sinT[pos * 16 + i]; xk[i] = (seg & 1) ? (xk[i] * cs + pr * sn) : (xk[i] * cs - pr * sn); } }
            LAS bf16_t* kd = KtB + (hh2 * 64 + key) * 72 + seg * 16;
            *(LAS u32x4*)kd = pack8(xk); *(LAS u32x4*)(kd + 8) = pack8(xk + 8);
        }
        {
            const int hh2 = pf_hh2, seg = pf_vseg, key = pf_vkey;
            const u32x4 a = pv0, c = pv1;
            LAS bf16_t* vd = VtB + (hh2 * 64 + seg * 16) * 72 + key;
            vd[0 * 72] = (bf16_t)(a.x & 0xffff); vd[1 * 72] = (bf16_t)(a.x >> 16); vd[2 * 72] = (bf16_t)(a.y & 0xffff); vd[3 * 72] = (bf16_t)(a.y >> 16);
            vd[4 * 72] = (bf16_t)(a.z & 0xffff); vd[5 * 72] = (bf16_t)(a.z >> 16); vd[6 * 72] = (bf16_t)(a.w & 0xffff); vd[7 * 72] = (bf16_t)(a.w >> 16);
            vd[8 * 72] = (bf16_t)(c.x & 0xffff); vd[9 * 72] = (bf16_t)(c.x >> 16); vd[10 * 72] = (bf16_t)(c.y & 0xffff); vd[11 * 72] = (bf16_t)(c.y >> 16);
            vd[12 * 72] = (bf16_t)(c.z & 0xffff); vd[13 * 72] = (bf16_t)(c.z >> 16); vd[14 * 72] = (bf16_t)(c.w & 0xffff); vd[15 * 72] = (bf16_t)(c.w >> 16);
        }
        { const int Tn = T + 1; if (Tn < ntot) { const size_t r0 = (Tn < nloc) ? (size_t)b * SEQ + (krU + Tn) * 64 : (size_t)NLAT + b * CTXL + (Tn - nloc) * 64;
            const bf16_t* kp = P + (r0 + pf_key) * PW + C_CK + pf_h2 * 64 + pf_seg * 16; pk0 = *(const u32x4*)kp; pk1 = *(const u32x4*)(kp + 8);
            const bf16_t* vp = P + (r0 + pf_vkey) * PW + C_CV + pf_h2 * 64 + pf_vseg * 16; pv0 = *(const u32x4*)vp; pv1 = *(const u32x4*)(vp + 8); } }
    };
    auto compute = [&](auto LOC, int T, int buf) {
        constexpr bool loc = decltype(LOC)::value; const int kr = krU + T;
        const LAS bf16_t* KtB = Kt + buf * (4 * 64 * 72); const LAS bf16_t* VtB = KtB + 2 * 64 * 72;
#pragma unroll
        for (int qi = 0; qi < 2; ++qi) {
            if (loc && (kr < kq0[qi] || kr >= kq0[qi] + 8)) continue;
            f32x4 st[4];
#pragma unroll
            for (int g = 0; g < 4; ++g) { const bool use = !loc || (g >= glo && g <= ghi);
                st[g] = (f32x4){0.f, 0.f, 0.f, 0.f};
                if (use) {
#pragma unroll
                    for (int ks = 0; ks < 2; ++ks) st[g] = mfma16(*(const LAS bf16x8*)(KtB + (hh * 64 + g * 16 + l16) * 72 + ks * 32 + q4 * 8), loc ? qrt[qi][ks] : qpl[qi][ks], st[g]);
                    if (loc) { const int dr31 = (kr - rq[qi] + 7) * 31;
#pragma unroll
                        for (int j = 0; j < 4; ++j) { const float sv = st[g][j] + rpbL[hh * 480 + min(max(bbase + g * 16 + j, -15), 15) + 15 + dr31]; st[g][j] = ((mbits >> (g * 4 + j)) & 1u) ? -1e30f : sv; } }
                } else st[g] = (f32x4){-1e30f, -1e30f, -1e30f, -1e30f};
            }
            float tmax = -1e30f;
#pragma unroll
            for (int g = 0; g < 4; ++g)
#pragma unroll
                for (int j = 0; j < 4; ++j) tmax = fmaxf(tmax, st[g][j]);
            tmax = fmaxf(tmax, __shfl_xor(tmax, 16)); tmax = fmaxf(tmax, __shfl_xor(tmax, 32));
            const float mnew = fmaxf(mrun[qi], tmax); const float alpha = fexp_(mrun[qi] - mnew); mrun[qi] = mnew;
            float psum = 0.f;
#pragma unroll
            for (int g = 0; g < 4; ++g) { const bool use = !loc || (g >= glo && g <= ghi);
                if (use) {
#pragma unroll
                    for (int j = 0; j < 4; ++j) { const float pv = fexp_(st[g][j] - mnew); st[g][j] = pv; psum += pv; }
                } else st[g] = (f32x4){0.f, 0.f, 0.f, 0.f}; }
            lsum[qi] = lsum[qi] * alpha + psum;
#pragma unroll
            for (int i = 0; i < 4; ++i) O[qi][i] *= alpha;
            bf16x8 pb[2];
#pragma unroll
            for (int ks = 0; ks < 2; ++ks) { u32x4 wv; wv.x = pack2(st[2 * ks][0], st[2 * ks][1]); wv.y = pack2(st[2 * ks][2], st[2 * ks][3]); wv.z = pack2(st[2 * ks + 1][0], st[2 * ks + 1][1]); wv.w = pack2(st[2 * ks + 1][2], st[2 * ks + 1][3]); pb[ks] = as_bf16x8(wv); }
#pragma unroll
            for (int ks = 0; ks < 2; ++ks) if (!loc || (2 * ks + 1 >= glo && 2 * ks <= ghi))
#pragma unroll
                for (int dg = 0; dg < 4; ++dg) { const LAS bf16_t* vr = VtB + (hh * 64 + dg * 16 + l16) * 72 + ks * 32 + q4 * 4;
                    const u32x2 lo = *(const LAS u32x2*)vr, hi = *(const LAS u32x2*)(vr + 16); u32x4 av; av.x = lo.x; av.y = lo.y; av.z = hi.x; av.w = hi.y;
                    O[qi][dg] = mfma16(as_bf16x8(av), pb[ks], O[qi][dg]); }
        }
    };
    stage(0, 0);
    __syncthreads();
    for (int T = 0; T < nloc; ++T) {
        stage(T + 1, (T + 1) & 1);
        compute(BoolC<true>{}, T, T & 1);
        __syncthreads();
    }
    for (int T = nloc; T < ntot; ++T) {
        if (T + 1 < ntot) stage(T + 1, (T + 1) & 1);
        compute(BoolC<false>{}, T, T & 1);
        __syncthreads();
    }
#pragma unroll
    for (int qi = 0; qi < 2; ++qi) {
        float ls = lsum[qi]; ls += __shfl_xor(ls, 16); ls += __shfl_xor(ls, 32);
        const float inv = 1.0f / ls;
        bf16_t* op = dry ? ((bf16_t*)(PF(ws) + WS_DUMMY) + (size_t)(blockIdx.x & 63) * 16384 + (size_t)((qi * 8 + w) * 16 + l16) * 64) : (P + (qrow0[qi] + qc) * PW + C_CQ + h * 64);
#pragma unroll
        for (int dg = 0; dg < 4; ++dg) { u32x2 wv; wv.x = pack2(O[qi][dg][0] * inv, O[qi][dg][1] * inv); wv.y = pack2(O[qi][dg][2] * inv, O[qi][dg][3] * inv); *(u32x2*)(op + dg * 16 + q4 * 4) = wv; }
    }
    __syncthreads();
}

__device__ __forceinline__ void hgrn_stage(const bf16_t* P, LAS unsigned char* lds, int w, int lane, size_t row0, int dir, int h) {
#pragma unroll
    for (int i = 0; i < 2; ++i) { const int blk = i * 8 + w; const int t = blk * 4 + (lane >> 4); const bf16_t* rp = P + (row0 + (dir ? 63 - t : t)) * PW + (lane & 15) * 8;
        __builtin_amdgcn_global_load_lds((const unsigned*)(rp + C_BQ + h * 128), (LAS unsigned*)(lds + 118784 + blk * 1024), 16, 0, 0);
        __builtin_amdgcn_global_load_lds((const unsigned*)(rp + C_BF + dir * 512 + h * 128), (LAS unsigned*)(lds + 135168 + blk * 1024), 16, 0, 0); }
}
__device__ __forceinline__ void hgrn_chain(const Params& p, int l, LAS unsigned char* lds, int chain, int dry = 0) {
    LAS bf16_t* Q0 = (LAS bf16_t*)lds;
    LAS bf16_t* KP = (LAS bf16_t*)(lds + 17408);
    LAS bf16_t* SB = (LAS bf16_t*)(lds + 34816);
    LAS bf16_t* KDT = (LAS bf16_t*)(lds + 69632);
    LAS bf16_t* VT = (LAS bf16_t*)(lds + 88064);
    LAS bf16_t* ATT = (LAS bf16_t*)(lds + 106496);
    LAS float* TOT = (LAS float*)(lds + 115712);
    LAS float* DD = (LAS float*)(lds + 117760);
    const LAS bf16_t* SQ = (const LAS bf16_t*)(lds + 118784);
    const LAS bf16_t* SF = (const LAS bf16_t*)(lds + 135168);
    bf16_t* P = (bf16_t*)(PF(ws) + WS_P);
    const int tid = tid_(), w = __builtin_amdgcn_readfirstlane(tid >> 6), lane = tid & 63, l16 = lane & 15, q4 = lane >> 4;
    const int dir = chain & 1, h = (chain >> 1) & 3, b = chain >> 3;
    const int d = tid & 127, sb = tid >> 7;
    float lbv = 0.f;
    if (l > 0) { const float x0 = PF(hg_lb)[(dir * 2 + 0) * 512 + h * 128 + d], x1 = PF(hg_lb)[(dir * 2 + 1) * 512 + h * 128 + d]; lbv = 1.0f / (1.0f + expf(x0 - x1)); }
    for (int i = tid; i < 64 * 72 / 2; i += 512) ((LAS unsigned*)ATT)[i] = 0u;
    f32x4 S[8];
#pragma unroll
    for (int i = 0; i < 8; ++i) S[i] = (f32x4){0.f, 0.f, 0.f, 0.f};
    { const int gch0 = dir == 0 ? 0 : 3; hgrn_stage(P, lds, w, lane, (size_t)NLAT + b * CTXL + gch0 * 64, dir, h); }
    asm volatile("s_waitcnt vmcnt(0)" ::: "memory");
    __syncthreads();
    for (int ci = 0; ci < 36; ++ci) {
        const int gch = dir == 0 ? ci : (ci < 4 ? 3 - ci : 39 - ci);
        const bool isctx = gch < 4; const int chunk = isctx ? gch : gch - 4;
        const size_t row0 = isctx ? (size_t)NLAT + b * CTXL + chunk * 64 : (size_t)b * SEQ + chunk * 64;
        float bl[16], qv[16], kv[16]; float run = 0.f;
        {
            unsigned vraw[16];
            { const bf16_t* vp = P + (row0 + (dir ? 63 - sb * 16 : sb * 16)) * PW + C_BI + h * 128 + d; const long vstep = dir ? -(long)PW : (long)PW;
#pragma unroll
              for (int ii = 0; ii < 16; ++ii) { vraw[ii] = *vp; vp += vstep; } }
#pragma unroll
            for (int eg = 0; eg < 8; ++eg) { u32x2 wv; wv.x = pack2(S[eg][0], S[eg][1]); wv.y = pack2(S[eg][2], S[eg][3]); *(LAS u32x2*)(SB + (eg * 16 + l16) * 136 + w * 16 + q4 * 4) = wv; }
#pragma unroll
            for (int ii = 0; ii < 16; ++ii) { const int t = sb * 16 + ii;
                const float fr = bf2f(SF[t * 128 + d]), qr = bf2f(SQ[t * 128 + d]);
                const float sg = __builtin_amdgcn_rcpf(1.0f + fexp_(-fr)); const float f = lbv + (1.0f - lbv) * sg; run += flog_(f); bl[ii] = run; kv[ii] = 1.0f - f; qv[ii] = qr * __builtin_amdgcn_rcpf(1.0f + fexp_(-qr)); }
            TOT[sb * 128 + d] = run;
            u32x4 v0, v1; v0.x = vraw[0] | (vraw[1] << 16); v0.y = vraw[2] | (vraw[3] << 16); v0.z = vraw[4] | (vraw[5] << 16); v0.w = vraw[6] | (vraw[7] << 16);
            v1.x = vraw[8] | (vraw[9] << 16); v1.y = vraw[10] | (vraw[11] << 16); v1.z = vraw[12] | (vraw[13] << 16); v1.w = vraw[14] | (vraw[15] << 16);
            *(LAS u32x4*)(VT + d * 72 + sb * 16) = v0; *(LAS u32x4*)(VT + d * 72 + sb * 16 + 8) = v1;
        }
        __syncthreads();
        if (ci < 35) { const int cn = ci + 1; const int gn = dir == 0 ? cn : (cn < 4 ? 3 - cn : 39 - cn); const bool cx = gn < 4; const int ck = cx ? gn : gn - 4;
            hgrn_stage(P, lds, w, lane, cx ? (size_t)NLAT + b * CTXL + ck * 64 : (size_t)b * SEQ + ck * 64, dir, h); }
        {
            const float t0 = TOT[d], t1 = TOT[128 + d], t2 = TOT[256 + d], t3 = TOT[384 + d];
            const float Bs1 = t0, Bs2 = t0 + t1, Bs3 = Bs2 + t2, total = Bs3 + t3;
            const float Bsb = sb == 0 ? 0.f : (sb == 1 ? Bs1 : (sb == 2 ? Bs2 : Bs3));
            const float eB = fexp_(Bsb), eT = fexp_(total);
            float kd[16];
#pragma unroll
            for (int ii = 0; ii < 16; ++ii) { const float e0 = fexp_(bl[ii]); Q0[(sb * 16 + ii) * 136 + d] = (bf16_t)pack2(qv[ii] * e0 * eB, 0.f);
                const float kp = kv[ii] * fexp_(fminf(-(Bsb + bl[ii]), 80.f)); KP[(sb * 16 + ii) * 136 + d] = (bf16_t)pack2(kp, 0.f); kd[ii] = kp * eT; }
            *(LAS u32x4*)(KDT + d * 72 + sb * 16) = pack8(kd); *(LAS u32x4*)(KDT + d * 72 + sb * 16 + 8) = pack8(kd + 8);
            if (sb == 0) DD[d] = eT;
        }
        __syncthreads();
        const bool need_o = !(l == 1 && isctx);
        if (need_o)
#pragma unroll
        for (int k2 = 0; k2 < 2; ++k2) { const int idx = w + 8 * k2;
            if (idx < 10) { const int i = idx < 1 ? 0 : (idx < 3 ? 1 : (idx < 6 ? 2 : 3)); const int j = idx - i * (i + 1) / 2;
                f32x4 sc = (f32x4){0.f, 0.f, 0.f, 0.f};
                const LAS bf16_t* qb = Q0 + (i * 16 + l16) * 136 + q4 * 8; const LAS bf16_t* kb = KP + (j * 16 + l16) * 136 + q4 * 8;
#pragma unroll
                for (int ks = 0; ks < 4; ++ks) sc = mfma16(*(const LAS bf16x8*)(qb + ks * 32), *(const LAS bf16x8*)(kb + ks * 32), sc);
#pragma unroll
                for (int jj = 0; jj < 4; ++jj) { const float v = (i == j && l16 > q4 * 4 + jj) ? 0.f : sc[jj]; ATT[(i * 16 + q4 * 4 + jj) * 72 + j * 16 + l16] = (bf16_t)pack2(v, 0.f); } } }
        __syncthreads();
        if (need_o) {
            bf16x8 SBf[4], VTf[2];
#pragma unroll
            for (int ks = 0; ks < 4; ++ks) SBf[ks] = *(const LAS bf16x8*)(SB + (w * 16 + l16) * 136 + ks * 32 + q4 * 8);
#pragma unroll
            for (int ks = 0; ks < 2; ++ks) VTf[ks] = *(const LAS bf16x8*)(VT + (w * 16 + l16) * 72 + ks * 32 + q4 * 8);
#pragma unroll
            for (int i = 0; i < 4; ++i) { f32x4 oa = (f32x4){0.f, 0.f, 0.f, 0.f};
#pragma unroll
                for (int ks = 0; ks < 4; ++ks) oa = mfma16(SBf[ks], *(const LAS bf16x8*)(Q0 + (i * 16 + l16) * 136 + ks * 32 + q4 * 8), oa);
#pragma unroll
                for (int ks = 0; ks < 2; ++ks) oa = mfma16(VTf[ks], *(const LAS bf16x8*)(ATT + (i * 16 + l16) * 72 + ks * 32 + q4 * 8), oa);
                const int t = i * 16 + l16; u32x2 wv; wv.x = pack2(oa[0], oa[1]); wv.y = pack2(oa[2], oa[3]);
                bf16_t* od = dry ? ((bf16_t*)(PF(ws) + WS_DUMMY) + (size_t)chain * 8192 + t * 128 + w * 16 + q4 * 4) : (P + (row0 + (dir ? 63 - t : t)) * PW + C_BF + dir * 512 + h * 128 + w * 16 + q4 * 4);
                *(u32x2*)od = wv; }
        }
        {
            const f32x4 dd = *(const LAS f32x4*)(DD + w * 16 + q4 * 4);
#pragma unroll
            for (int eg = 0; eg < 8; ++eg) S[eg] *= dd;
#pragma unroll
            for (int ks = 0; ks < 2; ++ks) { const bf16x8 A = *(const LAS bf16x8*)(KDT + (w * 16 + l16) * 72 + ks * 32 + q4 * 8);
#pragma unroll
                for (int eg = 0; eg < 8; ++eg) S[eg] = mfma16(A, *(const LAS bf16x8*)(VT + (eg * 16 + l16) * 72 + ks * 32 + q4 * 8), S[eg]); }
        }
        asm volatile("s_waitcnt vmcnt(0)" ::: "memory");
        __syncthreads();
    }
}

__global__ void __launch_bounds__(512, 2) fwd_megakernel(Params p) {
    extern __shared__ __attribute__((aligned(16))) unsigned char lds_raw[];
    LAS unsigned char* lds = (LAS unsigned char*)lds_raw;
    cg::grid_group grid = cg::this_grid();
    volatile LAS unsigned* xst = (volatile LAS unsigned*)(lds + LDS_BYTES - 16);
    if (threadIdx.x == 0) { xst[0] = 0u; xst[1] = 0u; xst[2] = 0u; xst[3] = 0u; }
    __syncthreads();
    const XcdBarrier xbar = xcd_barrier_post((unsigned*)(PF(ws) + WS_BAR), xst);
    const int G = gridDim.x, c = blockIdx.x;

    phase_mod(p, lds); __syncthreads();
    phase_rope(p);
    phase_convert(p, 0, lds);
    if (PF(ws) == nullptr) grid.sync();
    xcd_barrier(xbar);
#define WSP(T, off) ((T*)(PF(ws) + (off)))
    for (int l = 0; l < 2; ++l) {
        const bool lastl = (l == 1);
        const int Mrest = lastl ? NLAT : NTOK;
        if (l > 0) phase_convert(p, l, lds);
        phase_norm(p, l, l == 0 ? PF(x) : PF(out), l == 0 ? PF(ctx) : WSP(const float, WS_HC), PF(norm1_g) + l * DM, 0, NTOK,
                   (l > 0 && G == 256) ? (const float*)(PF(ws) + WS_P + (size_t)NTOK * DFF * 2) : nullptr, WSP(const float, WS_MOD) + (size_t)((l > 0 ? l - 1 : 0) * 9 + 8) * 6144 + 5120);
        xcd_barrier(xbar);

        { pg8::Gemm g{WSP(bf16_t, WS_U), WSP(bf16_t, WS_WIN), DM, DM, DM}; pg8::Sched S; S.init(NTOK, PW, G, c, DM, DM); pg8::EpiStore<0> E{WSP(bf16_t, WS_P), PW}; pg8::gemm_phase(lds, g, S, E); }
        xcd_barrier(xbar);
        {
            int staged = -1; float kc[3] = {0.f, 0.f, 0.f}; const LruPtrs lp = lru_ptrs();
            if (c < 64) hgrn_chain(p, l, lds, c);
            else { const int cc = c - 64, GG = G - 64; const int nA = lastl ? 512 : 576;
                for (int it = cc; it < nA; it += GG) attn_item(p, l, lds, it);
                for (int it = cc; it < 2304; it += GG) lru_tile(p, l, lds, it, 0, staged, lp, kc); }
            sub_barrier((unsigned*)(PF(ws) + WS_BAR) + 3520 + 64 * (2 * l + 1), (unsigned)G);
            if ((c & 7) != (staged & 7) || staged < 0) staged = -1;
            for (int it = c; it < 2304; it += G) { if (lastl && ((it >> 3) % 36) < 4) continue;
                lru_tile(p, l, lds, it, 1, staged, lp, kc); }
            if (G == 256) phase_hg_final(p, l, c >> 5, c & 31, 256); else if (c < 64) phase_hg_final(p, l, c >> 3, c & 7, 64);
        }
        xcd_barrier(xbar);
        { pg8::Gemm g{WSP(bf16_t, WS_U), WSP(bf16_t, WS_WIN) + (size_t)PW * DM, DM, DM, DM}; pg8::Sched S; S.init(Mrest, 3072, G, c, DM, DM); pg8::EpiStore<1> E{WSP(bf16_t, WS_P), PW}; pg8::gemm_phase(lds, g, S, E); }
        xcd_barrier(xbar);
        { pg8::Gemm g{WSP(bf16_t, WS_P), WSP(bf16_t, WS_WB), PW, 512, 512}; pg8::MergeSched S; S.base.init(Mrest, DM, G, c, PW, 512);
          pg8::EpiMerge E{WSP(bf16_t, WS_P), WSP(bf16_t, WS_U)}; pg8::gemm_phase(lds, g, S, E); }
        xcd_barrier(xbar);
        { pg8::Gemm g{WSP(bf16_t, WS_U), WSP(bf16_t, WS_WO), DM, DM, DM};
          pg8::EpiResid E{l == 0 ? PF(x) : PF(out), l == 0 ? PF(ctx) : WSP(const float, WS_HC), PF(out), WSP(float, WS_HC), WSP(const float, WS_MOD) + (size_t)l * 9 * 6144 + 2048, WSP(float, WS_P)};
          if (!lastl && G == 256) { pg8::SplitSched S; S.base.init(NLAT, DM, G, c, DM, DM); S.sk = 256; pg8::gemm_phase(lds, g, S, E); }
          else { pg8::Sched S; S.init(Mrest, DM, G, c, DM, DM); pg8::gemm_phase(lds, g, S, E); } }
        xcd_barrier(xbar);
        if (!lastl && G == 256) phase_norm(p, l, PF(out), l == 0 ? PF(ctx) : WSP(const float, WS_HC), PF(norm2_g) + l * DM, 3072, Mrest, WSP(const float, WS_P), WSP(const float, WS_MOD) + (size_t)(l * 9 + 8) * 6144 + 2048, WSP(float, WS_HC));
        else phase_norm(p, l, PF(out), WSP(const float, WS_HC), PF(norm2_g) + l * DM, 3072, Mrest);
        xcd_barrier(xbar);
        { pg8::Gemm g{WSP(bf16_t, WS_U), WSP(bf16_t, WS_W1), DM, DM, DM}; pg8::Sched S; S.init(Mrest, DFF, G, c, DM, DM); pg8::EpiStore<2> E{WSP(bf16_t, WS_P), DFF}; pg8::gemm_phase(lds, g, S, E); }
        xcd_barrier(xbar);
        { pg8::Gemm g{WSP(bf16_t, WS_P), WSP(bf16_t, WS_W2), DFF, DFF, DFF};
          float* slab = (float*)(PF(ws) + WS_P + (size_t)NTOK * DFF * 2);
          pg8::EpiResid E{PF(out), WSP(const float, WS_HC), PF(out), WSP(float, WS_HC), WSP(const float, WS_MOD) + (size_t)l * 9 * 6144 + 5120, slab};
          if (!lastl && G == 256) { pg8::SplitSched S; S.base.init(NLAT, DM, G, c, DFF, DFF); S.sk = 1024; pg8::gemm_phase(lds, g, S, E); }
          else { pg8::Sched S; S.init(Mrest, DM, G, c, DFF, DFF); pg8::gemm_phase(lds, g, S, E); } }
        if (!lastl) xcd_barrier(xbar);
    }
}

extern "C" void kernel_launch(void* const* d_in, const int* in_sizes, int n_in, void* d_out, int out_size, void* d_ws, size_t ws_size, hipStream_t stream) {
    static int grid_blocks = 0;
    if (grid_blocks == 0) {
        int dev = 0, cus = 0, per_cu = 0;
        hipGetDevice(&dev);
        hipDeviceGetAttribute(&cus, hipDeviceAttributeMultiprocessorCount, dev);
        hipFuncSetAttribute((const void*)fwd_megakernel, hipFuncAttributeMaxDynamicSharedMemorySize, LDS_BYTES);
        hipOccupancyMaxActiveBlocksPerMultiprocessor(&per_cu, (const void*)fwd_megakernel, 512, LDS_BYTES);
        if (per_cu < 1 || n_in != 25 || ws_size < WS_END) { fprintf(stderr, "kernel_launch: cannot launch (per_cu %d, n_in %d, ws %zu need %zu)\n", per_cu, n_in, ws_size, (size_t)WS_END); grid_blocks = -1; }
        else grid_blocks = cus;
    }
    if (grid_blocks < 0) return;
    hipMemsetAsync((char*)d_ws + WS_BAR, 0, 16384, stream);
    Params p{};
    const float** pp = (const float**)&p;
    for (int i = 0; i < 25; ++i) pp[i] = (const float*)d_in[i];
    p.out = (float*)d_out; p.ws = (unsigned char*)d_ws;
    void* args[] = {&p};
    hipError_t e = hipLaunchCooperativeKernel((const void*)fwd_megakernel, dim3(grid_blocks), dim3(512), args, LDS_BYTES, stream);
    if (e != hipSuccess) fprintf(stderr, "cooperative launch failed: %s (grid %d)\n", hipGetErrorString(e), grid_blocks);
}
```
